# Optimizing an MI355X kernel written in HIP

```python
import math
import jax
import jax.numpy as jnp
from jax import lax
import numpy as np


D_MODEL = 1024
BATCH = 8
SEQ = 4096
DEPTH = 4

MLA_HEADS = 8
MLA_NOPE = 64
MLA_ROPE = 32
MLA_V = 64
Q_LORA = 384
KV_LORA = 256
ROPE_THETA = 10000.0
Q_BLOCK = 128
NEG_INF = -1e30
RWKV_HEADS = 8
RWKV_HEAD = 64
RWKV_WIDTH = RWKV_HEADS * RWKV_HEAD
DECAY_LORA = 64
ICLR_LORA = 64
VRES_LORA = 32
GATE_LORA = 128
RWKV_GN_EPS = 64e-5
S5_GROUP = 16
S5_GROUPS = 32
S5_WIDTH = S5_GROUP * S5_GROUPS
S5_STATE = 64
N_BRANCH = 3
BRANCH_WIDTH = 512
MLA_IN = Q_LORA + KV_LORA + MLA_ROPE
RWKV_IN = 3 * RWKV_WIDTH + DECAY_LORA + ICLR_LORA + GATE_LORA
GATE_IN = N_BRANCH * D_MODEL
IN_WIDTH = MLA_IN + RWKV_IN + S5_WIDTH + GATE_IN
FFN_DIM = 2816
N_EXPERTS = 8
TOP_K = 2
EXPERT_DIM = 3584
MOE_BLOCK = 512
DEEPNORM_ALPHA = (2 * DEPTH) ** 0.25
DEEPNORM_BETA = (8 * DEPTH) ** -0.25
MAX_POS_OFFSET = 4096

kernel_name = 'hybrid_mla_rwkv7_s5_moe_trunk'


def _layer_norm(x, g, b, eps=1e-5):
    xf = x.astype(jnp.float32)
    xc = xf - jnp.mean(xf, axis=-1, keepdims=True)
    var = jnp.mean(xc * xc, axis=-1, keepdims=True)
    return (xc * lax.rsqrt(var + eps) * g.astype(jnp.float32) + b.astype(jnp.float32)).astype(x.dtype)


def _rms_norm(x, g, eps=1e-6):
    xf = x.astype(jnp.float32)
    return (xf * lax.rsqrt(jnp.mean(xf * xf, axis=-1, keepdims=True) + eps) * g.astype(jnp.float32)).astype(x.dtype)


def _rope(x, cos, sin):
    half = x.shape[-1] // 2
    x1, x2 = x[..., :half], x[..., half:]
    return jnp.concatenate([x1 * cos - x2 * sin, x1 * sin + x2 * cos], axis=-1).astype(x.dtype)


def _mla_branch(p, cos, sin, q_norm, w_uq, kv_norm, w_ukv):
    bsz, seq, _ = p.shape
    c_q = p[..., :Q_LORA]
    c_kv = p[..., Q_LORA:Q_LORA + KV_LORA]
    k_pe = _rope(p[..., Q_LORA + KV_LORA:], cos, sin)
    q = (_rms_norm(c_q, q_norm) @ w_uq).reshape(bsz, seq, MLA_HEADS, MLA_NOPE + MLA_ROPE)
    kv = (_rms_norm(c_kv, kv_norm) @ w_ukv).reshape(bsz, seq, MLA_HEADS, MLA_NOPE + MLA_V)
    q_nope = q[..., :MLA_NOPE]
    q_pe = _rope(q[..., MLA_NOPE:], cos[:, :, None], sin[:, :, None])
    k_nope, v = kv[..., :MLA_NOPE], kv[..., MLA_NOPE:]
    scale = (MLA_NOPE + MLA_ROPE) ** -0.5
    outs = []
    for blk in range(seq // Q_BLOCK):
        q0, q1 = blk * Q_BLOCK, (blk + 1) * Q_BLOCK
        s = (jnp.einsum('bqhd,bkhd->bhqk', q_nope[:, q0:q1], k_nope[:, :q1])
             + jnp.einsum('bqhr,bkr->bhqk', q_pe[:, q0:q1], k_pe[:, :q1]))
        s = s.astype(jnp.float32) * scale
        causal = (q0 + jnp.arange(Q_BLOCK))[:, None] >= jnp.arange(q1)[None, :]
        prob = jax.nn.softmax(jnp.where(causal, s, NEG_INF), axis=-1).astype(v.dtype)
        outs.append(jnp.einsum('bhqk,bkhd->bqhd', prob, v[:, :q1]))
    return jnp.concatenate(outs, axis=1).reshape(bsz, seq, MLA_HEADS * MLA_V)


def _rwkv7_step(state, inp):
    r, w, k, v, a, b = inp
    sa = jnp.einsum('bhij,bhj->bhi', state, a)
    state = state * w[:, :, None, :] + sa[..., None] * b[:, :, None, :] + v[..., None] * k[:, :, None, :]
    return state, jnp.einsum('bhij,bhj->bhi', state, r)


def _rwkv7_branch(p, v_first, mu, w0, w_up, a0, a_up, g_up, k_k, k_a, r_k, ln_g, ln_b, vres):
    bsz, seq, _ = p.shape
    prev = jnp.pad(p[:, :-1], ((0, 0), (1, 0), (0, 0)))
    p = p + (prev - p) * mu
    W = RWKV_WIDTH
    r, k, v = p[..., :W], p[..., W:2 * W], p[..., 2 * W:3 * W]
    o = 3 * W
    w_d = p[..., o:o + DECAY_LORA]
    a_d = p[..., o + DECAY_LORA:o + DECAY_LORA + ICLR_LORA]
    g_d = p[..., o + DECAY_LORA + ICLR_LORA:]
    w_log = -jax.nn.softplus(-(w0 + jnp.tanh(w_d) @ w_up).astype(jnp.float32)) - 0.5
    decay = jnp.exp(-jnp.exp(w_log))
    iclr = jax.nn.sigmoid((a0 + a_d @ a_up).astype(jnp.float32))
    g = jax.nn.sigmoid(g_d) @ g_up
    if vres is None:
        v_first = v
    else:
        vd, vu, vb = vres
        v = v + (v_first - v) * jax.nn.sigmoid(vb + (v @ vd) @ vu)
    def heads(t):
        return t.reshape(bsz, seq, RWKV_HEADS, RWKV_HEAD).astype(jnp.float32)
    r_h, v_h, dec_h, iclr_h = heads(r), heads(v), heads(decay), heads(iclr)
    kk = heads(k * k_k)
    kk = kk / jnp.maximum(jnp.sqrt(jnp.sum(kk * kk, axis=-1, keepdims=True)), 1e-12)
    k_a_h = k_a.reshape(RWKV_HEADS, RWKV_HEAD).astype(jnp.float32)
    k_h = heads(k) * (1.0 + (iclr_h - 1.0) * k_a_h)
    def tm(t):
        return jnp.moveaxis(t, 1, 0)
    s0 = jnp.zeros((bsz, RWKV_HEADS, RWKV_HEAD, RWKV_HEAD), jnp.float32)
    _, y = lax.scan(_rwkv7_step, s0, (tm(r_h), tm(dec_h), tm(k_h), tm(v_h), tm(-kk), tm(kk * iclr_h)))
    y = jnp.moveaxis(y, 0, 1)
    yc = y - jnp.mean(y, axis=-1, keepdims=True)
    y = yc * lax.rsqrt(jnp.mean(yc * yc, axis=-1, keepdims=True) + RWKV_GN_EPS)
    y = y.reshape(bsz, seq, W) * ln_g.astype(jnp.float32) + ln_b.astype(jnp.float32)
    bonus = jnp.sum(r_h * k_h * r_k.astype(jnp.float32), axis=-1, keepdims=True) * v_h
    out = (y + bonus.reshape(bsz, seq, W)) * g.astype(jnp.float32)
    return out.astype(p.dtype), v_first


def _complex_linear_combine(e1, e2):
    a1r, a1i, b1r, b1i = e1
    a2r, a2i, b2r, b2i = e2
    return (a1r * a2r - a1i * a2i, a1r * a2i + a1i * a2r,
            a2r * b1r - a2i * b1i + b2r, a2r * b1i + a2i * b1r + b2i)


def _s5_branch(u, a_re, a_im, log_dt, b_re, b_im, c_re, c_im, d, w_glu, b_glu):
    bsz, seq, _ = u.shape
    uf = u.astype(jnp.float32).reshape(bsz, seq, S5_GROUPS, S5_GROUP)
    dt = jnp.exp(log_dt.astype(jnp.float32))[:, None]
    lam_re = jnp.minimum(a_re.astype(jnp.float32), -1e-4)
    lam_im = a_im.astype(jnp.float32)
    mag = jnp.exp(dt * lam_re)
    ab_re, ab_im = mag * jnp.cos(dt * lam_im), mag * jnp.sin(dt * lam_im)
    den = lam_re * lam_re + lam_im * lam_im
    f_re = ((ab_re - 1.0) * lam_re + ab_im * lam_im) / den
    f_im = (ab_im * lam_re - (ab_re - 1.0) * lam_im) / den
    bb_re = f_re[..., None] * b_re - f_im[..., None] * b_im
    bb_im = f_re[..., None] * b_im + f_im[..., None] * b_re
    bu_re = jnp.einsum('bsgc,gpc->bsgp', uf, bb_re)
    bu_im = jnp.einsum('bsgc,gpc->bsgp', uf, bb_im)
    a_seq_re = jnp.broadcast_to(ab_re, (bsz, seq, S5_GROUPS, S5_STATE))
    a_seq_im = jnp.broadcast_to(ab_im, (bsz, seq, S5_GROUPS, S5_STATE))
    _, _, x_re, x_im = lax.associative_scan(_complex_linear_combine, (a_seq_re, a_seq_im, bu_re, bu_im), axis=1)
    y = (jnp.einsum('bsgp,gcp->bsgc', x_re, c_re) - jnp.einsum('bsgp,gcp->bsgc', x_im, c_im)
         + d.astype(jnp.float32) * uf)
    y = jax.nn.gelu(y.reshape(bsz, seq, S5_WIDTH))
    return (y * jax.nn.sigmoid(y @ w_glu + b_glu)).astype(u.dtype)


def _swiglu(h, w_gate, w_up, w_down):
    return (jax.nn.silu(h @ w_gate) * (h @ w_up)) @ w_down


def _moe_swiglu(h, router, w_gate, w_up, w_down):
    bsz, seq, dm = h.shape
    ht = h.reshape(-1, dm)
    n_tok = ht.shape[0]
    n_pair = n_tok * TOP_K
    logits = (ht @ router).astype(jnp.float32)
    top_logit, top_e = lax.top_k(logits, TOP_K)
    top_w = jax.nn.softmax(top_logit, axis=-1)
    pair_e = top_e.reshape(-1)
    pair_tok = jnp.arange(n_pair, dtype=jnp.int32) // TOP_K
    order = jnp.argsort(pair_e)
    se = pair_e[order]
    counts = jnp.bincount(pair_e, length=N_EXPERTS)
    start = jnp.cumsum(counts) - counts
    padded = (counts + MOE_BLOCK - 1) // MOE_BLOCK * MOE_BLOCK
    pad_end = jnp.cumsum(padded)
    pad_start = pad_end - padded
    dest = pad_start[se] + jnp.arange(n_pair, dtype=jnp.int32) - start[se]
    n_blocks = n_pair // MOE_BLOCK + N_EXPERTS
    slot_tok = jnp.zeros((n_blocks * MOE_BLOCK,), jnp.int32).at[dest].set(pair_tok[order])
    slot_w = jnp.zeros((n_blocks * MOE_BLOCK,), jnp.float32).at[dest].set(top_w.reshape(-1)[order])
    block_e = jnp.minimum(jnp.searchsorted(pad_end, jnp.arange(n_blocks, dtype=jnp.int32) * MOE_BLOCK, side='right'), N_EXPERTS - 1)
    def expert_block(args):
        tok, e = args
        xb = ht[tok]
        return (jax.nn.silu(xb @ w_gate[e]) * (xb @ w_up[e])) @ w_down[e]
    y = lax.map(expert_block, (slot_tok.reshape(n_blocks, MOE_BLOCK), block_e))
    y = y.reshape(-1, dm).astype(jnp.float32) * slot_w[:, None]
    out = jax.ops.segment_sum(y, slot_tok, num_segments=n_tok)
    return out.astype(h.dtype).reshape(bsz, seq, dm)


def setup_inputs(seed: int = 0) -> dict:
    key = jax.random.key(seed)
    ks = iter(jax.random.split(key, 64))
    L = DEPTH
    nd = (DEPTH + 1) // 2
    nm = DEPTH // 2
    f32 = jnp.float32
    def normal(shape, scale):
        return jax.random.normal(next(ks), shape, f32) * scale
    def uniform(shape, lo, hi):
        return jax.random.uniform(next(ks), shape, f32, lo, hi)
    beta = DEEPNORM_BETA
    x = normal((BATCH, SEQ, D_MODEL), 1.0)
    offset = jax.random.randint(next(ks), (BATCH, 1), 0, MAX_POS_OFFSET, dtype=jnp.int32)
    positions = (offset + jnp.arange(SEQ, dtype=jnp.int32)[None, :]).astype(jnp.int32)
    inp = {
        'x': x,
        'positions': positions,
        'w_in': normal((L, D_MODEL, IN_WIDTH), D_MODEL ** -0.5),
        'mla_q_norm': 1.0 + normal((L, Q_LORA), 0.02),
        'mla_w_uq': normal((L, Q_LORA, MLA_HEADS * (MLA_NOPE + MLA_ROPE)), Q_LORA ** -0.5),
        'mla_kv_norm': 1.0 + normal((L, KV_LORA), 0.02),
        'mla_w_ukv': normal((L, KV_LORA, MLA_HEADS * (MLA_NOPE + MLA_V)), KV_LORA ** -0.5),
        'rwkv_mu': uniform((L, RWKV_IN), 0.0, 1.0),
        'rwkv_w0': uniform((L, RWKV_WIDTH), -6.0, -1.0),
        'rwkv_w_up': normal((L, DECAY_LORA, RWKV_WIDTH), 0.1 * DECAY_LORA ** -0.5),
        'rwkv_a0': normal((L, RWKV_WIDTH), 0.1),
        'rwkv_a_up': normal((L, ICLR_LORA, RWKV_WIDTH), ICLR_LORA ** -0.5),
        'rwkv_g_up': normal((L, GATE_LORA, RWKV_WIDTH), GATE_LORA ** -0.5),
        'rwkv_k_k': 0.85 + normal((L, RWKV_WIDTH), 0.02),
        'rwkv_k_a': 1.0 + normal((L, RWKV_WIDTH), 0.02),
        'rwkv_r_k': normal((L, RWKV_HEADS, RWKV_HEAD), 0.1),
        'rwkv_ln_g': 1.0 + normal((L, RWKV_WIDTH), 0.02),
        'rwkv_ln_b': normal((L, RWKV_WIDTH), 0.02),
        'rwkv_vres_down': normal((L - 1, RWKV_WIDTH, VRES_LORA), RWKV_WIDTH ** -0.5),
        'rwkv_vres_up': normal((L - 1, VRES_LORA, RWKV_WIDTH), VRES_LORA ** -0.5),
        'rwkv_vres_b': normal((L - 1, RWKV_WIDTH), 0.1),
        's5_a_re': -0.5 + normal((L, S5_GROUPS, S5_STATE), 0.01),
        's5_a_im': math.pi * jnp.arange(S5_STATE, dtype=f32) + normal((L, S5_GROUPS, S5_STATE), 0.01),
        's5_log_dt': uniform((L, S5_GROUPS), math.log(0.001), math.log(0.1)),
        's5_b_re': normal((L, S5_GROUPS, S5_STATE, S5_GROUP), (2 * S5_GROUP) ** -0.5),
        's5_b_im': normal((L, S5_GROUPS, S5_STATE, S5_GROUP), (2 * S5_GROUP) ** -0.5),
        's5_c_re': normal((L, S5_GROUPS, S5_GROUP, S5_STATE), S5_STATE ** -0.5),
        's5_c_im': normal((L, S5_GROUPS, S5_GROUP, S5_STATE), S5_STATE ** -0.5),
        's5_d': normal((L, S5_GROUPS, S5_GROUP), 1.0),
        's5_w_glu': normal((L, S5_WIDTH, S5_WIDTH), S5_WIDTH ** -0.5),
        's5_b_glu': normal((L, S5_WIDTH), 0.02),
        'w_branch': normal((L, N_BRANCH, BRANCH_WIDTH, D_MODEL), beta * BRANCH_WIDTH ** -0.5),
        'w_out': normal((L, D_MODEL, D_MODEL), beta * D_MODEL ** -0.5),
        'ln1_g': 1.0 + normal((L, D_MODEL), 0.02),
        'ln1_b': normal((L, D_MODEL), 0.02),
        'ln2_g': 1.0 + normal((L, D_MODEL), 0.02),
        'ln2_b': normal((L, D_MODEL), 0.02),
        'ffn_w_gate': normal((nd, D_MODEL, FFN_DIM), D_MODEL ** -0.5),
        'ffn_w_up': normal((nd, D_MODEL, FFN_DIM), D_MODEL ** -0.5),
        'ffn_w_down': normal((nd, FFN_DIM, D_MODEL), beta * FFN_DIM ** -0.5),
        'moe_router': normal((nm, D_MODEL, N_EXPERTS), D_MODEL ** -0.5),
        'moe_w_gate': normal((nm, N_EXPERTS, D_MODEL, EXPERT_DIM), D_MODEL ** -0.5),
        'moe_w_up': normal((nm, N_EXPERTS, D_MODEL, EXPERT_DIM), D_MODEL ** -0.5),
        'moe_w_down': normal((nm, N_EXPERTS, EXPERT_DIM, D_MODEL), beta * EXPERT_DIM ** -0.5),
    }
    return inp


def reference(x, positions, w_in, mla_q_norm, mla_w_uq, mla_kv_norm, mla_w_ukv,
              rwkv_mu, rwkv_w0, rwkv_w_up, rwkv_a0, rwkv_a_up, rwkv_g_up, rwkv_k_k, rwkv_k_a,
              rwkv_r_k, rwkv_ln_g, rwkv_ln_b, rwkv_vres_down, rwkv_vres_up, rwkv_vres_b,
              s5_a_re, s5_a_im, s5_log_dt, s5_b_re, s5_b_im, s5_c_re, s5_c_im, s5_d, s5_w_glu, s5_b_glu,
              w_branch, w_out, ln1_g, ln1_b, ln2_g, ln2_b,
              ffn_w_gate, ffn_w_up, ffn_w_down, moe_router, moe_w_gate, moe_w_up, moe_w_down):
    bsz, seq, _ = x.shape
    inv_freq = ROPE_THETA ** (-jnp.arange(0, MLA_ROPE, 2, dtype=jnp.float32) / MLA_ROPE)
    ang = positions.astype(jnp.float32)[..., None] * inv_freq
    cos, sin = jnp.cos(ang), jnp.sin(ang)
    o1 = MLA_IN
    o2 = o1 + RWKV_IN
    o3 = o2 + S5_WIDTH
    v_first = None
    for l in range(DEPTH):
        proj = x @ w_in[l]
        y_mla = _mla_branch(proj[..., :o1], cos, sin, mla_q_norm[l], mla_w_uq[l], mla_kv_norm[l], mla_w_ukv[l])
        vres = None if l == 0 else (rwkv_vres_down[l - 1], rwkv_vres_up[l - 1], rwkv_vres_b[l - 1])
        y_rwkv, v_first = _rwkv7_branch(proj[..., o1:o2], v_first, rwkv_mu[l], rwkv_w0[l], rwkv_w_up[l],
                                        rwkv_a0[l], rwkv_a_up[l], rwkv_g_up[l], rwkv_k_k[l], rwkv_k_a[l],
                                        rwkv_r_k[l], rwkv_ln_g[l], rwkv_ln_b[l], vres)
        y_s5 = _s5_branch(proj[..., o2:o3], s5_a_re[l], s5_a_im[l], s5_log_dt[l], s5_b_re[l], s5_b_im[l],
                          s5_c_re[l], s5_c_im[l], s5_d[l], s5_w_glu[l], s5_b_glu[l])
        gates = jax.nn.sigmoid(proj[..., o3:].reshape(bsz, seq, N_BRANCH, D_MODEL))
        branches = jnp.stack([y_mla, y_rwkv, y_s5], axis=2)
        mixed = jnp.sum(gates * jnp.einsum('bsnc,ncd->bsnd', branches, w_branch[l]), axis=2)
        x = _layer_norm(DEEPNORM_ALPHA * x + mixed @ w_out[l], ln1_g[l], ln1_b[l])
        if l % 2 == 0:
            f = _swiglu(x, ffn_w_gate[l // 2], ffn_w_up[l // 2], ffn_w_down[l // 2])
        else:
            f = _moe_swiglu(x, moe_router[l // 2], moe_w_gate[l // 2], moe_w_up[l // 2], moe_w_down[l // 2])
        x = _layer_norm(DEEPNORM_ALPHA * x + f, ln2_g[l], ln2_b[l])
    return x
```

```cpp
#include <hip/hip_runtime.h>
#include <cstdio>
#include <cstdint>
#include <cmath>
namespace pg8 {
#define PG8_LAS __attribute__((address_space(3)))
typedef unsigned short bf16_t;
typedef short bf16x8 __attribute__((ext_vector_type(8)));
typedef float f32x4 __attribute__((ext_vector_type(4)));
typedef float f32x2 __attribute__((ext_vector_type(2)));
typedef unsigned u32x4 __attribute__((ext_vector_type(4)));
typedef unsigned u32x2 __attribute__((ext_vector_type(2)));
constexpr int BM = 256, BK = 64, HALF = 128, HTB = HALF * BK * 2  , STAGE_BYTES = 8 * HTB, NXCD = 8, WGM = 8;

__host__ __device__ __forceinline__ int lds_byte(int r, int c) { const int st = (r >> 4) * 2 + (c >> 5), rr = r & 15, cc = c & 31, ob = rr * 64 + cc * 2; return st * 1024 + (ob ^ (((ob >> 9) & 1) << 5)); }
__host__ __device__ __forceinline__ void stage_rc(int b, int& R, int& C) { const int st = b / 1024, sb = b % 1024, swz = sb ^ (((sb >> 9) & 1) << 5); R = (st >> 1) * 16 + swz / 64; C = (st & 1) * 32 + (swz % 64) / 2; }
__host__ __device__ __forceinline__ int perm32(int rho) { const int n = rho >> 4, i = rho & 15; return 8 * (i >> 2) + 4 * n + (i & 3); }

struct Unit { int pm, pn, z, aux; };

struct LocDense {
    static constexpr bool GATHER = false;
    const bf16_t* A; const bf16_t* Bt; int lda, ldb, K; size_t zA, zB;
    __device__ __forceinline__ const char* a_ptr(const Unit& u) const { return (const char*)(A + (size_t)u.z * zA + (size_t)u.pm * BM * lda); }
    __device__ __forceinline__ const char* b_ptr(const Unit& u) const { return (const char*)(Bt + (size_t)u.z * zB + (size_t)u.pn * BM * ldb); }
    __device__ __forceinline__ void a_off(const Unit&, int tid, unsigned (&v)[2][2]) const {
#pragma unroll
        for (int i = 0; i < 2; ++i) { int R, C; stage_rc(tid * 16 + i * 8192, R, C); v[0][i] = (unsigned)(R * lda + C) * 2u; v[1][i] = 0u; }
    }
};

struct StaticOrder {
    int nM, nN, nwg, nZ, G, c;
    __device__ void init(int M, int N, int Z, int G_, int c_) { nM = M / BM; nN = N / BM; nwg = nM * nN; nZ = Z; G = G_; c = c_; }
    __device__ bool next(int i, Unit& u) const {
        const long L = (long)i * G + c; if (L >= (long)nwg * nZ) return false;
        u.z = (int)(L / nwg); u.aux = 0;
        int wgid = (int)(L % nwg); { const int q = nwg / NXCD, r = nwg % NXCD, xcd = wgid % NXCD, off = wgid / NXCD; wgid = (xcd < r ? xcd * (q + 1) : r * (q + 1) + (xcd - r) * q) + off; }
        const int nig = WGM * nN, gid = wgid / nig, fm = gid * WGM, gsz = (nM - fm) < WGM ? (nM - fm) : WGM;
        u.pm = fm + ((wgid % nig) % gsz); u.pn = (wgid % nig) / gsz; return true;
    }
};

typedef float f32x2_cv __attribute__((ext_vector_type(2))); typedef __bf16 bf16x2_cv __attribute__((ext_vector_type(2)));
__device__ __forceinline__ unsigned cvt_pk_bf16(float lo, float hi) { const f32x2_cv v = {lo, hi}; const bf16x2_cv b = __builtin_convertvector(v, bf16x2_cv); return __builtin_bit_cast(unsigned, b); }
__device__ __forceinline__ u32x4 pack8(const f32x4 v0, const f32x4 v1) { u32x4 w; w.x = cvt_pk_bf16(v0[0], v0[1]); w.y = cvt_pk_bf16(v0[2], v0[3]); w.z = cvt_pk_bf16(v1[0], v1[1]); w.w = cvt_pk_bf16(v1[2], v1[3]); return w; }
__device__ __forceinline__ float bf_lo(unsigned w) { return __uint_as_float(w << 16); }
__device__ __forceinline__ float bf_hi(unsigned w) { return __uint_as_float(w & 0xffff0000u); }
__device__ __forceinline__ void unpack8(const u32x4 w, f32x4& v0, f32x4& v1) { v0 = (f32x4){bf_lo(w.x), bf_hi(w.x), bf_lo(w.y), bf_hi(w.y)}; v1 = (f32x4){bf_lo(w.z), bf_hi(w.z), bf_lo(w.w), bf_hi(w.w)}; }

struct NoPre {};
template <class F> struct Epi8 {
    static constexpr bool PERM = true;
    F f;
    __device__ __forceinline__ void operator()(const f32x4 (&acc)[2][2][4][2], const Unit& u, int wr, int wc, int fr, int fq) const {
        const int row0 = u.pm * BM + wr * 64 + fr, col0 = u.pn * BM + wc * 32 + 8 * fq;
        F g = f;
#pragma unroll
        for (int bj = 0; bj < 2; ++bj) { const int col = col0 + bj * HALF; g.begin_col(u, col);
#pragma unroll
            for (int b0 = 0; b0 < 8; b0 += F::BATCH) { typename F::Pre pr[F::BATCH];
#pragma unroll
                for (int i = 0; i < F::BATCH; ++i) { const int q = b0 + i; pr[i] = g.pre(u, row0 + (q >> 2) * HALF + (q & 3) * 16, col); }
#pragma unroll
                for (int i = 0; i < F::BATCH; ++i) { const int q = b0 + i; g.tile8(u, row0 + (q >> 2) * HALF + (q & 3) * 16, col, acc[q >> 2][bj][q & 3][0], acc[q >> 2][bj][q & 3][1], pr[i]); }
                asm volatile("" ::: "memory"); } }
    }
};
template <class F> struct EpiGU {
    static constexpr bool PERM = true;
    F f;
    __device__ __forceinline__ void operator()(const f32x4 (&acc)[2][2][4][2], const Unit& u, int wr, int wc, int fr, int fq) const {
        const int row0 = u.pm * BM + wr * 64 + fr, colh = u.pn * HALF + wc * 32 + 8 * fq;
#pragma unroll
        for (int ai = 0; ai < 2; ++ai)
#pragma unroll
            for (int m = 0; m < 4; ++m) { f.pair8(u, row0 + ai * HALF + m * 16, colh, acc[ai][0][m][0], acc[ai][0][m][1], acc[ai][1][m][0], acc[ai][1][m][1]); asm volatile("" ::: "memory"); }
    }
};

template <class Epi, class Sched, class Loc>
__device__ __forceinline__ void gemm_phase(PG8_LAS unsigned char* lds, const Loc& L, const Sched& S, const Epi& E) {
    int tid_ = threadIdx.x; asm volatile("" : "+v"(tid_));
    const int tid = tid_, wid = __builtin_amdgcn_readfirstlane(tid >> 6), lane = tid & 63, wr = wid >> 2, wc = wid & 3, fr = lane & 15, fq = lane >> 4;
    const int K = L.K, nt = K / BK;
    unsigned voffB[2];
#pragma unroll
    for (int i = 0; i < 2; ++i) { int R, C; stage_rc(tid * 16 + i * 8192, R, C); const int Rb = Epi::PERM ? ((R & ~31) + perm32(R & 31)) : R;
        voffB[i] = (unsigned)(Rb * L.ldb + C) * 2u; }
    const size_t kstep = (size_t)(BK * 2);
    const size_t hstepB = (size_t)HALF * L.ldb * 2;
    const unsigned ldsw = (unsigned)wid * 1024u;
    const int aoff = lds_byte(wr * 64 + fr, fq * 8), boff = lds_byte(wc * 32 + fr, fq * 8);
#define PG8_SA(b, h) (((b) * 2 + (h)) * HTB)
#define PG8_SB(b, h) ((4 + (b) * 2 + (h)) * HTB)
#define PG8_STAGE(bufoff, gbase, voff) do { _Pragma("unroll") for (int _i = 0; _i < 2; ++_i) \
        __builtin_amdgcn_global_load_lds((const unsigned*)((const char*)(gbase) + (voff)[_i]), (PG8_LAS unsigned*)(lds + (bufoff) + ldsw + _i * 8192), 16, 0, 0); } while (0)
#define PG8_LDA(dst, b, h) do { _Pragma("unroll") for (int m = 0; m < 4; ++m) _Pragma("unroll") for (int k = 0; k < 2; ++k) dst[m][k] = *(const PG8_LAS bf16x8*)(lds + PG8_SA(b, h) + aoff + m * 2048 + k * 1024); } while (0)
#define PG8_LDB(dst, b, h) do { _Pragma("unroll") for (int n = 0; n < 2; ++n) _Pragma("unroll") for (int k = 0; k < 2; ++k) dst[n][k] = *(const PG8_LAS bf16x8*)(lds + PG8_SB(b, h) + boff + n * 2048 + k * 1024); } while (0)
#define PG8_MMA(ai, bj, At, Bt) do { __builtin_amdgcn_s_setprio(1); _Pragma("unroll") for (int m = 0; m < 4; ++m) _Pragma("unroll") for (int n = 0; n < 2; ++n) _Pragma("unroll") for (int k = 0; k < 2; ++k) \
        acc[ai][bj][m][n] = __builtin_amdgcn_mfma_f32_16x16x32_bf16(Bt[n][k], At[m][k], acc[ai][bj][m][n], 0, 0, 0); __builtin_amdgcn_s_setprio(0); } while (0)
#define PG8_WAIT_V(n) asm volatile("s_waitcnt vmcnt(" #n ")" ::: "memory")
#define PG8_WAIT_L(n) asm volatile("s_waitcnt lgkmcnt(" #n ")" ::: "memory")
#define PG8_BAR __builtin_amdgcn_s_barrier()
#define PG8_SCHED __builtin_amdgcn_sched_barrier(0)
    Unit cur, nxt; int ui = 0;
    if (!S.next(0, cur)) return;
    f32x4 acc[2][2][4][2];
#pragma unroll
    for (int a = 0; a < 2; ++a)
#pragma unroll
        for (int b = 0; b < 2; ++b)
#pragma unroll
            for (int m = 0; m < 4; ++m)
#pragma unroll
                for (int n = 0; n < 2; ++n) acc[a][b][m][n] = (f32x4){0.f, 0.f, 0.f, 0.f};
    bf16x8 At[4][2], B0[2][2], B1[2][2];
    constexpr int NVH = Loc::GATHER ? 2 : 1;
    unsigned vc[2][2], vn[NVH][2];
    L.a_off(cur, tid, vc);
    if constexpr (Loc::GATHER) {
#pragma unroll
        for (int h = 0; h < 2; ++h)
#pragma unroll
            for (int i = 0; i < 2; ++i) vn[h][i] = vc[h][i];
    }
    const size_t hstepA = Loc::GATHER ? 0 : (size_t)HALF * L.lda * 2;
    const char* cA = L.a_ptr(cur); const char* cB = L.b_ptr(cur);
    PG8_STAGE(PG8_SB(0, 0), cB, voffB); PG8_STAGE(PG8_SB(0, 1), cB + hstepB, voffB); PG8_STAGE(PG8_SA(0, 0), cA, vc[0]); PG8_STAGE(PG8_SA(0, 1), cA + hstepA, vc[NVH - 1]);
    if (wr == 1) PG8_BAR;
    PG8_WAIT_V(2); PG8_BAR;
    PG8_STAGE(PG8_SB(1, 0), cB + kstep, voffB); PG8_STAGE(PG8_SA(1, 0), cA + kstep, vc[0]); PG8_STAGE(PG8_SB(1, 1), cB + hstepB + kstep, voffB);
    PG8_WAIT_V(6); PG8_BAR;
    for (;;) {
        const bool has_next = S.next(ui + 1, nxt);
        const char* nA = has_next ? L.a_ptr(nxt) : cA; const char* nB = has_next ? L.b_ptr(nxt) : cB;
        if constexpr (Loc::GATHER) { if (has_next) L.a_off(nxt, tid, vn); }
        for (int t = 0; t < nt; t += 2) {
            const bool last = (t == nt - 2);
            const char* a1 = cA + (size_t)(t + 1) * kstep;
            const char* a2 = last ? nA : cA + (size_t)(t + 2) * kstep; const char* b2 = last ? nB : cB + (size_t)(t + 2) * kstep;
            const char* a3 = a2 + kstep; const char* b3 = b2 + kstep;
            PG8_LDB(B0, 0, 0); PG8_LDB(B1, 0, 1); PG8_SCHED; PG8_LDA(At, 0, 0); PG8_STAGE(PG8_SA(1, 1), a1 + hstepA, vc[NVH - 1]);
            if constexpr (Loc::GATHER) { if (last) {
#pragma unroll
                for (int h = 0; h < 2; ++h)
#pragma unroll
                    for (int i = 0; i < 2; ++i) vc[h][i] = vn[h][i]; } }
            PG8_WAIT_V(8); PG8_WAIT_L(0); PG8_BAR; PG8_MMA(0, 0, At, B0); PG8_MMA(0, 1, At, B1); PG8_BAR; PG8_SCHED;
            PG8_LDA(At, 0, 1); PG8_STAGE(PG8_SB(0, 0), b2, voffB); PG8_STAGE(PG8_SB(0, 1), b2 + hstepB, voffB); PG8_STAGE(PG8_SA(0, 0), a2, vc[0]);
            PG8_WAIT_V(8); PG8_WAIT_L(0); PG8_BAR; PG8_MMA(1, 0, At, B0); PG8_MMA(1, 1, At, B1); PG8_BAR; PG8_SCHED;
            PG8_LDB(B0, 1, 0); PG8_LDB(B1, 1, 1); PG8_SCHED; PG8_LDA(At, 1, 0); PG8_STAGE(PG8_SA(0, 1), a2 + hstepA, vc[NVH - 1]);
            PG8_WAIT_V(8); PG8_WAIT_L(0); PG8_BAR; PG8_MMA(0, 0, At, B0); PG8_MMA(0, 1, At, B1); PG8_BAR; PG8_SCHED;
            PG8_LDA(At, 1, 1); PG8_STAGE(PG8_SB(1, 0), b3, voffB); PG8_STAGE(PG8_SB(1, 1), b3 + hstepB, voffB); PG8_STAGE(PG8_SA(1, 0), a3, vc[0]);
            PG8_WAIT_V(8); PG8_WAIT_L(0); PG8_BAR; PG8_MMA(1, 0, At, B0); PG8_MMA(1, 1, At, B1); PG8_BAR; PG8_SCHED;
        }
        if (wr == 0) PG8_BAR;
        E(acc, cur, wr, wc, fr, fq);
        if (!has_next) break;
#pragma unroll
        for (int a = 0; a < 2; ++a)
#pragma unroll
            for (int b = 0; b < 2; ++b)
#pragma unroll
                for (int m = 0; m < 4; ++m)
#pragma unroll
                    for (int n = 0; n < 2; ++n) acc[a][b][m][n] = (f32x4){0.f, 0.f, 0.f, 0.f};
        cur = nxt; cA = nA; cB = nB; ++ui;
        if (wr == 1) PG8_BAR;
    }
    PG8_WAIT_V(0);
    PG8_BAR;
#undef PG8_SA
#undef PG8_SB
#undef PG8_STAGE
#undef PG8_LDA
#undef PG8_LDB
#undef PG8_MMA
#undef PG8_WAIT_V
#undef PG8_WAIT_L
#undef PG8_BAR
#undef PG8_SCHED
}
}
constexpr int NWAVES = 8;
constexpr int M = 32768, DM = 1024, SEQ = 4096, NBATCH = 8, NLAYER = 4;
constexpr int NH = 8;
constexpr int IN_W = 6048;
constexpr int FFN = 2816, EXD = 3584, NEXP = 8;
constexpr float LN_EPS = 1e-5f, ALPHA = 1.681792830507429f;
constexpr int S5T = 32, S5CH = M / S5T  , S5K = 640, S5NC = SEQ / S5T  ;
constexpr int MOE_CAP = 65536;
constexpr int MOE_ROWS = 65536 + 8 * 256;

constexpr size_t MiB = 1u << 20;
constexpr size_t WS_CTL = 0, CTL_ZERO_BYTES = 1 * MiB;
constexpr size_t WS_WIN = 1 * MiB;
constexpr size_t WS_WG = 25 * MiB;
constexpr size_t WS_WUQ = 49 * MiB;
constexpr size_t WS_WUKV = 52 * MiB;
constexpr size_t WS_WLORA = 54 * MiB;
constexpr size_t WS_WVRES = 57 * MiB;
constexpr size_t WS_WGLU = 59 * MiB;
constexpr size_t WS_WBR = 61 * MiB;
constexpr size_t WS_WOUT = 73 * MiB;
constexpr size_t WS_WFGU = 81 * MiB;
constexpr size_t WS_WFD = 103 * MiB;
constexpr size_t WS_S5MAIN = 114 * MiB;
constexpr size_t WS_S5END = 134 * MiB;
constexpr size_t WS_S5A32 = 142 * MiB;
constexpr size_t WS_ROPE = 143 * MiB;
constexpr size_t WS_XB = 147 * MiB;
constexpr size_t WS_VFIRST = 211 * MiB;
constexpr size_t RB = 243 * MiB;
constexpr size_t WS_S5U = RB + 0;
constexpr size_t WS_S1 = RB + 40 * MiB;
constexpr size_t WS_MLARAW = WS_S1;
constexpr size_t WS_RWRAW = WS_S1 + 48 * MiB;
constexpr size_t WS_Q = WS_S1;
constexpr size_t WS_V = WS_S1 + 48 * MiB;
constexpr size_t WS_BV = WS_S1 + 80 * MiB;
constexpr size_t WS_DCY = WS_S1 + 112 * MiB;
constexpr size_t WS_YS5G = WS_S1;
constexpr size_t WS_YS5 = WS_S1 + 32 * MiB;
constexpr size_t WS_MIXED = WS_S1 + 64 * MiB;
constexpr size_t WS_R = RB + 200 * MiB;
constexpr size_t WS_KH = RB + 232 * MiB;
constexpr size_t WS_KKN = RB + 264 * MiB;
constexpr size_t WS_GL = RB + 296 * MiB;
constexpr size_t WS_GBUF = RB + 264 * MiB;
constexpr size_t WS_VFIN = RB + 328 * MiB;
constexpr size_t WS_K = RB + 360 * MiB;
constexpr size_t WS_VRAW = RB + 408 * MiB;
constexpr size_t WS_YRW = WS_VRAW;
constexpr size_t WS_S2 = RB + 440 * MiB;
constexpr size_t WS_CQN = WS_S2;
constexpr size_t WS_CKVN = WS_S2 + 24 * MiB;
constexpr size_t WS_LORAIN = WS_S2 + 40 * MiB;
constexpr size_t WS_YMLA = WS_S2;
constexpr size_t WS_XEND = RB + 496 * MiB;
constexpr size_t WS_GBUF2 = RB + 512 * MiB;
constexpr size_t WS_MIXED2 = RB + 576 * MiB;
constexpr size_t WS_HB = RB + 0;
constexpr size_t WS_WMGU = RB + 0;
constexpr size_t WS_YPAIR = RB + 0;
constexpr size_t WS_HM = RB + 132 * MiB;
constexpr size_t WS_WMD = RB + 594 * MiB;
constexpr size_t WS_SLOTTOK = RB + 650 * MiB;
constexpr size_t WS_SLOTW = RB + 652 * MiB;
constexpr size_t WS_PAIRPOS = RB + 654 * MiB;
constexpr size_t WS_END = RB + 655 * MiB;
constexpr int CW_BAR = 4096;
constexpr int CW_ATTN = 200000;
constexpr int CW_MOECNT = 201024;

constexpr int RING_OFF = 0, RING_BYTES = 131072;
constexpr int LDSCTL_OFF = RING_BYTES, MISC_OFF = LDSCTL_OFF + 320;
constexpr int LDS_BYTES = 147456;

#define GAS __attribute__((address_space(1)))
#define LAS __attribute__((address_space(3)))
typedef unsigned short bf16;
typedef _Float16 f16;
typedef f16 f16x8 __attribute__((ext_vector_type(8)));
typedef unsigned v4u __attribute__((ext_vector_type(4)));
typedef unsigned v2u __attribute__((ext_vector_type(2)));
typedef float f32x4 __attribute__((ext_vector_type(4)));
typedef float f32x16 __attribute__((ext_vector_type(16)));
typedef short bf16x8 __attribute__((ext_vector_type(8)));
typedef short s16x4 __attribute__((ext_vector_type(4)));
typedef GAS unsigned gu32;
#define RLX_AGENT __ATOMIC_RELAXED, __HIP_MEMORY_SCOPE_AGENT
#define LDS_WAIT() asm volatile("s_waitcnt lgkmcnt(0)" ::: "memory")
using pg8::cvt_pk_bf16; using pg8::pack8; using pg8::unpack8; using pg8::bf_lo; using pg8::bf_hi;

__device__ __forceinline__ float sigm(float x) { return __builtin_amdgcn_rcpf(1.0f + __expf(-x)); }
__device__ __forceinline__ float gelu_tanh(float y) { const float u = 0.7978845608028654f * (y + 0.044715f * y * y * y); const float t = 1.0f - 2.0f * __builtin_amdgcn_rcpf(__expf(2.0f * u) + 1.0f); return 0.5f * y * (1.0f + t); }
__device__ __forceinline__ float wave_sum(float v) {
#pragma unroll
    for (int o = 1; o < 64; o <<= 1) v += __shfl_xor(v, o);
    return v;
}
__device__ __forceinline__ v4u ld_nt16(const void* p) { return __builtin_nontemporal_load((const v4u*)p); }
__device__ __forceinline__ void f16x8_to_f32(const f16x8 h, float (&o)[8]) {
#pragma unroll
    for (int j = 0; j < 8; ++j) o[j] = (float)h[j];
}
__device__ __forceinline__ f16x8 f32_to_f16x8(const float (&v)[8]) { f16x8 h;
#pragma unroll
    for (int j = 0; j < 8; ++j) h[j] = (f16)v[j];
    return h; }
__device__ __forceinline__ void bf16x8_to_f32(const v4u w, float (&o)[8]) { o[0] = bf_lo(w.x); o[1] = bf_hi(w.x); o[2] = bf_lo(w.y); o[3] = bf_hi(w.y); o[4] = bf_lo(w.z); o[5] = bf_hi(w.z); o[6] = bf_lo(w.w); o[7] = bf_hi(w.w); }
__device__ __forceinline__ v4u f32_to_bf16x8(const float (&v)[8]) { v4u w; w.x = cvt_pk_bf16(v[0], v[1]); w.y = cvt_pk_bf16(v[2], v[3]); w.z = cvt_pk_bf16(v[4], v[5]); w.w = cvt_pk_bf16(v[6], v[7]); return w; }
__device__ __forceinline__ void ld8f(const float* p, float (&o)[8]) { const f32x4 a = *(const f32x4*)p, b = *(const f32x4*)(p + 4); o[0] = a[0]; o[1] = a[1]; o[2] = a[2]; o[3] = a[3]; o[4] = b[0]; o[5] = b[1]; o[6] = b[2]; o[7] = b[3]; }

#define XB_TMO      128
#define XB_XCNT(j)  (256  + 64 * (j))
#define XB_XSUB(j)  (1280 + 64 * (j))
#define XB_XGEN(j)  (2304 + 64 * (j))
#define XB_TOP      3328
#define XB_TOPGEN   3392
#define XCD_BAR_WORDS 3456
#define XB_SPIN_CAP (1u << 20)

__device__ __forceinline__ unsigned xb_ld(unsigned* p)              { return __hip_atomic_load(p, __ATOMIC_RELAXED, __HIP_MEMORY_SCOPE_AGENT); }
__device__ __forceinline__ unsigned xb_add(unsigned* p, unsigned v) { return __hip_atomic_fetch_add(p, v, __ATOMIC_RELAXED, __HIP_MEMORY_SCOPE_AGENT); }
__device__ __forceinline__ unsigned xb_xcc_id() { return (unsigned)__builtin_amdgcn_s_getreg((3 << 11) | 20) & 0xFu; }
#define XB_SPIN(cond, bar) do { unsigned _sp = 0; while (cond) { __builtin_amdgcn_s_sleep(1); \
    if ((++_sp & 255u) == 0u) { if (xb_ld(&(bar)[XB_TMO])) break; if (_sp > XB_SPIN_CAP) { atomicAdd(&(bar)[XB_TMO], 1u); break; } } } } while (0)

struct XcdBarrier { unsigned* bar; unsigned x; volatile LAS unsigned* st; };

__device__ __forceinline__ XcdBarrier xcd_barrier_post(unsigned* bar, volatile LAS unsigned* st) {
    XcdBarrier b; b.bar = bar; b.x = xb_xcc_id(); b.st = st;
    if (threadIdx.x == 0) (void)xb_add(&bar[XB_XCNT(b.x)], 1u);
    return b;
}
__device__ __forceinline__ void xcd_barrier_complete(unsigned* bar, unsigned x, unsigned& nloc, unsigned& nx) {
    const unsigned G = gridDim.x * gridDim.y * gridDim.z;
    unsigned sum, cnt, mine, sp = 0u;
    for (;;) {
        sum = 0u; cnt = 0u; mine = 0u;
#pragma unroll
        for (unsigned j = 0; j < 16; ++j) { const unsigned c = xb_ld(&bar[XB_XCNT(j)]); sum += c; cnt += (c > 0u) ? 1u : 0u; mine = (j == x) ? c : mine; }
        if (sum == G) break;
        __builtin_amdgcn_s_sleep(1);
        if ((++sp & 255u) == 0u) { if (xb_ld(&bar[XB_TMO])) break; if (sp > XB_SPIN_CAP) { atomicAdd(&bar[XB_TMO], 1u); break; } }
    }
    nloc = mine > 0u ? mine : 1u; nx = cnt > 0u ? cnt : 1u;
}
__device__ __forceinline__ void xcd_barrier(const XcdBarrier& b) {
    asm volatile("s_waitcnt vmcnt(0)" ::: "memory");
    __syncthreads();
    if (threadIdx.x == 0) {
        unsigned* bar = b.bar;
        __builtin_amdgcn_s_waitcnt(0);
        unsigned nloc = b.st[0], nx = b.st[1];
        if (nloc == 0u) { xcd_barrier_complete(bar, b.x, nloc, nx); b.st[0] = nloc; b.st[1] = nx; }
        const unsigned old = xb_add(&bar[XB_XSUB(b.x)], 1u);
        const unsigned gen = old / nloc;
        if (old + 1u == (gen + 1u) * nloc) {
            __builtin_amdgcn_fence(__ATOMIC_RELEASE, "agent");
            asm volatile("s_waitcnt vmcnt(0)" ::: "memory");
            const unsigned og = xb_add(&bar[XB_TOP], 1u);
            const unsigned tg = og / nx;
            if (og + 1u == (tg + 1u) * nx) xb_add(&bar[XB_TOPGEN], 1u);
            else XB_SPIN(xb_ld(&bar[XB_TOPGEN]) == tg, bar);
            __builtin_amdgcn_fence(__ATOMIC_ACQUIRE, "agent");
            xb_add(&bar[XB_XGEN(b.x)], 1u);
            asm volatile("s_waitcnt vmcnt(0)" ::: "memory");
        } else {
            XB_SPIN(xb_ld(&bar[XB_XGEN(b.x)]) == gen, bar);
            __builtin_amdgcn_fence(__ATOMIC_ACQUIRE, "agent");
            asm volatile("s_waitcnt vmcnt(0)" ::: "memory");
        }
    }
    __syncthreads();
}

struct Args { const void* in[44]; float* out; unsigned char* ws; int ph_lo, ph_hi, li, pad; };
typedef const __attribute__((address_space(4))) Args* KArgs;
struct Frame {
    LAS unsigned char* lds;
    unsigned char* ws;
    gu32* ctl;
    int tid, lane, wave;
    int G, blk;
    float* out;
    KArgs ka;
};
#define MKFRAME(F) Frame F; { int t_ = threadIdx.x; asm volatile("" : "+v"(t_)); KArgs k_ = (KArgs)__builtin_amdgcn_kernarg_segment_ptr(); asm volatile("" : "+s"(k_)); \
    F.lds = (LAS unsigned char*)lds_raw; F.ka = k_; F.ws = k_->ws; F.ctl = (gu32*)(k_->ws + WS_CTL); F.out = k_->out; F.tid = t_; F.lane = t_ & 63; F.wave = __builtin_amdgcn_readfirstlane(t_ >> 6); F.G = gridDim.x; F.blk = blockIdx.x; }
#define WSP(T, off) ((T*)(F.ws + (off)))
#define INP(T, i) ((const T*)F.ka->in[i])
using pg8::Unit; using pg8::Epi8; using pg8::EpiGU;
__device__ __forceinline__ void f4x2_to8(const f32x4 v0, const f32x4 v1, float (&o)[8]) { o[0] = v0[0]; o[1] = v0[1]; o[2] = v0[2]; o[3] = v0[3]; o[4] = v1[0]; o[5] = v1[1]; o[6] = v1[2]; o[7] = v1[3]; }

struct FProj {
    static constexpr int BATCH = 8; bf16* mla; bf16* rw; bf16* s5u;
    __device__ __forceinline__ void begin_col(const Unit&, int) {}
    typedef pg8::NoPre Pre; __device__ __forceinline__ Pre pre(const Unit&, int, int) const { return Pre{}; }
    __device__ __forceinline__ void tile8(const Unit&, int row, int col, const f32x4 v0, const f32x4 v1, const Pre&) const {
        const v4u w = pack8(v0, v1);
        if (col < 768) *(v4u*)(mla + (unsigned)row * 768 + col) = w;
        else if (col < 2560) *(v4u*)(rw + (unsigned)row * 1792 + (col - 768)) = w;
        else { const int c = col - 2560, g = c >> 4, i = c & 15; *(v4u*)(s5u + (unsigned)((g * S5CH + (row >> 5)) * S5K) + (row & 31) * 16 + i) = w; }
    }
};
struct FQup {
    static constexpr int BATCH = 4; bf16* Q; const float* cs; float qs;
    struct Pre { f32x4 c, s; };
    __device__ __forceinline__ void begin_col(const Unit&, int) {}
    __device__ __forceinline__ Pre pre(const Unit&, int row, int col) const { Pre p; const int head = col / 96, w = (col - head * 96) >> 3;
        if (w >= 8) { const int i0 = (w - 8) * 4; p.c = *(const f32x4*)(cs + (unsigned)row * 32 + i0); p.s = *(const f32x4*)(cs + (unsigned)row * 32 + 16 + i0); } else { p.c = (f32x4){0.f, 0.f, 0.f, 0.f}; p.s = p.c; } return p; }
    __device__ __forceinline__ void tile8(const Unit&, int row, int col, const f32x4 v0, const f32x4 v1, const Pre& p) const {
        const int head = col / 96, w = (col - head * 96) >> 3;
        bf16* q = Q + (unsigned)row * 768 + head * 96;
        if (w < 8) { *(v4u*)(q + 8 * w) = pack8(v0 * qs, v1 * qs); }
        else { const int i0 = (w - 8) * 4; const f32x4 c = p.c, s = p.s;
            const f32x4 x1 = (f32x4){v0[0], v0[2], v1[0], v1[2]}, x2 = (f32x4){v0[1], v0[3], v1[1], v1[3]};
            const f32x4 o1 = (x1 * c - x2 * s) * qs, o2 = (x1 * s + x2 * c) * qs;
            v2u a, b; a.x = cvt_pk_bf16(o1[0], o1[1]); a.y = cvt_pk_bf16(o1[2], o1[3]); b.x = cvt_pk_bf16(o2[0], o2[1]); b.y = cvt_pk_bf16(o2[2], o2[3]);
            *(v2u*)(q + 64 + i0) = a; *(v2u*)(q + 80 + i0) = b; }
    }
};
struct FKVup {
    static constexpr int BATCH = 8; bf16* K; bf16* V;
    __device__ __forceinline__ void begin_col(const Unit&, int) {}
    typedef pg8::NoPre Pre; __device__ __forceinline__ Pre pre(const Unit&, int, int) const { return Pre{}; }
    __device__ __forceinline__ void tile8(const Unit&, int row, int col, const f32x4 v0, const f32x4 v1, const Pre&) const {
        const int head = col >> 7, d = col & 127; const v4u w = pack8(v0, v1);
        if (d < 64) *(v4u*)(K + (unsigned)row * 768 + head * 96 + d) = w; else *(v4u*)(V + (unsigned)row * 512 + head * 64 + (d - 64)) = w;
    }
};
struct FLora {
    static constexpr int BATCH = 4;
    const float* w0; const float* a0; const float* k_a; f16* dcy; f16* kh; const f16* kkn; f16* bv; bf16* gl; float p[8], ka[8];
    struct Pre { f16x8 k, kn; };
    __device__ __forceinline__ void begin_col(const Unit&, int col) { const int seg = col >> 9, c = col & 511; ld8f(((seg == 0) ? w0 : a0) + c, p); ld8f(k_a + c, ka); }
    __device__ __forceinline__ Pre pre(const Unit&, int row, int col) const { Pre r; const unsigned off = (unsigned)row * 512 + (col & 511);
        if ((col >> 9) == 1) { r.k = *(const f16x8*)(kh + off); r.kn = *(const f16x8*)(kkn + off); } else { r.k = (f16x8)(0); r.kn = (f16x8)(0); } return r; }
    __device__ __forceinline__ void tile8(const Unit&, int row, int col, const f32x4 v0, const f32x4 v1, const Pre& pr) const {
        float a[8]; f4x2_to8(v0, v1, a);
        const int seg = col >> 9, c = col & 511; const unsigned off = (unsigned)row * 512 + c;
        if (seg == 0) { float o[8];
#pragma unroll
            for (int j = 0; j < 8; ++j) { const float e = 0.6065306597126334f * sigm(p[j] + a[j]); o[j] = -expm1f(-e); }
            *(f16x8*)(dcy + off) = f32_to_f16x8(o); }
        else if (seg == 1) { float k[8], kn[8]; f16x8_to_f32(pr.k, k); f16x8_to_f32(pr.kn, kn); float o1[8], o2[8];
#pragma unroll
            for (int j = 0; j < 8; ++j) { const float ic = sigm(p[j] + a[j]); o1[j] = k[j] * (1.0f + (ic - 1.0f) * ka[j]); o2[j] = kn[j] * ic; }
            *(f16x8*)(kh + off) = f32_to_f16x8(o1); *(f16x8*)(bv + off) = f32_to_f16x8(o2); }
        else { *(v4u*)(gl + off) = pack8(v0, v1); }
    }
};
struct FVres {
    static constexpr int BATCH = 4;
    const float* vb; const bf16* vraw; const bf16* vfirst; f16* vfin; float p[8];
    struct Pre { v4u v, vf; };
    __device__ __forceinline__ void begin_col(const Unit&, int col) { ld8f(vb + col, p); }
    __device__ __forceinline__ Pre pre(const Unit&, int row, int col) const { Pre r; const unsigned off = (unsigned)row * 512 + col; r.v = *(const v4u*)(vraw + off); r.vf = *(const v4u*)(vfirst + off); return r; }
    __device__ __forceinline__ void tile8(const Unit&, int row, int col, const f32x4 v0, const f32x4 v1, const Pre& pr) const {
        float a[8], v[8], vf[8], o[8]; f4x2_to8(v0, v1, a); const unsigned off = (unsigned)row * 512 + col;
        bf16x8_to_f32(pr.v, v); bf16x8_to_f32(pr.vf, vf);
#pragma unroll
        for (int j = 0; j < 8; ++j) o[j] = v[j] + (vf[j] - v[j]) * sigm(p[j] + a[j]);
        *(f16x8*)(vfin + off) = f32_to_f16x8(o);
    }
};
struct FS5End {
    static constexpr int BATCH = 8; float* xend;
    __device__ __forceinline__ void begin_col(const Unit&, int) {}
    typedef pg8::NoPre Pre; __device__ __forceinline__ Pre pre(const Unit&, int, int) const { return Pre{}; }
    __device__ __forceinline__ void tile8(const Unit& u, int row, int col, const f32x4 v0, const f32x4 v1, const Pre&) const {
        if (col < 128) { float* p = xend + (unsigned)((u.z * S5CH + row) * 128 + col); *(f32x4*)p = v0; *(f32x4*)(p + 4) = v1; }
    }
};
struct FS5Main {
    static constexpr int BATCH = 8;
    const bf16* s5u; const float* dvec; bf16* ys5g; float d[8];
    struct Pre { v4u uu; };
    __device__ __forceinline__ void begin_col(const Unit& u, int col) { ld8f(dvec + u.z * 16 + (col & 15), d); }
    __device__ __forceinline__ Pre pre(const Unit& u, int row, int col) const { Pre r; r.uu = *(const v4u*)(s5u + (unsigned)((u.z * S5CH + row) * S5K + col)); return r; }
    __device__ __forceinline__ void tile8(const Unit& u, int row, int col, const f32x4 v0, const f32x4 v1, const Pre& pr) const {
        float a[8], uu[8], o[8]; f4x2_to8(v0, v1, a); const int g = u.z, t = col >> 4, o0 = col & 15;
        bf16x8_to_f32(pr.uu, uu);
#pragma unroll
        for (int j = 0; j < 8; ++j) o[j] = gelu_tanh(a[j] + d[j] * uu[j]);
        *(v4u*)(ys5g + ((unsigned)row * 32 + t) * 512 + g * 16 + o0) = f32_to_bf16x8(o);
    }
};
struct FGlu {
    static constexpr int BATCH = 8;
    const bf16* ys5g; const float* bglu; bf16* ys5; float b[8];
    struct Pre { v4u y; };
    __device__ __forceinline__ void begin_col(const Unit&, int col) { ld8f(bglu + col, b); }
    __device__ __forceinline__ Pre pre(const Unit&, int row, int col) const { Pre r; r.y = *(const v4u*)(ys5g + (unsigned)row * 512 + col); return r; }
    __device__ __forceinline__ void tile8(const Unit&, int row, int col, const f32x4 v0, const f32x4 v1, const Pre& pr) const {
        float a[8], y[8], o[8]; f4x2_to8(v0, v1, a); const unsigned off = (unsigned)row * 512 + col; bf16x8_to_f32(pr.y, y);
#pragma unroll
        for (int j = 0; j < 8; ++j) o[j] = y[j] * sigm(a[j] + b[j]);
        *(v4u*)(ys5 + off) = f32_to_bf16x8(o);
    }
};
struct FGate {
    static constexpr int BATCH = 8; bf16* gbuf;
    __device__ __forceinline__ void begin_col(const Unit&, int) {}
    typedef pg8::NoPre Pre; __device__ __forceinline__ Pre pre(const Unit&, int, int) const { return Pre{}; }
    __device__ __forceinline__ void tile8(const Unit&, int row, int col, const f32x4 v0, const f32x4 v1, const Pre&) const {
        float a[8], o[8]; f4x2_to8(v0, v1, a);
#pragma unroll
        for (int j = 0; j < 8; ++j) o[j] = sigm(a[j]);
        *(v4u*)(gbuf + (unsigned)row * 1024 + col) = f32_to_bf16x8(o);
    }
};
struct FMerge {
    static constexpr int BATCH = 8; const bf16* gbuf; const bf16* min_; bf16* mout; int first; float scale;
    struct Pre { v4u g, m; };
    __device__ __forceinline__ void begin_col(const Unit&, int) {}
    __device__ __forceinline__ Pre pre(const Unit&, int row, int col) const { Pre r; const unsigned off = (unsigned)row * 1024 + col; r.g = *(const v4u*)(gbuf + off); if (!first) r.m = *(const v4u*)(min_ + off); else r.m = (v4u){0u, 0u, 0u, 0u}; return r; }
    __device__ __forceinline__ void tile8(const Unit&, int row, int col, const f32x4 v0, const f32x4 v1, const Pre& pr) const {
        float a[8], g[8], mprev[8], o[8]; f4x2_to8(v0, v1, a); const unsigned off = (unsigned)row * 1024 + col; bf16x8_to_f32(pr.g, g); bf16x8_to_f32(pr.m, mprev);
#pragma unroll
        for (int j = 0; j < 8; ++j) o[j] = mprev[j] + g[j] * a[j] * scale;
        *(v4u*)(mout + off) = f32_to_bf16x8(o);
    }
};
struct FResid {
    static constexpr int BATCH = 8; const float* xin; float* xout;
    struct Pre { f32x4 a, b; };
    __device__ __forceinline__ void begin_col(const Unit&, int) {}
    __device__ __forceinline__ Pre pre(const Unit&, int row, int col) const { Pre r; const unsigned off = (unsigned)row * 1024 + col; r.a = *(const f32x4*)(xin + off); r.b = *(const f32x4*)(xin + off + 4); return r; }
    __device__ __forceinline__ void tile8(const Unit&, int row, int col, const f32x4 v0, const f32x4 v1, const Pre& pr) const {
        const unsigned off = (unsigned)row * 1024 + col;
        *(f32x4*)(xout + off) = pr.a * ALPHA + v0; *(f32x4*)(xout + off + 4) = pr.b * ALPHA + v1;
    }
};
struct FSwiglu {
    bf16* h; int ldh;
    __device__ __forceinline__ void pair8(const Unit&, int row, int colh, const f32x4 g0, const f32x4 g1, const f32x4 u0, const f32x4 u1) const {
        float g[8], uu[8], o[8]; f4x2_to8(g0, g1, g); f4x2_to8(u0, u1, uu);
#pragma unroll
        for (int j = 0; j < 8; ++j) o[j] = g[j] * sigm(g[j]) * uu[j];
        *(v4u*)(h + (unsigned)row * ldh + colh) = f32_to_bf16x8(o);
    }
};
struct FMoeDown {
    static constexpr int BATCH = 8; bf16* ypair; const float* slotw; const unsigned* cnt;
    struct Pre { float w; };
    __device__ __forceinline__ void begin_col(const Unit&, int) {}
    __device__ __forceinline__ Pre pre(const Unit& u, int row, int) const { Pre r; const int rk = u.aux + (row - u.pm * 256); r.w = ((unsigned)rk < cnt[u.z]) ? slotw[(unsigned)(u.z * MOE_CAP + rk)] : 0.f; return r; }
    __device__ __forceinline__ void tile8(const Unit& u, int row, int col, const f32x4 v0, const f32x4 v1, const Pre& pr) const {
        const int rk = u.aux + (row - u.pm * 256);
        if ((unsigned)rk < cnt[u.z]) *(v4u*)(ypair + (unsigned)row * 1024 + col) = pack8(v0 * pr.w, v1 * pr.w);
    }
};

struct MoeOrder {
    int nN, G, c; int pt[NEXP + 1];
    __device__ void init(const unsigned* cnt, int nN_, int G_, int c_) { nN = nN_; G = G_; c = c_; pt[0] = 0;
#pragma unroll
        for (int e = 0; e < NEXP; ++e) pt[e + 1] = pt[e] + (int)((cnt[e] + 255u) >> 8); }
    __device__ bool next(int i, Unit& u) const {
        const long L = (long)i * G + c; if (L >= (long)pt[NEXP] * nN) return false;
        const int tile = (int)(L / nN); u.pn = (int)(L % nN); int e = 0;
#pragma unroll
        for (int k = 1; k < NEXP; ++k) e += (tile >= pt[k]) ? 1 : 0;
        int base = 0;
#pragma unroll
        for (int k = 1; k < NEXP; ++k) base = (tile >= pt[k]) ? pt[k] : base;
        u.z = e; u.pm = tile; u.aux = (tile - base) * 256; return true;
    }
};
struct LocMoe1 {
    static constexpr bool GATHER = true;
    const bf16* A; const bf16* Bt; int lda, ldb, K; const int* slot_tok; const unsigned* cnt;
    __device__ __forceinline__ const char* a_ptr(const Unit&) const { return (const char*)A; }
    __device__ __forceinline__ const char* b_ptr(const Unit& u) const { return (const char*)(Bt + (size_t)u.z * (2 * EXD) * DM + (size_t)u.pn * 256 * ldb); }
    __device__ __forceinline__ void a_off(const Unit& u, int tid, unsigned (&v)[2][2]) const {
        const unsigned n = cnt[u.z];
#pragma unroll
        for (int i = 0; i < 2; ++i) { int R, C; pg8::stage_rc(tid * 16 + i * 8192, R, C);
#pragma unroll
            for (int h = 0; h < 2; ++h) { const int r = u.aux + h * 128 + R; const int tok = ((unsigned)r < n) ? slot_tok[(unsigned)(u.z * MOE_CAP + r)] : 0; v[h][i] = (unsigned)(tok * lda + C) * 2u; } }
    }
};
__device__ __forceinline__ int qperm_row(int n) { const int h = n / 96, d = n - h * 96; if (d < 64) return n; const int e = d - 64; return h * 96 + 64 + ((e < 16) ? 2 * e : 2 * (e - 16) + 1); }
template <bool QPERM>
__device__ __forceinline__ void tr_item(const float* W, int ldw, int k0, int n0, const float* ksc, bf16* WT, int ldd, int kd0, int drow0, LAS float* scr, int lane) {
    if (W) {
#pragma unroll 8
        for (int i = 0; i < 32; ++i) { const int kk = 2 * i + (lane >> 5); float v = W[(size_t)(k0 + kk) * ldw + n0 + (lane & 31)]; if (ksc) v *= ksc[k0 + kk]; scr[kk * 33 + (lane & 31)] = v; }
    } else {
#pragma unroll 8
        for (int i = 0; i < 32; ++i) { const int kk = 2 * i + (lane >> 5); scr[kk * 33 + (lane & 31)] = 0.f; }
    }
    LDS_WAIT(); asm volatile("" ::: "memory");
    const int c = lane & 7;
#pragma unroll
    for (int j = 0; j < 4; ++j) { const int n = (lane >> 3) + 8 * j; const LAS float* s = scr + (8 * c) * 33 + n;
        v4u o; o.x = cvt_pk_bf16(s[0 * 33], s[1 * 33]); o.y = cvt_pk_bf16(s[2 * 33], s[3 * 33]); o.z = cvt_pk_bf16(s[4 * 33], s[5 * 33]); o.w = cvt_pk_bf16(s[6 * 33], s[7 * 33]);
        const int dr = QPERM ? qperm_row(n0 + n) : (drow0 + n);
        *(v4u*)(WT + (size_t)dr * ldd + kd0 + k0 + 8 * c) = o; }
    LDS_WAIT(); asm volatile("" ::: "memory");
}
#define TRJOB(r, W, ldw, K, c0, ncols, ksc, WT, ldd, drow0) { const int _nb = (ncols) / 32, _ni = ((K) / 64) * _nb; if ((r) < _ni) { const int _kb = (r) / _nb, _nbi = (r) % _nb; \
    tr_item<false>((W), (ldw), 64 * _kb, (c0) + 32 * _nbi, (ksc), (WT), (ldd), 0, (drow0) + 32 * _nbi, scr, lane); continue; } (r) -= _ni; }
#define TRJOB_GU(r, W, ldw, K, ncols, WT, ldd, up) { const int _nb = (ncols) / 32, _ni = ((K) / 64) * _nb; if ((r) < _ni) { const int _kb = (r) / _nb, _n0 = 32 * ((r) % _nb); \
    tr_item<false>((W), (ldw), 64 * _kb, _n0, nullptr, (WT), (ldd), 0, (_n0 >> 7) * 256 + (_n0 & 127) + ((up) ? 128 : 0), scr, lane); continue; } (r) -= _ni; }


__device__ __forceinline__ void p0_prologue(Frame& F) {
    LAS float* scr = (LAS float*)(F.lds + F.wave * 16384);
    const int lane = F.lane; const int gw = F.blk * NWAVES + F.wave, NGW = F.G * NWAVES;
    constexpr int PER_LAYER = 16 * 189 + 6 * 24 + 4 * 32 + 192 + 8 * 16 + 3 * 8 * 32 + 16 * 32 + 3 * 16;
    for (int it = gw; it < NLAYER * PER_LAYER; it += NGW) {
        const int l = it / PER_LAYER; int r = it % PER_LAYER;
        const float* win = INP(float, 2) + (size_t)l * DM * IN_W;
        bf16* win_t = WSP(bf16, WS_WIN) + (size_t)l * 3072 * DM; bf16* wg_t = WSP(bf16, WS_WG) + (size_t)l * 3072 * DM;
        TRJOB(r, win, IN_W, DM, 0, 672, nullptr, win_t, DM, 0);
        TRJOB(r, win, IN_W, DM, 672, 2304, nullptr, win_t, DM, 768);
        TRJOB(r, win, IN_W, DM, 2976, 3072, nullptr, wg_t, DM, 0);
        if (r < 48) { tr_item<false>(nullptr, 0, 64 * (r / 3), 0, nullptr, win_t, DM, 0, 672 + 32 * (r % 3), scr, lane); continue; } r -= 48;
        if (r < 144) { const int kb = r / 24, nbi = r % 24; tr_item<true>(INP(float, 4) + (size_t)l * 384 * 768, 768, 64 * kb, 32 * nbi, INP(float, 3) + l * 384, WSP(bf16, WS_WUQ) + (size_t)l * 768 * 384, 384, 0, 0, scr, lane); continue; } r -= 144;
        TRJOB(r, INP(float, 6) + (size_t)l * 256 * 1024, 1024, 256, 0, 1024, INP(float, 5) + l * 256, WSP(bf16, WS_WUKV) + (size_t)l * 1024 * 256, 256, 0);
        if (r < 192) { const int rb = r / 4, kb = r % 4; bf16* wl = WSP(bf16, WS_WLORA) + (size_t)l * 1536 * 256; const float* src = nullptr; int ldw = 512, k0 = 0, n0 = 0;
            if (rb < 16) { if (kb == 0) { src = INP(float, 9) + (size_t)l * 64 * 512; n0 = 32 * rb; } }
            else if (rb < 32) { if (kb == 1) { src = INP(float, 11) + (size_t)l * 64 * 512; n0 = 32 * (rb - 16); } }
            else { if (kb >= 2) { src = INP(float, 12) + (size_t)l * 128 * 512; k0 = 64 * (kb - 2); n0 = 32 * (rb - 32); } }
            tr_item<false>(src, ldw, k0, n0, nullptr, wl, 256, 64 * kb - k0, 32 * rb, scr, lane); continue; } r -= 192;
        TRJOB(r, INP(float, 29) + (size_t)l * 512 * 512, 512, 512, 0, 512, nullptr, WSP(bf16, WS_WGLU) + (size_t)l * 512 * 512, 512, 0);
        TRJOB(r, INP(float, 31) + (size_t)(l * 3 + 0) * 512 * 1024, 1024, 512, 0, 1024, nullptr, WSP(bf16, WS_WBR) + (size_t)(l * 3 + 0) * 1024 * 512, 512, 0);
        TRJOB(r, INP(float, 31) + (size_t)(l * 3 + 1) * 512 * 1024, 1024, 512, 0, 1024, nullptr, WSP(bf16, WS_WBR) + (size_t)(l * 3 + 1) * 1024 * 512, 512, 0);
        TRJOB(r, INP(float, 31) + (size_t)(l * 3 + 2) * 512 * 1024, 1024, 512, 0, 1024, nullptr, WSP(bf16, WS_WBR) + (size_t)(l * 3 + 2) * 1024 * 512, 512, 0);
        TRJOB(r, INP(float, 32) + (size_t)l * DM * DM, DM, DM, 0, DM, nullptr, WSP(bf16, WS_WOUT) + (size_t)l * DM * DM, DM, 0);
    }
    constexpr int PER_FFN = 3 * 16 * 88;
    for (int it = gw; it < 2 * PER_FFN; it += NGW) {
        const int i = it / PER_FFN; int r = it % PER_FFN;
        TRJOB_GU(r, INP(float, 37) + (size_t)i * DM * FFN, FFN, DM, FFN, WSP(bf16, WS_WFGU) + (size_t)i * 2 * FFN * DM, DM, 0);
        TRJOB_GU(r, INP(float, 38) + (size_t)i * DM * FFN, FFN, DM, FFN, WSP(bf16, WS_WFGU) + (size_t)i * 2 * FFN * DM, DM, 1);
        TRJOB(r, INP(float, 39) + (size_t)i * FFN * DM, DM, FFN, 0, DM, nullptr, WSP(bf16, WS_WFD) + (size_t)i * DM * FFN, FFN, 0);
    }
    for (int it = F.blk * 512 + F.tid; it < 3 * 512 * 64; it += F.G * 512) {
        const int i = it / (512 * 64), rem = it % (512 * 64), n = rem >> 6, k0 = (rem & 63) * 8;
        const float* vd = INP(float, 18) + (size_t)i * 512 * 32; const float* vu = INP(float, 19) + (size_t)i * 32 * 512; float o[8];
#pragma unroll
        for (int j = 0; j < 8; ++j) o[j] = 0.f;
        for (int rr = 0; rr < 32; ++rr) { const float u = vu[rr * 512 + n];
#pragma unroll
            for (int j = 0; j < 8; ++j) o[j] += vd[(k0 + j) * 32 + rr] * u; }
        *(v4u*)(WSP(bf16, WS_WVRES) + (size_t)i * 512 * 512 + (size_t)n * 512 + k0) = f32_to_bf16x8(o);
    }
    for (int it = F.blk * 512 + F.tid; it < M * 16; it += F.G * 512) {
        const int m = it >> 4, i = it & 15; const float inv = powf(10000.0f, -(float)i * (1.0f / 16.0f)); const float ang = (float)INP(int, 1)[m] * inv;
        float sn, cn; sincosf(ang, &sn, &cn); float* cs = WSP(float, WS_ROPE) + (size_t)m * 32; cs[i] = cn; cs[16 + i] = sn;
    }
}
__device__ __forceinline__ void moe_convert(Frame& F, int li) {
    LAS float* scr = (LAS float*)(F.lds + F.wave * 16384);
    const int lane = F.lane; const int gw = F.blk * NWAVES + F.wave, NGW = F.G * NWAVES;
    constexpr int PER_E = 2 * 16 * 112 + 56 * 32;
    for (int it = gw; it < NEXP * PER_E; it += NGW) {
        const int e = it / PER_E; int r = it % PER_E; const size_t wi = (size_t)(li * NEXP + e);
        TRJOB_GU(r, INP(float, 41) + wi * DM * EXD, EXD, DM, EXD, WSP(bf16, WS_WMGU) + (size_t)e * 2 * EXD * DM, DM, 0);
        TRJOB_GU(r, INP(float, 42) + wi * DM * EXD, EXD, DM, EXD, WSP(bf16, WS_WMGU) + (size_t)e * 2 * EXD * DM, DM, 1);
        TRJOB(r, INP(float, 43) + wi * EXD * DM, DM, EXD, 0, DM, nullptr, WSP(bf16, WS_WMD) + (size_t)e * DM * EXD, EXD, 0);
    }
}

__device__ __forceinline__ void ph2_prep(Frame& F, int l) {
    const int lane = F.lane; const int gw = F.blk * NWAVES + F.wave, NGW = F.G * NWAVES;
    const bf16* rwraw = WSP(bf16, WS_RWRAW); const bf16* mlaraw = WSP(bf16, WS_MLARAW);
    const float* mu = INP(float, 7) + l * 1792; const float* k_k = INP(float, 13) + l * 512;
    float mu_r[8], mu_k[8], mu_v[8], mu_t[8], kk8[8];
    ld8f(mu + 8 * lane, mu_r); ld8f(mu + 512 + 8 * lane, mu_k); ld8f(mu + 1024 + 8 * lane, mu_v); ld8f(mu + 1536 + 8 * (lane & 31), mu_t); ld8f(k_k + 8 * lane, kk8);
    const float* cs_all = WSP(float, WS_ROPE);
    for (int m = gw; m < M; m += NGW) {
        const int s = m & (SEQ - 1);
        const bf16* cur = rwraw + (size_t)m * 1792; const bf16* prv = cur - 1792;
        float c[8], p[8], o[8];
        bf16x8_to_f32(*(const v4u*)(cur + 8 * lane), c); if (s) bf16x8_to_f32(*(const v4u*)(prv + 8 * lane), p); else {
#pragma unroll
            for (int j = 0; j < 8; ++j) p[j] = 0.f; }
#pragma unroll
        for (int j = 0; j < 8; ++j) o[j] = c[j] + (p[j] - c[j]) * mu_r[j];
        *(f16x8*)(WSP(f16, WS_R) + (size_t)m * 512 + 8 * lane) = f32_to_f16x8(o);
        bf16x8_to_f32(*(const v4u*)(cur + 512 + 8 * lane), c); if (s) bf16x8_to_f32(*(const v4u*)(prv + 512 + 8 * lane), p);
        float ss = 0.f;
#pragma unroll
        for (int j = 0; j < 8; ++j) { o[j] = c[j] + (p[j] - c[j]) * mu_k[j]; const float q = o[j] * kk8[j]; ss += q * q; }
        *(f16x8*)(WSP(f16, WS_KH) + (size_t)m * 512 + 8 * lane) = f32_to_f16x8(o);
        ss += __shfl_xor(ss, 1); ss += __shfl_xor(ss, 2); ss += __shfl_xor(ss, 4);
        { const float rn = 1.0f / fmaxf(sqrtf(ss), 1e-12f);
#pragma unroll
          for (int j = 0; j < 8; ++j) o[j] = o[j] * kk8[j] * rn; }
        *(f16x8*)(WSP(f16, WS_KKN) + (size_t)m * 512 + 8 * lane) = f32_to_f16x8(o);
        bf16x8_to_f32(*(const v4u*)(cur + 1024 + 8 * lane), c); if (s) bf16x8_to_f32(*(const v4u*)(prv + 1024 + 8 * lane), p);
#pragma unroll
        for (int j = 0; j < 8; ++j) o[j] = c[j] + (p[j] - c[j]) * mu_v[j];
        { const v4u vb = f32_to_bf16x8(o); *(v4u*)(WSP(bf16, WS_VRAW) + (size_t)m * 512 + 8 * lane) = vb;
          if (l == 0) { *(v4u*)(WSP(bf16, WS_VFIRST) + (size_t)m * 512 + 8 * lane) = vb; *(f16x8*)(WSP(f16, WS_VFIN) + (size_t)m * 512 + 8 * lane) = f32_to_f16x8(o); } }
        if (lane < 32) {
            bf16x8_to_f32(*(const v4u*)(cur + 1536 + 8 * lane), c); if (s) bf16x8_to_f32(*(const v4u*)(prv + 1536 + 8 * lane), p);
#pragma unroll
            for (int j = 0; j < 8; ++j) { float v = c[j] + (p[j] - c[j]) * mu_t[j]; if (lane < 8) v = 1.0f - 2.0f * __builtin_amdgcn_rcpf(__expf(2.0f * v) + 1.0f); else if (lane >= 16) v = sigm(v); o[j] = v; }
            *(v4u*)(WSP(bf16, WS_LORAIN) + (size_t)m * 256 + 8 * lane) = f32_to_bf16x8(o);
        }
        const bf16* mr = mlaraw + (size_t)m * 768; float a8[8], b8[8];
        bf16x8_to_f32(*(const v4u*)(mr + 8 * lane), a8); float ssa = 0.f, ssb = 0.f;
#pragma unroll
        for (int j = 0; j < 8; ++j) ssa += a8[j] * a8[j];
        if (lane < 32) { bf16x8_to_f32(*(const v4u*)(mr + 512 + 8 * lane), b8);
#pragma unroll
            for (int j = 0; j < 8; ++j) ssb += b8[j] * b8[j]; } else {
#pragma unroll
            for (int j = 0; j < 8; ++j) b8[j] = 0.f; }
        const float sq = wave_sum(lane < 48 ? ssa : 0.f), skv = wave_sum((lane >= 48 ? ssa : 0.f) + (lane < 16 ? ssb : 0.f));
        const float rq = 1.0f / sqrtf(sq * (1.0f / 384.0f) + 1e-6f), rkv = 1.0f / sqrtf(skv * (1.0f / 256.0f) + 1e-6f);
        if (lane < 48) {
#pragma unroll
            for (int j = 0; j < 8; ++j) o[j] = a8[j] * rq;
            *(v4u*)(WSP(bf16, WS_CQN) + (size_t)m * 384 + 8 * lane) = f32_to_bf16x8(o);
        } else {
#pragma unroll
            for (int j = 0; j < 8; ++j) o[j] = a8[j] * rkv;
            *(v4u*)(WSP(bf16, WS_CKVN) + (size_t)m * 256 + 8 * (lane - 48)) = f32_to_bf16x8(o);
        }
        if (lane < 16) {
#pragma unroll
            for (int j = 0; j < 8; ++j) o[j] = b8[j] * rkv;
            *(v4u*)(WSP(bf16, WS_CKVN) + (size_t)m * 256 + 128 + 8 * lane) = f32_to_bf16x8(o);
        }
        float pr[8];
#pragma unroll
        for (int j = 0; j < 8; ++j) pr[j] = __shfl_xor(b8[j], 2);
        if (lane >= 16 && lane < 20) { const int i0 = 8 * (lane & 1); const float* cs = cs_all + (size_t)m * 32; float cc[8], sn[8]; ld8f(cs + i0, cc); ld8f(cs + 16 + i0, sn);
            const bool lo = lane < 18;
#pragma unroll
            for (int j = 0; j < 8; ++j) o[j] = lo ? (b8[j] * cc[j] - pr[j] * sn[j]) : (pr[j] * sn[j] + b8[j] * cc[j]);
            const v4u w = f32_to_bf16x8(o); bf16* kd = WSP(bf16, WS_K) + (size_t)m * 768 + 64 + (lo ? 0 : 16) + i0;
#pragma unroll
            for (int h = 0; h < NH; ++h) *(v4u*)(kd + h * 96) = w; }
    }
    if (F.blk < 256) {
        __syncthreads();
        const int g = F.blk >> 3, s8 = F.blk & 7, tid = F.tid;
        LAS float* pw = (LAS float*)F.lds;
        LAS float* Bb = pw + 33 * 64 * 2;
        LAS float* Cc = Bb + 64 * 16 * 2;
        LAS float* Kt = Cc + 16 * 64 * 2;
        const float dt = expf(INP(float, 23)[l * 32 + g]);
        const float* are = INP(float, 21) + (size_t)(l * 32 + g) * 64; const float* aim = INP(float, 22) + (size_t)(l * 32 + g) * 64;
        for (int e = tid; e < 33 * 64; e += 512) { const int n = e >> 6, p = e & 63; const float lr = fminf(are[p], -1e-4f), li = aim[p];
            const float mag = expf((float)n * (dt * lr)); float sn, cn; sincosf((float)n * (dt * li), &sn, &cn); pw[2 * e] = mag * cn; pw[2 * e + 1] = mag * sn; }
        for (int e = tid; e < 64 * 16; e += 512) { const int p = e >> 4; const float lr = fminf(are[p], -1e-4f), li = aim[p];
            const float mag = expf(dt * lr); float sn, cn; sincosf(dt * li, &sn, &cn); const float abr = mag * cn, abi = mag * sn, den = lr * lr + li * li;
            const float fr = ((abr - 1.0f) * lr + abi * li) / den, fi = (abi * lr - (abr - 1.0f) * li) / den;
            const float br = INP(float, 24)[(size_t)(l * 32 + g) * 1024 + e], bi = INP(float, 25)[(size_t)(l * 32 + g) * 1024 + e];
            Bb[2 * e] = fr * br - fi * bi; Bb[2 * e + 1] = fr * bi + fi * br; }
        for (int e = tid; e < 16 * 64; e += 512) { Cc[2 * e] = INP(float, 26)[(size_t)(l * 32 + g) * 1024 + e]; Cc[2 * e + 1] = INP(float, 27)[(size_t)(l * 32 + g) * 1024 + e]; }
        __syncthreads();
        { const int tau = tid >> 4, o = tid & 15; float acc[16];
#pragma unroll
          for (int i = 0; i < 16; ++i) acc[i] = 0.f;
          for (int p = 0; p < 64; ++p) { const float cr = Cc[2 * (o * 64 + p)], ci = Cc[2 * (o * 64 + p) + 1], pr_ = pw[2 * (tau * 64 + p)], pi_ = pw[2 * (tau * 64 + p) + 1];
              const float xr = cr * pr_ - ci * pi_, xi = cr * pi_ + ci * pr_;
#pragma unroll
              for (int i = 0; i < 16; ++i) acc[i] += xr * Bb[2 * (p * 16 + i)] - xi * Bb[2 * (p * 16 + i) + 1]; }
#pragma unroll
          for (int i = 0; i < 16; ++i) Kt[(tau * 16 + o) * 16 + i] = acc[i]; }
        __syncthreads();
        bf16* bm = WSP(bf16, WS_S5MAIN) + (size_t)g * 512 * S5K;
        for (int e = tid; e < 64 * 80; e += 512) { const int n = 64 * s8 + e / 80, k0 = (e % 80) * 8, t = n >> 4, o = n & 15; float v[8];
            if (k0 < 512) { const int sidx = k0 >> 4, i0 = k0 & 15;
#pragma unroll
                for (int j = 0; j < 8; ++j) v[j] = (sidx <= t) ? Kt[((t - sidx) * 16 + o) * 16 + i0 + j] : 0.f; }
            else {
#pragma unroll
                for (int j = 0; j < 8; ++j) { const int q = k0 - 512 + j, p = q & 63; const float cr = Cc[2 * (o * 64 + p)], ci = Cc[2 * (o * 64 + p) + 1], pr_ = pw[2 * ((t + 1) * 64 + p)], pi_ = pw[2 * ((t + 1) * 64 + p) + 1];
                    v[j] = (q < 64) ? (cr * pr_ - ci * pi_) : -(cr * pi_ + ci * pr_); } }
            *(v4u*)(bm + (size_t)n * S5K + k0) = f32_to_bf16x8(v); }
        bf16* be = WSP(bf16, WS_S5END) + (size_t)g * 256 * 512;
        for (int e = tid; e < 32 * 64; e += 512) { const int n = 32 * s8 + e / 64, k0 = (e % 64) * 8, sidx = k0 >> 4, i0 = k0 & 15; float v[8];
            if (n < 128) { const int p = n & 63; const float pr_ = pw[2 * ((31 - sidx) * 64 + p)], pi_ = pw[2 * ((31 - sidx) * 64 + p) + 1];
#pragma unroll
                for (int j = 0; j < 8; ++j) { const float br = Bb[2 * (p * 16 + i0 + j)], bi = Bb[2 * (p * 16 + i0 + j) + 1]; v[j] = (n < 64) ? (pr_ * br - pi_ * bi) : (pr_ * bi + pi_ * br); } }
            else {
#pragma unroll
                for (int j = 0; j < 8; ++j) v[j] = 0.f; }
            *(v4u*)(be + (size_t)n * 512 + k0) = f32_to_bf16x8(v); }
        if (s8 == 0 && tid < 64) { float* a32 = WSP(float, WS_S5A32) + (size_t)(g * 64 + tid) * 2; a32[0] = pw[2 * (32 * 64 + tid)]; a32[1] = pw[2 * (32 * 64 + tid) + 1]; }
        __syncthreads();
    }
}

__device__ __forceinline__ void ln_core(f32x4 (&v)[4], const float* gam, const float* bet, int lane) {
    float s = 0.f;
#pragma unroll
    for (int j = 0; j < 4; ++j) s += (v[j][0] + v[j][1]) + (v[j][2] + v[j][3]);
    const float mean = wave_sum(s) * (1.f / DM); float s2 = 0.f;
#pragma unroll
    for (int j = 0; j < 4; ++j) { v[j] = v[j] - mean; s2 += (v[j][0] * v[j][0] + v[j][1] * v[j][1]) + (v[j][2] * v[j][2] + v[j][3] * v[j][3]); }
    const float rstd = 1.f / sqrtf(wave_sum(s2) * (1.f / DM) + LN_EPS);
#pragma unroll
    for (int j = 0; j < 4; ++j) { const f32x4 g4 = *(const f32x4*)(gam + 4 * lane + 256 * j), b4 = *(const f32x4*)(bet + 4 * lane + 256 * j); v[j] = v[j] * rstd * g4 + b4; }
}
__device__ __forceinline__ void ln_store(const f32x4 (&v)[4], float* xrow, bf16* xbrow, int lane) {
#pragma unroll
    for (int j = 0; j < 4; ++j) { *(f32x4*)(xrow + 4 * lane + 256 * j) = v[j]; v2u w; w.x = cvt_pk_bf16(v[j][0], v[j][1]); w.y = cvt_pk_bf16(v[j][2], v[j][3]); *(v2u*)(xbrow + 4 * lane + 256 * j) = w; }
}
__device__ __forceinline__ void ln_phase(Frame& F, const float* gam, const float* bet) {
    const int lane = F.lane; const int gw = F.blk * NWAVES + F.wave, NGW = F.G * NWAVES; float* X = F.out; bf16* Xb = WSP(bf16, WS_XB);
    for (int m = gw; m < M; m += NGW) { f32x4 v[4];
#pragma unroll
        for (int j = 0; j < 4; ++j) v[j] = *(const f32x4*)(X + (size_t)m * DM + 4 * lane + 256 * j);
        ln_core(v, gam, bet, lane); ln_store(v, X + (size_t)m * DM, Xb + (size_t)m * DM, lane); }
}
__device__ __forceinline__ void ln2_moe_phase(Frame& F, const float* gam, const float* bet, int li) {
    const int lane = F.lane; const int gw = F.blk * NWAVES + F.wave, NGW = F.G * NWAVES; float* X = F.out; bf16* Xb = WSP(bf16, WS_XB);
    const unsigned* cnt = (const unsigned*)(F.ctl + CW_MOECNT + 64 * li); int pstart[NEXP]; { int acc = 0;
#pragma unroll
        for (int e = 0; e < NEXP; ++e) { pstart[e] = acc; acc += (int)(((cnt[e] + 255u) >> 8) << 8); } }
    const int* ppos = WSP(int, WS_PAIRPOS); const bf16* yp = WSP(bf16, WS_YPAIR);
    for (int m = gw; m < M; m += NGW) { f32x4 v[4];
        const int p0 = ppos[2 * m], p1 = ppos[2 * m + 1]; int r0 = 0, r1 = 0;
#pragma unroll
        for (int e = 0; e < NEXP; ++e) { if ((p0 >> 24) == e) r0 = pstart[e] + (p0 & 0xffffff); if ((p1 >> 24) == e) r1 = pstart[e] + (p1 & 0xffffff); }
#pragma unroll
        for (int j = 0; j < 4; ++j) { const f32x4 x = *(const f32x4*)(X + (size_t)m * DM + 4 * lane + 256 * j);
            const v2u a = *(const v2u*)(yp + (size_t)r0 * DM + 4 * lane + 256 * j), b = *(const v2u*)(yp + (size_t)r1 * DM + 4 * lane + 256 * j);
            v[j] = x * ALPHA + (f32x4){bf_lo(a.x) + bf_lo(b.x), bf_hi(a.x) + bf_hi(b.x), bf_lo(a.y) + bf_lo(b.y), bf_hi(a.y) + bf_hi(b.y)}; }
        ln_core(v, gam, bet, lane); ln_store(v, X + (size_t)m * DM, Xb + (size_t)m * DM, lane); }
}
__device__ __forceinline__ void ln1_moe_phase(Frame& F, const float* gam, const float* bet, int li) {
    const int lane = F.lane; float* X = F.out; bf16* Xb = WSP(bf16, WS_XB);
    LAS int* pe = (LAS int*)F.lds;
    LAS float* pwt = (LAS float*)(F.lds + 1024);
    LAS int* cntl = (LAS int*)(F.lds + 2048);
    const float* router = INP(float, 40) + (size_t)li * DM * NEXP;
    for (int blk0 = F.blk; blk0 * 128 < M; blk0 += F.G) {
        __syncthreads();
        for (int i = 0; i < 16; ++i) { const int tl = F.wave * 16 + i, m = blk0 * 128 + tl; f32x4 v[4];
#pragma unroll
            for (int j = 0; j < 4; ++j) v[j] = *(const f32x4*)(X + (size_t)m * DM + 4 * lane + 256 * j);
            ln_core(v, gam, bet, lane); ln_store(v, X + (size_t)m * DM, Xb + (size_t)m * DM, lane);
            float lg[NEXP];
#pragma unroll
            for (int e = 0; e < NEXP; ++e) lg[e] = 0.f;
#pragma unroll
            for (int j = 0; j < 4; ++j)
#pragma unroll
                for (int q = 0; q < 4; ++q) { const float xv = v[j][q]; const float* rr = router + (size_t)(4 * lane + 256 * j + q) * NEXP; const f32x4 ra = *(const f32x4*)rr, rb = *(const f32x4*)(rr + 4);
                    lg[0] += xv * ra[0]; lg[1] += xv * ra[1]; lg[2] += xv * ra[2]; lg[3] += xv * ra[3]; lg[4] += xv * rb[0]; lg[5] += xv * rb[1]; lg[6] += xv * rb[2]; lg[7] += xv * rb[3]; }
#pragma unroll
            for (int e = 0; e < NEXP; ++e) lg[e] = wave_sum(lg[e]);
            int e0 = 0; float l0 = lg[0];
#pragma unroll
            for (int e = 1; e < NEXP; ++e) if (lg[e] > l0) { l0 = lg[e]; e0 = e; }
            int e1 = -1; float l1 = -INFINITY;
#pragma unroll
            for (int e = 0; e < NEXP; ++e) if (e != e0 && lg[e] > l1) { l1 = lg[e]; e1 = e; }
            const float w1 = 1.0f / (1.0f + expf(l0 - l1)), w0 = 1.0f - w1;
            if (lane == 0) { pe[2 * tl] = e0; pe[2 * tl + 1] = e1; pwt[2 * tl] = w0; pwt[2 * tl + 1] = w1; }
        }
        __syncthreads();
        int myrank = 0, mye = 0;
        if (F.tid < 256) { mye = pe[F.tid]; for (int q = 0; q < F.tid; ++q) myrank += (pe[q] == mye) ? 1 : 0; }
#ifdef PROBE_ORDERED
        if (F.tid == 0) { unsigned sp = 0; while (__hip_atomic_load((unsigned*)(F.ctl + CW_MOECNT + 64 * li + 32), RLX_AGENT) != (unsigned)blk0 && ++sp < (1u << 22)) __builtin_amdgcn_s_sleep(2); }
        __syncthreads();
#endif
        if (F.tid < NEXP) { int c = 0; for (int q = 0; q < 256; ++q) c += (pe[q] == F.tid) ? 1 : 0; cntl[F.tid] = c;
            cntl[8 + F.tid] = (int)__hip_atomic_fetch_add((unsigned*)(F.ctl + CW_MOECNT + 64 * li + F.tid), (unsigned)c, RLX_AGENT); }
#ifdef PROBE_ORDERED
        __syncthreads();
        if (F.tid == 0) { asm volatile("s_waitcnt vmcnt(0)" ::: "memory"); __hip_atomic_fetch_add((unsigned*)(F.ctl + CW_MOECNT + 64 * li + 32), 1u, RLX_AGENT); }
#endif
        __syncthreads();
        if (F.tid < 256) { const int rk = cntl[8 + mye] + myrank; const int m = blk0 * 128 + (F.tid >> 1);
            WSP(int, WS_SLOTTOK)[(size_t)mye * MOE_CAP + rk] = m; WSP(float, WS_SLOTW)[(size_t)mye * MOE_CAP + rk] = pwt[F.tid]; WSP(int, WS_PAIRPOS)[blk0 * 256 + F.tid] = (mye << 24) | rk; }
    }
    __syncthreads();
}
constexpr int AT_KS = 208, AT_VS = 192;
constexpr int AT_KB = 64 * AT_KS, AT_VB = 64 * AT_VS, AT_STAGE = AT_KB + AT_VB;
constexpr int AT_WSF = 2 * AT_STAGE, AT_OST = AT_WSF + NWAVES * 256, AT_LDS = AT_OST + NWAVES * 4096;
__device__ __forceinline__ int crow(int r, int hi) { return (r & 3) + 8 * (r >> 2) + 4 * hi; }

__device__ __forceinline__ void attn_unit(int tid, int b, int h, int qb, const bf16* Q, const bf16* K, const bf16* V, bf16* O, LAS unsigned char* lds) {
    const int lane = tid & 63, r32 = lane & 31, hi = lane >> 5; const int wid = __builtin_amdgcn_readfirstlane(tid >> 6);
    const size_t rowbase = (size_t)b * SEQ; const int q0 = qb * 256;
    bf16x8 qr[6];
    { const bf16* qp = Q + (rowbase + q0 + wid * 32 + r32) * 768 + h * 96 + hi * 8;
#pragma unroll
      for (int d0 = 0; d0 < 6; ++d0) qr[d0] = *(const bf16x8*)(qp + d0 * 16); }
    const int kp0 = tid, kp1 = 512 + tid;
    const bf16* kg0 = K + (rowbase + kp0 / 12) * 768 + h * 96 + (kp0 % 12) * 8;
    const bf16* kg1 = K + (rowbase + kp1 / 12) * 768 + h * 96 + (kp1 % 12) * 8;
    const bf16* vg = V + (rowbase + (tid >> 3)) * 512 + h * 64 + (tid & 7) * 8;
    const int kl0 = (kp0 / 12) * AT_KS + (kp0 % 12) * 16, kl1 = (kp1 / 12) * AT_KS + (kp1 % 12) * 16, vl = (tid >> 3) * AT_VS + (tid & 7) * 16;
    const bool two = tid < 256;
    const int NT = 4 * (qb + 1);
    v4u ka, kb2, va;
    ka = *(const v4u*)kg0; if (two) kb2 = *(const v4u*)kg1; va = *(const v4u*)vg;
    *(LAS v4u*)(lds + kl0) = ka; if (two) *(LAS v4u*)(lds + kl1) = kb2; *(LAS v4u*)(lds + AT_KB + vl) = va;
    LAS float* wsf = (LAS float*)(lds + AT_WSF) + wid * 64;
    float m_run = -1e30f, l_run = 0.f; f32x16 o[2];
#pragma unroll
    for (int r = 0; r < 16; ++r) { o[0][r] = 0.f; o[1][r] = 0.f; }
    const int kfo = r32 * AT_KS + hi * 16;
    const int vfo = (4 * hi + ((lane & 15) >> 2)) * AT_VS + ((lane >> 4) & 1) * 32 + (lane & 3) * 8;
    const int qrel = wid * 32 + r32;
    __syncthreads();
    for (int t = 0; t < NT; ++t) {
        const int cur = (t & 1) * AT_STAGE, nxt = ((t + 1) & 1) * AT_STAGE; const bool more = (t + 1 < NT);
        if (more) { const size_t go = (size_t)(t + 1) * 64 * 768; ka = *(const v4u*)(kg0 + go); if (two) kb2 = *(const v4u*)(kg1 + go); va = *(const v4u*)(vg + (size_t)(t + 1) * 64 * 512); }
        const int jb = t - (NT - 4);
        if (jb < 0 || 64 * jb <= 32 * wid + 31) {
            f32x16 p0, p1;
#pragma unroll
            for (int r = 0; r < 16; ++r) { p0[r] = 0.f; p1[r] = 0.f; }
#pragma unroll
            for (int d0 = 0; d0 < 6; ++d0) { const bf16x8 k0 = *(const LAS bf16x8*)(lds + cur + kfo + d0 * 32), k1 = *(const LAS bf16x8*)(lds + cur + kfo + 32 * AT_KS + d0 * 32);
                p0 = __builtin_amdgcn_mfma_f32_32x32x16_bf16(k0, qr[d0], p0, 0, 0, 0); p1 = __builtin_amdgcn_mfma_f32_32x32x16_bf16(k1, qr[d0], p1, 0, 0, 0); }
            if (jb >= 0) { const int kb = 64 * jb + 4 * hi;
#pragma unroll
                for (int r = 0; r < 16; ++r) { const int kv = kb + (r & 3) + 8 * (r >> 2); if (kv > qrel) p0[r] = -INFINITY; if (kv + 32 > qrel) p1[r] = -INFINITY; } }
            float rm = fmaxf(p0[0], p1[0]);
#pragma unroll
            for (int r = 1; r < 16; ++r) rm = fmaxf(rm, fmaxf(p0[r], p1[r]));
            rm = fmaxf(rm, __shfl_xor(rm, 32));
            const float mnew = fmaxf(m_run, rm), alpha = __builtin_amdgcn_exp2f(m_run - mnew);
            float ps = 0.f;
#pragma unroll
            for (int r = 0; r < 16; ++r) { p0[r] = __builtin_amdgcn_exp2f(p0[r] - mnew); p1[r] = __builtin_amdgcn_exp2f(p1[r] - mnew); ps += p0[r] + p1[r]; }
            l_run = l_run * alpha + ps;
            if (__any(mnew > m_run)) {
                if (hi == 0) wsf[r32] = alpha;
                LDS_WAIT();
#pragma unroll
                for (int r = 0; r < 16; ++r) { const float f = wsf[crow(r, hi)]; o[0][r] *= f; o[1][r] *= f; }
            }
            m_run = mnew;
            bf16x8 pa[4];
            { v4u w;
              w.x = cvt_pk_bf16(p0[0], p0[1]); w.y = cvt_pk_bf16(p0[2], p0[3]); w.z = cvt_pk_bf16(p0[4], p0[5]); w.w = cvt_pk_bf16(p0[6], p0[7]); pa[0] = __builtin_bit_cast(bf16x8, w);
              w.x = cvt_pk_bf16(p0[8], p0[9]); w.y = cvt_pk_bf16(p0[10], p0[11]); w.z = cvt_pk_bf16(p0[12], p0[13]); w.w = cvt_pk_bf16(p0[14], p0[15]); pa[1] = __builtin_bit_cast(bf16x8, w);
              w.x = cvt_pk_bf16(p1[0], p1[1]); w.y = cvt_pk_bf16(p1[2], p1[3]); w.z = cvt_pk_bf16(p1[4], p1[5]); w.w = cvt_pk_bf16(p1[6], p1[7]); pa[2] = __builtin_bit_cast(bf16x8, w);
              w.x = cvt_pk_bf16(p1[8], p1[9]); w.y = cvt_pk_bf16(p1[10], p1[11]); w.z = cvt_pk_bf16(p1[12], p1[13]); w.w = cvt_pk_bf16(p1[14], p1[15]); pa[3] = __builtin_bit_cast(bf16x8, w); }
#pragma unroll
            for (int d0 = 0; d0 < 2; ++d0)
#pragma unroll
                for (int ks = 0; ks < 4; ++ks) {
                    const s16x4 lo = __builtin_bit_cast(s16x4, __builtin_amdgcn_ds_read_tr16_b64_v4i16((LAS s16x4*)(lds + cur + AT_KB + vfo + (16 * ks) * AT_VS + d0 * 64)));
                    const s16x4 hh = __builtin_bit_cast(s16x4, __builtin_amdgcn_ds_read_tr16_b64_v4i16((LAS s16x4*)(lds + cur + AT_KB + vfo + (16 * ks + 8) * AT_VS + d0 * 64)));
                    const bf16x8 vf = (bf16x8){lo[0], lo[1], lo[2], lo[3], hh[0], hh[1], hh[2], hh[3]};
                    o[d0] = __builtin_amdgcn_mfma_f32_32x32x16_bf16(pa[ks], vf, o[d0], 0, 0, 0);
                }
        }
        if (more) { *(LAS v4u*)(lds + nxt + kl0) = ka; if (two) *(LAS v4u*)(lds + nxt + kl1) = kb2; *(LAS v4u*)(lds + nxt + AT_KB + vl) = va; }
        __syncthreads();
    }
    l_run += __shfl_xor(l_run, 32);
    if (hi == 0) wsf[32 + r32] = l_run;
    LDS_WAIT();
    { bf16* stg = (bf16*)(lds + AT_OST + wid * 4096);
#pragma unroll
      for (int r = 0; r < 16; ++r) { const int orow = crow(r, hi); const float rl = __builtin_amdgcn_rcpf(wsf[32 + orow]);
#pragma unroll
          for (int d0 = 0; d0 < 2; ++d0) { const unsigned u = cvt_pk_bf16(o[d0][r] * rl, 0.f); ((LAS bf16*)(lds + AT_OST + wid * 4096))[orow * 64 + d0 * 32 + r32] = (bf16)(u & 0xffffu); } }
      (void)stg;
      LDS_WAIT();
      bf16* Ow = O + (rowbase + q0 + wid * 32) * 512 + h * 64;
#pragma unroll
      for (int i = 0; i < 4; ++i) { const int row = i * 8 + (lane >> 3), ch = lane & 7; const v4u v = *(const LAS v4u*)(lds + AT_OST + wid * 4096 + (row * 64 + ch * 8) * 2); *(v4u*)(Ow + (size_t)row * 512 + ch * 8) = v; } }
    __syncthreads();
}

template <int CTRL> __device__ __forceinline__ float dpp_add(float v) { return v + __builtin_bit_cast(float, __builtin_amdgcn_update_dpp(0, __builtin_bit_cast(int, v), CTRL, 0xF, 0xF, true)); }
struct RwStep { f16x8 r, k, a, b, d; f16 v; };
__device__ __forceinline__ void rw_load(RwStep& x, const f16* R, const f16* KH, const f16* KKN, const f16* BV, const f16* DCY, const f16* VF, size_t off8, size_t offa, size_t offv) {
    x.r = *(const f16x8*)(R + off8); x.k = *(const f16x8*)(KH + off8); x.a = *(const f16x8*)(KKN + offa); x.b = *(const f16x8*)(BV + off8); x.d = *(const f16x8*)(DCY + off8); x.v = VF[offv];
}
__device__ __forceinline__ void rwkv_scan(Frame& F, int bh) {
    const int lane = F.lane, rl = lane >> 3, cg = lane & 7, b = bh >> 3, h = bh & 7, row = F.wave * 8 + rl;
    const f16* R = WSP(f16, WS_R); const f16* KH = WSP(f16, WS_KH); const f16* KKN = WSP(f16, WS_KKN); const f16* BV = WSP(f16, WS_BV); const f16* DCY = WSP(f16, WS_DCY); const f16* VF = WSP(f16, WS_VFIN);
    f16* Y = WSP(f16, WS_YRW);
    const size_t base = (size_t)b * SEQ * 512 + h * 64;
    float S[8];
#pragma unroll
    for (int j = 0; j < 8; ++j) S[j] = 0.f;
    float sa = 0.f;
    RwStep buf[4];
#pragma unroll
    for (int s = 0; s < 4; ++s) { const size_t o = base + (size_t)s * 512; rw_load(buf[s], R, KH, KKN, BV, DCY, VF, o + 8 * cg, o + 512 + 8 * cg, o + row); }
    for (int t0 = 0; t0 < SEQ; t0 += 4) {
#pragma unroll
        for (int s = 0; s < 4; ++s) {
            const RwStep x = buf[s]; const int t = t0 + s;
            if (t + 4 < SEQ) { const size_t o = base + (size_t)(t + 4) * 512; const size_t oa = (t + 5 < SEQ) ? o + 512 : o; rw_load(buf[s], R, KH, KKN, BV, DCY, VF, o + 8 * cg, oa + 8 * cg, o + row); }
            const float v = (float)x.v; float yp = 0.f, sp = 0.f;
#pragma unroll
            for (int j = 0; j < 8; ++j) { float sj = S[j]; sj = sj - sj * (float)x.d[j]; sj = __builtin_fmaf(sa, (float)x.b[j], sj); sj = __builtin_fmaf(v, (float)x.k[j], sj); S[j] = sj;
                yp = __builtin_fmaf(sj, (float)x.r[j], yp); sp = __builtin_fmaf(sj, (float)x.a[j], sp); }
            yp = dpp_add<0xB1>(yp); sp = dpp_add<0xB1>(sp);
            yp = dpp_add<0x4E>(yp); sp = dpp_add<0x4E>(sp);
            yp = dpp_add<0x141>(yp); sp = dpp_add<0x141>(sp);
            sa = -sp;
            if (cg == 0) Y[base + (size_t)t * 512 + row] = (f16)yp;
        }
    }
}
__device__ __forceinline__ void s5_carry(Frame& F, int idx) {
    const int p = idx & 63, g = (idx >> 6) & 31, b = idx >> 11;
    const float* a32 = WSP(float, WS_S5A32) + (size_t)(g * 64 + p) * 2; const float ar = a32[0], ai = a32[1];
    const float* xe = WSP(float, WS_XEND) + ((size_t)g * S5CH + b * S5NC) * 128; bf16* u = WSP(bf16, WS_S5U) + ((size_t)g * S5CH + b * S5NC) * S5K + 512;
    float xr = 0.f, xi = 0.f;
    for (int c0 = 0; c0 < S5NC; c0 += 8) { float er[8], ei[8];
#pragma unroll
        for (int c = 0; c < 8; ++c) { er[c] = xe[(size_t)(c0 + c) * 128 + p]; ei[c] = xe[(size_t)(c0 + c) * 128 + 64 + p]; }
#pragma unroll
        for (int c = 0; c < 8; ++c) { bf16* up = u + (size_t)(c0 + c) * S5K; up[p] = (bf16)(cvt_pk_bf16(xr, 0.f) & 0xffffu); up[64 + p] = (bf16)(cvt_pk_bf16(xi, 0.f) & 0xffffu);
            const float nr = ar * xr - ai * xi + er[c], ni = ar * xi + ai * xr + ei[c]; xr = nr; xi = ni; } }
}
__device__ __forceinline__ void rwkv_post(Frame& F, int l) {
    const int lane = F.lane; const int gw = F.blk * NWAVES + F.wave, NGW = F.G * NWAVES;
    float lg[8], lb[8], rk[8]; ld8f(INP(float, 16) + l * 512 + 8 * lane, lg); ld8f(INP(float, 17) + l * 512 + 8 * lane, lb); ld8f(INP(float, 15) + l * 512 + 8 * lane, rk);
    for (int m = gw; m < M; m += NGW) { const size_t off = (size_t)m * 512 + 8 * lane; float y[8], r[8], k[8], v[8], g[8], o[8];
        f16x8_to_f32(*(const f16x8*)(WSP(f16, WS_YRW) + off), y); f16x8_to_f32(*(const f16x8*)(WSP(f16, WS_R) + off), r); f16x8_to_f32(*(const f16x8*)(WSP(f16, WS_KH) + off), k);
        f16x8_to_f32(*(const f16x8*)(WSP(f16, WS_VFIN) + off), v); bf16x8_to_f32(*(const v4u*)(WSP(bf16, WS_GL) + off), g);
        float s = 0.f, bs = 0.f;
#pragma unroll
        for (int j = 0; j < 8; ++j) { s += y[j]; bs += r[j] * k[j] * rk[j]; }
        s += __shfl_xor(s, 1); s += __shfl_xor(s, 2); s += __shfl_xor(s, 4); bs += __shfl_xor(bs, 1); bs += __shfl_xor(bs, 2); bs += __shfl_xor(bs, 4);
        const float mean = s * (1.0f / 64.0f); float q = 0.f;
#pragma unroll
        for (int j = 0; j < 8; ++j) { y[j] -= mean; q += y[j] * y[j]; }
        q += __shfl_xor(q, 1); q += __shfl_xor(q, 2); q += __shfl_xor(q, 4);
        const float rstd = 1.0f / sqrtf(q * (1.0f / 64.0f) + 64e-5f);
#pragma unroll
        for (int j = 0; j < 8; ++j) o[j] = (y[j] * rstd * lg[j] + lb[j] + bs * v[j]) * g[j];
        *(v4u*)(WSP(bf16, WS_YRW) + off) = f32_to_bf16x8(o); }
}
constexpr int PH_PER_LAYER = 12, N_PHASES = 1 + NLAYER * PH_PER_LAYER;
#ifndef MK_PER_PHASE
#define MK_PER_PHASE 1
#endif
#ifndef ABL_BRANCH
#define ABL_BRANCH -1
#endif
constexpr int NR_RWKV = 64;

__global__ void __launch_bounds__(NWAVES * 64, 2) mk_fwd(Args A) {
    extern __shared__ __attribute__((aligned(16))) unsigned char lds_raw[];
    volatile LAS unsigned* MISC = (volatile LAS unsigned*)((LAS unsigned char*)lds_raw + MISC_OFF);
    for (int u = threadIdx.x; u < (LDS_BYTES - LDSCTL_OFF) / 4; u += NWAVES * 64) ((LAS unsigned*)((LAS unsigned char*)lds_raw + LDSCTL_OFF))[u] = 0u;
    __syncthreads();
    XcdBarrier bar; bar.bar = (unsigned*)(A.ws + WS_CTL) + CW_BAR; bar.x = 0; bar.st = nullptr;
    if (!MK_PER_PHASE) bar = xcd_barrier_post((unsigned*)(A.ws + WS_CTL) + CW_BAR, MISC + 8);
    const int lo = A.ph_lo, hi = A.ph_hi;
#ifndef PHMASK
#define PHMASK 0xFFFF
#endif
#define PHON(k) ((PHMASK >> (k)) & 1)
#define IN(k) (lo <= (k) && (k) < hi)
#define SEAM(k) do { if (IN(k) && IN((k) + 1)) xcd_barrier(bar); } while (0)
    using pg8::gemm_phase; using pg8::StaticOrder; using pg8::LocDense;

    if (PHON(0) && IN(0)) {
        MKFRAME(F);
        p0_prologue(F);
        const int gw = F.blk * NWAVES + F.wave, NGW = F.G * NWAVES;
        for (int m = gw; m < M; m += NGW) {
#pragma unroll
            for (int j = 0; j < 4; ++j) { const f32x4 v = *(const f32x4*)(INP(float, 0) + (size_t)m * DM + 4 * F.lane + 256 * j); v2u w; w.x = cvt_pk_bf16(v[0], v[1]); w.y = cvt_pk_bf16(v[2], v[3]); *(v2u*)(WSP(bf16, WS_XB) + (size_t)m * DM + 4 * F.lane + 256 * j) = w; } }
    }
    SEAM(0);

    for (int l = 0; l < NLAYER; ++l) {
        const int pb = 1 + l * PH_PER_LAYER;
        const bool moe = (l & 1) != 0; const int li = l >> 1;
        if (PHON(1) && IN(pb + 0)) {
            asm volatile("; ==PH1");
            MKFRAME(F);
            LocDense L{WSP(bf16, WS_XB), WSP(bf16, WS_WIN) + (size_t)l * 3072 * DM, DM, DM, DM, 0, 0};
            StaticOrder S; S.init(M, 3072, 1, F.G, F.blk);
            Epi8<FProj> E{{WSP(bf16, WS_MLARAW), WSP(bf16, WS_RWRAW), WSP(bf16, WS_S5U)}};
            gemm_phase(F.lds + RING_OFF, L, S, E);
        }
        SEAM(pb + 0);
        if (PHON(2) && IN(pb + 1)) { MKFRAME(F); ph2_prep(F, l); }
        SEAM(pb + 1);
        if (PHON(3) && IN(pb + 2)) {
            asm volatile("; ==PH3");
            MKFRAME(F);
#ifndef P3SEL
#define P3SEL 31
#endif
            if (P3SEL & 1) { LocDense L{WSP(bf16, WS_CQN), WSP(bf16, WS_WUQ) + (size_t)l * 768 * 384, 384, 384, 384, 0, 0}; StaticOrder S; S.init(M, 768, 1, F.G, F.blk);
              Epi8<FQup> E{{WSP(bf16, WS_Q), WSP(float, WS_ROPE), 0.10206207261596575f * 1.4426950408889634f}}; gemm_phase(F.lds + RING_OFF, L, S, E); }
            if (P3SEL & 2) { LocDense L{WSP(bf16, WS_CKVN), WSP(bf16, WS_WUKV) + (size_t)l * 1024 * 256, 256, 256, 256, 0, 0}; StaticOrder S; S.init(M, 1024, 1, F.G, F.blk);
              Epi8<FKVup> E{{WSP(bf16, WS_K), WSP(bf16, WS_V)}}; gemm_phase(F.lds + RING_OFF, L, S, E); }
            if (P3SEL & 4) { LocDense L{WSP(bf16, WS_LORAIN), WSP(bf16, WS_WLORA) + (size_t)l * 1536 * 256, 256, 256, 256, 0, 0}; StaticOrder S; S.init(M, 1536, 1, F.G, F.blk);
              Epi8<FLora> E{{INP(float, 8) + l * 512, INP(float, 10) + l * 512, INP(float, 14) + l * 512, WSP(f16, WS_DCY), WSP(f16, WS_KH), WSP(f16, WS_KKN), WSP(f16, WS_BV), WSP(bf16, WS_GL), {}, {}}}; gemm_phase(F.lds + RING_OFF, L, S, E); }
            if ((P3SEL & 8) && l > 0) { LocDense L{WSP(bf16, WS_VRAW), WSP(bf16, WS_WVRES) + (size_t)(l - 1) * 512 * 512, 512, 512, 512, 0, 0}; StaticOrder S; S.init(M, 512, 1, F.G, F.blk);
              Epi8<FVres> E{{INP(float, 20) + (l - 1) * 512, WSP(bf16, WS_VRAW), WSP(bf16, WS_VFIRST), WSP(f16, WS_VFIN), {}}}; gemm_phase(F.lds + RING_OFF, L, S, E); }
            if (P3SEL & 16) { LocDense L{WSP(bf16, WS_S5U), WSP(bf16, WS_S5END), S5K, 512, 512, (size_t)S5CH * S5K, (size_t)256 * 512}; StaticOrder S; S.init(S5CH, 256, 32, F.G, F.blk);
              Epi8<FS5End> E{{WSP(float, WS_XEND)}}; gemm_phase(F.lds + RING_OFF, L, S, E); }
        }
        SEAM(pb + 2);
        if (PHON(4) && IN(pb + 3)) {
            asm volatile("; ==PH4");
            MKFRAME(F);
            if (F.blk < NR_RWKV && F.G > NR_RWKV) { for (int bh = F.blk; bh < NBATCH * NH; bh += NR_RWKV) rwkv_scan(F, bh); }
            else {
                const int ab = F.blk - NR_RWKV, na = F.G - NR_RWKV;
                for (int idx = ab * 512 + F.tid; idx < NBATCH * 32 * 64; idx += na * 512) s5_carry(F, idx);
                LAS int* slot = (LAS int*)(F.lds + AT_LDS);
                for (;;) {
                    __syncthreads();
                    if (F.tid == 0) *slot = (int)__hip_atomic_fetch_add((unsigned*)(F.ctl + CW_ATTN + 64 * l), 1u, RLX_AGENT);
                    __syncthreads();
                    const int n = *slot; if (n >= NBATCH * NH * 16) break;
                    const int qb = 15 - (n >> 6), bh = n & 63;
                    attn_unit(F.tid, bh >> 3, bh & 7, qb, WSP(bf16, WS_Q), WSP(bf16, WS_K), WSP(bf16, WS_V), WSP(bf16, WS_YMLA), F.lds);
                }
            }
        }
        SEAM(pb + 3);
        if (PHON(5) && IN(pb + 4)) {
            asm volatile("; ==PH5");
            MKFRAME(F);
            { LocDense L{WSP(bf16, WS_S5U), WSP(bf16, WS_S5MAIN), S5K, S5K, S5K, (size_t)S5CH * S5K, (size_t)512 * S5K}; StaticOrder S; S.init(S5CH, 512, 32, F.G, F.blk);
              Epi8<FS5Main> E{{WSP(bf16, WS_S5U), INP(float, 28) + l * 512, WSP(bf16, WS_YS5G), {}}}; gemm_phase(F.lds + RING_OFF, L, S, E); }
            rwkv_post(F, l);
        }
        SEAM(pb + 4);
        if (PHON(6) && IN(pb + 5)) {
            asm volatile("; ==PH6");
            MKFRAME(F);
            { LocDense L{WSP(bf16, WS_YS5G), WSP(bf16, WS_WGLU) + (size_t)l * 512 * 512, 512, 512, 512, 0, 0}; StaticOrder S; S.init(M, 512, 1, F.G, F.blk);
              Epi8<FGlu> E{{WSP(bf16, WS_YS5G), INP(float, 30) + l * 512, WSP(bf16, WS_YS5), {}}}; gemm_phase(F.lds + RING_OFF, L, S, E); }
            { LocDense L{WSP(bf16, WS_XB), WSP(bf16, WS_WG) + ((size_t)l * 3 + 0) * 1024 * DM, DM, DM, DM, 0, 0}; StaticOrder S; S.init(M, 1024, 1, F.G, F.blk);
              Epi8<FGate> E{{WSP(bf16, WS_GBUF)}}; gemm_phase(F.lds + RING_OFF, L, S, E); }
            { LocDense L{WSP(bf16, WS_YMLA), WSP(bf16, WS_WBR) + ((size_t)l * 3 + 0) * 1024 * 512, 512, 512, 512, 0, 0}; StaticOrder S; S.init(M, 1024, 1, F.G, F.blk);
              Epi8<FMerge> E{{WSP(bf16, WS_GBUF), WSP(bf16, WS_MIXED2), WSP(bf16, WS_MIXED), 1, (ABL_BRANCH == 0) ? 0.f : 1.f}}; gemm_phase(F.lds + RING_OFF, L, S, E); }
            { LocDense L{WSP(bf16, WS_XB), WSP(bf16, WS_WG) + ((size_t)l * 3 + 1) * 1024 * DM, DM, DM, DM, 0, 0}; StaticOrder S; S.init(M, 1024, 1, F.G, F.blk);
              Epi8<FGate> E{{WSP(bf16, WS_GBUF2)}}; gemm_phase(F.lds + RING_OFF, L, S, E); }
            { LocDense L{WSP(bf16, WS_YRW), WSP(bf16, WS_WBR) + ((size_t)l * 3 + 1) * 1024 * 512, 512, 512, 512, 0, 0}; StaticOrder S; S.init(M, 1024, 1, F.G, F.blk);
              Epi8<FMerge> E{{WSP(bf16, WS_GBUF2), WSP(bf16, WS_MIXED), WSP(bf16, WS_MIXED2), 0, (ABL_BRANCH == 1) ? 0.f : 1.f}}; gemm_phase(F.lds + RING_OFF, L, S, E); }
        }
        SEAM(pb + 5);
        if (PHON(7) && IN(pb + 6)) {
            asm volatile("; ==PH7");
            MKFRAME(F);
            { LocDense L{WSP(bf16, WS_XB), WSP(bf16, WS_WG) + ((size_t)l * 3 + 2) * 1024 * DM, DM, DM, DM, 0, 0}; StaticOrder S; S.init(M, 1024, 1, F.G, F.blk);
              Epi8<FGate> E{{WSP(bf16, WS_GBUF)}}; gemm_phase(F.lds + RING_OFF, L, S, E); }
            { LocDense L{WSP(bf16, WS_YS5), WSP(bf16, WS_WBR) + ((size_t)l * 3 + 2) * 1024 * 512, 512, 512, 512, 0, 0}; StaticOrder S; S.init(M, 1024, 1, F.G, F.blk);
              Epi8<FMerge> E{{WSP(bf16, WS_GBUF), WSP(bf16, WS_MIXED2), WSP(bf16, WS_MIXED), 0, (ABL_BRANCH == 2) ? 0.f : 1.f}}; gemm_phase(F.lds + RING_OFF, L, S, E); }
        }
        SEAM(pb + 6);
        if (PHON(8) && IN(pb + 7)) {
            asm volatile("; ==PH8");
            MKFRAME(F);
            LocDense L{WSP(bf16, WS_MIXED), WSP(bf16, WS_WOUT) + (size_t)l * DM * DM, DM, DM, DM, 0, 0}; StaticOrder S; S.init(M, DM, 1, F.G, F.blk);
            Epi8<FResid> E{{(l == 0) ? INP(float, 0) : (const float*)F.out, F.out}}; gemm_phase(F.lds + RING_OFF, L, S, E);
        }
        SEAM(pb + 7);
        if (PHON(9) && IN(pb + 8)) {
            asm volatile("; ==PH9");
            MKFRAME(F);
            if (moe) { ln1_moe_phase(F, INP(float, 33) + l * DM, INP(float, 34) + l * DM, li); moe_convert(F, li); }
            else ln_phase(F, INP(float, 33) + l * DM, INP(float, 34) + l * DM);
        }
        SEAM(pb + 8);
        if (PHON(10) && IN(pb + 9)) {
            asm volatile("; ==PH10");
            MKFRAME(F);
            if (moe) {
                const unsigned* cnt = (const unsigned*)(F.ctl + CW_MOECNT + 64 * li);
                LocMoe1 L{WSP(bf16, WS_XB), WSP(bf16, WS_WMGU), DM, DM, DM, WSP(int, WS_SLOTTOK), cnt}; MoeOrder S; S.init(cnt, 2 * EXD / 256, F.G, F.blk);
                EpiGU<FSwiglu> E{{WSP(bf16, WS_HM), EXD}}; gemm_phase(F.lds + RING_OFF, L, S, E);
            } else {
                LocDense L{WSP(bf16, WS_XB), WSP(bf16, WS_WFGU) + (size_t)li * 2 * FFN * DM, DM, DM, DM, 0, 0}; StaticOrder S; S.init(M, 2 * FFN, 1, F.G, F.blk);
                EpiGU<FSwiglu> E{{WSP(bf16, WS_HB), FFN}}; gemm_phase(F.lds + RING_OFF, L, S, E);
            }
        }
        SEAM(pb + 9);
        if (PHON(11) && IN(pb + 10)) {
            asm volatile("; ==PH11");
            MKFRAME(F);
            if (moe) {
                const unsigned* cnt = (const unsigned*)(F.ctl + CW_MOECNT + 64 * li);
                LocDense L{WSP(bf16, WS_HM), WSP(bf16, WS_WMD), EXD, EXD, EXD, 0, (size_t)DM * EXD}; MoeOrder S; S.init(cnt, DM / 256, F.G, F.blk);
                Epi8<FMoeDown> E{{WSP(bf16, WS_YPAIR), WSP(float, WS_SLOTW), cnt}}; gemm_phase(F.lds + RING_OFF, L, S, E);
            } else {
                LocDense L{WSP(bf16, WS_HB), WSP(bf16, WS_WFD) + (size_t)li * DM * FFN, FFN, FFN, FFN, 0, 0}; StaticOrder S; S.init(M, DM, 1, F.G, F.blk);
                Epi8<FResid> E{{F.out, F.out}}; gemm_phase(F.lds + RING_OFF, L, S, E);
            }
        }
        SEAM(pb + 10);
        if (PHON(12) && IN(pb + 11)) {
            asm volatile("; ==PH12");
            MKFRAME(F);
            if (moe) ln2_moe_phase(F, INP(float, 35) + l * DM, INP(float, 36) + l * DM, li);
            else ln_phase(F, INP(float, 35) + l * DM, INP(float, 36) + l * DM);
        }
        SEAM(pb + 11);
    }
#undef IN
#undef SEAM
}

#ifdef PROBE_P
__global__ void probe_sum(const unsigned* x, unsigned long long* sums, int n) {
    __shared__ unsigned long long sh[256];
    unsigned long long s = 0;
    for (int i = blockIdx.x * blockDim.x + threadIdx.x; i < n; i += gridDim.x * blockDim.x) s += (unsigned long long)x[i] * (unsigned long long)(2 * (i & 1023) + 1);
    sh[threadIdx.x] = s; __syncthreads();
    if (threadIdx.x == 0) { unsigned long long t = 0; for (int i = 0; i < 256; ++i) t += sh[i]; sums[blockIdx.x] = t; }
}
__global__ void probe_cmp(const unsigned long long* sums, unsigned* out) {
    if (sums[threadIdx.x] != sums[1024 + threadIdx.x]) out[threadIdx.x * 4099] = 0x7fc00000u;
}
#endif
extern "C" void kernel_launch(void* const* d_in, const int* in_sizes, int n_in, void* d_out, int out_size, void* d_ws, size_t ws_size, hipStream_t stream) {
    static int grid = 0;
    if (grid == 0) {
        if (n_in != 44 || out_size != M * DM || ws_size < WS_END) { fprintf(stderr, "kernel_launch: unexpected problem (n_in %d, out %d, ws %zu < %zu)\n", n_in, out_size, ws_size, (size_t)WS_END); grid = -1; return; }
        int dev = 0, cus = 0, per_cu = 0;
        if (hipGetDevice(&dev) != hipSuccess || hipDeviceGetAttribute(&cus, hipDeviceAttributeMultiprocessorCount, dev) != hipSuccess) { grid = -1; return; }
        if (hipFuncSetAttribute((const void*)mk_fwd, hipFuncAttributeMaxDynamicSharedMemorySize, LDS_BYTES) != hipSuccess) { fprintf(stderr, "kernel_launch: hipFuncSetAttribute failed\n"); grid = -1; return; }
        if (hipOccupancyMaxActiveBlocksPerMultiprocessor(&per_cu, (const void*)mk_fwd, NWAVES * 64, LDS_BYTES) != hipSuccess || per_cu < 1) { fprintf(stderr, "kernel_launch: occupancy query says %d blocks per CU\n", per_cu); }
        (void)hipGetLastError();
        grid = cus;
        if (grid != 256) fprintf(stderr, "kernel_launch: %d CUs (built for 256)\n", grid);
    }
    if (grid < 0) return;
    (void)in_sizes;
    if (hipMemsetAsync((char*)d_ws + WS_CTL, 0, CTL_ZERO_BYTES, stream) != hipSuccess) return;
    Args a{};
    for (int i = 0; i < 44; ++i) a.in[i] = d_in[i];
    a.out = (float*)d_out; a.ws = (unsigned char*)d_ws; a.pad = 0;
#if MK_PER_PHASE
#ifdef PROBE_P
    for (int p = 0; p <= PROBE_P; ++p) { a.ph_lo = p; a.ph_hi = p + 1; a.li = p; hipLaunchKernelGGL(mk_fwd, dim3(grid), dim3(NWAVES * 64), LDS_BYTES, stream, a); }
    hipLaunchKernelGGL(probe_sum, dim3(1024), dim3(256), 0, stream, (const unsigned*)((char*)d_ws + PROBE_OFF), (unsigned long long*)((char*)d_ws + WS_END), (int)(PROBE_BYTES / 4));
    hipMemsetAsync((char*)d_ws + WS_CTL, 0, CTL_ZERO_BYTES, stream);
    for (int p = 0; p <= PROBE_P; ++p) { a.ph_lo = p; a.ph_hi = p + 1; a.li = p; hipLaunchKernelGGL(mk_fwd, dim3(grid), dim3(NWAVES * 64), LDS_BYTES, stream, a); }
    hipLaunchKernelGGL(probe_sum, dim3(1024), dim3(256), 0, stream, (const unsigned*)((char*)d_ws + PROBE_OFF), (unsigned long long*)((char*)d_ws + WS_END) + 1024, (int)(PROBE_BYTES / 4));
    for (int p = PROBE_P + 1; p < N_PHASES; ++p) { a.ph_lo = p; a.ph_hi = p + 1; a.li = p; hipLaunchKernelGGL(mk_fwd, dim3(grid), dim3(NWAVES * 64), LDS_BYTES, stream, a); }
    hipLaunchKernelGGL(probe_cmp, dim3(1), dim3(1024), 0, stream, (const unsigned long long*)((char*)d_ws + WS_END), (unsigned*)d_out);
#else
    for (int p = 0; p < N_PHASES; ++p) { a.ph_lo = p; a.ph_hi = p + 1; a.li = p; hipLaunchKernelGGL(mk_fwd, dim3(grid), dim3(NWAVES * 64), LDS_BYTES, stream, a); }
#endif
#else
    a.ph_lo = 0; a.ph_hi = N_PHASES; a.li = 0;
    hipLaunchKernelGGL(mk_fwd, dim3(grid), dim3(NWAVES * 64), LDS_BYTES, stream, a);
#endif
}
```

```cpp
#include <hip/hip_runtime.h>
#include <cstdio>
#include <cstdint>
#include <cmath>
namespace pg8 {
#define PG8_LAS __attribute__((address_space(3)))
typedef unsigned short bf16_t;
typedef short bf16x8 __attribute__((ext_vector_type(8)));
typedef float f32x4 __attribute__((ext_vector_type(4)));
typedef float f32x2 __attribute__((ext_vector_type(2)));
typedef unsigned u32x4 __attribute__((ext_vector_type(4)));
typedef unsigned u32x2 __attribute__((ext_vector_type(2)));
constexpr int BM = 256, BK = 64, HALF = 128, HTB = HALF * BK * 2  , STAGE_BYTES = 8 * HTB, NXCD = 8, WGM = 8;

__host__ __device__ __forceinline__ int lds_byte(int r, int c) { const int st = (r >> 4) * 2 + (c >> 5), rr = r & 15, cc = c & 31, ob = rr * 64 + cc * 2; return st * 1024 + (ob ^ (((ob >> 9) & 1) << 5)); }
__host__ __device__ __forceinline__ void stage_rc(int b, int& R, int& C) { const int st = b / 1024, sb = b % 1024, swz = sb ^ (((sb >> 9) & 1) << 5); R = (st >> 1) * 16 + swz / 64; C = (st & 1) * 32 + (swz % 64) / 2; }
__host__ __device__ __forceinline__ int perm32(int rho) { const int n = rho >> 4, i = rho & 15; return 8 * (i >> 2) + 4 * n + (i & 3); }

struct Unit { int pm, pn, z, aux; };

struct LocDense {
    static constexpr bool GATHER = false;
    const bf16_t* A; const bf16_t* Bt; int lda, ldb, K; size_t zA, zB;
    __device__ __forceinline__ const char* a_ptr(const Unit& u) const { return (const char*)(A + (size_t)u.z * zA + (size_t)u.pm * BM * lda); }
    __device__ __forceinline__ const char* b_ptr(const Unit& u) const { return (const char*)(Bt + (size_t)u.z * zB + (size_t)u.pn * BM * ldb); }
    __device__ __forceinline__ void a_off(const Unit&, int tid, unsigned (&v)[2][2]) const {
#pragma unroll
        for (int i = 0; i < 2; ++i) { int R, C; stage_rc(tid * 16 + i * 8192, R, C); v[0][i] = (unsigned)(R * lda + C) * 2u; v[1][i] = 0u; }
    }
};

struct StaticOrder {
    int nM, nN, nwg, nZ, G, c;
    __device__ void init(int M, int N, int Z, int G_, int c_) { nM = M / BM; nN = N / BM; nwg = nM * nN; nZ = Z; G = G_; c = c_; }
    __device__ bool next(int i, Unit& u) const {
        const long L = (long)i * G + c; if (L >= (long)nwg * nZ) return false;
        u.z = (int)(L / nwg); u.aux = 0;
        int wgid = (int)(L % nwg); { const int q = nwg / NXCD, r = nwg % NXCD, xcd = wgid % NXCD, off = wgid / NXCD; wgid = (xcd < r ? xcd * (q + 1) : r * (q + 1) + (xcd - r) * q) + off; }
        const int nig = WGM * nN, gid = wgid / nig, fm = gid * WGM, gsz = (nM - fm) < WGM ? (nM - fm) : WGM;
        u.pm = fm + ((wgid % nig) % gsz); u.pn = (wgid % nig) / gsz; return true;
    }
};

typedef float f32x2_cv __attribute__((ext_vector_type(2))); typedef __bf16 bf16x2_cv __attribute__((ext_vector_type(2)));
__device__ __forceinline__ unsigned cvt_pk_bf16(float lo, float hi) { const f32x2_cv v = {lo, hi}; const bf16x2_cv b = __builtin_convertvector(v, bf16x2_cv); return __builtin_bit_cast(unsigned, b); }
__device__ __forceinline__ u32x4 pack8(const f32x4 v0, const f32x4 v1) { u32x4 w; w.x = cvt_pk_bf16(v0[0], v0[1]); w.y = cvt_pk_bf16(v0[2], v0[3]); w.z = cvt_pk_bf16(v1[0], v1[1]); w.w = cvt_pk_bf16(v1[2], v1[3]); return w; }
__device__ __forceinline__ float bf_lo(unsigned w) { return __uint_as_float(w << 16); }
__device__ __forceinline__ float bf_hi(unsigned w) { return __uint_as_float(w & 0xffff0000u); }
__device__ __forceinline__ void unpack8(const u32x4 w, f32x4& v0, f32x4& v1) { v0 = (f32x4){bf_lo(w.x), bf_hi(w.x), bf_lo(w.y), bf_hi(w.y)}; v1 = (f32x4){bf_lo(w.z), bf_hi(w.z), bf_lo(w.w), bf_hi(w.w)}; }

struct NoPre {};
template <class F> struct Epi8 {
    static constexpr bool PERM = true;
    F f;
    __device__ __forceinline__ void operator()(const f32x4 (&acc)[2][2][4][2], const Unit& u, int wr, int wc, int fr, int fq) const {
        const int row0 = u.pm * BM + wr * 64 + fr, col0 = u.pn * BM + wc * 32 + 8 * fq;
        F g = f;
#pragma unroll
        for (int bj = 0; bj < 2; ++bj) { const int col = col0 + bj * HALF; g.begin_col(u, col);
#pragma unroll
            for (int b0 = 0; b0 < 8; b0 += F::BATCH) { typename F::Pre pr[F::BATCH];
#pragma unroll
                for (int i = 0; i < F::BATCH; ++i) { const int q = b0 + i; pr[i] = g.pre(u, row0 + (q >> 2) * HALF + (q & 3) * 16, col); }
#pragma unroll
                for (int i = 0; i < F::BATCH; ++i) { const int q = b0 + i; g.tile8(u, row0 + (q >> 2) * HALF + (q & 3) * 16, col, acc[q >> 2][bj][q & 3][0], acc[q >> 2][bj][q & 3][1], pr[i]); }
                asm volatile("" ::: "memory"); } }
    }
};
template <class F> struct EpiGU {
    static constexpr bool PERM = true;
    F f;
    __device__ __forceinline__ void operator()(const f32x4 (&acc)[2][2][4][2], const Unit& u, int wr, int wc, int fr, int fq) const {
        const int row0 = u.pm * BM + wr * 64 + fr, colh = u.pn * HALF + wc * 32 + 8 * fq;
#pragma unroll
        for (int ai = 0; ai < 2; ++ai)
#pragma unroll
            for (int m = 0; m < 4; ++m) { f.pair8(u, row0 + ai * HALF + m * 16, colh, acc[ai][0][m][0], acc[ai][0][m][1], acc[ai][1][m][0], acc[ai][1][m][1]); asm volatile("" ::: "memory"); }
    }
};

template <class Epi, class Sched, class Loc>
__device__ __forceinline__ void gemm_phase(PG8_LAS unsigned char* lds, const Loc& L, const Sched& S, const Epi& E) {
    int tid_ = threadIdx.x; asm volatile("" : "+v"(tid_));
    const int tid = tid_, wid = __builtin_amdgcn_readfirstlane(tid >> 6), lane = tid & 63, wr = wid >> 2, wc = wid & 3, fr = lane & 15, fq = lane >> 4;
    const int K = L.K, nt = K / BK;
    unsigned voffB[2];
#pragma unroll
    for (int i = 0; i < 2; ++i) { int R, C; stage_rc(tid * 16 + i * 8192, R, C); const int Rb = Epi::PERM ? ((R & ~31) + perm32(R & 31)) : R;
        voffB[i] = (unsigned)(Rb * L.ldb + C) * 2u; }
    const size_t kstep = (size_t)(BK * 2);
    const size_t hstepB = (size_t)HALF * L.ldb * 2;
    const unsigned ldsw = (unsigned)wid * 1024u;
    const int aoff = lds_byte(wr * 64 + fr, fq * 8), boff = lds_byte(wc * 32 + fr, fq * 8);
#define PG8_SA(b, h) (((b) * 2 + (h)) * HTB)
#define PG8_SB(b, h) ((4 + (b) * 2 + (h)) * HTB)
#define PG8_STAGE(bufoff, gbase, voff) do { _Pragma("unroll") for (int _i = 0; _i < 2; ++_i) \
        __builtin_amdgcn_global_load_lds((const unsigned*)((const char*)(gbase) + (voff)[_i]), (PG8_LAS unsigned*)(lds + (bufoff) + ldsw + _i * 8192), 16, 0, 0); } while (0)
#define PG8_LDA(dst, b, h) do { _Pragma("unroll") for (int m = 0; m < 4; ++m) _Pragma("unroll") for (int k = 0; k < 2; ++k) dst[m][k] = *(const PG8_LAS bf16x8*)(lds + PG8_SA(b, h) + aoff + m * 2048 + k * 1024); } while (0)
#define PG8_LDB(dst, b, h) do { _Pragma("unroll") for (int n = 0; n < 2; ++n) _Pragma("unroll") for (int k = 0; k < 2; ++k) dst[n][k] = *(const PG8_LAS bf16x8*)(lds + PG8_SB(b, h) + boff + n * 2048 + k * 1024); } while (0)
#define PG8_MMA(ai, bj, At, Bt) do { __builtin_amdgcn_s_setprio(1); _Pragma("unroll") for (int m = 0; m < 4; ++m) _Pragma("unroll") for (int n = 0; n < 2; ++n) _Pragma("unroll") for (int k = 0; k < 2; ++k) \
        acc[ai][bj][m][n] = __builtin_amdgcn_mfma_f32_16x16x32_bf16(Bt[n][k], At[m][k], acc[ai][bj][m][n], 0, 0, 0); __builtin_amdgcn_s_setprio(0); } while (0)
#define PG8_WAIT_V(n) asm volatile("s_waitcnt vmcnt(" #n ")" ::: "memory")
#define PG8_WAIT_L(n) asm volatile("s_waitcnt lgkmcnt(" #n ")" ::: "memory")
#define PG8_BAR __builtin_amdgcn_s_barrier()
#define PG8_SCHED __builtin_amdgcn_sched_barrier(0)
    Unit cur, nxt; int ui = 0;
    if (!S.next(0, cur)) return;
    f32x4 acc[2][2][4][2];
#pragma unroll
    for (int a = 0; a < 2; ++a)
#pragma unroll
        for (int b = 0; b < 2; ++b)
#pragma unroll
            for (int m = 0; m < 4; ++m)
#pragma unroll
                for (int n = 0; n < 2; ++n) acc[a][b][m][n] = (f32x4){0.f, 0.f, 0.f, 0.f};
    bf16x8 At[4][2], B0[2][2], B1[2][2];
    constexpr int NVH = Loc::GATHER ? 2 : 1;
    unsigned vc[2][2], vn[NVH][2];
    L.a_off(cur, tid, vc);
    if constexpr (Loc::GATHER) {
#pragma unroll
        for (int h = 0; h < 2; ++h)
#pragma unroll
            for (int i = 0; i < 2; ++i) vn[h][i] = vc[h][i];
    }
    const size_t hstepA = Loc::GATHER ? 0 : (size_t)HALF * L.lda * 2;
    const char* cA = L.a_ptr(cur); const char* cB = L.b_ptr(cur);
    PG8_STAGE(PG8_SB(0, 0), cB, voffB); PG8_STAGE(PG8_SB(0, 1), cB + hstepB, voffB); PG8_STAGE(PG8_SA(0, 0), cA, vc[0]); PG8_STAGE(PG8_SA(0, 1), cA + hstepA, vc[NVH - 1]);
    if (wr == 1) PG8_BAR;
    PG8_WAIT_V(2); PG8_BAR;
    PG8_STAGE(PG8_SB(1, 0), cB + kstep, voffB); PG8_STAGE(PG8_SA(1, 0), cA + kstep, vc[0]); PG8_STAGE(PG8_SB(1, 1), cB + hstepB + kstep, voffB);
    PG8_WAIT_V(6); PG8_BAR;
    for (;;) {
        const bool has_next = S.next(ui + 1, nxt);
        const char* nA = has_next ? L.a_ptr(nxt) : cA; const char* nB = has_next ? L.b_ptr(nxt) : cB;
        if constexpr (Loc::GATHER) { if (has_next) L.a_off(nxt, tid, vn); }
        for (int t = 0; t < nt; t += 2) {
            const bool last = (t == nt - 2);
            const char* a1 = cA + (size_t)(t + 1) * kstep;
            const char* a2 = last ? nA : cA + (size_t)(t + 2) * kstep; const char* b2 = last ? nB : cB + (size_t)(t + 2) * kstep;
            const char* a3 = a2 + kstep; const char* b3 = b2 + kstep;
            PG8_LDB(B0, 0, 0); PG8_LDB(B1, 0, 1); PG8_SCHED; PG8_LDA(At, 0, 0); PG8_STAGE(PG8_SA(1, 1), a1 + hstepA, vc[NVH - 1]);
            if constexpr (Loc::GATHER) { if (last) {
#pragma unroll
                for (int h = 0; h < 2; ++h)
#pragma unroll
                    for (int i = 0; i < 2; ++i) vc[h][i] = vn[h][i]; } }
            PG8_WAIT_V(8); PG8_WAIT_L(0); PG8_BAR; PG8_MMA(0, 0, At, B0); PG8_MMA(0, 1, At, B1); PG8_BAR; PG8_SCHED;
            PG8_LDA(At, 0, 1); PG8_STAGE(PG8_SB(0, 0), b2, voffB); PG8_STAGE(PG8_SB(0, 1), b2 + hstepB, voffB); PG8_STAGE(PG8_SA(0, 0), a2, vc[0]);
            PG8_WAIT_V(8); PG8_WAIT_L(0); PG8_BAR; PG8_MMA(1, 0, At, B0); PG8_MMA(1, 1, At, B1); PG8_BAR; PG8_SCHED;
            PG8_LDB(B0, 1, 0); PG8_LDB(B1, 1, 1); PG8_SCHED; PG8_LDA(At, 1, 0); PG8_STAGE(PG8_SA(0, 1), a2 + hstepA, vc[NVH - 1]);
            PG8_WAIT_V(8); PG8_WAIT_L(0); PG8_BAR; PG8_MMA(0, 0, At, B0); PG8_MMA(0, 1, At, B1); PG8_BAR; PG8_SCHED;
            PG8_LDA(At, 1, 1); PG8_STAGE(PG8_SB(1, 0), b3, voffB); PG8_STAGE(PG8_SB(1, 1), b3 + hstepB, voffB); PG8_STAGE(PG8_SA(1, 0), a3, vc[0]);
            PG8_WAIT_V(8); PG8_WAIT_L(0); PG8_BAR; PG8_MMA(1, 0, At, B0); PG8_MMA(1, 1, At, B1); PG8_BAR; PG8_SCHED;
        }
        if (wr == 0) PG8_BAR;
        E(acc, cur, wr, wc, fr, fq);
        if (!has_next) break;
#pragma unroll
        for (int a = 0; a < 2; ++a)
#pragma unroll
            for (int b = 0; b < 2; ++b)
#pragma unroll
                for (int m = 0; m < 4; ++m)
#pragma unroll
                    for (int n = 0; n < 2; ++n) acc[a][b][m][n] = (f32x4){0.f, 0.f, 0.f, 0.f};
        cur = nxt; cA = nA; cB = nB; ++ui;
        if (wr == 1) PG8_BAR;
    }
    PG8_WAIT_V(0);
    PG8_BAR;
#undef PG8_SA
#undef PG8_SB
#undef PG8_STAGE
#undef PG8_LDA
#undef PG8_LDB
#undef PG8_MMA
#undef PG8_WAIT_V
#undef PG8_WAIT_L
#undef PG8_BAR
#undef PG8_SCHED
}
}
constexpr int NWAVES = 8;
constexpr int M = 32768, DM = 1024, SEQ = 4096, NBATCH = 8, NLAYER = 4;
constexpr int NH = 8;
constexpr int IN_W = 6048;
constexpr int FFN = 2816, EXD = 3584, NEXP = 8;
constexpr float LN_EPS = 1e-5f, ALPHA = 1.681792830507429f;
constexpr int S5T = 32, S5CH = M / S5T  , S5K = 640, S5NC = SEQ / S5T  ;
constexpr int MOE_CAP = 65536;
constexpr int MOE_ROWS = 65536 + 8 * 256;

constexpr size_t MiB = 1u << 20;
constexpr size_t WS_CTL = 0, CTL_ZERO_BYTES = 1 * MiB;
constexpr size_t WS_WIN = 1 * MiB;
constexpr size_t WS_WG = 25 * MiB;
constexpr size_t WS_WUQ = 49 * MiB;
constexpr size_t WS_WUKV = 52 * MiB;
constexpr size_t WS_WLORA = 54 * MiB;
constexpr size_t WS_WVRES = 57 * MiB;
constexpr size_t WS_WGLU = 59 * MiB;
constexpr size_t WS_WBR = 61 * MiB;
constexpr size_t WS_WOUT = 73 * MiB;
constexpr size_t WS_WFGU = 81 * MiB;
constexpr size_t WS_WFD = 103 * MiB;
constexpr size_t WS_S5MAIN = 114 * MiB;
constexpr size_t WS_S5END = 134 * MiB;
constexpr size_t WS_S5A32 = 142 * MiB;
constexpr size_t WS_ROPE = 143 * MiB;
constexpr size_t WS_XB = 147 * MiB;
constexpr size_t WS_VFIRST = 211 * MiB;
constexpr size_t RB = 243 * MiB;
constexpr size_t WS_S5U = RB + 0;
constexpr size_t WS_S1 = RB + 40 * MiB;
constexpr size_t WS_MLARAW = WS_S1;
constexpr size_t WS_RWRAW = WS_S1 + 48 * MiB;
constexpr size_t WS_Q = WS_S1;
constexpr size_t WS_V = WS_S1 + 48 * MiB;
constexpr size_t WS_BV = WS_S1 + 80 * MiB;
constexpr size_t WS_DCY = WS_S1 + 112 * MiB;
constexpr size_t WS_YS5G = WS_S1;
constexpr size_t WS_YS5 = WS_S1 + 32 * MiB;
constexpr size_t WS_MIXED = WS_S1 + 64 * MiB;
constexpr size_t WS_R = RB + 200 * MiB;
constexpr size_t WS_KH = RB + 232 * MiB;
constexpr size_t WS_KKN = RB + 264 * MiB;
constexpr size_t WS_GL = RB + 296 * MiB;
constexpr size_t WS_GBUF = RB + 264 * MiB;
constexpr size_t WS_VFIN = RB + 328 * MiB;
constexpr size_t WS_K = RB + 360 * MiB;
constexpr size_t WS_VRAW = RB + 408 * MiB;
constexpr size_t WS_YRW = WS_VRAW;
constexpr size_t WS_S2 = RB + 440 * MiB;
constexpr size_t WS_CQN = WS_S2;
constexpr size_t WS_CKVN = WS_S2 + 24 * MiB;
constexpr size_t WS_LORAIN = WS_S2 + 40 * MiB;
constexpr size_t WS_YMLA = WS_S2;
constexpr size_t WS_XEND = RB + 496 * MiB;
constexpr size_t WS_GBUF2 = RB + 512 * MiB;
constexpr size_t WS_MIXED2 = RB + 576 * MiB;
constexpr size_t WS_HB = RB + 0;
constexpr size_t WS_WMGU = RB + 0;
constexpr size_t WS_YPAIR = RB + 0;
constexpr size_t WS_HM = RB + 132 * MiB;
constexpr size_t WS_WMD = RB + 594 * MiB;
constexpr size_t WS_SLOTTOK = RB + 650 * MiB;
constexpr size_t WS_SLOTW = RB + 652 * MiB;
constexpr size_t WS_PAIRPOS = RB + 654 * MiB;
constexpr size_t WS_END = RB + 655 * MiB;
constexpr int CW_BAR = 4096;
constexpr int CW_ATTN = 200000;
constexpr int CW_MOECNT = 201024;

constexpr int RING_OFF = 0, RING_BYTES = 131072;
constexpr int LDSCTL_OFF = RING_BYTES, MISC_OFF = LDSCTL_OFF + 320;
constexpr int LDS_BYTES = 147456;

#define GAS __attribute__((address_space(1)))
#define LAS __attribute__((address_space(3)))
typedef unsigned short bf16;
typedef _Float16 f16;
typedef f16 f16x8 __attribute__((ext_vector_type(8)));
typedef unsigned v4u __attribute__((ext_vector_type(4)));
typedef unsigned v2u __attribute__((ext_vector_type(2)));
typedef float f32x4 __attribute__((ext_vector_type(4)));
typedef float f32x16 __attribute__((ext_vector_type(16)));
typedef short bf16x8 __attribute__((ext_vector_type(8)));
typedef short s16x4 __attribute__((ext_vector_type(4)));
typedef GAS unsigned gu32;
#define RLX_AGENT __ATOMIC_RELAXED, __HIP_MEMORY_SCOPE_AGENT
#define LDS_WAIT() asm volatile("s_waitcnt lgkmcnt(0)" ::: "memory")
using pg8::cvt_pk_bf16; using pg8::pack8; using pg8::unpack8; using pg8::bf_lo; using pg8::bf_hi;

__device__ __forceinline__ float sigm(float x) { return __builtin_amdgcn_rcpf(1.0f + __expf(-x)); }
__device__ __forceinline__ float gelu_tanh(float y) { const float u = 0.7978845608028654f * (y + 0.044715f * y * y * y); const float t = 1.0f - 2.0f * __builtin_amdgcn_rcpf(__expf(2.0f * u) + 1.0f); return 0.5f * y * (1.0f + t); }
__device__ __forceinline__ float wave_sum(float v) {
#pragma unroll
    for (int o = 1; o < 64; o <<= 1) v += __shfl_xor(v, o);
    return v;
}
__device__ __forceinline__ v4u ld_nt16(const void* p) { return __builtin_nontemporal_load((const v4u*)p); }
__device__ __forceinline__ void f16x8_to_f32(const f16x8 h, float (&o)[8]) {
#pragma unroll
    for (int j = 0; j < 8; ++j) o[j] = (float)h[j];
}
__device__ __forceinline__ f16x8 f32_to_f16x8(const float (&v)[8]) { f16x8 h;
#pragma unroll
    for (int j = 0; j < 8; ++j) h[j] = (f16)v[j];
    return h; }
__device__ __forceinline__ void bf16x8_to_f32(const v4u w, float (&o)[8]) { o[0] = bf_lo(w.x); o[1] = bf_hi(w.x); o[2] = bf_lo(w.y); o[3] = bf_hi(w.y); o[4] = bf_lo(w.z); o[5] = bf_hi(w.z); o[6] = bf_lo(w.w); o[7] = bf_hi(w.w); }
__device__ __forceinline__ v4u f32_to_bf16x8(const float (&v)[8]) { v4u w; w.x = cvt_pk_bf16(v[0], v[1]); w.y = cvt_pk_bf16(v[2], v[3]); w.z = cvt_pk_bf16(v[4], v[5]); w.w = cvt_pk_bf16(v[6], v[7]); return w; }
__device__ __forceinline__ void ld8f(const float* p, float (&o)[8]) { const f32x4 a = *(const f32x4*)p, b = *(const f32x4*)(p + 4); o[0] = a[0]; o[1] = a[1]; o[2] = a[2]; o[3] = a[3]; o[4] = b[0]; o[5] = b[1]; o[6] = b[2]; o[7] = b[3]; }

#define XB_TMO      128
#define XB_XCNT(j)  (256  + 64 * (j))
#define XB_XSUB(j)  (1280 + 64 * (j))
#define XB_XGEN(j)  (2304 + 64 * (j))
#define XB_TOP      3328
#define XB_TOPGEN   3392
#define XCD_BAR_WORDS 3456
#define XB_SPIN_CAP (1u << 20)

__device__ __forceinline__ unsigned xb_ld(unsigned* p)              { return __hip_atomic_load(p, __ATOMIC_RELAXED, __HIP_MEMORY_SCOPE_AGENT); }
__device__ __forceinline__ unsigned xb_add(unsigned* p, unsigned v) { return __hip_atomic_fetch_add(p, v, __ATOMIC_RELAXED, __HIP_MEMORY_SCOPE_AGENT); }
__device__ __forceinline__ unsigned xb_xcc_id() { return (unsigned)__builtin_amdgcn_s_getreg((3 << 11) | 20) & 0xFu; }
#define XB_SPIN(cond, bar) do { unsigned _sp = 0; while (cond) { __builtin_amdgcn_s_sleep(1); \
    if ((++_sp & 255u) == 0u) { if (xb_ld(&(bar)[XB_TMO])) break; if (_sp > XB_SPIN_CAP) { atomicAdd(&(bar)[XB_TMO], 1u); break; } } } } while (0)

struct XcdBarrier { unsigned* bar; unsigned x; volatile LAS unsigned* st; };

__device__ __forceinline__ XcdBarrier xcd_barrier_post(unsigned* bar, volatile LAS unsigned* st) {
    XcdBarrier b; b.bar = bar; b.x = xb_xcc_id(); b.st = st;
    if (threadIdx.x == 0) (void)xb_add(&bar[XB_XCNT(b.x)], 1u);
    return b;
}
__device__ __forceinline__ void xcd_barrier_complete(unsigned* bar, unsigned x, unsigned& nloc, unsigned& nx) {
    const unsigned G = gridDim.x * gridDim.y * gridDim.z;
    unsigned sum, cnt, mine, sp = 0u;
    for (;;) {
        sum = 0u; cnt = 0u; mine = 0u;
#pragma unroll
        for (unsigned j = 0; j < 16; ++j) { const unsigned c = xb_ld(&bar[XB_XCNT(j)]); sum += c; cnt += (c > 0u) ? 1u : 0u; mine = (j == x) ? c : mine; }
        if (sum == G) break;
        __builtin_amdgcn_s_sleep(1);
        if ((++sp & 255u) == 0u) { if (xb_ld(&bar[XB_TMO])) break; if (sp > XB_SPIN_CAP) { atomicAdd(&bar[XB_TMO], 1u); break; } }
    }
    nloc = mine > 0u ? mine : 1u; nx = cnt > 0u ? cnt : 1u;
}
__device__ __forceinline__ void xcd_barrier(const XcdBarrier& b) {
    asm volatile("s_waitcnt vmcnt(0)" ::: "memory");
    __syncthreads();
    if (threadIdx.x == 0) {
        unsigned* bar = b.bar;
        __builtin_amdgcn_s_waitcnt(0);
        unsigned nloc = b.st[0], nx = b.st[1];
        if (nloc == 0u) { xcd_barrier_complete(bar, b.x, nloc, nx); b.st[0] = nloc; b.st[1] = nx; }
        const unsigned old = xb_add(&bar[XB_XSUB(b.x)], 1u);
        const unsigned gen = old / nloc;
        if (old + 1u == (gen + 1u) * nloc) {
            __builtin_amdgcn_fence(__ATOMIC_RELEASE, "agent");
            asm volatile("s_waitcnt vmcnt(0)" ::: "memory");
            const unsigned og = xb_add(&bar[XB_TOP], 1u);
            const unsigned tg = og / nx;
            if (og + 1u == (tg + 1u) * nx) xb_add(&bar[XB_TOPGEN], 1u);
            else XB_SPIN(xb_ld(&bar[XB_TOPGEN]) == tg, bar);
            __builtin_amdgcn_fence(__ATOMIC_ACQUIRE, "agent");
            xb_add(&bar[XB_XGEN(b.x)], 1u);
            asm volatile("s_waitcnt vmcnt(0)" ::: "memory");
        } else {
            XB_SPIN(xb_ld(&bar[XB_XGEN(b.x)]) == gen, bar);
            __builtin_amdgcn_fence(__ATOMIC_ACQUIRE, "agent");
            asm volatile("s_waitcnt vmcnt(0)" ::: "memory");
        }
    }
    __syncthreads();
}

struct Args { const void* in[44]; float* out; unsigned char* ws; int ph_lo, ph_hi, li, pad; };
typedef const __attribute__((address_space(4))) Args* KArgs;
struct Frame {
    LAS unsigned char* lds;
    unsigned char* ws;
    gu32* ctl;
    int tid, lane, wave;
    int G, blk;
    float* out;
    KArgs ka;
};
#define MKFRAME(F) Frame F; { int t_ = threadIdx.x; asm volatile("" : "+v"(t_)); KArgs k_ = (KArgs)__builtin_amdgcn_kernarg_segment_ptr(); asm volatile("" : "+s"(k_)); \
    F.lds = (LAS unsigned char*)lds_raw; F.ka = k_; F.ws = k_->ws; F.ctl = (gu32*)(k_->ws + WS_CTL); F.out = k_->out; F.tid = t_; F.lane = t_ & 63; F.wave = __builtin_amdgcn_readfirstlane(t_ >> 6); F.G = gridDim.x; F.blk = blockIdx.x; }
#define WSP(T, off) ((T*)(F.ws + (off)))
#define INP(T, i) ((const T*)F.ka->in[i])
using pg8::Unit; using pg8::Epi8; using pg8::EpiGU;
__device__ __forceinline__ void f4x2_to8(const f32x4 v0, const f32x4 v1, float (&o)[8]) { o[0] = v0[0]; o[1] = v0[1]; o[2] = v0[2]; o[3] = v0[3]; o[4] = v1[0]; o[5] = v1[1]; o[6] = v1[2]; o[7] = v1[3]; }

struct FProj {
    static constexpr int BATCH = 8; bf16* mla; bf16* rw; bf16* s5u;
    __device__ __forceinline__ void begin_col(const Unit&, int) {}
    typedef pg8::NoPre Pre; __device__ __forceinline__ Pre pre(const Unit&, int, int) const { return Pre{}; }
    __device__ __forceinline__ void tile8(const Unit&, int row, int col, const f32x4 v0, const f32x4 v1, const Pre&) const {
        const v4u w = pack8(v0, v1);
        if (col < 768) *(v4u*)(mla + (unsigned)row * 768 + col) = w;
        else if (col < 2560) *(v4u*)(rw + (unsigned)row * 1792 + (col - 768)) = w;
        else { const int c = col - 2560, g = c >> 4, i = c & 15; *(v4u*)(s5u + (unsigned)((g * S5CH + (row >> 5)) * S5K) + (row & 31) * 16 + i) = w; }
    }
};
struct FQup {
    static constexpr int BATCH = 4; bf16* Q; const float* cs; float qs;
    struct Pre { f32x4 c, s; };
    __device__ __forceinline__ void begin_col(const Unit&, int) {}
    __device__ __forceinline__ Pre pre(const Unit&, int row, int col) const { Pre p; const int head = col / 96, w = (col - head * 96) >> 3;
        if (w >= 8) { const int i0 = (w - 8) * 4; p.c = *(const f32x4*)(cs + (unsigned)row * 32 + i0); p.s = *(const f32x4*)(cs + (unsigned)row * 32 + 16 + i0); } else { p.c = (f32x4){0.f, 0.f, 0.f, 0.f}; p.s = p.c; } return p; }
    __device__ __forceinline__ void tile8(const Unit&, int row, int col, const f32x4 v0, const f32x4 v1, const Pre& p) const {
        const int head = col / 96, w = (col - head * 96) >> 3;
        bf16* q = Q + (unsigned)row * 768 + head * 96;
        if (w < 8) { *(v4u*)(q + 8 * w) = pack8(v0 * qs, v1 * qs); }
        else { const int i0 = (w - 8) * 4; const f32x4 c = p.c, s = p.s;
            const f32x4 x1 = (f32x4){v0[0], v0[2], v1[0], v1[2]}, x2 = (f32x4){v0[1], v0[3], v1[1], v1[3]};
            const f32x4 o1 = (x1 * c - x2 * s) * qs, o2 = (x1 * s + x2 * c) * qs;
            v2u a, b; a.x = cvt_pk_bf16(o1[0], o1[1]); a.y = cvt_pk_bf16(o1[2], o1[3]); b.x = cvt_pk_bf16(o2[0], o2[1]); b.y = cvt_pk_bf16(o2[2], o2[3]);
            *(v2u*)(q + 64 + i0) = a; *(v2u*)(q + 80 + i0) = b; }
    }
};
struct FKVup {
    static constexpr int BATCH = 8; bf16* K; bf16* V;
    __device__ __forceinline__ void begin_col(const Unit&, int) {}
    typedef pg8::NoPre Pre; __device__ __forceinline__ Pre pre(const Unit&, int, int) const { return Pre{}; }
    __device__ __forceinline__ void tile8(const Unit&, int row, int col, const f32x4 v0, const f32x4 v1, const Pre&) const {
        const int head = col >> 7, d = col & 127; const v4u w = pack8(v0, v1);
        if (d < 64) *(v4u*)(K + (unsigned)row * 768 + head * 96 + d) = w; else *(v4u*)(V + (unsigned)row * 512 + head * 64 + (d - 64)) = w;
    }
};
struct FLora {
    static constexpr int BATCH = 4;
    const float* w0; const float* a0; const float* k_a; f16* dcy; f16* kh; const f16* kkn; f16* bv; bf16* gl; float p[8], ka[8];
    struct Pre { f16x8 k, kn; };
    __device__ __forceinline__ void begin_col(const Unit&, int col) { const int seg = col >> 9, c = col & 511; ld8f(((seg == 0) ? w0 : a0) + c, p); ld8f(k_a + c, ka); }
    __device__ __forceinline__ Pre pre(const Unit&, int row, int col) const { Pre r; const unsigned off = (unsigned)row * 512 + (col & 511);
        if ((col >> 9) == 1) { r.k = *(const f16x8*)(kh + off); r.kn = *(const f16x8*)(kkn + off); } else { r.k = (f16x8)(0); r.kn = (f16x8)(0); } return r; }
    __device__ __forceinline__ void tile8(const Unit&, int row, int col, const f32x4 v0, const f32x4 v1, const Pre& pr) const {
        float a[8]; f4x2_to8(v0, v1, a);
        const int seg = col >> 9, c = col & 511; const unsigned off = (unsigned)row * 512 + c;
        if (seg == 0) { float o[8];
#pragma unroll
            for (int j = 0; j < 8; ++j) { const float e = 0.6065306597126334f * sigm(p[j] + a[j]); o[j] = -expm1f(-e); }
            *(f16x8*)(dcy + off) = f32_to_f16x8(o); }
        else if (seg == 1) { float k[8], kn[8]; f16x8_to_f32(pr.k, k); f16x8_to_f32(pr.kn, kn); float o1[8], o2[8];
#pragma unroll
            for (int j = 0; j < 8; ++j) { const float ic = sigm(p[j] + a[j]); o1[j] = k[j] * (1.0f + (ic - 1.0f) * ka[j]); o2[j] = kn[j] * ic; }
            *(f16x8*)(kh + off) = f32_to_f16x8(o1); *(f16x8*)(bv + off) = f32_to_f16x8(o2); }
        else { *(v4u*)(gl + off) = pack8(v0, v1); }
    }
};
struct FVres {
    static constexpr int BATCH = 4;
    const float* vb; const bf16* vraw; const bf16* vfirst; f16* vfin; float p[8];
    struct Pre { v4u v, vf; };
    __device__ __forceinline__ void begin_col(const Unit&, int col) { ld8f(vb + col, p); }
    __device__ __forceinline__ Pre pre(const Unit&, int row, int col) const { Pre r; const unsigned off = (unsigned)row * 512 + col; r.v = *(const v4u*)(vraw + off); r.vf = *(const v4u*)(vfirst + off); return r; }
    __device__ __forceinline__ void tile8(const Unit&, int row, int col, const f32x4 v0, const f32x4 v1, const Pre& pr) const {
        float a[8], v[8], vf[8], o[8]; f4x2_to8(v0, v1, a); const unsigned off = (unsigned)row * 512 + col;
        bf16x8_to_f32(pr.v, v); bf16x8_to_f32(pr.vf, vf);
#pragma unroll
        for (int j = 0; j < 8; ++j) o[j] = v[j] + (vf[j] - v[j]) * sigm(p[j] + a[j]);
        *(f16x8*)(vfin + off) = f32_to_f16x8(o);
    }
};
struct FS5End {
    static constexpr int BATCH = 8; float* xend;
    __device__ __forceinline__ void begin_col(const Unit&, int) {}
    typedef pg8::NoPre Pre; __device__ __forceinline__ Pre pre(const Unit&, int, int) const { return Pre{}; }
    __device__ __forceinline__ void tile8(const Unit& u, int row, int col, const f32x4 v0, const f32x4 v1, const Pre&) const {
        if (col < 128) { float* p = xend + (unsigned)((u.z * S5CH + row) * 128 + col); *(f32x4*)p = v0; *(f32x4*)(p + 4) = v1; }
    }
};
struct FS5Main {
    static constexpr int BATCH = 8;
    const bf16* s5u; const float* dvec; bf16* ys5g; float d[8];
    struct Pre { v4u uu; };
    __device__ __forceinline__ void begin_col(const Unit& u, int col) { ld8f(dvec + u.z * 16 + (col & 15), d); }
    __device__ __forceinline__ Pre pre(const Unit& u, int row, int col) const { Pre r; r.uu = *(const v4u*)(s5u + (unsigned)((u.z * S5CH + row) * S5K + col)); return r; }
    __device__ __forceinline__ void tile8(const Unit& u, int row, int col, const f32x4 v0, const f32x4 v1, const Pre& pr) const {
        float a[8], uu[8], o[8]; f4x2_to8(v0, v1, a); const int g = u.z, t = col >> 4, o0 = col & 15;
        bf16x8_to_f32(pr.uu, uu);
#pragma unroll
        for (int j = 0; j < 8; ++j) o[j] = gelu_tanh(a[j] + d[j] * uu[j]);
        *(v4u*)(ys5g + ((unsigned)row * 32 + t) * 512 + g * 16 + o0) = f32_to_bf16x8(o);
    }
};
struct FGlu {
    static constexpr int BATCH = 8;
    const bf16* ys5g; const float* bglu; bf16* ys5; float b[8];
    struct Pre { v4u y; };
    __device__ __forceinline__ void begin_col(const Unit&, int col) { ld8f(bglu + col, b); }
    __device__ __forceinline__ Pre pre(const Unit&, int row, int col) const { Pre r; r.y = *(const v4u*)(ys5g + (unsigned)row * 512 + col); return r; }
    __device__ __forceinline__ void tile8(const Unit&, int row, int col, const f32x4 v0, const f32x4 v1, const Pre& pr) const {
        float a[8], y[8], o[8]; f4x2_to8(v0, v1, a); const unsigned off = (unsigned)row * 512 + col; bf16x8_to_f32(pr.y, y);
#pragma unroll
        for (int j = 0; j < 8; ++j) o[j] = y[j] * sigm(a[j] + b[j]);
        *(v4u*)(ys5 + off) = f32_to_bf16x8(o);
    }
};
struct FGate {
    static constexpr int BATCH = 8; bf16* gbuf;
    __device__ __forceinline__ void begin_col(const Unit&, int) {}
    typedef pg8::NoPre Pre; __device__ __forceinline__ Pre pre(const Unit&, int, int) const { return Pre{}; }
    __device__ __forceinline__ void tile8(const Unit&, int row, int col, const f32x4 v0, const f32x4 v1, const Pre&) const {
        float a[8], o[8]; f4x2_to8(v0, v1, a);
#pragma unroll
        for (int j = 0; j < 8; ++j) o[j] = sigm(a[j]);
        *(v4u*)(gbuf + (unsigned)row * 1024 + col) = f32_to_bf16x8(o);
    }
};
struct FMerge {
    static constexpr int BATCH = 8; const bf16* gbuf; const bf16* min_; bf16* mout; int first; float scale;
    struct Pre { v4u g, m; };
    __device__ __forceinline__ void begin_col(const Unit&, int) {}
    __device__ __forceinline__ Pre pre(const Unit&, int row, int col) const { Pre r; const unsigned off = (unsigned)row * 1024 + col; r.g = *(const v4u*)(gbuf + off); if (!first) r.m = *(const v4u*)(min_ + off); else r.m = (v4u){0u, 0u, 0u, 0u}; return r; }
    __device__ __forceinline__ void tile8(const Unit&, int row, int col, const f32x4 v0, const f32x4 v1, const Pre& pr) const {
        float a[8], g[8], mprev[8], o[8]; f4x2_to8(v0, v1, a); const unsigned off = (unsigned)row * 1024 + col; bf16x8_to_f32(pr.g, g); bf16x8_to_f32(pr.m, mprev);
#pragma unroll
        for (int j = 0; j < 8; ++j) o[j] = mprev[j] + g[j] * a[j] * scale;
        *(v4u*)(mout + off) = f32_to_bf16x8(o);
    }
};
struct FResid {
    static constexpr int BATCH = 8; const float* xin; float* xout;
    struct Pre { f32x4 a, b; };
    __device__ __forceinline__ void begin_col(const Unit&, int) {}
    __device__ __forceinline__ Pre pre(const Unit&, int row, int col) const { Pre r; const unsigned off = (unsigned)row * 1024 + col; r.a = *(const f32x4*)(xin + off); r.b = *(const f32x4*)(xin + off + 4); return r; }
    __device__ __forceinline__ void tile8(const Unit&, int row, int col, const f32x4 v0, const f32x4 v1, const Pre& pr) const {
        const unsigned off = (unsigned)row * 1024 + col;
        *(f32x4*)(xout + off) = pr.a * ALPHA + v0; *(f32x4*)(xout + off + 4) = pr.b * ALPHA + v1;
    }
};
struct FSwiglu {
    bf16* h; int ldh;
    __device__ __forceinline__ void pair8(const Unit&, int row, int colh, const f32x4 g0, const f32x4 g1, const f32x4 u0, const f32x4 u1) const {
        float g[8], uu[8], o[8]; f4x2_to8(g0, g1, g); f4x2_to8(u0, u1, uu);
#pragma unroll
        for (int j = 0; j < 8; ++j) o[j] = g[j] * sigm(g[j]) * uu[j];
        *(v4u*)(h + (unsigned)row * ldh + colh) = f32_to_bf16x8(o);
    }
};
struct FMoeDown {
    static constexpr int BATCH = 8; bf16* ypair; const float* slotw; const unsigned* cnt;
    struct Pre { float w; };
    __device__ __forceinline__ void begin_col(const Unit&, int) {}
    __device__ __forceinline__ Pre pre(const Unit& u, int row, int) const { Pre r; const int rk = u.aux + (row - u.pm * 256); r.w = ((unsigned)rk < cnt[u.z]) ? slotw[(unsigned)(u.z * MOE_CAP + rk)] : 0.f; return r; }
    __device__ __forceinline__ void tile8(const Unit& u, int row, int col, const f32x4 v0, const f32x4 v1, const Pre& pr) const {
        const int rk = u.aux + (row - u.pm * 256);
        if ((unsigned)rk < cnt[u.z]) *(v4u*)(ypair + (unsigned)row * 1024 + col) = pack8(v0 * pr.w, v1 * pr.w);
    }
};

struct MoeOrder {
    int nN, G, c; int pt[NEXP + 1];
    __device__ void init(const unsigned* cnt, int nN_, int G_, int c_) { nN = nN_; G = G_; c = c_; pt[0] = 0;
#pragma unroll
        for (int e = 0; e < NEXP; ++e) pt[e + 1] = pt[e] + (int)((cnt[e] + 255u) >> 8); }
    __device__ bool next(int i, Unit& u) const {
        const long L = (long)i * G + c; if (L >= (long)pt[NEXP] * nN) return false;
        const int tile = (int)(L / nN); u.pn = (int)(L % nN); int e = 0;
#pragma unroll
        for (int k = 1; k < NEXP; ++k) e += (tile >= pt[k]) ? 1 : 0;
        int base = 0;
#pragma unroll
        for (int k = 1; k < NEXP; ++k) base = (tile >= pt[k]) ? pt[k] : base;
        u.z = e; u.pm = tile; u.aux = (tile - base) * 256; return true;
    }
};
struct LocMoe1 {
    static constexpr bool GATHER = true;
    const bf16* A; const bf16* Bt; int lda, ldb, K; const int* slot_tok; const unsigned* cnt;
    __device__ __forceinline__ const char* a_ptr(const Unit&) const { return (const char*)A; }
    __device__ __forceinline__ const char* b_ptr(const Unit& u) const { return (const char*)(Bt + (size_t)u.z * (2 * EXD) * DM + (size_t)u.pn * 256 * ldb); }
    __device__ __forceinline__ void a_off(const Unit& u, int tid, unsigned (&v)[2][2]) const {
        const unsigned n = cnt[u.z];
#pragma unroll
        for (int i = 0; i < 2; ++i) { int R, C; pg8::stage_rc(tid * 16 + i * 8192, R, C);
#pragma unroll
            for (int h = 0; h < 2; ++h) { const int r = u.aux + h * 128 + R; const int tok = ((unsigned)r < n) ? slot_tok[(unsigned)(u.z * MOE_CAP + r)] : 0; v[h][i] = (unsigned)(tok * lda + C) * 2u; } }
    }
};
__device__ __forceinline__ int qperm_row(int n) { const int h = n / 96, d = n - h * 96; if (d < 64) return n; const int e = d - 64; return h * 96 + 64 + ((e < 16) ? 2 * e : 2 * (e - 16) + 1); }
template <bool QPERM>
__device__ __forceinline__ void tr_item(const float* W, int ldw, int k0, int n0, const float* ksc, bf16* WT, int ldd, int kd0, int drow0, LAS float* scr, int lane) {
    if (W) {
#pragma unroll 8
        for (int i = 0; i < 32; ++i) { const int kk = 2 * i + (lane >> 5); float v = W[(size_t)(k0 + kk) * ldw + n0 + (lane & 31)]; if (ksc) v *= ksc[k0 + kk]; scr[kk * 33 + (lane & 31)] = v; }
    } else {
#pragma unroll 8
        for (int i = 0; i < 32; ++i) { const int kk = 2 * i + (lane >> 5); scr[kk * 33 + (lane & 31)] = 0.f; }
    }
    LDS_WAIT(); asm volatile("" ::: "memory");
    const int c = lane & 7;
#pragma unroll
    for (int j = 0; j < 4; ++j) { const int n = (lane >> 3) + 8 * j; const LAS float* s = scr + (8 * c) * 33 + n;
        v4u o; o.x = cvt_pk_bf16(s[0 * 33], s[1 * 33]); o.y = cvt_pk_bf16(s[2 * 33], s[3 * 33]); o.z = cvt_pk_bf16(s[4 * 33], s[5 * 33]); o.w = cvt_pk_bf16(s[6 * 33], s[7 * 33]);
        const int dr = QPERM ? qperm_row(n0 + n) : (drow0 + n);
        *(v4u*)(WT + (size_t)dr * ldd + kd0 + k0 + 8 * c) = o; }
    LDS_WAIT(); asm volatile("" ::: "memory");
}
#define TRJOB(r, W, ldw, K, c0, ncols, ksc, WT, ldd, drow0) { const int _nb = (ncols) / 32, _ni = ((K) / 64) * _nb; if ((r) < _ni) { const int _kb = (r) / _nb, _nbi = (r) % _nb; \
    tr_item<false>((W), (ldw), 64 * _kb, (c0) + 32 * _nbi, (ksc), (WT), (ldd), 0, (drow0) + 32 * _nbi, scr, lane); continue; } (r) -= _ni; }
#define TRJOB_GU(r, W, ldw, K, ncols, WT, ldd, up) { const int _nb = (ncols) / 32, _ni = ((K) / 64) * _nb; if ((r) < _ni) { const int _kb = (r) / _nb, _n0 = 32 * ((r) % _nb); \
    tr_item<false>((W), (ldw), 64 * _kb, _n0, nullptr, (WT), (ldd), 0, (_n0 >> 7) * 256 + (_n0 & 127) + ((up) ? 128 : 0), scr, lane); continue; } (r) -= _ni; }


__device__ __forceinline__ void p0_prologue(Frame& F) {
    LAS float* scr = (LAS float*)(F.lds + F.wave * 16384);
    const int lane = F.lane; const int gw = F.blk * NWAVES + F.wave, NGW = F.G * NWAVES;
    constexpr int PER_LAYER = 16 * 189 + 6 * 24 + 4 * 32 + 192 + 8 * 16 + 3 * 8 * 32 + 16 * 32 + 3 * 16;
    for (int it = gw; it < NLAYER * PER_LAYER; it += NGW) {
        const int l = it / PER_LAYER; int r = it % PER_LAYER;
        const float* win = INP(float, 2) + (size_t)l * DM * IN_W;
        bf16* win_t = WSP(bf16, WS_WIN) + (size_t)l * 3072 * DM; bf16* wg_t = WSP(bf16, WS_WG) + (size_t)l * 3072 * DM;
        TRJOB(r, win, IN_W, DM, 0, 672, nullptr, win_t, DM, 0);
        TRJOB(r, win, IN_W, DM, 672, 2304, nullptr, win_t, DM, 768);
        TRJOB(r, win, IN_W, DM, 2976, 3072, nullptr, wg_t, DM, 0);
        if (r < 48) { tr_item<false>(nullptr, 0, 64 * (r / 3), 0, nullptr, win_t, DM, 0, 672 + 32 * (r % 3), scr, lane); continue; } r -= 48;
        if (r < 144) { const int kb = r / 24, nbi = r % 24; tr_item<true>(INP(float, 4) + (size_t)l * 384 * 768, 768, 64 * kb, 32 * nbi, INP(float, 3) + l * 384, WSP(bf16, WS_WUQ) + (size_t)l * 768 * 384, 384, 0, 0, scr, lane); continue; } r -= 144;
        TRJOB(r, INP(float, 6) + (size_t)l * 256 * 1024, 1024, 256, 0, 1024, INP(float, 5) + l * 256, WSP(bf16, WS_WUKV) + (size_t)l * 1024 * 256, 256, 0);
        if (r < 192) { const int rb = r / 4, kb = r % 4; bf16* wl = WSP(bf16, WS_WLORA) + (size_t)l * 1536 * 256; const float* src = nullptr; int ldw = 512, k0 = 0, n0 = 0;
            if (rb < 16) { if (kb == 0) { src = INP(float, 9) + (size_t)l * 64 * 512; n0 = 32 * rb; } }
            else if (rb < 32) { if (kb == 1) { src = INP(float, 11) + (size_t)l * 64 * 512; n0 = 32 * (rb - 16); } }
            else { if (kb >= 2) { src = INP(float, 12) + (size_t)l * 128 * 512; k0 = 64 * (kb - 2); n0 = 32 * (rb - 32); } }
            tr_item<false>(src, ldw, k0, n0, nullptr, wl, 256, 64 * kb - k0, 32 * rb, scr, lane); continue; } r -= 192;
        TRJOB(r, INP(float, 29) + (size_t)l * 512 * 512, 512, 512, 0, 512, nullptr, WSP(bf16, WS_WGLU) + (size_t)l * 512 * 512, 512, 0);
        TRJOB(r, INP(float, 31) + (size_t)(l * 3 + 0) * 512 * 1024, 1024, 512, 0, 1024, nullptr, WSP(bf16, WS_WBR) + (size_t)(l * 3 + 0) * 1024 * 512, 512, 0);
        TRJOB(r, INP(float, 31) + (size_t)(l * 3 + 1) * 512 * 1024, 1024, 512, 0, 1024, nullptr, WSP(bf16, WS_WBR) + (size_t)(l * 3 + 1) * 1024 * 512, 512, 0);
        TRJOB(r, INP(float, 31) + (size_t)(l * 3 + 2) * 512 * 1024, 1024, 512, 0, 1024, nullptr, WSP(bf16, WS_WBR) + (size_t)(l * 3 + 2) * 1024 * 512, 512, 0);
        TRJOB(r, INP(float, 32) + (size_t)l * DM * DM, DM, DM, 0, DM, nullptr, WSP(bf16, WS_WOUT) + (size_t)l * DM * DM, DM, 0);
    }
    constexpr int PER_FFN = 3 * 16 * 88;
    for (int it = gw; it < 2 * PER_FFN; it += NGW) {
        const int i = it / PER_FFN; int r = it % PER_FFN;
        TRJOB_GU(r, INP(float, 37) + (size_t)i * DM * FFN, FFN, DM, FFN, WSP(bf16, WS_WFGU) + (size_t)i * 2 * FFN * DM, DM, 0);
        TRJOB_GU(r, INP(float, 38) + (size_t)i * DM * FFN, FFN, DM, FFN, WSP(bf16, WS_WFGU) + (size_t)i * 2 * FFN * DM, DM, 1);
        TRJOB(r, INP(float, 39) + (size_t)i * FFN * DM, DM, FFN, 0, DM, nullptr, WSP(bf16, WS_WFD) + (size_t)i * DM * FFN, FFN, 0);
    }
    for (int it = F.blk * 512 + F.tid; it < 3 * 512 * 64; it += F.G * 512) {
        const int i = it / (512 * 64), rem = it % (512 * 64), n = rem >> 6, k0 = (rem & 63) * 8;
        const float* vd = INP(float, 18) + (size_t)i * 512 * 32; const float* vu = INP(float, 19) + (size_t)i * 32 * 512; float o[8];
#pragma unroll
        for (int j = 0; j < 8; ++j) o[j] = 0.f;
        for (int rr = 0; rr < 32; ++rr) { const float u = vu[rr * 512 + n];
#pragma unroll
            for (int j = 0; j < 8; ++j) o[j] += vd[(k0 + j) * 32 + rr] * u; }
        *(v4u*)(WSP(bf16, WS_WVRES) + (size_t)i * 512 * 512 + (size_t)n * 512 + k0) = f32_to_bf16x8(o);
    }
    for (int it = F.blk * 512 + F.tid; it < M * 16; it += F.G * 512) {
        const int m = it >> 4, i = it & 15; const float inv = powf(10000.0f, -(float)i * (1.0f / 16.0f)); const float ang = (float)INP(int, 1)[m] * inv;
        float sn, cn; sincosf(ang, &sn, &cn); float* cs = WSP(float, WS_ROPE) + (size_t)m * 32; cs[i] = cn; cs[16 + i] = sn;
    }
}
__device__ __forceinline__ void moe_convert(Frame& F, int li) {
    LAS float* scr = (LAS float*)(F.lds + F.wave * 16384);
    const int lane = F.lane; const int gw = F.blk * NWAVES + F.wave, NGW = F.G * NWAVES;
    constexpr int PER_E = 2 * 16 * 112 + 56 * 32;
    for (int it = gw; it < NEXP * PER_E; it += NGW) {
        const int e = it / PER_E; int r = it % PER_E; const size_t wi = (size_t)(li * NEXP + e);
        TRJOB_GU(r, INP(float, 41) + wi * DM * EXD, EXD, DM, EXD, WSP(bf16, WS_WMGU) + (size_t)e * 2 * EXD * DM, DM, 0);
        TRJOB_GU(r, INP(float, 42) + wi * DM * EXD, EXD, DM, EXD, WSP(bf16, WS_WMGU) + (size_t)e * 2 * EXD * DM, DM, 1);
        TRJOB(r, INP(float, 43) + wi * EXD * DM, DM, EXD, 0, DM, nullptr, WSP(bf16, WS_WMD) + (size_t)e * DM * EXD, EXD, 0);
    }
}

__device__ __forceinline__ void ph2_prep(Frame& F, int l) {
    const int lane = F.lane; const int gw = F.blk * NWAVES + F.wave, NGW = F.G * NWAVES;
    const bf16* rwraw = WSP(bf16, WS_RWRAW); const bf16* mlaraw = WSP(bf16, WS_MLARAW);
    const float* mu = INP(float, 7) + l * 1792; const float* k_k = INP(float, 13) + l * 512;
    float mu_r[8], mu_k[8], mu_v[8], mu_t[8], kk8[8];
    ld8f(mu + 8 * lane, mu_r); ld8f(mu + 512 + 8 * lane, mu_k); ld8f(mu + 1024 + 8 * lane, mu_v); ld8f(mu + 1536 + 8 * (lane & 31), mu_t); ld8f(k_k + 8 * lane, kk8);
    const float* cs_all = WSP(float, WS_ROPE);
    for (int m = gw; m < M; m += NGW) {
        const int s = m & (SEQ - 1);
        const bf16* cur = rwraw + (size_t)m * 1792; const bf16* prv = cur - 1792;
        float c[8], p[8], o[8];
        bf16x8_to_f32(*(const v4u*)(cur + 8 * lane), c); if (s) bf16x8_to_f32(*(const v4u*)(prv + 8 * lane), p); else {
#pragma unroll
            for (int j = 0; j < 8; ++j) p[j] = 0.f; }
#pragma unroll
        for (int j = 0; j < 8; ++j) o[j] = c[j] + (p[j] - c[j]) * mu_r[j];
        *(f16x8*)(WSP(f16, WS_R) + (size_t)m * 512 + 8 * lane) = f32_to_f16x8(o);
        bf16x8_to_f32(*(const v4u*)(cur + 512 + 8 * lane), c); if (s) bf16x8_to_f32(*(const v4u*)(prv + 512 + 8 * lane), p);
        float ss = 0.f;
#pragma unroll
        for (int j = 0; j < 8; ++j) { o[j] = c[j] + (p[j] - c[j]) * mu_k[j]; const float q = o[j] * kk8[j]; ss += q * q; }
        *(f16x8*)(WSP(f16, WS_KH) + (size_t)m * 512 + 8 * lane) = f32_to_f16x8(o);
        ss += __shfl_xor(ss, 1); ss += __shfl_xor(ss, 2); ss += __shfl_xor(ss, 4);
        { const float rn = 1.0f / fmaxf(sqrtf(ss), 1e-12f);
#pragma unroll
          for (int j = 0; j < 8; ++j) o[j] = o[j] * kk8[j] * rn; }
        *(f16x8*)(WSP(f16, WS_KKN) + (size_t)m * 512 + 8 * lane) = f32_to_f16x8(o);
        bf16x8_to_f32(*(const v4u*)(cur + 1024 + 8 * lane), c); if (s) bf16x8_to_f32(*(const v4u*)(prv + 1024 + 8 * lane), p);
#pragma unroll
        for (int j = 0; j < 8; ++j) o[j] = c[j] + (p[j] - c[j]) * mu_v[j];
        { const v4u vb = f32_to_bf16x8(o); *(v4u*)(WSP(bf16, WS_VRAW) + (size_t)m * 512 + 8 * lane) = vb;
          if (l == 0) { *(v4u*)(WSP(bf16, WS_VFIRST) + (size_t)m * 512 + 8 * lane) = vb; *(f16x8*)(WSP(f16, WS_VFIN) + (size_t)m * 512 + 8 * lane) = f32_to_f16x8(o); } }
        if (lane < 32) {
            bf16x8_to_f32(*(const v4u*)(cur + 1536 + 8 * lane), c); if (s) bf16x8_to_f32(*(const v4u*)(prv + 1536 + 8 * lane), p);
#pragma unroll
            for (int j = 0; j < 8; ++j) { float v = c[j] + (p[j] - c[j]) * mu_t[j]; if (lane < 8) v = 1.0f - 2.0f * __builtin_amdgcn_rcpf(__expf(2.0f * v) + 1.0f); else if (lane >= 16) v = sigm(v); o[j] = v; }
            *(v4u*)(WSP(bf16, WS_LORAIN) + (size_t)m * 256 + 8 * lane) = f32_to_bf16x8(o);
        }
        const bf16* mr = mlaraw + (size_t)m * 768; float a8[8], b8[8];
        bf16x8_to_f32(*(const v4u*)(mr + 8 * lane), a8); float ssa = 0.f, ssb = 0.f;
#pragma unroll
        for (int j = 0; j < 8; ++j) ssa += a8[j] * a8[j];
        if (lane < 32) { bf16x8_to_f32(*(const v4u*)(mr + 512 + 8 * lane), b8);
#pragma unroll
            for (int j = 0; j < 8; ++j) ssb += b8[j] * b8[j]; } else {
#pragma unroll
            for (int j = 0; j < 8; ++j) b8[j] = 0.f; }
        const float sq = wave_sum(lane < 48 ? ssa : 0.f), skv = wave_sum((lane >= 48 ? ssa : 0.f) + (lane < 16 ? ssb : 0.f));
        const float rq = 1.0f / sqrtf(sq * (1.0f / 384.0f) + 1e-6f), rkv = 1.0f / sqrtf(skv * (1.0f / 256.0f) + 1e-6f);
        if (lane < 48) {
#pragma unroll
            for (int j = 0; j < 8; ++j) o[j] = a8[j] * rq;
            *(v4u*)(WSP(bf16, WS_CQN) + (size_t)m * 384 + 8 * lane) = f32_to_bf16x8(o);
        } else {
#pragma unroll
            for (int j = 0; j < 8; ++j) o[j] = a8[j] * rkv;
            *(v4u*)(WSP(bf16, WS_CKVN) + (size_t)m * 256 + 8 * (lane - 48)) = f32_to_bf16x8(o);
        }
        if (lane < 16) {
#pragma unroll
            for (int j = 0; j < 8; ++j) o[j] = b8[j] * rkv;
            *(v4u*)(WSP(bf16, WS_CKVN) + (size_t)m * 256 + 128 + 8 * lane) = f32_to_bf16x8(o);
        }
        float pr[8];
#pragma unroll
        for (int j = 0; j < 8; ++j) pr[j] = __shfl_xor(b8[j], 2);
        if (lane >= 16 && lane < 20) { const int i0 = 8 * (lane & 1); const float* cs = cs_all + (size_t)m * 32; float cc[8], sn[8]; ld8f(cs + i0, cc); ld8f(cs + 16 + i0, sn);
            const bool lo = lane < 18;
#pragma unroll
            for (int j = 0; j < 8; ++j) o[j] = lo ? (b8[j] * cc[j] - pr[j] * sn[j]) : (pr[j] * sn[j] + b8[j] * cc[j]);
            const v4u w = f32_to_bf16x8(o); bf16* kd = WSP(bf16, WS_K) + (size_t)m * 768 + 64 + (lo ? 0 : 16) + i0;
#pragma unroll
            for (int h = 0; h < NH; ++h) *(v4u*)(kd + h * 96) = w; }
    }
    if (F.blk < 256) {
        __syncthreads();
        const int g = F.blk >> 3, s8 = F.blk & 7, tid = F.tid;
        LAS float* pw = (LAS float*)F.lds;
        LAS float* Bb = pw + 33 * 64 * 2;
        LAS float* Cc = Bb + 64 * 16 * 2;
        LAS float* Kt = Cc + 16 * 64 * 2;
        const float dt = expf(INP(float, 23)[l * 32 + g]);
        const float* are = INP(float, 21) + (size_t)(l * 32 + g) * 64; const float* aim = INP(float, 22) + (size_t)(l * 32 + g) * 64;
        for (int e = tid; e < 33 * 64; e += 512) { const int n = e >> 6, p = e & 63; const float lr = fminf(are[p], -1e-4f), li = aim[p];
            const float mag = expf((float)n * (dt * lr)); float sn, cn; sincosf((float)n * (dt * li), &sn, &cn); pw[2 * e] = mag * cn; pw[2 * e + 1] = mag * sn; }
        for (int e = tid; e < 64 * 16; e += 512) { const int p = e >> 4; const float lr = fminf(are[p], -1e-4f), li = aim[p];
            const float mag = expf(dt * lr); float sn, cn; sincosf(dt * li, &sn, &cn); const float abr = mag * cn, abi = mag * sn, den = lr * lr + li * li;
            const float fr = ((abr - 1.0f) * lr + abi * li) / den, fi = (abi * lr - (abr - 1.0f) * li) / den;
            const float br = INP(float, 24)[(size_t)(l * 32 + g) * 1024 + e], bi = INP(float, 25)[(size_t)(l * 32 + g) * 1024 + e];
            Bb[2 * e] = fr * br - fi * bi; Bb[2 * e + 1] = fr * bi + fi * br; }
        for (int e = tid; e < 16 * 64; e += 512) { Cc[2 * e] = INP(float, 26)[(size_t)(l * 32 + g) * 1024 + e]; Cc[2 * e + 1] = INP(float, 27)[(size_t)(l * 32 + g) * 1024 + e]; }
        __syncthreads();
        { const int tau = tid >> 4, o = tid & 15; float acc[16];
#pragma unroll
          for (int i = 0; i < 16; ++i) acc[i] = 0.f;
          for (int p = 0; p < 64; ++p) { const float cr = Cc[2 * (o * 64 + p)], ci = Cc[2 * (o * 64 + p) + 1], pr_ = pw[2 * (tau * 64 + p)], pi_ = pw[2 * (tau * 64 + p) + 1];
              const float xr = cr * pr_ - ci * pi_, xi = cr * pi_ + ci * pr_;
#pragma unroll
              for (int i = 0; i < 16; ++i) acc[i] += xr * Bb[2 * (p * 16 + i)] - xi * Bb[2 * (p * 16 + i) + 1]; }
#pragma unroll
          for (int i = 0; i < 16; ++i) Kt[(tau * 16 + o) * 16 + i] = acc[i]; }
        __syncthreads();
        bf16* bm = WSP(bf16, WS_S5MAIN) + (size_t)g * 512 * S5K;
        for (int e = tid; e < 64 * 80; e += 512) { const int n = 64 * s8 + e / 80, k0 = (e % 80) * 8, t = n >> 4, o = n & 15; float v[8];
            if (k0 < 512) { const int sidx = k0 >> 4, i0 = k0 & 15;
#pragma unroll
                for (int j = 0; j < 8; ++j) v[j] = (sidx <= t) ? Kt[((t - sidx) * 16 + o) * 16 + i0 + j] : 0.f; }
            else {
#pragma unroll
                for (int j = 0; j < 8; ++j) { const int q = k0 - 512 + j, p = q & 63; const float cr = Cc[2 * (o * 64 + p)], ci = Cc[2 * (o * 64 + p) + 1], pr_ = pw[2 * ((t + 1) * 64 + p)], pi_ = pw[2 * ((t + 1) * 64 + p) + 1];
                    v[j] = (q < 64) ? (cr * pr_ - ci * pi_) : -(cr * pi_ + ci * pr_); } }
            *(v4u*)(bm + (size_t)n * S5K + k0) = f32_to_bf16x8(v); }
        bf16* be = WSP(bf16, WS_S5END) + (size_t)g * 256 * 512;
        for (int e = tid; e < 32 * 64; e += 512) { const int n = 32 * s8 + e / 64, k0 = (e % 64) * 8, sidx = k0 >> 4, i0 = k0 & 15; float v[8];
            if (n < 128) { const int p = n & 63; const float pr_ = pw[2 * ((31 - sidx) * 64 + p)], pi_ = pw[2 * ((31 - sidx) * 64 + p) + 1];
#pragma unroll
                for (int j = 0; j < 8; ++j) { const float br = Bb[2 * (p * 16 + i0 + j)], bi = Bb[2 * (p * 16 + i0 + j) + 1]; v[j] = (n < 64) ? (pr_ * br - pi_ * bi) : (pr_ * bi + pi_ * br); } }
            else {
#pragma unroll
                for (int j = 0; j < 8; ++j) v[j] = 0.f; }
            *(v4u*)(be + (size_t)n * 512 + k0) = f32_to_bf16x8(v); }
        if (s8 == 0 && tid < 64) { float* a32 = WSP(float, WS_S5A32) + (size_t)(g * 64 + tid) * 2; a32[0] = pw[2 * (32 * 64 + tid)]; a32[1] = pw[2 * (32 * 64 + tid) + 1]; }
        __syncthreads();
    }
}

__device__ __forceinline__ void ln_core(f32x4 (&v)[4], const float* gam, const float* bet, int lane) {
    float s = 0.f;
#pragma unroll
    for (int j = 0; j < 4; ++j) s += (v[j][0] + v[j][1]) + (v[j][2] + v[j][3]);
    const float mean = wave_sum(s) * (1.f / DM); float s2 = 0.f;
#pragma unroll
    for (int j = 0; j < 4; ++j) { v[j] = v[j] - mean; s2 += (v[j][0] * v[j][0] + v[j][1] * v[j][1]) + (v[j][2] * v[j][2] + v[j][3] * v[j][3]); }
    const float rstd = 1.f / sqrtf(wave_sum(s2) * (1.f / DM) + LN_EPS);
#pragma unroll
    for (int j = 0; j < 4; ++j) { const f32x4 g4 = *(const f32x4*)(gam + 4 * lane + 256 * j), b4 = *(const f32x4*)(bet + 4 * lane + 256 * j); v[j] = v[j] * rstd * g4 + b4; }
}
__device__ __forceinline__ void ln_store(const f32x4 (&v)[4], float* xrow, bf16* xbrow, int lane) {
#pragma unroll
    for (int j = 0; j < 4; ++j) { *(f32x4*)(xrow + 4 * lane + 256 * j) = v[j]; v2u w; w.x = cvt_pk_bf16(v[j][0], v[j][1]); w.y = cvt_pk_bf16(v[j][2], v[j][3]); *(v2u*)(xbrow + 4 * lane + 256 * j) = w; }
}
__device__ __forceinline__ void ln_phase(Frame& F, const float* gam, const float* bet) {
    const int lane = F.lane; const int gw = F.blk * NWAVES + F.wave, NGW = F.G * NWAVES; float* X = F.out; bf16* Xb = WSP(bf16, WS_XB);
    for (int m = gw; m < M; m += NGW) { f32x4 v[4];
#pragma unroll
        for (int j = 0; j < 4; ++j) v[j] = *(const f32x4*)(X + (size_t)m * DM + 4 * lane + 256 * j);
        ln_core(v, gam, bet, lane); ln_store(v, X + (size_t)m * DM, Xb + (size_t)m * DM, lane); }
}
__device__ __forceinline__ void ln2_moe_phase(Frame& F, const float* gam, const float* bet, int li) {
    const int lane = F.lane; const int gw = F.blk * NWAVES + F.wave, NGW = F.G * NWAVES; float* X = F.out; bf16* Xb = WSP(bf16, WS_XB);
    const unsigned* cnt = (const unsigned*)(F.ctl + CW_MOECNT + 64 * li); int pstart[NEXP]; { int acc = 0;
#pragma unroll
        for (int e = 0; e < NEXP; ++e) { pstart[e] = acc; acc += (int)(((cnt[e] + 255u) >> 8) << 8); } }
    const int* ppos = WSP(int, WS_PAIRPOS); const bf16* yp = WSP(bf16, WS_YPAIR);
    for (int m = gw; m < M; m += NGW) { f32x4 v[4];
        const int p0 = ppos[2 * m], p1 = ppos[2 * m + 1]; int r0 = 0, r1 = 0;
#pragma unroll
        for (int e = 0; e < NEXP; ++e) { if ((p0 >> 24) == e) r0 = pstart[e] + (p0 & 0xffffff); if ((p1 >> 24) == e) r1 = pstart[e] + (p1 & 0xffffff); }
#pragma unroll
        for (int j = 0; j < 4; ++j) { const f32x4 x = *(const f32x4*)(X + (size_t)m * DM + 4 * lane + 256 * j);
            const v2u a = *(const v2u*)(yp + (size_t)r0 * DM + 4 * lane + 256 * j), b = *(const v2u*)(yp + (size_t)r1 * DM + 4 * lane + 256 * j);
            v[j] = x * ALPHA + (f32x4){bf_lo(a.x) + bf_lo(b.x), bf_hi(a.x) + bf_hi(b.x), bf_lo(a.y) + bf_lo(b.y), bf_hi(a.y) + bf_hi(b.y)}; }
        ln_core(v, gam, bet, lane); ln_store(v, X + (size_t)m * DM, Xb + (size_t)m * DM, lane); }
}
__device__ __forceinline__ void ln1_moe_phase(Frame& F, const float* gam, const float* bet, int li) {
    const int lane = F.lane; float* X = F.out; bf16* Xb = WSP(bf16, WS_XB);
    LAS int* pe = (LAS int*)F.lds;
    LAS float* pwt = (LAS float*)(F.lds + 1024);
    LAS int* cntl = (LAS int*)(F.lds + 2048);
    const float* router = INP(float, 40) + (size_t)li * DM * NEXP;
    for (int blk0 = F.blk; blk0 * 128 < M; blk0 += F.G) {
        __syncthreads();
        for (int i = 0; i < 16; ++i) { const int tl = F.wave * 16 + i, m = blk0 * 128 + tl; f32x4 v[4];
#pragma unroll
            for (int j = 0; j < 4; ++j) v[j] = *(const f32x4*)(X + (size_t)m * DM + 4 * lane + 256 * j);
            ln_core(v, gam, bet, lane); ln_store(v, X + (size_t)m * DM, Xb + (size_t)m * DM, lane);
            float lg[NEXP];
#pragma unroll
            for (int e = 0; e < NEXP; ++e) lg[e] = 0.f;
#pragma unroll
            for (int j = 0; j < 4; ++j)
#pragma unroll
                for (int q = 0; q < 4; ++q) { const float xv = v[j][q]; const float* rr = router + (size_t)(4 * lane + 256 * j + q) * NEXP; const f32x4 ra = *(const f32x4*)rr, rb = *(const f32x4*)(rr + 4);
                    lg[0] += xv * ra[0]; lg[1] += xv * ra[1]; lg[2] += xv * ra[2]; lg[3] += xv * ra[3]; lg[4] += xv * rb[0]; lg[5] += xv * rb[1]; lg[6] += xv * rb[2]; lg[7] += xv * rb[3]; }
#pragma unroll
            for (int e = 0; e < NEXP; ++e) lg[e] = wave_sum(lg[e]);
            int e0 = 0; float l0 = lg[0];
#pragma unroll
            for (int e = 1; e < NEXP; ++e) if (lg[e] > l0) { l0 = lg[e]; e0 = e; }
            int e1 = -1; float l1 = -INFINITY;
#pragma unroll
            for (int e = 0; e < NEXP; ++e) if (e != e0 && lg[e] > l1) { l1 = lg[e]; e1 = e; }
            const float w1 = 1.0f / (1.0f + expf(l0 - l1)), w0 = 1.0f - w1;
            if (lane == 0) { pe[2 * tl] = e0; pe[2 * tl + 1] = e1; pwt[2 * tl] = w0; pwt[2 * tl + 1] = w1; }
        }
        __syncthreads();
        int myrank = 0, mye = 0;
        if (F.tid < 256) { mye = pe[F.tid]; for (int q = 0; q < F.tid; ++q) myrank += (pe[q] == mye) ? 1 : 0; }
#ifdef PROBE_ORDERED
        if (F.tid == 0) { unsigned sp = 0; while (__hip_atomic_load((unsigned*)(F.ctl + CW_MOECNT + 64 * li + 32), RLX_AGENT) != (unsigned)blk0 && ++sp < (1u << 22)) __builtin_amdgcn_s_sleep(2); }
        __syncthreads();
#endif
        if (F.tid < NEXP) { int c = 0; for (int q = 0; q < 256; ++q) c += (pe[q] == F.tid) ? 1 : 0; cntl[F.tid] = c;
            cntl[8 + F.tid] = (int)__hip_atomic_fetch_add((unsigned*)(F.ctl + CW_MOECNT + 64 * li + F.tid), (unsigned)c, RLX_AGENT); }
#ifdef PROBE_ORDERED
        __syncthreads();
        if (F.tid == 0) { asm volatile("s_waitcnt vmcnt(0)" ::: "memory"); __hip_atomic_fetch_add((unsigned*)(F.ctl + CW_MOECNT + 64 * li + 32), 1u, RLX_AGENT); }
#endif
        __syncthreads();
        if (F.tid < 256) { const int rk = cntl[8 + mye] + myrank; const int m = blk0 * 128 + (F.tid >> 1);
            WSP(int, WS_SLOTTOK)[(size_t)mye * MOE_CAP + rk] = m; WSP(float, WS_SLOTW)[(size_t)mye * MOE_CAP + rk] = pwt[F.tid]; WSP(int, WS_PAIRPOS)[blk0 * 256 + F.tid] = (mye << 24) | rk; }
    }
    __syncthreads();
}
constexpr int AT_KS = 208, AT_VS = 192;
constexpr int AT_KB = 64 * AT_KS, AT_VB = 64 * AT_VS, AT_STAGE = AT_KB + AT_VB;
constexpr int AT_WSF = 2 * AT_STAGE, AT_OST = AT_WSF + NWAVES * 256, AT_LDS = AT_OST + NWAVES * 4096;
__device__ __forceinline__ int crow(int r, int hi) { return (r & 3) + 8 * (r >> 2) + 4 * hi; }

__device__ __forceinline__ void attn_unit(int tid, int b, int h, int qb, const bf16* Q, const bf16* K, const bf16* V, bf16* O, LAS unsigned char* lds) {
    const int lane = tid & 63, r32 = lane & 31, hi = lane >> 5; const int wid = __builtin_amdgcn_readfirstlane(tid >> 6);
    const size_t rowbase = (size_t)b * SEQ; const int q0 = qb * 256;
    bf16x8 qr[6];
    { const bf16* qp = Q + (rowbase + q0 + wid * 32 + r32) * 768 + h * 96 + hi * 8;
#pragma unroll
      for (int d0 = 0; d0 < 6; ++d0) qr[d0] = *(const bf16x8*)(qp + d0 * 16); }
    const int kp0 = tid, kp1 = 512 + tid;
    const bf16* kg0 = K + (rowbase + kp0 / 12) * 768 + h * 96 + (kp0 % 12) * 8;
    const bf16* kg1 = K + (rowbase + kp1 / 12) * 768 + h * 96 + (kp1 % 12) * 8;
    const bf16* vg = V + (rowbase + (tid >> 3)) * 512 + h * 64 + (tid & 7) * 8;
    const int kl0 = (kp0 / 12) * AT_KS + (kp0 % 12) * 16, kl1 = (kp1 / 12) * AT_KS + (kp1 % 12) * 16, vl = (tid >> 3) * AT_VS + (tid & 7) * 16;
    const bool two = tid < 256;
    const int NT = 4 * (qb + 1);
    v4u ka, kb2, va;
    ka = *(const v4u*)kg0; if (two) kb2 = *(const v4u*)kg1; va = *(const v4u*)vg;
    *(LAS v4u*)(lds + kl0) = ka; if (two) *(LAS v4u*)(lds + kl1) = kb2; *(LAS v4u*)(lds + AT_KB + vl) = va;
    LAS float* wsf = (LAS float*)(lds + AT_WSF) + wid * 64;
    float m_run = -1e30f, l_run = 0.f; f32x16 o[2];
#pragma unroll
    for (int r = 0; r < 16; ++r) { o[0][r] = 0.f; o[1][r] = 0.f; }
    const int kfo = r32 * AT_KS + hi * 16;
    const int vfo = (4 * hi + ((lane & 15) >> 2)) * AT_VS + ((lane >> 4) & 1) * 32 + (lane & 3) * 8;
    const int qrel = wid * 32 + r32;
    __syncthreads();
    for (int t = 0; t < NT; ++t) {
        const int cur = (t & 1) * AT_STAGE, nxt = ((t + 1) & 1) * AT_STAGE; const bool more = (t + 1 < NT);
        if (more) { const size_t go = (size_t)(t + 1) * 64 * 768; ka = *(const v4u*)(kg0 + go); if (two) kb2 = *(const v4u*)(kg1 + go); va = *(const v4u*)(vg + (size_t)(t + 1) * 64 * 512); }
        const int jb = t - (NT - 4);
        if (jb < 0 || 64 * jb <= 32 * wid + 31) {
            f32x16 p0, p1;
#pragma unroll
            for (int r = 0; r < 16; ++r) { p0[r] = 0.f; p1[r] = 0.f; }
#pragma unroll
            for (int d0 = 0; d0 < 6; ++d0) { const bf16x8 k0 = *(const LAS bf16x8*)(lds + cur + kfo + d0 * 32), k1 = *(const LAS bf16x8*)(lds + cur + kfo + 32 * AT_KS + d0 * 32);
                p0 = __builtin_amdgcn_mfma_f32_32x32x16_bf16(k0, qr[d0], p0, 0, 0, 0); p1 = __builtin_amdgcn_mfma_f32_32x32x16_bf16(k1, qr[d0], p1, 0, 0, 0); }
            if (jb >= 0) { const int kb = 64 * jb + 4 * hi;
#pragma unroll
                for (int r = 0; r < 16; ++r) { const int kv = kb + (r & 3) + 8 * (r >> 2); if (kv > qrel) p0[r] = -INFINITY; if (kv + 32 > qrel) p1[r] = -INFINITY; } }
            float rm = fmaxf(p0[0], p1[0]);
#pragma unroll
            for (int r = 1; r < 16; ++r) rm = fmaxf(rm, fmaxf(p0[r], p1[r]));
            rm = fmaxf(rm, __shfl_xor(rm, 32));
            const float mnew = fmaxf(m_run, rm), alpha = __builtin_amdgcn_exp2f(m_run - mnew);
            float ps = 0.f;
#pragma unroll
            for (int r = 0; r < 16; ++r) { p0[r] = __builtin_amdgcn_exp2f(p0[r] - mnew); p1[r] = __builtin_amdgcn_exp2f(p1[r] - mnew); ps += p0[r] + p1[r]; }
            l_run = l_run * alpha + ps;
            if (__any(mnew > m_run)) {
                if (hi == 0) wsf[r32] = alpha;
                LDS_WAIT();
#pragma unroll
                for (int r = 0; r < 16; ++r) { const float f = wsf[crow(r, hi)]; o[0][r] *= f; o[1][r] *= f; }
            }
            m_run = mnew;
            bf16x8 pa[4];
            { v4u w;
              w.x = cvt_pk_bf16(p0[0], p0[1]); w.y = cvt_pk_bf16(p0[2], p0[3]); w.z = cvt_pk_bf16(p0[4], p0[5]); w.w = cvt_pk_bf16(p0[6], p0[7]); pa[0] = __builtin_bit_cast(bf16x8, w);
              w.x = cvt_pk_bf16(p0[8], p0[9]); w.y = cvt_pk_bf16(p0[10], p0[11]); w.z = cvt_pk_bf16(p0[12], p0[13]); w.w = cvt_pk_bf16(p0[14], p0[15]); pa[1] = __builtin_bit_cast(bf16x8, w);
              w.x = cvt_pk_bf16(p1[0], p1[1]); w.y = cvt_pk_bf16(p1[2], p1[3]); w.z = cvt_pk_bf16(p1[4], p1[5]); w.w = cvt_pk_bf16(p1[6], p1[7]); pa[2] = __builtin_bit_cast(bf16x8, w);
              w.x = cvt_pk_bf16(p1[8], p1[9]); w.y = cvt_pk_bf16(p1[10], p1[11]); w.z = cvt_pk_bf16(p1[12], p1[13]); w.w = cvt_pk_bf16(p1[14], p1[15]); pa[3] = __builtin_bit_cast(bf16x8, w); }
#pragma unroll
            for (int d0 = 0; d0 < 2; ++d0)
#pragma unroll
                for (int ks = 0; ks < 4; ++ks) {
                    const s16x4 lo = __builtin_bit_cast(s16x4, __builtin_amdgcn_ds_read_tr16_b64_v4i16((LAS s16x4*)(lds + cur + AT_KB + vfo + (16 * ks) * AT_VS + d0 * 64)));
                    const s16x4 hh = __builtin_bit_cast(s16x4, __builtin_amdgcn_ds_read_tr16_b64_v4i16((LAS s16x4*)(lds + cur + AT_KB + vfo + (16 * ks + 8) * AT_VS + d0 * 64)));
                    const bf16x8 vf = (bf16x8){lo[0], lo[1], lo[2], lo[3], hh[0], hh[1], hh[2], hh[3]};
                    o[d0] = __builtin_amdgcn_mfma_f32_32x32x16_bf16(pa[ks], vf, o[d0], 0, 0, 0);
                }
        }
        if (more) { *(LAS v4u*)(lds + nxt + kl0) = ka; if (two) *(LAS v4u*)(lds + nxt + kl1) = kb2; *(LAS v4u*)(lds + nxt + AT_KB + vl) = va; }
        __syncthreads();
    }
    l_run += __shfl_xor(l_run, 32);
    if (hi == 0) wsf[32 + r32] = l_run;
    LDS_WAIT();
    { bf16* stg = (bf16*)(lds + AT_OST + wid * 4096);
#pragma unroll
      for (int r = 0; r < 16; ++r) { const int orow = crow(r, hi); const float rl = __builtin_amdgcn_rcpf(wsf[32 + orow]);
#pragma unroll
          for (int d0 = 0; d0 < 2; ++d0) { const unsigned u = cvt_pk_bf16(o[d0][r] * rl, 0.f); ((LAS bf16*)(lds + AT_OST + wid * 4096))[orow * 64 + d0 * 32 + r32] = (bf16)(u & 0xffffu); } }
      (void)stg;
      LDS_WAIT();
      bf16* Ow = O + (rowbase + q0 + wid * 32) * 512 + h * 64;
#pragma unroll
      for (int i = 0; i < 4; ++i) { const int row = i * 8 + (lane >> 3), ch = lane & 7; const v4u v = *(const LAS v4u*)(lds + AT_OST + wid * 4096 + (row * 64 + ch * 8) * 2); *(v4u*)(Ow + (size_t)row * 512 + ch * 8) = v; } }
    __syncthreads();
}

template <int CTRL> __device__ __forceinline__ float dpp_add(float v) { return v + __builtin_bit_cast(float, __builtin_amdgcn_update_dpp(0, __builtin_bit_cast(int, v), CTRL, 0xF, 0xF, true)); }
struct RwStep { f16x8 r, k, a, b, d; f16 v; };
__device__ __forceinline__ void rw_load(RwStep& x, const f16* R, const f16* KH, const f16* KKN, const f16* BV, const f16* DCY, const f16* VF, size_t off8, size_t offa, size_t offv) {
    x.r = *(const f16x8*)(R + off8); x.k = *(const f16x8*)(KH + off8); x.a = *(const f16x8*)(KKN + offa); x.b = *(const f16x8*)(BV + off8); x.d = *(const f16x8*)(DCY + off8); x.v = VF[offv];
}
__device__ __forceinline__ void rwkv_scan(Frame& F, int bh) {
    const int lane = F.lane, rl = lane >> 3, cg = lane & 7, b = bh >> 3, h = bh & 7, row = F.wave * 8 + rl;
    const f16* R = WSP(f16, WS_R); const f16* KH = WSP(f16, WS_KH); const f16* KKN = WSP(f16, WS_KKN); const f16* BV = WSP(f16, WS_BV); const f16* DCY = WSP(f16, WS_DCY); const f16* VF = WSP(f16, WS_VFIN);
    f16* Y = WSP(f16, WS_YRW);
    const size_t base = (size_t)b * SEQ * 512 + h * 64;
    float S[8];
#pragma unroll
    for (int j = 0; j < 8; ++j) S[j] = 0.f;
    float sa = 0.f;
    RwStep buf[4];
#pragma unroll
    for (int s = 0; s < 4; ++s) { const size_t o = base + (size_t)s * 512; rw_load(buf[s], R, KH, KKN, BV, DCY, VF, o + 8 * cg, o + 512 + 8 * cg, o + row); }
    for (int t0 = 0; t0 < SEQ; t0 += 4) {
#pragma unroll
        for (int s = 0; s < 4; ++s) {
            const RwStep x = buf[s]; const int t = t0 + s;
            if (t + 4 < SEQ) { const size_t o = base + (size_t)(t + 4) * 512; const size_t oa = (t + 5 < SEQ) ? o + 512 : o; rw_load(buf[s], R, KH, KKN, BV, DCY, VF, o + 8 * cg, oa + 8 * cg, o + row); }
            const float v = (float)x.v; float yp = 0.f, sp = 0.f;
#pragma unroll
            for (int j = 0; j < 8; ++j) { float sj = S[j]; sj = sj - sj * (float)x.d[j]; sj = __builtin_fmaf(sa, (float)x.b[j], sj); sj = __builtin_fmaf(v, (float)x.k[j], sj); S[j] = sj;
                yp = __builtin_fmaf(sj, (float)x.r[j], yp); sp = __builtin_fmaf(sj, (float)x.a[j], sp); }
            yp = dpp_add<0xB1>(yp); sp = dpp_add<0xB1>(sp);
            yp = dpp_add<0x4E>(yp); sp = dpp_add<0x4E>(sp);
            yp = dpp_add<0x141>(yp); sp = dpp_add<0x141>(sp);
            sa = -sp;
            if (cg == 0) Y[base + (size_t)t * 512 + row] = (f16)yp;
        }
    }
}
__device__ __forceinline__ void s5_carry(Frame& F, int idx) {
    const int p = idx & 63, g = (idx >> 6) & 31, b = idx >> 11;
    const float* a32 = WSP(float, WS_S5A32) + (size_t)(g * 64 + p) * 2; const float ar = a32[0], ai = a32[1];
    const float* xe = WSP(float, WS_XEND) + ((size_t)g * S5CH + b * S5NC) * 128; bf16* u = WSP(bf16, WS_S5U) + ((size_t)g * S5CH + b * S5NC) * S5K + 512;
    float xr = 0.f, xi = 0.f;
    for (int c0 = 0; c0 < S5NC; c0 += 8) { float er[8], ei[8];
#pragma unroll
        for (int c = 0; c < 8; ++c) { er[c] = xe[(size_t)(c0 + c) * 128 + p]; ei[c] = xe[(size_t)(c0 + c) * 128 + 64 + p]; }
#pragma unroll
        for (int c = 0; c < 8; ++c) { bf16* up = u + (size_t)(c0 + c) * S5K; up[p] = (bf16)(cvt_pk_bf16(xr, 0.f) & 0xffffu); up[64 + p] = (bf16)(cvt_pk_bf16(xi, 0.f) & 0xffffu);
            const float nr = ar * xr - ai * xi + er[c], ni = ar * xi + ai * xr + ei[c]; xr = nr; xi = ni; } }
}
__device__ __forceinline__ void rwkv_post(Frame& F, int l) {
    const int lane = F.lane; const int gw = F.blk * NWAVES + F.wave, NGW = F.G * NWAVES;
    float lg[8], lb[8], rk[8]; ld8f(INP(float, 16) + l * 512 + 8 * lane, lg); ld8f(INP(float, 17) + l * 512 + 8 * lane, lb); ld8f(INP(float, 15) + l * 512 + 8 * lane, rk);
    for (int m = gw; m < M; m += NGW) { const size_t off = (size_t)m * 512 + 8 * lane; float y[8], r[8], k[8], v[8], g[8], o[8];
        f16x8_to_f32(*(const f16x8*)(WSP(f16, WS_YRW) + off), y); f16x8_to_f32(*(const f16x8*)(WSP(f16, WS_R) + off), r); f16x8_to_f32(*(const f16x8*)(WSP(f16, WS_KH) + off), k);
        f16x8_to_f32(*(const f16x8*)(WSP(f16, WS_VFIN) + off), v); bf16x8_to_f32(*(const v4u*)(WSP(bf16, WS_GL) + off), g);
        float s = 0.f, bs = 0.f;
#pragma unroll
        for (int j = 0; j < 8; ++j) { s += y[j]; bs += r[j] * k[j] * rk[j]; }
        s += __shfl_xor(s, 1); s += __shfl_xor(s, 2); s += __shfl_xor(s, 4); bs += __shfl_xor(bs, 1); bs += __shfl_xor(bs, 2); bs += __shfl_xor(bs, 4);
        const float mean = s * (1.0f / 64.0f); float q = 0.f;
#pragma unroll
        for (int j = 0; j < 8; ++j) { y[j] -= mean; q += y[j] * y[j]; }
        q += __shfl_xor(q, 1); q += __shfl_xor(q, 2); q += __shfl_xor(q, 4);
        const float rstd = 1.0f / sqrtf(q * (1.0f / 64.0f) + 64e-5f);
#pragma unroll
        for (int j = 0; j < 8; ++j) o[j] = (y[j] * rstd * lg[j] + lb[j] + bs * v[j]) * g[j];
        *(v4u*)(WSP(bf16, WS_YRW) + off) = f32_to_bf16x8(o); }
}
constexpr int PH_PER_LAYER = 12, N_PHASES = 1 + NLAYER * PH_PER_LAYER;
#ifndef MK_PER_PHASE
#define MK_PER_PHASE 0
#endif
#ifndef ABL_BRANCH
#define ABL_BRANCH -1
#endif
constexpr int NR_RWKV = 64;

__global__ void __launch_bounds__(NWAVES * 64, 2) mk_fwd(Args A) {
    extern __shared__ __attribute__((aligned(16))) unsigned char lds_raw[];
    volatile LAS unsigned* MISC = (volatile LAS unsigned*)((LAS unsigned char*)lds_raw + MISC_OFF);
    for (int u = threadIdx.x; u < (LDS_BYTES - LDSCTL_OFF) / 4; u += NWAVES * 64) ((LAS unsigned*)((LAS unsigned char*)lds_raw + LDSCTL_OFF))[u] = 0u;
    __syncthreads();
    XcdBarrier bar; bar.bar = (unsigned*)(A.ws + WS_CTL) + CW_BAR; bar.x = 0; bar.st = nullptr;
    if (!MK_PER_PHASE) bar = xcd_barrier_post((unsigned*)(A.ws + WS_CTL) + CW_BAR, MISC + 8);
    const int lo = A.ph_lo, hi = A.ph_hi;
#ifndef PHMASK
#define PHMASK 0xFFFF
#endif
#define PHON(k) ((PHMASK >> (k)) & 1)
#define IN(k) (lo <= (k) && (k) < hi)
#define SEAM(k) do { if (IN(k) && IN((k) + 1)) xcd_barrier(bar); } while (0)
    using pg8::gemm_phase; using pg8::StaticOrder; using pg8::LocDense;

    if (PHON(0) && IN(0)) {
        MKFRAME(F);
        p0_prologue(F);
        const int gw = F.blk * NWAVES + F.wave, NGW = F.G * NWAVES;
        for (int m = gw; m < M; m += NGW) {
#pragma unroll
            for (int j = 0; j < 4; ++j) { const f32x4 v = *(const f32x4*)(INP(float, 0) + (size_t)m * DM + 4 * F.lane + 256 * j); v2u w; w.x = cvt_pk_bf16(v[0], v[1]); w.y = cvt_pk_bf16(v[2], v[3]); *(v2u*)(WSP(bf16, WS_XB) + (size_t)m * DM + 4 * F.lane + 256 * j) = w; } }
    }
    SEAM(0);

    for (int l = 0; l < NLAYER; ++l) {
        const int pb = 1 + l * PH_PER_LAYER;
        const bool moe = (l & 1) != 0; const int li = l >> 1;
        if (PHON(1) && IN(pb + 0)) {
            asm volatile("; ==PH1");
            MKFRAME(F);
            LocDense L{WSP(bf16, WS_XB), WSP(bf16, WS_WIN) + (size_t)l * 3072 * DM, DM, DM, DM, 0, 0};
            StaticOrder S; S.init(M, 3072, 1, F.G, F.blk);
            Epi8<FProj> E{{WSP(bf16, WS_MLARAW), WSP(bf16, WS_RWRAW), WSP(bf16, WS_S5U)}};
            gemm_phase(F.lds + RING_OFF, L, S, E);
        }
        SEAM(pb + 0);
        if (PHON(2) && IN(pb + 1)) { MKFRAME(F); ph2_prep(F, l); }
        SEAM(pb + 1);
        if (PHON(3) && IN(pb + 2)) {
            asm volatile("; ==PH3");
            MKFRAME(F);
#ifndef P3SEL
#define P3SEL 31
#endif
            if (P3SEL & 1) { LocDense L{WSP(bf16, WS_CQN), WSP(bf16, WS_WUQ) + (size_t)l * 768 * 384, 384, 384, 384, 0, 0}; StaticOrder S; S.init(M, 768, 1, F.G, F.blk);
              Epi8<FQup> E{{WSP(bf16, WS_Q), WSP(float, WS_ROPE), 0.10206207261596575f * 1.4426950408889634f}}; gemm_phase(F.lds + RING_OFF, L, S, E); }
            if (P3SEL & 2) { LocDense L{WSP(bf16, WS_CKVN), WSP(bf16, WS_WUKV) + (size_t)l * 1024 * 256, 256, 256, 256, 0, 0}; StaticOrder S; S.init(M, 1024, 1, F.G, F.blk);
              Epi8<FKVup> E{{WSP(bf16, WS_K), WSP(bf16, WS_V)}}; gemm_phase(F.lds + RING_OFF, L, S, E); }
            if (P3SEL & 4) { LocDense L{WSP(bf16, WS_LORAIN), WSP(bf16, WS_WLORA) + (size_t)l * 1536 * 256, 256, 256, 256, 0, 0}; StaticOrder S; S.init(M, 1536, 1, F.G, F.blk);
              Epi8<FLora> E{{INP(float, 8) + l * 512, INP(float, 10) + l * 512, INP(float, 14) + l * 512, WSP(f16, WS_DCY), WSP(f16, WS_KH), WSP(f16, WS_KKN), WSP(f16, WS_BV), WSP(bf16, WS_GL), {}, {}}}; gemm_phase(F.lds + RING_OFF, L, S, E); }
            if ((P3SEL & 8) && l > 0) { LocDense L{WSP(bf16, WS_VRAW), WSP(bf16, WS_WVRES) + (size_t)(l - 1) * 512 * 512, 512, 512, 512, 0, 0}; StaticOrder S; S.init(M, 512, 1, F.G, F.blk);
              Epi8<FVres> E{{INP(float, 20) + (l - 1) * 512, WSP(bf16, WS_VRAW), WSP(bf16, WS_VFIRST), WSP(f16, WS_VFIN), {}}}; gemm_phase(F.lds + RING_OFF, L, S, E); }
            if (P3SEL & 16) { LocDense L{WSP(bf16, WS_S5U), WSP(bf16, WS_S5END), S5K, 512, 512, (size_t)S5CH * S5K, (size_t)256 * 512}; StaticOrder S; S.init(S5CH, 256, 32, F.G, F.blk);
              Epi8<FS5End> E{{WSP(float, WS_XEND)}}; gemm_phase(F.lds + RING_OFF, L, S, E); }
        }
        SEAM(pb + 2);
        if (PHON(4) && IN(pb + 3)) {
            asm volatile("; ==PH4");
            MKFRAME(F);
            if (F.blk < NR_RWKV && F.G > NR_RWKV) { for (int bh = F.blk; bh < NBATCH * NH; bh += NR_RWKV) rwkv_scan(F, bh); }
            else {
                const int ab = F.blk - NR_RWKV, na = F.G - NR_RWKV;
                for (int idx = ab * 512 + F.tid; idx < NBATCH * 32 * 64; idx += na * 512) s5_carry(F, idx);
                LAS int* slot = (LAS int*)(F.lds + AT_LDS);
                for (;;) {
                    __syncthreads();
                    if (F.tid == 0) *slot = (int)__hip_atomic_fetch_add((unsigned*)(F.ctl + CW_ATTN + 64 * l), 1u, RLX_AGENT);
                    __syncthreads();
                    const int n = *slot; if (n >= NBATCH * NH * 16) break;
                    const int qb = 15 - (n >> 6), bh = n & 63;
                    attn_unit(F.tid, bh >> 3, bh & 7, qb, WSP(bf16, WS_Q), WSP(bf16, WS_K), WSP(bf16, WS_V), WSP(bf16, WS_YMLA), F.lds);
                }
            }
        }
        SEAM(pb + 3);
        if (PHON(5) && IN(pb + 4)) {
            asm volatile("; ==PH5");
            MKFRAME(F);
            { LocDense L{WSP(bf16, WS_S5U), WSP(bf16, WS_S5MAIN), S5K, S5K, S5K, (size_t)S5CH * S5K, (size_t)512 * S5K}; StaticOrder S; S.init(S5CH, 512, 32, F.G, F.blk);
              Epi8<FS5Main> E{{WSP(bf16, WS_S5U), INP(float, 28) + l * 512, WSP(bf16, WS_YS5G), {}}}; gemm_phase(F.lds + RING_OFF, L, S, E); }
            rwkv_post(F, l);
        }
        SEAM(pb + 4);
        if (PHON(6) && IN(pb + 5)) {
            asm volatile("; ==PH6");
            MKFRAME(F);
            { LocDense L{WSP(bf16, WS_YS5G), WSP(bf16, WS_WGLU) + (size_t)l * 512 * 512, 512, 512, 512, 0, 0}; StaticOrder S; S.init(M, 512, 1, F.G, F.blk);
              Epi8<FGlu> E{{WSP(bf16, WS_YS5G), INP(float, 30) + l * 512, WSP(bf16, WS_YS5), {}}}; gemm_phase(F.lds + RING_OFF, L, S, E); }
            { LocDense L{WSP(bf16, WS_XB), WSP(bf16, WS_WG) + ((size_t)l * 3 + 0) * 1024 * DM, DM, DM, DM, 0, 0}; StaticOrder S; S.init(M, 1024, 1, F.G, F.blk);
              Epi8<FGate> E{{WSP(bf16, WS_GBUF)}}; gemm_phase(F.lds + RING_OFF, L, S, E); }
            { LocDense L{WSP(bf16, WS_YMLA), WSP(bf16, WS_WBR) + ((size_t)l * 3 + 0) * 1024 * 512, 512, 512, 512, 0, 0}; StaticOrder S; S.init(M, 1024, 1, F.G, F.blk);
              Epi8<FMerge> E{{WSP(bf16, WS_GBUF), WSP(bf16, WS_MIXED2), WSP(bf16, WS_MIXED), 1, (ABL_BRANCH == 0) ? 0.f : 1.f}}; gemm_phase(F.lds + RING_OFF, L, S, E); }
            { LocDense L{WSP(bf16, WS_XB), WSP(bf16, WS_WG) + ((size_t)l * 3 + 1) * 1024 * DM, DM, DM, DM, 0, 0}; StaticOrder S; S.init(M, 1024, 1, F.G, F.blk);
              Epi8<FGate> E{{WSP(bf16, WS_GBUF2)}}; gemm_phase(F.lds + RING_OFF, L, S, E); }
            { LocDense L{WSP(bf16, WS_YRW), WSP(bf16, WS_WBR) + ((size_t)l * 3 + 1) * 1024 * 512, 512, 512, 512, 0, 0}; StaticOrder S; S.init(M, 1024, 1, F.G, F.blk);
              Epi8<FMerge> E{{WSP(bf16, WS_GBUF2), WSP(bf16, WS_MIXED), WSP(bf16, WS_MIXED2), 0, (ABL_BRANCH == 1) ? 0.f : 1.f}}; gemm_phase(F.lds + RING_OFF, L, S, E); }
        }
        SEAM(pb + 5);
        if (PHON(7) && IN(pb + 6)) {
            asm volatile("; ==PH7");
            MKFRAME(F);
            { LocDense L{WSP(bf16, WS_XB), WSP(bf16, WS_WG) + ((size_t)l * 3 + 2) * 1024 * DM, DM, DM, DM, 0, 0}; StaticOrder S; S.init(M, 1024, 1, F.G, F.blk);
              Epi8<FGate> E{{WSP(bf16, WS_GBUF)}}; gemm_phase(F.lds + RING_OFF, L, S, E); }
            { LocDense L{WSP(bf16, WS_YS5), WSP(bf16, WS_WBR) + ((size_t)l * 3 + 2) * 1024 * 512, 512, 512, 512, 0, 0}; StaticOrder S; S.init(M, 1024, 1, F.G, F.blk);
              Epi8<FMerge> E{{WSP(bf16, WS_GBUF), WSP(bf16, WS_MIXED2), WSP(bf16, WS_MIXED), 0, (ABL_BRANCH == 2) ? 0.f : 1.f}}; gemm_phase(F.lds + RING_OFF, L, S, E); }
        }
        SEAM(pb + 6);
        if (PHON(8) && IN(pb + 7)) {
            asm volatile("; ==PH8");
            MKFRAME(F);
            LocDense L{WSP(bf16, WS_MIXED), WSP(bf16, WS_WOUT) + (size_t)l * DM * DM, DM, DM, DM, 0, 0}; StaticOrder S; S.init(M, DM, 1, F.G, F.blk);
            Epi8<FResid> E{{(l == 0) ? INP(float, 0) : (const float*)F.out, F.out}}; gemm_phase(F.lds + RING_OFF, L, S, E);
        }
        SEAM(pb + 7);
        if (PHON(9) && IN(pb + 8)) {
            asm volatile("; ==PH9");
            MKFRAME(F);
            if (moe) { ln1_moe_phase(F, INP(float, 33) + l * DM, INP(float, 34) + l * DM, li); moe_convert(F, li); }
            else ln_phase(F, INP(float, 33) + l * DM, INP(float, 34) + l * DM);
        }
        SEAM(pb + 8);
        if (PHON(10) && IN(pb + 9)) {
            asm volatile("; ==PH10");
            MKFRAME(F);
            if (moe) {
                const unsigned* cnt = (const unsigned*)(F.ctl + CW_MOECNT + 64 * li);
                LocMoe1 L{WSP(bf16, WS_XB), WSP(bf16, WS_WMGU), DM, DM, DM, WSP(int, WS_SLOTTOK), cnt}; MoeOrder S; S.init(cnt, 2 * EXD / 256, F.G, F.blk);
                EpiGU<FSwiglu> E{{WSP(bf16, WS_HM), EXD}}; gemm_phase(F.lds + RING_OFF, L, S, E);
            } else {
                LocDense L{WSP(bf16, WS_XB), WSP(bf16, WS_WFGU) + (size_t)li * 2 * FFN * DM, DM, DM, DM, 0, 0}; StaticOrder S; S.init(M, 2 * FFN, 1, F.G, F.blk);
                EpiGU<FSwiglu> E{{WSP(bf16, WS_HB), FFN}}; gemm_phase(F.lds + RING_OFF, L, S, E);
            }
        }
        SEAM(pb + 9);
        if (PHON(11) && IN(pb + 10)) {
            asm volatile("; ==PH11");
            MKFRAME(F);
            if (moe) {
                const unsigned* cnt = (const unsigned*)(F.ctl + CW_MOECNT + 64 * li);
                LocDense L{WSP(bf16, WS_HM), WSP(bf16, WS_WMD), EXD, EXD, EXD, 0, (size_t)DM * EXD}; MoeOrder S; S.init(cnt, DM / 256, F.G, F.blk);
                Epi8<FMoeDown> E{{WSP(bf16, WS_YPAIR), WSP(float, WS_SLOTW), cnt}}; gemm_phase(F.lds + RING_OFF, L, S, E);
            } else {
                LocDense L{WSP(bf16, WS_HB), WSP(bf16, WS_WFD) + (size_t)li * DM * FFN, FFN, FFN, FFN, 0, 0}; StaticOrder S; S.init(M, DM, 1, F.G, F.blk);
                Epi8<FResid> E{{F.out, F.out}}; gemm_phase(F.lds + RING_OFF, L, S, E);
            }
        }
        SEAM(pb + 10);
        if (PHON(12) && IN(pb + 11)) {
            asm volatile("; ==PH12");
            MKFRAME(F);
            if (moe) ln2_moe_phase(F, INP(float, 35) + l * DM, INP(float, 36) + l * DM, li);
            else ln_phase(F, INP(float, 35) + l * DM, INP(float, 36) + l * DM);
        }
        SEAM(pb + 11);
    }
#undef IN
#undef SEAM
}

#ifdef PROBE_P
__global__ void probe_sum(const unsigned* x, unsigned long long* sums, int n) {
    __shared__ unsigned long long sh[256];
    unsigned long long s = 0;
    for (int i = blockIdx.x * blockDim.x + threadIdx.x; i < n; i += gridDim.x * blockDim.x) s += (unsigned long long)x[i] * (unsigned long long)(2 * (i & 1023) + 1);
    sh[threadIdx.x] = s; __syncthreads();
    if (threadIdx.x == 0) { unsigned long long t = 0; for (int i = 0; i < 256; ++i) t += sh[i]; sums[blockIdx.x] = t; }
}
__global__ void probe_cmp(const unsigned long long* sums, unsigned* out) {
    if (sums[threadIdx.x] != sums[1024 + threadIdx.x]) out[threadIdx.x * 4099] = 0x7fc00000u;
}
#endif
extern "C" void kernel_launch(void* const* d_in, const int* in_sizes, int n_in, void* d_out, int out_size, void* d_ws, size_t ws_size, hipStream_t stream) {
    static int grid = 0;
    if (grid == 0) {
        if (n_in != 44 || out_size != M * DM || ws_size < WS_END) { fprintf(stderr, "kernel_launch: unexpected problem (n_in %d, out %d, ws %zu < %zu)\n", n_in, out_size, ws_size, (size_t)WS_END); grid = -1; return; }
        int dev = 0, cus = 0, per_cu = 0;
        if (hipGetDevice(&dev) != hipSuccess || hipDeviceGetAttribute(&cus, hipDeviceAttributeMultiprocessorCount, dev) != hipSuccess) { grid = -1; return; }
        if (hipFuncSetAttribute((const void*)mk_fwd, hipFuncAttributeMaxDynamicSharedMemorySize, LDS_BYTES) != hipSuccess) { fprintf(stderr, "kernel_launch: hipFuncSetAttribute failed\n"); grid = -1; return; }
        if (hipOccupancyMaxActiveBlocksPerMultiprocessor(&per_cu, (const void*)mk_fwd, NWAVES * 64, LDS_BYTES) != hipSuccess || per_cu < 1) { fprintf(stderr, "kernel_launch: occupancy query says %d blocks per CU\n", per_cu); }
        (void)hipGetLastError();
        grid = cus;
        if (grid != 256) fprintf(stderr, "kernel_launch: %d CUs (built for 256)\n", grid);
    }
    if (grid < 0) return;
    (void)in_sizes;
    if (hipMemsetAsync((char*)d_ws + WS_CTL, 0, CTL_ZERO_BYTES, stream) != hipSuccess) return;
    Args a{};
    for (int i = 0; i < 44; ++i) a.in[i] = d_in[i];
    a.out = (float*)d_out; a.ws = (unsigned char*)d_ws; a.pad = 0;
#if MK_PER_PHASE
#ifdef PROBE_P
    for (int p = 0; p <= PROBE_P; ++p) { a.ph_lo = p; a.ph_hi = p + 1; a.li = p; hipLaunchKernelGGL(mk_fwd, dim3(grid), dim3(NWAVES * 64), LDS_BYTES, stream, a); }
    hipLaunchKernelGGL(probe_sum, dim3(1024), dim3(256), 0, stream, (const unsigned*)((char*)d_ws + PROBE_OFF), (unsigned long long*)((char*)d_ws + WS_END), (int)(PROBE_BYTES / 4));
    hipMemsetAsync((char*)d_ws + WS_CTL, 0, CTL_ZERO_BYTES, stream);
    for (int p = 0; p <= PROBE_P; ++p) { a.ph_lo = p; a.ph_hi = p + 1; a.li = p; hipLaunchKernelGGL(mk_fwd, dim3(grid), dim3(NWAVES * 64), LDS_BYTES, stream, a); }
    hipLaunchKernelGGL(probe_sum, dim3(1024), dim3(256), 0, stream, (const unsigned*)((char*)d_ws + PROBE_OFF), (unsigned long long*)((char*)d_ws + WS_END) + 1024, (int)(PROBE_BYTES / 4));
    for (int p = PROBE_P + 1; p < N_PHASES; ++p) { a.ph_lo = p; a.ph_hi = p + 1; a.li = p; hipLaunchKernelGGL(mk_fwd, dim3(grid), dim3(NWAVES * 64), LDS_BYTES, stream, a); }
    hipLaunchKernelGGL(probe_cmp, dim3(1), dim3(1024), 0, stream, (const unsigned long long*)((char*)d_ws + WS_END), (unsigned*)d_out);
#else
    for (int p = 0; p < N_PHASES; ++p) { a.ph_lo = p; a.ph_hi = p + 1; a.li = p; hipLaunchKernelGGL(mk_fwd, dim3(grid), dim3(NWAVES * 64), LDS_BYTES, stream, a); }
#endif
#else
    a.ph_lo = 0; a.ph_hi = N_PHASES; a.li = 0;
    hipLaunchKernelGGL(mk_fwd, dim3(grid), dim3(NWAVES * 64), LDS_BYTES, stream, a);
#endif
}
```

```cpp
#include <hip/hip_runtime.h>
#include <cstdio>
#include <cstdint>
#include <cmath>
namespace pg8 {
#define PG8_LAS __attribute__((address_space(3)))
typedef unsigned short bf16_t;
typedef short bf16x8 __attribute__((ext_vector_type(8)));
typedef float f32x4 __attribute__((ext_vector_type(4)));
typedef float f32x2 __attribute__((ext_vector_type(2)));
typedef unsigned u32x4 __attribute__((ext_vector_type(4)));
typedef unsigned u32x2 __attribute__((ext_vector_type(2)));
constexpr int BM = 256, BK = 64, HALF = 128, HTB = HALF * BK * 2  , STAGE_BYTES = 8 * HTB, NXCD = 8, WGM = 8;

__host__ __device__ __forceinline__ int lds_byte(int r, int c) { const int st = (r >> 4) * 2 + (c >> 5), rr = r & 15, cc = c & 31, ob = rr * 64 + cc * 2; return st * 1024 + (ob ^ (((ob >> 9) & 1) << 5)); }
__host__ __device__ __forceinline__ void stage_rc(int b, int& R, int& C) { const int st = b / 1024, sb = b % 1024, swz = sb ^ (((sb >> 9) & 1) << 5); R = (st >> 1) * 16 + swz / 64; C = (st & 1) * 32 + (swz % 64) / 2; }
__host__ __device__ __forceinline__ int perm32(int rho) { const int n = rho >> 4, i = rho & 15; return 8 * (i >> 2) + 4 * n + (i & 3); }

struct Unit { int pm, pn, z, aux; };

struct LocDense {
    static constexpr bool GATHER = false;
    const bf16_t* A; const bf16_t* Bt; int lda, ldb, K; size_t zA, zB;
    __device__ __forceinline__ const char* a_ptr(const Unit& u) const { return (const char*)(A + (size_t)u.z * zA + (size_t)u.pm * BM * lda); }
    __device__ __forceinline__ const char* b_ptr(const Unit& u) const { return (const char*)(Bt + (size_t)u.z * zB + (size_t)u.pn * BM * ldb); }
    __device__ __forceinline__ void a_off(const Unit&, int tid, unsigned (&v)[2][2]) const {
#pragma unroll
        for (int i = 0; i < 2; ++i) { int R, C; stage_rc(tid * 16 + i * 8192, R, C); v[0][i] = (unsigned)(R * lda + C) * 2u; v[1][i] = 0u; }
    }
};

struct StaticOrder {
    int nM, nN, nwg, nZ, G, c;
    __device__ void init(int M, int N, int Z, int G_, int c_) { nM = M / BM; nN = N / BM; nwg = nM * nN; nZ = Z; G = G_; c = c_; }
    __device__ bool next(int i, Unit& u) const {
        const long L = (long)i * G + c; if (L >= (long)nwg * nZ) return false;
        u.z = (int)(L / nwg); u.aux = 0;
        int wgid = (int)(L % nwg); { const int q = nwg / NXCD, r = nwg % NXCD, xcd = wgid % NXCD, off = wgid / NXCD; wgid = (xcd < r ? xcd * (q + 1) : r * (q + 1) + (xcd - r) * q) + off; }
        const int nig = WGM * nN, gid = wgid / nig, fm = gid * WGM, gsz = (nM - fm) < WGM ? (nM - fm) : WGM;
        u.pm = fm + ((wgid % nig) % gsz); u.pn = (wgid % nig) / gsz; return true;
    }
};

typedef float f32x2_cv __attribute__((ext_vector_type(2))); typedef __bf16 bf16x2_cv __attribute__((ext_vector_type(2)));
__device__ __forceinline__ unsigned cvt_pk_bf16(float lo, float hi) { const f32x2_cv v = {lo, hi}; const bf16x2_cv b = __builtin_convertvector(v, bf16x2_cv); return __builtin_bit_cast(unsigned, b); }
__device__ __forceinline__ u32x4 pack8(const f32x4 v0, const f32x4 v1) { u32x4 w; w.x = cvt_pk_bf16(v0[0], v0[1]); w.y = cvt_pk_bf16(v0[2], v0[3]); w.z = cvt_pk_bf16(v1[0], v1[1]); w.w = cvt_pk_bf16(v1[2], v1[3]); return w; }
__device__ __forceinline__ float bf_lo(unsigned w) { return __uint_as_float(w << 16); }
__device__ __forceinline__ float bf_hi(unsigned w) { return __uint_as_float(w & 0xffff0000u); }
__device__ __forceinline__ void unpack8(const u32x4 w, f32x4& v0, f32x4& v1) { v0 = (f32x4){bf_lo(w.x), bf_hi(w.x), bf_lo(w.y), bf_hi(w.y)}; v1 = (f32x4){bf_lo(w.z), bf_hi(w.z), bf_lo(w.w), bf_hi(w.w)}; }

struct NoPre {};
template <class F> struct Epi8 {
    static constexpr bool PERM = true;
    F f;
    __device__ __forceinline__ void operator()(const f32x4 (&acc)[2][2][4][2], const Unit& u, int wr, int wc, int fr, int fq) const {
        const int row0 = u.pm * BM + wr * 64 + fr, col0 = u.pn * BM + wc * 32 + 8 * fq;
        F g = f;
#pragma unroll
        for (int bj = 0; bj < 2; ++bj) { const int col = col0 + bj * HALF; g.begin_col(u, col);
#pragma unroll
            for (int b0 = 0; b0 < 8; b0 += F::BATCH) { typename F::Pre pr[F::BATCH];
#pragma unroll
                for (int i = 0; i < F::BATCH; ++i) { const int q = b0 + i; pr[i] = g.pre(u, row0 + (q >> 2) * HALF + (q & 3) * 16, col); }
#pragma unroll
                for (int i = 0; i < F::BATCH; ++i) { const int q = b0 + i; g.tile8(u, row0 + (q >> 2) * HALF + (q & 3) * 16, col, acc[q >> 2][bj][q & 3][0], acc[q >> 2][bj][q & 3][1], pr[i]); }
                asm volatile("" ::: "memory"); } }
    }
};
template <class F> struct EpiGU {
    static constexpr bool PERM = true;
    F f;
    __device__ __forceinline__ void operator()(const f32x4 (&acc)[2][2][4][2], const Unit& u, int wr, int wc, int fr, int fq) const {
        const int row0 = u.pm * BM + wr * 64 + fr, colh = u.pn * HALF + wc * 32 + 8 * fq;
#pragma unroll
        for (int ai = 0; ai < 2; ++ai)
#pragma unroll
            for (int m = 0; m < 4; ++m) { f.pair8(u, row0 + ai * HALF + m * 16, colh, acc[ai][0][m][0], acc[ai][0][m][1], acc[ai][1][m][0], acc[ai][1][m][1]); asm volatile("" ::: "memory"); }
    }
};

template <class Epi, class Sched, class Loc>
__device__ __forceinline__ void gemm_phase(PG8_LAS unsigned char* lds, const Loc& L, const Sched& S, const Epi& E) {
    int tid_ = threadIdx.x; asm volatile("" : "+v"(tid_));
    const int tid = tid_, wid = __builtin_amdgcn_readfirstlane(tid >> 6), lane = tid & 63, wr = wid >> 2, wc = wid & 3, fr = lane & 15, fq = lane >> 4;
    const int K = L.K, nt = K / BK;
    unsigned voffB[2];
#pragma unroll
    for (int i = 0; i < 2; ++i) { int R, C; stage_rc(tid * 16 + i * 8192, R, C); const int Rb = Epi::PERM ? ((R & ~31) + perm32(R & 31)) : R;
        voffB[i] = (unsigned)(Rb * L.ldb + C) * 2u; }
    const size_t kstep = (size_t)(BK * 2);
    const size_t hstepB = (size_t)HALF * L.ldb * 2;
    const unsigned ldsw = (unsigned)wid * 1024u;
    const int aoff = lds_byte(wr * 64 + fr, fq * 8), boff = lds_byte(wc * 32 + fr, fq * 8);
#define PG8_SA(b, h) (((b) * 2 + (h)) * HTB)
#define PG8_SB(b, h) ((4 + (b) * 2 + (h)) * HTB)
#define PG8_STAGE(bufoff, gbase, voff) do { _Pragma("unroll") for (int _i = 0; _i < 2; ++_i) \
        __builtin_amdgcn_global_load_lds((const unsigned*)((const char*)(gbase) + (voff)[_i]), (PG8_LAS unsigned*)(lds + (bufoff) + ldsw + _i * 8192), 16, 0, 0); } while (0)
#define PG8_LDA(dst, b, h) do { _Pragma("unroll") for (int m = 0; m < 4; ++m) _Pragma("unroll") for (int k = 0; k < 2; ++k) dst[m][k] = *(const PG8_LAS bf16x8*)(lds + PG8_SA(b, h) + aoff + m * 2048 + k * 1024); } while (0)
#define PG8_LDB(dst, b, h) do { _Pragma("unroll") for (int n = 0; n < 2; ++n) _Pragma("unroll") for (int k = 0; k < 2; ++k) dst[n][k] = *(const PG8_LAS bf16x8*)(lds + PG8_SB(b, h) + boff + n * 2048 + k * 1024); } while (0)
#define PG8_MMA(ai, bj, At, Bt) do { __builtin_amdgcn_s_setprio(1); _Pragma("unroll") for (int m = 0; m < 4; ++m) _Pragma("unroll") for (int n = 0; n < 2; ++n) _Pragma("unroll") for (int k = 0; k < 2; ++k) \
        acc[ai][bj][m][n] = __builtin_amdgcn_mfma_f32_16x16x32_bf16(Bt[n][k], At[m][k], acc[ai][bj][m][n], 0, 0, 0); __builtin_amdgcn_s_setprio(0); } while (0)
#define PG8_WAIT_V(n) asm volatile("s_waitcnt vmcnt(" #n ")" ::: "memory")
#define PG8_WAIT_L(n) asm volatile("s_waitcnt lgkmcnt(" #n ")" ::: "memory")
#define PG8_BAR __builtin_amdgcn_s_barrier()
#define PG8_SCHED __builtin_amdgcn_sched_barrier(0)
    Unit cur, nxt; int ui = 0;
    if (!S.next(0, cur)) return;
    f32x4 acc[2][2][4][2];
#pragma unroll
    for (int a = 0; a < 2; ++a)
#pragma unroll
        for (int b = 0; b < 2; ++b)
#pragma unroll
            for (int m = 0; m < 4; ++m)
#pragma unroll
                for (int n = 0; n < 2; ++n) acc[a][b][m][n] = (f32x4){0.f, 0.f, 0.f, 0.f};
    bf16x8 At[4][2], B0[2][2], B1[2][2];
    constexpr int NVH = Loc::GATHER ? 2 : 1;
    unsigned vc[2][2], vn[NVH][2];
    L.a_off(cur, tid, vc);
    if constexpr (Loc::GATHER) {
#pragma unroll
        for (int h = 0; h < 2; ++h)
#pragma unroll
            for (int i = 0; i < 2; ++i) vn[h][i] = vc[h][i];
    }
    const size_t hstepA = Loc::GATHER ? 0 : (size_t)HALF * L.lda * 2;
    const char* cA = L.a_ptr(cur); const char* cB = L.b_ptr(cur);
    PG8_STAGE(PG8_SB(0, 0), cB, voffB); PG8_STAGE(PG8_SB(0, 1), cB + hstepB, voffB); PG8_STAGE(PG8_SA(0, 0), cA, vc[0]); PG8_STAGE(PG8_SA(0, 1), cA + hstepA, vc[NVH - 1]);
    if (wr == 1) PG8_BAR;
    PG8_WAIT_V(2); PG8_BAR;
    PG8_STAGE(PG8_SB(1, 0), cB + kstep, voffB); PG8_STAGE(PG8_SA(1, 0), cA + kstep, vc[0]); PG8_STAGE(PG8_SB(1, 1), cB + hstepB + kstep, voffB);
    PG8_WAIT_V(6); PG8_BAR;
    for (;;) {
        const bool has_next = S.next(ui + 1, nxt);
        const char* nA = has_next ? L.a_ptr(nxt) : cA; const char* nB = has_next ? L.b_ptr(nxt) : cB;
        if constexpr (Loc::GATHER) { if (has_next) L.a_off(nxt, tid, vn); }
        for (int t = 0; t < nt; t += 2) {
            const bool last = (t == nt - 2);
            const char* a1 = cA + (size_t)(t + 1) * kstep;
            const char* a2 = last ? nA : cA + (size_t)(t + 2) * kstep; const char* b2 = last ? nB : cB + (size_t)(t + 2) * kstep;
            const char* a3 = a2 + kstep; const char* b3 = b2 + kstep;
            PG8_LDB(B0, 0, 0); PG8_LDB(B1, 0, 1); PG8_SCHED; PG8_LDA(At, 0, 0); PG8_STAGE(PG8_SA(1, 1), a1 + hstepA, vc[NVH - 1]);
            if constexpr (Loc::GATHER) { if (last) {
#pragma unroll
                for (int h = 0; h < 2; ++h)
#pragma unroll
                    for (int i = 0; i < 2; ++i) vc[h][i] = vn[h][i]; } }
            PG8_WAIT_V(8); PG8_WAIT_L(0); PG8_BAR; PG8_MMA(0, 0, At, B0); PG8_MMA(0, 1, At, B1); PG8_BAR; PG8_SCHED;
            PG8_LDA(At, 0, 1); PG8_STAGE(PG8_SB(0, 0), b2, voffB); PG8_STAGE(PG8_SB(0, 1), b2 + hstepB, voffB); PG8_STAGE(PG8_SA(0, 0), a2, vc[0]);
            PG8_WAIT_V(8); PG8_WAIT_L(0); PG8_BAR; PG8_MMA(1, 0, At, B0); PG8_MMA(1, 1, At, B1); PG8_BAR; PG8_SCHED;
            PG8_LDB(B0, 1, 0); PG8_LDB(B1, 1, 1); PG8_SCHED; PG8_LDA(At, 1, 0); PG8_STAGE(PG8_SA(0, 1), a2 + hstepA, vc[NVH - 1]);
            PG8_WAIT_V(8); PG8_WAIT_L(0); PG8_BAR; PG8_MMA(0, 0, At, B0); PG8_MMA(0, 1, At, B1); PG8_BAR; PG8_SCHED;
            PG8_LDA(At, 1, 1); PG8_STAGE(PG8_SB(1, 0), b3, voffB); PG8_STAGE(PG8_SB(1, 1), b3 + hstepB, voffB); PG8_STAGE(PG8_SA(1, 0), a3, vc[0]);
            PG8_WAIT_V(8); PG8_WAIT_L(0); PG8_BAR; PG8_MMA(1, 0, At, B0); PG8_MMA(1, 1, At, B1); PG8_BAR; PG8_SCHED;
        }
        if (wr == 0) PG8_BAR;
        E(acc, cur, wr, wc, fr, fq);
        if (!has_next) break;
#pragma unroll
        for (int a = 0; a < 2; ++a)
#pragma unroll
            for (int b = 0; b < 2; ++b)
#pragma unroll
                for (int m = 0; m < 4; ++m)
#pragma unroll
                    for (int n = 0; n < 2; ++n) acc[a][b][m][n] = (f32x4){0.f, 0.f, 0.f, 0.f};
        cur = nxt; cA = nA; cB = nB; ++ui;
        if (wr == 1) PG8_BAR;
    }
    PG8_WAIT_V(0);
    PG8_BAR;
#undef PG8_SA
#undef PG8_SB
#undef PG8_STAGE
#undef PG8_LDA
#undef PG8_LDB
#undef PG8_MMA
#undef PG8_WAIT_V
#undef PG8_WAIT_L
#undef PG8_BAR
#undef PG8_SCHED
}
}
constexpr int NWAVES = 8;
constexpr int M = 32768, DM = 1024, SEQ = 4096, NBATCH = 8, NLAYER = 4;
constexpr int NH = 8;
constexpr int IN_W = 6048;
constexpr int FFN = 2816, EXD = 3584, NEXP = 8;
constexpr float LN_EPS = 1e-5f, ALPHA = 1.681792830507429f;
constexpr int S5T = 32, S5CH = M / S5T  , S5K = 640, S5NC = SEQ / S5T  ;
constexpr int MOE_CAP = 65536;
constexpr int MOE_ROWS = 65536 + 8 * 256;

constexpr size_t MiB = 1u << 20;
constexpr size_t WS_CTL = 0, CTL_ZERO_BYTES = 1 * MiB;
constexpr size_t WS_WIN = 1 * MiB;
constexpr size_t WS_WG = 25 * MiB;
constexpr size_t WS_WUQ = 49 * MiB;
constexpr size_t WS_WUKV = 52 * MiB;
constexpr size_t WS_WLORA = 54 * MiB;
constexpr size_t WS_WVRES = 57 * MiB;
constexpr size_t WS_WGLU = 59 * MiB;
constexpr size_t WS_WBR = 61 * MiB;
constexpr size_t WS_WOUT = 73 * MiB;
constexpr size_t WS_WFGU = 81 * MiB;
constexpr size_t WS_WFD = 103 * MiB;
constexpr size_t WS_S5MAIN = 114 * MiB;
constexpr size_t WS_S5END = 134 * MiB;
constexpr size_t WS_S5A32 = 142 * MiB;
constexpr size_t WS_ROPE = 143 * MiB;
constexpr size_t WS_XB = 147 * MiB;
constexpr size_t WS_VFIRST = 211 * MiB;
constexpr size_t RB = 243 * MiB;
constexpr size_t WS_S5U = RB + 0;
constexpr size_t WS_S1 = RB + 40 * MiB;
constexpr size_t WS_MLARAW = WS_S1;
constexpr size_t WS_RWRAW = WS_S1 + 48 * MiB;
constexpr size_t WS_Q = WS_S1;
constexpr size_t WS_V = WS_S1 + 48 * MiB;
constexpr size_t WS_BV = WS_S1 + 80 * MiB;
constexpr size_t WS_DCY = WS_S1 + 112 * MiB;
constexpr size_t WS_YS5G = WS_S1;
constexpr size_t WS_YS5 = WS_S1 + 32 * MiB;
constexpr size_t WS_MIXED = WS_S1 + 64 * MiB;
constexpr size_t WS_R = RB + 200 * MiB;
constexpr size_t WS_KH = RB + 232 * MiB;
constexpr size_t WS_KKN = RB + 264 * MiB;
constexpr size_t WS_GL = RB + 296 * MiB;
constexpr size_t WS_GBUF = RB + 264 * MiB;
constexpr size_t WS_VFIN = RB + 328 * MiB;
constexpr size_t WS_K = RB + 360 * MiB;
constexpr size_t WS_VRAW = RB + 408 * MiB;
constexpr size_t WS_YRW = WS_VRAW;
constexpr size_t WS_S2 = RB + 440 * MiB;
constexpr size_t WS_CQN = WS_S2;
constexpr size_t WS_CKVN = WS_S2 + 24 * MiB;
constexpr size_t WS_LORAIN = WS_S2 + 40 * MiB;
constexpr size_t WS_YMLA = WS_S2;
constexpr size_t WS_XEND = RB + 496 * MiB;
constexpr size_t WS_GBUF2 = RB + 512 * MiB;
constexpr size_t WS_MIXED2 = RB + 576 * MiB;
constexpr size_t WS_HB = RB + 0;
constexpr size_t WS_WMGU = RB + 0;
constexpr size_t WS_YPAIR = RB + 0;
constexpr size_t WS_HM = RB + 132 * MiB;
constexpr size_t WS_WMD = RB + 594 * MiB;
constexpr size_t WS_SLOTTOK = RB + 650 * MiB;
constexpr size_t WS_SLOTW = RB + 652 * MiB;
constexpr size_t WS_PAIRPOS = RB + 654 * MiB;
constexpr size_t WS_END = RB + 655 * MiB;
constexpr int CW_BAR = 4096;
constexpr int CW_ATTN = 200000;
constexpr int CW_MOECNT = 201024;

constexpr int RING_OFF = 0, RING_BYTES = 131072;
constexpr int LDSCTL_OFF = RING_BYTES, MISC_OFF = LDSCTL_OFF + 320;
constexpr int LDS_BYTES = 147456;

#define GAS __attribute__((address_space(1)))
#define LAS __attribute__((address_space(3)))
typedef unsigned short bf16;
typedef _Float16 f16;
typedef f16 f16x8 __attribute__((ext_vector_type(8)));
typedef unsigned v4u __attribute__((ext_vector_type(4)));
typedef unsigned v2u __attribute__((ext_vector_type(2)));
typedef float f32x4 __attribute__((ext_vector_type(4)));
typedef float f32x16 __attribute__((ext_vector_type(16)));
typedef short bf16x8 __attribute__((ext_vector_type(8)));
typedef short s16x4 __attribute__((ext_vector_type(4)));
typedef GAS unsigned gu32;
#define RLX_AGENT __ATOMIC_RELAXED, __HIP_MEMORY_SCOPE_AGENT
#define LDS_WAIT() asm volatile("s_waitcnt lgkmcnt(0)" ::: "memory")
using pg8::cvt_pk_bf16; using pg8::pack8; using pg8::unpack8; using pg8::bf_lo; using pg8::bf_hi;

__device__ __forceinline__ float sigm(float x) { return __builtin_amdgcn_rcpf(1.0f + __expf(-x)); }
__device__ __forceinline__ float gelu_tanh(float y) { const float u = 0.7978845608028654f * (y + 0.044715f * y * y * y); const float t = 1.0f - 2.0f * __builtin_amdgcn_rcpf(__expf(2.0f * u) + 1.0f); return 0.5f * y * (1.0f + t); }
__device__ __forceinline__ float wave_sum(float v) {
#pragma unroll
    for (int o = 1; o < 64; o <<= 1) v += __shfl_xor(v, o);
    return v;
}
__device__ __forceinline__ v4u ld_nt16(const void* p) { return __builtin_nontemporal_load((const v4u*)p); }
__device__ __forceinline__ void f16x8_to_f32(const f16x8 h, float (&o)[8]) {
#pragma unroll
    for (int j = 0; j < 8; ++j) o[j] = (float)h[j];
}
__device__ __forceinline__ f16x8 f32_to_f16x8(const float (&v)[8]) { f16x8 h;
#pragma unroll
    for (int j = 0; j < 8; ++j) h[j] = (f16)v[j];
    return h; }
__device__ __forceinline__ void bf16x8_to_f32(const v4u w, float (&o)[8]) { o[0] = bf_lo(w.x); o[1] = bf_hi(w.x); o[2] = bf_lo(w.y); o[3] = bf_hi(w.y); o[4] = bf_lo(w.z); o[5] = bf_hi(w.z); o[6] = bf_lo(w.w); o[7] = bf_hi(w.w); }
__device__ __forceinline__ v4u f32_to_bf16x8(const float (&v)[8]) { v4u w; w.x = cvt_pk_bf16(v[0], v[1]); w.y = cvt_pk_bf16(v[2], v[3]); w.z = cvt_pk_bf16(v[4], v[5]); w.w = cvt_pk_bf16(v[6], v[7]); return w; }
__device__ __forceinline__ void ld8f(const float* p, float (&o)[8]) { const f32x4 a = *(const f32x4*)p, b = *(const f32x4*)(p + 4); o[0] = a[0]; o[1] = a[1]; o[2] = a[2]; o[3] = a[3]; o[4] = b[0]; o[5] = b[1]; o[6] = b[2]; o[7] = b[3]; }

#define XB_TMO      128
#define XB_XCNT(j)  (256  + 64 * (j))
#define XB_XSUB(j)  (1280 + 64 * (j))
#define XB_XGEN(j)  (2304 + 64 * (j))
#define XB_TOP      3328
#define XB_TOPGEN   3392
#define XCD_BAR_WORDS 3456
#define XB_SPIN_CAP (1u << 20)

__device__ __forceinline__ unsigned xb_ld(unsigned* p)              { return __hip_atomic_load(p, __ATOMIC_RELAXED, __HIP_MEMORY_SCOPE_AGENT); }
__device__ __forceinline__ unsigned xb_add(unsigned* p, unsigned v) { return __hip_atomic_fetch_add(p, v, __ATOMIC_RELAXED, __HIP_MEMORY_SCOPE_AGENT); }
__device__ __forceinline__ unsigned xb_xcc_id() { return (unsigned)__builtin_amdgcn_s_getreg((3 << 11) | 20) & 0xFu; }
#define XB_SPIN(cond, bar) do { unsigned _sp = 0; while (cond) { __builtin_amdgcn_s_sleep(1); \
    if ((++_sp & 255u) == 0u) { if (xb_ld(&(bar)[XB_TMO])) break; if (_sp > XB_SPIN_CAP) { atomicAdd(&(bar)[XB_TMO], 1u); break; } } } } while (0)

struct XcdBarrier { unsigned* bar; unsigned x; volatile LAS unsigned* st; };

__device__ __forceinline__ XcdBarrier xcd_barrier_post(unsigned* bar, volatile LAS unsigned* st) {
    XcdBarrier b; b.bar = bar; b.x = xb_xcc_id(); b.st = st;
    if (threadIdx.x == 0) (void)xb_add(&bar[XB_XCNT(b.x)], 1u);
    return b;
}
__device__ __forceinline__ void xcd_barrier_complete(unsigned* bar, unsigned x, unsigned& nloc, unsigned& nx) {
    const unsigned G = gridDim.x * gridDim.y * gridDim.z;
    unsigned sum, cnt, mine, sp = 0u;
    for (;;) {
        sum = 0u; cnt = 0u; mine = 0u;
#pragma unroll
        for (unsigned j = 0; j < 16; ++j) { const unsigned c = xb_ld(&bar[XB_XCNT(j)]); sum += c; cnt += (c > 0u) ? 1u : 0u; mine = (j == x) ? c : mine; }
        if (sum == G) break;
        __builtin_amdgcn_s_sleep(1);
        if ((++sp & 255u) == 0u) { if (xb_ld(&bar[XB_TMO])) break; if (sp > XB_SPIN_CAP) { atomicAdd(&bar[XB_TMO], 1u); break; } }
    }
    nloc = mine > 0u ? mine : 1u; nx = cnt > 0u ? cnt : 1u;
}
__device__ __forceinline__ void xcd_barrier(const XcdBarrier& b) {
    asm volatile("s_waitcnt vmcnt(0)" ::: "memory");
    __syncthreads();
    if (threadIdx.x == 0) {
        unsigned* bar = b.bar;
        __builtin_amdgcn_s_waitcnt(0);
        unsigned nloc = b.st[0], nx = b.st[1];
        if (nloc == 0u) { xcd_barrier_complete(bar, b.x, nloc, nx); b.st[0] = nloc; b.st[1] = nx; }
        const unsigned old = xb_add(&bar[XB_XSUB(b.x)], 1u);
        const unsigned gen = old / nloc;
        if (old + 1u == (gen + 1u) * nloc) {
            __builtin_amdgcn_fence(__ATOMIC_RELEASE, "agent");
            asm volatile("s_waitcnt vmcnt(0)" ::: "memory");
            const unsigned og = xb_add(&bar[XB_TOP], 1u);
            const unsigned tg = og / nx;
            if (og + 1u == (tg + 1u) * nx) xb_add(&bar[XB_TOPGEN], 1u);
            else XB_SPIN(xb_ld(&bar[XB_TOPGEN]) == tg, bar);
            __builtin_amdgcn_fence(__ATOMIC_ACQUIRE, "agent");
            xb_add(&bar[XB_XGEN(b.x)], 1u);
            asm volatile("s_waitcnt vmcnt(0)" ::: "memory");
        } else {
            XB_SPIN(xb_ld(&bar[XB_XGEN(b.x)]) == gen, bar);
            __builtin_amdgcn_fence(__ATOMIC_ACQUIRE, "agent");
            asm volatile("s_waitcnt vmcnt(0)" ::: "memory");
        }
    }
    __syncthreads();
}

struct Args { const void* in[44]; float* out; unsigned char* ws; int ph_lo, ph_hi, li, pad; };
typedef const __attribute__((address_space(4))) Args* KArgs;
struct Frame {
    LAS unsigned char* lds;
    unsigned char* ws;
    gu32* ctl;
    int tid, lane, wave;
    int G, blk;
    float* out;
    KArgs ka;
};
#define MKFRAME(F) Frame F; { int t_ = threadIdx.x; asm volatile("" : "+v"(t_)); KArgs k_ = (KArgs)__builtin_amdgcn_kernarg_segment_ptr(); asm volatile("" : "+s"(k_)); \
    F.lds = (LAS unsigned char*)lds_raw; F.ka = k_; F.ws = k_->ws; F.ctl = (gu32*)(k_->ws + WS_CTL); F.out = k_->out; F.tid = t_; F.lane = t_ & 63; F.wave = __builtin_amdgcn_readfirstlane(t_ >> 6); F.G = gridDim.x; F.blk = blockIdx.x; }
#define WSP(T, off) ((T*)(F.ws + (off)))
#define INP(T, i) ((const T*)F.ka->in[i])
using pg8::Unit; using pg8::Epi8; using pg8::EpiGU;
__device__ __forceinline__ void f4x2_to8(const f32x4 v0, const f32x4 v1, float (&o)[8]) { o[0] = v0[0]; o[1] = v0[1]; o[2] = v0[2]; o[3] = v0[3]; o[4] = v1[0]; o[5] = v1[1]; o[6] = v1[2]; o[7] = v1[3]; }

struct FProj {
    static constexpr int BATCH = 8; bf16* mla; bf16* rw; bf16* s5u;
    __device__ __forceinline__ void begin_col(const Unit&, int) {}
    typedef pg8::NoPre Pre; __device__ __forceinline__ Pre pre(const Unit&, int, int) const { return Pre{}; }
    __device__ __forceinline__ void tile8(const Unit&, int row, int col, const f32x4 v0, const f32x4 v1, const Pre&) const {
        const v4u w = pack8(v0, v1);
        if (col < 768) *(v4u*)(mla + (unsigned)row * 768 + col) = w;
        else if (col < 2560) *(v4u*)(rw + (unsigned)row * 1792 + (col - 768)) = w;
        else { const int c = col - 2560, g = c >> 4, i = c & 15; *(v4u*)(s5u + (unsigned)((g * S5CH + (row >> 5)) * S5K) + (row & 31) * 16 + i) = w; }
    }
};
struct FQup {
    static constexpr int BATCH = 4; bf16* Q; const float* cs; float qs;
    struct Pre { f32x4 c, s; };
    __device__ __forceinline__ void begin_col(const Unit&, int) {}
    __device__ __forceinline__ Pre pre(const Unit&, int row, int col) const { Pre p; const int head = col / 96, w = (col - head * 96) >> 3;
        if (w >= 8) { const int i0 = (w - 8) * 4; p.c = *(const f32x4*)(cs + (unsigned)row * 32 + i0); p.s = *(const f32x4*)(cs + (unsigned)row * 32 + 16 + i0); } else { p.c = (f32x4){0.f, 0.f, 0.f, 0.f}; p.s = p.c; } return p; }
    __device__ __forceinline__ void tile8(const Unit&, int row, int col, const f32x4 v0, const f32x4 v1, const Pre& p) const {
        const int head = col / 96, w = (col - head * 96) >> 3;
        bf16* q = Q + (unsigned)row * 768 + head * 96;
        if (w < 8) { *(v4u*)(q + 8 * w) = pack8(v0 * qs, v1 * qs); }
        else { const int i0 = (w - 8) * 4; const f32x4 c = p.c, s = p.s;
            const f32x4 x1 = (f32x4){v0[0], v0[2], v1[0], v1[2]}, x2 = (f32x4){v0[1], v0[3], v1[1], v1[3]};
            const f32x4 o1 = (x1 * c - x2 * s) * qs, o2 = (x1 * s + x2 * c) * qs;
            v2u a, b; a.x = cvt_pk_bf16(o1[0], o1[1]); a.y = cvt_pk_bf16(o1[2], o1[3]); b.x = cvt_pk_bf16(o2[0], o2[1]); b.y = cvt_pk_bf16(o2[2], o2[3]);
            *(v2u*)(q + 64 + i0) = a; *(v2u*)(q + 80 + i0) = b; }
    }
};
struct FKVup {
    static constexpr int BATCH = 8; bf16* K; bf16* V;
    __device__ __forceinline__ void begin_col(const Unit&, int) {}
    typedef pg8::NoPre Pre; __device__ __forceinline__ Pre pre(const Unit&, int, int) const { return Pre{}; }
    __device__ __forceinline__ void tile8(const Unit&, int row, int col, const f32x4 v0, const f32x4 v1, const Pre&) const {
        const int head = col >> 7, d = col & 127; const v4u w = pack8(v0, v1);
        if (d < 64) *(v4u*)(K + (unsigned)row * 768 + head * 96 + d) = w; else *(v4u*)(V + (unsigned)row * 512 + head * 64 + (d - 64)) = w;
    }
};
struct FLora {
    static constexpr int BATCH = 4;
    const float* w0; const float* a0; const float* k_a; f16* dcy; f16* kh; const f16* kkn; f16* bv; bf16* gl; float p[8], ka[8];
    struct Pre { f16x8 k, kn; };
    __device__ __forceinline__ void begin_col(const Unit&, int col) { const int seg = col >> 9, c = col & 511; ld8f(((seg == 0) ? w0 : a0) + c, p); ld8f(k_a + c, ka); }
    __device__ __forceinline__ Pre pre(const Unit&, int row, int col) const { Pre r; const unsigned off = (unsigned)row * 512 + (col & 511);
        if ((col >> 9) == 1) { r.k = *(const f16x8*)(kh + off); r.kn = *(const f16x8*)(kkn + off); } else { r.k = (f16x8)(0); r.kn = (f16x8)(0); } return r; }
    __device__ __forceinline__ void tile8(const Unit&, int row, int col, const f32x4 v0, const f32x4 v1, const Pre& pr) const {
        float a[8]; f4x2_to8(v0, v1, a);
        const int seg = col >> 9, c = col & 511; const unsigned off = (unsigned)row * 512 + c;
        if (seg == 0) { float o[8];
#pragma unroll
            for (int j = 0; j < 8; ++j) { const float e = 0.6065306597126334f * sigm(p[j] + a[j]); o[j] = -expm1f(-e); }
            *(f16x8*)(dcy + off) = f32_to_f16x8(o); }
        else if (seg == 1) { float k[8], kn[8]; f16x8_to_f32(pr.k, k); f16x8_to_f32(pr.kn, kn); float o1[8], o2[8];
#pragma unroll
            for (int j = 0; j < 8; ++j) { const float ic = sigm(p[j] + a[j]); o1[j] = k[j] * (1.0f + (ic - 1.0f) * ka[j]); o2[j] = kn[j] * ic; }
            *(f16x8*)(kh + off) = f32_to_f16x8(o1); *(f16x8*)(bv + off) = f32_to_f16x8(o2); }
        else { *(v4u*)(gl + off) = pack8(v0, v1); }
    }
};
struct FVres {
    static constexpr int BATCH = 4;
    const float* vb; const bf16* vraw; const bf16* vfirst; f16* vfin; float p[8];
    struct Pre { v4u v, vf; };
    __device__ __forceinline__ void begin_col(const Unit&, int col) { ld8f(vb + col, p); }
    __device__ __forceinline__ Pre pre(const Unit&, int row, int col) const { Pre r; const unsigned off = (unsigned)row * 512 + col; r.v = *(const v4u*)(vraw + off); r.vf = *(const v4u*)(vfirst + off); return r; }
    __device__ __forceinline__ void tile8(const Unit&, int row, int col, const f32x4 v0, const f32x4 v1, const Pre& pr) const {
        float a[8], v[8], vf[8], o[8]; f4x2_to8(v0, v1, a); const unsigned off = (unsigned)row * 512 + col;
        bf16x8_to_f32(pr.v, v); bf16x8_to_f32(pr.vf, vf);
#pragma unroll
        for (int j = 0; j < 8; ++j) o[j] = v[j] + (vf[j] - v[j]) * sigm(p[j] + a[j]);
        *(f16x8*)(vfin + off) = f32_to_f16x8(o);
    }
};
struct FS5End {
    static constexpr int BATCH = 8; float* xend;
    __device__ __forceinline__ void begin_col(const Unit&, int) {}
    typedef pg8::NoPre Pre; __device__ __forceinline__ Pre pre(const Unit&, int, int) const { return Pre{}; }
    __device__ __forceinline__ void tile8(const Unit& u, int row, int col, const f32x4 v0, const f32x4 v1, const Pre&) const {
        if (col < 128) { float* p = xend + (unsigned)((u.z * S5CH + row) * 128 + col); *(f32x4*)p = v0; *(f32x4*)(p + 4) = v1; }
    }
};
struct FS5Main {
    static constexpr int BATCH = 8;
    const bf16* s5u; const float* dvec; bf16* ys5g; float d[8];
    struct Pre { v4u uu; };
    __device__ __forceinline__ void begin_col(const Unit& u, int col) { ld8f(dvec + u.z * 16 + (col & 15), d); }
    __device__ __forceinline__ Pre pre(const Unit& u, int row, int col) const { Pre r; r.uu = *(const v4u*)(s5u + (unsigned)((u.z * S5CH + row) * S5K + col)); return r; }
    __device__ __forceinline__ void tile8(const Unit& u, int row, int col, const f32x4 v0, const f32x4 v1, const Pre& pr) const {
        float a[8], uu[8], o[8]; f4x2_to8(v0, v1, a); const int g = u.z, t = col >> 4, o0 = col & 15;
        bf16x8_to_f32(pr.uu, uu);
#pragma unroll
        for (int j = 0; j < 8; ++j) o[j] = gelu_tanh(a[j] + d[j] * uu[j]);
        *(v4u*)(ys5g + ((unsigned)row * 32 + t) * 512 + g * 16 + o0) = f32_to_bf16x8(o);
    }
};
struct FGlu {
    static constexpr int BATCH = 8;
    const bf16* ys5g; const float* bglu; bf16* ys5; float b[8];
    struct Pre { v4u y; };
    __device__ __forceinline__ void begin_col(const Unit&, int col) { ld8f(bglu + col, b); }
    __device__ __forceinline__ Pre pre(const Unit&, int row, int col) const { Pre r; r.y = *(const v4u*)(ys5g + (unsigned)row * 512 + col); return r; }
    __device__ __forceinline__ void tile8(const Unit&, int row, int col, const f32x4 v0, const f32x4 v1, const Pre& pr) const {
        float a[8], y[8], o[8]; f4x2_to8(v0, v1, a); const unsigned off = (unsigned)row * 512 + col; bf16x8_to_f32(pr.y, y);
#pragma unroll
        for (int j = 0; j < 8; ++j) o[j] = y[j] * sigm(a[j] + b[j]);
        *(v4u*)(ys5 + off) = f32_to_bf16x8(o);
    }
};
struct FGate {
    static constexpr int BATCH = 8; bf16* gbuf;
    __device__ __forceinline__ void begin_col(const Unit&, int) {}
    typedef pg8::NoPre Pre; __device__ __forceinline__ Pre pre(const Unit&, int, int) const { return Pre{}; }
    __device__ __forceinline__ void tile8(const Unit&, int row, int col, const f32x4 v0, const f32x4 v1, const Pre&) const {
        float a[8], o[8]; f4x2_to8(v0, v1, a);
#pragma unroll
        for (int j = 0; j < 8; ++j) o[j] = sigm(a[j]);
        *(v4u*)(gbuf + (unsigned)row * 1024 + col) = f32_to_bf16x8(o);
    }
};
struct FMerge {
    static constexpr int BATCH = 8; const bf16* gbuf; const bf16* min_; bf16* mout; int first; float scale;
    struct Pre { v4u g, m; };
    __device__ __forceinline__ void begin_col(const Unit&, int) {}
    __device__ __forceinline__ Pre pre(const Unit&, int row, int col) const { Pre r; const unsigned off = (unsigned)row * 1024 + col; r.g = *(const v4u*)(gbuf + off); if (!first) r.m = *(const v4u*)(min_ + off); else r.m = (v4u){0u, 0u, 0u, 0u}; return r; }
    __device__ __forceinline__ void tile8(const Unit&, int row, int col, const f32x4 v0, const f32x4 v1, const Pre& pr) const {
        float a[8], g[8], mprev[8], o[8]; f4x2_to8(v0, v1, a); const unsigned off = (unsigned)row * 1024 + col; bf16x8_to_f32(pr.g, g); bf16x8_to_f32(pr.m, mprev);
#pragma unroll
        for (int j = 0; j < 8; ++j) o[j] = mprev[j] + g[j] * a[j] * scale;
        *(v4u*)(mout + off) = f32_to_bf16x8(o);
    }
};
struct FResid {
    static constexpr int BATCH = 8; const float* xin; float* xout;
    struct Pre { f32x4 a, b; };
    __device__ __forceinline__ void begin_col(const Unit&, int) {}
    __device__ __forceinline__ Pre pre(const Unit&, int row, int col) const { Pre r; const unsigned off = (unsigned)row * 1024 + col; r.a = *(const f32x4*)(xin + off); r.b = *(const f32x4*)(xin + off + 4); return r; }
    __device__ __forceinline__ void tile8(const Unit&, int row, int col, const f32x4 v0, const f32x4 v1, const Pre& pr) const {
        const unsigned off = (unsigned)row * 1024 + col;
        *(f32x4*)(xout + off) = pr.a * ALPHA + v0; *(f32x4*)(xout + off + 4) = pr.b * ALPHA + v1;
    }
};
struct FSwiglu {
    bf16* h; int ldh;
    __device__ __forceinline__ void pair8(const Unit&, int row, int colh, const f32x4 g0, const f32x4 g1, const f32x4 u0, const f32x4 u1) const {
        float g[8], uu[8], o[8]; f4x2_to8(g0, g1, g); f4x2_to8(u0, u1, uu);
#pragma unroll
        for (int j = 0; j < 8; ++j) o[j] = g[j] * sigm(g[j]) * uu[j];
        *(v4u*)(h + (unsigned)row * ldh + colh) = f32_to_bf16x8(o);
    }
};
struct FMoeDown {
    static constexpr int BATCH = 8; bf16* ypair; const float* slotw; const unsigned* cnt;
    struct Pre { float w; };
    __device__ __forceinline__ void begin_col(const Unit&, int) {}
    __device__ __forceinline__ Pre pre(const Unit& u, int row, int) const { Pre r; const int rk = u.aux + (row - u.pm * 256); r.w = ((unsigned)rk < cnt[u.z]) ? slotw[(unsigned)(u.z * MOE_CAP + rk)] : 0.f; return r; }
    __device__ __forceinline__ void tile8(const Unit& u, int row, int col, const f32x4 v0, const f32x4 v1, const Pre& pr) const {
        const int rk = u.aux + (row - u.pm * 256);
        if ((unsigned)rk < cnt[u.z]) *(v4u*)(ypair + (unsigned)row * 1024 + col) = pack8(v0 * pr.w, v1 * pr.w);
    }
};

struct MoeOrder {
    int nN, G, c; int pt[NEXP + 1];
    __device__ void init(const unsigned* cnt, int nN_, int G_, int c_) { nN = nN_; G = G_; c = c_; pt[0] = 0;
#pragma unroll
        for (int e = 0; e < NEXP; ++e) pt[e + 1] = pt[e] + (int)((cnt[e] + 255u) >> 8); }
    __device__ bool next(int i, Unit& u) const {
        const long L = (long)i * G + c; if (L >= (long)pt[NEXP] * nN) return false;
        const int tile = (int)(L / nN); u.pn = (int)(L % nN); int e = 0;
#pragma unroll
        for (int k = 1; k < NEXP; ++k) e += (tile >= pt[k]) ? 1 : 0;
        int base = 0;
#pragma unroll
        for (int k = 1; k < NEXP; ++k) base = (tile >= pt[k]) ? pt[k] : base;
        u.z = e; u.pm = tile; u.aux = (tile - base) * 256; return true;
    }
};
struct LocMoe1 {
    static constexpr bool GATHER = true;
    const bf16* A; const bf16* Bt; int lda, ldb, K; const int* slot_tok; const unsigned* cnt;
    __device__ __forceinline__ const char* a_ptr(const Unit&) const { return (const char*)A; }
    __device__ __forceinline__ const char* b_ptr(const Unit& u) const { return (const char*)(Bt + (size_t)u.z * (2 * EXD) * DM + (size_t)u.pn * 256 * ldb); }
    __device__ __forceinline__ void a_off(const Unit& u, int tid, unsigned (&v)[2][2]) const {
        const unsigned n = cnt[u.z];
#pragma unroll
        for (int i = 0; i < 2; ++i) { int R, C; pg8::stage_rc(tid * 16 + i * 8192, R, C);
#pragma unroll
            for (int h = 0; h < 2; ++h) { const int r = u.aux + h * 128 + R; const int tok = ((unsigned)r < n) ? slot_tok[(unsigned)(u.z * MOE_CAP + r)] : 0; v[h][i] = (unsigned)(tok * lda + C) * 2u; } }
    }
};
__device__ __forceinline__ int qperm_row(int n) { const int h = n / 96, d = n - h * 96; if (d < 64) return n; const int e = d - 64; return h * 96 + 64 + ((e < 16) ? 2 * e : 2 * (e - 16) + 1); }
template <bool QPERM>
__device__ __forceinline__ void tr_item(const float* W, int ldw, int k0, int n0, const float* ksc, bf16* WT, int ldd, int kd0, int drow0, LAS float* scr, int lane) {
    if (W) {
#pragma unroll 8
        for (int i = 0; i < 32; ++i) { const int kk = 2 * i + (lane >> 5); float v = W[(size_t)(k0 + kk) * ldw + n0 + (lane & 31)]; if (ksc) v *= ksc[k0 + kk]; scr[kk * 33 + (lane & 31)] = v; }
    } else {
#pragma unroll 8
        for (int i = 0; i < 32; ++i) { const int kk = 2 * i + (lane >> 5); scr[kk * 33 + (lane & 31)] = 0.f; }
    }
    LDS_WAIT(); asm volatile("" ::: "memory");
    const int c = lane & 7;
#pragma unroll
    for (int j = 0; j < 4; ++j) { const int n = (lane >> 3) + 8 * j; const LAS float* s = scr + (8 * c) * 33 + n;
        v4u o; o.x = cvt_pk_bf16(s[0 * 33], s[1 * 33]); o.y = cvt_pk_bf16(s[2 * 33], s[3 * 33]); o.z = cvt_pk_bf16(s[4 * 33], s[5 * 33]); o.w = cvt_pk_bf16(s[6 * 33], s[7 * 33]);
        const int dr = QPERM ? qperm_row(n0 + n) : (drow0 + n);
        *(v4u*)(WT + (size_t)dr * ldd + kd0 + k0 + 8 * c) = o; }
    LDS_WAIT(); asm volatile("" ::: "memory");
}
#define TRJOB(r, W, ldw, K, c0, ncols, ksc, WT, ldd, drow0) { const int _nb = (ncols) / 32, _ni = ((K) / 64) * _nb; if ((r) < _ni) { const int _kb = (r) / _nb, _nbi = (r) % _nb; \
    tr_item<false>((W), (ldw), 64 * _kb, (c0) + 32 * _nbi, (ksc), (WT), (ldd), 0, (drow0) + 32 * _nbi, scr, lane); continue; } (r) -= _ni; }
#define TRJOB_GU(r, W, ldw, K, ncols, WT, ldd, up) { const int _nb = (ncols) / 32, _ni = ((K) / 64) * _nb; if ((r) < _ni) { const int _kb = (r) / _nb, _n0 = 32 * ((r) % _nb); \
    tr_item<false>((W), (ldw), 64 * _kb, _n0, nullptr, (WT), (ldd), 0, (_n0 >> 7) * 256 + (_n0 & 127) + ((up) ? 128 : 0), scr, lane); continue; } (r) -= _ni; }


__device__ __forceinline__ void p0_prologue(Frame& F) {
    LAS float* scr = (LAS float*)(F.lds + F.wave * 16384);
    const int lane = F.lane; const int gw = F.blk * NWAVES + F.wave, NGW = F.G * NWAVES;
    constexpr int PER_LAYER = 16 * 189 + 6 * 24 + 4 * 32 + 192 + 8 * 16 + 3 * 8 * 32 + 16 * 32 + 3 * 16;
    for (int it = gw; it < NLAYER * PER_LAYER; it += NGW) {
        const int l = it / PER_LAYER; int r = it % PER_LAYER;
        const float* win = INP(float, 2) + (size_t)l * DM * IN_W;
        bf16* win_t = WSP(bf16, WS_WIN) + (size_t)l * 3072 * DM; bf16* wg_t = WSP(bf16, WS_WG) + (size_t)l * 3072 * DM;
        TRJOB(r, win, IN_W, DM, 0, 672, nullptr, win_t, DM, 0);
        TRJOB(r, win, IN_W, DM, 672, 2304, nullptr, win_t, DM, 768);
        TRJOB(r, win, IN_W, DM, 2976, 3072, nullptr, wg_t, DM, 0);
        if (r < 48) { tr_item<false>(nullptr, 0, 64 * (r / 3), 0, nullptr, win_t, DM, 0, 672 + 32 * (r % 3), scr, lane); continue; } r -= 48;
        if (r < 144) { const int kb = r / 24, nbi = r % 24; tr_item<true>(INP(float, 4) + (size_t)l * 384 * 768, 768, 64 * kb, 32 * nbi, INP(float, 3) + l * 384, WSP(bf16, WS_WUQ) + (size_t)l * 768 * 384, 384, 0, 0, scr, lane); continue; } r -= 144;
        TRJOB(r, INP(float, 6) + (size_t)l * 256 * 1024, 1024, 256, 0, 1024, INP(float, 5) + l * 256, WSP(bf16, WS_WUKV) + (size_t)l * 1024 * 256, 256, 0);
        if (r < 192) { const int rb = r / 4, kb = r % 4; bf16* wl = WSP(bf16, WS_WLORA) + (size_t)l * 1536 * 256; const float* src = nullptr; int ldw = 512, k0 = 0, n0 = 0;
            if (rb < 16) { if (kb == 0) { src = INP(float, 9) + (size_t)l * 64 * 512; n0 = 32 * rb; } }
            else if (rb < 32) { if (kb == 1) { src = INP(float, 11) + (size_t)l * 64 * 512; n0 = 32 * (rb - 16); } }
            else { if (kb >= 2) { src = INP(float, 12) + (size_t)l * 128 * 512; k0 = 64 * (kb - 2); n0 = 32 * (rb - 32); } }
            tr_item<false>(src, ldw, k0, n0, nullptr, wl, 256, 64 * kb - k0, 32 * rb, scr, lane); continue; } r -= 192;
        TRJOB(r, INP(float, 29) + (size_t)l * 512 * 512, 512, 512, 0, 512, nullptr, WSP(bf16, WS_WGLU) + (size_t)l * 512 * 512, 512, 0);
        TRJOB(r, INP(float, 31) + (size_t)(l * 3 + 0) * 512 * 1024, 1024, 512, 0, 1024, nullptr, WSP(bf16, WS_WBR) + (size_t)(l * 3 + 0) * 1024 * 512, 512, 0);
        TRJOB(r, INP(float, 31) + (size_t)(l * 3 + 1) * 512 * 1024, 1024, 512, 0, 1024, nullptr, WSP(bf16, WS_WBR) + (size_t)(l * 3 + 1) * 1024 * 512, 512, 0);
        TRJOB(r, INP(float, 31) + (size_t)(l * 3 + 2) * 512 * 1024, 1024, 512, 0, 1024, nullptr, WSP(bf16, WS_WBR) + (size_t)(l * 3 + 2) * 1024 * 512, 512, 0);
        TRJOB(r, INP(float, 32) + (size_t)l * DM * DM, DM, DM, 0, DM, nullptr, WSP(bf16, WS_WOUT) + (size_t)l * DM * DM, DM, 0);
    }
    constexpr int PER_FFN = 3 * 16 * 88;
    for (int it = gw; it < 2 * PER_FFN; it += NGW) {
        const int i = it / PER_FFN; int r = it % PER_FFN;
        TRJOB_GU(r, INP(float, 37) + (size_t)i * DM * FFN, FFN, DM, FFN, WSP(bf16, WS_WFGU) + (size_t)i * 2 * FFN * DM, DM, 0);
        TRJOB_GU(r, INP(float, 38) + (size_t)i * DM * FFN, FFN, DM, FFN, WSP(bf16, WS_WFGU) + (size_t)i * 2 * FFN * DM, DM, 1);
        TRJOB(r, INP(float, 39) + (size_t)i * FFN * DM, DM, FFN, 0, DM, nullptr, WSP(bf16, WS_WFD) + (size_t)i * DM * FFN, FFN, 0);
    }
    for (int it = F.blk * 512 + F.tid; it < 3 * 512 * 64; it += F.G * 512) {
        const int i = it / (512 * 64), rem = it % (512 * 64), n = rem >> 6, k0 = (rem & 63) * 8;
        const float* vd = INP(float, 18) + (size_t)i * 512 * 32; const float* vu = INP(float, 19) + (size_t)i * 32 * 512; float o[8];
#pragma unroll
        for (int j = 0; j < 8; ++j) o[j] = 0.f;
        for (int rr = 0; rr < 32; ++rr) { const float u = vu[rr * 512 + n];
#pragma unroll
            for (int j = 0; j < 8; ++j) o[j] += vd[(k0 + j) * 32 + rr] * u; }
        *(v4u*)(WSP(bf16, WS_WVRES) + (size_t)i * 512 * 512 + (size_t)n * 512 + k0) = f32_to_bf16x8(o);
    }
    for (int it = F.blk * 512 + F.tid; it < M * 16; it += F.G * 512) {
        const int m = it >> 4, i = it & 15; const float inv = powf(10000.0f, -(float)i * (1.0f / 16.0f)); const float ang = (float)INP(int, 1)[m] * inv;
        float sn, cn; sincosf(ang, &sn, &cn); float* cs = WSP(float, WS_ROPE) + (size_t)m * 32; cs[i] = cn; cs[16 + i] = sn;
    }
}
__device__ __forceinline__ void moe_convert(Frame& F, int li) {
    LAS float* scr = (LAS float*)(F.lds + F.wave * 16384);
    const int lane = F.lane; const int gw = F.blk * NWAVES + F.wave, NGW = F.G * NWAVES;
    constexpr int PER_E = 2 * 16 * 112 + 56 * 32;
    for (int it = gw; it < NEXP * PER_E; it += NGW) {
        const int e = it / PER_E; int r = it % PER_E; const size_t wi = (size_t)(li * NEXP + e);
        TRJOB_GU(r, INP(float, 41) + wi * DM * EXD, EXD, DM, EXD, WSP(bf16, WS_WMGU) + (size_t)e * 2 * EXD * DM, DM, 0);
        TRJOB_GU(r, INP(float, 42) + wi * DM * EXD, EXD, DM, EXD, WSP(bf16, WS_WMGU) + (size_t)e * 2 * EXD * DM, DM, 1);
        TRJOB(r, INP(float, 43) + wi * EXD * DM, DM, EXD, 0, DM, nullptr, WSP(bf16, WS_WMD) + (size_t)e * DM * EXD, EXD, 0);
    }
}

__device__ __forceinline__ void ph2_prep(Frame& F, int l) {
    const int lane = F.lane; const int gw = F.blk * NWAVES + F.wave, NGW = F.G * NWAVES;
    const bf16* rwraw = WSP(bf16, WS_RWRAW); const bf16* mlaraw = WSP(bf16, WS_MLARAW);
    const float* mu = INP(float, 7) + l * 1792; const float* k_k = INP(float, 13) + l * 512;
    float mu_r[8], mu_k[8], mu_v[8], mu_t[8], kk8[8];
    ld8f(mu + 8 * lane, mu_r); ld8f(mu + 512 + 8 * lane, mu_k); ld8f(mu + 1024 + 8 * lane, mu_v); ld8f(mu + 1536 + 8 * (lane & 31), mu_t); ld8f(k_k + 8 * lane, kk8);
    const float* cs_all = WSP(float, WS_ROPE);
    for (int m = gw; m < M; m += NGW) {
        const int s = m & (SEQ - 1);
        const bf16* cur = rwraw + (size_t)m * 1792; const bf16* prv = cur - 1792;
        float c[8], p[8], o[8];
        bf16x8_to_f32(*(const v4u*)(cur + 8 * lane), c); if (s) bf16x8_to_f32(*(const v4u*)(prv + 8 * lane), p); else {
#pragma unroll
            for (int j = 0; j < 8; ++j) p[j] = 0.f; }
#pragma unroll
        for (int j = 0; j < 8; ++j) o[j] = c[j] + (p[j] - c[j]) * mu_r[j];
        *(f16x8*)(WSP(f16, WS_R) + (size_t)m * 512 + 8 * lane) = f32_to_f16x8(o);
        bf16x8_to_f32(*(const v4u*)(cur + 512 + 8 * lane), c); if (s) bf16x8_to_f32(*(const v4u*)(prv + 512 + 8 * lane), p);
        float ss = 0.f;
#pragma unroll
        for (int j = 0; j < 8; ++j) { o[j] = c[j] + (p[j] - c[j]) * mu_k[j]; const float q = o[j] * kk8[j]; ss += q * q; }
        *(f16x8*)(WSP(f16, WS_KH) + (size_t)m * 512 + 8 * lane) = f32_to_f16x8(o);
        ss += __shfl_xor(ss, 1); ss += __shfl_xor(ss, 2); ss += __shfl_xor(ss, 4);
        { const float rn = 1.0f / fmaxf(sqrtf(ss), 1e-12f);
#pragma unroll
          for (int j = 0; j < 8; ++j) o[j] = o[j] * kk8[j] * rn; }
        *(f16x8*)(WSP(f16, WS_KKN) + (size_t)m * 512 + 8 * lane) = f32_to_f16x8(o);
        bf16x8_to_f32(*(const v4u*)(cur + 1024 + 8 * lane), c); if (s) bf16x8_to_f32(*(const v4u*)(prv + 1024 + 8 * lane), p);
#pragma unroll
        for (int j = 0; j < 8; ++j) o[j] = c[j] + (p[j] - c[j]) * mu_v[j];
        { const v4u vb = f32_to_bf16x8(o); *(v4u*)(WSP(bf16, WS_VRAW) + (size_t)m * 512 + 8 * lane) = vb;
          if (l == 0) { *(v4u*)(WSP(bf16, WS_VFIRST) + (size_t)m * 512 + 8 * lane) = vb; *(f16x8*)(WSP(f16, WS_VFIN) + (size_t)m * 512 + 8 * lane) = f32_to_f16x8(o); } }
        if (lane < 32) {
            bf16x8_to_f32(*(const v4u*)(cur + 1536 + 8 * lane), c); if (s) bf16x8_to_f32(*(const v4u*)(prv + 1536 + 8 * lane), p);
#pragma unroll
            for (int j = 0; j < 8; ++j) { float v = c[j] + (p[j] - c[j]) * mu_t[j]; if (lane < 8) v = 1.0f - 2.0f * __builtin_amdgcn_rcpf(__expf(2.0f * v) + 1.0f); else if (lane >= 16) v = sigm(v); o[j] = v; }
            *(v4u*)(WSP(bf16, WS_LORAIN) + (size_t)m * 256 + 8 * lane) = f32_to_bf16x8(o);
        }
        const bf16* mr = mlaraw + (size_t)m * 768; float a8[8], b8[8];
        bf16x8_to_f32(*(const v4u*)(mr + 8 * lane), a8); float ssa = 0.f, ssb = 0.f;
#pragma unroll
        for (int j = 0; j < 8; ++j) ssa += a8[j] * a8[j];
        if (lane < 32) { bf16x8_to_f32(*(const v4u*)(mr + 512 + 8 * lane), b8);
#pragma unroll
            for (int j = 0; j < 8; ++j) ssb += b8[j] * b8[j]; } else {
#pragma unroll
            for (int j = 0; j < 8; ++j) b8[j] = 0.f; }
        const float sq = wave_sum(lane < 48 ? ssa : 0.f), skv = wave_sum((lane >= 48 ? ssa : 0.f) + (lane < 16 ? ssb : 0.f));
        const float rq = 1.0f / sqrtf(sq * (1.0f / 384.0f) + 1e-6f), rkv = 1.0f / sqrtf(skv * (1.0f / 256.0f) + 1e-6f);
        if (lane < 48) {
#pragma unroll
            for (int j = 0; j < 8; ++j) o[j] = a8[j] * rq;
            *(v4u*)(WSP(bf16, WS_CQN) + (size_t)m * 384 + 8 * lane) = f32_to_bf16x8(o);
        } else {
#pragma unroll
            for (int j = 0; j < 8; ++j) o[j] = a8[j] * rkv;
            *(v4u*)(WSP(bf16, WS_CKVN) + (size_t)m * 256 + 8 * (lane - 48)) = f32_to_bf16x8(o);
        }
        if (lane < 16) {
#pragma unroll
            for (int j = 0; j < 8; ++j) o[j] = b8[j] * rkv;
            *(v4u*)(WSP(bf16, WS_CKVN) + (size_t)m * 256 + 128 + 8 * lane) = f32_to_bf16x8(o);
        }
        float pr[8];
#pragma unroll
        for (int j = 0; j < 8; ++j) pr[j] = __shfl_xor(b8[j], 2);
        if (lane >= 16 && lane < 20) { const int i0 = 8 * (lane & 1); const float* cs = cs_all + (size_t)m * 32; float cc[8], sn[8]; ld8f(cs + i0, cc); ld8f(cs + 16 + i0, sn);
            const bool lo = lane < 18;
#pragma unroll
            for (int j = 0; j < 8; ++j) o[j] = lo ? (b8[j] * cc[j] - pr[j] * sn[j]) : (pr[j] * sn[j] + b8[j] * cc[j]);
            const v4u w = f32_to_bf16x8(o); bf16* kd = WSP(bf16, WS_K) + (size_t)m * 768 + 64 + (lo ? 0 : 16) + i0;
#pragma unroll
            for (int h = 0; h < NH; ++h) *(v4u*)(kd + h * 96) = w; }
    }
    if (F.blk < 256) {
        __syncthreads();
        const int g = F.blk >> 3, s8 = F.blk & 7, tid = F.tid;
        LAS float* pw = (LAS float*)F.lds;
        LAS float* Bb = pw + 33 * 64 * 2;
        LAS float* Cc = Bb + 64 * 16 * 2;
        LAS float* Kt = Cc + 16 * 64 * 2;
        const float dt = expf(INP(float, 23)[l * 32 + g]);
        const float* are = INP(float, 21) + (size_t)(l * 32 + g) * 64; const float* aim = INP(float, 22) + (size_t)(l * 32 + g) * 64;
        for (int e = tid; e < 33 * 64; e += 512) { const int n = e >> 6, p = e & 63; const float lr = fminf(are[p], -1e-4f), li = aim[p];
            const float mag = expf((float)n * (dt * lr)); float sn, cn; sincosf((float)n * (dt * li), &sn, &cn); pw[2 * e] = mag * cn; pw[2 * e + 1] = mag * sn; }
        for (int e = tid; e < 64 * 16; e += 512) { const int p = e >> 4; const float lr = fminf(are[p], -1e-4f), li = aim[p];
            const float mag = expf(dt * lr); float sn, cn; sincosf(dt * li, &sn, &cn); const float abr = mag * cn, abi = mag * sn, den = lr * lr + li * li;
            const float fr = ((abr - 1.0f) * lr + abi * li) / den, fi = (abi * lr - (abr - 1.0f) * li) / den;
            const float br = INP(float, 24)[(size_t)(l * 32 + g) * 1024 + e], bi = INP(float, 25)[(size_t)(l * 32 + g) * 1024 + e];
            Bb[2 * e] = fr * br - fi * bi; Bb[2 * e + 1] = fr * bi + fi * br; }
        for (int e = tid; e < 16 * 64; e += 512) { Cc[2 * e] = INP(float, 26)[(size_t)(l * 32 + g) * 1024 + e]; Cc[2 * e + 1] = INP(float, 27)[(size_t)(l * 32 + g) * 1024 + e]; }
        __syncthreads();
        { const int tau = tid >> 4, o = tid & 15; float acc[16];
#pragma unroll
          for (int i = 0; i < 16; ++i) acc[i] = 0.f;
          for (int p = 0; p < 64; ++p) { const float cr = Cc[2 * (o * 64 + p)], ci = Cc[2 * (o * 64 + p) + 1], pr_ = pw[2 * (tau * 64 + p)], pi_ = pw[2 * (tau * 64 + p) + 1];
              const float xr = cr * pr_ - ci * pi_, xi = cr * pi_ + ci * pr_;
#pragma unroll
              for (int i = 0; i < 16; ++i) acc[i] += xr * Bb[2 * (p * 16 + i)] - xi * Bb[2 * (p * 16 + i) + 1]; }
#pragma unroll
          for (int i = 0; i < 16; ++i) Kt[(tau * 16 + o) * 16 + i] = acc[i]; }
        __syncthreads();
        bf16* bm = WSP(bf16, WS_S5MAIN) + (size_t)g * 512 * S5K;
        for (int e = tid; e < 64 * 80; e += 512) { const int n = 64 * s8 + e / 80, k0 = (e % 80) * 8, t = n >> 4, o = n & 15; float v[8];
            if (k0 < 512) { const int sidx = k0 >> 4, i0 = k0 & 15;
#pragma unroll
                for (int j = 0; j < 8; ++j) v[j] = (sidx <= t) ? Kt[((t - sidx) * 16 + o) * 16 + i0 + j] : 0.f; }
            else {
#pragma unroll
                for (int j = 0; j < 8; ++j) { const int q = k0 - 512 + j, p = q & 63; const float cr = Cc[2 * (o * 64 + p)], ci = Cc[2 * (o * 64 + p) + 1], pr_ = pw[2 * ((t + 1) * 64 + p)], pi_ = pw[2 * ((t + 1) * 64 + p) + 1];
                    v[j] = (q < 64) ? (cr * pr_ - ci * pi_) : -(cr * pi_ + ci * pr_); } }
            *(v4u*)(bm + (size_t)n * S5K + k0) = f32_to_bf16x8(v); }
        bf16* be = WSP(bf16, WS_S5END) + (size_t)g * 256 * 512;
        for (int e = tid; e < 32 * 64; e += 512) { const int n = 32 * s8 + e / 64, k0 = (e % 64) * 8, sidx = k0 >> 4, i0 = k0 & 15; float v[8];
            if (n < 128) { const int p = n & 63; const float pr_ = pw[2 * ((31 - sidx) * 64 + p)], pi_ = pw[2 * ((31 - sidx) * 64 + p) + 1];
#pragma unroll
                for (int j = 0; j < 8; ++j) { const float br = Bb[2 * (p * 16 + i0 + j)], bi = Bb[2 * (p * 16 + i0 + j) + 1]; v[j] = (n < 64) ? (pr_ * br - pi_ * bi) : (pr_ * bi + pi_ * br); } }
            else {
#pragma unroll
                for (int j = 0; j < 8; ++j) v[j] = 0.f; }
            *(v4u*)(be + (size_t)n * 512 + k0) = f32_to_bf16x8(v); }
        if (s8 == 0 && tid < 64) { float* a32 = WSP(float, WS_S5A32) + (size_t)(g * 64 + tid) * 2; a32[0] = pw[2 * (32 * 64 + tid)]; a32[1] = pw[2 * (32 * 64 + tid) + 1]; }
        __syncthreads();
    }
}

__device__ __forceinline__ void ln_core(f32x4 (&v)[4], const float* gam, const float* bet, int lane) {
    float s = 0.f;
#pragma unroll
    for (int j = 0; j < 4; ++j) s += (v[j][0] + v[j][1]) + (v[j][2] + v[j][3]);
    const float mean = wave_sum(s) * (1.f / DM); float s2 = 0.f;
#pragma unroll
    for (int j = 0; j < 4; ++j) { v[j] = v[j] - mean; s2 += (v[j][0] * v[j][0] + v[j][1] * v[j][1]) + (v[j][2] * v[j][2] + v[j][3] * v[j][3]); }
    const float rstd = 1.f / sqrtf(wave_sum(s2) * (1.f / DM) + LN_EPS);
#pragma unroll
    for (int j = 0; j < 4; ++j) { const f32x4 g4 = *(const f32x4*)(gam + 4 * lane + 256 * j), b4 = *(const f32x4*)(bet + 4 * lane + 256 * j); v[j] = v[j] * rstd * g4 + b4; }
}
__device__ __forceinline__ void ln_store(const f32x4 (&v)[4], float* xrow, bf16* xbrow, int lane) {
#pragma unroll
    for (int j = 0; j < 4; ++j) { *(f32x4*)(xrow + 4 * lane + 256 * j) = v[j]; v2u w; w.x = cvt_pk_bf16(v[j][0], v[j][1]); w.y = cvt_pk_bf16(v[j][2], v[j][3]); *(v2u*)(xbrow + 4 * lane + 256 * j) = w; }
}
__device__ __forceinline__ void ln_phase(Frame& F, const float* gam, const float* bet) {
    const int lane = F.lane; const int gw = F.blk * NWAVES + F.wave, NGW = F.G * NWAVES; float* X = F.out; bf16* Xb = WSP(bf16, WS_XB);
    for (int m = gw; m < M; m += NGW) { f32x4 v[4];
#pragma unroll
        for (int j = 0; j < 4; ++j) v[j] = *(const f32x4*)(X + (size_t)m * DM + 4 * lane + 256 * j);
        ln_core(v, gam, bet, lane); ln_store(v, X + (size_t)m * DM, Xb + (size_t)m * DM, lane); }
}
__device__ __forceinline__ void ln2_moe_phase(Frame& F, const float* gam, const float* bet, int li) {
    const int lane = F.lane; const int gw = F.blk * NWAVES + F.wave, NGW = F.G * NWAVES; float* X = F.out; bf16* Xb = WSP(bf16, WS_XB);
    const unsigned* cnt = (const unsigned*)(F.ctl + CW_MOECNT + 64 * li); int pstart[NEXP]; { int acc = 0;
#pragma unroll
        for (int e = 0; e < NEXP; ++e) { pstart[e] = acc; acc += (int)(((cnt[e] + 255u) >> 8) << 8); } }
    const int* ppos = WSP(int, WS_PAIRPOS); const bf16* yp = WSP(bf16, WS_YPAIR);
    for (int m = gw; m < M; m += NGW) { f32x4 v[4];
        const int p0 = ppos[2 * m], p1 = ppos[2 * m + 1]; int r0 = 0, r1 = 0;
#pragma unroll
        for (int e = 0; e < NEXP; ++e) { if ((p0 >> 24) == e) r0 = pstart[e] + (p0 & 0xffffff); if ((p1 >> 24) == e) r1 = pstart[e] + (p1 & 0xffffff); }
#pragma unroll
        for (int j = 0; j < 4; ++j) { const f32x4 x = *(const f32x4*)(X + (size_t)m * DM + 4 * lane + 256 * j);
            const v2u a = *(const v2u*)(yp + (size_t)r0 * DM + 4 * lane + 256 * j), b = *(const v2u*)(yp + (size_t)r1 * DM + 4 * lane + 256 * j);
            v[j] = x * ALPHA + (f32x4){bf_lo(a.x) + bf_lo(b.x), bf_hi(a.x) + bf_hi(b.x), bf_lo(a.y) + bf_lo(b.y), bf_hi(a.y) + bf_hi(b.y)}; }
        ln_core(v, gam, bet, lane); ln_store(v, X + (size_t)m * DM, Xb + (size_t)m * DM, lane); }
}
__device__ __forceinline__ void ln1_moe_phase(Frame& F, const float* gam, const float* bet, int li) {
    const int lane = F.lane; float* X = F.out; bf16* Xb = WSP(bf16, WS_XB);
    LAS int* pe = (LAS int*)F.lds;
    LAS float* pwt = (LAS float*)(F.lds + 1024);
    LAS int* cntl = (LAS int*)(F.lds + 2048);
    const float* router = INP(float, 40) + (size_t)li * DM * NEXP;
    for (int blk0 = F.blk; blk0 * 128 < M; blk0 += F.G) {
        __syncthreads();
        for (int i = 0; i < 16; ++i) { const int tl = F.wave * 16 + i, m = blk0 * 128 + tl; f32x4 v[4];
#pragma unroll
            for (int j = 0; j < 4; ++j) v[j] = *(const f32x4*)(X + (size_t)m * DM + 4 * lane + 256 * j);
            ln_core(v, gam, bet, lane); ln_store(v, X + (size_t)m * DM, Xb + (size_t)m * DM, lane);
            float lg[NEXP];
#pragma unroll
            for (int e = 0; e < NEXP; ++e) lg[e] = 0.f;
#pragma unroll
            for (int j = 0; j < 4; ++j)
#pragma unroll
                for (int q = 0; q < 4; ++q) { const float xv = v[j][q]; const float* rr = router + (size_t)(4 * lane + 256 * j + q) * NEXP; const f32x4 ra = *(const f32x4*)rr, rb = *(const f32x4*)(rr + 4);
                    lg[0] += xv * ra[0]; lg[1] += xv * ra[1]; lg[2] += xv * ra[2]; lg[3] += xv * ra[3]; lg[4] += xv * rb[0]; lg[5] += xv * rb[1]; lg[6] += xv * rb[2]; lg[7] += xv * rb[3]; }
#pragma unroll
            for (int e = 0; e < NEXP; ++e) lg[e] = wave_sum(lg[e]);
            int e0 = 0; float l0 = lg[0];
#pragma unroll
            for (int e = 1; e < NEXP; ++e) if (lg[e] > l0) { l0 = lg[e]; e0 = e; }
            int e1 = -1; float l1 = -INFINITY;
#pragma unroll
            for (int e = 0; e < NEXP; ++e) if (e != e0 && lg[e] > l1) { l1 = lg[e]; e1 = e; }
            const float w1 = 1.0f / (1.0f + expf(l0 - l1)), w0 = 1.0f - w1;
            if (lane == 0) { pe[2 * tl] = e0; pe[2 * tl + 1] = e1; pwt[2 * tl] = w0; pwt[2 * tl + 1] = w1; }
        }
        __syncthreads();
        int myrank = 0, mye = 0;
        if (F.tid < 256) { mye = pe[F.tid]; for (int q = 0; q < F.tid; ++q) myrank += (pe[q] == mye) ? 1 : 0; }
#ifdef PROBE_ORDERED
        if (F.tid == 0) { unsigned sp = 0; while (__hip_atomic_load((unsigned*)(F.ctl + CW_MOECNT + 64 * li + 32), RLX_AGENT) != (unsigned)blk0 && ++sp < (1u << 22)) __builtin_amdgcn_s_sleep(2); }
        __syncthreads();
#endif
        if (F.tid < NEXP) { int c = 0; for (int q = 0; q < 256; ++q) c += (pe[q] == F.tid) ? 1 : 0; cntl[F.tid] = c;
            cntl[8 + F.tid] = (int)__hip_atomic_fetch_add((unsigned*)(F.ctl + CW_MOECNT + 64 * li + F.tid), (unsigned)c, RLX_AGENT); }
#ifdef PROBE_ORDERED
        __syncthreads();
        if (F.tid == 0) { asm volatile("s_waitcnt vmcnt(0)" ::: "memory"); __hip_atomic_fetch_add((unsigned*)(F.ctl + CW_MOECNT + 64 * li + 32), 1u, RLX_AGENT); }
#endif
        __syncthreads();
        if (F.tid < 256) { const int rk = cntl[8 + mye] + myrank; const int m = blk0 * 128 + (F.tid >> 1);
            WSP(int, WS_SLOTTOK)[(size_t)mye * MOE_CAP + rk] = m; WSP(float, WS_SLOTW)[(size_t)mye * MOE_CAP + rk] = pwt[F.tid]; WSP(int, WS_PAIRPOS)[blk0 * 256 + F.tid] = (mye << 24) | rk; }
    }
    __syncthreads();
}
constexpr int AT_KS = 208, AT_VS = 192;
constexpr int AT_KB = 64 * AT_KS, AT_VB = 64 * AT_VS, AT_STAGE = AT_KB + AT_VB;
constexpr int AT_WSF = 2 * AT_STAGE, AT_OST = AT_WSF + NWAVES * 256, AT_LDS = AT_OST + NWAVES * 4096;
__device__ __forceinline__ int crow(int r, int hi) { return (r & 3) + 8 * (r >> 2) + 4 * hi; }

__device__ __forceinline__ void attn_unit(int tid, int b, int h, int qb, const bf16* Q, const bf16* K, const bf16* V, bf16* O, LAS unsigned char* lds) {
    const int lane = tid & 63, r32 = lane & 31, hi = lane >> 5; const int wid = __builtin_amdgcn_readfirstlane(tid >> 6);
    const size_t rowbase = (size_t)b * SEQ; const int q0 = qb * 256;
    bf16x8 qr[6];
    { const bf16* qp = Q + (rowbase + q0 + wid * 32 + r32) * 768 + h * 96 + hi * 8;
#pragma unroll
      for (int d0 = 0; d0 < 6; ++d0) qr[d0] = *(const bf16x8*)(qp + d0 * 16); }
    const int kp0 = tid, kp1 = 512 + tid;
    const bf16* kg0 = K + (rowbase + kp0 / 12) * 768 + h * 96 + (kp0 % 12) * 8;
    const bf16* kg1 = K + (rowbase + kp1 / 12) * 768 + h * 96 + (kp1 % 12) * 8;
    const bf16* vg = V + (rowbase + (tid >> 3)) * 512 + h * 64 + (tid & 7) * 8;
    const int kl0 = (kp0 / 12) * AT_KS + (kp0 % 12) * 16, kl1 = (kp1 / 12) * AT_KS + (kp1 % 12) * 16, vl = (tid >> 3) * AT_VS + (tid & 7) * 16;
    const bool two = tid < 256;
    const int NT = 4 * (qb + 1);
    v4u ka, kb2, va;
    ka = *(const v4u*)kg0; if (two) kb2 = *(const v4u*)kg1; va = *(const v4u*)vg;
    *(LAS v4u*)(lds + kl0) = ka; if (two) *(LAS v4u*)(lds + kl1) = kb2; *(LAS v4u*)(lds + AT_KB + vl) = va;
    LAS float* wsf = (LAS float*)(lds + AT_WSF) + wid * 64;
    float m_run = -1e30f, l_run = 0.f; f32x16 o[2];
#pragma unroll
    for (int r = 0; r < 16; ++r) { o[0][r] = 0.f; o[1][r] = 0.f; }
    const int kfo = r32 * AT_KS + hi * 16;
    const int vfo = (4 * hi + ((lane & 15) >> 2)) * AT_VS + ((lane >> 4) & 1) * 32 + (lane & 3) * 8;
    const int qrel = wid * 32 + r32;
    __syncthreads();
    for (int t = 0; t < NT; ++t) {
        const int cur = (t & 1) * AT_STAGE, nxt = ((t + 1) & 1) * AT_STAGE; const bool more = (t + 1 < NT);
        if (more) { const size_t go = (size_t)(t + 1) * 64 * 768; ka = *(const v4u*)(kg0 + go); if (two) kb2 = *(const v4u*)(kg1 + go); va = *(const v4u*)(vg + (size_t)(t + 1) * 64 * 512); }
        const int jb = t - (NT - 4);
        if (jb < 0 || 64 * jb <= 32 * wid + 31) {
            f32x16 p0, p1;
#pragma unroll
            for (int r = 0; r < 16; ++r) { p0[r] = 0.f; p1[r] = 0.f; }
#pragma unroll
            for (int d0 = 0; d0 < 6; ++d0) { const bf16x8 k0 = *(const LAS bf16x8*)(lds + cur + kfo + d0 * 32), k1 = *(const LAS bf16x8*)(lds + cur + kfo + 32 * AT_KS + d0 * 32);
                p0 = __builtin_amdgcn_mfma_f32_32x32x16_bf16(k0, qr[d0], p0, 0, 0, 0); p1 = __builtin_amdgcn_mfma_f32_32x32x16_bf16(k1, qr[d0], p1, 0, 0, 0); }
            if (jb >= 0) { const int kb = 64 * jb + 4 * hi;
#pragma unroll
                for (int r = 0; r < 16; ++r) { const int kv = kb + (r & 3) + 8 * (r >> 2); if (kv > qrel) p0[r] = -INFINITY; if (kv + 32 > qrel) p1[r] = -INFINITY; } }
            float rm = fmaxf(p0[0], p1[0]);
#pragma unroll
            for (int r = 1; r < 16; ++r) rm = fmaxf(rm, fmaxf(p0[r], p1[r]));
            rm = fmaxf(rm, __shfl_xor(rm, 32));
            const float mnew = fmaxf(m_run, rm), alpha = __builtin_amdgcn_exp2f(m_run - mnew);
            float ps = 0.f;
#pragma unroll
            for (int r = 0; r < 16; ++r) { p0[r] = __builtin_amdgcn_exp2f(p0[r] - mnew); p1[r] = __builtin_amdgcn_exp2f(p1[r] - mnew); ps += p0[r] + p1[r]; }
            l_run = l_run * alpha + ps;
            if (__any(mnew > m_run)) {
                if (hi == 0) wsf[r32] = alpha;
                LDS_WAIT();
#pragma unroll
                for (int r = 0; r < 16; ++r) { const float f = wsf[crow(r, hi)]; o[0][r] *= f; o[1][r] *= f; }
            }
            m_run = mnew;
            bf16x8 pa[4];
            { v4u w;
              w.x = cvt_pk_bf16(p0[0], p0[1]); w.y = cvt_pk_bf16(p0[2], p0[3]); w.z = cvt_pk_bf16(p0[4], p0[5]); w.w = cvt_pk_bf16(p0[6], p0[7]); pa[0] = __builtin_bit_cast(bf16x8, w);
              w.x = cvt_pk_bf16(p0[8], p0[9]); w.y = cvt_pk_bf16(p0[10], p0[11]); w.z = cvt_pk_bf16(p0[12], p0[13]); w.w = cvt_pk_bf16(p0[14], p0[15]); pa[1] = __builtin_bit_cast(bf16x8, w);
              w.x = cvt_pk_bf16(p1[0], p1[1]); w.y = cvt_pk_bf16(p1[2], p1[3]); w.z = cvt_pk_bf16(p1[4], p1[5]); w.w = cvt_pk_bf16(p1[6], p1[7]); pa[2] = __builtin_bit_cast(bf16x8, w);
              w.x = cvt_pk_bf16(p1[8], p1[9]); w.y = cvt_pk_bf16(p1[10], p1[11]); w.z = cvt_pk_bf16(p1[12], p1[13]); w.w = cvt_pk_bf16(p1[14], p1[15]); pa[3] = __builtin_bit_cast(bf16x8, w); }
#pragma unroll
            for (int d0 = 0; d0 < 2; ++d0)
#pragma unroll
                for (int ks = 0; ks < 4; ++ks) {
                    const s16x4 lo = __builtin_bit_cast(s16x4, __builtin_amdgcn_ds_read_tr16_b64_v4i16((LAS s16x4*)(lds + cur + AT_KB + vfo + (16 * ks) * AT_VS + d0 * 64)));
                    const s16x4 hh = __builtin_bit_cast(s16x4, __builtin_amdgcn_ds_read_tr16_b64_v4i16((LAS s16x4*)(lds + cur + AT_KB + vfo + (16 * ks + 8) * AT_VS + d0 * 64)));
                    const bf16x8 vf = (bf16x8){lo[0], lo[1], lo[2], lo[3], hh[0], hh[1], hh[2], hh[3]};
                    o[d0] = __builtin_amdgcn_mfma_f32_32x32x16_bf16(pa[ks], vf, o[d0], 0, 0, 0);
                }
        }
        if (more) { *(LAS v4u*)(lds + nxt + kl0) = ka; if (two) *(LAS v4u*)(lds + nxt + kl1) = kb2; *(LAS v4u*)(lds + nxt + AT_KB + vl) = va; }
        __syncthreads();
    }
    l_run += __shfl_xor(l_run, 32);
    if (hi == 0) wsf[32 + r32] = l_run;
    LDS_WAIT();
    { bf16* stg = (bf16*)(lds + AT_OST + wid * 4096);
#pragma unroll
      for (int r = 0; r < 16; ++r) { const int orow = crow(r, hi); const float rl = __builtin_amdgcn_rcpf(wsf[32 + orow]);
#pragma unroll
          for (int d0 = 0; d0 < 2; ++d0) { const unsigned u = cvt_pk_bf16(o[d0][r] * rl, 0.f); ((LAS bf16*)(lds + AT_OST + wid * 4096))[orow * 64 + d0 * 32 + r32] = (bf16)(u & 0xffffu); } }
      (void)stg;
      LDS_WAIT();
      bf16* Ow = O + (rowbase + q0 + wid * 32) * 512 + h * 64;
#pragma unroll
      for (int i = 0; i < 4; ++i) { const int row = i * 8 + (lane >> 3), ch = lane & 7; const v4u v = *(const LAS v4u*)(lds + AT_OST + wid * 4096 + (row * 64 + ch * 8) * 2); *(v4u*)(Ow + (size_t)row * 512 + ch * 8) = v; } }
    __syncthreads();
}

template <int CTRL> __device__ __forceinline__ float dpp_add(float v) { return v + __builtin_bit_cast(float, __builtin_amdgcn_update_dpp(0, __builtin_bit_cast(int, v), CTRL, 0xF, 0xF, true)); }
constexpr int RW_TC = 64, RW_STREAM = RW_TC * 64 * 2  , RW_BUF = 6 * RW_STREAM  , RW_YOFF = 2 * RW_BUF  , RW_LDS = RW_YOFF + 2 * RW_STREAM;
constexpr int RW_SPLIT = 2, RW_RPW = 8 / RW_SPLIT, RW_LPR = 64 / RW_RPW  , RW_CPL = 64 / RW_LPR  , RW_ROWS = 64 / RW_SPLIT;
typedef f16 f16xc __attribute__((ext_vector_type(RW_CPL)));
struct RwIn { f16xc r, k, a, b, d; f16 v; };
__device__ __forceinline__ void rw_lds_read(RwIn& x, const LAS unsigned char* buf, int tt, int cg, int row) {
    const LAS unsigned char* p = buf + tt * 128 + cg * (RW_CPL * 2);
    x.r = *(const LAS f16xc*)(p); x.k = *(const LAS f16xc*)(p + RW_STREAM); x.a = *(const LAS f16xc*)(p + 2 * RW_STREAM); x.b = *(const LAS f16xc*)(p + 3 * RW_STREAM); x.d = *(const LAS f16xc*)(p + 4 * RW_STREAM);
    x.v = *(const LAS f16*)(buf + 5 * RW_STREAM + tt * 128 + row * 2);
}
__device__ __forceinline__ void rwkv_scan(Frame& F, int unit) {
    const int bh = unit / RW_SPLIT, part = unit % RW_SPLIT;
    const int tid = F.tid, lane = F.lane, rl = lane / RW_LPR, cg = lane % RW_LPR, b = bh >> 3, h = bh & 7, row = part * RW_ROWS + F.wave * RW_RPW + rl;
    const f16* R = WSP(f16, WS_R); const f16* KH = WSP(f16, WS_KH); const f16* KKN = WSP(f16, WS_KKN); const f16* BV = WSP(f16, WS_BV); const f16* DCY = WSP(f16, WS_DCY); const f16* VF = WSP(f16, WS_VFIN);
    f16* Y = WSP(f16, WS_YRW);
    const size_t base = (size_t)b * SEQ * 512 + h * 64;
    LAS unsigned char* lds = F.lds;
    const int ts = tid >> 3, pc = tid & 7;
    const size_t goff = base + (size_t)ts * 512 + pc * 8;
    const int loff = ts * 128 + pc * 16;
    v4u g[6];
#define RW_GLOAD(t0) do { const size_t o = goff + (size_t)(t0) * 512; const size_t oa = ((t0) + ts + 1 < SEQ) ? o + 512 : o; \
        g[0] = *(const v4u*)(R + o); g[1] = *(const v4u*)(KH + o); g[2] = *(const v4u*)(KKN + oa); g[3] = *(const v4u*)(BV + o); g[4] = *(const v4u*)(DCY + o); g[5] = *(const v4u*)(VF + o); } while (0)
#define RW_LSTORE(bufoff) do { _Pragma("unroll") for (int s_ = 0; s_ < 6; ++s_) *(LAS v4u*)(lds + (bufoff) + s_ * RW_STREAM + loff) = g[s_]; } while (0)
    float S[RW_CPL];
#pragma unroll
    for (int j = 0; j < RW_CPL; ++j) S[j] = 0.f;
    float sa = 0.f;
    __syncthreads();
    RW_GLOAD(0); RW_LSTORE(0);
    __syncthreads();
    for (int c = 0; c < SEQ / RW_TC; ++c) {
        const int cur = (c & 1) * RW_BUF, nxt = ((c + 1) & 1) * RW_BUF; const bool more = (c + 1 < SEQ / RW_TC);
        if (more) RW_GLOAD((c + 1) * RW_TC);
        const LAS unsigned char* buf = lds + cur;
        RwIn x, xn; rw_lds_read(x, buf, 0, cg, row);
#pragma unroll 4
        for (int tt = 0; tt < RW_TC; ++tt) {
            rw_lds_read(xn, buf, (tt + 1) & (RW_TC - 1), cg, row);
            const float v = (float)x.v; float yp = 0.f, sp = 0.f;
#pragma unroll
            for (int j = 0; j < RW_CPL; ++j) { float sj = S[j]; sj = sj - sj * (float)x.d[j]; sj = __builtin_fmaf(sa, (float)x.b[j], sj); sj = __builtin_fmaf(v, (float)x.k[j], sj); S[j] = sj;
                yp = __builtin_fmaf(sj, (float)x.r[j], yp); sp = __builtin_fmaf(sj, (float)x.a[j], sp); }
            yp = dpp_add<0xB1>(yp); sp = dpp_add<0xB1>(sp);
            yp = dpp_add<0x4E>(yp); sp = dpp_add<0x4E>(sp);
            if (RW_LPR >= 8) { yp = dpp_add<0x141>(yp); sp = dpp_add<0x141>(sp); }
            if (RW_LPR >= 16) { yp = dpp_add<0x140>(yp); sp = dpp_add<0x140>(sp); }
            sa = -sp;
            if (cg == 0) *(LAS f16*)(lds + RW_YOFF + (c & 1) * RW_STREAM + tt * 128 + row * 2) = (f16)yp;
            x = xn;
        }
        if (more) RW_LSTORE(nxt);
        __syncthreads();
        if (pc >= part * (8 / RW_SPLIT) && pc < (part + 1) * (8 / RW_SPLIT)) { const v4u yv = *(const LAS v4u*)(lds + RW_YOFF + (c & 1) * RW_STREAM + loff); *(v4u*)(Y + base + (size_t)(c * RW_TC + ts) * 512 + pc * 8) = yv; }
    }
    __syncthreads();
#undef RW_GLOAD
#undef RW_LSTORE
}
__device__ __forceinline__ void s5_carry(Frame& F, int idx) {
    const int p = idx & 63, g = (idx >> 6) & 31, b = idx >> 11;
    const float* a32 = WSP(float, WS_S5A32) + (size_t)(g * 64 + p) * 2; const float ar = a32[0], ai = a32[1];
    const float* xe = WSP(float, WS_XEND) + ((size_t)g * S5CH + b * S5NC) * 128; bf16* u = WSP(bf16, WS_S5U) + ((size_t)g * S5CH + b * S5NC) * S5K + 512;
    float xr = 0.f, xi = 0.f;
    for (int c0 = 0; c0 < S5NC; c0 += 8) { float er[8], ei[8];
#pragma unroll
        for (int c = 0; c < 8; ++c) { er[c] = xe[(size_t)(c0 + c) * 128 + p]; ei[c] = xe[(size_t)(c0 + c) * 128 + 64 + p]; }
#pragma unroll
        for (int c = 0; c < 8; ++c) { bf16* up = u + (size_t)(c0 + c) * S5K; up[p] = (bf16)(cvt_pk_bf16(xr, 0.f) & 0xffffu); up[64 + p] = (bf16)(cvt_pk_bf16(xi, 0.f) & 0xffffu);
            const float nr = ar * xr - ai * xi + er[c], ni = ar * xi + ai * xr + ei[c]; xr = nr; xi = ni; } }
}
__device__ __forceinline__ void rwkv_post(Frame& F, int l) {
    const int lane = F.lane; const int gw = F.blk * NWAVES + F.wave, NGW = F.G * NWAVES;
    float lg[8], lb[8], rk[8]; ld8f(INP(float, 16) + l * 512 + 8 * lane, lg); ld8f(INP(float, 17) + l * 512 + 8 * lane, lb); ld8f(INP(float, 15) + l * 512 + 8 * lane, rk);
    for (int m = gw; m < M; m += NGW) { const size_t off = (size_t)m * 512 + 8 * lane; float y[8], r[8], k[8], v[8], g[8], o[8];
        f16x8_to_f32(*(const f16x8*)(WSP(f16, WS_YRW) + off), y); f16x8_to_f32(*(const f16x8*)(WSP(f16, WS_R) + off), r); f16x8_to_f32(*(const f16x8*)(WSP(f16, WS_KH) + off), k);
        f16x8_to_f32(*(const f16x8*)(WSP(f16, WS_VFIN) + off), v); bf16x8_to_f32(*(const v4u*)(WSP(bf16, WS_GL) + off), g);
        float s = 0.f, bs = 0.f;
#pragma unroll
        for (int j = 0; j < 8; ++j) { s += y[j]; bs += r[j] * k[j] * rk[j]; }
        s += __shfl_xor(s, 1); s += __shfl_xor(s, 2); s += __shfl_xor(s, 4); bs += __shfl_xor(bs, 1); bs += __shfl_xor(bs, 2); bs += __shfl_xor(bs, 4);
        const float mean = s * (1.0f / 64.0f); float q = 0.f;
#pragma unroll
        for (int j = 0; j < 8; ++j) { y[j] -= mean; q += y[j] * y[j]; }
        q += __shfl_xor(q, 1); q += __shfl_xor(q, 2); q += __shfl_xor(q, 4);
        const float rstd = 1.0f / sqrtf(q * (1.0f / 64.0f) + 64e-5f);
#pragma unroll
        for (int j = 0; j < 8; ++j) o[j] = (y[j] * rstd * lg[j] + lb[j] + bs * v[j]) * g[j];
        *(v4u*)(WSP(bf16, WS_YRW) + off) = f32_to_bf16x8(o); }
}
constexpr int PH_PER_LAYER = 12, N_PHASES = 1 + NLAYER * PH_PER_LAYER;
#ifndef MK_PER_PHASE
#define MK_PER_PHASE 0
#endif
#ifndef ABL_BRANCH
#define ABL_BRANCH -1
#endif
constexpr int NR_RWKV = 64 * RW_SPLIT;

__global__ void __launch_bounds__(NWAVES * 64, 2) mk_fwd(Args A) {
    extern __shared__ __attribute__((aligned(16))) unsigned char lds_raw[];
    volatile LAS unsigned* MISC = (volatile LAS unsigned*)((LAS unsigned char*)lds_raw + MISC_OFF);
    for (int u = threadIdx.x; u < (LDS_BYTES - LDSCTL_OFF) / 4; u += NWAVES * 64) ((LAS unsigned*)((LAS unsigned char*)lds_raw + LDSCTL_OFF))[u] = 0u;
    __syncthreads();
    XcdBarrier bar; bar.bar = (unsigned*)(A.ws + WS_CTL) + CW_BAR; bar.x = 0; bar.st = nullptr;
    if (!MK_PER_PHASE) bar = xcd_barrier_post((unsigned*)(A.ws + WS_CTL) + CW_BAR, MISC + 8);
    const int lo = A.ph_lo, hi = A.ph_hi;
#ifndef PHMASK
#define PHMASK 0xFFFF
#endif
#define PHON(k) ((PHMASK >> (k)) & 1)
#define IN(k) (lo <= (k) && (k) < hi)
#define SEAM(k) do { if (IN(k) && IN((k) + 1)) xcd_barrier(bar); } while (0)
    using pg8::gemm_phase; using pg8::StaticOrder; using pg8::LocDense;

    if (PHON(0) && IN(0)) {
        MKFRAME(F);
        p0_prologue(F);
        const int gw = F.blk * NWAVES + F.wave, NGW = F.G * NWAVES;
        for (int m = gw; m < M; m += NGW) {
#pragma unroll
            for (int j = 0; j < 4; ++j) { const f32x4 v = *(const f32x4*)(INP(float, 0) + (size_t)m * DM + 4 * F.lane + 256 * j); v2u w; w.x = cvt_pk_bf16(v[0], v[1]); w.y = cvt_pk_bf16(v[2], v[3]); *(v2u*)(WSP(bf16, WS_XB) + (size_t)m * DM + 4 * F.lane + 256 * j) = w; } }
    }
    SEAM(0);

    for (int l = 0; l < NLAYER; ++l) {
        const int pb = 1 + l * PH_PER_LAYER;
        const bool moe = (l & 1) != 0; const int li = l >> 1;
        if (PHON(1) && IN(pb + 0)) {
            asm volatile("; ==PH1");
            MKFRAME(F);
            LocDense L{WSP(bf16, WS_XB), WSP(bf16, WS_WIN) + (size_t)l * 3072 * DM, DM, DM, DM, 0, 0};
            StaticOrder S; S.init(M, 3072, 1, F.G, F.blk);
            Epi8<FProj> E{{WSP(bf16, WS_MLARAW), WSP(bf16, WS_RWRAW), WSP(bf16, WS_S5U)}};
            gemm_phase(F.lds + RING_OFF, L, S, E);
        }
        SEAM(pb + 0);
        if (PHON(2) && IN(pb + 1)) { MKFRAME(F); ph2_prep(F, l); }
        SEAM(pb + 1);
        if (PHON(3) && IN(pb + 2)) {
            asm volatile("; ==PH3");
            MKFRAME(F);
#ifndef P3SEL
#define P3SEL 31
#endif
            if (P3SEL & 1) { LocDense L{WSP(bf16, WS_CQN), WSP(bf16, WS_WUQ) + (size_t)l * 768 * 384, 384, 384, 384, 0, 0}; StaticOrder S; S.init(M, 768, 1, F.G, F.blk);
              Epi8<FQup> E{{WSP(bf16, WS_Q), WSP(float, WS_ROPE), 0.10206207261596575f * 1.4426950408889634f}}; gemm_phase(F.lds + RING_OFF, L, S, E); }
            if (P3SEL & 2) { LocDense L{WSP(bf16, WS_CKVN), WSP(bf16, WS_WUKV) + (size_t)l * 1024 * 256, 256, 256, 256, 0, 0}; StaticOrder S; S.init(M, 1024, 1, F.G, F.blk);
              Epi8<FKVup> E{{WSP(bf16, WS_K), WSP(bf16, WS_V)}}; gemm_phase(F.lds + RING_OFF, L, S, E); }
            if (P3SEL & 4) { LocDense L{WSP(bf16, WS_LORAIN), WSP(bf16, WS_WLORA) + (size_t)l * 1536 * 256, 256, 256, 256, 0, 0}; StaticOrder S; S.init(M, 1536, 1, F.G, F.blk);
              Epi8<FLora> E{{INP(float, 8) + l * 512, INP(float, 10) + l * 512, INP(float, 14) + l * 512, WSP(f16, WS_DCY), WSP(f16, WS_KH), WSP(f16, WS_KKN), WSP(f16, WS_BV), WSP(bf16, WS_GL), {}, {}}}; gemm_phase(F.lds + RING_OFF, L, S, E); }
            if ((P3SEL & 8) && l > 0) { LocDense L{WSP(bf16, WS_VRAW), WSP(bf16, WS_WVRES) + (size_t)(l - 1) * 512 * 512, 512, 512, 512, 0, 0}; StaticOrder S; S.init(M, 512, 1, F.G, F.blk);
              Epi8<FVres> E{{INP(float, 20) + (l - 1) * 512, WSP(bf16, WS_VRAW), WSP(bf16, WS_VFIRST), WSP(f16, WS_VFIN), {}}}; gemm_phase(F.lds + RING_OFF, L, S, E); }
            if (P3SEL & 16) { LocDense L{WSP(bf16, WS_S5U), WSP(bf16, WS_S5END), S5K, 512, 512, (size_t)S5CH * S5K, (size_t)256 * 512}; StaticOrder S; S.init(S5CH, 256, 32, F.G, F.blk);
              Epi8<FS5End> E{{WSP(float, WS_XEND)}}; gemm_phase(F.lds + RING_OFF, L, S, E); }
        }
        SEAM(pb + 2);
        if (PHON(4) && IN(pb + 3)) {
            asm volatile("; ==PH4");
            MKFRAME(F);
            if (F.blk < NR_RWKV && F.G > NR_RWKV) { if (A.li != -2) for (int un = F.blk; un < NBATCH * NH * RW_SPLIT; un += NR_RWKV) rwkv_scan(F, un); }
            else if (A.li != -1) {
                const int ab = F.blk - NR_RWKV, na = F.G - NR_RWKV;
                for (int idx = ab * 512 + F.tid; idx < NBATCH * 32 * 64; idx += na * 512) s5_carry(F, idx);
                LAS int* slot = (LAS int*)(F.lds + AT_LDS);
                for (;;) {
                    __syncthreads();
                    if (F.tid == 0) *slot = (int)__hip_atomic_fetch_add((unsigned*)(F.ctl + CW_ATTN + 64 * l), 1u, RLX_AGENT);
                    __syncthreads();
                    const int n = *slot; if (n >= NBATCH * NH * 16) break;
                    const int qb = 15 - (n >> 6), bh = n & 63;
                    attn_unit(F.tid, bh >> 3, bh & 7, qb, WSP(bf16, WS_Q), WSP(bf16, WS_K), WSP(bf16, WS_V), WSP(bf16, WS_YMLA), F.lds);
                }
            }
        }
        SEAM(pb + 3);
        if (PHON(5) && IN(pb + 4)) {
            asm volatile("; ==PH5");
            MKFRAME(F);
            { LocDense L{WSP(bf16, WS_S5U), WSP(bf16, WS_S5MAIN), S5K, S5K, S5K, (size_t)S5CH * S5K, (size_t)512 * S5K}; StaticOrder S; S.init(S5CH, 512, 32, F.G, F.blk);
              Epi8<FS5Main> E{{WSP(bf16, WS_S5U), INP(float, 28) + l * 512, WSP(bf16, WS_YS5G), {}}}; gemm_phase(F.lds + RING_OFF, L, S, E); }
            rwkv_post(F, l);
        }
        SEAM(pb + 4);
        if (PHON(6) && IN(pb + 5)) {
            asm volatile("; ==PH6");
            MKFRAME(F);
            { LocDense L{WSP(bf16, WS_YS5G), WSP(bf16, WS_WGLU) + (size_t)l * 512 * 512, 512, 512, 512, 0, 0}; StaticOrder S; S.init(M, 512, 1, F.G, F.blk);
              Epi8<FGlu> E{{WSP(bf16, WS_YS5G), INP(float, 30) + l * 512, WSP(bf16, WS_YS5), {}}}; gemm_phase(F.lds + RING_OFF, L, S, E); }
            { LocDense L{WSP(bf16, WS_XB), WSP(bf16, WS_WG) + ((size_t)l * 3 + 0) * 1024 * DM, DM, DM, DM, 0, 0}; StaticOrder S; S.init(M, 1024, 1, F.G, F.blk);
              Epi8<FGate> E{{WSP(bf16, WS_GBUF)}}; gemm_phase(F.lds + RING_OFF, L, S, E); }
            { LocDense L{WSP(bf16, WS_YMLA), WSP(bf16, WS_WBR) + ((size_t)l * 3 + 0) * 1024 * 512, 512, 512, 512, 0, 0}; StaticOrder S; S.init(M, 1024, 1, F.G, F.blk);
              Epi8<FMerge> E{{WSP(bf16, WS_GBUF), WSP(bf16, WS_MIXED2), WSP(bf16, WS_MIXED), 1, (ABL_BRANCH == 0) ? 0.f : 1.f}}; gemm_phase(F.lds + RING_OFF, L, S, E); }
            { LocDense L{WSP(bf16, WS_XB), WSP(bf16, WS_WG) + ((size_t)l * 3 + 1) * 1024 * DM, DM, DM, DM, 0, 0}; StaticOrder S; S.init(M, 1024, 1, F.G, F.blk);
              Epi8<FGate> E{{WSP(bf16, WS_GBUF2)}}; gemm_phase(F.lds + RING_OFF, L, S, E); }
            { LocDense L{WSP(bf16, WS_YRW), WSP(bf16, WS_WBR) + ((size_t)l * 3 + 1) * 1024 * 512, 512, 512, 512, 0, 0}; StaticOrder S; S.init(M, 1024, 1, F.G, F.blk);
              Epi8<FMerge> E{{WSP(bf16, WS_GBUF2), WSP(bf16, WS_MIXED), WSP(bf16, WS_MIXED2), 0, (ABL_BRANCH == 1) ? 0.f : 1.f}}; gemm_phase(F.lds + RING_OFF, L, S, E); }
        }
        SEAM(pb + 5);
        if (PHON(7) && IN(pb + 6)) {
            asm volatile("; ==PH7");
            MKFRAME(F);
            { LocDense L{WSP(bf16, WS_XB), WSP(bf16, WS_WG) + ((size_t)l * 3 + 2) * 1024 * DM, DM, DM, DM, 0, 0}; StaticOrder S; S.init(M, 1024, 1, F.G, F.blk);
              Epi8<FGate> E{{WSP(bf16, WS_GBUF)}}; gemm_phase(F.lds + RING_OFF, L, S, E); }
            { LocDense L{WSP(bf16, WS_YS5), WSP(bf16, WS_WBR) + ((size_t)l * 3 + 2) * 1024 * 512, 512, 512, 512, 0, 0}; StaticOrder S; S.init(M, 1024, 1, F.G, F.blk);
              Epi8<FMerge> E{{WSP(bf16, WS_GBUF), WSP(bf16, WS_MIXED2), WSP(bf16, WS_MIXED), 0, (ABL_BRANCH == 2) ? 0.f : 1.f}}; gemm_phase(F.lds + RING_OFF, L, S, E); }
        }
        SEAM(pb + 6);
        if (PHON(8) && IN(pb + 7)) {
            asm volatile("; ==PH8");
            MKFRAME(F);
            LocDense L{WSP(bf16, WS_MIXED), WSP(bf16, WS_WOUT) + (size_t)l * DM * DM, DM, DM, DM, 0, 0}; StaticOrder S; S.init(M, DM, 1, F.G, F.blk);
            Epi8<FResid> E{{(l == 0) ? INP(float, 0) : (const float*)F.out, F.out}}; gemm_phase(F.lds + RING_OFF, L, S, E);
        }
        SEAM(pb + 7);
        if (PHON(9) && IN(pb + 8)) {
            asm volatile("; ==PH9");
            MKFRAME(F);
            if (moe) { ln1_moe_phase(F, INP(float, 33) + l * DM, INP(float, 34) + l * DM, li); moe_convert(F, li); }
            else ln_phase(F, INP(float, 33) + l * DM, INP(float, 34) + l * DM);
        }
        SEAM(pb + 8);
        if (PHON(10) && IN(pb + 9)) {
            asm volatile("; ==PH10");
            MKFRAME(F);
            if (moe) {
                const unsigned* cnt = (const unsigned*)(F.ctl + CW_MOECNT + 64 * li);
                LocMoe1 L{WSP(bf16, WS_XB), WSP(bf16, WS_WMGU), DM, DM, DM, WSP(int, WS_SLOTTOK), cnt}; MoeOrder S; S.init(cnt, 2 * EXD / 256, F.G, F.blk);
                EpiGU<FSwiglu> E{{WSP(bf16, WS_HM), EXD}}; gemm_phase(F.lds + RING_OFF, L, S, E);
            } else {
                LocDense L{WSP(bf16, WS_XB), WSP(bf16, WS_WFGU) + (size_t)li * 2 * FFN * DM, DM, DM, DM, 0, 0}; StaticOrder S; S.init(M, 2 * FFN, 1, F.G, F.blk);
                EpiGU<FSwiglu> E{{WSP(bf16, WS_HB), FFN}}; gemm_phase(F.lds + RING_OFF, L, S, E);
            }
        }
        SEAM(pb + 9);
        if (PHON(11) && IN(pb + 10)) {
            asm volatile("; ==PH11");
            MKFRAME(F);
            if (moe) {
                const unsigned* cnt = (const unsigned*)(F.ctl + CW_MOECNT + 64 * li);
                LocDense L{WSP(bf16, WS_HM), WSP(bf16, WS_WMD), EXD, EXD, EXD, 0, (size_t)DM * EXD}; MoeOrder S; S.init(cnt, DM / 256, F.G, F.blk);
                Epi8<FMoeDown> E{{WSP(bf16, WS_YPAIR), WSP(float, WS_SLOTW), cnt}}; gemm_phase(F.lds + RING_OFF, L, S, E);
            } else {
                LocDense L{WSP(bf16, WS_HB), WSP(bf16, WS_WFD) + (size_t)li * DM * FFN, FFN, FFN, FFN, 0, 0}; StaticOrder S; S.init(M, DM, 1, F.G, F.blk);
                Epi8<FResid> E{{F.out, F.out}}; gemm_phase(F.lds + RING_OFF, L, S, E);
            }
        }
        SEAM(pb + 10);
        if (PHON(12) && IN(pb + 11)) {
            asm volatile("; ==PH12");
            MKFRAME(F);
            if (moe) ln2_moe_phase(F, INP(float, 35) + l * DM, INP(float, 36) + l * DM, li);
            else ln_phase(F, INP(float, 35) + l * DM, INP(float, 36) + l * DM);
        }
        SEAM(pb + 11);
    }
#undef IN
#undef SEAM
}

#ifdef PROBE_P
__global__ void probe_sum(const unsigned* x, unsigned long long* sums, int n) {
    __shared__ unsigned long long sh[256];
    unsigned long long s = 0;
    for (int i = blockIdx.x * blockDim.x + threadIdx.x; i < n; i += gridDim.x * blockDim.x) s += (unsigned long long)x[i] * (unsigned long long)(2 * (i & 1023) + 1);
    sh[threadIdx.x] = s; __syncthreads();
    if (threadIdx.x == 0) { unsigned long long t = 0; for (int i = 0; i < 256; ++i) t += sh[i]; sums[blockIdx.x] = t; }
}
__global__ void probe_cmp(const unsigned long long* sums, unsigned* out) {
    if (sums[threadIdx.x] != sums[1024 + threadIdx.x]) out[threadIdx.x * 4099] = 0x7fc00000u;
}
#endif
extern "C" void kernel_launch(void* const* d_in, const int* in_sizes, int n_in, void* d_out, int out_size, void* d_ws, size_t ws_size, hipStream_t stream) {
    static int grid = 0;
    if (grid == 0) {
        if (n_in != 44 || out_size != M * DM || ws_size < WS_END) { fprintf(stderr, "kernel_launch: unexpected problem (n_in %d, out %d, ws %zu < %zu)\n", n_in, out_size, ws_size, (size_t)WS_END); grid = -1; return; }
        int dev = 0, cus = 0, per_cu = 0;
        if (hipGetDevice(&dev) != hipSuccess || hipDeviceGetAttribute(&cus, hipDeviceAttributeMultiprocessorCount, dev) != hipSuccess) { grid = -1; return; }
        if (hipFuncSetAttribute((const void*)mk_fwd, hipFuncAttributeMaxDynamicSharedMemorySize, LDS_BYTES) != hipSuccess) { fprintf(stderr, "kernel_launch: hipFuncSetAttribute failed\n"); grid = -1; return; }
        if (hipOccupancyMaxActiveBlocksPerMultiprocessor(&per_cu, (const void*)mk_fwd, NWAVES * 64, LDS_BYTES) != hipSuccess || per_cu < 1) { fprintf(stderr, "kernel_launch: occupancy query says %d blocks per CU\n", per_cu); }
        (void)hipGetLastError();
        grid = cus;
        if (grid != 256) fprintf(stderr, "kernel_launch: %d CUs (built for 256)\n", grid);
    }
    if (grid < 0) return;
    (void)in_sizes;
    if (hipMemsetAsync((char*)d_ws + WS_CTL, 0, CTL_ZERO_BYTES, stream) != hipSuccess) return;
    Args a{};
    for (int i = 0; i < 44; ++i) a.in[i] = d_in[i];
    a.out = (float*)d_out; a.ws = (unsigned char*)d_ws; a.pad = 0;
#if MK_PER_PHASE
#ifdef PROBE_P
    for (int p = 0; p <= PROBE_P; ++p) { a.ph_lo = p; a.ph_hi = p + 1; a.li = p; hipLaunchKernelGGL(mk_fwd, dim3(grid), dim3(NWAVES * 64), LDS_BYTES, stream, a); }
    hipLaunchKernelGGL(probe_sum, dim3(1024), dim3(256), 0, stream, (const unsigned*)((char*)d_ws + PROBE_OFF), (unsigned long long*)((char*)d_ws + WS_END), (int)(PROBE_BYTES / 4));
    hipMemsetAsync((char*)d_ws + WS_CTL, 0, CTL_ZERO_BYTES, stream);
    for (int p = 0; p <= PROBE_P; ++p) { a.ph_lo = p; a.ph_hi = p + 1; a.li = p; hipLaunchKernelGGL(mk_fwd, dim3(grid), dim3(NWAVES * 64), LDS_BYTES, stream, a); }
    hipLaunchKernelGGL(probe_sum, dim3(1024), dim3(256), 0, stream, (const unsigned*)((char*)d_ws + PROBE_OFF), (unsigned long long*)((char*)d_ws + WS_END) + 1024, (int)(PROBE_BYTES / 4));
    for (int p = PROBE_P + 1; p < N_PHASES; ++p) { a.ph_lo = p; a.ph_hi = p + 1; a.li = p; hipLaunchKernelGGL(mk_fwd, dim3(grid), dim3(NWAVES * 64), LDS_BYTES, stream, a); }
    hipLaunchKernelGGL(probe_cmp, dim3(1), dim3(1024), 0, stream, (const unsigned long long*)((char*)d_ws + WS_END), (unsigned*)d_out);
#else
    for (int p = 0; p < N_PHASES; ++p) { a.ph_lo = p; a.ph_hi = p + 1; a.li = p; hipLaunchKernelGGL(mk_fwd, dim3(grid), dim3(NWAVES * 64), LDS_BYTES, stream, a);
#ifdef DUP_MASK
        if (p >= 1 && ((DUP_MASK >> ((p - 1) % PH_PER_LAYER)) & 1)) { hipMemsetAsync((char*)d_ws + WS_CTL + (size_t)CW_ATTN * 4, 0, 4096, stream);
#ifdef DUP_LI
            a.li = DUP_LI;
#endif
            hipLaunchKernelGGL(mk_fwd, dim3(grid), dim3(NWAVES * 64), LDS_BYTES, stream, a); }
#endif
    }
#endif
#else
    a.ph_lo = 0; a.ph_hi = N_PHASES; a.li = 0;
    hipLaunchKernelGGL(mk_fwd, dim3(grid), dim3(NWAVES * 64), LDS_BYTES, stream, a);
#endif
}
```

```cpp
#include <hip/hip_runtime.h>
#include <cstdio>
#include <cstdint>
#include <cmath>
namespace pg8 {
#define PG8_LAS __attribute__((address_space(3)))
typedef unsigned short bf16_t;
typedef short bf16x8 __attribute__((ext_vector_type(8)));
typedef float f32x4 __attribute__((ext_vector_type(4)));
typedef float f32x2 __attribute__((ext_vector_type(2)));
typedef unsigned u32x4 __attribute__((ext_vector_type(4)));
typedef unsigned u32x2 __attribute__((ext_vector_type(2)));
constexpr int BM = 256, BK = 64, HALF = 128, HTB = HALF * BK * 2  , STAGE_BYTES = 8 * HTB, NXCD = 8, WGM = 8;

__host__ __device__ __forceinline__ int lds_byte(int r, int c) { const int st = (r >> 4) * 2 + (c >> 5), rr = r & 15, cc = c & 31, ob = rr * 64 + cc * 2; return st * 1024 + (ob ^ (((ob >> 9) & 1) << 5)); }
__host__ __device__ __forceinline__ void stage_rc(int b, int& R, int& C) { const int st = b / 1024, sb = b % 1024, swz = sb ^ (((sb >> 9) & 1) << 5); R = (st >> 1) * 16 + swz / 64; C = (st & 1) * 32 + (swz % 64) / 2; }
__host__ __device__ __forceinline__ int perm32(int rho) { const int n = rho >> 4, i = rho & 15; return 8 * (i >> 2) + 4 * n + (i & 3); }

struct Unit { int pm, pn, z, aux; };

struct LocDense {
    static constexpr bool GATHER = false;
    const bf16_t* A; const bf16_t* Bt; int lda, ldb, K; size_t zA, zB;
    __device__ __forceinline__ const char* a_ptr(const Unit& u) const { return (const char*)(A + (size_t)u.z * zA + (size_t)u.pm * BM * lda); }
    __device__ __forceinline__ const char* b_ptr(const Unit& u) const { return (const char*)(Bt + (size_t)u.z * zB + (size_t)u.pn * BM * ldb); }
    __device__ __forceinline__ void a_off(const Unit&, int tid, unsigned (&v)[2][2]) const {
#pragma unroll
        for (int i = 0; i < 2; ++i) { int R, C; stage_rc(tid * 16 + i * 8192, R, C); v[0][i] = (unsigned)(R * lda + C) * 2u; v[1][i] = 0u; }
    }
};

struct StaticOrder {
    int nM, nN, nwg, nZ, G, c;
    __device__ void init(int M, int N, int Z, int G_, int c_) { nM = M / BM; nN = N / BM; nwg = nM * nN; nZ = Z; G = G_; c = c_; }
    __device__ bool next(int i, Unit& u) const {
        const long L = (long)i * G + c; if (L >= (long)nwg * nZ) return false;
        u.z = (int)(L / nwg); u.aux = 0;
        int wgid = (int)(L % nwg); { const int q = nwg / NXCD, r = nwg % NXCD, xcd = wgid % NXCD, off = wgid / NXCD; wgid = (xcd < r ? xcd * (q + 1) : r * (q + 1) + (xcd - r) * q) + off; }
        const int nig = WGM * nN, gid = wgid / nig, fm = gid * WGM, gsz = (nM - fm) < WGM ? (nM - fm) : WGM;
        u.pm = fm + ((wgid % nig) % gsz); u.pn = (wgid % nig) / gsz; return true;
    }
};

typedef float f32x2_cv __attribute__((ext_vector_type(2))); typedef __bf16 bf16x2_cv __attribute__((ext_vector_type(2)));
__device__ __forceinline__ unsigned cvt_pk_bf16(float lo, float hi) { const f32x2_cv v = {lo, hi}; const bf16x2_cv b = __builtin_convertvector(v, bf16x2_cv); return __builtin_bit_cast(unsigned, b); }
__device__ __forceinline__ u32x4 pack8(const f32x4 v0, const f32x4 v1) { u32x4 w; w.x = cvt_pk_bf16(v0[0], v0[1]); w.y = cvt_pk_bf16(v0[2], v0[3]); w.z = cvt_pk_bf16(v1[0], v1[1]); w.w = cvt_pk_bf16(v1[2], v1[3]); return w; }
__device__ __forceinline__ float bf_lo(unsigned w) { return __uint_as_float(w << 16); }
__device__ __forceinline__ float bf_hi(unsigned w) { return __uint_as_float(w & 0xffff0000u); }
__device__ __forceinline__ void unpack8(const u32x4 w, f32x4& v0, f32x4& v1) { v0 = (f32x4){bf_lo(w.x), bf_hi(w.x), bf_lo(w.y), bf_hi(w.y)}; v1 = (f32x4){bf_lo(w.z), bf_hi(w.z), bf_lo(w.w), bf_hi(w.w)}; }

struct NoPre {};
template <class F> struct Epi8 {
    static constexpr bool PERM = true;
    F f;
    __device__ __forceinline__ void operator()(const f32x4 (&acc)[2][2][4][2], const Unit& u, int wr, int wc, int fr, int fq) const {
        const int row0 = u.pm * BM + wr * 64 + fr, col0 = u.pn * BM + wc * 32 + 8 * fq;
        F g = f;
#pragma unroll
        for (int bj = 0; bj < 2; ++bj) { const int col = col0 + bj * HALF; g.begin_col(u, col);
#pragma unroll
            for (int b0 = 0; b0 < 8; b0 += F::BATCH) { typename F::Pre pr[F::BATCH];
#pragma unroll
                for (int i = 0; i < F::BATCH; ++i) { const int q = b0 + i; pr[i] = g.pre(u, row0 + (q >> 2) * HALF + (q & 3) * 16, col); }
#pragma unroll
                for (int i = 0; i < F::BATCH; ++i) { const int q = b0 + i; g.tile8(u, row0 + (q >> 2) * HALF + (q & 3) * 16, col, acc[q >> 2][bj][q & 3][0], acc[q >> 2][bj][q & 3][1], pr[i]); }
                asm volatile("" ::: "memory"); } }
    }
};
template <class F> struct EpiGU {
    static constexpr bool PERM = true;
    F f;
    __device__ __forceinline__ void operator()(const f32x4 (&acc)[2][2][4][2], const Unit& u, int wr, int wc, int fr, int fq) const {
        const int row0 = u.pm * BM + wr * 64 + fr, colh = u.pn * HALF + wc * 32 + 8 * fq;
#pragma unroll
        for (int ai = 0; ai < 2; ++ai)
#pragma unroll
            for (int m = 0; m < 4; ++m) { f.pair8(u, row0 + ai * HALF + m * 16, colh, acc[ai][0][m][0], acc[ai][0][m][1], acc[ai][1][m][0], acc[ai][1][m][1]); asm volatile("" ::: "memory"); }
    }
};

template <class Epi, class Sched, class Loc>
__device__ __forceinline__ void gemm_phase(PG8_LAS unsigned char* lds, const Loc& L, const Sched& S, const Epi& E) {
    int tid_ = threadIdx.x; asm volatile("" : "+v"(tid_));
    const int tid = tid_, wid = __builtin_amdgcn_readfirstlane(tid >> 6), lane = tid & 63, wr = wid >> 2, wc = wid & 3, fr = lane & 15, fq = lane >> 4;
    const int K = L.K, nt = K / BK;
    unsigned voffB[2];
#pragma unroll
    for (int i = 0; i < 2; ++i) { int R, C; stage_rc(tid * 16 + i * 8192, R, C); const int Rb = Epi::PERM ? ((R & ~31) + perm32(R & 31)) : R;
        voffB[i] = (unsigned)(Rb * L.ldb + C) * 2u; }
    const size_t kstep = (size_t)(BK * 2);
    const size_t hstepB = (size_t)HALF * L.ldb * 2;
    const unsigned ldsw = (unsigned)wid * 1024u;
    const int aoff = lds_byte(wr * 64 + fr, fq * 8), boff = lds_byte(wc * 32 + fr, fq * 8);
#define PG8_SA(b, h) (((b) * 2 + (h)) * HTB)
#define PG8_SB(b, h) ((4 + (b) * 2 + (h)) * HTB)
#define PG8_STAGE(bufoff, gbase, voff) do { _Pragma("unroll") for (int _i = 0; _i < 2; ++_i) \
        __builtin_amdgcn_global_load_lds((const unsigned*)((const char*)(gbase) + (voff)[_i]), (PG8_LAS unsigned*)(lds + (bufoff) + ldsw + _i * 8192), 16, 0, 0); } while (0)
#define PG8_LDA(dst, b, h) do { _Pragma("unroll") for (int m = 0; m < 4; ++m) _Pragma("unroll") for (int k = 0; k < 2; ++k) dst[m][k] = *(const PG8_LAS bf16x8*)(lds + PG8_SA(b, h) + aoff + m * 2048 + k * 1024); } while (0)
#define PG8_LDB(dst, b, h) do { _Pragma("unroll") for (int n = 0; n < 2; ++n) _Pragma("unroll") for (int k = 0; k < 2; ++k) dst[n][k] = *(const PG8_LAS bf16x8*)(lds + PG8_SB(b, h) + boff + n * 2048 + k * 1024); } while (0)
#define PG8_MMA(ai, bj, At, Bt) do { __builtin_amdgcn_s_setprio(1); _Pragma("unroll") for (int m = 0; m < 4; ++m) _Pragma("unroll") for (int n = 0; n < 2; ++n) _Pragma("unroll") for (int k = 0; k < 2; ++k) \
        acc[ai][bj][m][n] = __builtin_amdgcn_mfma_f32_16x16x32_bf16(Bt[n][k], At[m][k], acc[ai][bj][m][n], 0, 0, 0); __builtin_amdgcn_s_setprio(0); } while (0)
#define PG8_WAIT_V(n) asm volatile("s_waitcnt vmcnt(" #n ")" ::: "memory")
#define PG8_WAIT_L(n) asm volatile("s_waitcnt lgkmcnt(" #n ")" ::: "memory")
#define PG8_BAR __builtin_amdgcn_s_barrier()
#define PG8_SCHED __builtin_amdgcn_sched_barrier(0)
    Unit cur, nxt; int ui = 0;
    if (!S.next(0, cur)) return;
    f32x4 acc[2][2][4][2];
#pragma unroll
    for (int a = 0; a < 2; ++a)
#pragma unroll
        for (int b = 0; b < 2; ++b)
#pragma unroll
            for (int m = 0; m < 4; ++m)
#pragma unroll
                for (int n = 0; n < 2; ++n) acc[a][b][m][n] = (f32x4){0.f, 0.f, 0.f, 0.f};
    bf16x8 At[4][2], B0[2][2], B1[2][2];
    constexpr int NVH = Loc::GATHER ? 2 : 1;
    unsigned vc[2][2], vn[NVH][2];
    L.a_off(cur, tid, vc);
    if constexpr (Loc::GATHER) {
#pragma unroll
        for (int h = 0; h < 2; ++h)
#pragma unroll
            for (int i = 0; i < 2; ++i) vn[h][i] = vc[h][i];
    }
    const size_t hstepA = Loc::GATHER ? 0 : (size_t)HALF * L.lda * 2;
    const char* cA = L.a_ptr(cur); const char* cB = L.b_ptr(cur);
    PG8_STAGE(PG8_SB(0, 0), cB, voffB); PG8_STAGE(PG8_SB(0, 1), cB + hstepB, voffB); PG8_STAGE(PG8_SA(0, 0), cA, vc[0]); PG8_STAGE(PG8_SA(0, 1), cA + hstepA, vc[NVH - 1]);
    if (wr == 1) PG8_BAR;
    PG8_WAIT_V(2); PG8_BAR;
    PG8_STAGE(PG8_SB(1, 0), cB + kstep, voffB); PG8_STAGE(PG8_SA(1, 0), cA + kstep, vc[0]); PG8_STAGE(PG8_SB(1, 1), cB + hstepB + kstep, voffB);
    PG8_WAIT_V(6); PG8_BAR;
    for (;;) {
        const bool has_next = S.next(ui + 1, nxt);
        const char* nA = has_next ? L.a_ptr(nxt) : cA; const char* nB = has_next ? L.b_ptr(nxt) : cB;
        if constexpr (Loc::GATHER) { if (has_next) L.a_off(nxt, tid, vn); }
        for (int t = 0; t < nt; t += 2) {
            const bool last = (t == nt - 2);
            const char* a1 = cA + (size_t)(t + 1) * kstep;
            const char* a2 = last ? nA : cA + (size_t)(t + 2) * kstep; const char* b2 = last ? nB : cB + (size_t)(t + 2) * kstep;
            const char* a3 = a2 + kstep; const char* b3 = b2 + kstep;
            PG8_LDB(B0, 0, 0); PG8_LDB(B1, 0, 1); PG8_SCHED; PG8_LDA(At, 0, 0); PG8_STAGE(PG8_SA(1, 1), a1 + hstepA, vc[NVH - 1]);
            if constexpr (Loc::GATHER) { if (last) {
#pragma unroll
                for (int h = 0; h < 2; ++h)
#pragma unroll
                    for (int i = 0; i < 2; ++i) vc[h][i] = vn[h][i]; } }
            PG8_WAIT_V(8); PG8_WAIT_L(0); PG8_BAR; PG8_MMA(0, 0, At, B0); PG8_MMA(0, 1, At, B1); PG8_BAR; PG8_SCHED;
            PG8_LDA(At, 0, 1); PG8_STAGE(PG8_SB(0, 0), b2, voffB); PG8_STAGE(PG8_SB(0, 1), b2 + hstepB, voffB); PG8_STAGE(PG8_SA(0, 0), a2, vc[0]);
            PG8_WAIT_V(8); PG8_WAIT_L(0); PG8_BAR; PG8_MMA(1, 0, At, B0); PG8_MMA(1, 1, At, B1); PG8_BAR; PG8_SCHED;
            PG8_LDB(B0, 1, 0); PG8_LDB(B1, 1, 1); PG8_SCHED; PG8_LDA(At, 1, 0); PG8_STAGE(PG8_SA(0, 1), a2 + hstepA, vc[NVH - 1]);
            PG8_WAIT_V(8); PG8_WAIT_L(0); PG8_BAR; PG8_MMA(0, 0, At, B0); PG8_MMA(0, 1, At, B1); PG8_BAR; PG8_SCHED;
            PG8_LDA(At, 1, 1); PG8_STAGE(PG8_SB(1, 0), b3, voffB); PG8_STAGE(PG8_SB(1, 1), b3 + hstepB, voffB); PG8_STAGE(PG8_SA(1, 0), a3, vc[0]);
            PG8_WAIT_V(8); PG8_WAIT_L(0); PG8_BAR; PG8_MMA(1, 0, At, B0); PG8_MMA(1, 1, At, B1); PG8_BAR; PG8_SCHED;
        }
        if (wr == 0) PG8_BAR;
        E(acc, cur, wr, wc, fr, fq);
        if (!has_next) break;
#pragma unroll
        for (int a = 0; a < 2; ++a)
#pragma unroll
            for (int b = 0; b < 2; ++b)
#pragma unroll
                for (int m = 0; m < 4; ++m)
#pragma unroll
                    for (int n = 0; n < 2; ++n) acc[a][b][m][n] = (f32x4){0.f, 0.f, 0.f, 0.f};
        cur = nxt; cA = nA; cB = nB; ++ui;
        if (wr == 1) PG8_BAR;
    }
    PG8_WAIT_V(0);
    PG8_BAR;
#undef PG8_SA
#undef PG8_SB
#undef PG8_STAGE
#undef PG8_LDA
#undef PG8_LDB
#undef PG8_MMA
#undef PG8_WAIT_V
#undef PG8_WAIT_L
#undef PG8_BAR
#undef PG8_SCHED
}
}
constexpr int NWAVES = 8;
constexpr int M = 32768, DM = 1024, SEQ = 4096, NBATCH = 8, NLAYER = 4;
constexpr int NH = 8;
constexpr int IN_W = 6048;
constexpr int FFN = 2816, EXD = 3584, NEXP = 8;
constexpr float LN_EPS = 1e-5f, ALPHA = 1.681792830507429f;
constexpr int S5T = 32, S5CH = M / S5T  , S5K = 640, S5NC = SEQ / S5T  ;
constexpr int MOE_CAP = 65536;
constexpr int MOE_ROWS = 65536 + 8 * 256;

constexpr size_t MiB = 1u << 20;
constexpr size_t WS_CTL = 0, CTL_ZERO_BYTES = 1 * MiB;
constexpr size_t WS_WIN = 1 * MiB;
constexpr size_t WS_WG = 25 * MiB;
constexpr size_t WS_WUQ = 49 * MiB;
constexpr size_t WS_WUKV = 52 * MiB;
constexpr size_t WS_WLORA = 54 * MiB;
constexpr size_t WS_WVRES = 57 * MiB;
constexpr size_t WS_WGLU = 59 * MiB;
constexpr size_t WS_WBR = 61 * MiB;
constexpr size_t WS_WOUT = 73 * MiB;
constexpr size_t WS_WFGU = 81 * MiB;
constexpr size_t WS_WFD = 103 * MiB;
constexpr size_t WS_S5MAIN = 898 * MiB;
constexpr size_t WS_S5END = 978 * MiB;
constexpr size_t WS_S5A32 = 1010 * MiB;
constexpr size_t WS_ROPE = 143 * MiB;
constexpr size_t WS_XB = 147 * MiB;
constexpr size_t WS_VFIRST = 211 * MiB;
constexpr size_t RB = 243 * MiB;
constexpr size_t WS_S5U = RB + 0;
constexpr size_t WS_S1 = RB + 40 * MiB;
constexpr size_t WS_MLARAW = WS_S1;
constexpr size_t WS_RWRAW = WS_S1 + 48 * MiB;
constexpr size_t WS_Q = WS_S1;
constexpr size_t WS_V = WS_S1 + 48 * MiB;
constexpr size_t WS_BV = WS_S1 + 80 * MiB;
constexpr size_t WS_DCY = WS_S1 + 112 * MiB;
constexpr size_t WS_YS5G = WS_S1;
constexpr size_t WS_YS5 = WS_S1 + 32 * MiB;
constexpr size_t WS_MIXED = WS_S1 + 64 * MiB;
constexpr size_t WS_R = RB + 200 * MiB;
constexpr size_t WS_KH = RB + 232 * MiB;
constexpr size_t WS_KKN = RB + 264 * MiB;
constexpr size_t WS_GL = RB + 296 * MiB;
constexpr size_t WS_GBUF = RB + 264 * MiB;
constexpr size_t WS_VFIN = RB + 328 * MiB;
constexpr size_t WS_K = RB + 360 * MiB;
constexpr size_t WS_VRAW = RB + 408 * MiB;
constexpr size_t WS_YRW = WS_VRAW;
constexpr size_t WS_S2 = RB + 440 * MiB;
constexpr size_t WS_CQN = WS_S2;
constexpr size_t WS_CKVN = WS_S2 + 24 * MiB;
constexpr size_t WS_LORAIN = WS_S2 + 40 * MiB;
constexpr size_t WS_YMLA = WS_S2;
constexpr size_t WS_XEND = RB + 496 * MiB;
constexpr size_t WS_GBUF2 = RB + 512 * MiB;
constexpr size_t WS_MIXED2 = RB + 576 * MiB;
constexpr size_t WS_HB = RB + 0;
constexpr size_t WS_WMGU = RB + 0;
constexpr size_t WS_YPAIR = RB + 0;
constexpr size_t WS_HM = RB + 132 * MiB;
constexpr size_t WS_WMD = RB + 594 * MiB;
constexpr size_t WS_SLOTTOK = RB + 650 * MiB;
constexpr size_t WS_SLOTW = RB + 652 * MiB;
constexpr size_t WS_PAIRPOS = RB + 654 * MiB;
constexpr size_t WS_END = 1011 * MiB;
constexpr int CW_BAR = 4096;
constexpr int CW_ATTN = 200000;
constexpr int CW_MOECNT = 201024;

constexpr int RING_OFF = 0, RING_BYTES = 131072;
constexpr int LDSCTL_OFF = RING_BYTES, MISC_OFF = LDSCTL_OFF + 320;
constexpr int LDS_BYTES = 147456;

#define GAS __attribute__((address_space(1)))
#define LAS __attribute__((address_space(3)))
typedef unsigned short bf16;
typedef _Float16 f16;
typedef f16 f16x8 __attribute__((ext_vector_type(8)));
typedef unsigned v4u __attribute__((ext_vector_type(4)));
typedef unsigned v2u __attribute__((ext_vector_type(2)));
typedef float f32x4 __attribute__((ext_vector_type(4)));
typedef float f32x16 __attribute__((ext_vector_type(16)));
typedef short bf16x8 __attribute__((ext_vector_type(8)));
typedef short s16x4 __attribute__((ext_vector_type(4)));
typedef GAS unsigned gu32;
#define RLX_AGENT __ATOMIC_RELAXED, __HIP_MEMORY_SCOPE_AGENT
#define LDS_WAIT() asm volatile("s_waitcnt lgkmcnt(0)" ::: "memory")
using pg8::cvt_pk_bf16; using pg8::pack8; using pg8::unpack8; using pg8::bf_lo; using pg8::bf_hi;

__device__ __forceinline__ float sigm(float x) { return __builtin_amdgcn_rcpf(1.0f + __expf(-x)); }
__device__ __forceinline__ float gelu_tanh(float y) { const float u = 0.7978845608028654f * (y + 0.044715f * y * y * y); const float t = 1.0f - 2.0f * __builtin_amdgcn_rcpf(__expf(2.0f * u) + 1.0f); return 0.5f * y * (1.0f + t); }
__device__ __forceinline__ float wave_sum(float v) {
#pragma unroll
    for (int o = 1; o < 64; o <<= 1) v += __shfl_xor(v, o);
    return v;
}
__device__ __forceinline__ v4u ld_nt16(const void* p) { return __builtin_nontemporal_load((const v4u*)p); }
__device__ __forceinline__ void f16x8_to_f32(const f16x8 h, float (&o)[8]) {
#pragma unroll
    for (int j = 0; j < 8; ++j) o[j] = (float)h[j];
}
__device__ __forceinline__ f16x8 f32_to_f16x8(const float (&v)[8]) { f16x8 h;
#pragma unroll
    for (int j = 0; j < 8; ++j) h[j] = (f16)v[j];
    return h; }
__device__ __forceinline__ void bf16x8_to_f32(const v4u w, float (&o)[8]) { o[0] = bf_lo(w.x); o[1] = bf_hi(w.x); o[2] = bf_lo(w.y); o[3] = bf_hi(w.y); o[4] = bf_lo(w.z); o[5] = bf_hi(w.z); o[6] = bf_lo(w.w); o[7] = bf_hi(w.w); }
__device__ __forceinline__ v4u f32_to_bf16x8(const float (&v)[8]) { v4u w; w.x = cvt_pk_bf16(v[0], v[1]); w.y = cvt_pk_bf16(v[2], v[3]); w.z = cvt_pk_bf16(v[4], v[5]); w.w = cvt_pk_bf16(v[6], v[7]); return w; }
__device__ __forceinline__ void ld8f(const float* p, float (&o)[8]) { const f32x4 a = *(const f32x4*)p, b = *(const f32x4*)(p + 4); o[0] = a[0]; o[1] = a[1]; o[2] = a[2]; o[3] = a[3]; o[4] = b[0]; o[5] = b[1]; o[6] = b[2]; o[7] = b[3]; }

#define XB_TMO      128
#define XB_XCNT(j)  (256  + 64 * (j))
#define XB_XSUB(j)  (1280 + 64 * (j))
#define XB_XGEN(j)  (2304 + 64 * (j))
#define XB_TOP      3328
#define XB_TOPGEN   3392
#define XCD_BAR_WORDS 3456
#define XB_SPIN_CAP (1u << 20)

__device__ __forceinline__ unsigned xb_ld(unsigned* p)              { return __hip_atomic_load(p, __ATOMIC_RELAXED, __HIP_MEMORY_SCOPE_AGENT); }
__device__ __forceinline__ unsigned xb_add(unsigned* p, unsigned v) { return __hip_atomic_fetch_add(p, v, __ATOMIC_RELAXED, __HIP_MEMORY_SCOPE_AGENT); }
__device__ __forceinline__ unsigned xb_xcc_id() { return (unsigned)__builtin_amdgcn_s_getreg((3 << 11) | 20) & 0xFu; }
#define XB_SPIN(cond, bar) do { unsigned _sp = 0; while (cond) { __builtin_amdgcn_s_sleep(1); \
    if ((++_sp & 255u) == 0u) { if (xb_ld(&(bar)[XB_TMO])) break; if (_sp > XB_SPIN_CAP) { atomicAdd(&(bar)[XB_TMO], 1u); break; } } } } while (0)

struct XcdBarrier { unsigned* bar; unsigned x; volatile LAS unsigned* st; };

__device__ __forceinline__ XcdBarrier xcd_barrier_post(unsigned* bar, volatile LAS unsigned* st) {
    XcdBarrier b; b.bar = bar; b.x = xb_xcc_id(); b.st = st;
    if (threadIdx.x == 0) (void)xb_add(&bar[XB_XCNT(b.x)], 1u);
    return b;
}
__device__ __forceinline__ void xcd_barrier_complete(unsigned* bar, unsigned x, unsigned& nloc, unsigned& nx) {
    const unsigned G = gridDim.x * gridDim.y * gridDim.z;
    unsigned sum, cnt, mine, sp = 0u;
    for (;;) {
        sum = 0u; cnt = 0u; mine = 0u;
#pragma unroll
        for (unsigned j = 0; j < 16; ++j) { const unsigned c = xb_ld(&bar[XB_XCNT(j)]); sum += c; cnt += (c > 0u) ? 1u : 0u; mine = (j == x) ? c : mine; }
        if (sum == G) break;
        __builtin_amdgcn_s_sleep(1);
        if ((++sp & 255u) == 0u) { if (xb_ld(&bar[XB_TMO])) break; if (sp > XB_SPIN_CAP) { atomicAdd(&bar[XB_TMO], 1u); break; } }
    }
    nloc = mine > 0u ? mine : 1u; nx = cnt > 0u ? cnt : 1u;
}
__device__ __forceinline__ void xcd_barrier(const XcdBarrier& b) {
    asm volatile("s_waitcnt vmcnt(0)" ::: "memory");
    __syncthreads();
    if (threadIdx.x == 0) {
        unsigned* bar = b.bar;
        __builtin_amdgcn_s_waitcnt(0);
        unsigned nloc = b.st[0], nx = b.st[1];
        if (nloc == 0u) { xcd_barrier_complete(bar, b.x, nloc, nx); b.st[0] = nloc; b.st[1] = nx; }
        const unsigned old = xb_add(&bar[XB_XSUB(b.x)], 1u);
        const unsigned gen = old / nloc;
        if (old + 1u == (gen + 1u) * nloc) {
            __builtin_amdgcn_fence(__ATOMIC_RELEASE, "agent");
            asm volatile("s_waitcnt vmcnt(0)" ::: "memory");
            const unsigned og = xb_add(&bar[XB_TOP], 1u);
            const unsigned tg = og / nx;
            if (og + 1u == (tg + 1u) * nx) xb_add(&bar[XB_TOPGEN], 1u);
            else XB_SPIN(xb_ld(&bar[XB_TOPGEN]) == tg, bar);
            __builtin_amdgcn_fence(__ATOMIC_ACQUIRE, "agent");
            xb_add(&bar[XB_XGEN(b.x)], 1u);
            asm volatile("s_waitcnt vmcnt(0)" ::: "memory");
        } else {
            XB_SPIN(xb_ld(&bar[XB_XGEN(b.x)]) == gen, bar);
            __builtin_amdgcn_fence(__ATOMIC_ACQUIRE, "agent");
            asm volatile("s_waitcnt vmcnt(0)" ::: "memory");
        }
    }
    __syncthreads();
}

struct Args { const void* in[44]; float* out; unsigned char* ws; int ph_lo, ph_hi, li, pad; };
typedef const __attribute__((address_space(4))) Args* KArgs;
struct Frame {
    LAS unsigned char* lds;
    unsigned char* ws;
    gu32* ctl;
    int tid, lane, wave;
    int G, blk;
    float* out;
    KArgs ka;
};
#define MKFRAME(F) Frame F; { int t_ = threadIdx.x; asm volatile("" : "+v"(t_)); KArgs k_ = (KArgs)__builtin_amdgcn_kernarg_segment_ptr(); asm volatile("" : "+s"(k_)); \
    F.lds = (LAS unsigned char*)lds_raw; F.ka = k_; F.ws = k_->ws; F.ctl = (gu32*)(k_->ws + WS_CTL); F.out = k_->out; F.tid = t_; F.lane = t_ & 63; F.wave = __builtin_amdgcn_readfirstlane(t_ >> 6); F.G = gridDim.x; F.blk = blockIdx.x; }
#define WSP(T, off) ((T*)(F.ws + (off)))
#define INP(T, i) ((const T*)F.ka->in[i])
using pg8::Unit; using pg8::Epi8; using pg8::EpiGU;
__device__ __forceinline__ void f4x2_to8(const f32x4 v0, const f32x4 v1, float (&o)[8]) { o[0] = v0[0]; o[1] = v0[1]; o[2] = v0[2]; o[3] = v0[3]; o[4] = v1[0]; o[5] = v1[1]; o[6] = v1[2]; o[7] = v1[3]; }

struct FProj {
    static constexpr int BATCH = 8; bf16* mla; bf16* rw; bf16* s5u;
    __device__ __forceinline__ void begin_col(const Unit&, int) {}
    typedef pg8::NoPre Pre; __device__ __forceinline__ Pre pre(const Unit&, int, int) const { return Pre{}; }
    __device__ __forceinline__ void tile8(const Unit&, int row, int col, const f32x4 v0, const f32x4 v1, const Pre&) const {
        const v4u w = pack8(v0, v1);
        if (col < 768) *(v4u*)(mla + (unsigned)row * 768 + col) = w;
        else if (col < 2560) *(v4u*)(rw + (unsigned)row * 1792 + (col - 768)) = w;
        else { const int c = col - 2560, g = c >> 4, i = c & 15; *(v4u*)(s5u + (unsigned)((g * S5CH + (row >> 5)) * S5K) + (row & 31) * 16 + i) = w; }
    }
};
struct FQup {
    static constexpr int BATCH = 4; bf16* Q; const float* cs; float qs;
    struct Pre { f32x4 c, s; };
    __device__ __forceinline__ void begin_col(const Unit&, int) {}
    __device__ __forceinline__ Pre pre(const Unit&, int row, int col) const { Pre p; const int head = col / 96, w = (col - head * 96) >> 3;
        if (w >= 8) { const int i0 = (w - 8) * 4; p.c = *(const f32x4*)(cs + (unsigned)row * 32 + i0); p.s = *(const f32x4*)(cs + (unsigned)row * 32 + 16 + i0); } else { p.c = (f32x4){0.f, 0.f, 0.f, 0.f}; p.s = p.c; } return p; }
    __device__ __forceinline__ void tile8(const Unit&, int row, int col, const f32x4 v0, const f32x4 v1, const Pre& p) const {
        const int head = col / 96, w = (col - head * 96) >> 3;
        bf16* q = Q + (unsigned)row * 768 + head * 96;
        if (w < 8) { *(v4u*)(q + 8 * w) = pack8(v0 * qs, v1 * qs); }
        else { const int i0 = (w - 8) * 4; const f32x4 c = p.c, s = p.s;
            const f32x4 x1 = (f32x4){v0[0], v0[2], v1[0], v1[2]}, x2 = (f32x4){v0[1], v0[3], v1[1], v1[3]};
            const f32x4 o1 = (x1 * c - x2 * s) * qs, o2 = (x1 * s + x2 * c) * qs;
            v2u a, b; a.x = cvt_pk_bf16(o1[0], o1[1]); a.y = cvt_pk_bf16(o1[2], o1[3]); b.x = cvt_pk_bf16(o2[0], o2[1]); b.y = cvt_pk_bf16(o2[2], o2[3]);
            *(v2u*)(q + 64 + i0) = a; *(v2u*)(q + 80 + i0) = b; }
    }
};
struct FKVup {
    static constexpr int BATCH = 8; bf16* K; bf16* V;
    __device__ __forceinline__ void begin_col(const Unit&, int) {}
    typedef pg8::NoPre Pre; __device__ __forceinline__ Pre pre(const Unit&, int, int) const { return Pre{}; }
    __device__ __forceinline__ void tile8(const Unit&, int row, int col, const f32x4 v0, const f32x4 v1, const Pre&) const {
        const int head = col >> 7, d = col & 127; const v4u w = pack8(v0, v1);
        if (d < 64) *(v4u*)(K + (unsigned)row * 768 + head * 96 + d) = w; else *(v4u*)(V + (unsigned)row * 512 + head * 64 + (d - 64)) = w;
    }
};
struct FLora {
    static constexpr int BATCH = 4;
    const float* w0; const float* a0; const float* k_a; f16* dcy; f16* kh; const f16* kkn; f16* bv; bf16* gl; float p[8], ka[8];
    struct Pre { f16x8 k, kn; };
    __device__ __forceinline__ void begin_col(const Unit&, int col) { const int seg = col >> 9, c = col & 511; ld8f(((seg == 0) ? w0 : a0) + c, p); ld8f(k_a + c, ka); }
    __device__ __forceinline__ Pre pre(const Unit&, int row, int col) const { Pre r; const unsigned off = (unsigned)row * 512 + (col & 511);
        if ((col >> 9) == 1) { r.k = *(const f16x8*)(kh + off); r.kn = *(const f16x8*)(kkn + off); } else { r.k = (f16x8)(0); r.kn = (f16x8)(0); } return r; }
    __device__ __forceinline__ void tile8(const Unit&, int row, int col, const f32x4 v0, const f32x4 v1, const Pre& pr) const {
        float a[8]; f4x2_to8(v0, v1, a);
        const int seg = col >> 9, c = col & 511; const unsigned off = (unsigned)row * 512 + c;
        if (seg == 0) { float o[8];
#pragma unroll
            for (int j = 0; j < 8; ++j) { const float e = 0.6065306597126334f * sigm(p[j] + a[j]); o[j] = -expm1f(-e); }
            *(f16x8*)(dcy + off) = f32_to_f16x8(o); }
        else if (seg == 1) { float k[8], kn[8]; f16x8_to_f32(pr.k, k); f16x8_to_f32(pr.kn, kn); float o1[8], o2[8];
#pragma unroll
            for (int j = 0; j < 8; ++j) { const float ic = sigm(p[j] + a[j]); o1[j] = k[j] * (1.0f + (ic - 1.0f) * ka[j]); o2[j] = kn[j] * ic; }
            *(f16x8*)(kh + off) = f32_to_f16x8(o1); *(f16x8*)(bv + off) = f32_to_f16x8(o2); }
        else { *(v4u*)(gl + off) = pack8(v0, v1); }
    }
};
struct FVres {
    static constexpr int BATCH = 4;
    const float* vb; const bf16* vraw; const bf16* vfirst; f16* vfin; float p[8];
    struct Pre { v4u v, vf; };
    __device__ __forceinline__ void begin_col(const Unit&, int col) { ld8f(vb + col, p); }
    __device__ __forceinline__ Pre pre(const Unit&, int row, int col) const { Pre r; const unsigned off = (unsigned)row * 512 + col; r.v = *(const v4u*)(vraw + off); r.vf = *(const v4u*)(vfirst + off); return r; }
    __device__ __forceinline__ void tile8(const Unit&, int row, int col, const f32x4 v0, const f32x4 v1, const Pre& pr) const {
        float a[8], v[8], vf[8], o[8]; f4x2_to8(v0, v1, a); const unsigned off = (unsigned)row * 512 + col;
        bf16x8_to_f32(pr.v, v); bf16x8_to_f32(pr.vf, vf);
#pragma unroll
        for (int j = 0; j < 8; ++j) o[j] = v[j] + (vf[j] - v[j]) * sigm(p[j] + a[j]);
        *(f16x8*)(vfin + off) = f32_to_f16x8(o);
    }
};
struct FS5End {
    static constexpr int BATCH = 8; float* xend;
    __device__ __forceinline__ void begin_col(const Unit&, int) {}
    typedef pg8::NoPre Pre; __device__ __forceinline__ Pre pre(const Unit&, int, int) const { return Pre{}; }
    __device__ __forceinline__ void tile8(const Unit& u, int row, int col, const f32x4 v0, const f32x4 v1, const Pre&) const {
        if (col < 128) { float* p = xend + (unsigned)((u.z * S5CH + row) * 128 + col); *(f32x4*)p = v0; *(f32x4*)(p + 4) = v1; }
    }
};
struct FS5Main {
    static constexpr int BATCH = 8;
    const bf16* s5u; const float* dvec; bf16* ys5g; float d[8];
    struct Pre { v4u uu; };
    __device__ __forceinline__ void begin_col(const Unit& u, int col) { ld8f(dvec + u.z * 16 + (col & 15), d); }
    __device__ __forceinline__ Pre pre(const Unit& u, int row, int col) const { Pre r; r.uu = *(const v4u*)(s5u + (unsigned)((u.z * S5CH + row) * S5K + col)); return r; }
    __device__ __forceinline__ void tile8(const Unit& u, int row, int col, const f32x4 v0, const f32x4 v1, const Pre& pr) const {
        float a[8], uu[8], o[8]; f4x2_to8(v0, v1, a); const int g = u.z, t = col >> 4, o0 = col & 15;
        bf16x8_to_f32(pr.uu, uu);
#pragma unroll
        for (int j = 0; j < 8; ++j) o[j] = gelu_tanh(a[j] + d[j] * uu[j]);
        *(v4u*)(ys5g + ((unsigned)row * 32 + t) * 512 + g * 16 + o0) = f32_to_bf16x8(o);
    }
};
struct FGlu {
    static constexpr int BATCH = 8;
    const bf16* ys5g; const float* bglu; bf16* ys5; float b[8];
    struct Pre { v4u y; };
    __device__ __forceinline__ void begin_col(const Unit&, int col) { ld8f(bglu + col, b); }
    __device__ __forceinline__ Pre pre(const Unit&, int row, int col) const { Pre r; r.y = *(const v4u*)(ys5g + (unsigned)row * 512 + col); return r; }
    __device__ __forceinline__ void tile8(const Unit&, int row, int col, const f32x4 v0, const f32x4 v1, const Pre& pr) const {
        float a[8], y[8], o[8]; f4x2_to8(v0, v1, a); const unsigned off = (unsigned)row * 512 + col; bf16x8_to_f32(pr.y, y);
#pragma unroll
        for (int j = 0; j < 8; ++j) o[j] = y[j] * sigm(a[j] + b[j]);
        *(v4u*)(ys5 + off) = f32_to_bf16x8(o);
    }
};
struct FGate {
    static constexpr int BATCH = 8; bf16* gbuf;
    __device__ __forceinline__ void begin_col(const Unit&, int) {}
    typedef pg8::NoPre Pre; __device__ __forceinline__ Pre pre(const Unit&, int, int) const { return Pre{}; }
    __device__ __forceinline__ void tile8(const Unit&, int row, int col, const f32x4 v0, const f32x4 v1, const Pre&) const {
        float a[8], o[8]; f4x2_to8(v0, v1, a);
#pragma unroll
        for (int j = 0; j < 8; ++j) o[j] = sigm(a[j]);
        *(v4u*)(gbuf + (unsigned)row * 1024 + col) = f32_to_bf16x8(o);
    }
};
struct FGate2 {
    static constexpr int BATCH = 8; bf16* g0; bf16* g1;
    __device__ __forceinline__ void begin_col(const Unit&, int) {}
    typedef pg8::NoPre Pre; __device__ __forceinline__ Pre pre(const Unit&, int, int) const { return Pre{}; }
    __device__ __forceinline__ void tile8(const Unit&, int row, int col, const f32x4 v0, const f32x4 v1, const Pre&) const {
        float a[8], o[8]; f4x2_to8(v0, v1, a);
#pragma unroll
        for (int j = 0; j < 8; ++j) o[j] = sigm(a[j]);
        bf16* g = (col < 1024) ? g0 : g1;
        *(v4u*)(g + (unsigned)row * 1024 + (col & 1023)) = f32_to_bf16x8(o);
    }
};
struct FMerge {
    static constexpr int BATCH = 8; const bf16* gbuf; const bf16* min_; bf16* mout; int first; float scale;
    struct Pre { v4u g, m; };
    __device__ __forceinline__ void begin_col(const Unit&, int) {}
    __device__ __forceinline__ Pre pre(const Unit&, int row, int col) const { Pre r; const unsigned off = (unsigned)row * 1024 + col; r.g = *(const v4u*)(gbuf + off); if (!first) r.m = *(const v4u*)(min_ + off); else r.m = (v4u){0u, 0u, 0u, 0u}; return r; }
    __device__ __forceinline__ void tile8(const Unit&, int row, int col, const f32x4 v0, const f32x4 v1, const Pre& pr) const {
        float a[8], g[8], mprev[8], o[8]; f4x2_to8(v0, v1, a); const unsigned off = (unsigned)row * 1024 + col; bf16x8_to_f32(pr.g, g); bf16x8_to_f32(pr.m, mprev);
#pragma unroll
        for (int j = 0; j < 8; ++j) o[j] = mprev[j] + g[j] * a[j] * scale;
        *(v4u*)(mout + off) = f32_to_bf16x8(o);
    }
};
struct FResid {
    static constexpr int BATCH = 8; const bf16* xin; float* xout;
    struct Pre { v4u x; };
    __device__ __forceinline__ void begin_col(const Unit&, int) {}
    __device__ __forceinline__ Pre pre(const Unit&, int row, int col) const { Pre r; r.x = *(const v4u*)(xin + (unsigned)row * 1024 + col); return r; }
    __device__ __forceinline__ void tile8(const Unit&, int row, int col, const f32x4 v0, const f32x4 v1, const Pre& pr) const {
        const unsigned off = (unsigned)row * 1024 + col; float x[8]; bf16x8_to_f32(pr.x, x);
        *(f32x4*)(xout + off) = (f32x4){x[0], x[1], x[2], x[3]} * ALPHA + v0; *(f32x4*)(xout + off + 4) = (f32x4){x[4], x[5], x[6], x[7]} * ALPHA + v1;
    }
};
struct FSwiglu {
    bf16* h; int ldh;
    __device__ __forceinline__ void pair8(const Unit&, int row, int colh, const f32x4 g0, const f32x4 g1, const f32x4 u0, const f32x4 u1) const {
        float g[8], uu[8], o[8]; f4x2_to8(g0, g1, g); f4x2_to8(u0, u1, uu);
#pragma unroll
        for (int j = 0; j < 8; ++j) o[j] = g[j] * sigm(g[j]) * uu[j];
        *(v4u*)(h + (unsigned)row * ldh + colh) = f32_to_bf16x8(o);
    }
};
struct FMoeDown {
    static constexpr int BATCH = 8; bf16* ypair; const float* slotw; const unsigned* cnt;
    struct Pre { float w; };
    __device__ __forceinline__ void begin_col(const Unit&, int) {}
    __device__ __forceinline__ Pre pre(const Unit& u, int row, int) const { Pre r; const int rk = u.aux + (row - u.pm * 256); r.w = ((unsigned)rk < cnt[u.z]) ? slotw[(unsigned)(u.z * MOE_CAP + rk)] : 0.f; return r; }
    __device__ __forceinline__ void tile8(const Unit& u, int row, int col, const f32x4 v0, const f32x4 v1, const Pre& pr) const {
        const int rk = u.aux + (row - u.pm * 256);
        if ((unsigned)rk < cnt[u.z]) *(v4u*)(ypair + (unsigned)row * 1024 + col) = pack8(v0 * pr.w, v1 * pr.w);
    }
};

struct MoeOrder {
    int nN, G, c; int pt[NEXP + 1];
    __device__ void init(const unsigned* cnt, int nN_, int G_, int c_) { nN = nN_; G = G_; c = c_; pt[0] = 0;
#pragma unroll
        for (int e = 0; e < NEXP; ++e) pt[e + 1] = pt[e] + (int)((cnt[e] + 255u) >> 8); }
    __device__ bool next(int i, Unit& u) const {
        const long L = (long)i * G + c; if (L >= (long)pt[NEXP] * nN) return false;
        const int tile = (int)(L / nN); u.pn = (int)(L % nN); int e = 0;
#pragma unroll
        for (int k = 1; k < NEXP; ++k) e += (tile >= pt[k]) ? 1 : 0;
        int base = 0;
#pragma unroll
        for (int k = 1; k < NEXP; ++k) base = (tile >= pt[k]) ? pt[k] : base;
        u.z = e; u.pm = tile; u.aux = (tile - base) * 256; return true;
    }
};
struct LocMoe1 {
    static constexpr bool GATHER = true;
    const bf16* A; const bf16* Bt; int lda, ldb, K; const int* slot_tok; const unsigned* cnt;
    __device__ __forceinline__ const char* a_ptr(const Unit&) const { return (const char*)A; }
    __device__ __forceinline__ const char* b_ptr(const Unit& u) const { return (const char*)(Bt + (size_t)u.z * (2 * EXD) * DM + (size_t)u.pn * 256 * ldb); }
    __device__ __forceinline__ void a_off(const Unit& u, int tid, unsigned (&v)[2][2]) const {
        const unsigned n = cnt[u.z];
#pragma unroll
        for (int i = 0; i < 2; ++i) { int R, C; pg8::stage_rc(tid * 16 + i * 8192, R, C);
#pragma unroll
            for (int h = 0; h < 2; ++h) { const int r = u.aux + h * 128 + R; const int tok = ((unsigned)r < n) ? slot_tok[(unsigned)(u.z * MOE_CAP + r)] : 0; v[h][i] = (unsigned)(tok * lda + C) * 2u; } }
    }
};
__device__ __forceinline__ int qperm_row(int n) { const int h = n / 96, d = n - h * 96; if (d < 64) return n; const int e = d - 64; return h * 96 + 64 + ((e < 16) ? 2 * e : 2 * (e - 16) + 1); }
template <bool QPERM>
__device__ __forceinline__ void tr_item(const float* W, int ldw, int k0, int n0, const float* ksc, bf16* WT, int ldd, int kd0, int drow0, LAS float* scr, int lane) {
    if (W) {
#pragma unroll 8
        for (int i = 0; i < 32; ++i) { const int kk = 2 * i + (lane >> 5); float v = W[(size_t)(k0 + kk) * ldw + n0 + (lane & 31)]; if (ksc) v *= ksc[k0 + kk]; scr[kk * 33 + (lane & 31)] = v; }
    } else {
#pragma unroll 8
        for (int i = 0; i < 32; ++i) { const int kk = 2 * i + (lane >> 5); scr[kk * 33 + (lane & 31)] = 0.f; }
    }
    LDS_WAIT(); asm volatile("" ::: "memory");
    const int c = lane & 7;
#pragma unroll
    for (int j = 0; j < 4; ++j) { const int n = (lane >> 3) + 8 * j; const LAS float* s = scr + (8 * c) * 33 + n;
        v4u o; o.x = cvt_pk_bf16(s[0 * 33], s[1 * 33]); o.y = cvt_pk_bf16(s[2 * 33], s[3 * 33]); o.z = cvt_pk_bf16(s[4 * 33], s[5 * 33]); o.w = cvt_pk_bf16(s[6 * 33], s[7 * 33]);
        const int dr = QPERM ? qperm_row(n0 + n) : (drow0 + n);
        *(v4u*)(WT + (size_t)dr * ldd + kd0 + k0 + 8 * c) = o; }
    LDS_WAIT(); asm volatile("" ::: "memory");
}
#define TRJOB(r, W, ldw, K, c0, ncols, ksc, WT, ldd, drow0) { const int _nb = (ncols) / 32, _ni = ((K) / 64) * _nb; if ((r) < _ni) { const int _kb = (r) / _nb, _nbi = (r) % _nb; \
    tr_item<false>((W), (ldw), 64 * _kb, (c0) + 32 * _nbi, (ksc), (WT), (ldd), 0, (drow0) + 32 * _nbi, scr, lane); continue; } (r) -= _ni; }
#define TRJOB_GU(r, W, ldw, K, ncols, WT, ldd, up) { const int _nb = (ncols) / 32, _ni = ((K) / 64) * _nb; if ((r) < _ni) { const int _kb = (r) / _nb, _n0 = 32 * ((r) % _nb); \
    tr_item<false>((W), (ldw), 64 * _kb, _n0, nullptr, (WT), (ldd), 0, (_n0 >> 7) * 256 + (_n0 & 127) + ((up) ? 128 : 0), scr, lane); continue; } (r) -= _ni; }


__device__ __forceinline__ void p0_prologue(Frame& F) {
    LAS float* scr = (LAS float*)(F.lds + F.wave * 16384);
    const int lane = F.lane; const int gw = F.blk * NWAVES + F.wave, NGW = F.G * NWAVES;
    constexpr int PER_LAYER = 16 * 189 + 6 * 24 + 4 * 32 + 192 + 8 * 16 + 3 * 8 * 32 + 16 * 32 + 3 * 16;
    for (int it = gw; it < NLAYER * PER_LAYER; it += NGW) {
        const int l = it / PER_LAYER; int r = it % PER_LAYER;
        const float* win = INP(float, 2) + (size_t)l * DM * IN_W;
        bf16* win_t = WSP(bf16, WS_WIN) + (size_t)l * 3072 * DM; bf16* wg_t = WSP(bf16, WS_WG) + (size_t)l * 3072 * DM;
        TRJOB(r, win, IN_W, DM, 0, 672, nullptr, win_t, DM, 0);
        TRJOB(r, win, IN_W, DM, 672, 2304, nullptr, win_t, DM, 768);
        TRJOB(r, win, IN_W, DM, 2976, 3072, nullptr, wg_t, DM, 0);
        if (r < 48) { tr_item<false>(nullptr, 0, 64 * (r / 3), 0, nullptr, win_t, DM, 0, 672 + 32 * (r % 3), scr, lane); continue; } r -= 48;
        if (r < 144) { const int kb = r / 24, nbi = r % 24; tr_item<true>(INP(float, 4) + (size_t)l * 384 * 768, 768, 64 * kb, 32 * nbi, INP(float, 3) + l * 384, WSP(bf16, WS_WUQ) + (size_t)l * 768 * 384, 384, 0, 0, scr, lane); continue; } r -= 144;
        TRJOB(r, INP(float, 6) + (size_t)l * 256 * 1024, 1024, 256, 0, 1024, INP(float, 5) + l * 256, WSP(bf16, WS_WUKV) + (size_t)l * 1024 * 256, 256, 0);
        if (r < 192) { const int rb = r / 4, kb = r % 4; bf16* wl = WSP(bf16, WS_WLORA) + (size_t)l * 1536 * 256; const float* src = nullptr; int ldw = 512, k0 = 0, n0 = 0;
            if (rb < 16) { if (kb == 0) { src = INP(float, 9) + (size_t)l * 64 * 512; n0 = 32 * rb; } }
            else if (rb < 32) { if (kb == 1) { src = INP(float, 11) + (size_t)l * 64 * 512; n0 = 32 * (rb - 16); } }
            else { if (kb >= 2) { src = INP(float, 12) + (size_t)l * 128 * 512; k0 = 64 * (kb - 2); n0 = 32 * (rb - 32); } }
            tr_item<false>(src, ldw, k0, n0, nullptr, wl, 256, 64 * kb - k0, 32 * rb, scr, lane); continue; } r -= 192;
        TRJOB(r, INP(float, 29) + (size_t)l * 512 * 512, 512, 512, 0, 512, nullptr, WSP(bf16, WS_WGLU) + (size_t)l * 512 * 512, 512, 0);
        TRJOB(r, INP(float, 31) + (size_t)(l * 3 + 0) * 512 * 1024, 1024, 512, 0, 1024, nullptr, WSP(bf16, WS_WBR) + (size_t)(l * 3 + 0) * 1024 * 512, 512, 0);
        TRJOB(r, INP(float, 31) + (size_t)(l * 3 + 1) * 512 * 1024, 1024, 512, 0, 1024, nullptr, WSP(bf16, WS_WBR) + (size_t)(l * 3 + 1) * 1024 * 512, 512, 0);
        TRJOB(r, INP(float, 31) + (size_t)(l * 3 + 2) * 512 * 1024, 1024, 512, 0, 1024, nullptr, WSP(bf16, WS_WBR) + (size_t)(l * 3 + 2) * 1024 * 512, 512, 0);
        TRJOB(r, INP(float, 32) + (size_t)l * DM * DM, DM, DM, 0, DM, nullptr, WSP(bf16, WS_WOUT) + (size_t)l * DM * DM, DM, 0);
    }
    constexpr int PER_FFN = 3 * 16 * 88;
    for (int it = gw; it < 2 * PER_FFN; it += NGW) {
        const int i = it / PER_FFN; int r = it % PER_FFN;
        TRJOB_GU(r, INP(float, 37) + (size_t)i * DM * FFN, FFN, DM, FFN, WSP(bf16, WS_WFGU) + (size_t)i * 2 * FFN * DM, DM, 0);
        TRJOB_GU(r, INP(float, 38) + (size_t)i * DM * FFN, FFN, DM, FFN, WSP(bf16, WS_WFGU) + (size_t)i * 2 * FFN * DM, DM, 1);
        TRJOB(r, INP(float, 39) + (size_t)i * FFN * DM, DM, FFN, 0, DM, nullptr, WSP(bf16, WS_WFD) + (size_t)i * DM * FFN, FFN, 0);
    }
    for (int it = F.blk * 512 + F.tid; it < 3 * 512 * 64; it += F.G * 512) {
        const int i = it / (512 * 64), rem = it % (512 * 64), n = rem >> 6, k0 = (rem & 63) * 8;
        const float* vd = INP(float, 18) + (size_t)i * 512 * 32; const float* vu = INP(float, 19) + (size_t)i * 32 * 512; float o[8];
#pragma unroll
        for (int j = 0; j < 8; ++j) o[j] = 0.f;
        for (int rr = 0; rr < 32; ++rr) { const float u = vu[rr * 512 + n];
#pragma unroll
            for (int j = 0; j < 8; ++j) o[j] += vd[(k0 + j) * 32 + rr] * u; }
        *(v4u*)(WSP(bf16, WS_WVRES) + (size_t)i * 512 * 512 + (size_t)n * 512 + k0) = f32_to_bf16x8(o);
    }
    for (int it = F.blk * 512 + F.tid; it < M * 16; it += F.G * 512) {
        const int m = it >> 4, i = it & 15; const float inv = powf(10000.0f, -(float)i * (1.0f / 16.0f)); const float ang = (float)INP(int, 1)[m] * inv;
        float sn, cn; sincosf(ang, &sn, &cn); float* cs = WSP(float, WS_ROPE) + (size_t)m * 32; cs[i] = cn; cs[16 + i] = sn;
    }
}
__device__ __forceinline__ void moe_convert(Frame& F, int li) {
    LAS float* scr = (LAS float*)(F.lds + F.wave * 16384);
    const int lane = F.lane; const int gw = F.blk * NWAVES + F.wave, NGW = F.G * NWAVES;
    constexpr int PER_E = 2 * 16 * 112 + 56 * 32;
    for (int it = gw; it < NEXP * PER_E; it += NGW) {
        const int e = it / PER_E; int r = it % PER_E; const size_t wi = (size_t)(li * NEXP + e);
        TRJOB_GU(r, INP(float, 41) + wi * DM * EXD, EXD, DM, EXD, WSP(bf16, WS_WMGU) + (size_t)e * 2 * EXD * DM, DM, 0);
        TRJOB_GU(r, INP(float, 42) + wi * DM * EXD, EXD, DM, EXD, WSP(bf16, WS_WMGU) + (size_t)e * 2 * EXD * DM, DM, 1);
        TRJOB(r, INP(float, 43) + wi * EXD * DM, DM, EXD, 0, DM, nullptr, WSP(bf16, WS_WMD) + (size_t)e * DM * EXD, EXD, 0);
    }
}

__device__ __forceinline__ void ph2_prep(Frame& F, int l) {
    const int lane = F.lane; const int gw = F.blk * NWAVES + F.wave, NGW = F.G * NWAVES;
    const bf16* rwraw = WSP(bf16, WS_RWRAW); const bf16* mlaraw = WSP(bf16, WS_MLARAW);
    const float* mu = INP(float, 7) + l * 1792; const float* k_k = INP(float, 13) + l * 512;
    float mu_r[8], mu_k[8], mu_v[8], mu_t[8], kk8[8];
    ld8f(mu + 8 * lane, mu_r); ld8f(mu + 512 + 8 * lane, mu_k); ld8f(mu + 1024 + 8 * lane, mu_v); ld8f(mu + 1536 + 8 * (lane & 31), mu_t); ld8f(k_k + 8 * lane, kk8);
    const float* cs_all = WSP(float, WS_ROPE);
    constexpr int TPW = 16;
    const int m0 = gw * TPW;
    v4u n_r, n_k, n_v, n_t, n_a, n_b, p_r, p_k, p_v, p_t;
    { const bf16* cur = rwraw + (size_t)m0 * 1792; n_r = *(const v4u*)(cur + 8 * lane); n_k = *(const v4u*)(cur + 512 + 8 * lane); n_v = *(const v4u*)(cur + 1024 + 8 * lane); n_t = *(const v4u*)(cur + 1536 + 8 * (lane & 31));
      const bf16* mr = mlaraw + (size_t)m0 * 768; n_a = *(const v4u*)(mr + 8 * lane); n_b = *(const v4u*)(mr + 512 + 8 * (lane & 31));
      if (m0 & (SEQ - 1)) { const bf16* prv = cur - 1792; p_r = *(const v4u*)(prv + 8 * lane); p_k = *(const v4u*)(prv + 512 + 8 * lane); p_v = *(const v4u*)(prv + 1024 + 8 * lane); p_t = *(const v4u*)(prv + 1536 + 8 * (lane & 31)); }
      else { p_r = (v4u){0u, 0u, 0u, 0u}; p_k = p_r; p_v = p_r; p_t = p_r; } }
    for (int i = 0; i < TPW; ++i) {
        const int m = m0 + i;
        const v4u c_r = n_r, c_k = n_k, c_v = n_v, c_t = n_t, c_a = n_a, c_b = n_b;
        if (i + 1 < TPW) { const bf16* nx = rwraw + (size_t)(m + 1) * 1792; n_r = *(const v4u*)(nx + 8 * lane); n_k = *(const v4u*)(nx + 512 + 8 * lane); n_v = *(const v4u*)(nx + 1024 + 8 * lane); n_t = *(const v4u*)(nx + 1536 + 8 * (lane & 31));
            const bf16* mr = mlaraw + (size_t)(m + 1) * 768; n_a = *(const v4u*)(mr + 8 * lane); n_b = *(const v4u*)(mr + 512 + 8 * (lane & 31)); }
        float c[8], p[8], o[8];
        bf16x8_to_f32(c_r, c); bf16x8_to_f32(p_r, p);
#pragma unroll
        for (int j = 0; j < 8; ++j) o[j] = c[j] + (p[j] - c[j]) * mu_r[j];
        *(f16x8*)(WSP(f16, WS_R) + (size_t)m * 512 + 8 * lane) = f32_to_f16x8(o);
        bf16x8_to_f32(c_k, c); bf16x8_to_f32(p_k, p);
        float ss = 0.f;
#pragma unroll
        for (int j = 0; j < 8; ++j) { o[j] = c[j] + (p[j] - c[j]) * mu_k[j]; const float q = o[j] * kk8[j]; ss += q * q; }
        *(f16x8*)(WSP(f16, WS_KH) + (size_t)m * 512 + 8 * lane) = f32_to_f16x8(o);
        ss += __shfl_xor(ss, 1); ss += __shfl_xor(ss, 2); ss += __shfl_xor(ss, 4);
        { const float rn = 1.0f / fmaxf(sqrtf(ss), 1e-12f);
#pragma unroll
          for (int j = 0; j < 8; ++j) o[j] = o[j] * kk8[j] * rn; }
        *(f16x8*)(WSP(f16, WS_KKN) + (size_t)m * 512 + 8 * lane) = f32_to_f16x8(o);
        bf16x8_to_f32(c_v, c); bf16x8_to_f32(p_v, p);
#pragma unroll
        for (int j = 0; j < 8; ++j) o[j] = c[j] + (p[j] - c[j]) * mu_v[j];
        { const v4u vb = f32_to_bf16x8(o); *(v4u*)(WSP(bf16, WS_VRAW) + (size_t)m * 512 + 8 * lane) = vb;
          if (l == 0) { *(v4u*)(WSP(bf16, WS_VFIRST) + (size_t)m * 512 + 8 * lane) = vb; *(f16x8*)(WSP(f16, WS_VFIN) + (size_t)m * 512 + 8 * lane) = f32_to_f16x8(o); } }
        if (lane < 32) {
            bf16x8_to_f32(c_t, c); bf16x8_to_f32(p_t, p);
#pragma unroll
            for (int j = 0; j < 8; ++j) { float v = c[j] + (p[j] - c[j]) * mu_t[j]; if (lane < 8) v = 1.0f - 2.0f * __builtin_amdgcn_rcpf(__expf(2.0f * v) + 1.0f); else if (lane >= 16) v = sigm(v); o[j] = v; }
            *(v4u*)(WSP(bf16, WS_LORAIN) + (size_t)m * 256 + 8 * lane) = f32_to_bf16x8(o);
        }
        p_r = c_r; p_k = c_k; p_v = c_v; p_t = c_t;
        float a8[8], b8[8];
        bf16x8_to_f32(c_a, a8); float ssa = 0.f, ssb = 0.f;
#pragma unroll
        for (int j = 0; j < 8; ++j) ssa += a8[j] * a8[j];
        if (lane < 32) { bf16x8_to_f32(c_b, b8);
#pragma unroll
            for (int j = 0; j < 8; ++j) ssb += b8[j] * b8[j]; } else {
#pragma unroll
            for (int j = 0; j < 8; ++j) b8[j] = 0.f; }
        const float sq = wave_sum(lane < 48 ? ssa : 0.f), skv = wave_sum((lane >= 48 ? ssa : 0.f) + (lane < 16 ? ssb : 0.f));
        const float rq = 1.0f / sqrtf(sq * (1.0f / 384.0f) + 1e-6f), rkv = 1.0f / sqrtf(skv * (1.0f / 256.0f) + 1e-6f);
        if (lane < 48) {
#pragma unroll
            for (int j = 0; j < 8; ++j) o[j] = a8[j] * rq;
            *(v4u*)(WSP(bf16, WS_CQN) + (size_t)m * 384 + 8 * lane) = f32_to_bf16x8(o);
        } else {
#pragma unroll
            for (int j = 0; j < 8; ++j) o[j] = a8[j] * rkv;
            *(v4u*)(WSP(bf16, WS_CKVN) + (size_t)m * 256 + 8 * (lane - 48)) = f32_to_bf16x8(o);
        }
        if (lane < 16) {
#pragma unroll
            for (int j = 0; j < 8; ++j) o[j] = b8[j] * rkv;
            *(v4u*)(WSP(bf16, WS_CKVN) + (size_t)m * 256 + 128 + 8 * lane) = f32_to_bf16x8(o);
        }
        float pr[8];
#pragma unroll
        for (int j = 0; j < 8; ++j) pr[j] = __shfl_xor(b8[j], 2);
        if (lane >= 16 && lane < 20) { const int i0 = 8 * (lane & 1); const float* cs = cs_all + (size_t)m * 32; float cc[8], sn[8]; ld8f(cs + i0, cc); ld8f(cs + 16 + i0, sn);
            const bool lo = lane < 18;
#pragma unroll
            for (int j = 0; j < 8; ++j) o[j] = lo ? (b8[j] * cc[j] - pr[j] * sn[j]) : (pr[j] * sn[j] + b8[j] * cc[j]);
            const v4u w = f32_to_bf16x8(o); bf16* kd = WSP(bf16, WS_K) + (size_t)m * 768 + 64 + (lo ? 0 : 16) + i0;
#pragma unroll
            for (int h = 0; h < NH; ++h) *(v4u*)(kd + h * 96) = w; }
    }
}

__device__ __forceinline__ void s5_gen(Frame& F, int l, int item) {
    {
        __syncthreads();
        const int g = item >> 3, s8 = item & 7, tid = F.tid;
        LAS float* pw = (LAS float*)F.lds;
        LAS float* Bb = pw + 33 * 64 * 2;
        LAS float* Cc = Bb + 64 * 16 * 2;
        LAS float* Kt = Cc + 16 * 64 * 2;
        const float dt = expf(INP(float, 23)[l * 32 + g]);
        const float* are = INP(float, 21) + (size_t)(l * 32 + g) * 64; const float* aim = INP(float, 22) + (size_t)(l * 32 + g) * 64;
        for (int e = tid; e < 33 * 64; e += 512) { const int n = e >> 6, p = e & 63; const float lr = fminf(are[p], -1e-4f), li = aim[p];
            const float mag = expf((float)n * (dt * lr)); float sn, cn; sincosf((float)n * (dt * li), &sn, &cn); pw[2 * e] = mag * cn; pw[2 * e + 1] = mag * sn; }
        for (int e = tid; e < 64 * 16; e += 512) { const int p = e >> 4; const float lr = fminf(are[p], -1e-4f), li = aim[p];
            const float mag = expf(dt * lr); float sn, cn; sincosf(dt * li, &sn, &cn); const float abr = mag * cn, abi = mag * sn, den = lr * lr + li * li;
            const float fr = ((abr - 1.0f) * lr + abi * li) / den, fi = (abi * lr - (abr - 1.0f) * li) / den;
            const float br = INP(float, 24)[(size_t)(l * 32 + g) * 1024 + e], bi = INP(float, 25)[(size_t)(l * 32 + g) * 1024 + e];
            Bb[2 * e] = fr * br - fi * bi; Bb[2 * e + 1] = fr * bi + fi * br; }
        for (int e = tid; e < 16 * 64; e += 512) { Cc[2 * e] = INP(float, 26)[(size_t)(l * 32 + g) * 1024 + e]; Cc[2 * e + 1] = INP(float, 27)[(size_t)(l * 32 + g) * 1024 + e]; }
        __syncthreads();
        { const int tau = tid >> 4, o = tid & 15; float acc[16];
#pragma unroll
          for (int i = 0; i < 16; ++i) acc[i] = 0.f;
          for (int p = 0; p < 64; ++p) { const float cr = Cc[2 * (o * 64 + p)], ci = Cc[2 * (o * 64 + p) + 1], pr_ = pw[2 * (tau * 64 + p)], pi_ = pw[2 * (tau * 64 + p) + 1];
              const float xr = cr * pr_ - ci * pi_, xi = cr * pi_ + ci * pr_;
#pragma unroll
              for (int i = 0; i < 16; ++i) acc[i] += xr * Bb[2 * (p * 16 + i)] - xi * Bb[2 * (p * 16 + i) + 1]; }
#pragma unroll
          for (int i = 0; i < 16; ++i) Kt[(tau * 16 + o) * 16 + i] = acc[i]; }
        __syncthreads();
        bf16* bm = WSP(bf16, WS_S5MAIN) + ((size_t)l * 32 + g) * 512 * S5K;
        for (int e = tid; e < 64 * 80; e += 512) { const int n = 64 * s8 + e / 80, k0 = (e % 80) * 8, t = n >> 4, o = n & 15; float v[8];
            if (k0 < 512) { const int sidx = k0 >> 4, i0 = k0 & 15;
#pragma unroll
                for (int j = 0; j < 8; ++j) v[j] = (sidx <= t) ? Kt[((t - sidx) * 16 + o) * 16 + i0 + j] : 0.f; }
            else {
#pragma unroll
                for (int j = 0; j < 8; ++j) { const int q = k0 - 512 + j, p = q & 63; const float cr = Cc[2 * (o * 64 + p)], ci = Cc[2 * (o * 64 + p) + 1], pr_ = pw[2 * ((t + 1) * 64 + p)], pi_ = pw[2 * ((t + 1) * 64 + p) + 1];
                    v[j] = (q < 64) ? (cr * pr_ - ci * pi_) : -(cr * pi_ + ci * pr_); } }
            *(v4u*)(bm + (size_t)n * S5K + k0) = f32_to_bf16x8(v); }
        bf16* be = WSP(bf16, WS_S5END) + ((size_t)l * 32 + g) * 256 * 512;
        for (int e = tid; e < 32 * 64; e += 512) { const int n = 32 * s8 + e / 64, k0 = (e % 64) * 8, sidx = k0 >> 4, i0 = k0 & 15; float v[8];
            if (n < 128) { const int p = n & 63; const float pr_ = pw[2 * ((31 - sidx) * 64 + p)], pi_ = pw[2 * ((31 - sidx) * 64 + p) + 1];
#pragma unroll
                for (int j = 0; j < 8; ++j) { const float br = Bb[2 * (p * 16 + i0 + j)], bi = Bb[2 * (p * 16 + i0 + j) + 1]; v[j] = (n < 64) ? (pr_ * br - pi_ * bi) : (pr_ * bi + pi_ * br); } }
            else {
#pragma unroll
                for (int j = 0; j < 8; ++j) v[j] = 0.f; }
            *(v4u*)(be + (size_t)n * 512 + k0) = f32_to_bf16x8(v); }
        if (s8 == 0 && tid < 64) { float* a32 = WSP(float, WS_S5A32) + (size_t)((l * 32 + g) * 64 + tid) * 2; a32[0] = pw[2 * (32 * 64 + tid)]; a32[1] = pw[2 * (32 * 64 + tid) + 1]; }
        __syncthreads();
    }
}

__device__ __forceinline__ void ln_core(f32x4 (&v)[4], const float* gam, const float* bet, int lane) {
    float s = 0.f;
#pragma unroll
    for (int j = 0; j < 4; ++j) s += (v[j][0] + v[j][1]) + (v[j][2] + v[j][3]);
    const float mean = wave_sum(s) * (1.f / DM); float s2 = 0.f;
#pragma unroll
    for (int j = 0; j < 4; ++j) { v[j] = v[j] - mean; s2 += (v[j][0] * v[j][0] + v[j][1] * v[j][1]) + (v[j][2] * v[j][2] + v[j][3] * v[j][3]); }
    const float rstd = 1.f / sqrtf(wave_sum(s2) * (1.f / DM) + LN_EPS);
#pragma unroll
    for (int j = 0; j < 4; ++j) { const f32x4 g4 = *(const f32x4*)(gam + 4 * lane + 256 * j), b4 = *(const f32x4*)(bet + 4 * lane + 256 * j); v[j] = v[j] * rstd * g4 + b4; }
}
__device__ __forceinline__ void ln_store(const f32x4 (&v)[4], float* xrow, bf16* xbrow, int lane) {
#pragma unroll
    for (int j = 0; j < 4; ++j) { if (xrow) *(f32x4*)(xrow + 4 * lane + 256 * j) = v[j]; v2u w; w.x = cvt_pk_bf16(v[j][0], v[j][1]); w.y = cvt_pk_bf16(v[j][2], v[j][3]); *(v2u*)(xbrow + 4 * lane + 256 * j) = w; }
}
__device__ __forceinline__ void ln_phase(Frame& F, const float* gam, const float* bet) {
    const int lane = F.lane; const int gw = F.blk * NWAVES + F.wave, NGW = F.G * NWAVES; const float* X = F.out; bf16* Xb = WSP(bf16, WS_XB);
    for (int m = gw; m < M; m += NGW) { f32x4 v[4];
#pragma unroll
        for (int j = 0; j < 4; ++j) v[j] = *(const f32x4*)(X + (size_t)m * DM + 4 * lane + 256 * j);
        ln_core(v, gam, bet, lane); ln_store(v, nullptr, Xb + (size_t)m * DM, lane); }
}
__device__ __forceinline__ void ln2_moe_phase(Frame& F, const float* gam, const float* bet, int li, bool last) {
    const int lane = F.lane; const int gw = F.blk * NWAVES + F.wave, NGW = F.G * NWAVES; float* X = F.out; bf16* Xb = WSP(bf16, WS_XB);
    const unsigned* cnt = (const unsigned*)(F.ctl + CW_MOECNT + 64 * li); int pstart[NEXP]; { int acc = 0;
#pragma unroll
        for (int e = 0; e < NEXP; ++e) { pstart[e] = acc; acc += (int)(((cnt[e] + 255u) >> 8) << 8); } }
    const int* ppos = WSP(int, WS_PAIRPOS); const bf16* yp = WSP(bf16, WS_YPAIR);
    for (int m = gw; m < M; m += NGW) { f32x4 v[4];
        const int p0 = ppos[2 * m], p1 = ppos[2 * m + 1]; int r0 = 0, r1 = 0;
#pragma unroll
        for (int e = 0; e < NEXP; ++e) { if ((p0 >> 24) == e) r0 = pstart[e] + (p0 & 0xffffff); if ((p1 >> 24) == e) r1 = pstart[e] + (p1 & 0xffffff); }
#pragma unroll
        for (int j = 0; j < 4; ++j) { const v2u xw = *(const v2u*)(Xb + (size_t)m * DM + 4 * lane + 256 * j); const f32x4 x = (f32x4){bf_lo(xw.x), bf_hi(xw.x), bf_lo(xw.y), bf_hi(xw.y)};
            const v2u a = *(const v2u*)(yp + (size_t)r0 * DM + 4 * lane + 256 * j), b = *(const v2u*)(yp + (size_t)r1 * DM + 4 * lane + 256 * j);
            v[j] = x * ALPHA + (f32x4){bf_lo(a.x) + bf_lo(b.x), bf_hi(a.x) + bf_hi(b.x), bf_lo(a.y) + bf_lo(b.y), bf_hi(a.y) + bf_hi(b.y)}; }
        ln_core(v, gam, bet, lane); ln_store(v, last ? X + (size_t)m * DM : nullptr, Xb + (size_t)m * DM, lane); }
}
__device__ __forceinline__ void ln1_moe_phase(Frame& F, const float* gam, const float* bet, int li) {
    const int lane = F.lane; float* X = F.out; bf16* Xb = WSP(bf16, WS_XB);
    LAS int* pe = (LAS int*)F.lds;
    LAS float* pwt = (LAS float*)(F.lds + 1024);
    LAS int* cntl = (LAS int*)(F.lds + 2048);
    const float* router = INP(float, 40) + (size_t)li * DM * NEXP;
    for (int blk0 = F.blk; blk0 * 128 < M; blk0 += F.G) {
        __syncthreads();
        for (int i = 0; i < 16; ++i) { const int tl = F.wave * 16 + i, m = blk0 * 128 + tl; f32x4 v[4];
#pragma unroll
            for (int j = 0; j < 4; ++j) v[j] = *(const f32x4*)(X + (size_t)m * DM + 4 * lane + 256 * j);
            ln_core(v, gam, bet, lane); ln_store(v, nullptr, Xb + (size_t)m * DM, lane);
            float lg[NEXP];
#pragma unroll
            for (int e = 0; e < NEXP; ++e) lg[e] = 0.f;
#pragma unroll
            for (int j = 0; j < 4; ++j)
#pragma unroll
                for (int q = 0; q < 4; ++q) { const float xv = v[j][q]; const float* rr = router + (size_t)(4 * lane + 256 * j + q) * NEXP; const f32x4 ra = *(const f32x4*)rr, rb = *(const f32x4*)(rr + 4);
                    lg[0] += xv * ra[0]; lg[1] += xv * ra[1]; lg[2] += xv * ra[2]; lg[3] += xv * ra[3]; lg[4] += xv * rb[0]; lg[5] += xv * rb[1]; lg[6] += xv * rb[2]; lg[7] += xv * rb[3]; }
#pragma unroll
            for (int e = 0; e < NEXP; ++e) lg[e] = wave_sum(lg[e]);
            int e0 = 0; float l0 = lg[0];
#pragma unroll
            for (int e = 1; e < NEXP; ++e) if (lg[e] > l0) { l0 = lg[e]; e0 = e; }
            int e1 = -1; float l1 = -INFINITY;
#pragma unroll
            for (int e = 0; e < NEXP; ++e) if (e != e0 && lg[e] > l1) { l1 = lg[e]; e1 = e; }
            const float w1 = 1.0f / (1.0f + expf(l0 - l1)), w0 = 1.0f - w1;
            if (lane == 0) { pe[2 * tl] = e0; pe[2 * tl + 1] = e1; pwt[2 * tl] = w0; pwt[2 * tl + 1] = w1; }
        }
        __syncthreads();
        int myrank = 0, mye = 0;
        if (F.tid < 256) { mye = pe[F.tid]; for (int q = 0; q < F.tid; ++q) myrank += (pe[q] == mye) ? 1 : 0; }
#ifdef PROBE_ORDERED
        if (F.tid == 0) { unsigned sp = 0; while (__hip_atomic_load((unsigned*)(F.ctl + CW_MOECNT + 64 * li + 32), RLX_AGENT) != (unsigned)blk0 && ++sp < (1u << 22)) __builtin_amdgcn_s_sleep(2); }
        __syncthreads();
#endif
        if (F.tid < NEXP) { int c = 0; for (int q = 0; q < 256; ++q) c += (pe[q] == F.tid) ? 1 : 0; cntl[F.tid] = c;
            cntl[8 + F.tid] = (int)__hip_atomic_fetch_add((unsigned*)(F.ctl + CW_MOECNT + 64 * li + F.tid), (unsigned)c, RLX_AGENT); }
#ifdef PROBE_ORDERED
        __syncthreads();
        if (F.tid == 0) { asm volatile("s_waitcnt vmcnt(0)" ::: "memory"); __hip_atomic_fetch_add((unsigned*)(F.ctl + CW_MOECNT + 64 * li + 32), 1u, RLX_AGENT); }
#endif
        __syncthreads();
        if (F.tid < 256) { const int rk = cntl[8 + mye] + myrank; const int m = blk0 * 128 + (F.tid >> 1);
            WSP(int, WS_SLOTTOK)[(size_t)mye * MOE_CAP + rk] = m; WSP(float, WS_SLOTW)[(size_t)mye * MOE_CAP + rk] = pwt[F.tid]; WSP(int, WS_PAIRPOS)[blk0 * 256 + F.tid] = (mye << 24) | rk; }
    }
    __syncthreads();
}
constexpr int AT_KS = 208, AT_VS = 192;
constexpr int AT_KB = 64 * AT_KS, AT_VB = 64 * AT_VS, AT_STAGE = AT_KB + AT_VB;
constexpr int AT_WSF = 2 * AT_STAGE, AT_OST = AT_WSF + NWAVES * 256, AT_LDS = AT_OST + NWAVES * 4096;
__device__ __forceinline__ int crow(int r, int hi) { return (r & 3) + 8 * (r >> 2) + 4 * hi; }

__device__ __forceinline__ void attn_unit(int tid, int b, int h, int qb, const bf16* Q, const bf16* K, const bf16* V, bf16* O, LAS unsigned char* lds) {
    const int lane = tid & 63, r32 = lane & 31, hi = lane >> 5; const int wid = __builtin_amdgcn_readfirstlane(tid >> 6);
    const size_t rowbase = (size_t)b * SEQ; const int q0 = qb * 256;
    bf16x8 qr[6];
    { const bf16* qp = Q + (rowbase + q0 + wid * 32 + r32) * 768 + h * 96 + hi * 8;
#pragma unroll
      for (int d0 = 0; d0 < 6; ++d0) qr[d0] = *(const bf16x8*)(qp + d0 * 16); }
    const int kp0 = tid, kp1 = 512 + tid;
    const bf16* kg0 = K + (rowbase + kp0 / 12) * 768 + h * 96 + (kp0 % 12) * 8;
    const bf16* kg1 = K + (rowbase + kp1 / 12) * 768 + h * 96 + (kp1 % 12) * 8;
    const bf16* vg = V + (rowbase + (tid >> 3)) * 512 + h * 64 + (tid & 7) * 8;
    const int kl0 = (kp0 / 12) * AT_KS + (kp0 % 12) * 16, kl1 = (kp1 / 12) * AT_KS + (kp1 % 12) * 16, vl = (tid >> 3) * AT_VS + (tid & 7) * 16;
    const bool two = tid < 256;
    const int NT = 4 * (qb + 1);
    v4u ka, kb2, va;
    ka = *(const v4u*)kg0; if (two) kb2 = *(const v4u*)kg1; va = *(const v4u*)vg;
    *(LAS v4u*)(lds + kl0) = ka; if (two) *(LAS v4u*)(lds + kl1) = kb2; *(LAS v4u*)(lds + AT_KB + vl) = va;
    LAS float* wsf = (LAS float*)(lds + AT_WSF) + wid * 64;
    float m_run = -1e30f, l_run = 0.f; f32x16 o[2];
#pragma unroll
    for (int r = 0; r < 16; ++r) { o[0][r] = 0.f; o[1][r] = 0.f; }
    const int kfo = r32 * AT_KS + hi * 16;
    const int vfo = (4 * hi + ((lane & 15) >> 2)) * AT_VS + ((lane >> 4) & 1) * 32 + (lane & 3) * 8;
    const int qrel = wid * 32 + r32;
    __syncthreads();
    for (int t = 0; t < NT; ++t) {
        const int cur = (t & 1) * AT_STAGE, nxt = ((t + 1) & 1) * AT_STAGE; const bool more = (t + 1 < NT);
        if (more) { const size_t go = (size_t)(t + 1) * 64 * 768; ka = *(const v4u*)(kg0 + go); if (two) kb2 = *(const v4u*)(kg1 + go); va = *(const v4u*)(vg + (size_t)(t + 1) * 64 * 512); }
        const int jb = t - (NT - 4);
        if (jb < 0 || 64 * jb <= 32 * wid + 31) {
            f32x16 p0, p1;
#pragma unroll
            for (int r = 0; r < 16; ++r) { p0[r] = 0.f; p1[r] = 0.f; }
#pragma unroll
            for (int d0 = 0; d0 < 6; ++d0) { const bf16x8 k0 = *(const LAS bf16x8*)(lds + cur + kfo + d0 * 32), k1 = *(const LAS bf16x8*)(lds + cur + kfo + 32 * AT_KS + d0 * 32);
                p0 = __builtin_amdgcn_mfma_f32_32x32x16_bf16(k0, qr[d0], p0, 0, 0, 0); p1 = __builtin_amdgcn_mfma_f32_32x32x16_bf16(k1, qr[d0], p1, 0, 0, 0); }
            if (jb >= 0) { const int kb = 64 * jb + 4 * hi;
#pragma unroll
                for (int r = 0; r < 16; ++r) { const int kv = kb + (r & 3) + 8 * (r >> 2); if (kv > qrel) p0[r] = -INFINITY; if (kv + 32 > qrel) p1[r] = -INFINITY; } }
            float rm = fmaxf(p0[0], p1[0]);
#pragma unroll
            for (int r = 1; r < 16; ++r) rm = fmaxf(rm, fmaxf(p0[r], p1[r]));
            rm = fmaxf(rm, __shfl_xor(rm, 32));
            const float mnew = fmaxf(m_run, rm), alpha = __builtin_amdgcn_exp2f(m_run - mnew);
            float ps = 0.f;
#pragma unroll
            for (int r = 0; r < 16; ++r) { p0[r] = __builtin_amdgcn_exp2f(p0[r] - mnew); p1[r] = __builtin_amdgcn_exp2f(p1[r] - mnew); ps += p0[r] + p1[r]; }
            l_run = l_run * alpha + ps;
            if (__any(mnew > m_run)) {
                if (hi == 0) wsf[r32] = alpha;
                LDS_WAIT();
#pragma unroll
                for (int r = 0; r < 16; ++r) { const float f = wsf[crow(r, hi)]; o[0][r] *= f; o[1][r] *= f; }
            }
            m_run = mnew;
            bf16x8 pa[4];
            { v4u w;
              w.x = cvt_pk_bf16(p0[0], p0[1]); w.y = cvt_pk_bf16(p0[2], p0[3]); w.z = cvt_pk_bf16(p0[4], p0[5]); w.w = cvt_pk_bf16(p0[6], p0[7]); pa[0] = __builtin_bit_cast(bf16x8, w);
              w.x = cvt_pk_bf16(p0[8], p0[9]); w.y = cvt_pk_bf16(p0[10], p0[11]); w.z = cvt_pk_bf16(p0[12], p0[13]); w.w = cvt_pk_bf16(p0[14], p0[15]); pa[1] = __builtin_bit_cast(bf16x8, w);
              w.x = cvt_pk_bf16(p1[0], p1[1]); w.y = cvt_pk_bf16(p1[2], p1[3]); w.z = cvt_pk_bf16(p1[4], p1[5]); w.w = cvt_pk_bf16(p1[6], p1[7]); pa[2] = __builtin_bit_cast(bf16x8, w);
              w.x = cvt_pk_bf16(p1[8], p1[9]); w.y = cvt_pk_bf16(p1[10], p1[11]); w.z = cvt_pk_bf16(p1[12], p1[13]); w.w = cvt_pk_bf16(p1[14], p1[15]); pa[3] = __builtin_bit_cast(bf16x8, w); }
#pragma unroll
            for (int d0 = 0; d0 < 2; ++d0)
#pragma unroll
                for (int ks = 0; ks < 4; ++ks) {
                    const s16x4 lo = __builtin_bit_cast(s16x4, __builtin_amdgcn_ds_read_tr16_b64_v4i16((LAS s16x4*)(lds + cur + AT_KB + vfo + (16 * ks) * AT_VS + d0 * 64)));
                    const s16x4 hh = __builtin_bit_cast(s16x4, __builtin_amdgcn_ds_read_tr16_b64_v4i16((LAS s16x4*)(lds + cur + AT_KB + vfo + (16 * ks + 8) * AT_VS + d0 * 64)));
                    const bf16x8 vf = (bf16x8){lo[0], lo[1], lo[2], lo[3], hh[0], hh[1], hh[2], hh[3]};
                    o[d0] = __builtin_amdgcn_mfma_f32_32x32x16_bf16(pa[ks], vf, o[d0], 0, 0, 0);
                }
        }
        if (more) { *(LAS v4u*)(lds + nxt + kl0) = ka; if (two) *(LAS v4u*)(lds + nxt + kl1) = kb2; *(LAS v4u*)(lds + nxt + AT_KB + vl) = va; }
        __syncthreads();
    }
    l_run += __shfl_xor(l_run, 32);
    if (hi == 0) wsf[32 + r32] = l_run;
    LDS_WAIT();
    { bf16* stg = (bf16*)(lds + AT_OST + wid * 4096);
#pragma unroll
      for (int r = 0; r < 16; ++r) { const int orow = crow(r, hi); const float rl = __builtin_amdgcn_rcpf(wsf[32 + orow]);
#pragma unroll
          for (int d0 = 0; d0 < 2; ++d0) { const unsigned u = cvt_pk_bf16(o[d0][r] * rl, 0.f); ((LAS bf16*)(lds + AT_OST + wid * 4096))[orow * 64 + d0 * 32 + r32] = (bf16)(u & 0xffffu); } }
      (void)stg;
      LDS_WAIT();
      bf16* Ow = O + (rowbase + q0 + wid * 32) * 512 + h * 64;
#pragma unroll
      for (int i = 0; i < 4; ++i) { const int row = i * 8 + (lane >> 3), ch = lane & 7; const v4u v = *(const LAS v4u*)(lds + AT_OST + wid * 4096 + (row * 64 + ch * 8) * 2); *(v4u*)(Ow + (size_t)row * 512 + ch * 8) = v; } }
    __syncthreads();
}

template <int CTRL> __device__ __forceinline__ float dpp_add(float v) { return v + __builtin_bit_cast(float, __builtin_amdgcn_update_dpp(0, __builtin_bit_cast(int, v), CTRL, 0xF, 0xF, true)); }
constexpr int RW_TC = 64, RW_STREAM = RW_TC * 64 * 2  , RW_BUF = 6 * RW_STREAM  , RW_YOFF = 2 * RW_BUF  , RW_LDS = RW_YOFF + 2 * RW_STREAM;
constexpr int RW_SPLIT = 2, RW_CW = 4  , RW_ROWS = 64 / RW_SPLIT, RW_RPW = RW_ROWS / RW_CW, RW_LPR = 64 / RW_RPW  , RW_CPL = 64 / RW_LPR  ;
typedef f16 f16xc __attribute__((ext_vector_type(RW_CPL)));
struct RwIn { f16xc r, k, a, b, d; f16 v; };
__device__ __forceinline__ void rw_lds_read(RwIn& x, const LAS unsigned char* buf, int tt, int cg, int row) {
    const LAS unsigned char* p = buf + tt * 128 + cg * (RW_CPL * 2);
    x.r = *(const LAS f16xc*)(p); x.k = *(const LAS f16xc*)(p + RW_STREAM); x.a = *(const LAS f16xc*)(p + 2 * RW_STREAM); x.b = *(const LAS f16xc*)(p + 3 * RW_STREAM); x.d = *(const LAS f16xc*)(p + 4 * RW_STREAM);
    x.v = *(const LAS f16*)(buf + 5 * RW_STREAM + tt * 128 + row * 2);
}
__device__ __forceinline__ void rwkv_scan(Frame& F, int unit) {
    const int bh = unit / RW_SPLIT, part = unit % RW_SPLIT;
    const int tid = F.tid, lane = F.lane, rl = lane / RW_LPR, cg = lane % RW_LPR, b = bh >> 3, h = bh & 7, row = part * RW_ROWS + F.wave * RW_RPW + rl;
    const f16* R = WSP(f16, WS_R); const f16* KH = WSP(f16, WS_KH); const f16* KKN = WSP(f16, WS_KKN); const f16* BV = WSP(f16, WS_BV); const f16* DCY = WSP(f16, WS_DCY); const f16* VF = WSP(f16, WS_VFIN);
    f16* Y = WSP(f16, WS_YRW);
    const size_t base = (size_t)b * SEQ * 512 + h * 64;
    LAS unsigned char* lds = F.lds;
    const int ts = tid >> 3, pc = tid & 7;
    const size_t goff = base + (size_t)ts * 512 + pc * 8;
    const int loff = ts * 128 + pc * 16;
    v4u g[6];
#define RW_GLOAD(t0) do { const size_t o = goff + (size_t)(t0) * 512; const size_t oa = ((t0) + ts + 1 < SEQ) ? o + 512 : o; \
        g[0] = *(const v4u*)(R + o); g[1] = *(const v4u*)(KH + o); g[2] = *(const v4u*)(KKN + oa); g[3] = *(const v4u*)(BV + o); g[4] = *(const v4u*)(DCY + o); g[5] = *(const v4u*)(VF + o); } while (0)
#define RW_LSTORE(bufoff) do { _Pragma("unroll") for (int s_ = 0; s_ < 6; ++s_) *(LAS v4u*)(lds + (bufoff) + s_ * RW_STREAM + loff) = g[s_]; } while (0)
    typedef f16 h2 __attribute__((ext_vector_type(2)));
    h2 S2[RW_CPL / 2];
#pragma unroll
    for (int j = 0; j < RW_CPL / 2; ++j) S2[j] = (h2){(f16)0.f, (f16)0.f};
    float sa = 0.f;
    __syncthreads();
    RW_GLOAD(0); RW_LSTORE(0);
    __syncthreads();
    for (int c = 0; c < SEQ / RW_TC; ++c) {
        const int cur = (c & 1) * RW_BUF, nxt = ((c + 1) & 1) * RW_BUF; const bool more = (c + 1 < SEQ / RW_TC);
        if (more) RW_GLOAD((c + 1) * RW_TC);
        const LAS unsigned char* buf = lds + cur;
        if (F.wave < RW_CW) {
        RwIn x, xn; rw_lds_read(x, buf, 0, cg, row);
#pragma unroll 4
        for (int tt = 0; tt < RW_TC; ++tt) {
            rw_lds_read(xn, buf, (tt + 1) & (RW_TC - 1), cg, row);
            const h2 sa2 = {(f16)sa, (f16)sa}, v2 = {x.v, x.v}; float yp = 0.f, sp = 0.f;
#pragma unroll
            for (int j = 0; j < RW_CPL / 2; ++j) { const h2 d2 = {x.d[2 * j], x.d[2 * j + 1]}, b2 = {x.b[2 * j], x.b[2 * j + 1]}, k2 = {x.k[2 * j], x.k[2 * j + 1]}, r2 = {x.r[2 * j], x.r[2 * j + 1]}, a2 = {x.a[2 * j], x.a[2 * j + 1]};
                h2 sj = S2[j]; sj = __builtin_elementwise_fma(-sj, d2, sj); sj = __builtin_elementwise_fma(sa2, b2, sj); sj = __builtin_elementwise_fma(v2, k2, sj); S2[j] = sj;
                yp = __builtin_amdgcn_fdot2(sj, r2, yp, false); sp = __builtin_amdgcn_fdot2(sj, a2, sp, false); }
            yp = dpp_add<0xB1>(yp); sp = dpp_add<0xB1>(sp);
            yp = dpp_add<0x4E>(yp); sp = dpp_add<0x4E>(sp);
            if (RW_LPR >= 8) { yp = dpp_add<0x141>(yp); sp = dpp_add<0x141>(sp); }
            if (RW_LPR >= 16) { yp = dpp_add<0x140>(yp); sp = dpp_add<0x140>(sp); }
            sa = -sp;
            if (cg == 0) *(LAS f16*)(lds + RW_YOFF + (c & 1) * RW_STREAM + tt * 128 + row * 2) = (f16)yp;
            x = xn;
        }
        }
        if (more) RW_LSTORE(nxt);
        __syncthreads();
        if (pc >= part * (8 / RW_SPLIT) && pc < (part + 1) * (8 / RW_SPLIT)) { const v4u yv = *(const LAS v4u*)(lds + RW_YOFF + (c & 1) * RW_STREAM + loff); *(v4u*)(Y + base + (size_t)(c * RW_TC + ts) * 512 + pc * 8) = yv; }
    }
    __syncthreads();
#undef RW_GLOAD
#undef RW_LSTORE
}
__device__ __forceinline__ void s5_carry(Frame& F, int l, int idx) {
    const int p = idx & 63, g = (idx >> 6) & 31, b = idx >> 11;
    const float* a32 = WSP(float, WS_S5A32) + (size_t)((l * 32 + g) * 64 + p) * 2; const float ar = a32[0], ai = a32[1];
    const float* xe = WSP(float, WS_XEND) + ((size_t)g * S5CH + b * S5NC) * 128; bf16* u = WSP(bf16, WS_S5U) + ((size_t)g * S5CH + b * S5NC) * S5K + 512;
    float xr = 0.f, xi = 0.f;
    for (int c0 = 0; c0 < S5NC; c0 += 8) { float er[8], ei[8];
#pragma unroll
        for (int c = 0; c < 8; ++c) { er[c] = xe[(size_t)(c0 + c) * 128 + p]; ei[c] = xe[(size_t)(c0 + c) * 128 + 64 + p]; }
#pragma unroll
        for (int c = 0; c < 8; ++c) { bf16* up = u + (size_t)(c0 + c) * S5K; up[p] = (bf16)(cvt_pk_bf16(xr, 0.f) & 0xffffu); up[64 + p] = (bf16)(cvt_pk_bf16(xi, 0.f) & 0xffffu);
            const float nr = ar * xr - ai * xi + er[c], ni = ar * xi + ai * xr + ei[c]; xr = nr; xi = ni; } }
}
__device__ __forceinline__ void rwkv_post(Frame& F, int l) {
    const int lane = F.lane; const int gw = F.blk * NWAVES + F.wave, NGW = F.G * NWAVES;
    float lg[8], lb[8], rk[8]; ld8f(INP(float, 16) + l * 512 + 8 * lane, lg); ld8f(INP(float, 17) + l * 512 + 8 * lane, lb); ld8f(INP(float, 15) + l * 512 + 8 * lane, rk);
    for (int m = gw; m < M; m += NGW) { const size_t off = (size_t)m * 512 + 8 * lane; float y[8], r[8], k[8], v[8], g[8], o[8];
        f16x8_to_f32(*(const f16x8*)(WSP(f16, WS_YRW) + off), y); f16x8_to_f32(*(const f16x8*)(WSP(f16, WS_R) + off), r); f16x8_to_f32(*(const f16x8*)(WSP(f16, WS_KH) + off), k);
        f16x8_to_f32(*(const f16x8*)(WSP(f16, WS_VFIN) + off), v); bf16x8_to_f32(*(const v4u*)(WSP(bf16, WS_GL) + off), g);
        float s = 0.f, bs = 0.f;
#pragma unroll
        for (int j = 0; j < 8; ++j) { s += y[j]; bs += r[j] * k[j] * rk[j]; }
        s += __shfl_xor(s, 1); s += __shfl_xor(s, 2); s += __shfl_xor(s, 4); bs += __shfl_xor(bs, 1); bs += __shfl_xor(bs, 2); bs += __shfl_xor(bs, 4);
        const float mean = s * (1.0f / 64.0f); float q = 0.f;
#pragma unroll
        for (int j = 0; j < 8; ++j) { y[j] -= mean; q += y[j] * y[j]; }
        q += __shfl_xor(q, 1); q += __shfl_xor(q, 2); q += __shfl_xor(q, 4);
        const float rstd = 1.0f / sqrtf(q * (1.0f / 64.0f) + 64e-5f);
#pragma unroll
        for (int j = 0; j < 8; ++j) o[j] = (y[j] * rstd * lg[j] + lb[j] + bs * v[j]) * g[j];
        *(v4u*)(WSP(bf16, WS_YRW) + off) = f32_to_bf16x8(o); }
}
constexpr int PH_PER_LAYER = 12, N_PHASES = 1 + NLAYER * PH_PER_LAYER;
#ifndef MK_PER_PHASE
#define MK_PER_PHASE 0
#endif
#ifndef ABL_BRANCH
#define ABL_BRANCH -1
#endif
constexpr int NR_RWKV = 64 * RW_SPLIT;

__global__ void __launch_bounds__(NWAVES * 64, 2) mk_fwd(Args A) {
    extern __shared__ __attribute__((aligned(16))) unsigned char lds_raw[];
    volatile LAS unsigned* MISC = (volatile LAS unsigned*)((LAS unsigned char*)lds_raw + MISC_OFF);
    for (int u = threadIdx.x; u < (LDS_BYTES - LDSCTL_OFF) / 4; u += NWAVES * 64) ((LAS unsigned*)((LAS unsigned char*)lds_raw + LDSCTL_OFF))[u] = 0u;
    __syncthreads();
    XcdBarrier bar; bar.bar = (unsigned*)(A.ws + WS_CTL) + CW_BAR; bar.x = 0; bar.st = nullptr;
    if (!MK_PER_PHASE) bar = xcd_barrier_post((unsigned*)(A.ws + WS_CTL) + CW_BAR, MISC + 8);
    const int lo = A.ph_lo, hi = A.ph_hi;
#ifndef PHMASK
#define PHMASK 0xFFFF
#endif
#define PHON(k) ((PHMASK >> (k)) & 1)
#define IN(k) (lo <= (k) && (k) < hi)
#define SEAM(k) do { if (IN(k) && IN((k) + 1)) xcd_barrier(bar); } while (0)
    using pg8::gemm_phase; using pg8::StaticOrder; using pg8::LocDense;

    if (PHON(0) && IN(0)) {
        MKFRAME(F);
        p0_prologue(F);
        for (int it = F.blk; it < NLAYER * 256; it += F.G) s5_gen(F, it >> 8, it & 255);
        const int gw = F.blk * NWAVES + F.wave, NGW = F.G * NWAVES;
        for (int m = gw; m < M; m += NGW) {
#pragma unroll
            for (int j = 0; j < 4; ++j) { const f32x4 v = *(const f32x4*)(INP(float, 0) + (size_t)m * DM + 4 * F.lane + 256 * j); v2u w; w.x = cvt_pk_bf16(v[0], v[1]); w.y = cvt_pk_bf16(v[2], v[3]); *(v2u*)(WSP(bf16, WS_XB) + (size_t)m * DM + 4 * F.lane + 256 * j) = w; } }
    }
    SEAM(0);

    for (int l = 0; l < NLAYER; ++l) {
        const int pb = 1 + l * PH_PER_LAYER;
        const bool moe = (l & 1) != 0; const int li = l >> 1;
        if (PHON(1) && IN(pb + 0)) {
            asm volatile("; ==PH1");
            MKFRAME(F);
            LocDense L{WSP(bf16, WS_XB), WSP(bf16, WS_WIN) + (size_t)l * 3072 * DM, DM, DM, DM, 0, 0};
            StaticOrder S; S.init(M, 3072, 1, F.G, F.blk);
            Epi8<FProj> E{{WSP(bf16, WS_MLARAW), WSP(bf16, WS_RWRAW), WSP(bf16, WS_S5U)}};
            gemm_phase(F.lds + RING_OFF, L, S, E);
        }
        SEAM(pb + 0);
        if (PHON(2) && IN(pb + 1)) { MKFRAME(F); ph2_prep(F, l); }
        SEAM(pb + 1);
        if (PHON(3) && IN(pb + 2)) {
            asm volatile("; ==PH3");
            MKFRAME(F);
#ifndef P3SEL
#define P3SEL 31
#endif
            if (P3SEL & 1) { LocDense L{WSP(bf16, WS_CQN), WSP(bf16, WS_WUQ) + (size_t)l * 768 * 384, 384, 384, 384, 0, 0}; StaticOrder S; S.init(M, 768, 1, F.G, F.blk);
              Epi8<FQup> E{{WSP(bf16, WS_Q), WSP(float, WS_ROPE), 0.10206207261596575f * 1.4426950408889634f}}; gemm_phase(F.lds + RING_OFF, L, S, E); }
            if (P3SEL & 2) { LocDense L{WSP(bf16, WS_CKVN), WSP(bf16, WS_WUKV) + (size_t)l * 1024 * 256, 256, 256, 256, 0, 0}; StaticOrder S; S.init(M, 1024, 1, F.G, F.blk);
              Epi8<FKVup> E{{WSP(bf16, WS_K), WSP(bf16, WS_V)}}; gemm_phase(F.lds + RING_OFF, L, S, E); }
            if (P3SEL & 4) { LocDense L{WSP(bf16, WS_LORAIN), WSP(bf16, WS_WLORA) + (size_t)l * 1536 * 256, 256, 256, 256, 0, 0}; StaticOrder S; S.init(M, 1536, 1, F.G, F.blk);
              Epi8<FLora> E{{INP(float, 8) + l * 512, INP(float, 10) + l * 512, INP(float, 14) + l * 512, WSP(f16, WS_DCY), WSP(f16, WS_KH), WSP(f16, WS_KKN), WSP(f16, WS_BV), WSP(bf16, WS_GL), {}, {}}}; gemm_phase(F.lds + RING_OFF, L, S, E); }
            if ((P3SEL & 8) && l > 0) { LocDense L{WSP(bf16, WS_VRAW), WSP(bf16, WS_WVRES) + (size_t)(l - 1) * 512 * 512, 512, 512, 512, 0, 0}; StaticOrder S; S.init(M, 512, 1, F.G, F.blk);
              Epi8<FVres> E{{INP(float, 20) + (l - 1) * 512, WSP(bf16, WS_VRAW), WSP(bf16, WS_VFIRST), WSP(f16, WS_VFIN), {}}}; gemm_phase(F.lds + RING_OFF, L, S, E); }
            if (P3SEL & 16) { LocDense L{WSP(bf16, WS_S5U), WSP(bf16, WS_S5END) + (size_t)l * 32 * 256 * 512, S5K, 512, 512, (size_t)S5CH * S5K, (size_t)256 * 512}; StaticOrder S; S.init(S5CH, 256, 32, F.G, (F.blk + F.G / 2) % F.G);
              Epi8<FS5End> E{{WSP(float, WS_XEND)}}; gemm_phase(F.lds + RING_OFF, L, S, E); }
        }
        SEAM(pb + 2);
        if (PHON(4) && IN(pb + 3)) {
            asm volatile("; ==PH4");
            MKFRAME(F);
            if (F.blk < NR_RWKV && F.G > NR_RWKV) { if (A.li != -2) for (int un = F.blk; un < NBATCH * NH * RW_SPLIT; un += NR_RWKV) rwkv_scan(F, un); }
            else { const int ab = F.blk - NR_RWKV, na = F.G - NR_RWKV; if (A.li != -1) for (int idx = ab * 512 + F.tid; idx < NBATCH * 32 * 64; idx += na * 512) s5_carry(F, l, idx); }
            if (A.li != -1) {
                LAS int* slot = (LAS int*)(F.lds + AT_LDS);
                for (;;) {
                    __syncthreads();
                    if (F.tid == 0) *slot = (int)__hip_atomic_fetch_add((unsigned*)(F.ctl + CW_ATTN + 64 * l), 1u, RLX_AGENT);
                    __syncthreads();
                    const int n = *slot; if (n >= NBATCH * NH * 16) break;
                    const int qb = 15 - (n >> 6), bh = n & 63;
                    attn_unit(F.tid, bh >> 3, bh & 7, qb, WSP(bf16, WS_Q), WSP(bf16, WS_K), WSP(bf16, WS_V), WSP(bf16, WS_YMLA), F.lds);
                }
            }
        }
        SEAM(pb + 3);
        if (PHON(5) && IN(pb + 4)) {
            asm volatile("; ==PH5");
            MKFRAME(F);
            { LocDense L{WSP(bf16, WS_S5U), WSP(bf16, WS_S5MAIN) + (size_t)l * 32 * 512 * S5K, S5K, S5K, S5K, (size_t)S5CH * S5K, (size_t)512 * S5K}; StaticOrder S; S.init(S5CH, 512, 32, F.G, F.blk);
              Epi8<FS5Main> E{{WSP(bf16, WS_S5U), INP(float, 28) + l * 512, WSP(bf16, WS_YS5G), {}}}; gemm_phase(F.lds + RING_OFF, L, S, E); }
            rwkv_post(F, l);
        }
        SEAM(pb + 4);
        if (PHON(6) && IN(pb + 5)) {
            asm volatile("; ==PH6");
            MKFRAME(F);
            { LocDense L{WSP(bf16, WS_YS5G), WSP(bf16, WS_WGLU) + (size_t)l * 512 * 512, 512, 512, 512, 0, 0}; StaticOrder S; S.init(M, 512, 1, F.G, F.blk);
              Epi8<FGlu> E{{WSP(bf16, WS_YS5G), INP(float, 30) + l * 512, WSP(bf16, WS_YS5), {}}}; gemm_phase(F.lds + RING_OFF, L, S, E); }
            { LocDense L{WSP(bf16, WS_XB), WSP(bf16, WS_WG) + ((size_t)l * 3 + 0) * 1024 * DM, DM, DM, DM, 0, 0}; StaticOrder S; S.init(M, 2048, 1, F.G, F.blk);
              Epi8<FGate2> E{{WSP(bf16, WS_GBUF), WSP(bf16, WS_GBUF2)}}; gemm_phase(F.lds + RING_OFF, L, S, E); }
            { LocDense L{WSP(bf16, WS_YMLA), WSP(bf16, WS_WBR) + ((size_t)l * 3 + 0) * 1024 * 512, 512, 512, 512, 0, 0}; StaticOrder S; S.init(M, 1024, 1, F.G, F.blk);
              Epi8<FMerge> E{{WSP(bf16, WS_GBUF), WSP(bf16, WS_MIXED2), WSP(bf16, WS_MIXED), 1, (ABL_BRANCH == 0) ? 0.f : 1.f}}; gemm_phase(F.lds + RING_OFF, L, S, E); }
            { LocDense L{WSP(bf16, WS_YRW), WSP(bf16, WS_WBR) + ((size_t)l * 3 + 1) * 1024 * 512, 512, 512, 512, 0, 0}; StaticOrder S; S.init(M, 1024, 1, F.G, F.blk);
              Epi8<FMerge> E{{WSP(bf16, WS_GBUF2), WSP(bf16, WS_MIXED), WSP(bf16, WS_MIXED2), 0, (ABL_BRANCH == 1) ? 0.f : 1.f}}; gemm_phase(F.lds + RING_OFF, L, S, E); }
        }
        SEAM(pb + 5);
        if (PHON(7) && IN(pb + 6)) {
            asm volatile("; ==PH7");
            MKFRAME(F);
            { LocDense L{WSP(bf16, WS_XB), WSP(bf16, WS_WG) + ((size_t)l * 3 + 2) * 1024 * DM, DM, DM, DM, 0, 0}; StaticOrder S; S.init(M, 1024, 1, F.G, F.blk);
              Epi8<FGate> E{{WSP(bf16, WS_GBUF)}}; gemm_phase(F.lds + RING_OFF, L, S, E); }
            { LocDense L{WSP(bf16, WS_YS5), WSP(bf16, WS_WBR) + ((size_t)l * 3 + 2) * 1024 * 512, 512, 512, 512, 0, 0}; StaticOrder S; S.init(M, 1024, 1, F.G, F.blk);
              Epi8<FMerge> E{{WSP(bf16, WS_GBUF), WSP(bf16, WS_MIXED2), WSP(bf16, WS_MIXED), 0, (ABL_BRANCH == 2) ? 0.f : 1.f}}; gemm_phase(F.lds + RING_OFF, L, S, E); }
        }
        SEAM(pb + 6);
        if (PHON(8) && IN(pb + 7)) {
            asm volatile("; ==PH8");
            MKFRAME(F);
            LocDense L{WSP(bf16, WS_MIXED), WSP(bf16, WS_WOUT) + (size_t)l * DM * DM, DM, DM, DM, 0, 0}; StaticOrder S; S.init(M, DM, 1, F.G, F.blk);
            Epi8<FResid> E{{WSP(bf16, WS_XB), F.out}}; gemm_phase(F.lds + RING_OFF, L, S, E);
        }
        SEAM(pb + 7);
        if (PHON(9) && IN(pb + 8)) {
            asm volatile("; ==PH9");
            MKFRAME(F);
            if (moe) { ln1_moe_phase(F, INP(float, 33) + l * DM, INP(float, 34) + l * DM, li); moe_convert(F, li); }
            else ln_phase(F, INP(float, 33) + l * DM, INP(float, 34) + l * DM);
        }
        SEAM(pb + 8);
        if (PHON(10) && IN(pb + 9)) {
            asm volatile("; ==PH10");
            MKFRAME(F);
            if (moe) {
                const unsigned* cnt = (const unsigned*)(F.ctl + CW_MOECNT + 64 * li);
                LocMoe1 L{WSP(bf16, WS_XB), WSP(bf16, WS_WMGU), DM, DM, DM, WSP(int, WS_SLOTTOK), cnt}; MoeOrder S; S.init(cnt, 2 * EXD / 256, F.G, F.blk);
                EpiGU<FSwiglu> E{{WSP(bf16, WS_HM), EXD}}; gemm_phase(F.lds + RING_OFF, L, S, E);
            } else {
                LocDense L{WSP(bf16, WS_XB), WSP(bf16, WS_WFGU) + (size_t)li * 2 * FFN * DM, DM, DM, DM, 0, 0}; StaticOrder S; S.init(M, 2 * FFN, 1, F.G, F.blk);
                EpiGU<FSwiglu> E{{WSP(bf16, WS_HB), FFN}}; gemm_phase(F.lds + RING_OFF, L, S, E);
            }
        }
        SEAM(pb + 9);
        if (PHON(11) && IN(pb + 10)) {
            asm volatile("; ==PH11");
            MKFRAME(F);
            if (moe) {
                const unsigned* cnt = (const unsigned*)(F.ctl + CW_MOECNT + 64 * li);
                LocDense L{WSP(bf16, WS_HM), WSP(bf16, WS_WMD), EXD, EXD, EXD, 0, (size_t)DM * EXD}; MoeOrder S; S.init(cnt, DM / 256, F.G, F.blk);
                Epi8<FMoeDown> E{{WSP(bf16, WS_YPAIR), WSP(float, WS_SLOTW), cnt}}; gemm_phase(F.lds + RING_OFF, L, S, E);
            } else {
                LocDense L{WSP(bf16, WS_HB), WSP(bf16, WS_WFD) + (size_t)li * DM * FFN, FFN, FFN, FFN, 0, 0}; StaticOrder S; S.init(M, DM, 1, F.G, F.blk);
                Epi8<FResid> E{{WSP(bf16, WS_XB), F.out}}; gemm_phase(F.lds + RING_OFF, L, S, E);
            }
        }
        SEAM(pb + 10);
        if (PHON(12) && IN(pb + 11)) {
            asm volatile("; ==PH12");
            MKFRAME(F);
            if (moe) ln2_moe_phase(F, INP(float, 35) + l * DM, INP(float, 36) + l * DM, li, l == NLAYER - 1);
            else ln_phase(F, INP(float, 35) + l * DM, INP(float, 36) + l * DM);
        }
        SEAM(pb + 11);
    }
#undef IN
#undef SEAM
}

#ifdef PROBE_P
__global__ void probe_sum(const unsigned* x, unsigned long long* sums, int n) {
    __shared__ unsigned long long sh[256];
    unsigned long long s = 0;
    for (int i = blockIdx.x * blockDim.x + threadIdx.x; i < n; i += gridDim.x * blockDim.x) s += (unsigned long long)x[i] * (unsigned long long)(2 * (i & 1023) + 1);
    sh[threadIdx.x] = s; __syncthreads();
    if (threadIdx.x == 0) { unsigned long long t = 0; for (int i = 0; i < 256; ++i) t += sh[i]; sums[blockIdx.x] = t; }
}
__global__ void probe_cmp(const unsigned long long* sums, unsigned* out) {
    if (sums[threadIdx.x] != sums[1024 + threadIdx.x]) out[threadIdx.x * 4099] = 0x7fc00000u;
}
#endif
extern "C" void kernel_launch(void* const* d_in, const int* in_sizes, int n_in, void* d_out, int out_size, void* d_ws, size_t ws_size, hipStream_t stream) {
    static int grid = 0;
    if (grid == 0) {
        if (n_in != 44 || out_size != M * DM || ws_size < WS_END) { fprintf(stderr, "kernel_launch: unexpected problem (n_in %d, out %d, ws %zu < %zu)\n", n_in, out_size, ws_size, (size_t)WS_END); grid = -1; return; }
        int dev = 0, cus = 0, per_cu = 0;
        if (hipGetDevice(&dev) != hipSuccess || hipDeviceGetAttribute(&cus, hipDeviceAttributeMultiprocessorCount, dev) != hipSuccess) { grid = -1; return; }
        if (hipFuncSetAttribute((const void*)mk_fwd, hipFuncAttributeMaxDynamicSharedMemorySize, LDS_BYTES) != hipSuccess) { fprintf(stderr, "kernel_launch: hipFuncSetAttribute failed\n"); grid = -1; return; }
        if (hipOccupancyMaxActiveBlocksPerMultiprocessor(&per_cu, (const void*)mk_fwd, NWAVES * 64, LDS_BYTES) != hipSuccess || per_cu < 1) { fprintf(stderr, "kernel_launch: occupancy query says %d blocks per CU\n", per_cu); }
        (void)hipGetLastError();
        grid = cus;
        if (grid != 256) fprintf(stderr, "kernel_launch: %d CUs (built for 256)\n", grid);
    }
    if (grid < 0) return;
    (void)in_sizes;
    if (hipMemsetAsync((char*)d_ws + WS_CTL, 0, CTL_ZERO_BYTES, stream) != hipSuccess) return;
    Args a{};
    for (int i = 0; i < 44; ++i) a.in[i] = d_in[i];
    a.out = (float*)d_out; a.ws = (unsigned char*)d_ws; a.pad = 0;
#if MK_PER_PHASE
#ifdef PROBE_P
    for (int p = 0; p <= PROBE_P; ++p) { a.ph_lo = p; a.ph_hi = p + 1; a.li = p; hipLaunchKernelGGL(mk_fwd, dim3(grid), dim3(NWAVES * 64), LDS_BYTES, stream, a); }
    hipLaunchKernelGGL(probe_sum, dim3(1024), dim3(256), 0, stream, (const unsigned*)((char*)d_ws + PROBE_OFF), (unsigned long long*)((char*)d_ws + WS_END), (int)(PROBE_BYTES / 4));
    hipMemsetAsync((char*)d_ws + WS_CTL, 0, CTL_ZERO_BYTES, stream);
    for (int p = 0; p <= PROBE_P; ++p) { a.ph_lo = p; a.ph_hi = p + 1; a.li = p; hipLaunchKernelGGL(mk_fwd, dim3(grid), dim3(NWAVES * 64), LDS_BYTES, stream, a); }
    hipLaunchKernelGGL(probe_sum, dim3(1024), dim3(256), 0, stream, (const unsigned*)((char*)d_ws + PROBE_OFF), (unsigned long long*)((char*)d_ws + WS_END) + 1024, (int)(PROBE_BYTES / 4));
    for (int p = PROBE_P + 1; p < N_PHASES; ++p) { a.ph_lo = p; a.ph_hi = p + 1; a.li = p; hipLaunchKernelGGL(mk_fwd, dim3(grid), dim3(NWAVES * 64), LDS_BYTES, stream, a); }
    hipLaunchKernelGGL(probe_cmp, dim3(1), dim3(1024), 0, stream, (const unsigned long long*)((char*)d_ws + WS_END), (unsigned*)d_out);
#else
    for (int p = 0; p < N_PHASES; ++p) { a.ph_lo = p; a.ph_hi = p + 1; a.li = p; hipLaunchKernelGGL(mk_fwd, dim3(grid), dim3(NWAVES * 64), LDS_BYTES, stream, a);
#ifdef DUP_MASK
        if (p >= 1 && ((DUP_MASK >> ((p - 1) % PH_PER_LAYER)) & 1)) { hipMemsetAsync((char*)d_ws + WS_CTL + (size_t)CW_ATTN * 4, 0, 4096, stream);
#ifdef DUP_LI
            a.li = DUP_LI;
#endif
            hipLaunchKernelGGL(mk_fwd, dim3(grid), dim3(NWAVES * 64), LDS_BYTES, stream, a); }
#endif
    }
#endif
#else
    a.ph_lo = 0; a.ph_hi = N_PHASES; a.li = 0;
    hipLaunchKernelGGL(mk_fwd, dim3(grid), dim3(NWAVES * 64), LDS_BYTES, stream, a);
#endif
}
```

```cpp
#include <hip/hip_runtime.h>
#include <cstdio>
#include <cstdint>
#include <cmath>
namespace pg8 {
#define PG8_LAS __attribute__((address_space(3)))
typedef unsigned short bf16_t;
typedef short bf16x8 __attribute__((ext_vector_type(8)));
typedef float f32x4 __attribute__((ext_vector_type(4)));
typedef float f32x2 __attribute__((ext_vector_type(2)));
typedef unsigned u32x4 __attribute__((ext_vector_type(4)));
typedef unsigned u32x2 __attribute__((ext_vector_type(2)));
constexpr int BM = 256, BK = 64, HALF = 128, HTB = HALF * BK * 2  , STAGE_BYTES = 8 * HTB, NXCD = 8, WGM = 8;

__host__ __device__ __forceinline__ int lds_byte(int r, int c) { const int st = (r >> 4) * 2 + (c >> 5), rr = r & 15, cc = c & 31, ob = rr * 64 + cc * 2; return st * 1024 + (ob ^ (((ob >> 9) & 1) << 5)); }
__host__ __device__ __forceinline__ void stage_rc(int b, int& R, int& C) { const int st = b / 1024, sb = b % 1024, swz = sb ^ (((sb >> 9) & 1) << 5); R = (st >> 1) * 16 + swz / 64; C = (st & 1) * 32 + (swz % 64) / 2; }
__host__ __device__ __forceinline__ int perm32(int rho) { const int n = rho >> 4, i = rho & 15; return 8 * (i >> 2) + 4 * n + (i & 3); }

struct Unit { int pm, pn, z, aux; };

struct LocDense {
    static constexpr bool GATHER = false;
    const bf16_t* A; const bf16_t* Bt; int lda, ldb, K; size_t zA, zB;
    __device__ __forceinline__ const char* a_ptr(const Unit& u) const { return (const char*)(A + (size_t)u.z * zA + (size_t)u.pm * BM * lda); }
    __device__ __forceinline__ const char* b_ptr(const Unit& u) const { return (const char*)(Bt + (size_t)u.z * zB + (size_t)u.pn * BM * ldb); }
    __device__ __forceinline__ void a_off(const Unit&, int tid, unsigned (&v)[2][2]) const {
#pragma unroll
        for (int i = 0; i < 2; ++i) { int R, C; stage_rc(tid * 16 + i * 8192, R, C); v[0][i] = (unsigned)(R * lda + C) * 2u; v[1][i] = 0u; }
    }
};

struct StaticOrder {
    int nM, nN, nwg, nZ, G, c;
    __device__ void init(int M, int N, int Z, int G_, int c_) { nM = M / BM; nN = N / BM; nwg = nM * nN; nZ = Z; G = G_; c = c_; }
    __device__ bool next(int i, Unit& u) const {
        const long L = (long)i * G + c; if (L >= (long)nwg * nZ) return false;
        u.z = (int)(L / nwg); u.aux = 0;
        int wgid = (int)(L % nwg); { const int q = nwg / NXCD, r = nwg % NXCD, xcd = wgid % NXCD, off = wgid / NXCD; wgid = (xcd < r ? xcd * (q + 1) : r * (q + 1) + (xcd - r) * q) + off; }
        const int nig = WGM * nN, gid = wgid / nig, fm = gid * WGM, gsz = (nM - fm) < WGM ? (nM - fm) : WGM;
        u.pm = fm + ((wgid % nig) % gsz); u.pn = (wgid % nig) / gsz; return true;
    }
};

typedef float f32x2_cv __attribute__((ext_vector_type(2))); typedef __bf16 bf16x2_cv __attribute__((ext_vector_type(2)));
__device__ __forceinline__ unsigned cvt_pk_bf16(float lo, float hi) { const f32x2_cv v = {lo, hi}; const bf16x2_cv b = __builtin_convertvector(v, bf16x2_cv); return __builtin_bit_cast(unsigned, b); }
__device__ __forceinline__ u32x4 pack8(const f32x4 v0, const f32x4 v1) { u32x4 w; w.x = cvt_pk_bf16(v0[0], v0[1]); w.y = cvt_pk_bf16(v0[2], v0[3]); w.z = cvt_pk_bf16(v1[0], v1[1]); w.w = cvt_pk_bf16(v1[2], v1[3]); return w; }
__device__ __forceinline__ float bf_lo(unsigned w) { return __uint_as_float(w << 16); }
__device__ __forceinline__ float bf_hi(unsigned w) { return __uint_as_float(w & 0xffff0000u); }
__device__ __forceinline__ void unpack8(const u32x4 w, f32x4& v0, f32x4& v1) { v0 = (f32x4){bf_lo(w.x), bf_hi(w.x), bf_lo(w.y), bf_hi(w.y)}; v1 = (f32x4){bf_lo(w.z), bf_hi(w.z), bf_lo(w.w), bf_hi(w.w)}; }

struct NoPre {};
template <class F> struct Epi8 {
    static constexpr bool PERM = true;
    F f;
    __device__ __forceinline__ void operator()(const f32x4 (&acc)[2][2][4][2], const Unit& u, int wr, int wc, int fr, int fq) const {
        const int row0 = u.pm * BM + wr * 64 + fr, col0 = u.pn * BM + wc * 32 + 8 * fq;
        F g = f;
#pragma unroll
        for (int bj = 0; bj < 2; ++bj) { const int col = col0 + bj * HALF; g.begin_col(u, col);
#pragma unroll
            for (int b0 = 0; b0 < 8; b0 += F::BATCH) { typename F::Pre pr[F::BATCH];
#pragma unroll
                for (int i = 0; i < F::BATCH; ++i) { const int q = b0 + i; pr[i] = g.pre(u, row0 + (q >> 2) * HALF + (q & 3) * 16, col); }
#pragma unroll
                for (int i = 0; i < F::BATCH; ++i) { const int q = b0 + i; g.tile8(u, row0 + (q >> 2) * HALF + (q & 3) * 16, col, acc[q >> 2][bj][q & 3][0], acc[q >> 2][bj][q & 3][1], pr[i]); }
                asm volatile("" ::: "memory"); } }
    }
};
template <class F> struct EpiGU {
    static constexpr bool PERM = true;
    F f;
    __device__ __forceinline__ void operator()(const f32x4 (&acc)[2][2][4][2], const Unit& u, int wr, int wc, int fr, int fq) const {
        const int row0 = u.pm * BM + wr * 64 + fr, colh = u.pn * HALF + wc * 32 + 8 * fq;
#pragma unroll
        for (int ai = 0; ai < 2; ++ai)
#pragma unroll
            for (int m = 0; m < 4; ++m) { f.pair8(u, row0 + ai * HALF + m * 16, colh, acc[ai][0][m][0], acc[ai][0][m][1], acc[ai][1][m][0], acc[ai][1][m][1]); asm volatile("" ::: "memory"); }
    }
};

template <class Epi, class Sched, class Loc>
__device__ __forceinline__ void gemm_phase(PG8_LAS unsigned char* lds, const Loc& L, const Sched& S, const Epi& E) {
    int tid_ = threadIdx.x; asm volatile("" : "+v"(tid_));
    const int tid = tid_, wid = __builtin_amdgcn_readfirstlane(tid >> 6), lane = tid & 63, wr = wid >> 2, wc = wid & 3, fr = lane & 15, fq = lane >> 4;
    const int K = L.K, nt = K / BK;
    unsigned voffB[2];
#pragma unroll
    for (int i = 0; i < 2; ++i) { int R, C; stage_rc(tid * 16 + i * 8192, R, C); const int Rb = Epi::PERM ? ((R & ~31) + perm32(R & 31)) : R;
        voffB[i] = (unsigned)(Rb * L.ldb + C) * 2u; }
    const size_t kstep = (size_t)(BK * 2);
    const size_t hstepB = (size_t)HALF * L.ldb * 2;
    const unsigned ldsw = (unsigned)wid * 1024u;
    const int aoff = lds_byte(wr * 64 + fr, fq * 8), boff = lds_byte(wc * 32 + fr, fq * 8);
#define PG8_SA(b, h) (((b) * 2 + (h)) * HTB)
#define PG8_SB(b, h) ((4 + (b) * 2 + (h)) * HTB)
#define PG8_STAGE(bufoff, gbase, voff) do { _Pragma("unroll") for (int _i = 0; _i < 2; ++_i) \
        __builtin_amdgcn_global_load_lds((const unsigned*)((const char*)(gbase) + (voff)[_i]), (PG8_LAS unsigned*)(lds + (bufoff) + ldsw + _i * 8192), 16, 0, 0); } while (0)
#define PG8_LDA(dst, b, h) do { _Pragma("unroll") for (int m = 0; m < 4; ++m) _Pragma("unroll") for (int k = 0; k < 2; ++k) dst[m][k] = *(const PG8_LAS bf16x8*)(lds + PG8_SA(b, h) + aoff + m * 2048 + k * 1024); } while (0)
#define PG8_LDB(dst, b, h) do { _Pragma("unroll") for (int n = 0; n < 2; ++n) _Pragma("unroll") for (int k = 0; k < 2; ++k) dst[n][k] = *(const PG8_LAS bf16x8*)(lds + PG8_SB(b, h) + boff + n * 2048 + k * 1024); } while (0)
#define PG8_MMA(ai, bj, At, Bt) do { __builtin_amdgcn_s_setprio(1); _Pragma("unroll") for (int m = 0; m < 4; ++m) _Pragma("unroll") for (int n = 0; n < 2; ++n) _Pragma("unroll") for (int k = 0; k < 2; ++k) \
        acc[ai][bj][m][n] = __builtin_amdgcn_mfma_f32_16x16x32_bf16(Bt[n][k], At[m][k], acc[ai][bj][m][n], 0, 0, 0); __builtin_amdgcn_s_setprio(0); } while (0)
#define PG8_WAIT_V(n) asm volatile("s_waitcnt vmcnt(" #n ")" ::: "memory")
#define PG8_WAIT_L(n) asm volatile("s_waitcnt lgkmcnt(" #n ")" ::: "memory")
#define PG8_BAR __builtin_amdgcn_s_barrier()
#define PG8_SCHED __builtin_amdgcn_sched_barrier(0)
    Unit cur, nxt; int ui = 0;
    if (!S.next(0, cur)) return;
    f32x4 acc[2][2][4][2];
#pragma unroll
    for (int a = 0; a < 2; ++a)
#pragma unroll
        for (int b = 0; b < 2; ++b)
#pragma unroll
            for (int m = 0; m < 4; ++m)
#pragma unroll
                for (int n = 0; n < 2; ++n) acc[a][b][m][n] = (f32x4){0.f, 0.f, 0.f, 0.f};
    bf16x8 At[4][2], B0[2][2], B1[2][2];
    constexpr int NVH = Loc::GATHER ? 2 : 1;
    unsigned vc[2][2], vn[NVH][2];
    L.a_off(cur, tid, vc);
    if constexpr (Loc::GATHER) {
#pragma unroll
        for (int h = 0; h < 2; ++h)
#pragma unroll
            for (int i = 0; i < 2; ++i) vn[h][i] = vc[h][i];
    }
    const size_t hstepA = Loc::GATHER ? 0 : (size_t)HALF * L.lda * 2;
    const char* cA = L.a_ptr(cur); const char* cB = L.b_ptr(cur);
    PG8_STAGE(PG8_SB(0, 0), cB, voffB); PG8_STAGE(PG8_SB(0, 1), cB + hstepB, voffB); PG8_STAGE(PG8_SA(0, 0), cA, vc[0]); PG8_STAGE(PG8_SA(0, 1), cA + hstepA, vc[NVH - 1]);
    if (wr == 1) PG8_BAR;
    PG8_WAIT_V(2); PG8_BAR;
    PG8_STAGE(PG8_SB(1, 0), cB + kstep, voffB); PG8_STAGE(PG8_SA(1, 0), cA + kstep, vc[0]); PG8_STAGE(PG8_SB(1, 1), cB + hstepB + kstep, voffB);
    PG8_WAIT_V(6); PG8_BAR;
    for (;;) {
        const bool has_next = S.next(ui + 1, nxt);
        const char* nA = has_next ? L.a_ptr(nxt) : cA; const char* nB = has_next ? L.b_ptr(nxt) : cB;
        if constexpr (Loc::GATHER) { if (has_next) L.a_off(nxt, tid, vn); }
        for (int t = 0; t < nt; t += 2) {
            const bool last = (t == nt - 2);
            const char* a1 = cA + (size_t)(t + 1) * kstep;
            const char* a2 = last ? nA : cA + (size_t)(t + 2) * kstep; const char* b2 = last ? nB : cB + (size_t)(t + 2) * kstep;
            const char* a3 = a2 + kstep; const char* b3 = b2 + kstep;
            PG8_LDB(B0, 0, 0); PG8_LDB(B1, 0, 1); PG8_SCHED; PG8_LDA(At, 0, 0); PG8_STAGE(PG8_SA(1, 1), a1 + hstepA, vc[NVH - 1]);
            if constexpr (Loc::GATHER) { if (last) {
#pragma unroll
                for (int h = 0; h < 2; ++h)
#pragma unroll
                    for (int i = 0; i < 2; ++i) vc[h][i] = vn[h][i]; } }
            PG8_WAIT_V(8); PG8_WAIT_L(0); PG8_BAR; PG8_MMA(0, 0, At, B0); PG8_MMA(0, 1, At, B1); PG8_BAR; PG8_SCHED;
            PG8_LDA(At, 0, 1); PG8_STAGE(PG8_SB(0, 0), b2, voffB); PG8_STAGE(PG8_SB(0, 1), b2 + hstepB, voffB); PG8_STAGE(PG8_SA(0, 0), a2, vc[0]);
            PG8_WAIT_V(8); PG8_WAIT_L(0); PG8_BAR; PG8_MMA(1, 0, At, B0); PG8_MMA(1, 1, At, B1); PG8_BAR; PG8_SCHED;
            PG8_LDB(B0, 1, 0); PG8_LDB(B1, 1, 1); PG8_SCHED; PG8_LDA(At, 1, 0); PG8_STAGE(PG8_SA(0, 1), a2 + hstepA, vc[NVH - 1]);
            PG8_WAIT_V(8); PG8_WAIT_L(0); PG8_BAR; PG8_MMA(0, 0, At, B0); PG8_MMA(0, 1, At, B1); PG8_BAR; PG8_SCHED;
            PG8_LDA(At, 1, 1); PG8_STAGE(PG8_SB(1, 0), b3, voffB); PG8_STAGE(PG8_SB(1, 1), b3 + hstepB, voffB); PG8_STAGE(PG8_SA(1, 0), a3, vc[0]);
            PG8_WAIT_V(8); PG8_WAIT_L(0); PG8_BAR; PG8_MMA(1, 0, At, B0); PG8_MMA(1, 1, At, B1); PG8_BAR; PG8_SCHED;
        }
        if (wr == 0) PG8_BAR;
        E(acc, cur, wr, wc, fr, fq);
        if (!has_next) break;
#pragma unroll
        for (int a = 0; a < 2; ++a)
#pragma unroll
            for (int b = 0; b < 2; ++b)
#pragma unroll
                for (int m = 0; m < 4; ++m)
#pragma unroll
                    for (int n = 0; n < 2; ++n) acc[a][b][m][n] = (f32x4){0.f, 0.f, 0.f, 0.f};
        cur = nxt; cA = nA; cB = nB; ++ui;
        if (wr == 1) PG8_BAR;
    }
    PG8_WAIT_V(0);
    PG8_BAR;
#undef PG8_SA
#undef PG8_SB
#undef PG8_STAGE
#undef PG8_LDA
#undef PG8_LDB
#undef PG8_MMA
#undef PG8_WAIT_V
#undef PG8_WAIT_L
#undef PG8_BAR
#undef PG8_SCHED
}
}
constexpr int NWAVES = 8;
constexpr int M = 32768, DM = 1024, SEQ = 4096, NBATCH = 8, NLAYER = 4;
constexpr int NH = 8;
constexpr int IN_W = 6048;
constexpr int FFN = 2816, EXD = 3584, NEXP = 8;
constexpr float LN_EPS = 1e-5f, ALPHA = 1.681792830507429f;
constexpr int S5T = 32, S5CH = M / S5T  , S5K = 640, S5NC = SEQ / S5T  ;
constexpr int MOE_CAP = 65536;
constexpr int MOE_ROWS = 65536 + 8 * 256;

constexpr size_t MiB = 1u << 20;
constexpr size_t WS_CTL = 0, CTL_ZERO_BYTES = 1 * MiB;
constexpr size_t WS_WIN = 1 * MiB;
constexpr size_t WS_WG = 25 * MiB;
constexpr size_t WS_WUQ = 49 * MiB;
constexpr size_t WS_WUKV = 52 * MiB;
constexpr size_t WS_WLORA = 54 * MiB;
constexpr size_t WS_WVRES = 57 * MiB;
constexpr size_t WS_WGLU = 59 * MiB;
constexpr size_t WS_WBR = 61 * MiB;
constexpr size_t WS_WOUT = 73 * MiB;
constexpr size_t WS_WFGU = 81 * MiB;
constexpr size_t WS_WFD = 103 * MiB;
constexpr size_t WS_S5MAIN = 898 * MiB;
constexpr size_t WS_S5END = 978 * MiB;
constexpr size_t WS_S5A32 = 1010 * MiB;
constexpr size_t WS_ROPE = 143 * MiB;
constexpr size_t WS_XB = 147 * MiB;
constexpr size_t WS_VFIRST = 211 * MiB;
constexpr size_t RB = 243 * MiB;
constexpr size_t WS_S5U = RB + 0;
constexpr size_t WS_S1 = RB + 40 * MiB;
constexpr size_t WS_MLARAW = WS_S1;
constexpr size_t WS_RWRAW = WS_S1 + 48 * MiB;
constexpr size_t WS_Q = WS_S1;
constexpr size_t WS_V = WS_S1 + 48 * MiB;
constexpr size_t WS_BV = WS_S1 + 80 * MiB;
constexpr size_t WS_DCY = WS_S1 + 112 * MiB;
constexpr size_t WS_YS5G = WS_S1;
constexpr size_t WS_YS5 = WS_S1 + 32 * MiB;
constexpr size_t WS_MIXED = WS_S1 + 64 * MiB;
constexpr size_t WS_R = RB + 200 * MiB;
constexpr size_t WS_KH = RB + 232 * MiB;
constexpr size_t WS_KKN = RB + 264 * MiB;
constexpr size_t WS_GL = RB + 296 * MiB;
constexpr size_t WS_GBUF = RB + 264 * MiB;
constexpr size_t WS_VFIN = RB + 328 * MiB;
constexpr size_t WS_K = RB + 360 * MiB;
constexpr size_t WS_VRAW = RB + 408 * MiB;
constexpr size_t WS_YRW = WS_VRAW;
constexpr size_t WS_S2 = RB + 440 * MiB;
constexpr size_t WS_CQN = WS_S2;
constexpr size_t WS_CKVN = WS_S2 + 24 * MiB;
constexpr size_t WS_LORAIN = WS_S2 + 40 * MiB;
constexpr size_t WS_YMLA = WS_S2;
constexpr size_t WS_XEND = RB + 496 * MiB;
constexpr size_t WS_GBUF2 = RB + 512 * MiB;
constexpr size_t WS_MIXED2 = RB + 576 * MiB;
constexpr size_t WS_HB = RB + 0;
constexpr size_t WS_WMGU = RB + 0;
constexpr size_t WS_YPAIR = RB + 0;
constexpr size_t WS_HM = RB + 132 * MiB;
constexpr size_t WS_WMD = RB + 594 * MiB;
constexpr size_t WS_SLOTTOK = RB + 650 * MiB;
constexpr size_t WS_SLOTW = RB + 652 * MiB;
constexpr size_t WS_PAIRPOS = RB + 654 * MiB;
constexpr size_t WS_END = 1011 * MiB;
constexpr int CW_BAR = 4096;
constexpr int CW_ATTN = 200000;
constexpr int CW_MOECNT = 201024;

constexpr int RING_OFF = 0, RING_BYTES = 131072;
constexpr int LDSCTL_OFF = RING_BYTES, MISC_OFF = LDSCTL_OFF + 320;
constexpr int LDS_BYTES = 147456;

#define GAS __attribute__((address_space(1)))
#define LAS __attribute__((address_space(3)))
typedef unsigned short bf16;
typedef _Float16 f16;
typedef f16 f16x8 __attribute__((ext_vector_type(8)));
typedef unsigned v4u __attribute__((ext_vector_type(4)));
typedef unsigned v2u __attribute__((ext_vector_type(2)));
typedef float f32x4 __attribute__((ext_vector_type(4)));
typedef float f32x16 __attribute__((ext_vector_type(16)));
typedef short bf16x8 __attribute__((ext_vector_type(8)));
typedef short s16x4 __attribute__((ext_vector_type(4)));
typedef GAS unsigned gu32;
#define RLX_AGENT __ATOMIC_RELAXED, __HIP_MEMORY_SCOPE_AGENT
#define LDS_WAIT() asm volatile("s_waitcnt lgkmcnt(0)" ::: "memory")
using pg8::cvt_pk_bf16; using pg8::pack8; using pg8::unpack8; using pg8::bf_lo; using pg8::bf_hi;

__device__ __forceinline__ float sigm(float x) { return __builtin_amdgcn_rcpf(1.0f + __expf(-x)); }
__device__ __forceinline__ float gelu_tanh(float y) { const float u = 0.7978845608028654f * (y + 0.044715f * y * y * y); const float t = 1.0f - 2.0f * __builtin_amdgcn_rcpf(__expf(2.0f * u) + 1.0f); return 0.5f * y * (1.0f + t); }
__device__ __forceinline__ float wave_sum(float v) {
#pragma unroll
    for (int o = 1; o < 64; o <<= 1) v += __shfl_xor(v, o);
    return v;
}
__device__ __forceinline__ v4u ld_nt16(const void* p) { return __builtin_nontemporal_load((const v4u*)p); }
__device__ __forceinline__ void f16x8_to_f32(const f16x8 h, float (&o)[8]) {
#pragma unroll
    for (int j = 0; j < 8; ++j) o[j] = (float)h[j];
}
__device__ __forceinline__ f16x8 f32_to_f16x8(const float (&v)[8]) { f16x8 h;
#pragma unroll
    for (int j = 0; j < 8; ++j) h[j] = (f16)v[j];
    return h; }
__device__ __forceinline__ void bf16x8_to_f32(const v4u w, float (&o)[8]) { o[0] = bf_lo(w.x); o[1] = bf_hi(w.x); o[2] = bf_lo(w.y); o[3] = bf_hi(w.y); o[4] = bf_lo(w.z); o[5] = bf_hi(w.z); o[6] = bf_lo(w.w); o[7] = bf_hi(w.w); }
__device__ __forceinline__ v4u f32_to_bf16x8(const float (&v)[8]) { v4u w; w.x = cvt_pk_bf16(v[0], v[1]); w.y = cvt_pk_bf16(v[2], v[3]); w.z = cvt_pk_bf16(v[4], v[5]); w.w = cvt_pk_bf16(v[6], v[7]); return w; }
__device__ __forceinline__ void ld8f(const float* p, float (&o)[8]) { const f32x4 a = *(const f32x4*)p, b = *(const f32x4*)(p + 4); o[0] = a[0]; o[1] = a[1]; o[2] = a[2]; o[3] = a[3]; o[4] = b[0]; o[5] = b[1]; o[6] = b[2]; o[7] = b[3]; }

#define XB_TMO      128
#define XB_XCNT(j)  (256  + 64 * (j))
#define XB_XSUB(j)  (1280 + 64 * (j))
#define XB_XGEN(j)  (2304 + 64 * (j))
#define XB_TOP      3328
#define XB_TOPGEN   3392
#define XCD_BAR_WORDS 3456
#define XB_SPIN_CAP (1u << 20)

__device__ __forceinline__ unsigned xb_ld(unsigned* p)              { return __hip_atomic_load(p, __ATOMIC_RELAXED, __HIP_MEMORY_SCOPE_AGENT); }
__device__ __forceinline__ unsigned xb_add(unsigned* p, unsigned v) { return __hip_atomic_fetch_add(p, v, __ATOMIC_RELAXED, __HIP_MEMORY_SCOPE_AGENT); }
__device__ __forceinline__ unsigned xb_xcc_id() { return (unsigned)__builtin_amdgcn_s_getreg((3 << 11) | 20) & 0xFu; }
#define XB_SPIN(cond, bar) do { unsigned _sp = 0; while (cond) { __builtin_amdgcn_s_sleep(1); \
    if ((++_sp & 255u) == 0u) { if (xb_ld(&(bar)[XB_TMO])) break; if (_sp > XB_SPIN_CAP) { atomicAdd(&(bar)[XB_TMO], 1u); break; } } } } while (0)

struct XcdBarrier { unsigned* bar; unsigned x; volatile LAS unsigned* st; };

__device__ __forceinline__ XcdBarrier xcd_barrier_post(unsigned* bar, volatile LAS unsigned* st) {
    XcdBarrier b; b.bar = bar; b.x = xb_xcc_id(); b.st = st;
    if (threadIdx.x == 0) (void)xb_add(&bar[XB_XCNT(b.x)], 1u);
    return b;
}
__device__ __forceinline__ void xcd_barrier_complete(unsigned* bar, unsigned x, unsigned& nloc, unsigned& nx) {
    const unsigned G = gridDim.x * gridDim.y * gridDim.z;
    unsigned sum, cnt, mine, sp = 0u;
    for (;;) {
        sum = 0u; cnt = 0u; mine = 0u;
#pragma unroll
        for (unsigned j = 0; j < 16; ++j) { const unsigned c = xb_ld(&bar[XB_XCNT(j)]); sum += c; cnt += (c > 0u) ? 1u : 0u; mine = (j == x) ? c : mine; }
        if (sum == G) break;
        __builtin_amdgcn_s_sleep(1);
        if ((++sp & 255u) == 0u) { if (xb_ld(&bar[XB_TMO])) break; if (sp > XB_SPIN_CAP) { atomicAdd(&bar[XB_TMO], 1u); break; } }
    }
    nloc = mine > 0u ? mine : 1u; nx = cnt > 0u ? cnt : 1u;
}
__device__ __forceinline__ void xcd_barrier(const XcdBarrier& b) {
    asm volatile("s_waitcnt vmcnt(0)" ::: "memory");
    __syncthreads();
    if (threadIdx.x == 0) {
        unsigned* bar = b.bar;
        __builtin_amdgcn_s_waitcnt(0);
        unsigned nloc = b.st[0], nx = b.st[1];
        if (nloc == 0u) { xcd_barrier_complete(bar, b.x, nloc, nx); b.st[0] = nloc; b.st[1] = nx; }
        const unsigned old = xb_add(&bar[XB_XSUB(b.x)], 1u);
        const unsigned gen = old / nloc;
        if (old + 1u == (gen + 1u) * nloc) {
            __builtin_amdgcn_fence(__ATOMIC_RELEASE, "agent");
            asm volatile("s_waitcnt vmcnt(0)" ::: "memory");
            const unsigned og = xb_add(&bar[XB_TOP], 1u);
            const unsigned tg = og / nx;
            if (og + 1u == (tg + 1u) * nx) xb_add(&bar[XB_TOPGEN], 1u);
            else XB_SPIN(xb_ld(&bar[XB_TOPGEN]) == tg, bar);
            __builtin_amdgcn_fence(__ATOMIC_ACQUIRE, "agent");
            xb_add(&bar[XB_XGEN(b.x)], 1u);
            asm volatile("s_waitcnt vmcnt(0)" ::: "memory");
        } else {
            XB_SPIN(xb_ld(&bar[XB_XGEN(b.x)]) == gen, bar);
            __builtin_amdgcn_fence(__ATOMIC_ACQUIRE, "agent");
            asm volatile("s_waitcnt vmcnt(0)" ::: "memory");
        }
    }
    __syncthreads();
}

struct Args { const void* in[44]; float* out; unsigned char* ws; int ph_lo, ph_hi, li, pad; };
typedef const __attribute__((address_space(4))) Args* KArgs;
struct Frame {
    LAS unsigned char* lds;
    unsigned char* ws;
    gu32* ctl;
    int tid, lane, wave;
    int G, blk;
    float* out;
    KArgs ka;
};
#define MKFRAME(F) Frame F; { int t_ = threadIdx.x; asm volatile("" : "+v"(t_)); KArgs k_ = (KArgs)__builtin_amdgcn_kernarg_segment_ptr(); asm volatile("" : "+s"(k_)); \
    F.lds = (LAS unsigned char*)lds_raw; F.ka = k_; F.ws = k_->ws; F.ctl = (gu32*)(k_->ws + WS_CTL); F.out = k_->out; F.tid = t_; F.lane = t_ & 63; F.wave = __builtin_amdgcn_readfirstlane(t_ >> 6); F.G = gridDim.x; F.blk = blockIdx.x; }
#define WSP(T, off) ((T*)(F.ws + (off)))
#define INP(T, i) ((const T*)F.ka->in[i])
using pg8::Unit; using pg8::Epi8; using pg8::EpiGU;
__device__ __forceinline__ void f4x2_to8(const f32x4 v0, const f32x4 v1, float (&o)[8]) { o[0] = v0[0]; o[1] = v0[1]; o[2] = v0[2]; o[3] = v0[3]; o[4] = v1[0]; o[5] = v1[1]; o[6] = v1[2]; o[7] = v1[3]; }

struct FProj {
    static constexpr int BATCH = 8; bf16* mla; bf16* rw; bf16* s5u;
    __device__ __forceinline__ void begin_col(const Unit&, int) {}
    typedef pg8::NoPre Pre; __device__ __forceinline__ Pre pre(const Unit&, int, int) const { return Pre{}; }
    __device__ __forceinline__ void tile8(const Unit&, int row, int col, const f32x4 v0, const f32x4 v1, const Pre&) const {
        const v4u w = pack8(v0, v1);
        if (col < 768) *(v4u*)(mla + (unsigned)row * 768 + col) = w;
        else if (col < 2560) *(v4u*)(rw + (unsigned)row * 1792 + (col - 768)) = w;
        else { const int c = col - 2560, g = c >> 4, i = c & 15; *(v4u*)(s5u + (unsigned)((g * S5CH + (row >> 5)) * S5K) + (row & 31) * 16 + i) = w; }
    }
};
struct FQup {
    static constexpr int BATCH = 4; bf16* Q; const float* cs; float qs;
    struct Pre { f32x4 c, s; };
    __device__ __forceinline__ void begin_col(const Unit&, int) {}
    __device__ __forceinline__ Pre pre(const Unit&, int row, int col) const { Pre p; const int head = col / 96, w = (col - head * 96) >> 3;
        if (w >= 8) { const int i0 = (w - 8) * 4; p.c = *(const f32x4*)(cs + (unsigned)row * 32 + i0); p.s = *(const f32x4*)(cs + (unsigned)row * 32 + 16 + i0); } else { p.c = (f32x4){0.f, 0.f, 0.f, 0.f}; p.s = p.c; } return p; }
    __device__ __forceinline__ void tile8(const Unit&, int row, int col, const f32x4 v0, const f32x4 v1, const Pre& p) const {
        const int head = col / 96, w = (col - head * 96) >> 3;
        bf16* q = Q + (unsigned)row * 768 + head * 96;
        if (w < 8) { *(v4u*)(q + 8 * w) = pack8(v0 * qs, v1 * qs); }
        else { const int i0 = (w - 8) * 4; const f32x4 c = p.c, s = p.s;
            const f32x4 x1 = (f32x4){v0[0], v0[2], v1[0], v1[2]}, x2 = (f32x4){v0[1], v0[3], v1[1], v1[3]};
            const f32x4 o1 = (x1 * c - x2 * s) * qs, o2 = (x1 * s + x2 * c) * qs;
            v2u a, b; a.x = cvt_pk_bf16(o1[0], o1[1]); a.y = cvt_pk_bf16(o1[2], o1[3]); b.x = cvt_pk_bf16(o2[0], o2[1]); b.y = cvt_pk_bf16(o2[2], o2[3]);
            *(v2u*)(q + 64 + i0) = a; *(v2u*)(q + 80 + i0) = b; }
    }
};
struct FKVup {
    static constexpr int BATCH = 8; bf16* K; bf16* V;
    __device__ __forceinline__ void begin_col(const Unit&, int) {}
    typedef pg8::NoPre Pre; __device__ __forceinline__ Pre pre(const Unit&, int, int) const { return Pre{}; }
    __device__ __forceinline__ void tile8(const Unit&, int row, int col, const f32x4 v0, const f32x4 v1, const Pre&) const {
        const int head = col >> 7, d = col & 127; const v4u w = pack8(v0, v1);
        if (d < 64) *(v4u*)(K + (unsigned)row * 768 + head * 96 + d) = w; else *(v4u*)(V + (unsigned)row * 512 + head * 64 + (d - 64)) = w;
    }
};
struct FLora {
    static constexpr int BATCH = 4;
    const float* w0; const float* a0; const float* k_a; f16* dcy; f16* kh; const f16* kkn; f16* bv; bf16* gl; float p[8], ka[8];
    struct Pre { f16x8 k, kn; };
    __device__ __forceinline__ void begin_col(const Unit&, int col) { const int seg = col >> 9, c = col & 511; ld8f(((seg == 0) ? w0 : a0) + c, p); ld8f(k_a + c, ka); }
    __device__ __forceinline__ Pre pre(const Unit&, int row, int col) const { Pre r; const unsigned off = (unsigned)row * 512 + (col & 511);
        if ((col >> 9) == 1) { r.k = *(const f16x8*)(kh + off); r.kn = *(const f16x8*)(kkn + off); } else { r.k = (f16x8)(0); r.kn = (f16x8)(0); } return r; }
    __device__ __forceinline__ void tile8(const Unit&, int row, int col, const f32x4 v0, const f32x4 v1, const Pre& pr) const {
        float a[8]; f4x2_to8(v0, v1, a);
        const int seg = col >> 9, c = col & 511; const unsigned off = (unsigned)row * 512 + c;
        if (seg == 0) { float o[8];
#pragma unroll
            for (int j = 0; j < 8; ++j) { const float e = 0.6065306597126334f * sigm(p[j] + a[j]); o[j] = -expm1f(-e); }
            *(f16x8*)(dcy + off) = f32_to_f16x8(o); }
        else if (seg == 1) { float k[8], kn[8]; f16x8_to_f32(pr.k, k); f16x8_to_f32(pr.kn, kn); float o1[8], o2[8];
#pragma unroll
            for (int j = 0; j < 8; ++j) { const float ic = sigm(p[j] + a[j]); o1[j] = k[j] * (1.0f + (ic - 1.0f) * ka[j]); o2[j] = kn[j] * ic; }
            *(f16x8*)(kh + off) = f32_to_f16x8(o1); *(f16x8*)(bv + off) = f32_to_f16x8(o2); }
        else { *(v4u*)(gl + off) = pack8(v0, v1); }
    }
};
struct FVres {
    static constexpr int BATCH = 4;
    const float* vb; const bf16* vraw; const bf16* vfirst; f16* vfin; float p[8];
    struct Pre { v4u v, vf; };
    __device__ __forceinline__ void begin_col(const Unit&, int col) { ld8f(vb + col, p); }
    __device__ __forceinline__ Pre pre(const Unit&, int row, int col) const { Pre r; const unsigned off = (unsigned)row * 512 + col; r.v = *(const v4u*)(vraw + off); r.vf = *(const v4u*)(vfirst + off); return r; }
    __device__ __forceinline__ void tile8(const Unit&, int row, int col, const f32x4 v0, const f32x4 v1, const Pre& pr) const {
        float a[8], v[8], vf[8], o[8]; f4x2_to8(v0, v1, a); const unsigned off = (unsigned)row * 512 + col;
        bf16x8_to_f32(pr.v, v); bf16x8_to_f32(pr.vf, vf);
#pragma unroll
        for (int j = 0; j < 8; ++j) o[j] = v[j] + (vf[j] - v[j]) * sigm(p[j] + a[j]);
        *(f16x8*)(vfin + off) = f32_to_f16x8(o);
    }
};
struct FS5End {
    static constexpr int BATCH = 8; float* xend;
    __device__ __forceinline__ void begin_col(const Unit&, int) {}
    typedef pg8::NoPre Pre; __device__ __forceinline__ Pre pre(const Unit&, int, int) const { return Pre{}; }
    __device__ __forceinline__ void tile8(const Unit& u, int row, int col, const f32x4 v0, const f32x4 v1, const Pre&) const {
        if (col < 128) { float* p = xend + (unsigned)((u.z * S5CH + row) * 128 + col); *(f32x4*)p = v0; *(f32x4*)(p + 4) = v1; }
    }
};
struct FS5Main {
    static constexpr int BATCH = 8;
    const bf16* s5u; const float* dvec; bf16* ys5g; float d[8];
    struct Pre { v4u uu; };
    __device__ __forceinline__ void begin_col(const Unit& u, int col) { ld8f(dvec + u.z * 16 + (col & 15), d); }
    __device__ __forceinline__ Pre pre(const Unit& u, int row, int col) const { Pre r; r.uu = *(const v4u*)(s5u + (unsigned)((u.z * S5CH + row) * S5K + col)); return r; }
    __device__ __forceinline__ void tile8(const Unit& u, int row, int col, const f32x4 v0, const f32x4 v1, const Pre& pr) const {
        float a[8], uu[8], o[8]; f4x2_to8(v0, v1, a); const int g = u.z, t = col >> 4, o0 = col & 15;
        bf16x8_to_f32(pr.uu, uu);
#pragma unroll
        for (int j = 0; j < 8; ++j) o[j] = gelu_tanh(a[j] + d[j] * uu[j]);
        *(v4u*)(ys5g + ((unsigned)row * 32 + t) * 512 + g * 16 + o0) = f32_to_bf16x8(o);
    }
};
struct FGlu {
    static constexpr int BATCH = 8;
    const bf16* ys5g; const float* bglu; bf16* ys5; float b[8];
    struct Pre { v4u y; };
    __device__ __forceinline__ void begin_col(const Unit&, int col) { ld8f(bglu + col, b); }
    __device__ __forceinline__ Pre pre(const Unit&, int row, int col) const { Pre r; r.y = *(const v4u*)(ys5g + (unsigned)row * 512 + col); return r; }
    __device__ __forceinline__ void tile8(const Unit&, int row, int col, const f32x4 v0, const f32x4 v1, const Pre& pr) const {
        float a[8], y[8], o[8]; f4x2_to8(v0, v1, a); const unsigned off = (unsigned)row * 512 + col; bf16x8_to_f32(pr.y, y);
#pragma unroll
        for (int j = 0; j < 8; ++j) o[j] = y[j] * sigm(a[j] + b[j]);
        *(v4u*)(ys5 + off) = f32_to_bf16x8(o);
    }
};
struct FGate {
    static constexpr int BATCH = 8; bf16* gbuf;
    __device__ __forceinline__ void begin_col(const Unit&, int) {}
    typedef pg8::NoPre Pre; __device__ __forceinline__ Pre pre(const Unit&, int, int) const { return Pre{}; }
    __device__ __forceinline__ void tile8(const Unit&, int row, int col, const f32x4 v0, const f32x4 v1, const Pre&) const {
        float a[8], o[8]; f4x2_to8(v0, v1, a);
#pragma unroll
        for (int j = 0; j < 8; ++j) o[j] = sigm(a[j]);
        *(v4u*)(gbuf + (unsigned)row * 1024 + col) = f32_to_bf16x8(o);
    }
};
struct FGate2 {
    static constexpr int BATCH = 8; bf16* g0; bf16* g1;
    __device__ __forceinline__ void begin_col(const Unit&, int) {}
    typedef pg8::NoPre Pre; __device__ __forceinline__ Pre pre(const Unit&, int, int) const { return Pre{}; }
    __device__ __forceinline__ void tile8(const Unit&, int row, int col, const f32x4 v0, const f32x4 v1, const Pre&) const {
        float a[8], o[8]; f4x2_to8(v0, v1, a);
#pragma unroll
        for (int j = 0; j < 8; ++j) o[j] = sigm(a[j]);
        bf16* g = (col < 1024) ? g0 : g1;
        *(v4u*)(g + (unsigned)row * 1024 + (col & 1023)) = f32_to_bf16x8(o);
    }
};
struct FMerge {
    static constexpr int BATCH = 8; const bf16* gbuf; const bf16* min_; bf16* mout; int first; float scale;
    struct Pre { v4u g, m; };
    __device__ __forceinline__ void begin_col(const Unit&, int) {}
    __device__ __forceinline__ Pre pre(const Unit&, int row, int col) const { Pre r; const unsigned off = (unsigned)row * 1024 + col; r.g = *(const v4u*)(gbuf + off); if (!first) r.m = *(const v4u*)(min_ + off); else r.m = (v4u){0u, 0u, 0u, 0u}; return r; }
    __device__ __forceinline__ void tile8(const Unit&, int row, int col, const f32x4 v0, const f32x4 v1, const Pre& pr) const {
        float a[8], g[8], mprev[8], o[8]; f4x2_to8(v0, v1, a); const unsigned off = (unsigned)row * 1024 + col; bf16x8_to_f32(pr.g, g); bf16x8_to_f32(pr.m, mprev);
#pragma unroll
        for (int j = 0; j < 8; ++j) o[j] = mprev[j] + g[j] * a[j] * scale;
        *(v4u*)(mout + off) = f32_to_bf16x8(o);
    }
};
struct FResid {
    static constexpr int BATCH = 8; const bf16* xin; f16* xout;
    struct Pre { v4u x; };
    __device__ __forceinline__ void begin_col(const Unit&, int) {}
    __device__ __forceinline__ Pre pre(const Unit&, int row, int col) const { Pre r; r.x = *(const v4u*)(xin + (unsigned)row * 1024 + col); return r; }
    __device__ __forceinline__ void tile8(const Unit&, int row, int col, const f32x4 v0, const f32x4 v1, const Pre& pr) const {
        float x[8], a[8], o[8]; bf16x8_to_f32(pr.x, x); f4x2_to8(v0, v1, a);
#pragma unroll
        for (int j = 0; j < 8; ++j) o[j] = x[j] * ALPHA + a[j];
        *(f16x8*)(xout + (unsigned)row * 1024 + col) = f32_to_f16x8(o);
    }
};
struct FSwiglu {
    bf16* h; int ldh;
    __device__ __forceinline__ void pair8(const Unit&, int row, int colh, const f32x4 g0, const f32x4 g1, const f32x4 u0, const f32x4 u1) const {
        float g[8], uu[8], o[8]; f4x2_to8(g0, g1, g); f4x2_to8(u0, u1, uu);
#pragma unroll
        for (int j = 0; j < 8; ++j) o[j] = g[j] * sigm(g[j]) * uu[j];
        *(v4u*)(h + (unsigned)row * ldh + colh) = f32_to_bf16x8(o);
    }
};
struct FMoeDown {
    static constexpr int BATCH = 8; bf16* ypair; const float* slotw; const unsigned* cnt;
    struct Pre { float w; };
    __device__ __forceinline__ void begin_col(const Unit&, int) {}
    __device__ __forceinline__ Pre pre(const Unit& u, int row, int) const { Pre r; const int rk = u.aux + (row - u.pm * 256); r.w = ((unsigned)rk < cnt[u.z]) ? slotw[(unsigned)(u.z * MOE_CAP + rk)] : 0.f; return r; }
    __device__ __forceinline__ void tile8(const Unit& u, int row, int col, const f32x4 v0, const f32x4 v1, const Pre& pr) const {
        const int rk = u.aux + (row - u.pm * 256);
        if ((unsigned)rk < cnt[u.z]) *(v4u*)(ypair + (unsigned)row * 1024 + col) = pack8(v0 * pr.w, v1 * pr.w);
    }
};

struct MoeOrder {
    int nN, G, c; int pt[NEXP + 1];
    __device__ void init(const unsigned* cnt, int nN_, int G_, int c_) { nN = nN_; G = G_; c = c_; pt[0] = 0;
#pragma unroll
        for (int e = 0; e < NEXP; ++e) pt[e + 1] = pt[e] + (int)((cnt[e] + 255u) >> 8); }
    __device__ bool next(int i, Unit& u) const {
        const long L = (long)i * G + c; if (L >= (long)pt[NEXP] * nN) return false;
        const int tile = (int)(L / nN); u.pn = (int)(L % nN); int e = 0;
#pragma unroll
        for (int k = 1; k < NEXP; ++k) e += (tile >= pt[k]) ? 1 : 0;
        int base = 0;
#pragma unroll
        for (int k = 1; k < NEXP; ++k) base = (tile >= pt[k]) ? pt[k] : base;
        u.z = e; u.pm = tile; u.aux = (tile - base) * 256; return true;
    }
};
struct LocMoe1 {
    static constexpr bool GATHER = true;
    const bf16* A; const bf16* Bt; int lda, ldb, K; const int* slot_tok; const unsigned* cnt;
    __device__ __forceinline__ const char* a_ptr(const Unit&) const { return (const char*)A; }
    __device__ __forceinline__ const char* b_ptr(const Unit& u) const { return (const char*)(Bt + (size_t)u.z * (2 * EXD) * DM + (size_t)u.pn * 256 * ldb); }
    __device__ __forceinline__ void a_off(const Unit& u, int tid, unsigned (&v)[2][2]) const {
        const unsigned n = cnt[u.z];
#pragma unroll
        for (int i = 0; i < 2; ++i) { int R, C; pg8::stage_rc(tid * 16 + i * 8192, R, C);
#pragma unroll
            for (int h = 0; h < 2; ++h) { const int r = u.aux + h * 128 + R; const int tok = ((unsigned)r < n) ? slot_tok[(unsigned)(u.z * MOE_CAP + r)] : 0; v[h][i] = (unsigned)(tok * lda + C) * 2u; } }
    }
};
__device__ __forceinline__ int qperm_row(int n) { const int h = n / 96, d = n - h * 96; if (d < 64) return n; const int e = d - 64; return h * 96 + 64 + ((e < 16) ? 2 * e : 2 * (e - 16) + 1); }
struct TrDesc { const float* W; const float* ksc; bf16* WT; int ldw, k0, n0, ldd, kdst, drow0, qperm; };
struct TrRegs { f32x4 v[8]; };
__device__ __forceinline__ void tr_load(const TrDesc& d, TrRegs& r, int lane) {
    if (d.W) {
#pragma unroll
        for (int i = 0; i < 8; ++i) { const int kk = (lane >> 3) + 8 * i; f32x4 v = *(const f32x4*)(d.W + (size_t)(d.k0 + kk) * d.ldw + d.n0 + 4 * (lane & 7)); if (d.ksc) v = v * d.ksc[d.k0 + kk]; r.v[i] = v; }
    } else {
#pragma unroll
        for (int i = 0; i < 8; ++i) r.v[i] = (f32x4){0.f, 0.f, 0.f, 0.f};
    }
}
__device__ __forceinline__ void tr_finish(const TrDesc& d, const TrRegs& r, LAS float* scr, int lane) {
#pragma unroll
    for (int i = 0; i < 8; ++i) { const int kk = (lane >> 3) + 8 * i; LAS float* s = scr + kk * 33 + 4 * (lane & 7); s[0] = r.v[i][0]; s[1] = r.v[i][1]; s[2] = r.v[i][2]; s[3] = r.v[i][3]; }
    LDS_WAIT(); asm volatile("" ::: "memory");
    const int c = lane & 7;
#pragma unroll
    for (int j = 0; j < 4; ++j) { const int n = (lane >> 3) + 8 * j; const LAS float* s = scr + (8 * c) * 33 + n;
        v4u o; o.x = cvt_pk_bf16(s[0 * 33], s[1 * 33]); o.y = cvt_pk_bf16(s[2 * 33], s[3 * 33]); o.z = cvt_pk_bf16(s[4 * 33], s[5 * 33]); o.w = cvt_pk_bf16(s[6 * 33], s[7 * 33]);
        const int dr = d.qperm ? qperm_row(d.n0 + n) : (d.drow0 + n);
        *(v4u*)(d.WT + (size_t)dr * d.ldd + d.kdst + 8 * c) = o; }
    LDS_WAIT(); asm volatile("" ::: "memory");
}
__device__ __forceinline__ bool trjob(int& r, TrDesc& d, const float* W, int ldw, int K, int c0, int ncols, const float* ksc, bf16* WT, int ldd, int drow0) {
    const int nb = ncols / 32, ni = (K / 64) * nb; if (r < ni) { const int kb = r / nb, nbi = r % nb; d = TrDesc{W, ksc, WT, ldw, 64 * kb, c0 + 32 * nbi, ldd, 64 * kb, drow0 + 32 * nbi, 0}; return true; } r -= ni; return false; }
__device__ __forceinline__ bool trjob_gu(int& r, TrDesc& d, const float* W, int ldw, int K, int ncols, bf16* WT, int ldd, int up) {
    const int nb = ncols / 32, ni = (K / 64) * nb; if (r < ni) { const int kb = r / nb, n0 = 32 * (r % nb); d = TrDesc{W, nullptr, WT, ldw, 64 * kb, n0, ldd, 64 * kb, (n0 >> 7) * 256 + (n0 & 127) + (up ? 128 : 0), 0}; return true; } r -= ni; return false; }

constexpr int TR_PER_LAYER = 16 * 189 + 6 * 24 + 4 * 32 + 192 + 8 * 16 + 3 * 8 * 32 + 16 * 32 + 3 * 16;
constexpr int TR_PER_FFN = 3 * 16 * 88, TR_PROLOGUE = NLAYER * TR_PER_LAYER + 2 * TR_PER_FFN;
__device__ __forceinline__ void tr_decode_prologue(Frame& F, int it, TrDesc& d) {
    if (it < NLAYER * TR_PER_LAYER) {
        const int l = it / TR_PER_LAYER; int r = it % TR_PER_LAYER;
        const float* win = INP(float, 2) + (size_t)l * DM * IN_W;
        bf16* win_t = WSP(bf16, WS_WIN) + (size_t)l * 3072 * DM; bf16* wg_t = WSP(bf16, WS_WG) + (size_t)l * 3072 * DM;
        if (trjob(r, d, win, IN_W, DM, 0, 672, nullptr, win_t, DM, 0)) return;
        if (trjob(r, d, win, IN_W, DM, 672, 2304, nullptr, win_t, DM, 768)) return;
        if (trjob(r, d, win, IN_W, DM, 2976, 3072, nullptr, wg_t, DM, 0)) return;
        if (r < 48) { d = TrDesc{nullptr, nullptr, win_t, 0, 64 * (r / 3), 0, DM, 64 * (r / 3), 672 + 32 * (r % 3), 0}; return; } r -= 48;
        if (r < 144) { const int kb = r / 24, nbi = r % 24; d = TrDesc{INP(float, 4) + (size_t)l * 384 * 768, INP(float, 3) + l * 384, WSP(bf16, WS_WUQ) + (size_t)l * 768 * 384, 768, 64 * kb, 32 * nbi, 384, 64 * kb, 0, 1}; return; } r -= 144;
        if (trjob(r, d, INP(float, 6) + (size_t)l * 256 * 1024, 1024, 256, 0, 1024, INP(float, 5) + l * 256, WSP(bf16, WS_WUKV) + (size_t)l * 1024 * 256, 256, 0)) return;
        if (r < 192) { const int rb = r / 4, kb = r % 4; bf16* wl = WSP(bf16, WS_WLORA) + (size_t)l * 1536 * 256; const float* src = nullptr; int k0 = 0, n0 = 0;
            if (rb < 16) { if (kb == 0) { src = INP(float, 9) + (size_t)l * 64 * 512; n0 = 32 * rb; } }
            else if (rb < 32) { if (kb == 1) { src = INP(float, 11) + (size_t)l * 64 * 512; n0 = 32 * (rb - 16); } }
            else { if (kb >= 2) { src = INP(float, 12) + (size_t)l * 128 * 512; k0 = 64 * (kb - 2); n0 = 32 * (rb - 32); } }
            d = TrDesc{src, nullptr, wl, 512, k0, n0, 256, 64 * kb, 32 * rb, 0}; return; } r -= 192;
        if (trjob(r, d, INP(float, 29) + (size_t)l * 512 * 512, 512, 512, 0, 512, nullptr, WSP(bf16, WS_WGLU) + (size_t)l * 512 * 512, 512, 0)) return;
        if (trjob(r, d, INP(float, 31) + (size_t)(l * 3 + 0) * 512 * 1024, 1024, 512, 0, 1024, nullptr, WSP(bf16, WS_WBR) + (size_t)(l * 3 + 0) * 1024 * 512, 512, 0)) return;
        if (trjob(r, d, INP(float, 31) + (size_t)(l * 3 + 1) * 512 * 1024, 1024, 512, 0, 1024, nullptr, WSP(bf16, WS_WBR) + (size_t)(l * 3 + 1) * 1024 * 512, 512, 0)) return;
        if (trjob(r, d, INP(float, 31) + (size_t)(l * 3 + 2) * 512 * 1024, 1024, 512, 0, 1024, nullptr, WSP(bf16, WS_WBR) + (size_t)(l * 3 + 2) * 1024 * 512, 512, 0)) return;
        (void)trjob(r, d, INP(float, 32) + (size_t)l * DM * DM, DM, DM, 0, DM, nullptr, WSP(bf16, WS_WOUT) + (size_t)l * DM * DM, DM, 0);
    } else {
        const int q = it - NLAYER * TR_PER_LAYER, i = q / TR_PER_FFN; int r = q % TR_PER_FFN;
        if (trjob_gu(r, d, INP(float, 37) + (size_t)i * DM * FFN, FFN, DM, FFN, WSP(bf16, WS_WFGU) + (size_t)i * 2 * FFN * DM, DM, 0)) return;
        if (trjob_gu(r, d, INP(float, 38) + (size_t)i * DM * FFN, FFN, DM, FFN, WSP(bf16, WS_WFGU) + (size_t)i * 2 * FFN * DM, DM, 1)) return;
        (void)trjob(r, d, INP(float, 39) + (size_t)i * FFN * DM, DM, FFN, 0, DM, nullptr, WSP(bf16, WS_WFD) + (size_t)i * DM * FFN, FFN, 0);
    }
}
constexpr int TR_PER_E = 2 * 16 * 112 + 56 * 32;
__device__ __forceinline__ void tr_decode_moe(Frame& F, int li, int it, TrDesc& d) {
    const int e = it / TR_PER_E; int r = it % TR_PER_E; const size_t wi = (size_t)(li * NEXP + e);
    if (trjob_gu(r, d, INP(float, 41) + wi * DM * EXD, EXD, DM, EXD, WSP(bf16, WS_WMGU) + (size_t)e * 2 * EXD * DM, DM, 0)) return;
    if (trjob_gu(r, d, INP(float, 42) + wi * DM * EXD, EXD, DM, EXD, WSP(bf16, WS_WMGU) + (size_t)e * 2 * EXD * DM, DM, 1)) return;
    (void)trjob(r, d, INP(float, 43) + wi * EXD * DM, DM, EXD, 0, DM, nullptr, WSP(bf16, WS_WMD) + (size_t)e * DM * EXD, EXD, 0);
}

__device__ __forceinline__ void p0_prologue(Frame& F) {
    LAS float* scr = (LAS float*)(F.lds + F.wave * 16384);
    const int lane = F.lane; const int gw = F.blk * NWAVES + F.wave, NGW = F.G * NWAVES;
    { TrDesc dc, dn; TrRegs rc, rn; int it = gw;
      if (it < TR_PROLOGUE) { tr_decode_prologue(F, it, dc); tr_load(dc, rc, lane); }
      for (; it < TR_PROLOGUE; it += NGW) { const bool more = it + NGW < TR_PROLOGUE;
          if (more) { tr_decode_prologue(F, it + NGW, dn); tr_load(dn, rn, lane); }
          tr_finish(dc, rc, scr, lane);
          if (more) { dc = dn; rc = rn; } } }
    for (int it = F.blk * 512 + F.tid; it < 3 * 512 * 64; it += F.G * 512) {
        const int i = it / (512 * 64), rem = it % (512 * 64), n = rem >> 6, k0 = (rem & 63) * 8;
        const float* vd = INP(float, 18) + (size_t)i * 512 * 32; const float* vu = INP(float, 19) + (size_t)i * 32 * 512; float o[8];
#pragma unroll
        for (int j = 0; j < 8; ++j) o[j] = 0.f;
        for (int rr = 0; rr < 32; ++rr) { const float u = vu[rr * 512 + n];
#pragma unroll
            for (int j = 0; j < 8; ++j) o[j] += vd[(k0 + j) * 32 + rr] * u; }
        *(v4u*)(WSP(bf16, WS_WVRES) + (size_t)i * 512 * 512 + (size_t)n * 512 + k0) = f32_to_bf16x8(o);
    }
    for (int it = F.blk * 512 + F.tid; it < M * 16; it += F.G * 512) {
        const int m = it >> 4, i = it & 15; const float inv = powf(10000.0f, -(float)i * (1.0f / 16.0f)); const float ang = (float)INP(int, 1)[m] * inv;
        float sn, cn; sincosf(ang, &sn, &cn); float* cs = WSP(float, WS_ROPE) + (size_t)m * 32; cs[i] = cn; cs[16 + i] = sn;
    }
}
__device__ __forceinline__ void moe_convert(Frame& F, int li) {
    LAS float* scr = (LAS float*)(F.lds + F.wave * 16384);
    const int lane = F.lane; const int gw = F.blk * NWAVES + F.wave, NGW = F.G * NWAVES;
    TrDesc dc, dn; TrRegs rc, rn; int it = gw;
    if (it < NEXP * TR_PER_E) { tr_decode_moe(F, li, it, dc); tr_load(dc, rc, lane); }
    for (; it < NEXP * TR_PER_E; it += NGW) { const bool more = it + NGW < NEXP * TR_PER_E;
        if (more) { tr_decode_moe(F, li, it + NGW, dn); tr_load(dn, rn, lane); }
        tr_finish(dc, rc, scr, lane);
        if (more) { dc = dn; rc = rn; } }
}

__device__ __forceinline__ void ph2_prep(Frame& F, int l) {
    const int lane = F.lane; const int gw = F.blk * NWAVES + F.wave, NGW = F.G * NWAVES;
    const bf16* rwraw = WSP(bf16, WS_RWRAW); const bf16* mlaraw = WSP(bf16, WS_MLARAW);
    const float* mu = INP(float, 7) + l * 1792; const float* k_k = INP(float, 13) + l * 512;
    float mu_r[8], mu_k[8], mu_v[8], mu_t[8], kk8[8];
    ld8f(mu + 8 * lane, mu_r); ld8f(mu + 512 + 8 * lane, mu_k); ld8f(mu + 1024 + 8 * lane, mu_v); ld8f(mu + 1536 + 8 * (lane & 31), mu_t); ld8f(k_k + 8 * lane, kk8);
    const float* cs_all = WSP(float, WS_ROPE);
    constexpr int TPW = 16;
    const int m0 = gw * TPW;
    v4u n_r, n_k, n_v, n_t, n_a, n_b, p_r, p_k, p_v, p_t;
    { const bf16* cur = rwraw + (size_t)m0 * 1792; n_r = *(const v4u*)(cur + 8 * lane); n_k = *(const v4u*)(cur + 512 + 8 * lane); n_v = *(const v4u*)(cur + 1024 + 8 * lane); n_t = *(const v4u*)(cur + 1536 + 8 * (lane & 31));
      const bf16* mr = mlaraw + (size_t)m0 * 768; n_a = *(const v4u*)(mr + 8 * lane); n_b = *(const v4u*)(mr + 512 + 8 * (lane & 31));
      if (m0 & (SEQ - 1)) { const bf16* prv = cur - 1792; p_r = *(const v4u*)(prv + 8 * lane); p_k = *(const v4u*)(prv + 512 + 8 * lane); p_v = *(const v4u*)(prv + 1024 + 8 * lane); p_t = *(const v4u*)(prv + 1536 + 8 * (lane & 31)); }
      else { p_r = (v4u){0u, 0u, 0u, 0u}; p_k = p_r; p_v = p_r; p_t = p_r; } }
    for (int i = 0; i < TPW; ++i) {
        const int m = m0 + i;
        const v4u c_r = n_r, c_k = n_k, c_v = n_v, c_t = n_t, c_a = n_a, c_b = n_b;
        if (i + 1 < TPW) { const bf16* nx = rwraw + (size_t)(m + 1) * 1792; n_r = *(const v4u*)(nx + 8 * lane); n_k = *(const v4u*)(nx + 512 + 8 * lane); n_v = *(const v4u*)(nx + 1024 + 8 * lane); n_t = *(const v4u*)(nx + 1536 + 8 * (lane & 31));
            const bf16* mr = mlaraw + (size_t)(m + 1) * 768; n_a = *(const v4u*)(mr + 8 * lane); n_b = *(const v4u*)(mr + 512 + 8 * (lane & 31)); }
        float c[8], p[8], o[8];
        bf16x8_to_f32(c_r, c); bf16x8_to_f32(p_r, p);
#pragma unroll
        for (int j = 0; j < 8; ++j) o[j] = c[j] + (p[j] - c[j]) * mu_r[j];
        *(f16x8*)(WSP(f16, WS_R) + (size_t)m * 512 + 8 * lane) = f32_to_f16x8(o);
        bf16x8_to_f32(c_k, c); bf16x8_to_f32(p_k, p);
        float ss = 0.f;
#pragma unroll
        for (int j = 0; j < 8; ++j) { o[j] = c[j] + (p[j] - c[j]) * mu_k[j]; const float q = o[j] * kk8[j]; ss += q * q; }
        *(f16x8*)(WSP(f16, WS_KH) + (size_t)m * 512 + 8 * lane) = f32_to_f16x8(o);
        ss += __shfl_xor(ss, 1); ss += __shfl_xor(ss, 2); ss += __shfl_xor(ss, 4);
        { const float rn = 1.0f / fmaxf(sqrtf(ss), 1e-12f);
#pragma unroll
          for (int j = 0; j < 8; ++j) o[j] = o[j] * kk8[j] * rn; }
        *(f16x8*)(WSP(f16, WS_KKN) + (size_t)m * 512 + 8 * lane) = f32_to_f16x8(o);
        bf16x8_to_f32(c_v, c); bf16x8_to_f32(p_v, p);
#pragma unroll
        for (int j = 0; j < 8; ++j) o[j] = c[j] + (p[j] - c[j]) * mu_v[j];
        { const v4u vb = f32_to_bf16x8(o); *(v4u*)(WSP(bf16, WS_VRAW) + (size_t)m * 512 + 8 * lane) = vb;
          if (l == 0) { *(v4u*)(WSP(bf16, WS_VFIRST) + (size_t)m * 512 + 8 * lane) = vb; *(f16x8*)(WSP(f16, WS_VFIN) + (size_t)m * 512 + 8 * lane) = f32_to_f16x8(o); } }
        if (lane < 32) {
            bf16x8_to_f32(c_t, c); bf16x8_to_f32(p_t, p);
#pragma unroll
            for (int j = 0; j < 8; ++j) { float v = c[j] + (p[j] - c[j]) * mu_t[j]; if (lane < 8) v = 1.0f - 2.0f * __builtin_amdgcn_rcpf(__expf(2.0f * v) + 1.0f); else if (lane >= 16) v = sigm(v); o[j] = v; }
            *(v4u*)(WSP(bf16, WS_LORAIN) + (size_t)m * 256 + 8 * lane) = f32_to_bf16x8(o);
        }
        p_r = c_r; p_k = c_k; p_v = c_v; p_t = c_t;
        float a8[8], b8[8];
        bf16x8_to_f32(c_a, a8); float ssa = 0.f, ssb = 0.f;
#pragma unroll
        for (int j = 0; j < 8; ++j) ssa += a8[j] * a8[j];
        if (lane < 32) { bf16x8_to_f32(c_b, b8);
#pragma unroll
            for (int j = 0; j < 8; ++j) ssb += b8[j] * b8[j]; } else {
#pragma unroll
            for (int j = 0; j < 8; ++j) b8[j] = 0.f; }
        const float sq = wave_sum(lane < 48 ? ssa : 0.f), skv = wave_sum((lane >= 48 ? ssa : 0.f) + (lane < 16 ? ssb : 0.f));
        const float rq = 1.0f / sqrtf(sq * (1.0f / 384.0f) + 1e-6f), rkv = 1.0f / sqrtf(skv * (1.0f / 256.0f) + 1e-6f);
        if (lane < 48) {
#pragma unroll
            for (int j = 0; j < 8; ++j) o[j] = a8[j] * rq;
            *(v4u*)(WSP(bf16, WS_CQN) + (size_t)m * 384 + 8 * lane) = f32_to_bf16x8(o);
        } else {
#pragma unroll
            for (int j = 0; j < 8; ++j) o[j] = a8[j] * rkv;
            *(v4u*)(WSP(bf16, WS_CKVN) + (size_t)m * 256 + 8 * (lane - 48)) = f32_to_bf16x8(o);
        }
        if (lane < 16) {
#pragma unroll
            for (int j = 0; j < 8; ++j) o[j] = b8[j] * rkv;
            *(v4u*)(WSP(bf16, WS_CKVN) + (size_t)m * 256 + 128 + 8 * lane) = f32_to_bf16x8(o);
        }
        float pr[8];
#pragma unroll
        for (int j = 0; j < 8; ++j) pr[j] = __shfl_xor(b8[j], 2);
        if (lane >= 16 && lane < 20) { const int i0 = 8 * (lane & 1); const float* cs = cs_all + (size_t)m * 32; float cc[8], sn[8]; ld8f(cs + i0, cc); ld8f(cs + 16 + i0, sn);
            const bool lo = lane < 18;
#pragma unroll
            for (int j = 0; j < 8; ++j) o[j] = lo ? (b8[j] * cc[j] - pr[j] * sn[j]) : (pr[j] * sn[j] + b8[j] * cc[j]);
            const v4u w = f32_to_bf16x8(o); bf16* kd = WSP(bf16, WS_K) + (size_t)m * 768 + 64 + (lo ? 0 : 16) + i0;
#pragma unroll
            for (int h = 0; h < NH; ++h) *(v4u*)(kd + h * 96) = w; }
    }
}

__device__ __forceinline__ void s5_gen(Frame& F, int l, int g) {
    {
        __syncthreads();
        const int tid = F.tid;
        LAS float* pw = (LAS float*)F.lds;
        LAS float* Bb = pw + 33 * 64 * 2;
        LAS float* Cc = Bb + 64 * 16 * 2;
        LAS float* Kt = Cc + 16 * 64 * 2;
        const float dt = expf(INP(float, 23)[l * 32 + g]);
        const float* are = INP(float, 21) + (size_t)(l * 32 + g) * 64; const float* aim = INP(float, 22) + (size_t)(l * 32 + g) * 64;
        for (int e = tid; e < 33 * 64; e += 512) { const int n = e >> 6, p = e & 63; const float lr = fminf(are[p], -1e-4f), li = aim[p];
            const float mag = expf((float)n * (dt * lr)); float sn, cn; sincosf((float)n * (dt * li), &sn, &cn); pw[2 * e] = mag * cn; pw[2 * e + 1] = mag * sn; }
        for (int e = tid; e < 64 * 16; e += 512) { const int p = e >> 4; const float lr = fminf(are[p], -1e-4f), li = aim[p];
            const float mag = expf(dt * lr); float sn, cn; sincosf(dt * li, &sn, &cn); const float abr = mag * cn, abi = mag * sn, den = lr * lr + li * li;
            const float fr = ((abr - 1.0f) * lr + abi * li) / den, fi = (abi * lr - (abr - 1.0f) * li) / den;
            const float br = INP(float, 24)[(size_t)(l * 32 + g) * 1024 + e], bi = INP(float, 25)[(size_t)(l * 32 + g) * 1024 + e];
            Bb[2 * e] = fr * br - fi * bi; Bb[2 * e + 1] = fr * bi + fi * br; }
        for (int e = tid; e < 16 * 64; e += 512) { Cc[2 * e] = INP(float, 26)[(size_t)(l * 32 + g) * 1024 + e]; Cc[2 * e + 1] = INP(float, 27)[(size_t)(l * 32 + g) * 1024 + e]; }
        __syncthreads();
        { const int tau = tid >> 4, o = tid & 15; float acc[16];
#pragma unroll
          for (int i = 0; i < 16; ++i) acc[i] = 0.f;
          for (int p = 0; p < 64; ++p) { const float cr = Cc[2 * (o * 64 + p)], ci = Cc[2 * (o * 64 + p) + 1], pr_ = pw[2 * (tau * 64 + p)], pi_ = pw[2 * (tau * 64 + p) + 1];
              const float xr = cr * pr_ - ci * pi_, xi = cr * pi_ + ci * pr_;
#pragma unroll
              for (int i = 0; i < 16; ++i) acc[i] += xr * Bb[2 * (p * 16 + i)] - xi * Bb[2 * (p * 16 + i) + 1]; }
#pragma unroll
          for (int i = 0; i < 16; ++i) Kt[(tau * 16 + o) * 16 + i] = acc[i]; }
        __syncthreads();
        bf16* bm = WSP(bf16, WS_S5MAIN) + ((size_t)l * 32 + g) * 512 * S5K;
        for (int e = tid; e < 512 * 80; e += 512) { const int n = e / 80, k0 = (e % 80) * 8, t = n >> 4, o = n & 15; float v[8];
            if (k0 < 512) { const int sidx = k0 >> 4, i0 = k0 & 15;
#pragma unroll
                for (int j = 0; j < 8; ++j) v[j] = (sidx <= t) ? Kt[((t - sidx) * 16 + o) * 16 + i0 + j] : 0.f; }
            else {
#pragma unroll
                for (int j = 0; j < 8; ++j) { const int q = k0 - 512 + j, p = q & 63; const float cr = Cc[2 * (o * 64 + p)], ci = Cc[2 * (o * 64 + p) + 1], pr_ = pw[2 * ((t + 1) * 64 + p)], pi_ = pw[2 * ((t + 1) * 64 + p) + 1];
                    v[j] = (q < 64) ? (cr * pr_ - ci * pi_) : -(cr * pi_ + ci * pr_); } }
            *(v4u*)(bm + (size_t)n * S5K + k0) = f32_to_bf16x8(v); }
        bf16* be = WSP(bf16, WS_S5END) + ((size_t)l * 32 + g) * 256 * 512;
        for (int e = tid; e < 256 * 64; e += 512) { const int n = e / 64, k0 = (e % 64) * 8, sidx = k0 >> 4, i0 = k0 & 15; float v[8];
            if (n < 128) { const int p = n & 63; const float pr_ = pw[2 * ((31 - sidx) * 64 + p)], pi_ = pw[2 * ((31 - sidx) * 64 + p) + 1];
#pragma unroll
                for (int j = 0; j < 8; ++j) { const float br = Bb[2 * (p * 16 + i0 + j)], bi = Bb[2 * (p * 16 + i0 + j) + 1]; v[j] = (n < 64) ? (pr_ * br - pi_ * bi) : (pr_ * bi + pi_ * br); } }
            else {
#pragma unroll
                for (int j = 0; j < 8; ++j) v[j] = 0.f; }
            *(v4u*)(be + (size_t)n * 512 + k0) = f32_to_bf16x8(v); }
        if (tid < 64) { float* a32 = WSP(float, WS_S5A32) + (size_t)((l * 32 + g) * 64 + tid) * 2; a32[0] = pw[2 * (32 * 64 + tid)]; a32[1] = pw[2 * (32 * 64 + tid) + 1]; }
        __syncthreads();
    }
}

__device__ __forceinline__ void ln_core(f32x4 (&v)[4], const float* gam, const float* bet, int lane) {
    float s = 0.f;
#pragma unroll
    for (int j = 0; j < 4; ++j) s += (v[j][0] + v[j][1]) + (v[j][2] + v[j][3]);
    const float mean = wave_sum(s) * (1.f / DM); float s2 = 0.f;
#pragma unroll
    for (int j = 0; j < 4; ++j) { v[j] = v[j] - mean; s2 += (v[j][0] * v[j][0] + v[j][1] * v[j][1]) + (v[j][2] * v[j][2] + v[j][3] * v[j][3]); }
    const float rstd = 1.f / sqrtf(wave_sum(s2) * (1.f / DM) + LN_EPS);
#pragma unroll
    for (int j = 0; j < 4; ++j) { const f32x4 g4 = *(const f32x4*)(gam + 4 * lane + 256 * j), b4 = *(const f32x4*)(bet + 4 * lane + 256 * j); v[j] = v[j] * rstd * g4 + b4; }
}
__device__ __forceinline__ void ln_store(const f32x4 (&v)[4], float* xrow, bf16* xbrow, int lane) {
#pragma unroll
    for (int j = 0; j < 4; ++j) { if (xrow) *(f32x4*)(xrow + 4 * lane + 256 * j) = v[j]; v2u w; w.x = cvt_pk_bf16(v[j][0], v[j][1]); w.y = cvt_pk_bf16(v[j][2], v[j][3]); *(v2u*)(xbrow + 4 * lane + 256 * j) = w; }
}
__device__ __forceinline__ void ln_phase(Frame& F, const float* gam, const float* bet) {
    const int lane = F.lane; const int gw = F.blk * NWAVES + F.wave, NGW = F.G * NWAVES; const f16* X = (const f16*)F.out; bf16* Xb = WSP(bf16, WS_XB);
    for (int m = gw; m < M; m += NGW) { f32x4 v[4];
#pragma unroll
        for (int j = 0; j < 4; ++j) { typedef f16 f16x4 __attribute__((ext_vector_type(4))); const f16x4 h = *(const f16x4*)(X + (size_t)m * DM + 4 * lane + 256 * j); v[j] = (f32x4){(float)h[0], (float)h[1], (float)h[2], (float)h[3]}; }
        ln_core(v, gam, bet, lane); ln_store(v, nullptr, Xb + (size_t)m * DM, lane); }
}
__device__ __forceinline__ void ln2_moe_phase(Frame& F, const float* gam, const float* bet, int li, bool last) {
    const int lane = F.lane; const int gw = F.blk * NWAVES + F.wave, NGW = F.G * NWAVES; float* X = F.out; bf16* Xb = WSP(bf16, WS_XB);
    const unsigned* cnt = (const unsigned*)(F.ctl + CW_MOECNT + 64 * li); int pstart[NEXP]; { int acc = 0;
#pragma unroll
        for (int e = 0; e < NEXP; ++e) { pstart[e] = acc; acc += (int)(((cnt[e] + 255u) >> 8) << 8); } }
    const int* ppos = WSP(int, WS_PAIRPOS); const bf16* yp = WSP(bf16, WS_YPAIR);
    for (int m = gw; m < M; m += NGW) { f32x4 v[4];
        const int p0 = ppos[2 * m], p1 = ppos[2 * m + 1]; int r0 = 0, r1 = 0;
#pragma unroll
        for (int e = 0; e < NEXP; ++e) { if ((p0 >> 24) == e) r0 = pstart[e] + (p0 & 0xffffff); if ((p1 >> 24) == e) r1 = pstart[e] + (p1 & 0xffffff); }
#pragma unroll
        for (int j = 0; j < 4; ++j) { const v2u xw = *(const v2u*)(Xb + (size_t)m * DM + 4 * lane + 256 * j); const f32x4 x = (f32x4){bf_lo(xw.x), bf_hi(xw.x), bf_lo(xw.y), bf_hi(xw.y)};
            const v2u a = *(const v2u*)(yp + (size_t)r0 * DM + 4 * lane + 256 * j), b = *(const v2u*)(yp + (size_t)r1 * DM + 4 * lane + 256 * j);
            v[j] = x * ALPHA + (f32x4){bf_lo(a.x) + bf_lo(b.x), bf_hi(a.x) + bf_hi(b.x), bf_lo(a.y) + bf_lo(b.y), bf_hi(a.y) + bf_hi(b.y)}; }
        ln_core(v, gam, bet, lane); ln_store(v, last ? X + (size_t)m * DM : nullptr, Xb + (size_t)m * DM, lane); }
}
__device__ __forceinline__ void ln1_moe_phase(Frame& F, const float* gam, const float* bet, int li) {
    const int lane = F.lane; float* X = F.out; bf16* Xb = WSP(bf16, WS_XB);
    LAS int* pe = (LAS int*)F.lds;
    LAS float* pwt = (LAS float*)(F.lds + 1024);
    LAS int* cntl = (LAS int*)(F.lds + 2048);
    const float* router = INP(float, 40) + (size_t)li * DM * NEXP;
    for (int blk0 = F.blk; blk0 * 128 < M; blk0 += F.G) {
        __syncthreads();
        for (int i = 0; i < 16; ++i) { const int tl = F.wave * 16 + i, m = blk0 * 128 + tl; f32x4 v[4];
#pragma unroll
            for (int j = 0; j < 4; ++j) { typedef f16 f16x4 __attribute__((ext_vector_type(4))); const f16x4 h = *(const f16x4*)((const f16*)X + (size_t)m * DM + 4 * lane + 256 * j); v[j] = (f32x4){(float)h[0], (float)h[1], (float)h[2], (float)h[3]}; }
            ln_core(v, gam, bet, lane); ln_store(v, nullptr, Xb + (size_t)m * DM, lane);
            float lg[NEXP];
#pragma unroll
            for (int e = 0; e < NEXP; ++e) lg[e] = 0.f;
#pragma unroll
            for (int j = 0; j < 4; ++j)
#pragma unroll
                for (int q = 0; q < 4; ++q) { const float xv = v[j][q]; const float* rr = router + (size_t)(4 * lane + 256 * j + q) * NEXP; const f32x4 ra = *(const f32x4*)rr, rb = *(const f32x4*)(rr + 4);
                    lg[0] += xv * ra[0]; lg[1] += xv * ra[1]; lg[2] += xv * ra[2]; lg[3] += xv * ra[3]; lg[4] += xv * rb[0]; lg[5] += xv * rb[1]; lg[6] += xv * rb[2]; lg[7] += xv * rb[3]; }
#pragma unroll
            for (int e = 0; e < NEXP; ++e) lg[e] = wave_sum(lg[e]);
            int e0 = 0; float l0 = lg[0];
#pragma unroll
            for (int e = 1; e < NEXP; ++e) if (lg[e] > l0) { l0 = lg[e]; e0 = e; }
            int e1 = -1; float l1 = -INFINITY;
#pragma unroll
            for (int e = 0; e < NEXP; ++e) if (e != e0 && lg[e] > l1) { l1 = lg[e]; e1 = e; }
            const float w1 = 1.0f / (1.0f + expf(l0 - l1)), w0 = 1.0f - w1;
            if (lane == 0) { pe[2 * tl] = e0; pe[2 * tl + 1] = e1; pwt[2 * tl] = w0; pwt[2 * tl + 1] = w1; }
        }
        __syncthreads();
        int myrank = 0, mye = 0;
        if (F.tid < 256) { mye = pe[F.tid]; for (int q = 0; q < F.tid; ++q) myrank += (pe[q] == mye) ? 1 : 0; }
#ifdef PROBE_ORDERED
        if (F.tid == 0) { unsigned sp = 0; while (__hip_atomic_load((unsigned*)(F.ctl + CW_MOECNT + 64 * li + 32), RLX_AGENT) != (unsigned)blk0 && ++sp < (1u << 22)) __builtin_amdgcn_s_sleep(2); }
        __syncthreads();
#endif
        if (F.tid < NEXP) { int c = 0; for (int q = 0; q < 256; ++q) c += (pe[q] == F.tid) ? 1 : 0; cntl[F.tid] = c;
            cntl[8 + F.tid] = (int)__hip_atomic_fetch_add((unsigned*)(F.ctl + CW_MOECNT + 64 * li + F.tid), (unsigned)c, RLX_AGENT); }
#ifdef PROBE_ORDERED
        __syncthreads();
        if (F.tid == 0) { asm volatile("s_waitcnt vmcnt(0)" ::: "memory"); __hip_atomic_fetch_add((unsigned*)(F.ctl + CW_MOECNT + 64 * li + 32), 1u, RLX_AGENT); }
#endif
        __syncthreads();
        if (F.tid < 256) { const int rk = cntl[8 + mye] + myrank; const int m = blk0 * 128 + (F.tid >> 1);
            WSP(int, WS_SLOTTOK)[(size_t)mye * MOE_CAP + rk] = m; WSP(float, WS_SLOTW)[(size_t)mye * MOE_CAP + rk] = pwt[F.tid]; WSP(int, WS_PAIRPOS)[blk0 * 256 + F.tid] = (mye << 24) | rk; }
    }
    __syncthreads();
}
constexpr int AT_KS = 208, AT_VS = 192;
constexpr int AT_KB = 64 * AT_KS, AT_VB = 64 * AT_VS, AT_STAGE = AT_KB + AT_VB;
constexpr int AT_WSF = 2 * AT_STAGE, AT_OST = AT_WSF + NWAVES * 256, AT_LDS = AT_OST + NWAVES * 4096;
__device__ __forceinline__ int crow(int r, int hi) { return (r & 3) + 8 * (r >> 2) + 4 * hi; }

__device__ __forceinline__ void attn_unit(int tid, int b, int h, int qb, const bf16* Q, const bf16* K, const bf16* V, bf16* O, LAS unsigned char* lds) {
    const int lane = tid & 63, r32 = lane & 31, hi = lane >> 5; const int wid = __builtin_amdgcn_readfirstlane(tid >> 6);
    const size_t rowbase = (size_t)b * SEQ; const int q0 = qb * 256;
    bf16x8 qr[6];
    { const bf16* qp = Q + (rowbase + q0 + wid * 32 + r32) * 768 + h * 96 + hi * 8;
#pragma unroll
      for (int d0 = 0; d0 < 6; ++d0) qr[d0] = *(const bf16x8*)(qp + d0 * 16); }
    const int kp0 = tid, kp1 = 512 + tid;
    const bf16* kg0 = K + (rowbase + kp0 / 12) * 768 + h * 96 + (kp0 % 12) * 8;
    const bf16* kg1 = K + (rowbase + kp1 / 12) * 768 + h * 96 + (kp1 % 12) * 8;
    const bf16* vg = V + (rowbase + (tid >> 3)) * 512 + h * 64 + (tid & 7) * 8;
    const int kl0 = (kp0 / 12) * AT_KS + (kp0 % 12) * 16, kl1 = (kp1 / 12) * AT_KS + (kp1 % 12) * 16, vl = (tid >> 3) * AT_VS + (tid & 7) * 16;
    const bool two = tid < 256;
    const int NT = 4 * (qb + 1);
    v4u ka, kb2, va;
    ka = *(const v4u*)kg0; if (two) kb2 = *(const v4u*)kg1; va = *(const v4u*)vg;
    *(LAS v4u*)(lds + kl0) = ka; if (two) *(LAS v4u*)(lds + kl1) = kb2; *(LAS v4u*)(lds + AT_KB + vl) = va;
    LAS float* wsf = (LAS float*)(lds + AT_WSF) + wid * 64;
    float m_run = -1e30f, l_run = 0.f; f32x16 o[2];
#pragma unroll
    for (int r = 0; r < 16; ++r) { o[0][r] = 0.f; o[1][r] = 0.f; }
    const int kfo = r32 * AT_KS + hi * 16;
    const int vfo = (4 * hi + ((lane & 15) >> 2)) * AT_VS + ((lane >> 4) & 1) * 32 + (lane & 3) * 8;
    const int qrel = wid * 32 + r32;
    __syncthreads();
    for (int t = 0; t < NT; ++t) {
        const int cur = (t & 1) * AT_STAGE, nxt = ((t + 1) & 1) * AT_STAGE; const bool more = (t + 1 < NT);
        if (more) { const size_t go = (size_t)(t + 1) * 64 * 768; ka = *(const v4u*)(kg0 + go); if (two) kb2 = *(const v4u*)(kg1 + go); va = *(const v4u*)(vg + (size_t)(t + 1) * 64 * 512); }
        const int jb = t - (NT - 4);
        if (jb < 0 || 64 * jb <= 32 * wid + 31) {
            f32x16 p0, p1;
#pragma unroll
            for (int r = 0; r < 16; ++r) { p0[r] = 0.f; p1[r] = 0.f; }
#pragma unroll
            for (int d0 = 0; d0 < 6; ++d0) { const bf16x8 k0 = *(const LAS bf16x8*)(lds + cur + kfo + d0 * 32), k1 = *(const LAS bf16x8*)(lds + cur + kfo + 32 * AT_KS + d0 * 32);
                p0 = __builtin_amdgcn_mfma_f32_32x32x16_bf16(k0, qr[d0], p0, 0, 0, 0); p1 = __builtin_amdgcn_mfma_f32_32x32x16_bf16(k1, qr[d0], p1, 0, 0, 0); }
            if (jb >= 0) { const int kb = 64 * jb + 4 * hi;
#pragma unroll
                for (int r = 0; r < 16; ++r) { const int kv = kb + (r & 3) + 8 * (r >> 2); if (kv > qrel) p0[r] = -INFINITY; if (kv + 32 > qrel) p1[r] = -INFINITY; } }
            float rm = fmaxf(p0[0], p1[0]);
#pragma unroll
            for (int r = 1; r < 16; ++r) rm = fmaxf(rm, fmaxf(p0[r], p1[r]));
            rm = fmaxf(rm, __shfl_xor(rm, 32));
            const float mnew = fmaxf(m_run, rm), alpha = __builtin_amdgcn_exp2f(m_run - mnew);
            float ps = 0.f;
#pragma unroll
            for (int r = 0; r < 16; ++r) { p0[r] = __builtin_amdgcn_exp2f(p0[r] - mnew); p1[r] = __builtin_amdgcn_exp2f(p1[r] - mnew); ps += p0[r] + p1[r]; }
            l_run = l_run * alpha + ps;
            if (__any(mnew > m_run)) {
                if (hi == 0) wsf[r32] = alpha;
                LDS_WAIT();
#pragma unroll
                for (int r = 0; r < 16; ++r) { const float f = wsf[crow(r, hi)]; o[0][r] *= f; o[1][r] *= f; }
            }
            m_run = mnew;
            bf16x8 pa[4];
            { v4u w;
              w.x = cvt_pk_bf16(p0[0], p0[1]); w.y = cvt_pk_bf16(p0[2], p0[3]); w.z = cvt_pk_bf16(p0[4], p0[5]); w.w = cvt_pk_bf16(p0[6], p0[7]); pa[0] = __builtin_bit_cast(bf16x8, w);
              w.x = cvt_pk_bf16(p0[8], p0[9]); w.y = cvt_pk_bf16(p0[10], p0[11]); w.z = cvt_pk_bf16(p0[12], p0[13]); w.w = cvt_pk_bf16(p0[14], p0[15]); pa[1] = __builtin_bit_cast(bf16x8, w);
              w.x = cvt_pk_bf16(p1[0], p1[1]); w.y = cvt_pk_bf16(p1[2], p1[3]); w.z = cvt_pk_bf16(p1[4], p1[5]); w.w = cvt_pk_bf16(p1[6], p1[7]); pa[2] = __builtin_bit_cast(bf16x8, w);
              w.x = cvt_pk_bf16(p1[8], p1[9]); w.y = cvt_pk_bf16(p1[10], p1[11]); w.z = cvt_pk_bf16(p1[12], p1[13]); w.w = cvt_pk_bf16(p1[14], p1[15]); pa[3] = __builtin_bit_cast(bf16x8, w); }
#pragma unroll
            for (int d0 = 0; d0 < 2; ++d0)
#pragma unroll
                for (int ks = 0; ks < 4; ++ks) {
                    const s16x4 lo = __builtin_bit_cast(s16x4, __builtin_amdgcn_ds_read_tr16_b64_v4i16((LAS s16x4*)(lds + cur + AT_KB + vfo + (16 * ks) * AT_VS + d0 * 64)));
                    const s16x4 hh = __builtin_bit_cast(s16x4, __builtin_amdgcn_ds_read_tr16_b64_v4i16((LAS s16x4*)(lds + cur + AT_KB + vfo + (16 * ks + 8) * AT_VS + d0 * 64)));
                    const bf16x8 vf = (bf16x8){lo[0], lo[1], lo[2], lo[3], hh[0], hh[1], hh[2], hh[3]};
                    o[d0] = __builtin_amdgcn_mfma_f32_32x32x16_bf16(pa[ks], vf, o[d0], 0, 0, 0);
                }
        }
        if (more) { *(LAS v4u*)(lds + nxt + kl0) = ka; if (two) *(LAS v4u*)(lds + nxt + kl1) = kb2; *(LAS v4u*)(lds + nxt + AT_KB + vl) = va; }
        __syncthreads();
    }
    l_run += __shfl_xor(l_run, 32);
    if (hi == 0) wsf[32 + r32] = l_run;
    LDS_WAIT();
    { bf16* stg = (bf16*)(lds + AT_OST + wid * 4096);
#pragma unroll
      for (int r = 0; r < 16; ++r) { const int orow = crow(r, hi); const float rl = __builtin_amdgcn_rcpf(wsf[32 + orow]);
#pragma unroll
          for (int d0 = 0; d0 < 2; ++d0) { const unsigned u = cvt_pk_bf16(o[d0][r] * rl, 0.f); ((LAS bf16*)(lds + AT_OST + wid * 4096))[orow * 64 + d0 * 32 + r32] = (bf16)(u & 0xffffu); } }
      (void)stg;
      LDS_WAIT();
      bf16* Ow = O + (rowbase + q0 + wid * 32) * 512 + h * 64;
#pragma unroll
      for (int i = 0; i < 4; ++i) { const int row = i * 8 + (lane >> 3), ch = lane & 7; const v4u v = *(const LAS v4u*)(lds + AT_OST + wid * 4096 + (row * 64 + ch * 8) * 2); *(v4u*)(Ow + (size_t)row * 512 + ch * 8) = v; } }
    __syncthreads();
}

template <int CTRL> __device__ __forceinline__ float dpp_add(float v) { return v + __builtin_bit_cast(float, __builtin_amdgcn_update_dpp(0, __builtin_bit_cast(int, v), CTRL, 0xF, 0xF, true)); }
constexpr int RW_TC = 64, RW_STREAM = RW_TC * 64 * 2  , RW_BUF = 6 * RW_STREAM  , RW_YOFF = 2 * RW_BUF  , RW_LDS = RW_YOFF + 2 * RW_STREAM;
constexpr int RW_SPLIT = 2, RW_CW = 4  , RW_ROWS = 64 / RW_SPLIT, RW_RPW = RW_ROWS / RW_CW, RW_LPR = 64 / RW_RPW  , RW_CPL = 64 / RW_LPR  ;
typedef f16 f16xc __attribute__((ext_vector_type(RW_CPL)));
struct RwIn { f16xc r, k, a, b, d; f16 v; };
__device__ __forceinline__ void rw_lds_read(RwIn& x, const LAS unsigned char* buf, int tt, int cg, int row) {
    const LAS unsigned char* p = buf + tt * 128 + cg * (RW_CPL * 2);
    x.r = *(const LAS f16xc*)(p); x.k = *(const LAS f16xc*)(p + RW_STREAM); x.a = *(const LAS f16xc*)(p + 2 * RW_STREAM); x.b = *(const LAS f16xc*)(p + 3 * RW_STREAM); x.d = *(const LAS f16xc*)(p + 4 * RW_STREAM);
    x.v = *(const LAS f16*)(buf + 5 * RW_STREAM + tt * 128 + row * 2);
}
__device__ __forceinline__ void rwkv_scan(Frame& F, int unit) {
    const int bh = unit / RW_SPLIT, part = unit % RW_SPLIT;
    const int tid = F.tid, lane = F.lane, rl = lane / RW_LPR, cg = lane % RW_LPR, b = bh >> 3, h = bh & 7, row = part * RW_ROWS + F.wave * RW_RPW + rl;
    const f16* R = WSP(f16, WS_R); const f16* KH = WSP(f16, WS_KH); const f16* KKN = WSP(f16, WS_KKN); const f16* BV = WSP(f16, WS_BV); const f16* DCY = WSP(f16, WS_DCY); const f16* VF = WSP(f16, WS_VFIN);
    f16* Y = WSP(f16, WS_YRW);
    const size_t base = (size_t)b * SEQ * 512 + h * 64;
    LAS unsigned char* lds = F.lds;
    const int ts = tid >> 3, pc = tid & 7;
    const size_t goff = base + (size_t)ts * 512 + pc * 8;
    const int loff = ts * 128 + pc * 16;
    v4u g[6];
#define RW_GLOAD(t0) do { const size_t o = goff + (size_t)(t0) * 512; const size_t oa = ((t0) + ts + 1 < SEQ) ? o + 512 : o; \
        g[0] = *(const v4u*)(R + o); g[1] = *(const v4u*)(KH + o); g[2] = *(const v4u*)(KKN + oa); g[3] = *(const v4u*)(BV + o); g[4] = *(const v4u*)(DCY + o); g[5] = *(const v4u*)(VF + o); } while (0)
#define RW_LSTORE(bufoff) do { _Pragma("unroll") for (int s_ = 0; s_ < 6; ++s_) *(LAS v4u*)(lds + (bufoff) + s_ * RW_STREAM + loff) = g[s_]; } while (0)
    typedef f16 h2 __attribute__((ext_vector_type(2)));
    h2 S2[RW_CPL / 2];
#pragma unroll
    for (int j = 0; j < RW_CPL / 2; ++j) S2[j] = (h2){(f16)0.f, (f16)0.f};
    float sa = 0.f;
    __syncthreads();
    RW_GLOAD(0); RW_LSTORE(0);
    __syncthreads();
    for (int c = 0; c < SEQ / RW_TC; ++c) {
        const int cur = (c & 1) * RW_BUF, nxt = ((c + 1) & 1) * RW_BUF; const bool more = (c + 1 < SEQ / RW_TC);
        if (more) RW_GLOAD((c + 1) * RW_TC);
        const LAS unsigned char* buf = lds + cur;
        if (F.wave < RW_CW) {
        RwIn x0, x1, x2; rw_lds_read(x0, buf, 0, cg, row); rw_lds_read(x1, buf, 1, cg, row);
        float ykeep = 0.f;
#define RW_STEP(X, TT) do { \
            const h2 sa2 = {(f16)sa, (f16)sa}, v2 = {X.v, X.v}; float yp = 0.f, sp = 0.f; \
            _Pragma("unroll") for (int j = 0; j < RW_CPL / 2; ++j) { const h2 d2 = {X.d[2 * j], X.d[2 * j + 1]}, b2 = {X.b[2 * j], X.b[2 * j + 1]}, k2 = {X.k[2 * j], X.k[2 * j + 1]}, r2 = {X.r[2 * j], X.r[2 * j + 1]}, a2 = {X.a[2 * j], X.a[2 * j + 1]}; \
                h2 sj = S2[j]; sj = __builtin_elementwise_fma(-sj, d2, sj); sj = __builtin_elementwise_fma(sa2, b2, sj); sj = __builtin_elementwise_fma(v2, k2, sj); S2[j] = sj; \
                yp = __builtin_amdgcn_fdot2(sj, r2, yp, false); sp = __builtin_amdgcn_fdot2(sj, a2, sp, false); } \
            yp = dpp_add<0xB1>(yp); sp = dpp_add<0xB1>(sp); \
            yp = dpp_add<0x4E>(yp); sp = dpp_add<0x4E>(sp); \
            if (RW_LPR >= 8) { yp = dpp_add<0x141>(yp); sp = dpp_add<0x141>(sp); } \
            if (RW_LPR >= 16) { yp = dpp_add<0x140>(yp); sp = dpp_add<0x140>(sp); } \
            sa = -sp; ykeep = (cg == ((TT) & 3)) ? yp : ykeep; } while (0)
        for (int tt = 0; tt < RW_TC; tt += 4) {
            rw_lds_read(x2, buf, (tt + 2) & (RW_TC - 1), cg, row); RW_STEP(x0, tt);
            rw_lds_read(x0, buf, (tt + 3) & (RW_TC - 1), cg, row); RW_STEP(x1, tt + 1);
            rw_lds_read(x1, buf, (tt + 4) & (RW_TC - 1), cg, row); RW_STEP(x2, tt + 2);
            rw_lds_read(x2, buf, (tt + 5) & (RW_TC - 1), cg, row); RW_STEP(x0, tt + 3);
            if (cg < 4) *(LAS f16*)(lds + RW_YOFF + (c & 1) * RW_STREAM + (tt + cg) * 128 + row * 2) = (f16)ykeep;
            x0 = x1; x1 = x2;
        }
#undef RW_STEP
        }
        if (more) RW_LSTORE(nxt);
        __syncthreads();
        if (pc >= part * (8 / RW_SPLIT) && pc < (part + 1) * (8 / RW_SPLIT)) { const v4u yv = *(const LAS v4u*)(lds + RW_YOFF + (c & 1) * RW_STREAM + loff); *(v4u*)(Y + base + (size_t)(c * RW_TC + ts) * 512 + pc * 8) = yv; }
    }
    __syncthreads();
#undef RW_GLOAD
#undef RW_LSTORE
}
__device__ __forceinline__ void s5_carry(Frame& F, int l, int idx) {
    const int p = idx & 63, g = (idx >> 6) & 31, b = idx >> 11;
    const float* a32 = WSP(float, WS_S5A32) + (size_t)((l * 32 + g) * 64 + p) * 2; const float ar = a32[0], ai = a32[1];
    const float* xe = WSP(float, WS_XEND) + ((size_t)g * S5CH + b * S5NC) * 128; bf16* u = WSP(bf16, WS_S5U) + ((size_t)g * S5CH + b * S5NC) * S5K + 512;
    float xr = 0.f, xi = 0.f;
    for (int c0 = 0; c0 < S5NC; c0 += 8) { float er[8], ei[8];
#pragma unroll
        for (int c = 0; c < 8; ++c) { er[c] = xe[(size_t)(c0 + c) * 128 + p]; ei[c] = xe[(size_t)(c0 + c) * 128 + 64 + p]; }
#pragma unroll
        for (int c = 0; c < 8; ++c) { bf16* up = u + (size_t)(c0 + c) * S5K; up[p] = (bf16)(cvt_pk_bf16(xr, 0.f) & 0xffffu); up[64 + p] = (bf16)(cvt_pk_bf16(xi, 0.f) & 0xffffu);
            const float nr = ar * xr - ai * xi + er[c], ni = ar * xi + ai * xr + ei[c]; xr = nr; xi = ni; } }
}
__device__ __forceinline__ void rwkv_post(Frame& F, int l) {
    const int lane = F.lane; const int gw = F.blk * NWAVES + F.wave, NGW = F.G * NWAVES;
    float lg[8], lb[8], rk[8]; ld8f(INP(float, 16) + l * 512 + 8 * lane, lg); ld8f(INP(float, 17) + l * 512 + 8 * lane, lb); ld8f(INP(float, 15) + l * 512 + 8 * lane, rk);
    for (int m = gw; m < M; m += NGW) { const size_t off = (size_t)m * 512 + 8 * lane; float y[8], r[8], k[8], v[8], g[8], o[8];
        f16x8_to_f32(*(const f16x8*)(WSP(f16, WS_YRW) + off), y); f16x8_to_f32(*(const f16x8*)(WSP(f16, WS_R) + off), r); f16x8_to_f32(*(const f16x8*)(WSP(f16, WS_KH) + off), k);
        f16x8_to_f32(*(const f16x8*)(WSP(f16, WS_VFIN) + off), v); bf16x8_to_f32(*(const v4u*)(WSP(bf16, WS_GL) + off), g);
        float s = 0.f, bs = 0.f;
#pragma unroll
        for (int j = 0; j < 8; ++j) { s += y[j]; bs += r[j] * k[j] * rk[j]; }
        s += __shfl_xor(s, 1); s += __shfl_xor(s, 2); s += __shfl_xor(s, 4); bs += __shfl_xor(bs, 1); bs += __shfl_xor(bs, 2); bs += __shfl_xor(bs, 4);
        const float mean = s * (1.0f / 64.0f); float q = 0.f;
#pragma unroll
        for (int j = 0; j < 8; ++j) { y[j] -= mean; q += y[j] * y[j]; }
        q += __shfl_xor(q, 1); q += __shfl_xor(q, 2); q += __shfl_xor(q, 4);
        const float rstd = 1.0f / sqrtf(q * (1.0f / 64.0f) + 64e-5f);
#pragma unroll
        for (int j = 0; j < 8; ++j) o[j] = (y[j] * rstd * lg[j] + lb[j] + bs * v[j]) * g[j];
        *(v4u*)(WSP(bf16, WS_YRW) + off) = f32_to_bf16x8(o); }
}
constexpr int PH_PER_LAYER = 12, N_PHASES = 1 + NLAYER * PH_PER_LAYER;
#ifndef MK_PER_PHASE
#define MK_PER_PHASE 0
#endif
#ifndef ABL_BRANCH
#define ABL_BRANCH -1
#endif
constexpr int NR_RWKV = 64 * RW_SPLIT;

__global__ void __launch_bounds__(NWAVES * 64, 2) mk_fwd(Args A) {
    extern __shared__ __attribute__((aligned(16))) unsigned char lds_raw[];
    volatile LAS unsigned* MISC = (volatile LAS unsigned*)((LAS unsigned char*)lds_raw + MISC_OFF);
    for (int u = threadIdx.x; u < (LDS_BYTES - LDSCTL_OFF) / 4; u += NWAVES * 64) ((LAS unsigned*)((LAS unsigned char*)lds_raw + LDSCTL_OFF))[u] = 0u;
    __syncthreads();
    XcdBarrier bar; bar.bar = (unsigned*)(A.ws + WS_CTL) + CW_BAR; bar.x = 0; bar.st = nullptr;
    if (!MK_PER_PHASE) bar = xcd_barrier_post((unsigned*)(A.ws + WS_CTL) + CW_BAR, MISC + 8);
    const int lo = A.ph_lo, hi = A.ph_hi;
#ifndef PHMASK
#define PHMASK 0xFFFF
#endif
#define PHON(k) ((PHMASK >> (k)) & 1)
#define IN(k) (lo <= (k) && (k) < hi)
#define SEAM(k) do { if (IN(k) && IN((k) + 1)) xcd_barrier(bar); } while (0)
    using pg8::gemm_phase; using pg8::StaticOrder; using pg8::LocDense;

    if (PHON(0) && IN(0)) {
        MKFRAME(F);
        p0_prologue(F);
        for (int it = F.G - 1 - F.blk; it < NLAYER * 32; it += F.G) s5_gen(F, it >> 5, it & 31);
        const int gw = F.blk * NWAVES + F.wave, NGW = F.G * NWAVES;
        for (int m = gw; m < M; m += NGW) {
#pragma unroll
            for (int j = 0; j < 4; ++j) { const f32x4 v = *(const f32x4*)(INP(float, 0) + (size_t)m * DM + 4 * F.lane + 256 * j); v2u w; w.x = cvt_pk_bf16(v[0], v[1]); w.y = cvt_pk_bf16(v[2], v[3]); *(v2u*)(WSP(bf16, WS_XB) + (size_t)m * DM + 4 * F.lane + 256 * j) = w; } }
    }
    SEAM(0);

    for (int l = 0; l < NLAYER; ++l) {
        const int pb = 1 + l * PH_PER_LAYER;
        const bool moe = (l & 1) != 0; const int li = l >> 1;
        if (PHON(1) && IN(pb + 0)) {
            asm volatile("; ==PH1");
            MKFRAME(F);
            LocDense L{WSP(bf16, WS_XB), WSP(bf16, WS_WIN) + (size_t)l * 3072 * DM, DM, DM, DM, 0, 0};
            StaticOrder S; S.init(M, 3072, 1, F.G, F.blk);
            Epi8<FProj> E{{WSP(bf16, WS_MLARAW), WSP(bf16, WS_RWRAW), WSP(bf16, WS_S5U)}};
            gemm_phase(F.lds + RING_OFF, L, S, E);
        }
        SEAM(pb + 0);
        if (PHON(2) && IN(pb + 1)) { MKFRAME(F); ph2_prep(F, l); }
        SEAM(pb + 1);
        if (PHON(3) && IN(pb + 2)) {
            asm volatile("; ==PH3");
            MKFRAME(F);
#ifndef P3SEL
#define P3SEL 31
#endif
            if (P3SEL & 1) { LocDense L{WSP(bf16, WS_CQN), WSP(bf16, WS_WUQ) + (size_t)l * 768 * 384, 384, 384, 384, 0, 0}; StaticOrder S; S.init(M, 768, 1, F.G, F.blk);
              Epi8<FQup> E{{WSP(bf16, WS_Q), WSP(float, WS_ROPE), 0.10206207261596575f * 1.4426950408889634f}}; gemm_phase(F.lds + RING_OFF, L, S, E); }
            if (P3SEL & 2) { LocDense L{WSP(bf16, WS_CKVN), WSP(bf16, WS_WUKV) + (size_t)l * 1024 * 256, 256, 256, 256, 0, 0}; StaticOrder S; S.init(M, 1024, 1, F.G, F.blk);
              Epi8<FKVup> E{{WSP(bf16, WS_K), WSP(bf16, WS_V)}}; gemm_phase(F.lds + RING_OFF, L, S, E); }
            if (P3SEL & 4) { LocDense L{WSP(bf16, WS_LORAIN), WSP(bf16, WS_WLORA) + (size_t)l * 1536 * 256, 256, 256, 256, 0, 0}; StaticOrder S; S.init(M, 1536, 1, F.G, F.blk);
              Epi8<FLora> E{{INP(float, 8) + l * 512, INP(float, 10) + l * 512, INP(float, 14) + l * 512, WSP(f16, WS_DCY), WSP(f16, WS_KH), WSP(f16, WS_KKN), WSP(f16, WS_BV), WSP(bf16, WS_GL), {}, {}}}; gemm_phase(F.lds + RING_OFF, L, S, E); }
            if ((P3SEL & 8) && l > 0) { LocDense L{WSP(bf16, WS_VRAW), WSP(bf16, WS_WVRES) + (size_t)(l - 1) * 512 * 512, 512, 512, 512, 0, 0}; StaticOrder S; S.init(M, 512, 1, F.G, F.blk);
              Epi8<FVres> E{{INP(float, 20) + (l - 1) * 512, WSP(bf16, WS_VRAW), WSP(bf16, WS_VFIRST), WSP(f16, WS_VFIN), {}}}; gemm_phase(F.lds + RING_OFF, L, S, E); }
            if (P3SEL & 16) { LocDense L{WSP(bf16, WS_S5U), WSP(bf16, WS_S5END) + (size_t)l * 32 * 256 * 512, S5K, 512, 512, (size_t)S5CH * S5K, (size_t)256 * 512}; StaticOrder S; S.init(S5CH, 256, 32, F.G, (F.blk + F.G / 2) % F.G);
              Epi8<FS5End> E{{WSP(float, WS_XEND)}}; gemm_phase(F.lds + RING_OFF, L, S, E); }
        }
        SEAM(pb + 2);
        if (PHON(4) && IN(pb + 3)) {
            asm volatile("; ==PH4");
            MKFRAME(F);
            if (F.blk < NR_RWKV && F.G > NR_RWKV) { if (A.li != -2) for (int un = F.blk; un < NBATCH * NH * RW_SPLIT; un += NR_RWKV) rwkv_scan(F, un); }
            else { const int ab = F.blk - NR_RWKV, na = F.G - NR_RWKV; if (A.li != -1) for (int idx = ab * 512 + F.tid; idx < NBATCH * 32 * 64; idx += na * 512) s5_carry(F, l, idx); }
            if (A.li != -1) {
                LAS int* slot = (LAS int*)(F.lds + AT_LDS);
                for (;;) {
                    __syncthreads();
                    if (F.tid == 0) *slot = (int)__hip_atomic_fetch_add((unsigned*)(F.ctl + CW_ATTN + 64 * l), 1u, RLX_AGENT);
                    __syncthreads();
                    const int n = *slot; if (n >= NBATCH * NH * 16) break;
                    const int qb = 15 - (n >> 6), bh = n & 63;
                    attn_unit(F.tid, bh >> 3, bh & 7, qb, WSP(bf16, WS_Q), WSP(bf16, WS_K), WSP(bf16, WS_V), WSP(bf16, WS_YMLA), F.lds);
                }
            }
        }
        SEAM(pb + 3);
        if (PHON(5) && IN(pb + 4)) {
            asm volatile("; ==PH5");
            MKFRAME(F);
            { LocDense L{WSP(bf16, WS_S5U), WSP(bf16, WS_S5MAIN) + (size_t)l * 32 * 512 * S5K, S5K, S5K, S5K, (size_t)S5CH * S5K, (size_t)512 * S5K}; StaticOrder S; S.init(S5CH, 512, 32, F.G, F.blk);
              Epi8<FS5Main> E{{WSP(bf16, WS_S5U), INP(float, 28) + l * 512, WSP(bf16, WS_YS5G), {}}}; gemm_phase(F.lds + RING_OFF, L, S, E); }
            rwkv_post(F, l);
        }
        SEAM(pb + 4);
        if (PHON(6) && IN(pb + 5)) {
            asm volatile("; ==PH6");
            MKFRAME(F);
            { LocDense L{WSP(bf16, WS_YS5G), WSP(bf16, WS_WGLU) + (size_t)l * 512 * 512, 512, 512, 512, 0, 0}; StaticOrder S; S.init(M, 512, 1, F.G, F.blk);
              Epi8<FGlu> E{{WSP(bf16, WS_YS5G), INP(float, 30) + l * 512, WSP(bf16, WS_YS5), {}}}; gemm_phase(F.lds + RING_OFF, L, S, E); }
            { LocDense L{WSP(bf16, WS_XB), WSP(bf16, WS_WG) + ((size_t)l * 3 + 0) * 1024 * DM, DM, DM, DM, 0, 0}; StaticOrder S; S.init(M, 2048, 1, F.G, F.blk);
              Epi8<FGate2> E{{WSP(bf16, WS_GBUF), WSP(bf16, WS_GBUF2)}}; gemm_phase(F.lds + RING_OFF, L, S, E); }
            { LocDense L{WSP(bf16, WS_YMLA), WSP(bf16, WS_WBR) + ((size_t)l * 3 + 0) * 1024 * 512, 512, 512, 512, 0, 0}; StaticOrder S; S.init(M, 1024, 1, F.G, F.blk);
              Epi8<FMerge> E{{WSP(bf16, WS_GBUF), WSP(bf16, WS_MIXED2), WSP(bf16, WS_MIXED), 1, (ABL_BRANCH == 0) ? 0.f : 1.f}}; gemm_phase(F.lds + RING_OFF, L, S, E); }
            { LocDense L{WSP(bf16, WS_YRW), WSP(bf16, WS_WBR) + ((size_t)l * 3 + 1) * 1024 * 512, 512, 512, 512, 0, 0}; StaticOrder S; S.init(M, 1024, 1, F.G, F.blk);
              Epi8<FMerge> E{{WSP(bf16, WS_GBUF2), WSP(bf16, WS_MIXED), WSP(bf16, WS_MIXED2), 0, (ABL_BRANCH == 1) ? 0.f : 1.f}}; gemm_phase(F.lds + RING_OFF, L, S, E); }
        }
        SEAM(pb + 5);
        if (PHON(7) && IN(pb + 6)) {
            asm volatile("; ==PH7");
            MKFRAME(F);
            { LocDense L{WSP(bf16, WS_XB), WSP(bf16, WS_WG) + ((size_t)l * 3 + 2) * 1024 * DM, DM, DM, DM, 0, 0}; StaticOrder S; S.init(M, 1024, 1, F.G, F.blk);
              Epi8<FGate> E{{WSP(bf16, WS_GBUF)}}; gemm_phase(F.lds + RING_OFF, L, S, E); }
            { LocDense L{WSP(bf16, WS_YS5), WSP(bf16, WS_WBR) + ((size_t)l * 3 + 2) * 1024 * 512, 512, 512, 512, 0, 0}; StaticOrder S; S.init(M, 1024, 1, F.G, F.blk);
              Epi8<FMerge> E{{WSP(bf16, WS_GBUF), WSP(bf16, WS_MIXED2), WSP(bf16, WS_MIXED), 0, (ABL_BRANCH == 2) ? 0.f : 1.f}}; gemm_phase(F.lds + RING_OFF, L, S, E); }
        }
        SEAM(pb + 6);
        if (PHON(8) && IN(pb + 7)) {
            asm volatile("; ==PH8");
            MKFRAME(F);
            LocDense L{WSP(bf16, WS_MIXED), WSP(bf16, WS_WOUT) + (size_t)l * DM * DM, DM, DM, DM, 0, 0}; StaticOrder S; S.init(M, DM, 1, F.G, F.blk);
            Epi8<FResid> E{{WSP(bf16, WS_XB), (f16*)F.out}}; gemm_phase(F.lds + RING_OFF, L, S, E);
        }
        SEAM(pb + 7);
        if (PHON(9) && IN(pb + 8)) {
            asm volatile("; ==PH9");
            MKFRAME(F);
            if (moe) { ln1_moe_phase(F, INP(float, 33) + l * DM, INP(float, 34) + l * DM, li); moe_convert(F, li); }
            else ln_phase(F, INP(float, 33) + l * DM, INP(float, 34) + l * DM);
        }
        SEAM(pb + 8);
        if (PHON(10) && IN(pb + 9)) {
            asm volatile("; ==PH10");
            MKFRAME(F);
            if (moe) {
                const unsigned* cnt = (const unsigned*)(F.ctl + CW_MOECNT + 64 * li);
                LocMoe1 L{WSP(bf16, WS_XB), WSP(bf16, WS_WMGU), DM, DM, DM, WSP(int, WS_SLOTTOK), cnt}; MoeOrder S; S.init(cnt, 2 * EXD / 256, F.G, F.blk);
                EpiGU<FSwiglu> E{{WSP(bf16, WS_HM), EXD}}; gemm_phase(F.lds + RING_OFF, L, S, E);
            } else {
                LocDense L{WSP(bf16, WS_XB), WSP(bf16, WS_WFGU) + (size_t)li * 2 * FFN * DM, DM, DM, DM, 0, 0}; StaticOrder S; S.init(M, 2 * FFN, 1, F.G, F.blk);
                EpiGU<FSwiglu> E{{WSP(bf16, WS_HB), FFN}}; gemm_phase(F.lds + RING_OFF, L, S, E);
            }
        }
        SEAM(pb + 9);
        if (PHON(11) && IN(pb + 10)) {
            asm volatile("; ==PH11");
            MKFRAME(F);
            if (moe) {
                const unsigned* cnt = (const unsigned*)(F.ctl + CW_MOECNT + 64 * li);
                LocDense L{WSP(bf16, WS_HM), WSP(bf16, WS_WMD), EXD, EXD, EXD, 0, (size_t)DM * EXD}; MoeOrder S; S.init(cnt, DM / 256, F.G, F.blk);
                Epi8<FMoeDown> E{{WSP(bf16, WS_YPAIR), WSP(float, WS_SLOTW), cnt}}; gemm_phase(F.lds + RING_OFF, L, S, E);
            } else {
                LocDense L{WSP(bf16, WS_HB), WSP(bf16, WS_WFD) + (size_t)li * DM * FFN, FFN, FFN, FFN, 0, 0}; StaticOrder S; S.init(M, DM, 1, F.G, F.blk);
                Epi8<FResid> E{{WSP(bf16, WS_XB), (f16*)F.out}}; gemm_phase(F.lds + RING_OFF, L, S, E);
            }
        }
        SEAM(pb + 10);
        if (PHON(12) && IN(pb + 11)) {
            asm volatile("; ==PH12");
            MKFRAME(F);
            if (moe) ln2_moe_phase(F, INP(float, 35) + l * DM, INP(float, 36) + l * DM, li, l == NLAYER - 1);
            else ln_phase(F, INP(float, 35) + l * DM, INP(float, 36) + l * DM);
        }
        SEAM(pb + 11);
    }
#undef IN
#undef SEAM
}

#ifdef PROBE_P
__global__ void probe_sum(const unsigned* x, unsigned long long* sums, int n) {
    __shared__ unsigned long long sh[256];
    unsigned long long s = 0;
    for (int i = blockIdx.x * blockDim.x + threadIdx.x; i < n; i += gridDim.x * blockDim.x) s += (unsigned long long)x[i] * (unsigned long long)(2 * (i & 1023) + 1);
    sh[threadIdx.x] = s; __syncthreads();
    if (threadIdx.x == 0) { unsigned long long t = 0; for (int i = 0; i < 256; ++i) t += sh[i]; sums[blockIdx.x] = t; }
}
__global__ void probe_cmp(const unsigned long long* sums, unsigned* out) {
    if (sums[threadIdx.x] != sums[1024 + threadIdx.x]) out[threadIdx.x * 4099] = 0x7fc00000u;
}
#endif
extern "C" void kernel_launch(void* const* d_in, const int* in_sizes, int n_in, void* d_out, int out_size, void* d_ws, size_t ws_size, hipStream_t stream) {
    static int grid = 0;
    if (grid == 0) {
        if (n_in != 44 || out_size != M * DM || ws_size < WS_END) { fprintf(stderr, "kernel_launch: unexpected problem (n_in %d, out %d, ws %zu < %zu)\n", n_in, out_size, ws_size, (size_t)WS_END); grid = -1; return; }
        int dev = 0, cus = 0, per_cu = 0;
        if (hipGetDevice(&dev) != hipSuccess || hipDeviceGetAttribute(&cus, hipDeviceAttributeMultiprocessorCount, dev) != hipSuccess) { grid = -1; return; }
        if (hipFuncSetAttribute((const void*)mk_fwd, hipFuncAttributeMaxDynamicSharedMemorySize, LDS_BYTES) != hipSuccess) { fprintf(stderr, "kernel_launch: hipFuncSetAttribute failed\n"); grid = -1; return; }
        if (hipOccupancyMaxActiveBlocksPerMultiprocessor(&per_cu, (const void*)mk_fwd, NWAVES * 64, LDS_BYTES) != hipSuccess || per_cu < 1) { fprintf(stderr, "kernel_launch: occupancy query says %d blocks per CU\n", per_cu); }
        (void)hipGetLastError();
        grid = cus;
        if (grid != 256) fprintf(stderr, "kernel_launch: %d CUs (built for 256)\n", grid);
    }
    if (grid < 0) return;
    (void)in_sizes;
    if (hipMemsetAsync((char*)d_ws + WS_CTL, 0, CTL_ZERO_BYTES, stream) != hipSuccess) return;
    Args a{};
    for (int i = 0; i < 44; ++i) a.in[i] = d_in[i];
    a.out = (float*)d_out; a.ws = (unsigned char*)d_ws; a.pad = 0;
#if MK_PER_PHASE
#ifdef PROBE_P
    for (int p = 0; p <= PROBE_P; ++p) { a.ph_lo = p; a.ph_hi = p + 1; a.li = p; hipLaunchKernelGGL(mk_fwd, dim3(grid), dim3(NWAVES * 64), LDS_BYTES, stream, a); }
    hipLaunchKernelGGL(probe_sum, dim3(1024), dim3(256), 0, stream, (const unsigned*)((char*)d_ws + PROBE_OFF), (unsigned long long*)((char*)d_ws + WS_END), (int)(PROBE_BYTES / 4));
    hipMemsetAsync((char*)d_ws + WS_CTL, 0, CTL_ZERO_BYTES, stream);
    for (int p = 0; p <= PROBE_P; ++p) { a.ph_lo = p; a.ph_hi = p + 1; a.li = p; hipLaunchKernelGGL(mk_fwd, dim3(grid), dim3(NWAVES * 64), LDS_BYTES, stream, a); }
    hipLaunchKernelGGL(probe_sum, dim3(1024), dim3(256), 0, stream, (const unsigned*)((char*)d_ws + PROBE_OFF), (unsigned long long*)((char*)d_ws + WS_END) + 1024, (int)(PROBE_BYTES / 4));
    for (int p = PROBE_P + 1; p < N_PHASES; ++p) { a.ph_lo = p; a.ph_hi = p + 1; a.li = p; hipLaunchKernelGGL(mk_fwd, dim3(grid), dim3(NWAVES * 64), LDS_BYTES, stream, a); }
    hipLaunchKernelGGL(probe_cmp, dim3(1), dim3(1024), 0, stream, (const unsigned long long*)((char*)d_ws + WS_END), (unsigned*)d_out);
#else
    for (int p = 0; p < N_PHASES; ++p) { a.ph_lo = p; a.ph_hi = p + 1; a.li = p; hipLaunchKernelGGL(mk_fwd, dim3(grid), dim3(NWAVES * 64), LDS_BYTES, stream, a);
#ifdef DUP_MASK
        if ((p >= 1 && ((DUP_MASK >> ((p - 1) % PH_PER_LAYER)) & 1)) || (p == 0 && ((DUP_MASK >> 12) & 1))) { hipMemsetAsync((char*)d_ws + WS_CTL + (size_t)CW_ATTN * 4, 0, 4096, stream);
#ifdef DUP_LI
            a.li = DUP_LI;
#endif
            hipLaunchKernelGGL(mk_fwd, dim3(grid), dim3(NWAVES * 64), LDS_BYTES, stream, a); }
#endif
    }
#endif
#else
    a.ph_lo = 0; a.ph_hi = N_PHASES; a.li = 0;
    hipLaunchKernelGGL(mk_fwd, dim3(grid), dim3(NWAVES * 64), LDS_BYTES, stream, a);
#endif
}
```

```cpp
#include <hip/hip_runtime.h>
#include <cstdio>
#include <cstdint>
#include <cmath>
namespace pg8 {
#define PG8_LAS __attribute__((address_space(3)))
typedef unsigned short bf16_t;
typedef short bf16x8 __attribute__((ext_vector_type(8)));
typedef float f32x4 __attribute__((ext_vector_type(4)));
typedef float f32x2 __attribute__((ext_vector_type(2)));
typedef unsigned u32x4 __attribute__((ext_vector_type(4)));
typedef unsigned u32x2 __attribute__((ext_vector_type(2)));
constexpr int BM = 256, BK = 64, HALF = 128, HTB = HALF * BK * 2  , STAGE_BYTES = 8 * HTB, NXCD = 8, WGM = 8;

__host__ __device__ __forceinline__ int lds_byte(int r, int c) { const int st = (r >> 4) * 2 + (c >> 5), rr = r & 15, cc = c & 31, ob = rr * 64 + cc * 2; return st * 1024 + (ob ^ (((ob >> 9) & 1) << 5)); }
__host__ __device__ __forceinline__ void stage_rc(int b, int& R, int& C) { const int st = b / 1024, sb = b % 1024, swz = sb ^ (((sb >> 9) & 1) << 5); R = (st >> 1) * 16 + swz / 64; C = (st & 1) * 32 + (swz % 64) / 2; }
__host__ __device__ __forceinline__ int perm32(int rho) { const int n = rho >> 4, i = rho & 15; return 8 * (i >> 2) + 4 * n + (i & 3); }

struct Unit { int pm, pn, z, aux; };

struct LocDense {
    static constexpr bool GATHER = false;
    const bf16_t* A; const bf16_t* Bt; int lda, ldb, K; size_t zA, zB;
    __device__ __forceinline__ const char* a_ptr(const Unit& u) const { return (const char*)(A + (size_t)u.z * zA + (size_t)u.pm * BM * lda); }
    __device__ __forceinline__ const char* b_ptr(const Unit& u) const { return (const char*)(Bt + (size_t)u.z * zB + (size_t)u.pn * BM * ldb); }
    __device__ __forceinline__ void a_off(const Unit&, int tid, unsigned (&v)[2][2]) const {
#pragma unroll
        for (int i = 0; i < 2; ++i) { int R, C; stage_rc(tid * 16 + i * 8192, R, C); v[0][i] = (unsigned)(R * lda + C) * 2u; v[1][i] = 0u; }
    }
};

struct StaticOrder {
    int nM, nN, nwg, nZ, G, c;
    __device__ void init(int M, int N, int Z, int G_, int c_) { nM = M / BM; nN = N / BM; nwg = nM * nN; nZ = Z; G = G_; c = c_; }
    __device__ bool next(int i, Unit& u) const {
        const long L = (long)i * G + c; if (L >= (long)nwg * nZ) return false;
        u.z = (int)(L / nwg); u.aux = 0;
        int wgid = (int)(L % nwg); { const int q = nwg / NXCD, r = nwg % NXCD, xcd = wgid % NXCD, off = wgid / NXCD; wgid = (xcd < r ? xcd * (q + 1) : r * (q + 1) + (xcd - r) * q) + off; }
        const int nig = WGM * nN, gid = wgid / nig, fm = gid * WGM, gsz = (nM - fm) < WGM ? (nM - fm) : WGM;
        u.pm = fm + ((wgid % nig) % gsz); u.pn = (wgid % nig) / gsz; return true;
    }
};

typedef float f32x2_cv __attribute__((ext_vector_type(2))); typedef __bf16 bf16x2_cv __attribute__((ext_vector_type(2)));
__device__ __forceinline__ unsigned cvt_pk_bf16(float lo, float hi) { const f32x2_cv v = {lo, hi}; const bf16x2_cv b = __builtin_convertvector(v, bf16x2_cv); return __builtin_bit_cast(unsigned, b); }
__device__ __forceinline__ u32x4 pack8(const f32x4 v0, const f32x4 v1) { u32x4 w; w.x = cvt_pk_bf16(v0[0], v0[1]); w.y = cvt_pk_bf16(v0[2], v0[3]); w.z = cvt_pk_bf16(v1[0], v1[1]); w.w = cvt_pk_bf16(v1[2], v1[3]); return w; }
__device__ __forceinline__ float bf_lo(unsigned w) { return __uint_as_float(w << 16); }
__device__ __forceinline__ float bf_hi(unsigned w) { return __uint_as_float(w & 0xffff0000u); }
__device__ __forceinline__ void unpack8(const u32x4 w, f32x4& v0, f32x4& v1) { v0 = (f32x4){bf_lo(w.x), bf_hi(w.x), bf_lo(w.y), bf_hi(w.y)}; v1 = (f32x4){bf_lo(w.z), bf_hi(w.z), bf_lo(w.w), bf_hi(w.w)}; }

struct NoPre {};
template <class F> struct Epi8 {
    static constexpr bool PERM = true;
    F f;
    __device__ __forceinline__ void operator()(const f32x4 (&acc)[2][2][4][2], const Unit& u, int wr, int wc, int fr, int fq) const {
        const int row0 = u.pm * BM + wr * 64 + fr, col0 = u.pn * BM + wc * 32 + 8 * fq;
        F g = f;
#pragma unroll
        for (int bj = 0; bj < 2; ++bj) { const int col = col0 + bj * HALF; g.begin_col(u, col);
#pragma unroll
            for (int b0 = 0; b0 < 8; b0 += F::BATCH) { typename F::Pre pr[F::BATCH];
#pragma unroll
                for (int i = 0; i < F::BATCH; ++i) { const int q = b0 + i; pr[i] = g.pre(u, row0 + (q >> 2) * HALF + (q & 3) * 16, col); }
#pragma unroll
                for (int i = 0; i < F::BATCH; ++i) { const int q = b0 + i; g.tile8(u, row0 + (q >> 2) * HALF + (q & 3) * 16, col, acc[q >> 2][bj][q & 3][0], acc[q >> 2][bj][q & 3][1], pr[i]); }
                asm volatile("" ::: "memory"); } }
    }
};
template <class F> struct EpiGU {
    static constexpr bool PERM = true;
    F f;
    __device__ __forceinline__ void operator()(const f32x4 (&acc)[2][2][4][2], const Unit& u, int wr, int wc, int fr, int fq) const {
        const int row0 = u.pm * BM + wr * 64 + fr, colh = u.pn * HALF + wc * 32 + 8 * fq;
#pragma unroll
        for (int ai = 0; ai < 2; ++ai)
#pragma unroll
            for (int m = 0; m < 4; ++m) { f.pair8(u, row0 + ai * HALF + m * 16, colh, acc[ai][0][m][0], acc[ai][0][m][1], acc[ai][1][m][0], acc[ai][1][m][1]); asm volatile("" ::: "memory"); }
    }
};

template <class Epi, class Sched, class Loc>
__device__ __forceinline__ void gemm_phase(PG8_LAS unsigned char* lds, const Loc& L, const Sched& S, const Epi& E) {
    int tid_ = threadIdx.x; asm volatile("" : "+v"(tid_));
    const int tid = tid_, wid = __builtin_amdgcn_readfirstlane(tid >> 6), lane = tid & 63, wr = wid >> 2, wc = wid & 3, fr = lane & 15, fq = lane >> 4;
    const int K = L.K, nt = K / BK;
    unsigned voffB[2];
#pragma unroll
    for (int i = 0; i < 2; ++i) { int R, C; stage_rc(tid * 16 + i * 8192, R, C); const int Rb = Epi::PERM ? ((R & ~31) + perm32(R & 31)) : R;
        voffB[i] = (unsigned)(Rb * L.ldb + C) * 2u; }
    const size_t kstep = (size_t)(BK * 2);
    const size_t hstepB = (size_t)HALF * L.ldb * 2;
    const unsigned ldsw = (unsigned)wid * 1024u;
    const int aoff = lds_byte(wr * 64 + fr, fq * 8), boff = lds_byte(wc * 32 + fr, fq * 8);
#define PG8_SA(b, h) (((b) * 2 + (h)) * HTB)
#define PG8_SB(b, h) ((4 + (b) * 2 + (h)) * HTB)
#define PG8_STAGE(bufoff, gbase, voff) do { _Pragma("unroll") for (int _i = 0; _i < 2; ++_i) \
        __builtin_amdgcn_global_load_lds((const unsigned*)((const char*)(gbase) + (voff)[_i]), (PG8_LAS unsigned*)(lds + (bufoff) + ldsw + _i * 8192), 16, 0, 0); } while (0)
#define PG8_LDA(dst, b, h) do { _Pragma("unroll") for (int m = 0; m < 4; ++m) _Pragma("unroll") for (int k = 0; k < 2; ++k) dst[m][k] = *(const PG8_LAS bf16x8*)(lds + PG8_SA(b, h) + aoff + m * 2048 + k * 1024); } while (0)
#define PG8_LDB(dst, b, h) do { _Pragma("unroll") for (int n = 0; n < 2; ++n) _Pragma("unroll") for (int k = 0; k < 2; ++k) dst[n][k] = *(const PG8_LAS bf16x8*)(lds + PG8_SB(b, h) + boff + n * 2048 + k * 1024); } while (0)
#define PG8_MMA(ai, bj, At, Bt) do { __builtin_amdgcn_s_setprio(1); _Pragma("unroll") for (int m = 0; m < 4; ++m) _Pragma("unroll") for (int n = 0; n < 2; ++n) _Pragma("unroll") for (int k = 0; k < 2; ++k) \
        acc[ai][bj][m][n] = __builtin_amdgcn_mfma_f32_16x16x32_bf16(Bt[n][k], At[m][k], acc[ai][bj][m][n], 0, 0, 0); __builtin_amdgcn_s_setprio(0); } while (0)
#define PG8_WAIT_V(n) asm volatile("s_waitcnt vmcnt(" #n ")" ::: "memory")
#define PG8_WAIT_L(n) asm volatile("s_waitcnt lgkmcnt(" #n ")" ::: "memory")
#define PG8_BAR __builtin_amdgcn_s_barrier()
#define PG8_SCHED __builtin_amdgcn_sched_barrier(0)
    Unit cur, nxt; int ui = 0;
    if (!S.next(0, cur)) return;
    f32x4 acc[2][2][4][2];
#pragma unroll
    for (int a = 0; a < 2; ++a)
#pragma unroll
        for (int b = 0; b < 2; ++b)
#pragma unroll
            for (int m = 0; m < 4; ++m)
#pragma unroll
                for (int n = 0; n < 2; ++n) acc[a][b][m][n] = (f32x4){0.f, 0.f, 0.f, 0.f};
    bf16x8 At[4][2], B0[2][2], B1[2][2];
    constexpr int NVH = Loc::GATHER ? 2 : 1;
    unsigned vc[2][2], vn[NVH][2];
    L.a_off(cur, tid, vc);
    if constexpr (Loc::GATHER) {
#pragma unroll
        for (int h = 0; h < 2; ++h)
#pragma unroll
            for (int i = 0; i < 2; ++i) vn[h][i] = vc[h][i];
    }
    const size_t hstepA = Loc::GATHER ? 0 : (size_t)HALF * L.lda * 2;
    const char* cA = L.a_ptr(cur); const char* cB = L.b_ptr(cur);
    PG8_STAGE(PG8_SB(0, 0), cB, voffB); PG8_STAGE(PG8_SB(0, 1), cB + hstepB, voffB); PG8_STAGE(PG8_SA(0, 0), cA, vc[0]); PG8_STAGE(PG8_SA(0, 1), cA + hstepA, vc[NVH - 1]);
    if (wr == 1) PG8_BAR;
    PG8_WAIT_V(2); PG8_BAR;
    PG8_STAGE(PG8_SB(1, 0), cB + kstep, voffB); PG8_STAGE(PG8_SA(1, 0), cA + kstep, vc[0]); PG8_STAGE(PG8_SB(1, 1), cB + hstepB + kstep, voffB);
    PG8_WAIT_V(6); PG8_BAR;
    for (;;) {
        const bool has_next = S.next(ui + 1, nxt);
        const char* nA = has_next ? L.a_ptr(nxt) : cA; const char* nB = has_next ? L.b_ptr(nxt) : cB;
        if constexpr (Loc::GATHER) { if (has_next) L.a_tok(nxt, tid, vn); }
        for (int t = 0; t < nt; t += 2) {
            const bool last = (t == nt - 2);
            const char* a1 = cA + (size_t)(t + 1) * kstep;
            const char* a2 = last ? nA : cA + (size_t)(t + 2) * kstep; const char* b2 = last ? nB : cB + (size_t)(t + 2) * kstep;
            const char* a3 = a2 + kstep; const char* b3 = b2 + kstep;
            PG8_LDB(B0, 0, 0); PG8_LDB(B1, 0, 1); PG8_SCHED; PG8_LDA(At, 0, 0); PG8_STAGE(PG8_SA(1, 1), a1 + hstepA, vc[NVH - 1]);
            if constexpr (Loc::GATHER) { if (last && has_next) L.a_fin(tid, vn, vc); }
            PG8_WAIT_V(8); PG8_WAIT_L(0); PG8_BAR; PG8_MMA(0, 0, At, B0); PG8_MMA(0, 1, At, B1); PG8_BAR; PG8_SCHED;
            PG8_LDA(At, 0, 1); PG8_STAGE(PG8_SB(0, 0), b2, voffB); PG8_STAGE(PG8_SB(0, 1), b2 + hstepB, voffB); PG8_STAGE(PG8_SA(0, 0), a2, vc[0]);
            PG8_WAIT_V(8); PG8_WAIT_L(0); PG8_BAR; PG8_MMA(1, 0, At, B0); PG8_MMA(1, 1, At, B1); PG8_BAR; PG8_SCHED;
            PG8_LDB(B0, 1, 0); PG8_LDB(B1, 1, 1); PG8_SCHED; PG8_LDA(At, 1, 0); PG8_STAGE(PG8_SA(0, 1), a2 + hstepA, vc[NVH - 1]);
            PG8_WAIT_V(8); PG8_WAIT_L(0); PG8_BAR; PG8_MMA(0, 0, At, B0); PG8_MMA(0, 1, At, B1); PG8_BAR; PG8_SCHED;
            PG8_LDA(At, 1, 1); PG8_STAGE(PG8_SB(1, 0), b3, voffB); PG8_STAGE(PG8_SB(1, 1), b3 + hstepB, voffB); PG8_STAGE(PG8_SA(1, 0), a3, vc[0]);
            PG8_WAIT_V(8); PG8_WAIT_L(0); PG8_BAR; PG8_MMA(1, 0, At, B0); PG8_MMA(1, 1, At, B1); PG8_BAR; PG8_SCHED;
        }
        if (wr == 0) PG8_BAR;
        E(acc, cur, wr, wc, fr, fq);
        if (!has_next) break;
#pragma unroll
        for (int a = 0; a < 2; ++a)
#pragma unroll
            for (int b = 0; b < 2; ++b)
#pragma unroll
                for (int m = 0; m < 4; ++m)
#pragma unroll
                    for (int n = 0; n < 2; ++n) acc[a][b][m][n] = (f32x4){0.f, 0.f, 0.f, 0.f};
        cur = nxt; cA = nA; cB = nB; ++ui;
        if (wr == 1) PG8_BAR;
    }
    PG8_WAIT_V(0);
    PG8_BAR;
#undef PG8_SA
#undef PG8_SB
#undef PG8_STAGE
#undef PG8_LDA
#undef PG8_LDB
#undef PG8_MMA
#undef PG8_WAIT_V
#undef PG8_WAIT_L
#undef PG8_BAR
#undef PG8_SCHED
}
}
constexpr int NWAVES = 8;
constexpr int M = 32768, DM = 1024, SEQ = 4096, NBATCH = 8, NLAYER = 4;
constexpr int NH = 8;
constexpr int IN_W = 6048;
constexpr int FFN = 2816, EXD = 3584, NEXP = 8;
constexpr float LN_EPS = 1e-5f, ALPHA = 1.681792830507429f;
constexpr int S5T = 32, S5CH = M / S5T  , S5K = 640, S5NC = SEQ / S5T  ;
constexpr int MOE_CAP = 65536;
constexpr int MOE_ROWS = 65536 + 8 * 256;

constexpr size_t MiB = 1u << 20;
constexpr size_t WS_CTL = 0, CTL_ZERO_BYTES = 1 * MiB;
constexpr size_t WS_WIN = 1 * MiB;
constexpr size_t WS_WG = 25 * MiB;
constexpr size_t WS_WUQ = 49 * MiB;
constexpr size_t WS_WUKV = 52 * MiB;
constexpr size_t WS_WLORA = 54 * MiB;
constexpr size_t WS_WVRES = 57 * MiB;
constexpr size_t WS_WGLU = 59 * MiB;
constexpr size_t WS_WBR = 61 * MiB;
constexpr size_t WS_WOUT = 73 * MiB;
constexpr size_t WS_WFGU = 81 * MiB;
constexpr size_t WS_WFD = 103 * MiB;
constexpr size_t WS_S5MAIN = 898 * MiB;
constexpr size_t WS_S5END = 978 * MiB;
constexpr size_t WS_S5A32 = 1010 * MiB;
constexpr size_t WS_ROPE = 143 * MiB;
constexpr size_t WS_XB = 147 * MiB;
constexpr size_t WS_VFIRST = 211 * MiB;
constexpr size_t RB = 243 * MiB;
constexpr size_t WS_S5U = RB + 0;
constexpr size_t WS_S1 = RB + 40 * MiB;
constexpr size_t WS_MLARAW = WS_S1;
constexpr size_t WS_RWRAW = WS_S1 + 48 * MiB;
constexpr size_t WS_Q = WS_S1;
constexpr size_t WS_V = WS_S1 + 48 * MiB;
constexpr size_t WS_BV = WS_S1 + 80 * MiB;
constexpr size_t WS_DCY = WS_S1 + 112 * MiB;
constexpr size_t WS_YS5G = WS_S1;
constexpr size_t WS_YS5 = WS_S1 + 32 * MiB;
constexpr size_t WS_MIXED = WS_S1 + 64 * MiB;
constexpr size_t WS_R = RB + 200 * MiB;
constexpr size_t WS_KH = RB + 232 * MiB;
constexpr size_t WS_KKN = RB + 264 * MiB;
constexpr size_t WS_GL = RB + 296 * MiB;
constexpr size_t WS_GBUF = RB + 264 * MiB;
constexpr size_t WS_VFIN = RB + 328 * MiB;
constexpr size_t WS_K = RB + 360 * MiB;
constexpr size_t WS_VRAW = RB + 408 * MiB;
constexpr size_t WS_YRW = WS_VRAW;
constexpr size_t WS_S2 = RB + 440 * MiB;
constexpr size_t WS_CQN = WS_S2;
constexpr size_t WS_CKVN = WS_S2 + 24 * MiB;
constexpr size_t WS_LORAIN = WS_S2 + 40 * MiB;
constexpr size_t WS_YMLA = WS_S2;
constexpr size_t WS_XEND = RB + 496 * MiB;
constexpr size_t WS_GBUF2 = RB + 512 * MiB;
constexpr size_t WS_MIXED2 = RB + 576 * MiB;
constexpr size_t WS_HB = RB + 0;
constexpr size_t WS_WMGU = RB + 0;
constexpr size_t WS_YPAIR = RB + 0;
constexpr size_t WS_HM = RB + 132 * MiB;
constexpr size_t WS_WMD = RB + 594 * MiB;
constexpr size_t WS_SLOTTOK = RB + 650 * MiB;
constexpr size_t WS_SLOTW = RB + 652 * MiB;
constexpr size_t WS_PAIRPOS = RB + 654 * MiB;
constexpr size_t WS_END = 1011 * MiB;
constexpr int CW_BAR = 4096;
constexpr int CW_ATTN = 200000;
constexpr int CW_MOECNT = 201024;

constexpr int RING_OFF = 0, RING_BYTES = 131072;
constexpr int LDSCTL_OFF = RING_BYTES, MISC_OFF = LDSCTL_OFF + 320;
constexpr int LDS_BYTES = 147456;

#define GAS __attribute__((address_space(1)))
#define LAS __attribute__((address_space(3)))
typedef unsigned short bf16;
typedef _Float16 f16;
typedef f16 f16x8 __attribute__((ext_vector_type(8)));
typedef unsigned v4u __attribute__((ext_vector_type(4)));
typedef unsigned v2u __attribute__((ext_vector_type(2)));
typedef float f32x4 __attribute__((ext_vector_type(4)));
typedef float f32x16 __attribute__((ext_vector_type(16)));
typedef short bf16x8 __attribute__((ext_vector_type(8)));
typedef short s16x4 __attribute__((ext_vector_type(4)));
typedef GAS unsigned gu32;
#define RLX_AGENT __ATOMIC_RELAXED, __HIP_MEMORY_SCOPE_AGENT
#define LDS_WAIT() asm volatile("s_waitcnt lgkmcnt(0)" ::: "memory")
using pg8::cvt_pk_bf16; using pg8::pack8; using pg8::unpack8; using pg8::bf_lo; using pg8::bf_hi;

__device__ __forceinline__ float sigm(float x) { return __builtin_amdgcn_rcpf(1.0f + __expf(-x)); }
__device__ __forceinline__ float gelu_tanh(float y) { const float u = 0.7978845608028654f * (y + 0.044715f * y * y * y); const float t = 1.0f - 2.0f * __builtin_amdgcn_rcpf(__expf(2.0f * u) + 1.0f); return 0.5f * y * (1.0f + t); }
__device__ __forceinline__ float wave_sum(float v) {
#pragma unroll
    for (int o = 1; o < 64; o <<= 1) v += __shfl_xor(v, o);
    return v;
}
__device__ __forceinline__ v4u ld_nt16(const void* p) { return __builtin_nontemporal_load((const v4u*)p); }
__device__ __forceinline__ void f16x8_to_f32(const f16x8 h, float (&o)[8]) {
#pragma unroll
    for (int j = 0; j < 8; ++j) o[j] = (float)h[j];
}
__device__ __forceinline__ f16x8 f32_to_f16x8(const float (&v)[8]) { f16x8 h;
#pragma unroll
    for (int j = 0; j < 8; ++j) h[j] = (f16)v[j];
    return h; }
__device__ __forceinline__ void bf16x8_to_f32(const v4u w, float (&o)[8]) { o[0] = bf_lo(w.x); o[1] = bf_hi(w.x); o[2] = bf_lo(w.y); o[3] = bf_hi(w.y); o[4] = bf_lo(w.z); o[5] = bf_hi(w.z); o[6] = bf_lo(w.w); o[7] = bf_hi(w.w); }
__device__ __forceinline__ v4u f32_to_bf16x8(const float (&v)[8]) { v4u w; w.x = cvt_pk_bf16(v[0], v[1]); w.y = cvt_pk_bf16(v[2], v[3]); w.z = cvt_pk_bf16(v[4], v[5]); w.w = cvt_pk_bf16(v[6], v[7]); return w; }
__device__ __forceinline__ void ld8f(const float* p, float (&o)[8]) { const f32x4 a = *(const f32x4*)p, b = *(const f32x4*)(p + 4); o[0] = a[0]; o[1] = a[1]; o[2] = a[2]; o[3] = a[3]; o[4] = b[0]; o[5] = b[1]; o[6] = b[2]; o[7] = b[3]; }

#define XB_TMO      128
#define XB_XCNT(j)  (256  + 64 * (j))
#define XB_XSUB(j)  (1280 + 64 * (j))
#define XB_XGEN(j)  (2304 + 64 * (j))
#define XB_TOP      3328
#define XB_TOPGEN   3392
#define XCD_BAR_WORDS 3456
#define XB_SPIN_CAP (1u << 20)

__device__ __forceinline__ unsigned xb_ld(unsigned* p)              { return __hip_atomic_load(p, __ATOMIC_RELAXED, __HIP_MEMORY_SCOPE_AGENT); }
__device__ __forceinline__ unsigned xb_add(unsigned* p, unsigned v) { return __hip_atomic_fetch_add(p, v, __ATOMIC_RELAXED, __HIP_MEMORY_SCOPE_AGENT); }
__device__ __forceinline__ unsigned xb_xcc_id() { return (unsigned)__builtin_amdgcn_s_getreg((3 << 11) | 20) & 0xFu; }
#define XB_SPIN(cond, bar) do { unsigned _sp = 0; while (cond) { __builtin_amdgcn_s_sleep(1); \
    if ((++_sp & 255u) == 0u) { if (xb_ld(&(bar)[XB_TMO])) break; if (_sp > XB_SPIN_CAP) { atomicAdd(&(bar)[XB_TMO], 1u); break; } } } } while (0)

struct XcdBarrier { unsigned* bar; unsigned x; volatile LAS unsigned* st; };

__device__ __forceinline__ XcdBarrier xcd_barrier_post(unsigned* bar, volatile LAS unsigned* st) {
    XcdBarrier b; b.bar = bar; b.x = xb_xcc_id(); b.st = st;
    if (threadIdx.x == 0) (void)xb_add(&bar[XB_XCNT(b.x)], 1u);
    return b;
}
__device__ __forceinline__ void xcd_barrier_complete(unsigned* bar, unsigned x, unsigned& nloc, unsigned& nx) {
    const unsigned G = gridDim.x * gridDim.y * gridDim.z;
    unsigned sum, cnt, mine, sp = 0u;
    for (;;) {
        sum = 0u; cnt = 0u; mine = 0u;
#pragma unroll
        for (unsigned j = 0; j < 16; ++j) { const unsigned c = xb_ld(&bar[XB_XCNT(j)]); sum += c; cnt += (c > 0u) ? 1u : 0u; mine = (j == x) ? c : mine; }
        if (sum == G) break;
        __builtin_amdgcn_s_sleep(1);
        if ((++sp & 255u) == 0u) { if (xb_ld(&bar[XB_TMO])) break; if (sp > XB_SPIN_CAP) { atomicAdd(&bar[XB_TMO], 1u); break; } }
    }
    nloc = mine > 0u ? mine : 1u; nx = cnt > 0u ? cnt : 1u;
}
__device__ __forceinline__ void xcd_barrier(const XcdBarrier& b) {
    asm volatile("s_waitcnt vmcnt(0)" ::: "memory");
    __syncthreads();
    if (threadIdx.x == 0) {
        unsigned* bar = b.bar;
        __builtin_amdgcn_s_waitcnt(0);
        unsigned nloc = b.st[0], nx = b.st[1];
        if (nloc == 0u) { xcd_barrier_complete(bar, b.x, nloc, nx); b.st[0] = nloc; b.st[1] = nx; }
        const unsigned old = xb_add(&bar[XB_XSUB(b.x)], 1u);
        const unsigned gen = old / nloc;
        if (old + 1u == (gen + 1u) * nloc) {
            __builtin_amdgcn_fence(__ATOMIC_RELEASE, "agent");
            asm volatile("s_waitcnt vmcnt(0)" ::: "memory");
            const unsigned og = xb_add(&bar[XB_TOP], 1u);
            const unsigned tg = og / nx;
            if (og + 1u == (tg + 1u) * nx) xb_add(&bar[XB_TOPGEN], 1u);
            else XB_SPIN(xb_ld(&bar[XB_TOPGEN]) == tg, bar);
            __builtin_amdgcn_fence(__ATOMIC_ACQUIRE, "agent");
            xb_add(&bar[XB_XGEN(b.x)], 1u);
            asm volatile("s_waitcnt vmcnt(0)" ::: "memory");
        } else {
            XB_SPIN(xb_ld(&bar[XB_XGEN(b.x)]) == gen, bar);
            __builtin_amdgcn_fence(__ATOMIC_ACQUIRE, "agent");
            asm volatile("s_waitcnt vmcnt(0)" ::: "memory");
        }
    }
    __syncthreads();
}

struct Args { const void* in[44]; float* out; unsigned char* ws; int ph_lo, ph_hi, li, pad; };
typedef const __attribute__((address_space(4))) Args* KArgs;
struct Frame {
    LAS unsigned char* lds;
    unsigned char* ws;
    gu32* ctl;
    int tid, lane, wave;
    int G, blk;
    float* out;
    KArgs ka;
};
#define MKFRAME(F) Frame F; { int t_ = threadIdx.x; asm volatile("" : "+v"(t_)); KArgs k_ = (KArgs)__builtin_amdgcn_kernarg_segment_ptr(); asm volatile("" : "+s"(k_)); \
    F.lds = (LAS unsigned char*)lds_raw; F.ka = k_; F.ws = k_->ws; F.ctl = (gu32*)(k_->ws + WS_CTL); F.out = k_->out; F.tid = t_; F.lane = t_ & 63; F.wave = __builtin_amdgcn_readfirstlane(t_ >> 6); F.G = gridDim.x; F.blk = blockIdx.x; }
#define WSP(T, off) ((T*)(F.ws + (off)))
#define INP(T, i) ((const T*)F.ka->in[i])
using pg8::Unit; using pg8::Epi8; using pg8::EpiGU;
__device__ __forceinline__ void f4x2_to8(const f32x4 v0, const f32x4 v1, float (&o)[8]) { o[0] = v0[0]; o[1] = v0[1]; o[2] = v0[2]; o[3] = v0[3]; o[4] = v1[0]; o[5] = v1[1]; o[6] = v1[2]; o[7] = v1[3]; }

struct FProj {
    static constexpr int BATCH = 8; bf16* mla; bf16* rw; bf16* s5u;
    __device__ __forceinline__ void begin_col(const Unit&, int) {}
    typedef pg8::NoPre Pre; __device__ __forceinline__ Pre pre(const Unit&, int, int) const { return Pre{}; }
    __device__ __forceinline__ void tile8(const Unit&, int row, int col, const f32x4 v0, const f32x4 v1, const Pre&) const {
        const v4u w = pack8(v0, v1);
        if (col < 768) *(v4u*)(mla + (unsigned)row * 768 + col) = w;
        else if (col < 2560) *(v4u*)(rw + (unsigned)row * 1792 + (col - 768)) = w;
        else { const int c = col - 2560, g = c >> 4, i = c & 15; *(v4u*)(s5u + (unsigned)((g * S5CH + (row >> 5)) * S5K) + (row & 31) * 16 + i) = w; }
    }
};
struct FQup {
    static constexpr int BATCH = 4; bf16* Q; const float* cs; float qs;
    struct Pre { f32x4 c, s; };
    __device__ __forceinline__ void begin_col(const Unit&, int) {}
    __device__ __forceinline__ Pre pre(const Unit&, int row, int col) const { Pre p; const int head = col / 96, w = (col - head * 96) >> 3;
        if (w >= 8) { const int i0 = (w - 8) * 4; p.c = *(const f32x4*)(cs + (unsigned)row * 32 + i0); p.s = *(const f32x4*)(cs + (unsigned)row * 32 + 16 + i0); } else { p.c = (f32x4){0.f, 0.f, 0.f, 0.f}; p.s = p.c; } return p; }
    __device__ __forceinline__ void tile8(const Unit&, int row, int col, const f32x4 v0, const f32x4 v1, const Pre& p) const {
        const int head = col / 96, w = (col - head * 96) >> 3;
        bf16* q = Q + (unsigned)row * 768 + head * 96;
        if (w < 8) { *(v4u*)(q + 8 * w) = pack8(v0 * qs, v1 * qs); }
        else { const int i0 = (w - 8) * 4; const f32x4 c = p.c, s = p.s;
            const f32x4 x1 = (f32x4){v0[0], v0[2], v1[0], v1[2]}, x2 = (f32x4){v0[1], v0[3], v1[1], v1[3]};
            const f32x4 o1 = (x1 * c - x2 * s) * qs, o2 = (x1 * s + x2 * c) * qs;
            v2u a, b; a.x = cvt_pk_bf16(o1[0], o1[1]); a.y = cvt_pk_bf16(o1[2], o1[3]); b.x = cvt_pk_bf16(o2[0], o2[1]); b.y = cvt_pk_bf16(o2[2], o2[3]);
            *(v2u*)(q + 64 + i0) = a; *(v2u*)(q + 80 + i0) = b; }
    }
};
struct FKVup {
    static constexpr int BATCH = 8; bf16* K; bf16* V;
    __device__ __forceinline__ void begin_col(const Unit&, int) {}
    typedef pg8::NoPre Pre; __device__ __forceinline__ Pre pre(const Unit&, int, int) const { return Pre{}; }
    __device__ __forceinline__ void tile8(const Unit&, int row, int col, const f32x4 v0, const f32x4 v1, const Pre&) const {
        const int head = col >> 7, d = col & 127; const v4u w = pack8(v0, v1);
        if (d < 64) *(v4u*)(K + (unsigned)row * 768 + head * 96 + d) = w; else *(v4u*)(V + (unsigned)row * 512 + head * 64 + (d - 64)) = w;
    }
};
struct FLora {
    static constexpr int BATCH = 4;
    const float* w0; const float* a0; const float* k_a; f16* dcy; f16* kh; const f16* kkn; f16* bv; bf16* gl; float p[8], ka[8];
    struct Pre { f16x8 k, kn; };
    __device__ __forceinline__ void begin_col(const Unit&, int col) { const int seg = col >> 9, c = col & 511; ld8f(((seg == 0) ? w0 : a0) + c, p); ld8f(k_a + c, ka); }
    __device__ __forceinline__ Pre pre(const Unit&, int row, int col) const { Pre r; const unsigned off = (unsigned)row * 512 + (col & 511);
        if ((col >> 9) == 1) { r.k = *(const f16x8*)(kh + off); r.kn = *(const f16x8*)(kkn + off); } else { r.k = (f16x8)(0); r.kn = (f16x8)(0); } return r; }
    __device__ __forceinline__ void tile8(const Unit&, int row, int col, const f32x4 v0, const f32x4 v1, const Pre& pr) const {
        float a[8]; f4x2_to8(v0, v1, a);
        const int seg = col >> 9, c = col & 511; const unsigned off = (unsigned)row * 512 + c;
        if (seg == 0) { float o[8];
#pragma unroll
            for (int j = 0; j < 8; ++j) { const float e = 0.6065306597126334f * sigm(p[j] + a[j]); o[j] = -expm1f(-e); }
            *(f16x8*)(dcy + off) = f32_to_f16x8(o); }
        else if (seg == 1) { float k[8], kn[8]; f16x8_to_f32(pr.k, k); f16x8_to_f32(pr.kn, kn); float o1[8], o2[8];
#pragma unroll
            for (int j = 0; j < 8; ++j) { const float ic = sigm(p[j] + a[j]); o1[j] = k[j] * (1.0f + (ic - 1.0f) * ka[j]); o2[j] = kn[j] * ic; }
            *(f16x8*)(kh + off) = f32_to_f16x8(o1); *(f16x8*)(bv + off) = f32_to_f16x8(o2); }
        else { *(v4u*)(gl + off) = pack8(v0, v1); }
    }
};
struct FVres {
    static constexpr int BATCH = 4;
    const float* vb; const bf16* vraw; const bf16* vfirst; f16* vfin; float p[8];
    struct Pre { v4u v, vf; };
    __device__ __forceinline__ void begin_col(const Unit&, int col) { ld8f(vb + col, p); }
    __device__ __forceinline__ Pre pre(const Unit&, int row, int col) const { Pre r; const unsigned off = (unsigned)row * 512 + col; r.v = *(const v4u*)(vraw + off); r.vf = *(const v4u*)(vfirst + off); return r; }
    __device__ __forceinline__ void tile8(const Unit&, int row, int col, const f32x4 v0, const f32x4 v1, const Pre& pr) const {
        float a[8], v[8], vf[8], o[8]; f4x2_to8(v0, v1, a); const unsigned off = (unsigned)row * 512 + col;
        bf16x8_to_f32(pr.v, v); bf16x8_to_f32(pr.vf, vf);
#pragma unroll
        for (int j = 0; j < 8; ++j) o[j] = v[j] + (vf[j] - v[j]) * sigm(p[j] + a[j]);
        *(f16x8*)(vfin + off) = f32_to_f16x8(o);
    }
};
struct FS5End {
    static constexpr int BATCH = 8; float* xend;
    __device__ __forceinline__ void begin_col(const Unit&, int) {}
    typedef pg8::NoPre Pre; __device__ __forceinline__ Pre pre(const Unit&, int, int) const { return Pre{}; }
    __device__ __forceinline__ void tile8(const Unit& u, int row, int col, const f32x4 v0, const f32x4 v1, const Pre&) const {
        if (col < 128) { float* p = xend + (unsigned)((u.z * S5CH + row) * 128 + col); *(f32x4*)p = v0; *(f32x4*)(p + 4) = v1; }
    }
};
struct FS5Main {
    static constexpr int BATCH = 8;
    const bf16* s5u; const float* dvec; bf16* ys5g; float d[8];
    struct Pre { v4u uu; };
    __device__ __forceinline__ void begin_col(const Unit& u, int col) { ld8f(dvec + u.z * 16 + (col & 15), d); }
    __device__ __forceinline__ Pre pre(const Unit& u, int row, int col) const { Pre r; r.uu = *(const v4u*)(s5u + (unsigned)((u.z * S5CH + row) * S5K + col)); return r; }
    __device__ __forceinline__ void tile8(const Unit& u, int row, int col, const f32x4 v0, const f32x4 v1, const Pre& pr) const {
        float a[8], uu[8], o[8]; f4x2_to8(v0, v1, a); const int g = u.z, t = col >> 4, o0 = col & 15;
        bf16x8_to_f32(pr.uu, uu);
#pragma unroll
        for (int j = 0; j < 8; ++j) o[j] = gelu_tanh(a[j] + d[j] * uu[j]);
        *(v4u*)(ys5g + ((unsigned)row * 32 + t) * 512 + g * 16 + o0) = f32_to_bf16x8(o);
    }
};
struct FGlu {
    static constexpr int BATCH = 8;
    const bf16* ys5g; const float* bglu; bf16* ys5; float b[8];
    struct Pre { v4u y; };
    __device__ __forceinline__ void begin_col(const Unit&, int col) { ld8f(bglu + col, b); }
    __device__ __forceinline__ Pre pre(const Unit&, int row, int col) const { Pre r; r.y = *(const v4u*)(ys5g + (unsigned)row * 512 + col); return r; }
    __device__ __forceinline__ void tile8(const Unit&, int row, int col, const f32x4 v0, const f32x4 v1, const Pre& pr) const {
        float a[8], y[8], o[8]; f4x2_to8(v0, v1, a); const unsigned off = (unsigned)row * 512 + col; bf16x8_to_f32(pr.y, y);
#pragma unroll
        for (int j = 0; j < 8; ++j) o[j] = y[j] * sigm(a[j] + b[j]);
        *(v4u*)(ys5 + off) = f32_to_bf16x8(o);
    }
};
struct FGate {
    static constexpr int BATCH = 8; bf16* gbuf;
    __device__ __forceinline__ void begin_col(const Unit&, int) {}
    typedef pg8::NoPre Pre; __device__ __forceinline__ Pre pre(const Unit&, int, int) const { return Pre{}; }
    __device__ __forceinline__ void tile8(const Unit&, int row, int col, const f32x4 v0, const f32x4 v1, const Pre&) const {
        float a[8], o[8]; f4x2_to8(v0, v1, a);
#pragma unroll
        for (int j = 0; j < 8; ++j) o[j] = sigm(a[j]);
        *(v4u*)(gbuf + (unsigned)row * 1024 + col) = f32_to_bf16x8(o);
    }
};
struct FGate2 {
    static constexpr int BATCH = 8; bf16* g0; bf16* g1;
    __device__ __forceinline__ void begin_col(const Unit&, int) {}
    typedef pg8::NoPre Pre; __device__ __forceinline__ Pre pre(const Unit&, int, int) const { return Pre{}; }
    __device__ __forceinline__ void tile8(const Unit&, int row, int col, const f32x4 v0, const f32x4 v1, const Pre&) const {
        float a[8], o[8]; f4x2_to8(v0, v1, a);
#pragma unroll
        for (int j = 0; j < 8; ++j) o[j] = sigm(a[j]);
        bf16* g = (col < 1024) ? g0 : g1;
        *(v4u*)(g + (unsigned)row * 1024 + (col & 1023)) = f32_to_bf16x8(o);
    }
};
struct FMerge {
    static constexpr int BATCH = 8; const bf16* gbuf; const bf16* min_; bf16* mout; int first; float scale;
    struct Pre { v4u g, m; };
    __device__ __forceinline__ void begin_col(const Unit&, int) {}
    __device__ __forceinline__ Pre pre(const Unit&, int row, int col) const { Pre r; const unsigned off = (unsigned)row * 1024 + col; r.g = *(const v4u*)(gbuf + off); if (!first) r.m = *(const v4u*)(min_ + off); else r.m = (v4u){0u, 0u, 0u, 0u}; return r; }
    __device__ __forceinline__ void tile8(const Unit&, int row, int col, const f32x4 v0, const f32x4 v1, const Pre& pr) const {
        float a[8], g[8], mprev[8], o[8]; f4x2_to8(v0, v1, a); const unsigned off = (unsigned)row * 1024 + col; bf16x8_to_f32(pr.g, g); bf16x8_to_f32(pr.m, mprev);
#pragma unroll
        for (int j = 0; j < 8; ++j) o[j] = mprev[j] + g[j] * a[j] * scale;
        *(v4u*)(mout + off) = f32_to_bf16x8(o);
    }
};
struct FResid {
    static constexpr int BATCH = 8; const bf16* xin; f16* xout;
    struct Pre { v4u x; };
    __device__ __forceinline__ void begin_col(const Unit&, int) {}
    __device__ __forceinline__ Pre pre(const Unit&, int row, int col) const { Pre r; r.x = *(const v4u*)(xin + (unsigned)row * 1024 + col); return r; }
    __device__ __forceinline__ void tile8(const Unit&, int row, int col, const f32x4 v0, const f32x4 v1, const Pre& pr) const {
        float x[8], a[8], o[8]; bf16x8_to_f32(pr.x, x); f4x2_to8(v0, v1, a);
#pragma unroll
        for (int j = 0; j < 8; ++j) o[j] = x[j] * ALPHA + a[j];
        *(f16x8*)(xout + (unsigned)row * 1024 + col) = f32_to_f16x8(o);
    }
};
struct FSwiglu {
    bf16* h; int ldh;
    __device__ __forceinline__ void pair8(const Unit&, int row, int colh, const f32x4 g0, const f32x4 g1, const f32x4 u0, const f32x4 u1) const {
        float g[8], uu[8], o[8]; f4x2_to8(g0, g1, g); f4x2_to8(u0, u1, uu);
#pragma unroll
        for (int j = 0; j < 8; ++j) o[j] = g[j] * sigm(g[j]) * uu[j];
        *(v4u*)(h + (unsigned)row * ldh + colh) = f32_to_bf16x8(o);
    }
};
struct FMoeDown {
    static constexpr int BATCH = 8; bf16* ypair; const float* slotw; const unsigned* cnt;
    struct Pre { float w; };
    __device__ __forceinline__ void begin_col(const Unit&, int) {}
    __device__ __forceinline__ Pre pre(const Unit& u, int row, int) const { Pre r; const int rk = u.aux + (row - u.pm * 256); r.w = ((unsigned)rk < cnt[u.z]) ? slotw[(unsigned)(u.z * MOE_CAP + rk)] : 0.f; return r; }
    __device__ __forceinline__ void tile8(const Unit& u, int row, int col, const f32x4 v0, const f32x4 v1, const Pre& pr) const {
        const int rk = u.aux + (row - u.pm * 256);
        if ((unsigned)rk < cnt[u.z]) *(v4u*)(ypair + (unsigned)row * 1024 + col) = pack8(v0 * pr.w, v1 * pr.w);
    }
};

struct MoeOrder {
    int nN, G, c; int pt[NEXP + 1];
    __device__ void init(const unsigned* cnt, int nN_, int G_, int c_) { nN = nN_; G = G_; c = c_; pt[0] = 0;
#pragma unroll
        for (int e = 0; e < NEXP; ++e) pt[e + 1] = pt[e] + (int)((cnt[e] + 255u) >> 8); }
    __device__ bool next(int i, Unit& u) const {
        const int nM = pt[NEXP], nwg = nM * nN; const long L = (long)i * G + c; if (L >= (long)nwg) return false;
        int wgid = (int)L; { const int q = nwg / pg8::NXCD, r = nwg % pg8::NXCD, xcd = wgid % pg8::NXCD, off = wgid / pg8::NXCD; wgid = (xcd < r ? xcd * (q + 1) : r * (q + 1) + (xcd - r) * q) + off; }
        const int nig = pg8::WGM * nN, gid = wgid / nig, fm = gid * pg8::WGM, gsz = (nM - fm) < pg8::WGM ? (nM - fm) : pg8::WGM;
        const int tile = fm + ((wgid % nig) % gsz); u.pn = (wgid % nig) / gsz; int e = 0;
#pragma unroll
        for (int k = 1; k < NEXP; ++k) e += (tile >= pt[k]) ? 1 : 0;
        int base = 0;
#pragma unroll
        for (int k = 1; k < NEXP; ++k) base = (tile >= pt[k]) ? pt[k] : base;
        u.z = e; u.pm = tile; u.aux = (tile - base) * 256; return true;
    }
};
struct LocMoe1 {
    static constexpr bool GATHER = true;
    const bf16* A; const bf16* Bt; int lda, ldb, K; const int* slot_tok; const unsigned* cnt;
    __device__ __forceinline__ const char* a_ptr(const Unit&) const { return (const char*)A; }
    __device__ __forceinline__ const char* b_ptr(const Unit& u) const { return (const char*)(Bt + (size_t)u.z * (2 * EXD) * DM + (size_t)u.pn * 256 * ldb); }
    __device__ __forceinline__ void a_tok(const Unit& u, int tid, unsigned (&v)[2][2]) const {
        const unsigned n = cnt[u.z];
#pragma unroll
        for (int i = 0; i < 2; ++i) { int R, C; pg8::stage_rc(tid * 16 + i * 8192, R, C);
#pragma unroll
            for (int h = 0; h < 2; ++h) { const int r = u.aux + h * 128 + R; v[h][i] = ((unsigned)r < n) ? (unsigned)slot_tok[(unsigned)(u.z * MOE_CAP + r)] : 0u; } }
    }
    __device__ __forceinline__ void a_fin(int tid, const unsigned (&t)[2][2], unsigned (&v)[2][2]) const {
#pragma unroll
        for (int i = 0; i < 2; ++i) { int R, C; pg8::stage_rc(tid * 16 + i * 8192, R, C);
#pragma unroll
            for (int h = 0; h < 2; ++h) v[h][i] = (t[h][i] * (unsigned)lda + (unsigned)C) * 2u; }
    }
    __device__ __forceinline__ void a_off(const Unit& u, int tid, unsigned (&v)[2][2]) const { unsigned t[2][2]; a_tok(u, tid, t); a_fin(tid, t, v); }
};
__device__ __forceinline__ int qperm_row(int n) { const int h = n / 96, d = n - h * 96; if (d < 64) return n; const int e = d - 64; return h * 96 + 64 + ((e < 16) ? 2 * e : 2 * (e - 16) + 1); }
struct TrDesc { const float* W; const float* ksc; bf16* WT; int ldw, k0, n0, ldd, kdst, drow0, qperm; };
struct TrRegs { f32x4 v[8]; };
__device__ __forceinline__ void tr_load(const TrDesc& d, TrRegs& r, int lane) {
    if (d.W) {
#pragma unroll
        for (int i = 0; i < 8; ++i) { const int kk = (lane >> 3) + 8 * i; f32x4 v = *(const f32x4*)(d.W + (size_t)(d.k0 + kk) * d.ldw + d.n0 + 4 * (lane & 7)); if (d.ksc) v = v * d.ksc[d.k0 + kk]; r.v[i] = v; }
    } else {
#pragma unroll
        for (int i = 0; i < 8; ++i) r.v[i] = (f32x4){0.f, 0.f, 0.f, 0.f};
    }
}
__device__ __forceinline__ void tr_finish(const TrDesc& d, const TrRegs& r, LAS float* scr, int lane) {
#pragma unroll
    for (int i = 0; i < 8; ++i) { const int kk = (lane >> 3) + 8 * i; LAS float* s = scr + kk * 33 + 4 * (lane & 7); s[0] = r.v[i][0]; s[1] = r.v[i][1]; s[2] = r.v[i][2]; s[3] = r.v[i][3]; }
    LDS_WAIT(); asm volatile("" ::: "memory");
    const int c = lane & 7;
#pragma unroll
    for (int j = 0; j < 4; ++j) { const int n = (lane >> 3) + 8 * j; const LAS float* s = scr + (8 * c) * 33 + n;
        v4u o; o.x = cvt_pk_bf16(s[0 * 33], s[1 * 33]); o.y = cvt_pk_bf16(s[2 * 33], s[3 * 33]); o.z = cvt_pk_bf16(s[4 * 33], s[5 * 33]); o.w = cvt_pk_bf16(s[6 * 33], s[7 * 33]);
        const int dr = d.qperm ? qperm_row(d.n0 + n) : (d.drow0 + n);
        *(v4u*)(d.WT + (size_t)dr * d.ldd + d.kdst + 8 * c) = o; }
    LDS_WAIT(); asm volatile("" ::: "memory");
}
__device__ __forceinline__ bool trjob(int& r, TrDesc& d, const float* W, int ldw, int K, int c0, int ncols, const float* ksc, bf16* WT, int ldd, int drow0) {
    const int nb = ncols / 32, ni = (K / 64) * nb; if (r < ni) { const int kb = r / nb, nbi = r % nb; d = TrDesc{W, ksc, WT, ldw, 64 * kb, c0 + 32 * nbi, ldd, 64 * kb, drow0 + 32 * nbi, 0}; return true; } r -= ni; return false; }
__device__ __forceinline__ bool trjob_gu(int& r, TrDesc& d, const float* W, int ldw, int K, int ncols, bf16* WT, int ldd, int up) {
    const int nb = ncols / 32, ni = (K / 64) * nb; if (r < ni) { const int kb = r / nb, n0 = 32 * (r % nb); d = TrDesc{W, nullptr, WT, ldw, 64 * kb, n0, ldd, 64 * kb, (n0 >> 7) * 256 + (n0 & 127) + (up ? 128 : 0), 0}; return true; } r -= ni; return false; }

constexpr int TR_PER_LAYER = 16 * 189 + 6 * 24 + 4 * 32 + 192 + 8 * 16 + 3 * 8 * 32 + 16 * 32 + 3 * 16;
constexpr int TR_PER_FFN = 3 * 16 * 88, TR_PROLOGUE = NLAYER * TR_PER_LAYER + 2 * TR_PER_FFN;
__device__ __forceinline__ void tr_decode_prologue(Frame& F, int it, TrDesc& d) {
    if (it < NLAYER * TR_PER_LAYER) {
        const int l = it / TR_PER_LAYER; int r = it % TR_PER_LAYER;
        const float* win = INP(float, 2) + (size_t)l * DM * IN_W;
        bf16* win_t = WSP(bf16, WS_WIN) + (size_t)l * 3072 * DM; bf16* wg_t = WSP(bf16, WS_WG) + (size_t)l * 3072 * DM;
        if (trjob(r, d, win, IN_W, DM, 0, 672, nullptr, win_t, DM, 0)) return;
        if (trjob(r, d, win, IN_W, DM, 672, 2304, nullptr, win_t, DM, 768)) return;
        if (trjob(r, d, win, IN_W, DM, 2976, 3072, nullptr, wg_t, DM, 0)) return;
        if (r < 48) { d = TrDesc{nullptr, nullptr, win_t, 0, 64 * (r / 3), 0, DM, 64 * (r / 3), 672 + 32 * (r % 3), 0}; return; } r -= 48;
        if (r < 144) { const int kb = r / 24, nbi = r % 24; d = TrDesc{INP(float, 4) + (size_t)l * 384 * 768, INP(float, 3) + l * 384, WSP(bf16, WS_WUQ) + (size_t)l * 768 * 384, 768, 64 * kb, 32 * nbi, 384, 64 * kb, 0, 1}; return; } r -= 144;
        if (trjob(r, d, INP(float, 6) + (size_t)l * 256 * 1024, 1024, 256, 0, 1024, INP(float, 5) + l * 256, WSP(bf16, WS_WUKV) + (size_t)l * 1024 * 256, 256, 0)) return;
        if (r < 192) { const int rb = r / 4, kb = r % 4; bf16* wl = WSP(bf16, WS_WLORA) + (size_t)l * 1536 * 256; const float* src = nullptr; int k0 = 0, n0 = 0;
            if (rb < 16) { if (kb == 0) { src = INP(float, 9) + (size_t)l * 64 * 512; n0 = 32 * rb; } }
            else if (rb < 32) { if (kb == 1) { src = INP(float, 11) + (size_t)l * 64 * 512; n0 = 32 * (rb - 16); } }
            else { if (kb >= 2) { src = INP(float, 12) + (size_t)l * 128 * 512; k0 = 64 * (kb - 2); n0 = 32 * (rb - 32); } }
            d = TrDesc{src, nullptr, wl, 512, k0, n0, 256, 64 * kb, 32 * rb, 0}; return; } r -= 192;
        if (trjob(r, d, INP(float, 29) + (size_t)l * 512 * 512, 512, 512, 0, 512, nullptr, WSP(bf16, WS_WGLU) + (size_t)l * 512 * 512, 512, 0)) return;
        if (trjob(r, d, INP(float, 31) + (size_t)(l * 3 + 0) * 512 * 1024, 1024, 512, 0, 1024, nullptr, WSP(bf16, WS_WBR) + (size_t)(l * 3 + 0) * 1024 * 512, 512, 0)) return;
        if (trjob(r, d, INP(float, 31) + (size_t)(l * 3 + 1) * 512 * 1024, 1024, 512, 0, 1024, nullptr, WSP(bf16, WS_WBR) + (size_t)(l * 3 + 1) * 1024 * 512, 512, 0)) return;
        if (trjob(r, d, INP(float, 31) + (size_t)(l * 3 + 2) * 512 * 1024, 1024, 512, 0, 1024, nullptr, WSP(bf16, WS_WBR) + (size_t)(l * 3 + 2) * 1024 * 512, 512, 0)) return;
        (void)trjob(r, d, INP(float, 32) + (size_t)l * DM * DM, DM, DM, 0, DM, nullptr, WSP(bf16, WS_WOUT) + (size_t)l * DM * DM, DM, 0);
    } else {
        const int q = it - NLAYER * TR_PER_LAYER, i = q / TR_PER_FFN; int r = q % TR_PER_FFN;
        if (trjob_gu(r, d, INP(float, 37) + (size_t)i * DM * FFN, FFN, DM, FFN, WSP(bf16, WS_WFGU) + (size_t)i * 2 * FFN * DM, DM, 0)) return;
        if (trjob_gu(r, d, INP(float, 38) + (size_t)i * DM * FFN, FFN, DM, FFN, WSP(bf16, WS_WFGU) + (size_t)i * 2 * FFN * DM, DM, 1)) return;
        (void)trjob(r, d, INP(float, 39) + (size_t)i * FFN * DM, DM, FFN, 0, DM, nullptr, WSP(bf16, WS_WFD) + (size_t)i * DM * FFN, FFN, 0);
    }
}
constexpr int TR_PER_E = 2 * 16 * 112 + 56 * 32;
__device__ __forceinline__ void tr_decode_moe(Frame& F, int li, int it, TrDesc& d) {
    const int e = it / TR_PER_E; int r = it % TR_PER_E; const size_t wi = (size_t)(li * NEXP + e);
    if (trjob_gu(r, d, INP(float, 41) + wi * DM * EXD, EXD, DM, EXD, WSP(bf16, WS_WMGU) + (size_t)e * 2 * EXD * DM, DM, 0)) return;
    if (trjob_gu(r, d, INP(float, 42) + wi * DM * EXD, EXD, DM, EXD, WSP(bf16, WS_WMGU) + (size_t)e * 2 * EXD * DM, DM, 1)) return;
    (void)trjob(r, d, INP(float, 43) + wi * EXD * DM, DM, EXD, 0, DM, nullptr, WSP(bf16, WS_WMD) + (size_t)e * DM * EXD, EXD, 0);
}

__device__ __forceinline__ void p0_prologue(Frame& F) {
    LAS float* scr = (LAS float*)(F.lds + F.wave * 16384);
    const int lane = F.lane; const int gw = F.blk * NWAVES + F.wave, NGW = F.G * NWAVES;
    { TrDesc dc, dn; TrRegs rc, rn; int it = gw;
      if (it < TR_PROLOGUE) { tr_decode_prologue(F, it, dc); tr_load(dc, rc, lane); }
      for (; it < TR_PROLOGUE; it += NGW) { const bool more = it + NGW < TR_PROLOGUE;
          if (more) { tr_decode_prologue(F, it + NGW, dn); tr_load(dn, rn, lane); }
          tr_finish(dc, rc, scr, lane);
          if (more) { dc = dn; rc = rn; } } }
    for (int it = F.blk * 512 + F.tid; it < 3 * 512 * 64; it += F.G * 512) {
        const int i = it / (512 * 64), rem = it % (512 * 64), n = rem >> 6, k0 = (rem & 63) * 8;
        const float* vd = INP(float, 18) + (size_t)i * 512 * 32; const float* vu = INP(float, 19) + (size_t)i * 32 * 512; float o[8];
#pragma unroll
        for (int j = 0; j < 8; ++j) o[j] = 0.f;
        for (int rr = 0; rr < 32; ++rr) { const float u = vu[rr * 512 + n];
#pragma unroll
            for (int j = 0; j < 8; ++j) o[j] += vd[(k0 + j) * 32 + rr] * u; }
        *(v4u*)(WSP(bf16, WS_WVRES) + (size_t)i * 512 * 512 + (size_t)n * 512 + k0) = f32_to_bf16x8(o);
    }
    for (int it = F.blk * 512 + F.tid; it < M * 16; it += F.G * 512) {
        const int m = it >> 4, i = it & 15; const float inv = powf(10000.0f, -(float)i * (1.0f / 16.0f)); const float ang = (float)INP(int, 1)[m] * inv;
        float sn, cn; sincosf(ang, &sn, &cn); float* cs = WSP(float, WS_ROPE) + (size_t)m * 32; cs[i] = cn; cs[16 + i] = sn;
    }
}
__device__ __forceinline__ void moe_convert(Frame& F, int li) {
    LAS float* scr = (LAS float*)(F.lds + F.wave * 16384);
    const int lane = F.lane; const int gw = F.blk * NWAVES + F.wave, NGW = F.G * NWAVES;
    TrDesc dc, dn; TrRegs rc, rn; int it = gw;
    if (it < NEXP * TR_PER_E) { tr_decode_moe(F, li, it, dc); tr_load(dc, rc, lane); }
    for (; it < NEXP * TR_PER_E; it += NGW) { const bool more = it + NGW < NEXP * TR_PER_E;
        if (more) { tr_decode_moe(F, li, it + NGW, dn); tr_load(dn, rn, lane); }
        tr_finish(dc, rc, scr, lane);
        if (more) { dc = dn; rc = rn; } }
}

__device__ __forceinline__ void ph2_prep(Frame& F, int l) {
    const int lane = F.lane; const int gw = F.blk * NWAVES + F.wave, NGW = F.G * NWAVES;
    const bf16* rwraw = WSP(bf16, WS_RWRAW); const bf16* mlaraw = WSP(bf16, WS_MLARAW);
    const float* mu = INP(float, 7) + l * 1792; const float* k_k = INP(float, 13) + l * 512;
    float mu_r[8], mu_k[8], mu_v[8], mu_t[8], kk8[8];
    ld8f(mu + 8 * lane, mu_r); ld8f(mu + 512 + 8 * lane, mu_k); ld8f(mu + 1024 + 8 * lane, mu_v); ld8f(mu + 1536 + 8 * (lane & 31), mu_t); ld8f(k_k + 8 * lane, kk8);
    const float* cs_all = WSP(float, WS_ROPE);
    constexpr int TPW = 16;
    const int m0 = gw * TPW;
    v4u n_r, n_k, n_v, n_t, n_a, n_b, p_r, p_k, p_v, p_t;
    { const bf16* cur = rwraw + (size_t)m0 * 1792; n_r = *(const v4u*)(cur + 8 * lane); n_k = *(const v4u*)(cur + 512 + 8 * lane); n_v = *(const v4u*)(cur + 1024 + 8 * lane); n_t = *(const v4u*)(cur + 1536 + 8 * (lane & 31));
      const bf16* mr = mlaraw + (size_t)m0 * 768; n_a = *(const v4u*)(mr + 8 * lane); n_b = *(const v4u*)(mr + 512 + 8 * (lane & 31));
      if (m0 & (SEQ - 1)) { const bf16* prv = cur - 1792; p_r = *(const v4u*)(prv + 8 * lane); p_k = *(const v4u*)(prv + 512 + 8 * lane); p_v = *(const v4u*)(prv + 1024 + 8 * lane); p_t = *(const v4u*)(prv + 1536 + 8 * (lane & 31)); }
      else { p_r = (v4u){0u, 0u, 0u, 0u}; p_k = p_r; p_v = p_r; p_t = p_r; } }
    for (int i = 0; i < TPW; ++i) {
        const int m = m0 + i;
        const v4u c_r = n_r, c_k = n_k, c_v = n_v, c_t = n_t, c_a = n_a, c_b = n_b;
        if (i + 1 < TPW) { const bf16* nx = rwraw + (size_t)(m + 1) * 1792; n_r = *(const v4u*)(nx + 8 * lane); n_k = *(const v4u*)(nx + 512 + 8 * lane); n_v = *(const v4u*)(nx + 1024 + 8 * lane); n_t = *(const v4u*)(nx + 1536 + 8 * (lane & 31));
            const bf16* mr = mlaraw + (size_t)(m + 1) * 768; n_a = *(const v4u*)(mr + 8 * lane); n_b = *(const v4u*)(mr + 512 + 8 * (lane & 31)); }
        float c[8], p[8], o[8];
        bf16x8_to_f32(c_r, c); bf16x8_to_f32(p_r, p);
#pragma unroll
        for (int j = 0; j < 8; ++j) o[j] = c[j] + (p[j] - c[j]) * mu_r[j];
        *(f16x8*)(WSP(f16, WS_R) + (size_t)m * 512 + 8 * lane) = f32_to_f16x8(o);
        bf16x8_to_f32(c_k, c); bf16x8_to_f32(p_k, p);
        float ss = 0.f;
#pragma unroll
        for (int j = 0; j < 8; ++j) { o[j] = c[j] + (p[j] - c[j]) * mu_k[j]; const float q = o[j] * kk8[j]; ss += q * q; }
        *(f16x8*)(WSP(f16, WS_KH) + (size_t)m * 512 + 8 * lane) = f32_to_f16x8(o);
        ss += __shfl_xor(ss, 1); ss += __shfl_xor(ss, 2); ss += __shfl_xor(ss, 4);
        { const float rn = 1.0f / fmaxf(sqrtf(ss), 1e-12f);
#pragma unroll
          for (int j = 0; j < 8; ++j) o[j] = o[j] * kk8[j] * rn; }
        *(f16x8*)(WSP(f16, WS_KKN) + (size_t)m * 512 + 8 * lane) = f32_to_f16x8(o);
        bf16x8_to_f32(c_v, c); bf16x8_to_f32(p_v, p);
#pragma unroll
        for (int j = 0; j < 8; ++j) o[j] = c[j] + (p[j] - c[j]) * mu_v[j];
        { const v4u vb = f32_to_bf16x8(o); *(v4u*)(WSP(bf16, WS_VRAW) + (size_t)m * 512 + 8 * lane) = vb;
          if (l == 0) { *(v4u*)(WSP(bf16, WS_VFIRST) + (size_t)m * 512 + 8 * lane) = vb; *(f16x8*)(WSP(f16, WS_VFIN) + (size_t)m * 512 + 8 * lane) = f32_to_f16x8(o); } }
        if (lane < 32) {
            bf16x8_to_f32(c_t, c); bf16x8_to_f32(p_t, p);
#pragma unroll
            for (int j = 0; j < 8; ++j) { float v = c[j] + (p[j] - c[j]) * mu_t[j]; if (lane < 8) v = 1.0f - 2.0f * __builtin_amdgcn_rcpf(__expf(2.0f * v) + 1.0f); else if (lane >= 16) v = sigm(v); o[j] = v; }
            *(v4u*)(WSP(bf16, WS_LORAIN) + (size_t)m * 256 + 8 * lane) = f32_to_bf16x8(o);
        }
        p_r = c_r; p_k = c_k; p_v = c_v; p_t = c_t;
        float a8[8], b8[8];
        bf16x8_to_f32(c_a, a8); float ssa = 0.f, ssb = 0.f;
#pragma unroll
        for (int j = 0; j < 8; ++j) ssa += a8[j] * a8[j];
        if (lane < 32) { bf16x8_to_f32(c_b, b8);
#pragma unroll
            for (int j = 0; j < 8; ++j) ssb += b8[j] * b8[j]; } else {
#pragma unroll
            for (int j = 0; j < 8; ++j) b8[j] = 0.f; }
        const float sq = wave_sum(lane < 48 ? ssa : 0.f), skv = wave_sum((lane >= 48 ? ssa : 0.f) + (lane < 16 ? ssb : 0.f));
        const float rq = 1.0f / sqrtf(sq * (1.0f / 384.0f) + 1e-6f), rkv = 1.0f / sqrtf(skv * (1.0f / 256.0f) + 1e-6f);
        if (lane < 48) {
#pragma unroll
            for (int j = 0; j < 8; ++j) o[j] = a8[j] * rq;
            *(v4u*)(WSP(bf16, WS_CQN) + (size_t)m * 384 + 8 * lane) = f32_to_bf16x8(o);
        } else {
#pragma unroll
            for (int j = 0; j < 8; ++j) o[j] = a8[j] * rkv;
            *(v4u*)(WSP(bf16, WS_CKVN) + (size_t)m * 256 + 8 * (lane - 48)) = f32_to_bf16x8(o);
        }
        if (lane < 16) {
#pragma unroll
            for (int j = 0; j < 8; ++j) o[j] = b8[j] * rkv;
            *(v4u*)(WSP(bf16, WS_CKVN) + (size_t)m * 256 + 128 + 8 * lane) = f32_to_bf16x8(o);
        }
        float pr[8];
#pragma unroll
        for (int j = 0; j < 8; ++j) pr[j] = __shfl_xor(b8[j], 2);
        if (lane >= 16 && lane < 20) { const int i0 = 8 * (lane & 1); const float* cs = cs_all + (size_t)m * 32; float cc[8], sn[8]; ld8f(cs + i0, cc); ld8f(cs + 16 + i0, sn);
            const bool lo = lane < 18;
#pragma unroll
            for (int j = 0; j < 8; ++j) o[j] = lo ? (b8[j] * cc[j] - pr[j] * sn[j]) : (pr[j] * sn[j] + b8[j] * cc[j]);
            const v4u w = f32_to_bf16x8(o); bf16* kd = WSP(bf16, WS_K) + (size_t)m * 768 + 64 + (lo ? 0 : 16) + i0;
#pragma unroll
            for (int h = 0; h < NH; ++h) *(v4u*)(kd + h * 96) = w; }
    }
}

__device__ __forceinline__ void s5_gen(Frame& F, int l, int g) {
    {
        __syncthreads();
        const int tid = F.tid;
        LAS float* pw = (LAS float*)F.lds;
        LAS float* Bb = pw + 33 * 64 * 2;
        LAS float* Cc = Bb + 64 * 16 * 2;
        LAS float* Kt = Cc + 16 * 64 * 2;
        const float dt = expf(INP(float, 23)[l * 32 + g]);
        const float* are = INP(float, 21) + (size_t)(l * 32 + g) * 64; const float* aim = INP(float, 22) + (size_t)(l * 32 + g) * 64;
        for (int e = tid; e < 33 * 64; e += 512) { const int n = e >> 6, p = e & 63; const float lr = fminf(are[p], -1e-4f), li = aim[p];
            const float mag = expf((float)n * (dt * lr)); float sn, cn; sincosf((float)n * (dt * li), &sn, &cn); pw[2 * e] = mag * cn; pw[2 * e + 1] = mag * sn; }
        for (int e = tid; e < 64 * 16; e += 512) { const int p = e >> 4; const float lr = fminf(are[p], -1e-4f), li = aim[p];
            const float mag = expf(dt * lr); float sn, cn; sincosf(dt * li, &sn, &cn); const float abr = mag * cn, abi = mag * sn, den = lr * lr + li * li;
            const float fr = ((abr - 1.0f) * lr + abi * li) / den, fi = (abi * lr - (abr - 1.0f) * li) / den;
            const float br = INP(float, 24)[(size_t)(l * 32 + g) * 1024 + e], bi = INP(float, 25)[(size_t)(l * 32 + g) * 1024 + e];
            Bb[2 * e] = fr * br - fi * bi; Bb[2 * e + 1] = fr * bi + fi * br; }
        for (int e = tid; e < 16 * 64; e += 512) { Cc[2 * e] = INP(float, 26)[(size_t)(l * 32 + g) * 1024 + e]; Cc[2 * e + 1] = INP(float, 27)[(size_t)(l * 32 + g) * 1024 + e]; }
        __syncthreads();
        { const int tau = tid >> 4, o = tid & 15; float acc[16];
#pragma unroll
          for (int i = 0; i < 16; ++i) acc[i] = 0.f;
          for (int p = 0; p < 64; ++p) { const float cr = Cc[2 * (o * 64 + p)], ci = Cc[2 * (o * 64 + p) + 1], pr_ = pw[2 * (tau * 64 + p)], pi_ = pw[2 * (tau * 64 + p) + 1];
              const float xr = cr * pr_ - ci * pi_, xi = cr * pi_ + ci * pr_;
#pragma unroll
              for (int i = 0; i < 16; ++i) acc[i] += xr * Bb[2 * (p * 16 + i)] - xi * Bb[2 * (p * 16 + i) + 1]; }
#pragma unroll
          for (int i = 0; i < 16; ++i) Kt[(tau * 16 + o) * 16 + i] = acc[i]; }
        __syncthreads();
        bf16* bm = WSP(bf16, WS_S5MAIN) + ((size_t)l * 32 + g) * 512 * S5K;
        for (int e = tid; e < 512 * 80; e += 512) { const int n = e / 80, k0 = (e % 80) * 8, t = n >> 4, o = n & 15; float v[8];
            if (k0 < 512) { const int sidx = k0 >> 4, i0 = k0 & 15;
#pragma unroll
                for (int j = 0; j < 8; ++j) v[j] = (sidx <= t) ? Kt[((t - sidx) * 16 + o) * 16 + i0 + j] : 0.f; }
            else {
#pragma unroll
                for (int j = 0; j < 8; ++j) { const int q = k0 - 512 + j, p = q & 63; const float cr = Cc[2 * (o * 64 + p)], ci = Cc[2 * (o * 64 + p) + 1], pr_ = pw[2 * ((t + 1) * 64 + p)], pi_ = pw[2 * ((t + 1) * 64 + p) + 1];
                    v[j] = (q < 64) ? (cr * pr_ - ci * pi_) : -(cr * pi_ + ci * pr_); } }
            *(v4u*)(bm + (size_t)n * S5K + k0) = f32_to_bf16x8(v); }
        bf16* be = WSP(bf16, WS_S5END) + ((size_t)l * 32 + g) * 256 * 512;
        for (int e = tid; e < 256 * 64; e += 512) { const int n = e / 64, k0 = (e % 64) * 8, sidx = k0 >> 4, i0 = k0 & 15; float v[8];
            if (n < 128) { const int p = n & 63; const float pr_ = pw[2 * ((31 - sidx) * 64 + p)], pi_ = pw[2 * ((31 - sidx) * 64 + p) + 1];
#pragma unroll
                for (int j = 0; j < 8; ++j) { const float br = Bb[2 * (p * 16 + i0 + j)], bi = Bb[2 * (p * 16 + i0 + j) + 1]; v[j] = (n < 64) ? (pr_ * br - pi_ * bi) : (pr_ * bi + pi_ * br); } }
            else {
#pragma unroll
                for (int j = 0; j < 8; ++j) v[j] = 0.f; }
            *(v4u*)(be + (size_t)n * 512 + k0) = f32_to_bf16x8(v); }
        if (tid < 64) { float* a32 = WSP(float, WS_S5A32) + (size_t)((l * 32 + g) * 64 + tid) * 2; a32[0] = pw[2 * (32 * 64 + tid)]; a32[1] = pw[2 * (32 * 64 + tid) + 1]; }
        __syncthreads();
    }
}

__device__ __forceinline__ void ln_core(f32x4 (&v)[4], const float* gam, const float* bet, int lane) {
    float s = 0.f;
#pragma unroll
    for (int j = 0; j < 4; ++j) s += (v[j][0] + v[j][1]) + (v[j][2] + v[j][3]);
    const float mean = wave_sum(s) * (1.f / DM); float s2 = 0.f;
#pragma unroll
    for (int j = 0; j < 4; ++j) { v[j] = v[j] - mean; s2 += (v[j][0] * v[j][0] + v[j][1] * v[j][1]) + (v[j][2] * v[j][2] + v[j][3] * v[j][3]); }
    const float rstd = 1.f / sqrtf(wave_sum(s2) * (1.f / DM) + LN_EPS);
#pragma unroll
    for (int j = 0; j < 4; ++j) { const f32x4 g4 = *(const f32x4*)(gam + 4 * lane + 256 * j), b4 = *(const f32x4*)(bet + 4 * lane + 256 * j); v[j] = v[j] * rstd * g4 + b4; }
}
__device__ __forceinline__ void ln_store(const f32x4 (&v)[4], float* xrow, bf16* xbrow, int lane) {
#pragma unroll
    for (int j = 0; j < 4; ++j) { if (xrow) *(f32x4*)(xrow + 4 * lane + 256 * j) = v[j]; v2u w; w.x = cvt_pk_bf16(v[j][0], v[j][1]); w.y = cvt_pk_bf16(v[j][2], v[j][3]); *(v2u*)(xbrow + 4 * lane + 256 * j) = w; }
}
__device__ __forceinline__ void ln_phase(Frame& F, const float* gam, const float* bet) {
    const int lane = F.lane; const int gw = F.blk * NWAVES + F.wave, NGW = F.G * NWAVES; const f16* X = (const f16*)F.out; bf16* Xb = WSP(bf16, WS_XB);
    for (int m = gw; m < M; m += NGW) { f32x4 v[4];
#pragma unroll
        for (int j = 0; j < 4; ++j) { typedef f16 f16x4 __attribute__((ext_vector_type(4))); const f16x4 h = *(const f16x4*)(X + (size_t)m * DM + 4 * lane + 256 * j); v[j] = (f32x4){(float)h[0], (float)h[1], (float)h[2], (float)h[3]}; }
        ln_core(v, gam, bet, lane); ln_store(v, nullptr, Xb + (size_t)m * DM, lane); }
}
__device__ __forceinline__ void ln2_moe_phase(Frame& F, const float* gam, const float* bet, int li, bool last) {
    const int lane = F.lane; const int gw = F.blk * NWAVES + F.wave, NGW = F.G * NWAVES; float* X = F.out; bf16* Xb = WSP(bf16, WS_XB);
    const unsigned* cnt = (const unsigned*)(F.ctl + CW_MOECNT + 64 * li); int pstart[NEXP]; { int acc = 0;
#pragma unroll
        for (int e = 0; e < NEXP; ++e) { pstart[e] = acc; acc += (int)(((cnt[e] + 255u) >> 8) << 8); } }
    const int* ppos = WSP(int, WS_PAIRPOS); const bf16* yp = WSP(bf16, WS_YPAIR);
    for (int m = gw; m < M; m += NGW) { f32x4 v[4];
        const int p0 = ppos[2 * m], p1 = ppos[2 * m + 1]; int r0 = 0, r1 = 0;
#pragma unroll
        for (int e = 0; e < NEXP; ++e) { if ((p0 >> 24) == e) r0 = pstart[e] + (p0 & 0xffffff); if ((p1 >> 24) == e) r1 = pstart[e] + (p1 & 0xffffff); }
#pragma unroll
        for (int j = 0; j < 4; ++j) { const v2u xw = *(const v2u*)(Xb + (size_t)m * DM + 4 * lane + 256 * j); const f32x4 x = (f32x4){bf_lo(xw.x), bf_hi(xw.x), bf_lo(xw.y), bf_hi(xw.y)};
            const v2u a = *(const v2u*)(yp + (size_t)r0 * DM + 4 * lane + 256 * j), b = *(const v2u*)(yp + (size_t)r1 * DM + 4 * lane + 256 * j);
            v[j] = x * ALPHA + (f32x4){bf_lo(a.x) + bf_lo(b.x), bf_hi(a.x) + bf_hi(b.x), bf_lo(a.y) + bf_lo(b.y), bf_hi(a.y) + bf_hi(b.y)}; }
        ln_core(v, gam, bet, lane); ln_store(v, last ? X + (size_t)m * DM : nullptr, Xb + (size_t)m * DM, lane); }
}
__device__ __forceinline__ void ln1_moe_phase(Frame& F, const float* gam, const float* bet, int li) {
    const int lane = F.lane; float* X = F.out; bf16* Xb = WSP(bf16, WS_XB);
    LAS int* pe = (LAS int*)F.lds;
    LAS float* pwt = (LAS float*)(F.lds + 1024);
    LAS int* cntl = (LAS int*)(F.lds + 2048);
    const float* router = INP(float, 40) + (size_t)li * DM * NEXP;
    for (int blk0 = F.blk; blk0 * 128 < M; blk0 += F.G) {
        __syncthreads();
        for (int i = 0; i < 16; ++i) { const int tl = F.wave * 16 + i, m = blk0 * 128 + tl; f32x4 v[4];
#pragma unroll
            for (int j = 0; j < 4; ++j) { typedef f16 f16x4 __attribute__((ext_vector_type(4))); const f16x4 h = *(const f16x4*)((const f16*)X + (size_t)m * DM + 4 * lane + 256 * j); v[j] = (f32x4){(float)h[0], (float)h[1], (float)h[2], (float)h[3]}; }
            ln_core(v, gam, bet, lane); ln_store(v, nullptr, Xb + (size_t)m * DM, lane);
            float lg[NEXP];
#pragma unroll
            for (int e = 0; e < NEXP; ++e) lg[e] = 0.f;
#pragma unroll
            for (int j = 0; j < 4; ++j)
#pragma unroll
                for (int q = 0; q < 4; ++q) { const float xv = v[j][q]; const float* rr = router + (size_t)(4 * lane + 256 * j + q) * NEXP; const f32x4 ra = *(const f32x4*)rr, rb = *(const f32x4*)(rr + 4);
                    lg[0] += xv * ra[0]; lg[1] += xv * ra[1]; lg[2] += xv * ra[2]; lg[3] += xv * ra[3]; lg[4] += xv * rb[0]; lg[5] += xv * rb[1]; lg[6] += xv * rb[2]; lg[7] += xv * rb[3]; }
#pragma unroll
            for (int e = 0; e < NEXP; ++e) lg[e] = wave_sum(lg[e]);
            int e0 = 0; float l0 = lg[0];
#pragma unroll
            for (int e = 1; e < NEXP; ++e) if (lg[e] > l0) { l0 = lg[e]; e0 = e; }
            int e1 = -1; float l1 = -INFINITY;
#pragma unroll
            for (int e = 0; e < NEXP; ++e) if (e != e0 && lg[e] > l1) { l1 = lg[e]; e1 = e; }
            const float w1 = 1.0f / (1.0f + expf(l0 - l1)), w0 = 1.0f - w1;
            if (lane == 0) { pe[2 * tl] = e0; pe[2 * tl + 1] = e1; pwt[2 * tl] = w0; pwt[2 * tl + 1] = w1; }
        }
        __syncthreads();
        int myrank = 0, mye = 0;
        if (F.tid < 256) { mye = pe[F.tid]; for (int q = 0; q < F.tid; ++q) myrank += (pe[q] == mye) ? 1 : 0; }
#ifdef PROBE_ORDERED
        if (F.tid == 0) { unsigned sp = 0; while (__hip_atomic_load((unsigned*)(F.ctl + CW_MOECNT + 64 * li + 32), RLX_AGENT) != (unsigned)blk0 && ++sp < (1u << 22)) __builtin_amdgcn_s_sleep(2); }
        __syncthreads();
#endif
        if (F.tid < NEXP) { int c = 0; for (int q = 0; q < 256; ++q) c += (pe[q] == F.tid) ? 1 : 0; cntl[F.tid] = c;
            cntl[8 + F.tid] = (int)__hip_atomic_fetch_add((unsigned*)(F.ctl + CW_MOECNT + 64 * li + F.tid), (unsigned)c, RLX_AGENT); }
#ifdef PROBE_ORDERED
        __syncthreads();
        if (F.tid == 0) { asm volatile("s_waitcnt vmcnt(0)" ::: "memory"); __hip_atomic_fetch_add((unsigned*)(F.ctl + CW_MOECNT + 64 * li + 32), 1u, RLX_AGENT); }
#endif
        __syncthreads();
        if (F.tid < 256) { const int rk = cntl[8 + mye] + myrank; const int m = blk0 * 128 + (F.tid >> 1);
            WSP(int, WS_SLOTTOK)[(size_t)mye * MOE_CAP + rk] = m; WSP(float, WS_SLOTW)[(size_t)mye * MOE_CAP + rk] = pwt[F.tid]; WSP(int, WS_PAIRPOS)[blk0 * 256 + F.tid] = (mye << 24) | rk; }
    }
    __syncthreads();
}
constexpr int AT_CW = 8, AT_QR = 32 * AT_CW;
constexpr int AT_KS = 208, AT_VS = 192;
constexpr int AT_KB = 64 * AT_KS, AT_VB = 64 * AT_VS, AT_STAGE = AT_KB + AT_VB;
constexpr int AT_WSF = 2 * AT_STAGE, AT_OST = AT_WSF + NWAVES * 256, AT_LDS = AT_OST + NWAVES * 4096;
__device__ __forceinline__ int crow(int r, int hi) { return (r & 3) + 8 * (r >> 2) + 4 * hi; }

__device__ __forceinline__ void attn_unit(int tid, int b, int h, int qb, const bf16* Q, const bf16* K, const bf16* V, bf16* O, LAS unsigned char* lds) {
    const int lane = tid & 63, r32 = lane & 31, hi = lane >> 5; const int wid = __builtin_amdgcn_readfirstlane(tid >> 6);
    const size_t rowbase = (size_t)b * SEQ; const int q0 = qb * AT_QR; const bool cw = wid < AT_CW;
    bf16x8 qr[6];
    { const bf16* qp = Q + (rowbase + q0 + (cw ? wid : 0) * 32 + r32) * 768 + h * 96 + hi * 8;
#pragma unroll
      for (int d0 = 0; d0 < 6; ++d0) qr[d0] = *(const bf16x8*)(qp + d0 * 16); }
    const int kp0 = tid, kp1 = 512 + tid;
    const bf16* kg0 = K + (rowbase + kp0 / 12) * 768 + h * 96 + (kp0 % 12) * 8;
    const bf16* kg1 = K + (rowbase + kp1 / 12) * 768 + h * 96 + (kp1 % 12) * 8;
    const bf16* vg = V + (rowbase + (tid >> 3)) * 512 + h * 64 + (tid & 7) * 8;
    const int kl0 = (kp0 / 12) * AT_KS + (kp0 % 12) * 16, kl1 = (kp1 / 12) * AT_KS + (kp1 % 12) * 16, vl = (tid >> 3) * AT_VS + (tid & 7) * 16;
    const bool two = tid < 256;
    const int NT = (q0 + AT_QR) / 64;
    v4u ka, kb2, va;
    ka = *(const v4u*)kg0; if (two) kb2 = *(const v4u*)kg1; va = *(const v4u*)vg;
    *(LAS v4u*)(lds + kl0) = ka; if (two) *(LAS v4u*)(lds + kl1) = kb2; *(LAS v4u*)(lds + AT_KB + vl) = va;
    LAS float* wsf = (LAS float*)(lds + AT_WSF) + wid * 64;
    float m_run = -1e30f, l_run = 0.f; f32x16 o[2];
#pragma unroll
    for (int r = 0; r < 16; ++r) { o[0][r] = 0.f; o[1][r] = 0.f; }
    const int kfo = r32 * AT_KS + hi * 16;
    const int vfo = (4 * hi + ((lane & 15) >> 2)) * AT_VS + ((lane >> 4) & 1) * 32 + (lane & 3) * 8;
    const int qrel = wid * 32 + r32;
    __syncthreads();
    for (int t = 0; t < NT; ++t) {
        const int cur = (t & 1) * AT_STAGE, nxt = ((t + 1) & 1) * AT_STAGE; const bool more = (t + 1 < NT);
        if (more) { const size_t go = (size_t)(t + 1) * 64 * 768; ka = *(const v4u*)(kg0 + go); if (two) kb2 = *(const v4u*)(kg1 + go); va = *(const v4u*)(vg + (size_t)(t + 1) * 64 * 512); }
        const int jb = t - (NT - AT_QR / 64);
        if (cw && (jb < 0 || 64 * jb <= 32 * wid + 31)) {
            f32x16 p0, p1;
#pragma unroll
            for (int r = 0; r < 16; ++r) { p0[r] = 0.f; p1[r] = 0.f; }
#pragma unroll
            for (int d0 = 0; d0 < 6; ++d0) { const bf16x8 k0 = *(const LAS bf16x8*)(lds + cur + kfo + d0 * 32), k1 = *(const LAS bf16x8*)(lds + cur + kfo + 32 * AT_KS + d0 * 32);
                p0 = __builtin_amdgcn_mfma_f32_32x32x16_bf16(k0, qr[d0], p0, 0, 0, 0); p1 = __builtin_amdgcn_mfma_f32_32x32x16_bf16(k1, qr[d0], p1, 0, 0, 0); }
            s16x4 vlo[8], vhh[8];
#pragma unroll
            for (int d0 = 0; d0 < 2; ++d0)
#pragma unroll
                for (int ks = 0; ks < 4; ++ks) {
                    vlo[d0 * 4 + ks] = __builtin_bit_cast(s16x4, __builtin_amdgcn_ds_read_tr16_b64_v4i16((LAS s16x4*)(lds + cur + AT_KB + vfo + (16 * ks) * AT_VS + d0 * 64)));
                    vhh[d0 * 4 + ks] = __builtin_bit_cast(s16x4, __builtin_amdgcn_ds_read_tr16_b64_v4i16((LAS s16x4*)(lds + cur + AT_KB + vfo + (16 * ks + 8) * AT_VS + d0 * 64))); }
            if (jb >= 0) { const int kb = 64 * jb + 4 * hi;
#pragma unroll
                for (int r = 0; r < 16; ++r) { const int kv = kb + (r & 3) + 8 * (r >> 2); if (kv > qrel) p0[r] = -INFINITY; if (kv + 32 > qrel) p1[r] = -INFINITY; } }
            float rm = fmaxf(p0[0], p1[0]);
#pragma unroll
            for (int r = 1; r < 16; ++r) rm = fmaxf(rm, fmaxf(p0[r], p1[r]));
            rm = fmaxf(rm, __shfl_xor(rm, 32));
            const float mnew = fmaxf(m_run, rm), alpha = __builtin_amdgcn_exp2f(m_run - mnew);
            float ps = 0.f;
#pragma unroll
            for (int r = 0; r < 16; ++r) { p0[r] = __builtin_amdgcn_exp2f(p0[r] - mnew); p1[r] = __builtin_amdgcn_exp2f(p1[r] - mnew); ps += p0[r] + p1[r]; }
            l_run = l_run * alpha + ps;
            if (__any(mnew > m_run)) {
                if (hi == 0) wsf[r32] = alpha;
                LDS_WAIT();
#pragma unroll
                for (int r = 0; r < 16; ++r) { const float f = wsf[crow(r, hi)]; o[0][r] *= f; o[1][r] *= f; }
            }
            m_run = mnew;
            bf16x8 pa[4];
            { v4u w;
              w.x = cvt_pk_bf16(p0[0], p0[1]); w.y = cvt_pk_bf16(p0[2], p0[3]); w.z = cvt_pk_bf16(p0[4], p0[5]); w.w = cvt_pk_bf16(p0[6], p0[7]); pa[0] = __builtin_bit_cast(bf16x8, w);
              w.x = cvt_pk_bf16(p0[8], p0[9]); w.y = cvt_pk_bf16(p0[10], p0[11]); w.z = cvt_pk_bf16(p0[12], p0[13]); w.w = cvt_pk_bf16(p0[14], p0[15]); pa[1] = __builtin_bit_cast(bf16x8, w);
              w.x = cvt_pk_bf16(p1[0], p1[1]); w.y = cvt_pk_bf16(p1[2], p1[3]); w.z = cvt_pk_bf16(p1[4], p1[5]); w.w = cvt_pk_bf16(p1[6], p1[7]); pa[2] = __builtin_bit_cast(bf16x8, w);
              w.x = cvt_pk_bf16(p1[8], p1[9]); w.y = cvt_pk_bf16(p1[10], p1[11]); w.z = cvt_pk_bf16(p1[12], p1[13]); w.w = cvt_pk_bf16(p1[14], p1[15]); pa[3] = __builtin_bit_cast(bf16x8, w); }
#pragma unroll
            for (int d0 = 0; d0 < 2; ++d0)
#pragma unroll
                for (int ks = 0; ks < 4; ++ks) {
                    const s16x4 lo = vlo[d0 * 4 + ks], hh = vhh[d0 * 4 + ks];
                    const bf16x8 vf = (bf16x8){lo[0], lo[1], lo[2], lo[3], hh[0], hh[1], hh[2], hh[3]};
                    o[d0] = __builtin_amdgcn_mfma_f32_32x32x16_bf16(pa[ks], vf, o[d0], 0, 0, 0);
                }
        }
        if (more) { *(LAS v4u*)(lds + nxt + kl0) = ka; if (two) *(LAS v4u*)(lds + nxt + kl1) = kb2; *(LAS v4u*)(lds + nxt + AT_KB + vl) = va; }
        __syncthreads();
    }
    l_run += __shfl_xor(l_run, 32);
    if (cw) {
    if (hi == 0) wsf[32 + r32] = l_run;
    LDS_WAIT();
    { bf16* stg = (bf16*)(lds + AT_OST + wid * 4096);
#pragma unroll
      for (int r = 0; r < 16; ++r) { const int orow = crow(r, hi); const float rl = __builtin_amdgcn_rcpf(wsf[32 + orow]);
#pragma unroll
          for (int d0 = 0; d0 < 2; ++d0) { const unsigned u = cvt_pk_bf16(o[d0][r] * rl, 0.f); ((LAS bf16*)(lds + AT_OST + wid * 4096))[orow * 64 + d0 * 32 + r32] = (bf16)(u & 0xffffu); } }
      (void)stg;
      LDS_WAIT();
      bf16* Ow = O + (rowbase + q0 + wid * 32) * 512 + h * 64;
#pragma unroll
      for (int i = 0; i < 4; ++i) { const int row = i * 8 + (lane >> 3), ch = lane & 7; const v4u v = *(const LAS v4u*)(lds + AT_OST + wid * 4096 + (row * 64 + ch * 8) * 2); *(v4u*)(Ow + (size_t)row * 512 + ch * 8) = v; } }
    }
    __syncthreads();
}

template <int CTRL> __device__ __forceinline__ float dpp_add(float v) { return v + __builtin_bit_cast(float, __builtin_amdgcn_update_dpp(0, __builtin_bit_cast(int, v), CTRL, 0xF, 0xF, true)); }
constexpr int RW_TC = 64, RW_STREAM = RW_TC * 64 * 2  , RW_BUF = 6 * RW_STREAM  , RW_YOFF = 2 * RW_BUF  , RW_LDS = RW_YOFF + 2 * RW_STREAM;
constexpr int RW_SPLIT = 2, RW_CW = 4  , RW_ROWS = 64 / RW_SPLIT, RW_RPW = RW_ROWS / RW_CW, RW_LPR = 64 / RW_RPW  , RW_CPL = 64 / RW_LPR  ;
typedef f16 f16xc __attribute__((ext_vector_type(RW_CPL)));
struct RwIn { f16xc r, k, a, b, d; f16 v; };
__device__ __forceinline__ void rw_lds_read(RwIn& x, const LAS unsigned char* buf, int tt, int cg, int row) {
    const LAS unsigned char* p = buf + tt * 128 + cg * (RW_CPL * 2);
    x.r = *(const LAS f16xc*)(p); x.k = *(const LAS f16xc*)(p + RW_STREAM); x.a = *(const LAS f16xc*)(p + 2 * RW_STREAM); x.b = *(const LAS f16xc*)(p + 3 * RW_STREAM); x.d = *(const LAS f16xc*)(p + 4 * RW_STREAM);
    x.v = *(const LAS f16*)(buf + 5 * RW_STREAM + tt * 128 + row * 2);
}
__device__ __forceinline__ void rwkv_scan(Frame& F, int unit) {
    const int bh = unit / RW_SPLIT, part = unit % RW_SPLIT;
    const int tid = F.tid, lane = F.lane, rl = lane / RW_LPR, cg = lane % RW_LPR, b = bh >> 3, h = bh & 7, row = part * RW_ROWS + F.wave * RW_RPW + rl;
    const f16* R = WSP(f16, WS_R); const f16* KH = WSP(f16, WS_KH); const f16* KKN = WSP(f16, WS_KKN); const f16* BV = WSP(f16, WS_BV); const f16* DCY = WSP(f16, WS_DCY); const f16* VF = WSP(f16, WS_VFIN);
    f16* Y = WSP(f16, WS_YRW);
    const size_t base = (size_t)b * SEQ * 512 + h * 64;
    LAS unsigned char* lds = F.lds;
    const int ts = tid >> 3, pc = tid & 7;
    const size_t goff = base + (size_t)ts * 512 + pc * 8;
    const int loff = ts * 128 + pc * 16;
    v4u g[6];
#define RW_GLOAD(t0) do { const size_t o = goff + (size_t)(t0) * 512; const size_t oa = ((t0) + ts + 1 < SEQ) ? o + 512 : o; \
        g[0] = *(const v4u*)(R + o); g[1] = *(const v4u*)(KH + o); g[2] = *(const v4u*)(KKN + oa); g[3] = *(const v4u*)(BV + o); g[4] = *(const v4u*)(DCY + o); g[5] = *(const v4u*)(VF + o); } while (0)
#define RW_LSTORE(bufoff) do { _Pragma("unroll") for (int s_ = 0; s_ < 6; ++s_) *(LAS v4u*)(lds + (bufoff) + s_ * RW_STREAM + loff) = g[s_]; } while (0)
    typedef f16 h2 __attribute__((ext_vector_type(2)));
    h2 S2[RW_CPL / 2];
#pragma unroll
    for (int j = 0; j < RW_CPL / 2; ++j) S2[j] = (h2){(f16)0.f, (f16)0.f};
    float sa = 0.f;
    __syncthreads();
    RW_GLOAD(0); RW_LSTORE(0);
    __syncthreads();
    for (int c = 0; c < SEQ / RW_TC; ++c) {
        const int cur = (c & 1) * RW_BUF, nxt = ((c + 1) & 1) * RW_BUF; const bool more = (c + 1 < SEQ / RW_TC);
        if (more) RW_GLOAD((c + 1) * RW_TC);
        const LAS unsigned char* buf = lds + cur;
        if (F.wave < RW_CW) {
        RwIn x0, x1, x2; rw_lds_read(x0, buf, 0, cg, row); rw_lds_read(x1, buf, 1, cg, row);
        float ykeep = 0.f;
#define RW_STEP(X, TT) do { \
            const h2 sa2 = {(f16)sa, (f16)sa}, v2 = {X.v, X.v}; float yp = 0.f, sp = 0.f; \
            _Pragma("unroll") for (int j = 0; j < RW_CPL / 2; ++j) { const h2 d2 = {X.d[2 * j], X.d[2 * j + 1]}, b2 = {X.b[2 * j], X.b[2 * j + 1]}, k2 = {X.k[2 * j], X.k[2 * j + 1]}, r2 = {X.r[2 * j], X.r[2 * j + 1]}, a2 = {X.a[2 * j], X.a[2 * j + 1]}; \
                h2 sj = S2[j]; sj = __builtin_elementwise_fma(-sj, d2, sj); sj = __builtin_elementwise_fma(sa2, b2, sj); sj = __builtin_elementwise_fma(v2, k2, sj); S2[j] = sj; \
                yp = __builtin_amdgcn_fdot2(sj, r2, yp, false); sp = __builtin_amdgcn_fdot2(sj, a2, sp, false); } \
            yp = dpp_add<0xB1>(yp); sp = dpp_add<0xB1>(sp); \
            yp = dpp_add<0x4E>(yp); sp = dpp_add<0x4E>(sp); \
            if (RW_LPR >= 8) { yp = dpp_add<0x141>(yp); sp = dpp_add<0x141>(sp); } \
            if (RW_LPR >= 16) { yp = dpp_add<0x140>(yp); sp = dpp_add<0x140>(sp); } \
            sa = -sp; ykeep = (cg == ((TT) & 3)) ? yp : ykeep; } while (0)
        for (int tt = 0; tt < RW_TC; tt += 4) {
            rw_lds_read(x2, buf, (tt + 2) & (RW_TC - 1), cg, row); RW_STEP(x0, tt);
            rw_lds_read(x0, buf, (tt + 3) & (RW_TC - 1), cg, row); RW_STEP(x1, tt + 1);
            rw_lds_read(x1, buf, (tt + 4) & (RW_TC - 1), cg, row); RW_STEP(x2, tt + 2);
            rw_lds_read(x2, buf, (tt + 5) & (RW_TC - 1), cg, row); RW_STEP(x0, tt + 3);
            if (cg < 4) *(LAS f16*)(lds + RW_YOFF + (c & 1) * RW_STREAM + (tt + cg) * 128 + row * 2) = (f16)ykeep;
            x0 = x1; x1 = x2;
        }
#undef RW_STEP
        }
        if (more) RW_LSTORE(nxt);
        __syncthreads();
        if (pc >= part * (8 / RW_SPLIT) && pc < (part + 1) * (8 / RW_SPLIT)) { const v4u yv = *(const LAS v4u*)(lds + RW_YOFF + (c & 1) * RW_STREAM + loff); *(v4u*)(Y + base + (size_t)(c * RW_TC + ts) * 512 + pc * 8) = yv; }
    }
    __syncthreads();
#undef RW_GLOAD
#undef RW_LSTORE
}
__device__ __forceinline__ void s5_carry(Frame& F, int l, int idx) {
    const int p = idx & 63, g = (idx >> 6) & 31, b = idx >> 11;
    const float* a32 = WSP(float, WS_S5A32) + (size_t)((l * 32 + g) * 64 + p) * 2; const float ar = a32[0], ai = a32[1];
    const float* xe = WSP(float, WS_XEND) + ((size_t)g * S5CH + b * S5NC) * 128; bf16* u = WSP(bf16, WS_S5U) + ((size_t)g * S5CH + b * S5NC) * S5K + 512;
    float xr = 0.f, xi = 0.f;
    for (int c0 = 0; c0 < S5NC; c0 += 8) { float er[8], ei[8];
#pragma unroll
        for (int c = 0; c < 8; ++c) { er[c] = xe[(size_t)(c0 + c) * 128 + p]; ei[c] = xe[(size_t)(c0 + c) * 128 + 64 + p]; }
#pragma unroll
        for (int c = 0; c < 8; ++c) { bf16* up = u + (size_t)(c0 + c) * S5K; up[p] = (bf16)(cvt_pk_bf16(xr, 0.f) & 0xffffu); up[64 + p] = (bf16)(cvt_pk_bf16(xi, 0.f) & 0xffffu);
            const float nr = ar * xr - ai * xi + er[c], ni = ar * xi + ai * xr + ei[c]; xr = nr; xi = ni; } }
}
__device__ __forceinline__ void rwkv_post(Frame& F, int l) {
    const int lane = F.lane; const int gw = F.blk * NWAVES + F.wave, NGW = F.G * NWAVES;
    float lg[8], lb[8], rk[8]; ld8f(INP(float, 16) + l * 512 + 8 * lane, lg); ld8f(INP(float, 17) + l * 512 + 8 * lane, lb); ld8f(INP(float, 15) + l * 512 + 8 * lane, rk);
    for (int m = gw; m < M; m += NGW) { const size_t off = (size_t)m * 512 + 8 * lane; float y[8], r[8], k[8], v[8], g[8], o[8];
        f16x8_to_f32(*(const f16x8*)(WSP(f16, WS_YRW) + off), y); f16x8_to_f32(*(const f16x8*)(WSP(f16, WS_R) + off), r); f16x8_to_f32(*(const f16x8*)(WSP(f16, WS_KH) + off), k);
        f16x8_to_f32(*(const f16x8*)(WSP(f16, WS_VFIN) + off), v); bf16x8_to_f32(*(const v4u*)(WSP(bf16, WS_GL) + off), g);
        float s = 0.f, bs = 0.f;
#pragma unroll
        for (int j = 0; j < 8; ++j) { s += y[j]; bs += r[j] * k[j] * rk[j]; }
        s += __shfl_xor(s, 1); s += __shfl_xor(s, 2); s += __shfl_xor(s, 4); bs += __shfl_xor(bs, 1); bs += __shfl_xor(bs, 2); bs += __shfl_xor(bs, 4);
        const float mean = s * (1.0f / 64.0f); float q = 0.f;
#pragma unroll
        for (int j = 0; j < 8; ++j) { y[j] -= mean; q += y[j] * y[j]; }
        q += __shfl_xor(q, 1); q += __shfl_xor(q, 2); q += __shfl_xor(q, 4);
        const float rstd = 1.0f / sqrtf(q * (1.0f / 64.0f) + 64e-5f);
#pragma unroll
        for (int j = 0; j < 8; ++j) o[j] = (y[j] * rstd * lg[j] + lb[j] + bs * v[j]) * g[j];
        *(v4u*)(WSP(bf16, WS_YRW) + off) = f32_to_bf16x8(o); }
}
constexpr int PH_PER_LAYER = 12, N_PHASES = 1 + NLAYER * PH_PER_LAYER;
#ifndef MK_PER_PHASE
#define MK_PER_PHASE 0
#endif
#ifndef ABL_BRANCH
#define ABL_BRANCH -1
#endif
constexpr int NR_RWKV = 64 * RW_SPLIT;

__global__ void __launch_bounds__(NWAVES * 64, 2) mk_fwd(Args A) {
    extern __shared__ __attribute__((aligned(16))) unsigned char lds_raw[];
    volatile LAS unsigned* MISC = (volatile LAS unsigned*)((LAS unsigned char*)lds_raw + MISC_OFF);
    for (int u = threadIdx.x; u < (LDS_BYTES - LDSCTL_OFF) / 4; u += NWAVES * 64) ((LAS unsigned*)((LAS unsigned char*)lds_raw + LDSCTL_OFF))[u] = 0u;
    __syncthreads();
    XcdBarrier bar; bar.bar = (unsigned*)(A.ws + WS_CTL) + CW_BAR; bar.x = 0; bar.st = nullptr;
    if (!MK_PER_PHASE) bar = xcd_barrier_post((unsigned*)(A.ws + WS_CTL) + CW_BAR, MISC + 8);
    const int lo = A.ph_lo, hi = A.ph_hi;
#ifndef PHMASK
#define PHMASK 0xFFFF
#endif
#define PHON(k) ((PHMASK >> (k)) & 1)
#define IN(k) (lo <= (k) && (k) < hi)
#define SEAM(k) do { if (IN(k) && IN((k) + 1)) xcd_barrier(bar); } while (0)
    using pg8::gemm_phase; using pg8::StaticOrder; using pg8::LocDense;

    if (PHON(0) && IN(0)) {
        MKFRAME(F);
        p0_prologue(F);
        for (int it = F.G - 1 - F.blk; it < NLAYER * 32; it += F.G) s5_gen(F, it >> 5, it & 31);
        const int gw = F.blk * NWAVES + F.wave, NGW = F.G * NWAVES;
        for (int m = gw; m < M; m += NGW) {
#pragma unroll
            for (int j = 0; j < 4; ++j) { const f32x4 v = *(const f32x4*)(INP(float, 0) + (size_t)m * DM + 4 * F.lane + 256 * j); v2u w; w.x = cvt_pk_bf16(v[0], v[1]); w.y = cvt_pk_bf16(v[2], v[3]); *(v2u*)(WSP(bf16, WS_XB) + (size_t)m * DM + 4 * F.lane + 256 * j) = w; } }
    }
    SEAM(0);

    for (int l = 0; l < NLAYER; ++l) {
        const int pb = 1 + l * PH_PER_LAYER;
        const bool moe = (l & 1) != 0; const int li = l >> 1;
        if (PHON(1) && IN(pb + 0)) {
            asm volatile("; ==PH1");
            MKFRAME(F);
            LocDense L{WSP(bf16, WS_XB), WSP(bf16, WS_WIN) + (size_t)l * 3072 * DM, DM, DM, DM, 0, 0};
            StaticOrder S; S.init(M, 3072, 1, F.G, F.blk);
            Epi8<FProj> E{{WSP(bf16, WS_MLARAW), WSP(bf16, WS_RWRAW), WSP(bf16, WS_S5U)}};
            gemm_phase(F.lds + RING_OFF, L, S, E);
        }
        SEAM(pb + 0);
        if (PHON(2) && IN(pb + 1)) { MKFRAME(F); ph2_prep(F, l); }
        SEAM(pb + 1);
        if (PHON(3) && IN(pb + 2)) {
            asm volatile("; ==PH3");
            MKFRAME(F);
#ifndef P3SEL
#define P3SEL 31
#endif
            if (P3SEL & 1) { LocDense L{WSP(bf16, WS_CQN), WSP(bf16, WS_WUQ) + (size_t)l * 768 * 384, 384, 384, 384, 0, 0}; StaticOrder S; S.init(M, 768, 1, F.G, F.blk);
              Epi8<FQup> E{{WSP(bf16, WS_Q), WSP(float, WS_ROPE), 0.10206207261596575f * 1.4426950408889634f}}; gemm_phase(F.lds + RING_OFF, L, S, E); }
            if (P3SEL & 2) { LocDense L{WSP(bf16, WS_CKVN), WSP(bf16, WS_WUKV) + (size_t)l * 1024 * 256, 256, 256, 256, 0, 0}; StaticOrder S; S.init(M, 1024, 1, F.G, F.blk);
              Epi8<FKVup> E{{WSP(bf16, WS_K), WSP(bf16, WS_V)}}; gemm_phase(F.lds + RING_OFF, L, S, E); }
            if (P3SEL & 4) { LocDense L{WSP(bf16, WS_LORAIN), WSP(bf16, WS_WLORA) + (size_t)l * 1536 * 256, 256, 256, 256, 0, 0}; StaticOrder S; S.init(M, 1536, 1, F.G, F.blk);
              Epi8<FLora> E{{INP(float, 8) + l * 512, INP(float, 10) + l * 512, INP(float, 14) + l * 512, WSP(f16, WS_DCY), WSP(f16, WS_KH), WSP(f16, WS_KKN), WSP(f16, WS_BV), WSP(bf16, WS_GL), {}, {}}}; gemm_phase(F.lds + RING_OFF, L, S, E); }
            if ((P3SEL & 8) && l > 0) { LocDense L{WSP(bf16, WS_VRAW), WSP(bf16, WS_WVRES) + (size_t)(l - 1) * 512 * 512, 512, 512, 512, 0, 0}; StaticOrder S; S.init(M, 512, 1, F.G, F.blk);
              Epi8<FVres> E{{INP(float, 20) + (l - 1) * 512, WSP(bf16, WS_VRAW), WSP(bf16, WS_VFIRST), WSP(f16, WS_VFIN), {}}}; gemm_phase(F.lds + RING_OFF, L, S, E); }
            if (P3SEL & 16) { LocDense L{WSP(bf16, WS_S5U), WSP(bf16, WS_S5END) + (size_t)l * 32 * 256 * 512, S5K, 512, 512, (size_t)S5CH * S5K, (size_t)256 * 512}; StaticOrder S; S.init(S5CH, 256, 32, F.G, (F.blk + F.G / 2) % F.G);
              Epi8<FS5End> E{{WSP(float, WS_XEND)}}; gemm_phase(F.lds + RING_OFF, L, S, E); }
        }
        SEAM(pb + 2);
        if (PHON(4) && IN(pb + 3)) {
            asm volatile("; ==PH4");
            MKFRAME(F);
            if (F.blk < NR_RWKV && F.G > NR_RWKV) { if (A.li != -2) for (int un = F.blk; un < NBATCH * NH * RW_SPLIT; un += NR_RWKV) rwkv_scan(F, un); }
            else { const int ab = F.blk - NR_RWKV, na = F.G - NR_RWKV; if (A.li != -1) for (int idx = ab * 512 + F.tid; idx < NBATCH * 32 * 64; idx += na * 512) s5_carry(F, l, idx); }
            if (A.li != -1) {
                LAS int* slot = (LAS int*)(F.lds + AT_LDS);
                for (;;) {
                    __syncthreads();
                    if (F.tid == 0) *slot = (int)__hip_atomic_fetch_add((unsigned*)(F.ctl + CW_ATTN + 64 * l), 1u, RLX_AGENT);
                    __syncthreads();
                    const int n = *slot; if (n >= NBATCH * NH * (SEQ / AT_QR)) break;
                    const int qb = (SEQ / AT_QR - 1) - (n >> 6), bh = n & 63;
                    attn_unit(F.tid, bh >> 3, bh & 7, qb, WSP(bf16, WS_Q), WSP(bf16, WS_K), WSP(bf16, WS_V), WSP(bf16, WS_YMLA), F.lds);
                }
            }
        }
        SEAM(pb + 3);
        if (PHON(5) && IN(pb + 4)) {
            asm volatile("; ==PH5");
            MKFRAME(F);
            { LocDense L{WSP(bf16, WS_S5U), WSP(bf16, WS_S5MAIN) + (size_t)l * 32 * 512 * S5K, S5K, S5K, S5K, (size_t)S5CH * S5K, (size_t)512 * S5K}; StaticOrder S; S.init(S5CH, 512, 32, F.G, F.blk);
              Epi8<FS5Main> E{{WSP(bf16, WS_S5U), INP(float, 28) + l * 512, WSP(bf16, WS_YS5G), {}}}; gemm_phase(F.lds + RING_OFF, L, S, E); }
            rwkv_post(F, l);
        }
        SEAM(pb + 4);
        if (PHON(6) && IN(pb + 5)) {
            asm volatile("; ==PH6");
            MKFRAME(F);
            { LocDense L{WSP(bf16, WS_YS5G), WSP(bf16, WS_WGLU) + (size_t)l * 512 * 512, 512, 512, 512, 0, 0}; StaticOrder S; S.init(M, 512, 1, F.G, F.blk);
              Epi8<FGlu> E{{WSP(bf16, WS_YS5G), INP(float, 30) + l * 512, WSP(bf16, WS_YS5), {}}}; gemm_phase(F.lds + RING_OFF, L, S, E); }
            { LocDense L{WSP(bf16, WS_XB), WSP(bf16, WS_WG) + ((size_t)l * 3 + 0) * 1024 * DM, DM, DM, DM, 0, 0}; StaticOrder S; S.init(M, 2048, 1, F.G, F.blk);
              Epi8<FGate2> E{{WSP(bf16, WS_GBUF), WSP(bf16, WS_GBUF2)}}; gemm_phase(F.lds + RING_OFF, L, S, E); }
            { LocDense L{WSP(bf16, WS_YMLA), WSP(bf16, WS_WBR) + ((size_t)l * 3 + 0) * 1024 * 512, 512, 512, 512, 0, 0}; StaticOrder S; S.init(M, 1024, 1, F.G, F.blk);
              Epi8<FMerge> E{{WSP(bf16, WS_GBUF), WSP(bf16, WS_MIXED2), WSP(bf16, WS_MIXED), 1, (ABL_BRANCH == 0) ? 0.f : 1.f}}; gemm_phase(F.lds + RING_OFF, L, S, E); }
            { LocDense L{WSP(bf16, WS_YRW), WSP(bf16, WS_WBR) + ((size_t)l * 3 + 1) * 1024 * 512, 512, 512, 512, 0, 0}; StaticOrder S; S.init(M, 1024, 1, F.G, F.blk);
              Epi8<FMerge> E{{WSP(bf16, WS_GBUF2), WSP(bf16, WS_MIXED), WSP(bf16, WS_MIXED2), 0, (ABL_BRANCH == 1) ? 0.f : 1.f}}; gemm_phase(F.lds + RING_OFF, L, S, E); }
        }
        SEAM(pb + 5);
        if (PHON(7) && IN(pb + 6)) {
            asm volatile("; ==PH7");
            MKFRAME(F);
            { LocDense L{WSP(bf16, WS_XB), WSP(bf16, WS_WG) + ((size_t)l * 3 + 2) * 1024 * DM, DM, DM, DM, 0, 0}; StaticOrder S; S.init(M, 1024, 1, F.G, F.blk);
              Epi8<FGate> E{{WSP(bf16, WS_GBUF)}}; gemm_phase(F.lds + RING_OFF, L, S, E); }
            { LocDense L{WSP(bf16, WS_YS5), WSP(bf16, WS_WBR) + ((size_t)l * 3 + 2) * 1024 * 512, 512, 512, 512, 0, 0}; StaticOrder S; S.init(M, 1024, 1, F.G, F.blk);
              Epi8<FMerge> E{{WSP(bf16, WS_GBUF), WSP(bf16, WS_MIXED2), WSP(bf16, WS_MIXED), 0, (ABL_BRANCH == 2) ? 0.f : 1.f}}; gemm_phase(F.lds + RING_OFF, L, S, E); }
        }
        SEAM(pb + 6);
        if (PHON(8) && IN(pb + 7)) {
            asm volatile("; ==PH8");
            MKFRAME(F);
            LocDense L{WSP(bf16, WS_MIXED), WSP(bf16, WS_WOUT) + (size_t)l * DM * DM, DM, DM, DM, 0, 0}; StaticOrder S; S.init(M, DM, 1, F.G, F.blk);
            Epi8<FResid> E{{WSP(bf16, WS_XB), (f16*)F.out}}; gemm_phase(F.lds + RING_OFF, L, S, E);
        }
        SEAM(pb + 7);
        if (PHON(9) && IN(pb + 8)) {
            asm volatile("; ==PH9");
            MKFRAME(F);
            if (moe) { ln1_moe_phase(F, INP(float, 33) + l * DM, INP(float, 34) + l * DM, li); moe_convert(F, li); }
            else ln_phase(F, INP(float, 33) + l * DM, INP(float, 34) + l * DM);
        }
        SEAM(pb + 8);
        if (PHON(10) && IN(pb + 9)) {
            asm volatile("; ==PH10");
            MKFRAME(F);
            if (moe) {
                const unsigned* cnt = (const unsigned*)(F.ctl + CW_MOECNT + 64 * li);
                LocMoe1 L{WSP(bf16, WS_XB), WSP(bf16, WS_WMGU), DM, DM, DM, WSP(int, WS_SLOTTOK), cnt}; MoeOrder S; S.init(cnt, 2 * EXD / 256, F.G, F.blk);
                EpiGU<FSwiglu> E{{WSP(bf16, WS_HM), EXD}}; gemm_phase(F.lds + RING_OFF, L, S, E);
            } else {
                LocDense L{WSP(bf16, WS_XB), WSP(bf16, WS_WFGU) + (size_t)li * 2 * FFN * DM, DM, DM, DM, 0, 0}; StaticOrder S; S.init(M, 2 * FFN, 1, F.G, F.blk);
                EpiGU<FSwiglu> E{{WSP(bf16, WS_HB), FFN}}; gemm_phase(F.lds + RING_OFF, L, S, E);
            }
        }
        SEAM(pb + 9);
        if (PHON(11) && IN(pb + 10)) {
            asm volatile("; ==PH11");
            MKFRAME(F);
            if (moe) {
                const unsigned* cnt = (const unsigned*)(F.ctl + CW_MOECNT + 64 * li);
                LocDense L{WSP(bf16, WS_HM), WSP(bf16, WS_WMD), EXD, EXD, EXD, 0, (size_t)DM * EXD}; MoeOrder S; S.init(cnt, DM / 256, F.G, F.blk);
                Epi8<FMoeDown> E{{WSP(bf16, WS_YPAIR), WSP(float, WS_SLOTW), cnt}}; gemm_phase(F.lds + RING_OFF, L, S, E);
            } else {
                LocDense L{WSP(bf16, WS_HB), WSP(bf16, WS_WFD) + (size_t)li * DM * FFN, FFN, FFN, FFN, 0, 0}; StaticOrder S; S.init(M, DM, 1, F.G, F.blk);
                Epi8<FResid> E{{WSP(bf16, WS_XB), (f16*)F.out}}; gemm_phase(F.lds + RING_OFF, L, S, E);
            }
        }
        SEAM(pb + 10);
        if (PHON(12) && IN(pb + 11)) {
            asm volatile("; ==PH12");
            MKFRAME(F);
            if (moe) ln2_moe_phase(F, INP(float, 35) + l * DM, INP(float, 36) + l * DM, li, l == NLAYER - 1);
            else ln_phase(F, INP(float, 35) + l * DM, INP(float, 36) + l * DM);
        }
        SEAM(pb + 11);
    }
#undef IN
#undef SEAM
}

#ifdef PROBE_P
__global__ void probe_sum(const unsigned* x, unsigned long long* sums, int n) {
    __shared__ unsigned long long sh[256];
    unsigned long long s = 0;
    for (int i = blockIdx.x * blockDim.x + threadIdx.x; i < n; i += gridDim.x * blockDim.x) s += (unsigned long long)x[i] * (unsigned long long)(2 * (i & 1023) + 1);
    sh[threadIdx.x] = s; __syncthreads();
    if (threadIdx.x == 0) { unsigned long long t = 0; for (int i = 0; i < 256; ++i) t += sh[i]; sums[blockIdx.x] = t; }
}
__global__ void probe_cmp(const unsigned long long* sums, unsigned* out) {
    if (sums[threadIdx.x] != sums[1024 + threadIdx.x]) out[threadIdx.x * 4099] = 0x7fc00000u;
}
#endif
extern "C" void kernel_launch(void* const* d_in, const int* in_sizes, int n_in, void* d_out, int out_size, void* d_ws, size_t ws_size, hipStream_t stream) {
    static int grid = 0;
    if (grid == 0) {
        if (n_in != 44 || out_size != M * DM || ws_size < WS_END) { fprintf(stderr, "kernel_launch: unexpected problem (n_in %d, out %d, ws %zu < %zu)\n", n_in, out_size, ws_size, (size_t)WS_END); grid = -1; return; }
        int dev = 0, cus = 0, per_cu = 0;
        if (hipGetDevice(&dev) != hipSuccess || hipDeviceGetAttribute(&cus, hipDeviceAttributeMultiprocessorCount, dev) != hipSuccess) { grid = -1; return; }
        if (hipFuncSetAttribute((const void*)mk_fwd, hipFuncAttributeMaxDynamicSharedMemorySize, LDS_BYTES) != hipSuccess) { fprintf(stderr, "kernel_launch: hipFuncSetAttribute failed\n"); grid = -1; return; }
        if (hipOccupancyMaxActiveBlocksPerMultiprocessor(&per_cu, (const void*)mk_fwd, NWAVES * 64, LDS_BYTES) != hipSuccess || per_cu < 1) { fprintf(stderr, "kernel_launch: occupancy query says %d blocks per CU\n", per_cu); }
        (void)hipGetLastError();
        grid = cus;
        if (grid != 256) fprintf(stderr, "kernel_launch: %d CUs (built for 256)\n", grid);
    }
    if (grid < 0) return;
    (void)in_sizes;
    if (hipMemsetAsync((char*)d_ws + WS_CTL, 0, CTL_ZERO_BYTES, stream) != hipSuccess) return;
    Args a{};
    for (int i = 0; i < 44; ++i) a.in[i] = d_in[i];
    a.out = (float*)d_out; a.ws = (unsigned char*)d_ws; a.pad = 0;
#if MK_PER_PHASE
#ifdef PROBE_P
    for (int p = 0; p <= PROBE_P; ++p) { a.ph_lo = p; a.ph_hi = p + 1; a.li = p; hipLaunchKernelGGL(mk_fwd, dim3(grid), dim3(NWAVES * 64), LDS_BYTES, stream, a); }
    hipLaunchKernelGGL(probe_sum, dim3(1024), dim3(256), 0, stream, (const unsigned*)((char*)d_ws + PROBE_OFF), (unsigned long long*)((char*)d_ws + WS_END), (int)(PROBE_BYTES / 4));
    hipMemsetAsync((char*)d_ws + WS_CTL, 0, CTL_ZERO_BYTES, stream);
    for (int p = 0; p <= PROBE_P; ++p) { a.ph_lo = p; a.ph_hi = p + 1; a.li = p; hipLaunchKernelGGL(mk_fwd, dim3(grid), dim3(NWAVES * 64), LDS_BYTES, stream, a); }
    hipLaunchKernelGGL(probe_sum, dim3(1024), dim3(256), 0, stream, (const unsigned*)((char*)d_ws + PROBE_OFF), (unsigned long long*)((char*)d_ws + WS_END) + 1024, (int)(PROBE_BYTES / 4));
    for (int p = PROBE_P + 1; p < N_PHASES; ++p) { a.ph_lo = p; a.ph_hi = p + 1; a.li = p; hipLaunchKernelGGL(mk_fwd, dim3(grid), dim3(NWAVES * 64), LDS_BYTES, stream, a); }
    hipLaunchKernelGGL(probe_cmp, dim3(1), dim3(1024), 0, stream, (const unsigned long long*)((char*)d_ws + WS_END), (unsigned*)d_out);
#else
    for (int p = 0; p < N_PHASES; ++p) { a.ph_lo = p; a.ph_hi = p + 1; a.li = p; hipLaunchKernelGGL(mk_fwd, dim3(grid), dim3(NWAVES * 64), LDS_BYTES, stream, a);
#ifdef DUP_MASK
        if ((p >= 1 && ((DUP_MASK >> ((p - 1) % PH_PER_LAYER)) & 1)) || (p == 0 && ((DUP_MASK >> 12) & 1))) { hipMemsetAsync((char*)d_ws + WS_CTL + (size_t)CW_ATTN * 4, 0, 4096, stream);
#ifdef DUP_LI
            a.li = DUP_LI;
#endif
            hipLaunchKernelGGL(mk_fwd, dim3(grid), dim3(NWAVES * 64), LDS_BYTES, stream, a); }
#endif
    }
#endif
#else
    a.ph_lo = 0; a.ph_hi = N_PHASES; a.li = 0;
    hipLaunchKernelGGL(mk_fwd, dim3(grid), dim3(NWAVES * 64), LDS_BYTES, stream, a);
#endif
}
```

```cpp
#include <hip/hip_runtime.h>
#include <cstdio>
#include <cstdint>
#include <cmath>
namespace pg8 {
#define PG8_LAS __attribute__((address_space(3)))
typedef unsigned short bf16_t;
typedef short bf16x8 __attribute__((ext_vector_type(8)));
typedef float f32x4 __attribute__((ext_vector_type(4)));
typedef float f32x2 __attribute__((ext_vector_type(2)));
typedef unsigned u32x4 __attribute__((ext_vector_type(4)));
typedef unsigned u32x2 __attribute__((ext_vector_type(2)));
constexpr int BM = 256, BK = 64, HALF = 128, HTB = HALF * BK * 2  , STAGE_BYTES = 8 * HTB, NXCD = 8, WGM = 8;

__host__ __device__ __forceinline__ int lds_byte(int r, int c) { const int st = (r >> 4) * 2 + (c >> 5), rr = r & 15, cc = c & 31, ob = rr * 64 + cc * 2; return st * 1024 + (ob ^ (((ob >> 9) & 1) << 5)); }
__host__ __device__ __forceinline__ void stage_rc(int b, int& R, int& C) { const int st = b / 1024, sb = b % 1024, swz = sb ^ (((sb >> 9) & 1) << 5); R = (st >> 1) * 16 + swz / 64; C = (st & 1) * 32 + (swz % 64) / 2; }
__host__ __device__ __forceinline__ int perm32(int rho) { const int n = rho >> 4, i = rho & 15; return 8 * (i >> 2) + 4 * n + (i & 3); }

struct Unit { int pm, pn, z, aux; };

struct LocDense {
    static constexpr bool GATHER = false;
    const bf16_t* A; const bf16_t* Bt; int lda, ldb, K; size_t zA, zB;
    __device__ __forceinline__ const char* a_ptr(const Unit& u) const { return (const char*)(A + (size_t)u.z * zA + (size_t)u.pm * BM * lda); }
    __device__ __forceinline__ const char* b_ptr(const Unit& u) const { return (const char*)(Bt + (size_t)u.z * zB + (size_t)u.pn * BM * ldb); }
    __device__ __forceinline__ void a_off(const Unit&, int tid, unsigned (&v)[2][2]) const {
#pragma unroll
        for (int i = 0; i < 2; ++i) { int R, C; stage_rc(tid * 16 + i * 8192, R, C); v[0][i] = (unsigned)(R * lda + C) * 2u; v[1][i] = 0u; }
    }
};

struct StaticOrder {
    int nM, nN, nwg, nZ, G, c;
    __device__ void init(int M, int N, int Z, int G_, int c_) { nM = M / BM; nN = N / BM; nwg = nM * nN; nZ = Z; G = G_; c = c_; }
    __device__ bool next(int i, Unit& u) const {
        const long L = (long)i * G + c; if (L >= (long)nwg * nZ) return false;
        u.z = (int)(L / nwg); u.aux = 0;
        int wgid = (int)(L % nwg); { const int q = nwg / NXCD, r = nwg % NXCD, xcd = wgid % NXCD, off = wgid / NXCD; wgid = (xcd < r ? xcd * (q + 1) : r * (q + 1) + (xcd - r) * q) + off; }
        const int nig = WGM * nN, gid = wgid / nig, fm = gid * WGM, gsz = (nM - fm) < WGM ? (nM - fm) : WGM;
        u.pm = fm + ((wgid % nig) % gsz); u.pn = (wgid % nig) / gsz; return true;
    }
};

typedef float f32x2_cv __attribute__((ext_vector_type(2))); typedef __bf16 bf16x2_cv __attribute__((ext_vector_type(2)));
__device__ __forceinline__ unsigned cvt_pk_bf16(float lo, float hi) { const f32x2_cv v = {lo, hi}; const bf16x2_cv b = __builtin_convertvector(v, bf16x2_cv); return __builtin_bit_cast(unsigned, b); }
__device__ __forceinline__ u32x4 pack8(const f32x4 v0, const f32x4 v1) { u32x4 w; w.x = cvt_pk_bf16(v0[0], v0[1]); w.y = cvt_pk_bf16(v0[2], v0[3]); w.z = cvt_pk_bf16(v1[0], v1[1]); w.w = cvt_pk_bf16(v1[2], v1[3]); return w; }
__device__ __forceinline__ float bf_lo(unsigned w) { return __uint_as_float(w << 16); }
__device__ __forceinline__ float bf_hi(unsigned w) { return __uint_as_float(w & 0xffff0000u); }
__device__ __forceinline__ void unpack8(const u32x4 w, f32x4& v0, f32x4& v1) { v0 = (f32x4){bf_lo(w.x), bf_hi(w.x), bf_lo(w.y), bf_hi(w.y)}; v1 = (f32x4){bf_lo(w.z), bf_hi(w.z), bf_lo(w.w), bf_hi(w.w)}; }

struct NoPre {};
template <class F> struct Epi8 {
    static constexpr bool PERM = true;
    F f;
    __device__ __forceinline__ void operator()(const f32x4 (&acc)[2][2][4][2], const Unit& u, int wr, int wc, int fr, int fq) const {
        const int row0 = u.pm * BM + wr * 64 + fr, col0 = u.pn * BM + wc * 32 + 8 * fq;
        F g = f;
#pragma unroll
        for (int bj = 0; bj < 2; ++bj) { const int col = col0 + bj * HALF; g.begin_col(u, col);
#pragma unroll
            for (int b0 = 0; b0 < 8; b0 += F::BATCH) { typename F::Pre pr[F::BATCH];
#pragma unroll
                for (int i = 0; i < F::BATCH; ++i) { const int q = b0 + i; pr[i] = g.pre(u, row0 + (q >> 2) * HALF + (q & 3) * 16, col); }
#pragma unroll
                for (int i = 0; i < F::BATCH; ++i) { const int q = b0 + i; g.tile8(u, row0 + (q >> 2) * HALF + (q & 3) * 16, col, acc[q >> 2][bj][q & 3][0], acc[q >> 2][bj][q & 3][1], pr[i]); }
                asm volatile("" ::: "memory"); } }
    }
};
template <class F> struct EpiGU {
    static constexpr bool PERM = true;
    F f;
    __device__ __forceinline__ void operator()(const f32x4 (&acc)[2][2][4][2], const Unit& u, int wr, int wc, int fr, int fq) const {
        const int row0 = u.pm * BM + wr * 64 + fr, colh = u.pn * HALF + wc * 32 + 8 * fq;
#pragma unroll
        for (int ai = 0; ai < 2; ++ai)
#pragma unroll
            for (int m = 0; m < 4; ++m) { f.pair8(u, row0 + ai * HALF + m * 16, colh, acc[ai][0][m][0], acc[ai][0][m][1], acc[ai][1][m][0], acc[ai][1][m][1]); asm volatile("" ::: "memory"); }
    }
};

template <class Epi, class Sched, class Loc>
__device__ __forceinline__ void gemm_phase(PG8_LAS unsigned char* lds, const Loc& L, const Sched& S, const Epi& E) {
    int tid_ = threadIdx.x; asm volatile("" : "+v"(tid_));
    const int tid = tid_, wid = __builtin_amdgcn_readfirstlane(tid >> 6), lane = tid & 63, wr = wid >> 2, wc = wid & 3, fr = lane & 15, fq = lane >> 4;
    const int K = L.K, nt = K / BK;
    unsigned voffB[2];
#pragma unroll
    for (int i = 0; i < 2; ++i) { int R, C; stage_rc(tid * 16 + i * 8192, R, C); const int Rb = Epi::PERM ? ((R & ~31) + perm32(R & 31)) : R;
        voffB[i] = (unsigned)(Rb * L.ldb + C) * 2u; }
    const size_t kstep = (size_t)(BK * 2);
    const size_t hstepB = (size_t)HALF * L.ldb * 2;
    const unsigned ldsw = (unsigned)wid * 1024u;
    const int aoff = lds_byte(wr * 64 + fr, fq * 8), boff = lds_byte(wc * 32 + fr, fq * 8);
#define PG8_SA(b, h) (((b) * 2 + (h)) * HTB)
#define PG8_SB(b, h) ((4 + (b) * 2 + (h)) * HTB)
#define PG8_STAGE(bufoff, gbase, voff) do { _Pragma("unroll") for (int _i = 0; _i < 2; ++_i) \
        __builtin_amdgcn_global_load_lds((const unsigned*)((const char*)(gbase) + (voff)[_i]), (PG8_LAS unsigned*)(lds + (bufoff) + ldsw + _i * 8192), 16, 0, 0); } while (0)
#define PG8_LDA(dst, b, h) do { _Pragma("unroll") for (int m = 0; m < 4; ++m) _Pragma("unroll") for (int k = 0; k < 2; ++k) dst[m][k] = *(const PG8_LAS bf16x8*)(lds + PG8_SA(b, h) + aoff + m * 2048 + k * 1024); } while (0)
#define PG8_LDB(dst, b, h) do { _Pragma("unroll") for (int n = 0; n < 2; ++n) _Pragma("unroll") for (int k = 0; k < 2; ++k) dst[n][k] = *(const PG8_LAS bf16x8*)(lds + PG8_SB(b, h) + boff + n * 2048 + k * 1024); } while (0)
#define PG8_MMA(ai, bj, At, Bt) do { __builtin_amdgcn_s_setprio(1); _Pragma("unroll") for (int m = 0; m < 4; ++m) _Pragma("unroll") for (int n = 0; n < 2; ++n) _Pragma("unroll") for (int k = 0; k < 2; ++k) \
        acc[ai][bj][m][n] = __builtin_amdgcn_mfma_f32_16x16x32_bf16(Bt[n][k], At[m][k], acc[ai][bj][m][n], 0, 0, 0); __builtin_amdgcn_s_setprio(0); } while (0)
#define PG8_WAIT_V(n) asm volatile("s_waitcnt vmcnt(" #n ")" ::: "memory")
#define PG8_WAIT_L(n) asm volatile("s_waitcnt lgkmcnt(" #n ")" ::: "memory")
#define PG8_BAR __builtin_amdgcn_s_barrier()
#define PG8_SCHED __builtin_amdgcn_sched_barrier(0)
    Unit cur, nxt; int ui = 0;
    if (!S.next(0, cur)) return;
    f32x4 acc[2][2][4][2];
#pragma unroll
    for (int a = 0; a < 2; ++a)
#pragma unroll
        for (int b = 0; b < 2; ++b)
#pragma unroll
            for (int m = 0; m < 4; ++m)
#pragma unroll
                for (int n = 0; n < 2; ++n) acc[a][b][m][n] = (f32x4){0.f, 0.f, 0.f, 0.f};
    bf16x8 At[4][2], B0[2][2], B1[2][2];
    constexpr int NVH = Loc::GATHER ? 2 : 1;
    unsigned vc[2][2], vn[NVH][2];
    L.a_off(cur, tid, vc);
    if constexpr (Loc::GATHER) {
#pragma unroll
        for (int h = 0; h < 2; ++h)
#pragma unroll
            for (int i = 0; i < 2; ++i) vn[h][i] = vc[h][i];
    }
    const size_t hstepA = Loc::GATHER ? 0 : (size_t)HALF * L.lda * 2;
    const char* cA = L.a_ptr(cur); const char* cB = L.b_ptr(cur);
    PG8_STAGE(PG8_SB(0, 0), cB, voffB); PG8_STAGE(PG8_SB(0, 1), cB + hstepB, voffB); PG8_STAGE(PG8_SA(0, 0), cA, vc[0]); PG8_STAGE(PG8_SA(0, 1), cA + hstepA, vc[NVH - 1]);
    if (wr == 1) PG8_BAR;
    PG8_WAIT_V(2); PG8_BAR;
    PG8_STAGE(PG8_SB(1, 0), cB + kstep, voffB); PG8_STAGE(PG8_SA(1, 0), cA + kstep, vc[0]); PG8_STAGE(PG8_SB(1, 1), cB + hstepB + kstep, voffB);
    PG8_WAIT_V(6); PG8_BAR;
    for (;;) {
        const bool has_next = S.next(ui + 1, nxt);
        const char* nA = has_next ? L.a_ptr(nxt) : cA; const char* nB = has_next ? L.b_ptr(nxt) : cB;
        if constexpr (Loc::GATHER) { if (has_next) L.a_tok(nxt, tid, vn); }
        for (int t = 0; t < nt; t += 2) {
            const bool last = (t == nt - 2);
            const char* a1 = cA + (size_t)(t + 1) * kstep;
            const char* a2 = last ? nA : cA + (size_t)(t + 2) * kstep; const char* b2 = last ? nB : cB + (size_t)(t + 2) * kstep;
            const char* a3 = a2 + kstep; const char* b3 = b2 + kstep;
            PG8_LDB(B0, 0, 0); PG8_LDB(B1, 0, 1); PG8_SCHED; PG8_LDA(At, 0, 0); PG8_STAGE(PG8_SA(1, 1), a1 + hstepA, vc[NVH - 1]);
            if constexpr (Loc::GATHER) { if (last && has_next) L.a_fin(tid, vn, vc); }
            PG8_WAIT_V(8); PG8_WAIT_L(0); PG8_BAR; PG8_MMA(0, 0, At, B0); PG8_MMA(0, 1, At, B1); PG8_BAR; PG8_SCHED;
            PG8_LDA(At, 0, 1); PG8_STAGE(PG8_SB(0, 0), b2, voffB); PG8_STAGE(PG8_SB(0, 1), b2 + hstepB, voffB); PG8_STAGE(PG8_SA(0, 0), a2, vc[0]);
            PG8_WAIT_V(8); PG8_WAIT_L(0); PG8_BAR; PG8_MMA(1, 0, At, B0); PG8_MMA(1, 1, At, B1); PG8_BAR; PG8_SCHED;
            PG8_LDB(B0, 1, 0); PG8_LDB(B1, 1, 1); PG8_SCHED; PG8_LDA(At, 1, 0); PG8_STAGE(PG8_SA(0, 1), a2 + hstepA, vc[NVH - 1]);
            PG8_WAIT_V(8); PG8_WAIT_L(0); PG8_BAR; PG8_MMA(0, 0, At, B0); PG8_MMA(0, 1, At, B1); PG8_BAR; PG8_SCHED;
            PG8_LDA(At, 1, 1); PG8_STAGE(PG8_SB(1, 0), b3, voffB); PG8_STAGE(PG8_SB(1, 1), b3 + hstepB, voffB); PG8_STAGE(PG8_SA(1, 0), a3, vc[0]);
            PG8_WAIT_V(8); PG8_WAIT_L(0); PG8_BAR; PG8_MMA(1, 0, At, B0); PG8_MMA(1, 1, At, B1); PG8_BAR; PG8_SCHED;
        }
        if (wr == 0) PG8_BAR;
        E(acc, cur, wr, wc, fr, fq);
        if (!has_next) break;
#pragma unroll
        for (int a = 0; a < 2; ++a)
#pragma unroll
            for (int b = 0; b < 2; ++b)
#pragma unroll
                for (int m = 0; m < 4; ++m)
#pragma unroll
                    for (int n = 0; n < 2; ++n) acc[a][b][m][n] = (f32x4){0.f, 0.f, 0.f, 0.f};
        cur = nxt; cA = nA; cB = nB; ++ui;
        if (wr == 1) PG8_BAR;
    }
    PG8_WAIT_V(0);
    PG8_BAR;
#undef PG8_SA
#undef PG8_SB
#undef PG8_STAGE
#undef PG8_LDA
#undef PG8_LDB
#undef PG8_MMA
#undef PG8_WAIT_V
#undef PG8_WAIT_L
#undef PG8_BAR
#undef PG8_SCHED
}
}
constexpr int NWAVES = 8;
constexpr int M = 32768, DM = 1024, SEQ = 4096, NBATCH = 8, NLAYER = 4;
constexpr int NH = 8;
constexpr int IN_W = 6048;
constexpr int FFN = 2816, EXD = 3584, NEXP = 8;
constexpr float LN_EPS = 1e-5f, ALPHA = 1.681792830507429f;
constexpr int S5T = 32, S5CH = M / S5T  , S5K = 640, S5NC = SEQ / S5T  ;
constexpr int MOE_CAP = 65536;
constexpr int MOE_ROWS = 65536 + 8 * 256;

constexpr size_t MiB = 1u << 20;
constexpr size_t WS_CTL = 0, CTL_ZERO_BYTES = 1 * MiB;
constexpr size_t WS_WIN = 1 * MiB;
constexpr size_t WS_WG = 25 * MiB;
constexpr size_t WS_WUQ = 49 * MiB;
constexpr size_t WS_WUKV = 52 * MiB;
constexpr size_t WS_WLORA = 54 * MiB;
constexpr size_t WS_WVRES = 57 * MiB;
constexpr size_t WS_WGLU = 59 * MiB;
constexpr size_t WS_WBR = 61 * MiB;
constexpr size_t WS_WOUT = 73 * MiB;
constexpr size_t WS_WFGU = 81 * MiB;
constexpr size_t WS_WFD = 103 * MiB;
constexpr size_t WS_S5MAIN = 898 * MiB;
constexpr size_t WS_S5END = 978 * MiB;
constexpr size_t WS_S5A32 = 1010 * MiB;
constexpr size_t WS_ROPE = 143 * MiB;
constexpr size_t WS_XB = 147 * MiB;
constexpr size_t WS_VFIRST = 211 * MiB;
constexpr size_t RB = 243 * MiB;
constexpr size_t WS_S5U = RB + 0;
constexpr size_t WS_S1 = RB + 40 * MiB;
constexpr size_t WS_MLARAW = WS_S1;
constexpr size_t WS_RWRAW = WS_S1 + 48 * MiB;
constexpr size_t WS_Q = WS_S1;
constexpr size_t WS_V = WS_S1 + 48 * MiB;
constexpr size_t WS_BV = WS_S1 + 80 * MiB;
constexpr size_t WS_DCY = WS_S1 + 112 * MiB;
constexpr size_t WS_YS5G = WS_S1;
constexpr size_t WS_YS5 = WS_S1 + 32 * MiB;
constexpr size_t WS_MIXED = WS_S1 + 64 * MiB;
constexpr size_t WS_R = RB + 200 * MiB;
constexpr size_t WS_KH = RB + 232 * MiB;
constexpr size_t WS_KKN = RB + 264 * MiB;
constexpr size_t WS_GL = RB + 296 * MiB;
constexpr size_t WS_GBUF = RB + 264 * MiB;
constexpr size_t WS_VFIN = RB + 328 * MiB;
constexpr size_t WS_K = RB + 360 * MiB;
constexpr size_t WS_VRAW = RB + 408 * MiB;
constexpr size_t WS_YRW = WS_VRAW;
constexpr size_t WS_S2 = RB + 440 * MiB;
constexpr size_t WS_CQN = WS_S2;
constexpr size_t WS_CKVN = WS_S2 + 24 * MiB;
constexpr size_t WS_LORAIN = WS_S2 + 40 * MiB;
constexpr size_t WS_YMLA = WS_S2;
constexpr size_t WS_XEND = RB + 496 * MiB;
constexpr size_t WS_GBUF2 = RB + 512 * MiB;
constexpr size_t WS_MIXED2 = RB + 576 * MiB;
constexpr size_t WS_HB = RB + 0;
constexpr size_t WS_WMGU = RB + 0;
constexpr size_t WS_YPAIR = RB + 0;
constexpr size_t WS_HM = RB + 132 * MiB;
constexpr size_t WS_WMD = RB + 594 * MiB;
constexpr size_t WS_SLOTTOK = RB + 650 * MiB;
constexpr size_t WS_SLOTW = RB + 652 * MiB;
constexpr size_t WS_PAIRPOS = RB + 654 * MiB;
constexpr size_t WS_END = 1011 * MiB;
constexpr int CW_BAR = 4096;
constexpr int CW_ATTN = 200000;
constexpr int CW_MOECNT = 201024;

constexpr int RING_OFF = 0, RING_BYTES = 131072;
constexpr int LDSCTL_OFF = RING_BYTES, MISC_OFF = LDSCTL_OFF + 320;
constexpr int LDS_BYTES = 147456;

#define GAS __attribute__((address_space(1)))
#define LAS __attribute__((address_space(3)))
typedef unsigned short bf16;
typedef _Float16 f16;
typedef f16 f16x8 __attribute__((ext_vector_type(8)));
typedef unsigned v4u __attribute__((ext_vector_type(4)));
typedef unsigned v2u __attribute__((ext_vector_type(2)));
typedef float f32x4 __attribute__((ext_vector_type(4)));
typedef float f32x16 __attribute__((ext_vector_type(16)));
typedef short bf16x8 __attribute__((ext_vector_type(8)));
typedef short s16x4 __attribute__((ext_vector_type(4)));
typedef GAS unsigned gu32;
#define RLX_AGENT __ATOMIC_RELAXED, __HIP_MEMORY_SCOPE_AGENT
#define LDS_WAIT() asm volatile("s_waitcnt lgkmcnt(0)" ::: "memory")
using pg8::cvt_pk_bf16; using pg8::pack8; using pg8::unpack8; using pg8::bf_lo; using pg8::bf_hi;

__device__ __forceinline__ float sigm(float x) { return __builtin_amdgcn_rcpf(1.0f + __expf(-x)); }
__device__ __forceinline__ float gelu_tanh(float y) { const float u = 0.7978845608028654f * (y + 0.044715f * y * y * y); const float t = 1.0f - 2.0f * __builtin_amdgcn_rcpf(__expf(2.0f * u) + 1.0f); return 0.5f * y * (1.0f + t); }
__device__ __forceinline__ float wave_sum(float v) {
#pragma unroll
    for (int o = 1; o < 64; o <<= 1) v += __shfl_xor(v, o);
    return v;
}
__device__ __forceinline__ v4u ld_nt16(const void* p) { return __builtin_nontemporal_load((const v4u*)p); }
__device__ __forceinline__ void f16x8_to_f32(const f16x8 h, float (&o)[8]) {
#pragma unroll
    for (int j = 0; j < 8; ++j) o[j] = (float)h[j];
}
__device__ __forceinline__ f16x8 f32_to_f16x8(const float (&v)[8]) { f16x8 h;
#pragma unroll
    for (int j = 0; j < 8; ++j) h[j] = (f16)v[j];
    return h; }
__device__ __forceinline__ void bf16x8_to_f32(const v4u w, float (&o)[8]) { o[0] = bf_lo(w.x); o[1] = bf_hi(w.x); o[2] = bf_lo(w.y); o[3] = bf_hi(w.y); o[4] = bf_lo(w.z); o[5] = bf_hi(w.z); o[6] = bf_lo(w.w); o[7] = bf_hi(w.w); }
__device__ __forceinline__ v4u f32_to_bf16x8(const float (&v)[8]) { v4u w; w.x = cvt_pk_bf16(v[0], v[1]); w.y = cvt_pk_bf16(v[2], v[3]); w.z = cvt_pk_bf16(v[4], v[5]); w.w = cvt_pk_bf16(v[6], v[7]); return w; }
__device__ __forceinline__ void ld8f(const float* p, float (&o)[8]) { const f32x4 a = *(const f32x4*)p, b = *(const f32x4*)(p + 4); o[0] = a[0]; o[1] = a[1]; o[2] = a[2]; o[3] = a[3]; o[4] = b[0]; o[5] = b[1]; o[6] = b[2]; o[7] = b[3]; }

#define XB_TMO      128
#define XB_XCNT(j)  (256  + 64 * (j))
#define XB_XSUB(j)  (1280 + 64 * (j))
#define XB_XGEN(j)  (2304 + 64 * (j))
#define XB_TOP      3328
#define XB_TOPGEN   3392
#define XCD_BAR_WORDS 3456
#define XB_SPIN_CAP (1u << 20)

__device__ __forceinline__ unsigned xb_ld(unsigned* p)              { return __hip_atomic_load(p, __ATOMIC_RELAXED, __HIP_MEMORY_SCOPE_AGENT); }
__device__ __forceinline__ unsigned xb_add(unsigned* p, unsigned v) { return __hip_atomic_fetch_add(p, v, __ATOMIC_RELAXED, __HIP_MEMORY_SCOPE_AGENT); }
__device__ __forceinline__ unsigned xb_xcc_id() { return (unsigned)__builtin_amdgcn_s_getreg((3 << 11) | 20) & 0xFu; }
#define XB_SPIN(cond, bar) do { unsigned _sp = 0; while (cond) { __builtin_amdgcn_s_sleep(1); \
    if ((++_sp & 255u) == 0u) { if (xb_ld(&(bar)[XB_TMO])) break; if (_sp > XB_SPIN_CAP) { atomicAdd(&(bar)[XB_TMO], 1u); break; } } } } while (0)

struct XcdBarrier { unsigned* bar; unsigned x; volatile LAS unsigned* st; };

__device__ __forceinline__ XcdBarrier xcd_barrier_post(unsigned* bar, volatile LAS unsigned* st) {
    XcdBarrier b; b.bar = bar; b.x = xb_xcc_id(); b.st = st;
    if (threadIdx.x == 0) (void)xb_add(&bar[XB_XCNT(b.x)], 1u);
    return b;
}
__device__ __forceinline__ void xcd_barrier_complete(unsigned* bar, unsigned x, unsigned& nloc, unsigned& nx) {
    const unsigned G = gridDim.x * gridDim.y * gridDim.z;
    unsigned sum, cnt, mine, sp = 0u;
    for (;;) {
        sum = 0u; cnt = 0u; mine = 0u;
#pragma unroll
        for (unsigned j = 0; j < 16; ++j) { const unsigned c = xb_ld(&bar[XB_XCNT(j)]); sum += c; cnt += (c > 0u) ? 1u : 0u; mine = (j == x) ? c : mine; }
        if (sum == G) break;
        __builtin_amdgcn_s_sleep(1);
        if ((++sp & 255u) == 0u) { if (xb_ld(&bar[XB_TMO])) break; if (sp > XB_SPIN_CAP) { atomicAdd(&bar[XB_TMO], 1u); break; } }
    }
    nloc = mine > 0u ? mine : 1u; nx = cnt > 0u ? cnt : 1u;
}
__device__ __forceinline__ void xcd_barrier(const XcdBarrier& b) {
    asm volatile("s_waitcnt vmcnt(0)" ::: "memory");
    __syncthreads();
    if (threadIdx.x == 0) {
        unsigned* bar = b.bar;
        __builtin_amdgcn_s_waitcnt(0);
        unsigned nloc = b.st[0], nx = b.st[1];
        if (nloc == 0u) { xcd_barrier_complete(bar, b.x, nloc, nx); b.st[0] = nloc; b.st[1] = nx; }
        const unsigned old = xb_add(&bar[XB_XSUB(b.x)], 1u);
        const unsigned gen = old / nloc;
        if (old + 1u == (gen + 1u) * nloc) {
            __builtin_amdgcn_fence(__ATOMIC_RELEASE, "agent");
            asm volatile("s_waitcnt vmcnt(0)" ::: "memory");
            const unsigned og = xb_add(&bar[XB_TOP], 1u);
            const unsigned tg = og / nx;
            if (og + 1u == (tg + 1u) * nx) xb_add(&bar[XB_TOPGEN], 1u);
            else XB_SPIN(xb_ld(&bar[XB_TOPGEN]) == tg, bar);
            __builtin_amdgcn_fence(__ATOMIC_ACQUIRE, "agent");
            xb_add(&bar[XB_XGEN(b.x)], 1u);
            asm volatile("s_waitcnt vmcnt(0)" ::: "memory");
        } else {
            XB_SPIN(xb_ld(&bar[XB_XGEN(b.x)]) == gen, bar);
            __builtin_amdgcn_fence(__ATOMIC_ACQUIRE, "agent");
            asm volatile("s_waitcnt vmcnt(0)" ::: "memory");
        }
    }
    __syncthreads();
}

struct Args { const void* in[44]; float* out; unsigned char* ws; int ph_lo, ph_hi, li, pad; };
typedef const __attribute__((address_space(4))) Args* KArgs;
struct Frame {
    LAS unsigned char* lds;
    unsigned char* ws;
    gu32* ctl;
    int tid, lane, wave;
    int G, blk;
    float* out;
    KArgs ka;
};
#define MKFRAME(F) Frame F; { int t_ = threadIdx.x; asm volatile("" : "+v"(t_)); KArgs k_ = (KArgs)__builtin_amdgcn_kernarg_segment_ptr(); asm volatile("" : "+s"(k_)); \
    F.lds = (LAS unsigned char*)lds_raw; F.ka = k_; F.ws = k_->ws; F.ctl = (gu32*)(k_->ws + WS_CTL); F.out = k_->out; F.tid = t_; F.lane = t_ & 63; F.wave = __builtin_amdgcn_readfirstlane(t_ >> 6); F.G = gridDim.x; F.blk = blockIdx.x; }
#define WSP(T, off) ((T*)(F.ws + (off)))
#define INP(T, i) ((const T*)F.ka->in[i])
using pg8::Unit; using pg8::Epi8; using pg8::EpiGU;
__device__ __forceinline__ void f4x2_to8(const f32x4 v0, const f32x4 v1, float (&o)[8]) { o[0] = v0[0]; o[1] = v0[1]; o[2] = v0[2]; o[3] = v0[3]; o[4] = v1[0]; o[5] = v1[1]; o[6] = v1[2]; o[7] = v1[3]; }

struct FProj {
    static constexpr int BATCH = 8; bf16* mla; bf16* rw; bf16* s5u;
    __device__ __forceinline__ void begin_col(const Unit&, int) {}
    typedef pg8::NoPre Pre; __device__ __forceinline__ Pre pre(const Unit&, int, int) const { return Pre{}; }
    __device__ __forceinline__ void tile8(const Unit&, int row, int col, const f32x4 v0, const f32x4 v1, const Pre&) const {
        const v4u w = pack8(v0, v1);
        if (col < 768) *(v4u*)(mla + (unsigned)row * 768 + col) = w;
        else if (col < 2560) *(v4u*)(rw + (unsigned)row * 1792 + (col - 768)) = w;
        else { const int c = col - 2560, g = c >> 4, i = c & 15; *(v4u*)(s5u + (unsigned)((g * S5CH + (row >> 5)) * S5K) + (row & 31) * 16 + i) = w; }
    }
};
struct FQup {
    static constexpr int BATCH = 4; bf16* Q; const float* cs; float qs;
    struct Pre { f32x4 c, s; };
    __device__ __forceinline__ void begin_col(const Unit&, int) {}
    __device__ __forceinline__ Pre pre(const Unit&, int row, int col) const { Pre p; const int head = col / 96, w = (col - head * 96) >> 3;
        if (w >= 8) { const int i0 = (w - 8) * 4; p.c = *(const f32x4*)(cs + (unsigned)row * 32 + i0); p.s = *(const f32x4*)(cs + (unsigned)row * 32 + 16 + i0); } else { p.c = (f32x4){0.f, 0.f, 0.f, 0.f}; p.s = p.c; } return p; }
    __device__ __forceinline__ void tile8(const Unit&, int row, int col, const f32x4 v0, const f32x4 v1, const Pre& p) const {
        const int head = col / 96, w = (col - head * 96) >> 3;
        bf16* q = Q + (unsigned)row * 768 + head * 96;
        if (w < 8) { *(v4u*)(q + 8 * w) = pack8(v0 * qs, v1 * qs); }
        else { const int i0 = (w - 8) * 4; const f32x4 c = p.c, s = p.s;
            const f32x4 x1 = (f32x4){v0[0], v0[2], v1[0], v1[2]}, x2 = (f32x4){v0[1], v0[3], v1[1], v1[3]};
            const f32x4 o1 = (x1 * c - x2 * s) * qs, o2 = (x1 * s + x2 * c) * qs;
            v2u a, b; a.x = cvt_pk_bf16(o1[0], o1[1]); a.y = cvt_pk_bf16(o1[2], o1[3]); b.x = cvt_pk_bf16(o2[0], o2[1]); b.y = cvt_pk_bf16(o2[2], o2[3]);
            *(v2u*)(q + 64 + i0) = a; *(v2u*)(q + 80 + i0) = b; }
    }
};
struct FKVup {
    static constexpr int BATCH = 8; bf16* K; bf16* V;
    __device__ __forceinline__ void begin_col(const Unit&, int) {}
    typedef pg8::NoPre Pre; __device__ __forceinline__ Pre pre(const Unit&, int, int) const { return Pre{}; }
    __device__ __forceinline__ void tile8(const Unit&, int row, int col, const f32x4 v0, const f32x4 v1, const Pre&) const {
        const int head = col >> 7, d = col & 127; const v4u w = pack8(v0, v1);
        if (d < 64) *(v4u*)(K + (unsigned)row * 768 + head * 96 + d) = w; else *(v4u*)(V + (unsigned)row * 512 + head * 64 + (d - 64)) = w;
    }
};
struct FLora {
    static constexpr int BATCH = 4;
    const float* w0; const float* a0; const float* k_a; f16* dcy; f16* kh; const f16* kkn; f16* bv; bf16* gl; float p[8], ka[8];
    struct Pre { f16x8 k, kn; };
    __device__ __forceinline__ void begin_col(const Unit&, int col) { const int seg = col >> 9, c = col & 511; ld8f(((seg == 0) ? w0 : a0) + c, p); ld8f(k_a + c, ka); }
    __device__ __forceinline__ Pre pre(const Unit&, int row, int col) const { Pre r; const unsigned off = (unsigned)row * 512 + (col & 511);
        if ((col >> 9) == 1) { r.k = *(const f16x8*)(kh + off); r.kn = *(const f16x8*)(kkn + off); } else { r.k = (f16x8)(0); r.kn = (f16x8)(0); } return r; }
    __device__ __forceinline__ void tile8(const Unit&, int row, int col, const f32x4 v0, const f32x4 v1, const Pre& pr) const {
        float a[8]; f4x2_to8(v0, v1, a);
        const int seg = col >> 9, c = col & 511; const unsigned off = (unsigned)row * 512 + c;
        if (seg == 0) { float o[8];
#pragma unroll
            for (int j = 0; j < 8; ++j) { const float e = 0.6065306597126334f * sigm(p[j] + a[j]); o[j] = -expm1f(-e); }
            *(f16x8*)(dcy + off) = f32_to_f16x8(o); }
        else if (seg == 1) { float k[8], kn[8]; f16x8_to_f32(pr.k, k); f16x8_to_f32(pr.kn, kn); float o1[8], o2[8];
#pragma unroll
            for (int j = 0; j < 8; ++j) { const float ic = sigm(p[j] + a[j]); o1[j] = k[j] * (1.0f + (ic - 1.0f) * ka[j]); o2[j] = kn[j] * ic; }
            *(f16x8*)(kh + off) = f32_to_f16x8(o1); *(f16x8*)(bv + off) = f32_to_f16x8(o2); }
        else { *(v4u*)(gl + off) = pack8(v0, v1); }
    }
};
struct FVres {
    static constexpr int BATCH = 4;
    const float* vb; const bf16* vraw; const bf16* vfirst; f16* vfin; float p[8];
    struct Pre { v4u v, vf; };
    __device__ __forceinline__ void begin_col(const Unit&, int col) { ld8f(vb + col, p); }
    __device__ __forceinline__ Pre pre(const Unit&, int row, int col) const { Pre r; const unsigned off = (unsigned)row * 512 + col; r.v = *(const v4u*)(vraw + off); r.vf = *(const v4u*)(vfirst + off); return r; }
    __device__ __forceinline__ void tile8(const Unit&, int row, int col, const f32x4 v0, const f32x4 v1, const Pre& pr) const {
        float a[8], v[8], vf[8], o[8]; f4x2_to8(v0, v1, a); const unsigned off = (unsigned)row * 512 + col;
        bf16x8_to_f32(pr.v, v); bf16x8_to_f32(pr.vf, vf);
#pragma unroll
        for (int j = 0; j < 8; ++j) o[j] = v[j] + (vf[j] - v[j]) * sigm(p[j] + a[j]);
        *(f16x8*)(vfin + off) = f32_to_f16x8(o);
    }
};
struct FS5End {
    static constexpr int BATCH = 8; float* xend;
    __device__ __forceinline__ void begin_col(const Unit&, int) {}
    typedef pg8::NoPre Pre; __device__ __forceinline__ Pre pre(const Unit&, int, int) const { return Pre{}; }
    __device__ __forceinline__ void tile8(const Unit& u, int row, int col, const f32x4 v0, const f32x4 v1, const Pre&) const {
        if (col < 128) { float* p = xend + (unsigned)((u.z * S5CH + row) * 128 + col); *(f32x4*)p = v0; *(f32x4*)(p + 4) = v1; }
    }
};
struct FS5Main {
    static constexpr int BATCH = 8;
    const bf16* s5u; const float* dvec; bf16* ys5g; float d[8];
    struct Pre { v4u uu; };
    __device__ __forceinline__ void begin_col(const Unit& u, int col) { ld8f(dvec + u.z * 16 + (col & 15), d); }
    __device__ __forceinline__ Pre pre(const Unit& u, int row, int col) const { Pre r; r.uu = *(const v4u*)(s5u + (unsigned)((u.z * S5CH + row) * S5K + col)); return r; }
    __device__ __forceinline__ void tile8(const Unit& u, int row, int col, const f32x4 v0, const f32x4 v1, const Pre& pr) const {
        float a[8], uu[8], o[8]; f4x2_to8(v0, v1, a); const int g = u.z, t = col >> 4, o0 = col & 15;
        bf16x8_to_f32(pr.uu, uu);
#pragma unroll
        for (int j = 0; j < 8; ++j) o[j] = gelu_tanh(a[j] + d[j] * uu[j]);
        *(v4u*)(ys5g + ((unsigned)row * 32 + t) * 512 + g * 16 + o0) = f32_to_bf16x8(o);
    }
};
struct FGlu {
    static constexpr int BATCH = 8;
    const bf16* ys5g; const float* bglu; bf16* ys5; float b[8];
    struct Pre { v4u y; };
    __device__ __forceinline__ void begin_col(const Unit&, int col) { ld8f(bglu + col, b); }
    __device__ __forceinline__ Pre pre(const Unit&, int row, int col) const { Pre r; r.y = *(const v4u*)(ys5g + (unsigned)row * 512 + col); return r; }
    __device__ __forceinline__ void tile8(const Unit&, int row, int col, const f32x4 v0, const f32x4 v1, const Pre& pr) const {
        float a[8], y[8], o[8]; f4x2_to8(v0, v1, a); const unsigned off = (unsigned)row * 512 + col; bf16x8_to_f32(pr.y, y);
#pragma unroll
        for (int j = 0; j < 8; ++j) o[j] = y[j] * sigm(a[j] + b[j]);
        *(v4u*)(ys5 + off) = f32_to_bf16x8(o);
    }
};
struct FGate {
    static constexpr int BATCH = 8; bf16* gbuf;
    __device__ __forceinline__ void begin_col(const Unit&, int) {}
    typedef pg8::NoPre Pre; __device__ __forceinline__ Pre pre(const Unit&, int, int) const { return Pre{}; }
    __device__ __forceinline__ void tile8(const Unit&, int row, int col, const f32x4 v0, const f32x4 v1, const Pre&) const {
        float a[8], o[8]; f4x2_to8(v0, v1, a);
#pragma unroll
        for (int j = 0; j < 8; ++j) o[j] = sigm(a[j]);
        *(v4u*)(gbuf + (unsigned)row * 1024 + col) = f32_to_bf16x8(o);
    }
};
struct FGate2 {
    static constexpr int BATCH = 8; bf16* g0; bf16* g1;
    __device__ __forceinline__ void begin_col(const Unit&, int) {}
    typedef pg8::NoPre Pre; __device__ __forceinline__ Pre pre(const Unit&, int, int) const { return Pre{}; }
    __device__ __forceinline__ void tile8(const Unit&, int row, int col, const f32x4 v0, const f32x4 v1, const Pre&) const {
        float a[8], o[8]; f4x2_to8(v0, v1, a);
#pragma unroll
        for (int j = 0; j < 8; ++j) o[j] = sigm(a[j]);
        bf16* g = (col < 1024) ? g0 : g1;
        *(v4u*)(g + (unsigned)row * 1024 + (col & 1023)) = f32_to_bf16x8(o);
    }
};
struct FMerge {
    static constexpr int BATCH = 8; const bf16* gbuf; const bf16* min_; bf16* mout; int first;
    struct Pre { v4u g, m; };
    __device__ __forceinline__ void begin_col(const Unit&, int) {}
    __device__ __forceinline__ Pre pre(const Unit&, int row, int col) const { Pre r; const unsigned off = (unsigned)row * 1024 + col; r.g = *(const v4u*)(gbuf + off); if (!first) r.m = *(const v4u*)(min_ + off); else r.m = (v4u){0u, 0u, 0u, 0u}; return r; }
    __device__ __forceinline__ void tile8(const Unit&, int row, int col, const f32x4 v0, const f32x4 v1, const Pre& pr) const {
        float a[8], g[8], mprev[8], o[8]; f4x2_to8(v0, v1, a); const unsigned off = (unsigned)row * 1024 + col; bf16x8_to_f32(pr.g, g); bf16x8_to_f32(pr.m, mprev);
#pragma unroll
        for (int j = 0; j < 8; ++j) o[j] = mprev[j] + g[j] * a[j];
        *(v4u*)(mout + off) = f32_to_bf16x8(o);
    }
};
struct FResid {
    static constexpr int BATCH = 8; const bf16* xin; f16* xout;
    struct Pre { v4u x; };
    __device__ __forceinline__ void begin_col(const Unit&, int) {}
    __device__ __forceinline__ Pre pre(const Unit&, int row, int col) const { Pre r; r.x = *(const v4u*)(xin + (unsigned)row * 1024 + col); return r; }
    __device__ __forceinline__ void tile8(const Unit&, int row, int col, const f32x4 v0, const f32x4 v1, const Pre& pr) const {
        float x[8], a[8], o[8]; bf16x8_to_f32(pr.x, x); f4x2_to8(v0, v1, a);
#pragma unroll
        for (int j = 0; j < 8; ++j) o[j] = x[j] * ALPHA + a[j];
        *(f16x8*)(xout + (unsigned)row * 1024 + col) = f32_to_f16x8(o);
    }
};
struct FSwiglu {
    bf16* h; int ldh;
    __device__ __forceinline__ void pair8(const Unit&, int row, int colh, const f32x4 g0, const f32x4 g1, const f32x4 u0, const f32x4 u1) const {
        float g[8], uu[8], o[8]; f4x2_to8(g0, g1, g); f4x2_to8(u0, u1, uu);
#pragma unroll
        for (int j = 0; j < 8; ++j) o[j] = g[j] * sigm(g[j]) * uu[j];
        *(v4u*)(h + (unsigned)row * ldh + colh) = f32_to_bf16x8(o);
    }
};
struct FMoeDown {
    static constexpr int BATCH = 8; bf16* ypair; const float* slotw; const unsigned* cnt;
    struct Pre { float w; };
    __device__ __forceinline__ void begin_col(const Unit&, int) {}
    __device__ __forceinline__ Pre pre(const Unit& u, int row, int) const { Pre r; const int rk = u.aux + (row - u.pm * 256); r.w = ((unsigned)rk < cnt[u.z]) ? slotw[(unsigned)(u.z * MOE_CAP + rk)] : 0.f; return r; }
    __device__ __forceinline__ void tile8(const Unit& u, int row, int col, const f32x4 v0, const f32x4 v1, const Pre& pr) const {
        const int rk = u.aux + (row - u.pm * 256);
        if ((unsigned)rk < cnt[u.z]) *(v4u*)(ypair + (unsigned)row * 1024 + col) = pack8(v0 * pr.w, v1 * pr.w);
    }
};

struct MoeOrder {
    int nN, G, c; int pt[NEXP + 1];
    __device__ void init(const unsigned* cnt, int nN_, int G_, int c_) { nN = nN_; G = G_; c = c_; pt[0] = 0;
#pragma unroll
        for (int e = 0; e < NEXP; ++e) pt[e + 1] = pt[e] + (int)((cnt[e] + 255u) >> 8); }
    __device__ bool next(int i, Unit& u) const {
        const int nM = pt[NEXP], nwg = nM * nN; const long L = (long)i * G + c; if (L >= (long)nwg) return false;
        int wgid = (int)L; { const int q = nwg / pg8::NXCD, r = nwg % pg8::NXCD, xcd = wgid % pg8::NXCD, off = wgid / pg8::NXCD; wgid = (xcd < r ? xcd * (q + 1) : r * (q + 1) + (xcd - r) * q) + off; }
        const int nig = pg8::WGM * nN, gid = wgid / nig, fm = gid * pg8::WGM, gsz = (nM - fm) < pg8::WGM ? (nM - fm) : pg8::WGM;
        const int tile = fm + ((wgid % nig) % gsz); u.pn = (wgid % nig) / gsz; int e = 0;
#pragma unroll
        for (int k = 1; k < NEXP; ++k) e += (tile >= pt[k]) ? 1 : 0;
        int base = 0;
#pragma unroll
        for (int k = 1; k < NEXP; ++k) base = (tile >= pt[k]) ? pt[k] : base;
        u.z = e; u.pm = tile; u.aux = (tile - base) * 256; return true;
    }
};
struct LocMoe1 {
    static constexpr bool GATHER = true;
    const bf16* A; const bf16* Bt; int lda, ldb, K; const int* slot_tok; const unsigned* cnt;
    __device__ __forceinline__ const char* a_ptr(const Unit&) const { return (const char*)A; }
    __device__ __forceinline__ const char* b_ptr(const Unit& u) const { return (const char*)(Bt + (size_t)u.z * (2 * EXD) * DM + (size_t)u.pn * 256 * ldb); }
    __device__ __forceinline__ void a_tok(const Unit& u, int tid, unsigned (&v)[2][2]) const {
        const unsigned n = cnt[u.z];
#pragma unroll
        for (int i = 0; i < 2; ++i) { int R, C; pg8::stage_rc(tid * 16 + i * 8192, R, C);
#pragma unroll
            for (int h = 0; h < 2; ++h) { const int r = u.aux + h * 128 + R; v[h][i] = ((unsigned)r < n) ? (unsigned)slot_tok[(unsigned)(u.z * MOE_CAP + r)] : 0u; } }
    }
    __device__ __forceinline__ void a_fin(int tid, const unsigned (&t)[2][2], unsigned (&v)[2][2]) const {
#pragma unroll
        for (int i = 0; i < 2; ++i) { int R, C; pg8::stage_rc(tid * 16 + i * 8192, R, C);
#pragma unroll
            for (int h = 0; h < 2; ++h) v[h][i] = (t[h][i] * (unsigned)lda + (unsigned)C) * 2u; }
    }
    __device__ __forceinline__ void a_off(const Unit& u, int tid, unsigned (&v)[2][2]) const { unsigned t[2][2]; a_tok(u, tid, t); a_fin(tid, t, v); }
};
__device__ __forceinline__ int qperm_row(int n) { const int h = n / 96, d = n - h * 96; if (d < 64) return n; const int e = d - 64; return h * 96 + 64 + ((e < 16) ? 2 * e : 2 * (e - 16) + 1); }
struct TrDesc { const float* W; const float* ksc; bf16* WT; int ldw, k0, n0, ldd, kdst, drow0, qperm; };
struct TrRegs { f32x4 v[8]; };
__device__ __forceinline__ void tr_load(const TrDesc& d, TrRegs& r, int lane) {
    if (d.W) {
#pragma unroll
        for (int i = 0; i < 8; ++i) { const int kk = (lane >> 3) + 8 * i; f32x4 v = *(const f32x4*)(d.W + (size_t)(d.k0 + kk) * d.ldw + d.n0 + 4 * (lane & 7)); if (d.ksc) v = v * d.ksc[d.k0 + kk]; r.v[i] = v; }
    } else {
#pragma unroll
        for (int i = 0; i < 8; ++i) r.v[i] = (f32x4){0.f, 0.f, 0.f, 0.f};
    }
}
__device__ __forceinline__ void tr_finish(const TrDesc& d, const TrRegs& r, LAS float* scr, int lane) {
#pragma unroll
    for (int i = 0; i < 8; ++i) { const int kk = (lane >> 3) + 8 * i; LAS float* s = scr + kk * 33 + 4 * (lane & 7); s[0] = r.v[i][0]; s[1] = r.v[i][1]; s[2] = r.v[i][2]; s[3] = r.v[i][3]; }
    LDS_WAIT(); asm volatile("" ::: "memory");
    const int c = lane & 7;
#pragma unroll
    for (int j = 0; j < 4; ++j) { const int n = (lane >> 3) + 8 * j; const LAS float* s = scr + (8 * c) * 33 + n;
        v4u o; o.x = cvt_pk_bf16(s[0 * 33], s[1 * 33]); o.y = cvt_pk_bf16(s[2 * 33], s[3 * 33]); o.z = cvt_pk_bf16(s[4 * 33], s[5 * 33]); o.w = cvt_pk_bf16(s[6 * 33], s[7 * 33]);
        const int dr = d.qperm ? qperm_row(d.n0 + n) : (d.drow0 + n);
        *(v4u*)(d.WT + (size_t)dr * d.ldd + d.kdst + 8 * c) = o; }
    LDS_WAIT(); asm volatile("" ::: "memory");
}
__device__ __forceinline__ bool trjob(int& r, TrDesc& d, const float* W, int ldw, int K, int c0, int ncols, const float* ksc, bf16* WT, int ldd, int drow0) {
    const int nb = ncols / 32, ni = (K / 64) * nb; if (r < ni) { const int kb = r / nb, nbi = r % nb; d = TrDesc{W, ksc, WT, ldw, 64 * kb, c0 + 32 * nbi, ldd, 64 * kb, drow0 + 32 * nbi, 0}; return true; } r -= ni; return false; }
__device__ __forceinline__ bool trjob_gu(int& r, TrDesc& d, const float* W, int ldw, int K, int ncols, bf16* WT, int ldd, int up) {
    const int nb = ncols / 32, ni = (K / 64) * nb; if (r < ni) { const int kb = r / nb, n0 = 32 * (r % nb); d = TrDesc{W, nullptr, WT, ldw, 64 * kb, n0, ldd, 64 * kb, (n0 >> 7) * 256 + (n0 & 127) + (up ? 128 : 0), 0}; return true; } r -= ni; return false; }

constexpr int TR_PER_LAYER = 16 * 189 + 6 * 24 + 4 * 32 + 192 + 8 * 16 + 3 * 8 * 32 + 16 * 32 + 3 * 16;
constexpr int TR_PER_FFN = 3 * 16 * 88, TR_PROLOGUE = NLAYER * TR_PER_LAYER + 2 * TR_PER_FFN;
__device__ __forceinline__ void tr_decode_prologue(Frame& F, int it, TrDesc& d) {
    if (it < NLAYER * TR_PER_LAYER) {
        const int l = it / TR_PER_LAYER; int r = it % TR_PER_LAYER;
        const float* win = INP(float, 2) + (size_t)l * DM * IN_W;
        bf16* win_t = WSP(bf16, WS_WIN) + (size_t)l * 3072 * DM; bf16* wg_t = WSP(bf16, WS_WG) + (size_t)l * 3072 * DM;
        if (trjob(r, d, win, IN_W, DM, 0, 672, nullptr, win_t, DM, 0)) return;
        if (trjob(r, d, win, IN_W, DM, 672, 2304, nullptr, win_t, DM, 768)) return;
        if (trjob(r, d, win, IN_W, DM, 2976, 3072, nullptr, wg_t, DM, 0)) return;
        if (r < 48) { d = TrDesc{nullptr, nullptr, win_t, 0, 64 * (r / 3), 0, DM, 64 * (r / 3), 672 + 32 * (r % 3), 0}; return; } r -= 48;
        if (r < 144) { const int kb = r / 24, nbi = r % 24; d = TrDesc{INP(float, 4) + (size_t)l * 384 * 768, INP(float, 3) + l * 384, WSP(bf16, WS_WUQ) + (size_t)l * 768 * 384, 768, 64 * kb, 32 * nbi, 384, 64 * kb, 0, 1}; return; } r -= 144;
        if (trjob(r, d, INP(float, 6) + (size_t)l * 256 * 1024, 1024, 256, 0, 1024, INP(float, 5) + l * 256, WSP(bf16, WS_WUKV) + (size_t)l * 1024 * 256, 256, 0)) return;
        if (r < 192) { const int rb = r / 4, kb = r % 4; bf16* wl = WSP(bf16, WS_WLORA) + (size_t)l * 1536 * 256; const float* src = nullptr; int k0 = 0, n0 = 0;
            if (rb < 16) { if (kb == 0) { src = INP(float, 9) + (size_t)l * 64 * 512; n0 = 32 * rb; } }
            else if (rb < 32) { if (kb == 1) { src = INP(float, 11) + (size_t)l * 64 * 512; n0 = 32 * (rb - 16); } }
            else { if (kb >= 2) { src = INP(float, 12) + (size_t)l * 128 * 512; k0 = 64 * (kb - 2); n0 = 32 * (rb - 32); } }
            d = TrDesc{src, nullptr, wl, 512, k0, n0, 256, 64 * kb, 32 * rb, 0}; return; } r -= 192;
        if (trjob(r, d, INP(float, 29) + (size_t)l * 512 * 512, 512, 512, 0, 512, nullptr, WSP(bf16, WS_WGLU) + (size_t)l * 512 * 512, 512, 0)) return;
        if (trjob(r, d, INP(float, 31) + (size_t)(l * 3 + 0) * 512 * 1024, 1024, 512, 0, 1024, nullptr, WSP(bf16, WS_WBR) + (size_t)(l * 3 + 0) * 1024 * 512, 512, 0)) return;
        if (trjob(r, d, INP(float, 31) + (size_t)(l * 3 + 1) * 512 * 1024, 1024, 512, 0, 1024, nullptr, WSP(bf16, WS_WBR) + (size_t)(l * 3 + 1) * 1024 * 512, 512, 0)) return;
        if (trjob(r, d, INP(float, 31) + (size_t)(l * 3 + 2) * 512 * 1024, 1024, 512, 0, 1024, nullptr, WSP(bf16, WS_WBR) + (size_t)(l * 3 + 2) * 1024 * 512, 512, 0)) return;
        (void)trjob(r, d, INP(float, 32) + (size_t)l * DM * DM, DM, DM, 0, DM, nullptr, WSP(bf16, WS_WOUT) + (size_t)l * DM * DM, DM, 0);
    } else {
        const int q = it - NLAYER * TR_PER_LAYER, i = q / TR_PER_FFN; int r = q % TR_PER_FFN;
        if (trjob_gu(r, d, INP(float, 37) + (size_t)i * DM * FFN, FFN, DM, FFN, WSP(bf16, WS_WFGU) + (size_t)i * 2 * FFN * DM, DM, 0)) return;
        if (trjob_gu(r, d, INP(float, 38) + (size_t)i * DM * FFN, FFN, DM, FFN, WSP(bf16, WS_WFGU) + (size_t)i * 2 * FFN * DM, DM, 1)) return;
        (void)trjob(r, d, INP(float, 39) + (size_t)i * FFN * DM, DM, FFN, 0, DM, nullptr, WSP(bf16, WS_WFD) + (size_t)i * DM * FFN, FFN, 0);
    }
}
constexpr int TR_PER_E = 2 * 16 * 112 + 56 * 32;
__device__ __forceinline__ void tr_decode_moe(Frame& F, int li, int it, TrDesc& d) {
    const int e = it / TR_PER_E; int r = it % TR_PER_E; const size_t wi = (size_t)(li * NEXP + e);
    if (trjob_gu(r, d, INP(float, 41) + wi * DM * EXD, EXD, DM, EXD, WSP(bf16, WS_WMGU) + (size_t)e * 2 * EXD * DM, DM, 0)) return;
    if (trjob_gu(r, d, INP(float, 42) + wi * DM * EXD, EXD, DM, EXD, WSP(bf16, WS_WMGU) + (size_t)e * 2 * EXD * DM, DM, 1)) return;
    (void)trjob(r, d, INP(float, 43) + wi * EXD * DM, DM, EXD, 0, DM, nullptr, WSP(bf16, WS_WMD) + (size_t)e * DM * EXD, EXD, 0);
}

__device__ __forceinline__ void p0_prologue(Frame& F) {
    LAS float* scr = (LAS float*)(F.lds + F.wave * 16384);
    const int lane = F.lane; const int gw = F.blk * NWAVES + F.wave, NGW = F.G * NWAVES;
    { TrDesc dc, dn; TrRegs rc, rn; int it = gw;
      if (it < TR_PROLOGUE) { tr_decode_prologue(F, it, dc); tr_load(dc, rc, lane); }
      for (; it < TR_PROLOGUE; it += NGW) { const bool more = it + NGW < TR_PROLOGUE;
          if (more) { tr_decode_prologue(F, it + NGW, dn); tr_load(dn, rn, lane); }
          tr_finish(dc, rc, scr, lane);
          if (more) { dc = dn; rc = rn; } } }
    for (int it = F.blk * 512 + F.tid; it < 3 * 512 * 64; it += F.G * 512) {
        const int i = it / (512 * 64), rem = it % (512 * 64), n = rem >> 6, k0 = (rem & 63) * 8;
        const float* vd = INP(float, 18) + (size_t)i * 512 * 32; const float* vu = INP(float, 19) + (size_t)i * 32 * 512; float o[8];
#pragma unroll
        for (int j = 0; j < 8; ++j) o[j] = 0.f;
        for (int rr = 0; rr < 32; ++rr) { const float u = vu[rr * 512 + n];
#pragma unroll
            for (int j = 0; j < 8; ++j) o[j] += vd[(k0 + j) * 32 + rr] * u; }
        *(v4u*)(WSP(bf16, WS_WVRES) + (size_t)i * 512 * 512 + (size_t)n * 512 + k0) = f32_to_bf16x8(o);
    }
    for (int it = F.blk * 512 + F.tid; it < M * 16; it += F.G * 512) {
        const int m = it >> 4, i = it & 15; const float inv = powf(10000.0f, -(float)i * (1.0f / 16.0f)); const float ang = (float)INP(int, 1)[m] * inv;
        float sn, cn; sincosf(ang, &sn, &cn); float* cs = WSP(float, WS_ROPE) + (size_t)m * 32; cs[i] = cn; cs[16 + i] = sn;
    }
}
__device__ __forceinline__ void moe_convert(Frame& F, int li) {
    LAS float* scr = (LAS float*)(F.lds + F.wave * 16384);
    const int lane = F.lane; const int gw = F.blk * NWAVES + F.wave, NGW = F.G * NWAVES;
    TrDesc dc, dn; TrRegs rc, rn; int it = gw;
    if (it < NEXP * TR_PER_E) { tr_decode_moe(F, li, it, dc); tr_load(dc, rc, lane); }
    for (; it < NEXP * TR_PER_E; it += NGW) { const bool more = it + NGW < NEXP * TR_PER_E;
        if (more) { tr_decode_moe(F, li, it + NGW, dn); tr_load(dn, rn, lane); }
        tr_finish(dc, rc, scr, lane);
        if (more) { dc = dn; rc = rn; } }
}

__device__ __forceinline__ void ph2_prep(Frame& F, int l) {
    const int lane = F.lane; const int gw = F.blk * NWAVES + F.wave, NGW = F.G * NWAVES;
    const bf16* rwraw = WSP(bf16, WS_RWRAW); const bf16* mlaraw = WSP(bf16, WS_MLARAW);
    const float* mu = INP(float, 7) + l * 1792; const float* k_k = INP(float, 13) + l * 512;
    float mu_r[8], mu_k[8], mu_v[8], mu_t[8], kk8[8];
    ld8f(mu + 8 * lane, mu_r); ld8f(mu + 512 + 8 * lane, mu_k); ld8f(mu + 1024 + 8 * lane, mu_v); ld8f(mu + 1536 + 8 * (lane & 31), mu_t); ld8f(k_k + 8 * lane, kk8);
    const float* cs_all = WSP(float, WS_ROPE);
    constexpr int TPW = 16;
    const int m0 = gw * TPW;
    v4u n_r, n_k, n_v, n_t, n_a, n_b, p_r, p_k, p_v, p_t;
    { const bf16* cur = rwraw + (size_t)m0 * 1792; n_r = *(const v4u*)(cur + 8 * lane); n_k = *(const v4u*)(cur + 512 + 8 * lane); n_v = *(const v4u*)(cur + 1024 + 8 * lane); n_t = *(const v4u*)(cur + 1536 + 8 * (lane & 31));
      const bf16* mr = mlaraw + (size_t)m0 * 768; n_a = *(const v4u*)(mr + 8 * lane); n_b = *(const v4u*)(mr + 512 + 8 * (lane & 31));
      if (m0 & (SEQ - 1)) { const bf16* prv = cur - 1792; p_r = *(const v4u*)(prv + 8 * lane); p_k = *(const v4u*)(prv + 512 + 8 * lane); p_v = *(const v4u*)(prv + 1024 + 8 * lane); p_t = *(const v4u*)(prv + 1536 + 8 * (lane & 31)); }
      else { p_r = (v4u){0u, 0u, 0u, 0u}; p_k = p_r; p_v = p_r; p_t = p_r; } }
    for (int i = 0; i < TPW; ++i) {
        const int m = m0 + i;
        const v4u c_r = n_r, c_k = n_k, c_v = n_v, c_t = n_t, c_a = n_a, c_b = n_b;
        if (i + 1 < TPW) { const bf16* nx = rwraw + (size_t)(m + 1) * 1792; n_r = *(const v4u*)(nx + 8 * lane); n_k = *(const v4u*)(nx + 512 + 8 * lane); n_v = *(const v4u*)(nx + 1024 + 8 * lane); n_t = *(const v4u*)(nx + 1536 + 8 * (lane & 31));
            const bf16* mr = mlaraw + (size_t)(m + 1) * 768; n_a = *(const v4u*)(mr + 8 * lane); n_b = *(const v4u*)(mr + 512 + 8 * (lane & 31)); }
        float c[8], p[8], o[8];
        bf16x8_to_f32(c_r, c); bf16x8_to_f32(p_r, p);
#pragma unroll
        for (int j = 0; j < 8; ++j) o[j] = c[j] + (p[j] - c[j]) * mu_r[j];
        *(f16x8*)(WSP(f16, WS_R) + (size_t)m * 512 + 8 * lane) = f32_to_f16x8(o);
        bf16x8_to_f32(c_k, c); bf16x8_to_f32(p_k, p);
        float ss = 0.f;
#pragma unroll
        for (int j = 0; j < 8; ++j) { o[j] = c[j] + (p[j] - c[j]) * mu_k[j]; const float q = o[j] * kk8[j]; ss += q * q; }
        *(f16x8*)(WSP(f16, WS_KH) + (size_t)m * 512 + 8 * lane) = f32_to_f16x8(o);
        ss += __shfl_xor(ss, 1); ss += __shfl_xor(ss, 2); ss += __shfl_xor(ss, 4);
        { const float rn = 1.0f / fmaxf(sqrtf(ss), 1e-12f);
#pragma unroll
          for (int j = 0; j < 8; ++j) o[j] = o[j] * kk8[j] * rn; }
        *(f16x8*)(WSP(f16, WS_KKN) + (size_t)m * 512 + 8 * lane) = f32_to_f16x8(o);
        bf16x8_to_f32(c_v, c); bf16x8_to_f32(p_v, p);
#pragma unroll
        for (int j = 0; j < 8; ++j) o[j] = c[j] + (p[j] - c[j]) * mu_v[j];
        { const v4u vb = f32_to_bf16x8(o); *(v4u*)(WSP(bf16, WS_VRAW) + (size_t)m * 512 + 8 * lane) = vb;
          if (l == 0) { *(v4u*)(WSP(bf16, WS_VFIRST) + (size_t)m * 512 + 8 * lane) = vb; *(f16x8*)(WSP(f16, WS_VFIN) + (size_t)m * 512 + 8 * lane) = f32_to_f16x8(o); } }
        if (lane < 32) {
            bf16x8_to_f32(c_t, c); bf16x8_to_f32(p_t, p);
#pragma unroll
            for (int j = 0; j < 8; ++j) { float v = c[j] + (p[j] - c[j]) * mu_t[j]; if (lane < 8) v = 1.0f - 2.0f * __builtin_amdgcn_rcpf(__expf(2.0f * v) + 1.0f); else if (lane >= 16) v = sigm(v); o[j] = v; }
            *(v4u*)(WSP(bf16, WS_LORAIN) + (size_t)m * 256 + 8 * lane) = f32_to_bf16x8(o);
        }
        p_r = c_r; p_k = c_k; p_v = c_v; p_t = c_t;
        float a8[8], b8[8];
        bf16x8_to_f32(c_a, a8); float ssa = 0.f, ssb = 0.f;
#pragma unroll
        for (int j = 0; j < 8; ++j) ssa += a8[j] * a8[j];
        if (lane < 32) { bf16x8_to_f32(c_b, b8);
#pragma unroll
            for (int j = 0; j < 8; ++j) ssb += b8[j] * b8[j]; } else {
#pragma unroll
            for (int j = 0; j < 8; ++j) b8[j] = 0.f; }
        const float sq = wave_sum(lane < 48 ? ssa : 0.f), skv = wave_sum((lane >= 48 ? ssa : 0.f) + (lane < 16 ? ssb : 0.f));
        const float rq = 1.0f / sqrtf(sq * (1.0f / 384.0f) + 1e-6f), rkv = 1.0f / sqrtf(skv * (1.0f / 256.0f) + 1e-6f);
        if (lane < 48) {
#pragma unroll
            for (int j = 0; j < 8; ++j) o[j] = a8[j] * rq;
            *(v4u*)(WSP(bf16, WS_CQN) + (size_t)m * 384 + 8 * lane) = f32_to_bf16x8(o);
        } else {
#pragma unroll
            for (int j = 0; j < 8; ++j) o[j] = a8[j] * rkv;
            *(v4u*)(WSP(bf16, WS_CKVN) + (size_t)m * 256 + 8 * (lane - 48)) = f32_to_bf16x8(o);
        }
        if (lane < 16) {
#pragma unroll
            for (int j = 0; j < 8; ++j) o[j] = b8[j] * rkv;
            *(v4u*)(WSP(bf16, WS_CKVN) + (size_t)m * 256 + 128 + 8 * lane) = f32_to_bf16x8(o);
        }
        float pr[8];
#pragma unroll
        for (int j = 0; j < 8; ++j) pr[j] = __shfl_xor(b8[j], 2);
        if (lane >= 16 && lane < 20) { const int i0 = 8 * (lane & 1); const float* cs = cs_all + (size_t)m * 32; float cc[8], sn[8]; ld8f(cs + i0, cc); ld8f(cs + 16 + i0, sn);
            const bool lo = lane < 18;
#pragma unroll
            for (int j = 0; j < 8; ++j) o[j] = lo ? (b8[j] * cc[j] - pr[j] * sn[j]) : (pr[j] * sn[j] + b8[j] * cc[j]);
            const v4u w = f32_to_bf16x8(o); bf16* kd = WSP(bf16, WS_K) + (size_t)m * 768 + 64 + (lo ? 0 : 16) + i0;
#pragma unroll
            for (int h = 0; h < NH; ++h) *(v4u*)(kd + h * 96) = w; }
    }
}

__device__ __forceinline__ void s5_gen(Frame& F, int l, int g) {
    {
        __syncthreads();
        const int tid = F.tid;
        LAS float* pw = (LAS float*)F.lds;
        LAS float* Bb = pw + 33 * 64 * 2;
        LAS float* Cc = Bb + 64 * 16 * 2;
        LAS float* Kt = Cc + 16 * 64 * 2;
        const float dt = expf(INP(float, 23)[l * 32 + g]);
        const float* are = INP(float, 21) + (size_t)(l * 32 + g) * 64; const float* aim = INP(float, 22) + (size_t)(l * 32 + g) * 64;
        for (int e = tid; e < 33 * 64; e += 512) { const int n = e >> 6, p = e & 63; const float lr = fminf(are[p], -1e-4f), li = aim[p];
            const float mag = expf((float)n * (dt * lr)); float sn, cn; sincosf((float)n * (dt * li), &sn, &cn); pw[2 * e] = mag * cn; pw[2 * e + 1] = mag * sn; }
        for (int e = tid; e < 64 * 16; e += 512) { const int p = e >> 4; const float lr = fminf(are[p], -1e-4f), li = aim[p];
            const float mag = expf(dt * lr); float sn, cn; sincosf(dt * li, &sn, &cn); const float abr = mag * cn, abi = mag * sn, den = lr * lr + li * li;
            const float fr = ((abr - 1.0f) * lr + abi * li) / den, fi = (abi * lr - (abr - 1.0f) * li) / den;
            const float br = INP(float, 24)[(size_t)(l * 32 + g) * 1024 + e], bi = INP(float, 25)[(size_t)(l * 32 + g) * 1024 + e];
            Bb[2 * e] = fr * br - fi * bi; Bb[2 * e + 1] = fr * bi + fi * br; }
        for (int e = tid; e < 16 * 64; e += 512) { Cc[2 * e] = INP(float, 26)[(size_t)(l * 32 + g) * 1024 + e]; Cc[2 * e + 1] = INP(float, 27)[(size_t)(l * 32 + g) * 1024 + e]; }
        __syncthreads();
        { const int tau = tid >> 4, o = tid & 15; float acc[16];
#pragma unroll
          for (int i = 0; i < 16; ++i) acc[i] = 0.f;
          for (int p = 0; p < 64; ++p) { const float cr = Cc[2 * (o * 64 + p)], ci = Cc[2 * (o * 64 + p) + 1], pr_ = pw[2 * (tau * 64 + p)], pi_ = pw[2 * (tau * 64 + p) + 1];
              const float xr = cr * pr_ - ci * pi_, xi = cr * pi_ + ci * pr_;
#pragma unroll
              for (int i = 0; i < 16; ++i) acc[i] += xr * Bb[2 * (p * 16 + i)] - xi * Bb[2 * (p * 16 + i) + 1]; }
#pragma unroll
          for (int i = 0; i < 16; ++i) Kt[(tau * 16 + o) * 16 + i] = acc[i]; }
        __syncthreads();
        bf16* bm = WSP(bf16, WS_S5MAIN) + ((size_t)l * 32 + g) * 512 * S5K;
        for (int e = tid; e < 512 * 80; e += 512) { const int n = e / 80, k0 = (e % 80) * 8, t = n >> 4, o = n & 15; float v[8];
            if (k0 < 512) { const int sidx = k0 >> 4, i0 = k0 & 15;
#pragma unroll
                for (int j = 0; j < 8; ++j) v[j] = (sidx <= t) ? Kt[((t - sidx) * 16 + o) * 16 + i0 + j] : 0.f; }
            else {
#pragma unroll
                for (int j = 0; j < 8; ++j) { const int q = k0 - 512 + j, p = q & 63; const float cr = Cc[2 * (o * 64 + p)], ci = Cc[2 * (o * 64 + p) + 1], pr_ = pw[2 * ((t + 1) * 64 + p)], pi_ = pw[2 * ((t + 1) * 64 + p) + 1];
                    v[j] = (q < 64) ? (cr * pr_ - ci * pi_) : -(cr * pi_ + ci * pr_); } }
            *(v4u*)(bm + (size_t)n * S5K + k0) = f32_to_bf16x8(v); }
        bf16* be = WSP(bf16, WS_S5END) + ((size_t)l * 32 + g) * 256 * 512;
        for (int e = tid; e < 256 * 64; e += 512) { const int n = e / 64, k0 = (e % 64) * 8, sidx = k0 >> 4, i0 = k0 & 15; float v[8];
            if (n < 128) { const int p = n & 63; const float pr_ = pw[2 * ((31 - sidx) * 64 + p)], pi_ = pw[2 * ((31 - sidx) * 64 + p) + 1];
#pragma unroll
                for (int j = 0; j < 8; ++j) { const float br = Bb[2 * (p * 16 + i0 + j)], bi = Bb[2 * (p * 16 + i0 + j) + 1]; v[j] = (n < 64) ? (pr_ * br - pi_ * bi) : (pr_ * bi + pi_ * br); } }
            else {
#pragma unroll
                for (int j = 0; j < 8; ++j) v[j] = 0.f; }
            *(v4u*)(be + (size_t)n * 512 + k0) = f32_to_bf16x8(v); }
        if (tid < 64) { float* a32 = WSP(float, WS_S5A32) + (size_t)((l * 32 + g) * 64 + tid) * 2; a32[0] = pw[2 * (32 * 64 + tid)]; a32[1] = pw[2 * (32 * 64 + tid) + 1]; }
        __syncthreads();
    }
}

__device__ __forceinline__ void ln_core(f32x4 (&v)[4], const float* gam, const float* bet, int lane) {
    float s = 0.f;
#pragma unroll
    for (int j = 0; j < 4; ++j) s += (v[j][0] + v[j][1]) + (v[j][2] + v[j][3]);
    const float mean = wave_sum(s) * (1.f / DM); float s2 = 0.f;
#pragma unroll
    for (int j = 0; j < 4; ++j) { v[j] = v[j] - mean; s2 += (v[j][0] * v[j][0] + v[j][1] * v[j][1]) + (v[j][2] * v[j][2] + v[j][3] * v[j][3]); }
    const float rstd = 1.f / sqrtf(wave_sum(s2) * (1.f / DM) + LN_EPS);
#pragma unroll
    for (int j = 0; j < 4; ++j) { const f32x4 g4 = *(const f32x4*)(gam + 4 * lane + 256 * j), b4 = *(const f32x4*)(bet + 4 * lane + 256 * j); v[j] = v[j] * rstd * g4 + b4; }
}
__device__ __forceinline__ void ln_store(const f32x4 (&v)[4], float* xrow, bf16* xbrow, int lane) {
#pragma unroll
    for (int j = 0; j < 4; ++j) { if (xrow) *(f32x4*)(xrow + 4 * lane + 256 * j) = v[j]; v2u w; w.x = cvt_pk_bf16(v[j][0], v[j][1]); w.y = cvt_pk_bf16(v[j][2], v[j][3]); *(v2u*)(xbrow + 4 * lane + 256 * j) = w; }
}
__device__ __forceinline__ void ln_phase(Frame& F, const float* gam, const float* bet) {
    const int lane = F.lane; const int gw = F.blk * NWAVES + F.wave, NGW = F.G * NWAVES; const f16* X = (const f16*)F.out; bf16* Xb = WSP(bf16, WS_XB);
    for (int m = gw; m < M; m += NGW) { f32x4 v[4];
#pragma unroll
        for (int j = 0; j < 4; ++j) { typedef f16 f16x4 __attribute__((ext_vector_type(4))); const f16x4 h = *(const f16x4*)(X + (size_t)m * DM + 4 * lane + 256 * j); v[j] = (f32x4){(float)h[0], (float)h[1], (float)h[2], (float)h[3]}; }
        ln_core(v, gam, bet, lane); ln_store(v, nullptr, Xb + (size_t)m * DM, lane); }
}
__device__ __forceinline__ void ln2_moe_phase(Frame& F, const float* gam, const float* bet, int li, bool last) {
    const int lane = F.lane; const int gw = F.blk * NWAVES + F.wave, NGW = F.G * NWAVES; float* X = F.out; bf16* Xb = WSP(bf16, WS_XB);
    const unsigned* cnt = (const unsigned*)(F.ctl + CW_MOECNT + 64 * li); int pstart[NEXP]; { int acc = 0;
#pragma unroll
        for (int e = 0; e < NEXP; ++e) { pstart[e] = acc; acc += (int)(((cnt[e] + 255u) >> 8) << 8); } }
    const int* ppos = WSP(int, WS_PAIRPOS); const bf16* yp = WSP(bf16, WS_YPAIR);
    for (int m = gw; m < M; m += NGW) { f32x4 v[4];
        const int p0 = ppos[2 * m], p1 = ppos[2 * m + 1]; int r0 = 0, r1 = 0;
#pragma unroll
        for (int e = 0; e < NEXP; ++e) { if ((p0 >> 24) == e) r0 = pstart[e] + (p0 & 0xffffff); if ((p1 >> 24) == e) r1 = pstart[e] + (p1 & 0xffffff); }
#pragma unroll
        for (int j = 0; j < 4; ++j) { const v2u xw = *(const v2u*)(Xb + (size_t)m * DM + 4 * lane + 256 * j); const f32x4 x = (f32x4){bf_lo(xw.x), bf_hi(xw.x), bf_lo(xw.y), bf_hi(xw.y)};
            const v2u a = *(const v2u*)(yp + (size_t)r0 * DM + 4 * lane + 256 * j), b = *(const v2u*)(yp + (size_t)r1 * DM + 4 * lane + 256 * j);
            v[j] = x * ALPHA + (f32x4){bf_lo(a.x) + bf_lo(b.x), bf_hi(a.x) + bf_hi(b.x), bf_lo(a.y) + bf_lo(b.y), bf_hi(a.y) + bf_hi(b.y)}; }
        ln_core(v, gam, bet, lane); ln_store(v, last ? X + (size_t)m * DM : nullptr, Xb + (size_t)m * DM, lane); }
}
__device__ __forceinline__ void ln1_moe_phase(Frame& F, const float* gam, const float* bet, int li) {
    const int lane = F.lane; float* X = F.out; bf16* Xb = WSP(bf16, WS_XB);
    LAS int* pe = (LAS int*)F.lds;
    LAS float* pwt = (LAS float*)(F.lds + 1024);
    LAS int* cntl = (LAS int*)(F.lds + 2048);
    const float* router = INP(float, 40) + (size_t)li * DM * NEXP;
    for (int blk0 = F.blk; blk0 * 128 < M; blk0 += F.G) {
        __syncthreads();
        for (int i = 0; i < 16; ++i) { const int tl = F.wave * 16 + i, m = blk0 * 128 + tl; f32x4 v[4];
#pragma unroll
            for (int j = 0; j < 4; ++j) { typedef f16 f16x4 __attribute__((ext_vector_type(4))); const f16x4 h = *(const f16x4*)((const f16*)X + (size_t)m * DM + 4 * lane + 256 * j); v[j] = (f32x4){(float)h[0], (float)h[1], (float)h[2], (float)h[3]}; }
            ln_core(v, gam, bet, lane); ln_store(v, nullptr, Xb + (size_t)m * DM, lane);
            float lg[NEXP];
#pragma unroll
            for (int e = 0; e < NEXP; ++e) lg[e] = 0.f;
#pragma unroll
            for (int j = 0; j < 4; ++j)
#pragma unroll
                for (int q = 0; q < 4; ++q) { const float xv = v[j][q]; const float* rr = router + (size_t)(4 * lane + 256 * j + q) * NEXP; const f32x4 ra = *(const f32x4*)rr, rb = *(const f32x4*)(rr + 4);
                    lg[0] += xv * ra[0]; lg[1] += xv * ra[1]; lg[2] += xv * ra[2]; lg[3] += xv * ra[3]; lg[4] += xv * rb[0]; lg[5] += xv * rb[1]; lg[6] += xv * rb[2]; lg[7] += xv * rb[3]; }
#pragma unroll
            for (int e = 0; e < NEXP; ++e) lg[e] = wave_sum(lg[e]);
            int e0 = 0; float l0 = lg[0];
#pragma unroll
            for (int e = 1; e < NEXP; ++e) if (lg[e] > l0) { l0 = lg[e]; e0 = e; }
            int e1 = -1; float l1 = -INFINITY;
#pragma unroll
            for (int e = 0; e < NEXP; ++e) if (e != e0 && lg[e] > l1) { l1 = lg[e]; e1 = e; }
            const float w1 = 1.0f / (1.0f + expf(l0 - l1)), w0 = 1.0f - w1;
            if (lane == 0) { pe[2 * tl] = e0; pe[2 * tl + 1] = e1; pwt[2 * tl] = w0; pwt[2 * tl + 1] = w1; }
        }
        __syncthreads();
        int myrank = 0, mye = 0;
        if (F.tid < 256) { mye = pe[F.tid]; for (int q = 0; q < F.tid; ++q) myrank += (pe[q] == mye) ? 1 : 0; }
        if (F.tid < NEXP) { int c = 0; for (int q = 0; q < 256; ++q) c += (pe[q] == F.tid) ? 1 : 0; cntl[F.tid] = c;
            cntl[8 + F.tid] = (int)__hip_atomic_fetch_add((unsigned*)(F.ctl + CW_MOECNT + 64 * li + F.tid), (unsigned)c, RLX_AGENT); }
        __syncthreads();
        if (F.tid < 256) { const int rk = cntl[8 + mye] + myrank; const int m = blk0 * 128 + (F.tid >> 1);
            WSP(int, WS_SLOTTOK)[(size_t)mye * MOE_CAP + rk] = m; WSP(float, WS_SLOTW)[(size_t)mye * MOE_CAP + rk] = pwt[F.tid]; WSP(int, WS_PAIRPOS)[blk0 * 256 + F.tid] = (mye << 24) | rk; }
    }
    __syncthreads();
}
constexpr int AT_CW = 8, AT_QR = 32 * AT_CW;
constexpr int AT_KS = 208, AT_VS = 192;
constexpr int AT_KB = 64 * AT_KS, AT_VB = 64 * AT_VS, AT_STAGE = AT_KB + AT_VB;
constexpr int AT_WSF = 2 * AT_STAGE, AT_OST = AT_WSF + NWAVES * 256, AT_LDS = AT_OST + NWAVES * 4096;
__device__ __forceinline__ int crow(int r, int hi) { return (r & 3) + 8 * (r >> 2) + 4 * hi; }

__device__ __forceinline__ void attn_unit(int tid, int b, int h, int qb, const bf16* Q, const bf16* K, const bf16* V, bf16* O, LAS unsigned char* lds) {
    const int lane = tid & 63, r32 = lane & 31, hi = lane >> 5; const int wid = __builtin_amdgcn_readfirstlane(tid >> 6);
    const size_t rowbase = (size_t)b * SEQ; const int q0 = qb * AT_QR; const bool cw = wid < AT_CW;
    bf16x8 qr[6];
    { const bf16* qp = Q + (rowbase + q0 + (cw ? wid : 0) * 32 + r32) * 768 + h * 96 + hi * 8;
#pragma unroll
      for (int d0 = 0; d0 < 6; ++d0) qr[d0] = *(const bf16x8*)(qp + d0 * 16); }
    const int kp0 = tid, kp1 = 512 + tid;
    const bf16* kg0 = K + (rowbase + kp0 / 12) * 768 + h * 96 + (kp0 % 12) * 8;
    const bf16* kg1 = K + (rowbase + kp1 / 12) * 768 + h * 96 + (kp1 % 12) * 8;
    const bf16* vg = V + (rowbase + (tid >> 3)) * 512 + h * 64 + (tid & 7) * 8;
    const int kl0 = (kp0 / 12) * AT_KS + (kp0 % 12) * 16, kl1 = (kp1 / 12) * AT_KS + (kp1 % 12) * 16, vl = (tid >> 3) * AT_VS + (tid & 7) * 16;
    const bool two = tid < 256;
    const int NT = (q0 + AT_QR) / 64;
    v4u ka, kb2, va;
    ka = *(const v4u*)kg0; if (two) kb2 = *(const v4u*)kg1; va = *(const v4u*)vg;
    *(LAS v4u*)(lds + kl0) = ka; if (two) *(LAS v4u*)(lds + kl1) = kb2; *(LAS v4u*)(lds + AT_KB + vl) = va;
    LAS float* wsf = (LAS float*)(lds + AT_WSF) + wid * 64;
    float m_run = -1e30f, l_run = 0.f; f32x16 o[2];
#pragma unroll
    for (int r = 0; r < 16; ++r) { o[0][r] = 0.f; o[1][r] = 0.f; }
    const int kfo = r32 * AT_KS + hi * 16;
    const int vfo = (4 * hi + ((lane & 15) >> 2)) * AT_VS + ((lane >> 4) & 1) * 32 + (lane & 3) * 8;
    const int qrel = wid * 32 + r32;
    __syncthreads();
    for (int t = 0; t < NT; ++t) {
        const int cur = (t & 1) * AT_STAGE, nxt = ((t + 1) & 1) * AT_STAGE; const bool more = (t + 1 < NT);
        if (more) { const size_t go = (size_t)(t + 1) * 64 * 768; ka = *(const v4u*)(kg0 + go); if (two) kb2 = *(const v4u*)(kg1 + go); va = *(const v4u*)(vg + (size_t)(t + 1) * 64 * 512); }
        const int jb = t - (NT - AT_QR / 64);
        if (cw && (jb < 0 || 64 * jb <= 32 * wid + 31)) {
            f32x16 p0, p1;
#pragma unroll
            for (int r = 0; r < 16; ++r) { p0[r] = 0.f; p1[r] = 0.f; }
#pragma unroll
            for (int d0 = 0; d0 < 6; ++d0) { const bf16x8 k0 = *(const LAS bf16x8*)(lds + cur + kfo + d0 * 32), k1 = *(const LAS bf16x8*)(lds + cur + kfo + 32 * AT_KS + d0 * 32);
                p0 = __builtin_amdgcn_mfma_f32_32x32x16_bf16(k0, qr[d0], p0, 0, 0, 0); p1 = __builtin_amdgcn_mfma_f32_32x32x16_bf16(k1, qr[d0], p1, 0, 0, 0); }
            s16x4 vlo[8], vhh[8];
#pragma unroll
            for (int d0 = 0; d0 < 2; ++d0)
#pragma unroll
                for (int ks = 0; ks < 4; ++ks) {
                    vlo[d0 * 4 + ks] = __builtin_bit_cast(s16x4, __builtin_amdgcn_ds_read_tr16_b64_v4i16((LAS s16x4*)(lds + cur + AT_KB + vfo + (16 * ks) * AT_VS + d0 * 64)));
                    vhh[d0 * 4 + ks] = __builtin_bit_cast(s16x4, __builtin_amdgcn_ds_read_tr16_b64_v4i16((LAS s16x4*)(lds + cur + AT_KB + vfo + (16 * ks + 8) * AT_VS + d0 * 64))); }
            if (jb >= 0) { const int kb = 64 * jb + 4 * hi;
#pragma unroll
                for (int r = 0; r < 16; ++r) { const int kv = kb + (r & 3) + 8 * (r >> 2); if (kv > qrel) p0[r] = -INFINITY; if (kv + 32 > qrel) p1[r] = -INFINITY; } }
            float rm = fmaxf(p0[0], p1[0]);
#pragma unroll
            for (int r = 1; r < 16; ++r) rm = fmaxf(rm, fmaxf(p0[r], p1[r]));
            rm = fmaxf(rm, __shfl_xor(rm, 32));
            const float mnew = fmaxf(m_run, rm), alpha = __builtin_amdgcn_exp2f(m_run - mnew);
            float ps = 0.f;
#pragma unroll
            for (int r = 0; r < 16; ++r) { p0[r] = __builtin_amdgcn_exp2f(p0[r] - mnew); p1[r] = __builtin_amdgcn_exp2f(p1[r] - mnew); ps += p0[r] + p1[r]; }
            l_run = l_run * alpha + ps;
            if (__any(mnew > m_run)) {
                if (hi == 0) wsf[r32] = alpha;
                LDS_WAIT();
#pragma unroll
                for (int r = 0; r < 16; ++r) { const float f = wsf[crow(r, hi)]; o[0][r] *= f; o[1][r] *= f; }
            }
            m_run = mnew;
            bf16x8 pa[4];
            { v4u w;
              w.x = cvt_pk_bf16(p0[0], p0[1]); w.y = cvt_pk_bf16(p0[2], p0[3]); w.z = cvt_pk_bf16(p0[4], p0[5]); w.w = cvt_pk_bf16(p0[6], p0[7]); pa[0] = __builtin_bit_cast(bf16x8, w);
              w.x = cvt_pk_bf16(p0[8], p0[9]); w.y = cvt_pk_bf16(p0[10], p0[11]); w.z = cvt_pk_bf16(p0[12], p0[13]); w.w = cvt_pk_bf16(p0[14], p0[15]); pa[1] = __builtin_bit_cast(bf16x8, w);
              w.x = cvt_pk_bf16(p1[0], p1[1]); w.y = cvt_pk_bf16(p1[2], p1[3]); w.z = cvt_pk_bf16(p1[4], p1[5]); w.w = cvt_pk_bf16(p1[6], p1[7]); pa[2] = __builtin_bit_cast(bf16x8, w);
              w.x = cvt_pk_bf16(p1[8], p1[9]); w.y = cvt_pk_bf16(p1[10], p1[11]); w.z = cvt_pk_bf16(p1[12], p1[13]); w.w = cvt_pk_bf16(p1[14], p1[15]); pa[3] = __builtin_bit_cast(bf16x8, w); }
#pragma unroll
            for (int d0 = 0; d0 < 2; ++d0)
#pragma unroll
                for (int ks = 0; ks < 4; ++ks) {
                    const s16x4 lo = vlo[d0 * 4 + ks], hh = vhh[d0 * 4 + ks];
                    const bf16x8 vf = (bf16x8){lo[0], lo[1], lo[2], lo[3], hh[0], hh[1], hh[2], hh[3]};
                    o[d0] = __builtin_amdgcn_mfma_f32_32x32x16_bf16(pa[ks], vf, o[d0], 0, 0, 0);
                }
        }
        if (more) { *(LAS v4u*)(lds + nxt + kl0) = ka; if (two) *(LAS v4u*)(lds + nxt + kl1) = kb2; *(LAS v4u*)(lds + nxt + AT_KB + vl) = va; }
        __syncthreads();
    }
    l_run += __shfl_xor(l_run, 32);
    if (cw) {
    if (hi == 0) wsf[32 + r32] = l_run;
    LDS_WAIT();
    { bf16* stg = (bf16*)(lds + AT_OST + wid * 4096);
#pragma unroll
      for (int r = 0; r < 16; ++r) { const int orow = crow(r, hi); const float rl = __builtin_amdgcn_rcpf(wsf[32 + orow]);
#pragma unroll
          for (int d0 = 0; d0 < 2; ++d0) { const unsigned u = cvt_pk_bf16(o[d0][r] * rl, 0.f); ((LAS bf16*)(lds + AT_OST + wid * 4096))[orow * 64 + d0 * 32 + r32] = (bf16)(u & 0xffffu); } }
      (void)stg;
      LDS_WAIT();
      bf16* Ow = O + (rowbase + q0 + wid * 32) * 512 + h * 64;
#pragma unroll
      for (int i = 0; i < 4; ++i) { const int row = i * 8 + (lane >> 3), ch = lane & 7; const v4u v = *(const LAS v4u*)(lds + AT_OST + wid * 4096 + (row * 64 + ch * 8) * 2); *(v4u*)(Ow + (size_t)row * 512 + ch * 8) = v; } }
    }
    __syncthreads();
}

template <int CTRL> __device__ __forceinline__ float dpp_add(float v) { return v + __builtin_bit_cast(float, __builtin_amdgcn_update_dpp(0, __builtin_bit_cast(int, v), CTRL, 0xF, 0xF, true)); }
constexpr int RW_TC = 64, RW_STREAM = RW_TC * 64 * 2  , RW_BUF = 6 * RW_STREAM  , RW_YOFF = 2 * RW_BUF  , RW_LDS = RW_YOFF + 2 * RW_STREAM;
constexpr int RW_SPLIT = 2, RW_CW = 4  , RW_ROWS = 64 / RW_SPLIT, RW_RPW = RW_ROWS / RW_CW, RW_LPR = 64 / RW_RPW  , RW_CPL = 64 / RW_LPR  ;
typedef f16 f16xc __attribute__((ext_vector_type(RW_CPL)));
struct RwIn { f16xc r, k, a, b, d; f16 v; };
__device__ __forceinline__ void rw_lds_read(RwIn& x, const LAS unsigned char* buf, int tt, int cg, int row) {
    const LAS unsigned char* p = buf + tt * 128 + cg * (RW_CPL * 2);
    x.r = *(const LAS f16xc*)(p); x.k = *(const LAS f16xc*)(p + RW_STREAM); x.a = *(const LAS f16xc*)(p + 2 * RW_STREAM); x.b = *(const LAS f16xc*)(p + 3 * RW_STREAM); x.d = *(const LAS f16xc*)(p + 4 * RW_STREAM);
    x.v = *(const LAS f16*)(buf + 5 * RW_STREAM + tt * 128 + row * 2);
}
__device__ __forceinline__ void rwkv_scan(Frame& F, int unit) {
    const int bh = unit / RW_SPLIT, part = unit % RW_SPLIT;
    const int tid = F.tid, lane = F.lane, rl = lane / RW_LPR, cg = lane % RW_LPR, b = bh >> 3, h = bh & 7, row = part * RW_ROWS + F.wave * RW_RPW + rl;
    const f16* R = WSP(f16, WS_R); const f16* KH = WSP(f16, WS_KH); const f16* KKN = WSP(f16, WS_KKN); const f16* BV = WSP(f16, WS_BV); const f16* DCY = WSP(f16, WS_DCY); const f16* VF = WSP(f16, WS_VFIN);
    f16* Y = WSP(f16, WS_YRW);
    const size_t base = (size_t)b * SEQ * 512 + h * 64;
    LAS unsigned char* lds = F.lds;
    const int ts = tid >> 3, pc = tid & 7;
    const size_t goff = base + (size_t)ts * 512 + pc * 8;
    const int loff = ts * 128 + pc * 16;
    v4u g[6];
#define RW_GLOAD(t0) do { const size_t o = goff + (size_t)(t0) * 512; const size_t oa = ((t0) + ts + 1 < SEQ) ? o + 512 : o; \
        g[0] = *(const v4u*)(R + o); g[1] = *(const v4u*)(KH + o); g[2] = *(const v4u*)(KKN + oa); g[3] = *(const v4u*)(BV + o); g[4] = *(const v4u*)(DCY + o); g[5] = *(const v4u*)(VF + o); } while (0)
#define RW_LSTORE(bufoff) do { _Pragma("unroll") for (int s_ = 0; s_ < 6; ++s_) *(LAS v4u*)(lds + (bufoff) + s_ * RW_STREAM + loff) = g[s_]; } while (0)
    typedef f16 h2 __attribute__((ext_vector_type(2)));
    h2 S2[RW_CPL / 2];
#pragma unroll
    for (int j = 0; j < RW_CPL / 2; ++j) S2[j] = (h2){(f16)0.f, (f16)0.f};
    float sa = 0.f;
    __syncthreads();
    RW_GLOAD(0); RW_LSTORE(0);
    __syncthreads();
    for (int c = 0; c < SEQ / RW_TC; ++c) {
        const int cur = (c & 1) * RW_BUF, nxt = ((c + 1) & 1) * RW_BUF; const bool more = (c + 1 < SEQ / RW_TC);
        if (more) RW_GLOAD((c + 1) * RW_TC);
        const LAS unsigned char* buf = lds + cur;
        if (F.wave < RW_CW) {
        RwIn x0, x1, x2; rw_lds_read(x0, buf, 0, cg, row); rw_lds_read(x1, buf, 1, cg, row);
        float ykeep = 0.f;
#define RW_STEP(X, TT) do { \
            const h2 sa2 = {(f16)sa, (f16)sa}, v2 = {X.v, X.v}; float yp = 0.f, sp = 0.f; \
            _Pragma("unroll") for (int j = 0; j < RW_CPL / 2; ++j) { const h2 d2 = {X.d[2 * j], X.d[2 * j + 1]}, b2 = {X.b[2 * j], X.b[2 * j + 1]}, k2 = {X.k[2 * j], X.k[2 * j + 1]}, r2 = {X.r[2 * j], X.r[2 * j + 1]}, a2 = {X.a[2 * j], X.a[2 * j + 1]}; \
                h2 sj = S2[j]; sj = __builtin_elementwise_fma(-sj, d2, sj); sj = __builtin_elementwise_fma(sa2, b2, sj); sj = __builtin_elementwise_fma(v2, k2, sj); S2[j] = sj; \
                yp = __builtin_amdgcn_fdot2(sj, r2, yp, false); sp = __builtin_amdgcn_fdot2(sj, a2, sp, false); } \
            yp = dpp_add<0xB1>(yp); sp = dpp_add<0xB1>(sp); \
            yp = dpp_add<0x4E>(yp); sp = dpp_add<0x4E>(sp); \
            if (RW_LPR >= 8) { yp = dpp_add<0x141>(yp); sp = dpp_add<0x141>(sp); } \
            if (RW_LPR >= 16) { yp = dpp_add<0x140>(yp); sp = dpp_add<0x140>(sp); } \
            sa = -sp; ykeep = (cg == ((TT) & 3)) ? yp : ykeep; } while (0)
        for (int tt = 0; tt < RW_TC; tt += 4) {
            rw_lds_read(x2, buf, (tt + 2) & (RW_TC - 1), cg, row); RW_STEP(x0, tt);
            rw_lds_read(x0, buf, (tt + 3) & (RW_TC - 1), cg, row); RW_STEP(x1, tt + 1);
            rw_lds_read(x1, buf, (tt + 4) & (RW_TC - 1), cg, row); RW_STEP(x2, tt + 2);
            rw_lds_read(x2, buf, (tt + 5) & (RW_TC - 1), cg, row); RW_STEP(x0, tt + 3);
            if (cg < 4) *(LAS f16*)(lds + RW_YOFF + (c & 1) * RW_STREAM + (tt + cg) * 128 + row * 2) = (f16)ykeep;
            x0 = x1; x1 = x2;
        }
#undef RW_STEP
        }
        if (more) RW_LSTORE(nxt);
        __syncthreads();
        if (pc >= part * (8 / RW_SPLIT) && pc < (part + 1) * (8 / RW_SPLIT)) { const v4u yv = *(const LAS v4u*)(lds + RW_YOFF + (c & 1) * RW_STREAM + loff); *(v4u*)(Y + base + (size_t)(c * RW_TC + ts) * 512 + pc * 8) = yv; }
    }
    __syncthreads();
#undef RW_GLOAD
#undef RW_LSTORE
}
__device__ __forceinline__ void s5_carry(Frame& F, int l, int idx) {
    const int p = idx & 63, g = (idx >> 6) & 31, b = idx >> 11;
    const float* a32 = WSP(float, WS_S5A32) + (size_t)((l * 32 + g) * 64 + p) * 2; const float ar = a32[0], ai = a32[1];
    const float* xe = WSP(float, WS_XEND) + ((size_t)g * S5CH + b * S5NC) * 128; bf16* u = WSP(bf16, WS_S5U) + ((size_t)g * S5CH + b * S5NC) * S5K + 512;
    float xr = 0.f, xi = 0.f;
    for (int c0 = 0; c0 < S5NC; c0 += 8) { float er[8], ei[8];
#pragma unroll
        for (int c = 0; c < 8; ++c) { er[c] = xe[(size_t)(c0 + c) * 128 + p]; ei[c] = xe[(size_t)(c0 + c) * 128 + 64 + p]; }
#pragma unroll
        for (int c = 0; c < 8; ++c) { bf16* up = u + (size_t)(c0 + c) * S5K; up[p] = (bf16)(cvt_pk_bf16(xr, 0.f) & 0xffffu); up[64 + p] = (bf16)(cvt_pk_bf16(xi, 0.f) & 0xffffu);
            const float nr = ar * xr - ai * xi + er[c], ni = ar * xi + ai * xr + ei[c]; xr = nr; xi = ni; } }
}
__device__ __forceinline__ void rwkv_post(Frame& F, int l) {
    const int lane = F.lane; const int gw = F.blk * NWAVES + F.wave, NGW = F.G * NWAVES;
    float lg[8], lb[8], rk[8]; ld8f(INP(float, 16) + l * 512 + 8 * lane, lg); ld8f(INP(float, 17) + l * 512 + 8 * lane, lb); ld8f(INP(float, 15) + l * 512 + 8 * lane, rk);
    for (int m = gw; m < M; m += NGW) { const size_t off = (size_t)m * 512 + 8 * lane; float y[8], r[8], k[8], v[8], g[8], o[8];
        f16x8_to_f32(*(const f16x8*)(WSP(f16, WS_YRW) + off), y); f16x8_to_f32(*(const f16x8*)(WSP(f16, WS_R) + off), r); f16x8_to_f32(*(const f16x8*)(WSP(f16, WS_KH) + off), k);
        f16x8_to_f32(*(const f16x8*)(WSP(f16, WS_VFIN) + off), v); bf16x8_to_f32(*(const v4u*)(WSP(bf16, WS_GL) + off), g);
        float s = 0.f, bs = 0.f;
#pragma unroll
        for (int j = 0; j < 8; ++j) { s += y[j]; bs += r[j] * k[j] * rk[j]; }
        s += __shfl_xor(s, 1); s += __shfl_xor(s, 2); s += __shfl_xor(s, 4); bs += __shfl_xor(bs, 1); bs += __shfl_xor(bs, 2); bs += __shfl_xor(bs, 4);
        const float mean = s * (1.0f / 64.0f); float q = 0.f;
#pragma unroll
        for (int j = 0; j < 8; ++j) { y[j] -= mean; q += y[j] * y[j]; }
        q += __shfl_xor(q, 1); q += __shfl_xor(q, 2); q += __shfl_xor(q, 4);
        const float rstd = 1.0f / sqrtf(q * (1.0f / 64.0f) + 64e-5f);
#pragma unroll
        for (int j = 0; j < 8; ++j) o[j] = (y[j] * rstd * lg[j] + lb[j] + bs * v[j]) * g[j];
        *(v4u*)(WSP(bf16, WS_YRW) + off) = f32_to_bf16x8(o); }
}
constexpr int PH_PER_LAYER = 12, N_PHASES = 1 + NLAYER * PH_PER_LAYER;
#ifndef MK_PER_PHASE
#define MK_PER_PHASE 0
#endif
constexpr int NR_RWKV = 64 * RW_SPLIT;

__global__ void __launch_bounds__(NWAVES * 64, 2) mk_fwd(Args A) {
    extern __shared__ __attribute__((aligned(16))) unsigned char lds_raw[];
    volatile LAS unsigned* MISC = (volatile LAS unsigned*)((LAS unsigned char*)lds_raw + MISC_OFF);
    for (int u = threadIdx.x; u < (LDS_BYTES - LDSCTL_OFF) / 4; u += NWAVES * 64) ((LAS unsigned*)((LAS unsigned char*)lds_raw + LDSCTL_OFF))[u] = 0u;
    __syncthreads();
    XcdBarrier bar; bar.bar = (unsigned*)(A.ws + WS_CTL) + CW_BAR; bar.x = 0; bar.st = nullptr;
    if (!MK_PER_PHASE) bar = xcd_barrier_post((unsigned*)(A.ws + WS_CTL) + CW_BAR, MISC + 8);
    const int lo = A.ph_lo, hi = A.ph_hi;
#ifndef PHMASK
#define PHMASK 0xFFFF
#endif
#define PHON(k) ((PHMASK >> (k)) & 1)
#define IN(k) (lo <= (k) && (k) < hi)
#define SEAM(k) do { if (IN(k) && IN((k) + 1)) xcd_barrier(bar); } while (0)
    using pg8::gemm_phase; using pg8::StaticOrder; using pg8::LocDense;

    if (PHON(0) && IN(0)) {
        MKFRAME(F);
        p0_prologue(F);
        for (int it = F.G - 1 - F.blk; it < NLAYER * 32; it += F.G) s5_gen(F, it >> 5, it & 31);
        const int gw = F.blk * NWAVES + F.wave, NGW = F.G * NWAVES;
        for (int m = gw; m < M; m += NGW) {
#pragma unroll
            for (int j = 0; j < 4; ++j) { const f32x4 v = *(const f32x4*)(INP(float, 0) + (size_t)m * DM + 4 * F.lane + 256 * j); v2u w; w.x = cvt_pk_bf16(v[0], v[1]); w.y = cvt_pk_bf16(v[2], v[3]); *(v2u*)(WSP(bf16, WS_XB) + (size_t)m * DM + 4 * F.lane + 256 * j) = w; } }
    }
    SEAM(0);

    for (int l = 0; l < NLAYER; ++l) {
        const int pb = 1 + l * PH_PER_LAYER;
        const bool moe = (l & 1) != 0; const int li = l >> 1;
        if (PHON(1) && IN(pb + 0)) {
            asm volatile("; ==PH1");
            MKFRAME(F);
            LocDense L{WSP(bf16, WS_XB), WSP(bf16, WS_WIN) + (size_t)l * 3072 * DM, DM, DM, DM, 0, 0};
            StaticOrder S; S.init(M, 3072, 1, F.G, F.blk);
            Epi8<FProj> E{{WSP(bf16, WS_MLARAW), WSP(bf16, WS_RWRAW), WSP(bf16, WS_S5U)}};
            gemm_phase(F.lds + RING_OFF, L, S, E);
        }
        SEAM(pb + 0);
        if (PHON(2) && IN(pb + 1)) { MKFRAME(F); ph2_prep(F, l); }
        SEAM(pb + 1);
        if (PHON(3) && IN(pb + 2)) {
            asm volatile("; ==PH3");
            MKFRAME(F);
#ifndef P3SEL
#define P3SEL 31
#endif
            if (P3SEL & 1) { LocDense L{WSP(bf16, WS_CQN), WSP(bf16, WS_WUQ) + (size_t)l * 768 * 384, 384, 384, 384, 0, 0}; StaticOrder S; S.init(M, 768, 1, F.G, F.blk);
              Epi8<FQup> E{{WSP(bf16, WS_Q), WSP(float, WS_ROPE), 0.10206207261596575f * 1.4426950408889634f}}; gemm_phase(F.lds + RING_OFF, L, S, E); }
            if (P3SEL & 2) { LocDense L{WSP(bf16, WS_CKVN), WSP(bf16, WS_WUKV) + (size_t)l * 1024 * 256, 256, 256, 256, 0, 0}; StaticOrder S; S.init(M, 1024, 1, F.G, F.blk);
              Epi8<FKVup> E{{WSP(bf16, WS_K), WSP(bf16, WS_V)}}; gemm_phase(F.lds + RING_OFF, L, S, E); }
            if (P3SEL & 4) { LocDense L{WSP(bf16, WS_LORAIN), WSP(bf16, WS_WLORA) + (size_t)l * 1536 * 256, 256, 256, 256, 0, 0}; StaticOrder S; S.init(M, 1536, 1, F.G, F.blk);
              Epi8<FLora> E{{INP(float, 8) + l * 512, INP(float, 10) + l * 512, INP(float, 14) + l * 512, WSP(f16, WS_DCY), WSP(f16, WS_KH), WSP(f16, WS_KKN), WSP(f16, WS_BV), WSP(bf16, WS_GL), {}, {}}}; gemm_phase(F.lds + RING_OFF, L, S, E); }
            if ((P3SEL & 8) && l > 0) { LocDense L{WSP(bf16, WS_VRAW), WSP(bf16, WS_WVRES) + (size_t)(l - 1) * 512 * 512, 512, 512, 512, 0, 0}; StaticOrder S; S.init(M, 512, 1, F.G, F.blk);
              Epi8<FVres> E{{INP(float, 20) + (l - 1) * 512, WSP(bf16, WS_VRAW), WSP(bf16, WS_VFIRST), WSP(f16, WS_VFIN), {}}}; gemm_phase(F.lds + RING_OFF, L, S, E); }
            if (P3SEL & 16) { LocDense L{WSP(bf16, WS_S5U), WSP(bf16, WS_S5END) + (size_t)l * 32 * 256 * 512, S5K, 512, 512, (size_t)S5CH * S5K, (size_t)256 * 512}; StaticOrder S; S.init(S5CH, 256, 32, F.G, (F.blk + F.G / 2) % F.G);
              Epi8<FS5End> E{{WSP(float, WS_XEND)}}; gemm_phase(F.lds + RING_OFF, L, S, E); }
        }
        SEAM(pb + 2);
        if (PHON(4) && IN(pb + 3)) {
            asm volatile("; ==PH4");
            MKFRAME(F);
            if (F.blk < NR_RWKV && F.G > NR_RWKV) { for (int un = F.blk; un < NBATCH * NH * RW_SPLIT; un += NR_RWKV) rwkv_scan(F, un); }
            else { const int ab = F.blk - NR_RWKV, na = F.G - NR_RWKV; for (int idx = ab * 512 + F.tid; idx < NBATCH * 32 * 64; idx += na * 512) s5_carry(F, l, idx); }
            {
                LAS int* slot = (LAS int*)(F.lds + AT_LDS);
                for (;;) {
                    __syncthreads();
                    if (F.tid == 0) *slot = (int)__hip_atomic_fetch_add((unsigned*)(F.ctl + CW_ATTN + 64 * l), 1u, RLX_AGENT);
                    __syncthreads();
                    const int n = *slot; if (n >= NBATCH * NH * (SEQ / AT_QR)) break;
                    const int qb = (SEQ / AT_QR - 1) - (n >> 6), bh = n & 63;
                    attn_unit(F.tid, bh >> 3, bh & 7, qb, WSP(bf16, WS_Q), WSP(bf16, WS_K), WSP(bf16, WS_V), WSP(bf16, WS_YMLA), F.lds);
                }
            }
        }
        SEAM(pb + 3);
        if (PHON(5) && IN(pb + 4)) {
            asm volatile("; ==PH5");
            MKFRAME(F);
            { LocDense L{WSP(bf16, WS_S5U), WSP(bf16, WS_S5MAIN) + (size_t)l * 32 * 512 * S5K, S5K, S5K, S5K, (size_t)S5CH * S5K, (size_t)512 * S5K}; StaticOrder S; S.init(S5CH, 512, 32, F.G, F.blk);
              Epi8<FS5Main> E{{WSP(bf16, WS_S5U), INP(float, 28) + l * 512, WSP(bf16, WS_YS5G), {}}}; gemm_phase(F.lds + RING_OFF, L, S, E); }
            rwkv_post(F, l);
        }
        SEAM(pb + 4);
        if (PHON(6) && IN(pb + 5)) {
            asm volatile("; ==PH6");
            MKFRAME(F);
            { LocDense L{WSP(bf16, WS_YS5G), WSP(bf16, WS_WGLU) + (size_t)l * 512 * 512, 512, 512, 512, 0, 0}; StaticOrder S; S.init(M, 512, 1, F.G, F.blk);
              Epi8<FGlu> E{{WSP(bf16, WS_YS5G), INP(float, 30) + l * 512, WSP(bf16, WS_YS5), {}}}; gemm_phase(F.lds + RING_OFF, L, S, E); }
            { LocDense L{WSP(bf16, WS_XB), WSP(bf16, WS_WG) + ((size_t)l * 3 + 0) * 1024 * DM, DM, DM, DM, 0, 0}; StaticOrder S; S.init(M, 2048, 1, F.G, F.blk);
              Epi8<FGate2> E{{WSP(bf16, WS_GBUF), WSP(bf16, WS_GBUF2)}}; gemm_phase(F.lds + RING_OFF, L, S, E); }
            { LocDense L{WSP(bf16, WS_YMLA), WSP(bf16, WS_WBR) + ((size_t)l * 3 + 0) * 1024 * 512, 512, 512, 512, 0, 0}; StaticOrder S; S.init(M, 1024, 1, F.G, F.blk);
              Epi8<FMerge> E{{WSP(bf16, WS_GBUF), WSP(bf16, WS_MIXED2), WSP(bf16, WS_MIXED), 1}}; gemm_phase(F.lds + RING_OFF, L, S, E); }
            { LocDense L{WSP(bf16, WS_YRW), WSP(bf16, WS_WBR) + ((size_t)l * 3 + 1) * 1024 * 512, 512, 512, 512, 0, 0}; StaticOrder S; S.init(M, 1024, 1, F.G, F.blk);
              Epi8<FMerge> E{{WSP(bf16, WS_GBUF2), WSP(bf16, WS_MIXED), WSP(bf16, WS_MIXED2), 0}}; gemm_phase(F.lds + RING_OFF, L, S, E); }
        }
        SEAM(pb + 5);
        if (PHON(7) && IN(pb + 6)) {
            asm volatile("; ==PH7");
            MKFRAME(F);
            { LocDense L{WSP(bf16, WS_XB), WSP(bf16, WS_WG) + ((size_t)l * 3 + 2) * 1024 * DM, DM, DM, DM, 0, 0}; StaticOrder S; S.init(M, 1024, 1, F.G, F.blk);
              Epi8<FGate> E{{WSP(bf16, WS_GBUF)}}; gemm_phase(F.lds + RING_OFF, L, S, E); }
            { LocDense L{WSP(bf16, WS_YS5), WSP(bf16, WS_WBR) + ((size_t)l * 3 + 2) * 1024 * 512, 512, 512, 512, 0, 0}; StaticOrder S; S.init(M, 1024, 1, F.G, F.blk);
              Epi8<FMerge> E{{WSP(bf16, WS_GBUF), WSP(bf16, WS_MIXED2), WSP(bf16, WS_MIXED), 0}}; gemm_phase(F.lds + RING_OFF, L, S, E); }
        }
        SEAM(pb + 6);
        if (PHON(8) && IN(pb + 7)) {
            asm volatile("; ==PH8");
            MKFRAME(F);
            LocDense L{WSP(bf16, WS_MIXED), WSP(bf16, WS_WOUT) + (size_t)l * DM * DM, DM, DM, DM, 0, 0}; StaticOrder S; S.init(M, DM, 1, F.G, F.blk);
            Epi8<FResid> E{{WSP(bf16, WS_XB), (f16*)F.out}}; gemm_phase(F.lds + RING_OFF, L, S, E);
        }
        SEAM(pb + 7);
        if (PHON(9) && IN(pb + 8)) {
            asm volatile("; ==PH9");
            MKFRAME(F);
            if (moe) { ln1_moe_phase(F, INP(float, 33) + l * DM, INP(float, 34) + l * DM, li); moe_convert(F, li); }
            else ln_phase(F, INP(float, 33) + l * DM, INP(float, 34) + l * DM);
        }
        SEAM(pb + 8);
        if (PHON(10) && IN(pb + 9)) {
            asm volatile("; ==PH10");
            MKFRAME(F);
            if (moe) {
                const unsigned* cnt = (const unsigned*)(F.ctl + CW_MOECNT + 64 * li);
                LocMoe1 L{WSP(bf16, WS_XB), WSP(bf16, WS_WMGU), DM, DM, DM, WSP(int, WS_SLOTTOK), cnt}; MoeOrder S; S.init(cnt, 2 * EXD / 256, F.G, F.blk);
                EpiGU<FSwiglu> E{{WSP(bf16, WS_HM), EXD}}; gemm_phase(F.lds + RING_OFF, L, S, E);
            } else {
                LocDense L{WSP(bf16, WS_XB), WSP(bf16, WS_WFGU) + (size_t)li * 2 * FFN * DM, DM, DM, DM, 0, 0}; StaticOrder S; S.init(M, 2 * FFN, 1, F.G, F.blk);
                EpiGU<FSwiglu> E{{WSP(bf16, WS_HB), FFN}}; gemm_phase(F.lds + RING_OFF, L, S, E);
            }
        }
        SEAM(pb + 9);
        if (PHON(11) && IN(pb + 10)) {
            asm volatile("; ==PH11");
            MKFRAME(F);
            if (moe) {
                const unsigned* cnt = (const unsigned*)(F.ctl + CW_MOECNT + 64 * li);
                LocDense L{WSP(bf16, WS_HM), WSP(bf16, WS_WMD), EXD, EXD, EXD, 0, (size_t)DM * EXD}; MoeOrder S; S.init(cnt, DM / 256, F.G, F.blk);
                Epi8<FMoeDown> E{{WSP(bf16, WS_YPAIR), WSP(float, WS_SLOTW), cnt}}; gemm_phase(F.lds + RING_OFF, L, S, E);
            } else {
                LocDense L{WSP(bf16, WS_HB), WSP(bf16, WS_WFD) + (size_t)li * DM * FFN, FFN, FFN, FFN, 0, 0}; StaticOrder S; S.init(M, DM, 1, F.G, F.blk);
                Epi8<FResid> E{{WSP(bf16, WS_XB), (f16*)F.out}}; gemm_phase(F.lds + RING_OFF, L, S, E);
            }
        }
        SEAM(pb + 10);
        if (PHON(12) && IN(pb + 11)) {
            asm volatile("; ==PH12");
            MKFRAME(F);
            if (moe) ln2_moe_phase(F, INP(float, 35) + l * DM, INP(float, 36) + l * DM, li, l == NLAYER - 1);
            else ln_phase(F, INP(float, 35) + l * DM, INP(float, 36) + l * DM);
        }
        SEAM(pb + 11);
    }
#undef IN
#undef SEAM
}

extern "C" void kernel_launch(void* const* d_in, const int* in_sizes, int n_in, void* d_out, int out_size, void* d_ws, size_t ws_size, hipStream_t stream) {
    static int grid = 0;
    if (grid == 0) {
        if (n_in != 44 || out_size != M * DM || ws_size < WS_END) { fprintf(stderr, "kernel_launch: unexpected problem (n_in %d, out %d, ws %zu < %zu)\n", n_in, out_size, ws_size, (size_t)WS_END); grid = -1; return; }
        int dev = 0, cus = 0, per_cu = 0;
        if (hipGetDevice(&dev) != hipSuccess || hipDeviceGetAttribute(&cus, hipDeviceAttributeMultiprocessorCount, dev) != hipSuccess) { grid = -1; return; }
        if (hipFuncSetAttribute((const void*)mk_fwd, hipFuncAttributeMaxDynamicSharedMemorySize, LDS_BYTES) != hipSuccess) { fprintf(stderr, "kernel_launch: hipFuncSetAttribute failed\n"); grid = -1; return; }
        if (hipOccupancyMaxActiveBlocksPerMultiprocessor(&per_cu, (const void*)mk_fwd, NWAVES * 64, LDS_BYTES) != hipSuccess || per_cu < 1) { fprintf(stderr, "kernel_launch: occupancy query says %d blocks per CU\n", per_cu); }
        (void)hipGetLastError();
        grid = cus;
        if (grid != 256) fprintf(stderr, "kernel_launch: %d CUs (built for 256)\n", grid);
    }
    if (grid < 0) return;
    (void)in_sizes;
    if (hipMemsetAsync((char*)d_ws + WS_CTL, 0, CTL_ZERO_BYTES, stream) != hipSuccess) return;
    Args a{};
    for (int i = 0; i < 44; ++i) a.in[i] = d_in[i];
    a.out = (float*)d_out; a.ws = (unsigned char*)d_ws; a.pad = 0;
#if MK_PER_PHASE
    for (int p = 0; p < N_PHASES; ++p) { a.ph_lo = p; a.ph_hi = p + 1; a.li = p; hipLaunchKernelGGL(mk_fwd, dim3(grid), dim3(NWAVES * 64), LDS_BYTES, stream, a); }
#else
    a.ph_lo = 0; a.ph_hi = N_PHASES; a.li = 0;
    hipLaunchKernelGGL(mk_fwd, dim3(grid), dim3(NWAVES * 64), LDS_BYTES, stream, a);
#endif
}
```

```cpp
#include <hip/hip_runtime.h>
#include <cstdio>
#include <cstdint>
#include <cmath>
namespace pg8 {
#define PG8_LAS __attribute__((address_space(3)))
typedef unsigned short bf16_t;
typedef short bf16x8 __attribute__((ext_vector_type(8)));
typedef float f32x4 __attribute__((ext_vector_type(4)));
typedef float f32x2 __attribute__((ext_vector_type(2)));
typedef unsigned u32x4 __attribute__((ext_vector_type(4)));
typedef unsigned u32x2 __attribute__((ext_vector_type(2)));
constexpr int BM = 256, BK = 64, HALF = 128, HTB = HALF * BK * 2  , STAGE_BYTES = 8 * HTB, NXCD = 8, WGM = 8;

__host__ __device__ __forceinline__ int lds_byte(int r, int c) { const int st = (r >> 4) * 2 + (c >> 5), rr = r & 15, cc = c & 31, ob = rr * 64 + cc * 2; return st * 1024 + (ob ^ (((ob >> 9) & 1) << 5)); }
__host__ __device__ __forceinline__ void stage_rc(int b, int& R, int& C) { const int st = b / 1024, sb = b % 1024, swz = sb ^ (((sb >> 9) & 1) << 5); R = (st >> 1) * 16 + swz / 64; C = (st & 1) * 32 + (swz % 64) / 2; }
__host__ __device__ __forceinline__ int perm32(int rho) { const int n = rho >> 4, i = rho & 15; return 8 * (i >> 2) + 4 * n + (i & 3); }

struct Unit { int pm, pn, z, aux; };

struct LocDense {
    static constexpr bool GATHER = false;
    const bf16_t* A; const bf16_t* Bt; int lda, ldb, K; size_t zA, zB;
    __device__ __forceinline__ const char* a_ptr(const Unit& u) const { return (const char*)(A + (size_t)u.z * zA + (size_t)u.pm * BM * lda); }
    __device__ __forceinline__ const char* b_ptr(const Unit& u) const { return (const char*)(Bt + (size_t)u.z * zB + (size_t)u.pn * BM * ldb); }
    __device__ __forceinline__ void a_off(const Unit&, int tid, unsigned (&v)[2][2]) const {
#pragma unroll
        for (int i = 0; i < 2; ++i) { int R, C; stage_rc(tid * 16 + i * 8192, R, C); v[0][i] = (unsigned)(R * lda + C) * 2u; v[1][i] = 0u; }
    }
};

struct StaticOrder {
    int nM, nN, nwg, nZ, G, c;
    __device__ void init(int M, int N, int Z, int G_, int c_) { nM = M / BM; nN = N / BM; nwg = nM * nN; nZ = Z; G = G_; c = c_; }
    __device__ bool next(int i, Unit& u) const {
        const long L = (long)i * G + c; if (L >= (long)nwg * nZ) return false;
        u.z = (int)(L / nwg); u.aux = 0;
        int wgid = (int)(L % nwg); { const int q = nwg / NXCD, r = nwg % NXCD, xcd = wgid % NXCD, off = wgid / NXCD; wgid = (xcd < r ? xcd * (q + 1) : r * (q + 1) + (xcd - r) * q) + off; }
        const int nig = WGM * nN, gid = wgid / nig, fm = gid * WGM, gsz = (nM - fm) < WGM ? (nM - fm) : WGM;
        u.pm = fm + ((wgid % nig) % gsz); u.pn = (wgid % nig) / gsz; return true;
    }
};

typedef float f32x2_cv __attribute__((ext_vector_type(2))); typedef __bf16 bf16x2_cv __attribute__((ext_vector_type(2)));
__device__ __forceinline__ unsigned cvt_pk_bf16(float lo, float hi) { const f32x2_cv v = {lo, hi}; const bf16x2_cv b = __builtin_convertvector(v, bf16x2_cv); return __builtin_bit_cast(unsigned, b); }
__device__ __forceinline__ u32x4 pack8(const f32x4 v0, const f32x4 v1) { u32x4 w; w.x = cvt_pk_bf16(v0[0], v0[1]); w.y = cvt_pk_bf16(v0[2], v0[3]); w.z = cvt_pk_bf16(v1[0], v1[1]); w.w = cvt_pk_bf16(v1[2], v1[3]); return w; }
__device__ __forceinline__ float bf_lo(unsigned w) { return __uint_as_float(w << 16); }
__device__ __forceinline__ float bf_hi(unsigned w) { return __uint_as_float(w & 0xffff0000u); }
__device__ __forceinline__ void unpack8(const u32x4 w, f32x4& v0, f32x4& v1) { v0 = (f32x4){bf_lo(w.x), bf_hi(w.x), bf_lo(w.y), bf_hi(w.y)}; v1 = (f32x4){bf_lo(w.z), bf_hi(w.z), bf_lo(w.w), bf_hi(w.w)}; }

struct NoPre {};
template <class F> struct Epi8 {
    static constexpr bool PERM = true;
    F f;
    __device__ __forceinline__ void operator()(const f32x4 (&acc)[2][2][4][2], const Unit& u, int wr, int wc, int fr, int fq) const {
        const int row0 = u.pm * BM + wr * 64 + fr, col0 = u.pn * BM + wc * 32 + 8 * fq;
        F g = f;
#pragma unroll
        for (int bj = 0; bj < 2; ++bj) { const int col = col0 + bj * HALF; g.begin_col(u, col);
#pragma unroll
            for (int b0 = 0; b0 < 8; b0 += F::BATCH) { typename F::Pre pr[F::BATCH];
#pragma unroll
                for (int i = 0; i < F::BATCH; ++i) { const int q = b0 + i; pr[i] = g.pre(u, row0 + (q >> 2) * HALF + (q & 3) * 16, col); }
#pragma unroll
                for (int i = 0; i < F::BATCH; ++i) { const int q = b0 + i; g.tile8(u, row0 + (q >> 2) * HALF + (q & 3) * 16, col, acc[q >> 2][bj][q & 3][0], acc[q >> 2][bj][q & 3][1], pr[i]); }
                asm volatile("" ::: "memory"); } }
    }
};
template <class F> struct EpiGU {
    static constexpr bool PERM = true;
    F f;
    __device__ __forceinline__ void operator()(const f32x4 (&acc)[2][2][4][2], const Unit& u, int wr, int wc, int fr, int fq) const {
        const int row0 = u.pm * BM + wr * 64 + fr, colh = u.pn * HALF + wc * 32 + 8 * fq;
#pragma unroll
        for (int ai = 0; ai < 2; ++ai)
#pragma unroll
            for (int m = 0; m < 4; ++m) { f.pair8(u, row0 + ai * HALF + m * 16, colh, acc[ai][0][m][0], acc[ai][0][m][1], acc[ai][1][m][0], acc[ai][1][m][1]); asm volatile("" ::: "memory"); }
    }
};

template <class Epi, class Sched, class Loc>
__device__ __forceinline__ void gemm_phase(PG8_LAS unsigned char* lds, const Loc& L, const Sched& S, const Epi& E) {
    int tid_ = threadIdx.x; asm volatile("" : "+v"(tid_));
    const int tid = tid_, wid = __builtin_amdgcn_readfirstlane(tid >> 6), lane = tid & 63, wr = wid >> 2, wc = wid & 3, fr = lane & 15, fq = lane >> 4;
    const int K = L.K, nt = K / BK;
    unsigned voffB[2];
#pragma unroll
    for (int i = 0; i < 2; ++i) { int R, C; stage_rc(tid * 16 + i * 8192, R, C); const int Rb = Epi::PERM ? ((R & ~31) + perm32(R & 31)) : R;
        voffB[i] = (unsigned)(Rb * L.ldb + C) * 2u; }
    const size_t kstep = (size_t)(BK * 2);
    const size_t hstepB = (size_t)HALF * L.ldb * 2;
    const unsigned ldsw = (unsigned)wid * 1024u;
    const int aoff = lds_byte(wr * 64 + fr, fq * 8), boff = lds_byte(wc * 32 + fr, fq * 8);
#define PG8_SA(b, h) (((b) * 2 + (h)) * HTB)
#define PG8_SB(b, h) ((4 + (b) * 2 + (h)) * HTB)
#define PG8_STAGE(bufoff, gbase, voff) do { _Pragma("unroll") for (int _i = 0; _i < 2; ++_i) \
        __builtin_amdgcn_global_load_lds((const unsigned*)((const char*)(gbase) + (voff)[_i]), (PG8_LAS unsigned*)(lds + (bufoff) + ldsw + _i * 8192), 16, 0, 0); } while (0)
#define PG8_LDA(dst, b, h) do { _Pragma("unroll") for (int m = 0; m < 4; ++m) _Pragma("unroll") for (int k = 0; k < 2; ++k) dst[m][k] = *(const PG8_LAS bf16x8*)(lds + PG8_SA(b, h) + aoff + m * 2048 + k * 1024); } while (0)
#define PG8_LDB(dst, b, h) do { _Pragma("unroll") for (int n = 0; n < 2; ++n) _Pragma("unroll") for (int k = 0; k < 2; ++k) dst[n][k] = *(const PG8_LAS bf16x8*)(lds + PG8_SB(b, h) + boff + n * 2048 + k * 1024); } while (0)
#define PG8_MMA(ai, bj, At, Bt) do { __builtin_amdgcn_s_setprio(1); _Pragma("unroll") for (int m = 0; m < 4; ++m) _Pragma("unroll") for (int n = 0; n < 2; ++n) _Pragma("unroll") for (int k = 0; k < 2; ++k) \
        acc[ai][bj][m][n] = __builtin_amdgcn_mfma_f32_16x16x32_bf16(Bt[n][k], At[m][k], acc[ai][bj][m][n], 0, 0, 0); __builtin_amdgcn_s_setprio(0); } while (0)
#define PG8_WAIT_V(n) asm volatile("s_waitcnt vmcnt(" #n ")" ::: "memory")
#define PG8_WAIT_L(n) asm volatile("s_waitcnt lgkmcnt(" #n ")" ::: "memory")
#define PG8_BAR __builtin_amdgcn_s_barrier()
#define PG8_SCHED __builtin_amdgcn_sched_barrier(0)
    Unit cur, nxt; int ui = 0;
    if (!S.next(0, cur)) return;
    f32x4 acc[2][2][4][2];
#pragma unroll
    for (int a = 0; a < 2; ++a)
#pragma unroll
        for (int b = 0; b < 2; ++b)
#pragma unroll
            for (int m = 0; m < 4; ++m)
#pragma unroll
                for (int n = 0; n < 2; ++n) acc[a][b][m][n] = (f32x4){0.f, 0.f, 0.f, 0.f};
    bf16x8 At[4][2], B0[2][2], B1[2][2];
    constexpr int NVH = Loc::GATHER ? 2 : 1;
    unsigned vc[2][2], vn[NVH][2];
    L.a_off(cur, tid, vc);
    if constexpr (Loc::GATHER) {
#pragma unroll
        for (int h = 0; h < 2; ++h)
#pragma unroll
            for (int i = 0; i < 2; ++i) vn[h][i] = vc[h][i];
    }
    const size_t hstepA = Loc::GATHER ? 0 : (size_t)HALF * L.lda * 2;
    const char* cA = L.a_ptr(cur); const char* cB = L.b_ptr(cur);
    PG8_STAGE(PG8_SB(0, 0), cB, voffB); PG8_STAGE(PG8_SB(0, 1), cB + hstepB, voffB); PG8_STAGE(PG8_SA(0, 0), cA, vc[0]); PG8_STAGE(PG8_SA(0, 1), cA + hstepA, vc[NVH - 1]);
    if (wr == 1) PG8_BAR;
    PG8_WAIT_V(2); PG8_BAR;
    PG8_STAGE(PG8_SB(1, 0), cB + kstep, voffB); PG8_STAGE(PG8_SA(1, 0), cA + kstep, vc[0]); PG8_STAGE(PG8_SB(1, 1), cB + hstepB + kstep, voffB);
    PG8_WAIT_V(6); PG8_BAR;
    for (;;) {
        const bool has_next = S.next(ui + 1, nxt);
        const char* nA = has_next ? L.a_ptr(nxt) : cA; const char* nB = has_next ? L.b_ptr(nxt) : cB;
        if constexpr (Loc::GATHER) { if (has_next) L.a_tok(nxt, tid, vn); }
        for (int t = 0; t < nt; t += 2) {
            const bool last = (t == nt - 2);
            const char* a1 = cA + (size_t)(t + 1) * kstep;
            const char* a2 = last ? nA : cA + (size_t)(t + 2) * kstep; const char* b2 = last ? nB : cB + (size_t)(t + 2) * kstep;
            const char* a3 = a2 + kstep; const char* b3 = b2 + kstep;
            PG8_LDB(B0, 0, 0); PG8_LDB(B1, 0, 1); PG8_SCHED; PG8_LDA(At, 0, 0); PG8_STAGE(PG8_SA(1, 1), a1 + hstepA, vc[NVH - 1]);
            if constexpr (Loc::GATHER) { if (last && has_next) L.a_fin(tid, vn, vc); }
            PG8_WAIT_V(8); PG8_WAIT_L(0); PG8_BAR; PG8_MMA(0, 0, At, B0); PG8_MMA(0, 1, At, B1); PG8_BAR; PG8_SCHED;
            PG8_LDA(At, 0, 1); PG8_STAGE(PG8_SB(0, 0), b2, voffB); PG8_STAGE(PG8_SB(0, 1), b2 + hstepB, voffB); PG8_STAGE(PG8_SA(0, 0), a2, vc[0]);
            PG8_WAIT_V(8); PG8_WAIT_L(0); PG8_BAR; PG8_MMA(1, 0, At, B0); PG8_MMA(1, 1, At, B1); PG8_BAR; PG8_SCHED;
            PG8_LDB(B0, 1, 0); PG8_LDB(B1, 1, 1); PG8_SCHED; PG8_LDA(At, 1, 0); PG8_STAGE(PG8_SA(0, 1), a2 + hstepA, vc[NVH - 1]);
            PG8_WAIT_V(8); PG8_WAIT_L(0); PG8_BAR; PG8_MMA(0, 0, At, B0); PG8_MMA(0, 1, At, B1); PG8_BAR; PG8_SCHED;
            PG8_LDA(At, 1, 1); PG8_STAGE(PG8_SB(1, 0), b3, voffB); PG8_STAGE(PG8_SB(1, 1), b3 + hstepB, voffB); PG8_STAGE(PG8_SA(1, 0), a3, vc[0]);
            PG8_WAIT_V(8); PG8_WAIT_L(0); PG8_BAR; PG8_MMA(1, 0, At, B0); PG8_MMA(1, 1, At, B1); PG8_BAR; PG8_SCHED;
        }
        if (wr == 0) PG8_BAR;
        E(acc, cur, wr, wc, fr, fq);
        if (!has_next) break;
#pragma unroll
        for (int a = 0; a < 2; ++a)
#pragma unroll
            for (int b = 0; b < 2; ++b)
#pragma unroll
                for (int m = 0; m < 4; ++m)
#pragma unroll
                    for (int n = 0; n < 2; ++n) acc[a][b][m][n] = (f32x4){0.f, 0.f, 0.f, 0.f};
        cur = nxt; cA = nA; cB = nB; ++ui;
        if (wr == 1) PG8_BAR;
    }
    PG8_WAIT_V(0);
    PG8_BAR;
#undef PG8_SA
#undef PG8_SB
#undef PG8_STAGE
#undef PG8_LDA
#undef PG8_LDB
#undef PG8_MMA
#undef PG8_WAIT_V
#undef PG8_WAIT_L
#undef PG8_BAR
#undef PG8_SCHED
}
}
constexpr int NWAVES = 8;
constexpr int M = 32768, DM = 1024, SEQ = 4096, NBATCH = 8, NLAYER = 4;
constexpr int NH = 8;
constexpr int IN_W = 6048;
constexpr int FFN = 2816, EXD = 3584, NEXP = 8;
constexpr float LN_EPS = 1e-5f, ALPHA = 1.681792830507429f;
constexpr int S5T = 32, S5CH = M / S5T  , S5K = 640, S5NC = SEQ / S5T  ;
constexpr int MOE_CAP = 65536;
constexpr int MOE_ROWS = 65536 + 8 * 256;

constexpr size_t MiB = 1u << 20;
constexpr size_t WS_CTL = 0, CTL_ZERO_BYTES = 1 * MiB;
constexpr size_t WS_WIN = 1 * MiB;
constexpr size_t WS_WG = 25 * MiB;
constexpr size_t WS_WUQ = 49 * MiB;
constexpr size_t WS_WUKV = 52 * MiB;
constexpr size_t WS_WLORA = 54 * MiB;
constexpr size_t WS_WVRES = 57 * MiB;
constexpr size_t WS_WGLU = 59 * MiB;
constexpr size_t WS_WBR = 61 * MiB;
constexpr size_t WS_WOUT = 73 * MiB;
constexpr size_t WS_WFGU = 81 * MiB;
constexpr size_t WS_WFD = 103 * MiB;
constexpr size_t WS_S5MAIN = 898 * MiB;
constexpr size_t WS_S5END = 978 * MiB;
constexpr size_t WS_S5A32 = 1010 * MiB;
constexpr size_t WS_ROPE = 143 * MiB;
constexpr size_t WS_XB = 147 * MiB;
constexpr size_t WS_VFIRST = 211 * MiB;
constexpr size_t RB = 243 * MiB;
constexpr size_t WS_S5U = RB + 0;
constexpr size_t WS_S1 = RB + 40 * MiB;
constexpr size_t WS_MLARAW = WS_S1;
constexpr size_t WS_RWRAW = WS_S1 + 48 * MiB;
constexpr size_t WS_Q = WS_S1;
constexpr size_t WS_V = WS_S1 + 48 * MiB;
constexpr size_t WS_BV = WS_S1 + 80 * MiB;
constexpr size_t WS_DCY = WS_S1 + 112 * MiB;
constexpr size_t WS_YS5G = WS_S1;
constexpr size_t WS_YS5 = WS_S1 + 32 * MiB;
constexpr size_t WS_MIXED = WS_S1 + 64 * MiB;
constexpr size_t WS_R = RB + 200 * MiB;
constexpr size_t WS_KH = RB + 232 * MiB;
constexpr size_t WS_KKN = RB + 264 * MiB;
constexpr size_t WS_GL = RB + 296 * MiB;
constexpr size_t WS_GBUF = RB + 264 * MiB;
constexpr size_t WS_VFIN = RB + 328 * MiB;
constexpr size_t WS_K = RB + 360 * MiB;
constexpr size_t WS_VRAW = RB + 408 * MiB;
constexpr size_t WS_YRW = WS_VRAW;
constexpr size_t WS_S2 = RB + 440 * MiB;
constexpr size_t WS_CQN = WS_S2;
constexpr size_t WS_CKVN = WS_S2 + 24 * MiB;
constexpr size_t WS_LORAIN = WS_S2 + 40 * MiB;
constexpr size_t WS_YMLA = WS_S2;
constexpr size_t WS_XEND = RB + 496 * MiB;
constexpr size_t WS_GBUF2 = RB + 512 * MiB;
constexpr size_t WS_MIXED2 = RB + 576 * MiB;
constexpr size_t WS_HB = RB + 0;
constexpr size_t WS_WMGU = RB + 0;
constexpr size_t WS_YPAIR = RB + 0;
constexpr size_t WS_HM = RB + 132 * MiB;
constexpr size_t WS_WMD = RB + 594 * MiB;
constexpr size_t WS_SLOTTOK = RB + 650 * MiB;
constexpr size_t WS_SLOTW = RB + 652 * MiB;
constexpr size_t WS_PAIRPOS = RB + 654 * MiB;
constexpr size_t WS_END = 1011 * MiB;
constexpr int CW_BAR = 4096;
constexpr int CW_ATTN = 200000;
constexpr int CW_MOECNT = 201024;

constexpr int RING_OFF = 0, RING_BYTES = 131072;
constexpr int LDSCTL_OFF = RING_BYTES, MISC_OFF = LDSCTL_OFF + 320;
constexpr int LDS_BYTES = 147456;

#define GAS __attribute__((address_space(1)))
#define LAS __attribute__((address_space(3)))
typedef unsigned short bf16;
typedef _Float16 f16;
typedef f16 f16x8 __attribute__((ext_vector_type(8)));
typedef unsigned v4u __attribute__((ext_vector_type(4)));
typedef unsigned v2u __attribute__((ext_vector_type(2)));
typedef float f32x4 __attribute__((ext_vector_type(4)));
typedef float f32x16 __attribute__((ext_vector_type(16)));
typedef short bf16x8 __attribute__((ext_vector_type(8)));
typedef short s16x4 __attribute__((ext_vector_type(4)));
typedef GAS unsigned gu32;
#define RLX_AGENT __ATOMIC_RELAXED, __HIP_MEMORY_SCOPE_AGENT
#define LDS_WAIT() asm volatile("s_waitcnt lgkmcnt(0)" ::: "memory")
using pg8::cvt_pk_bf16; using pg8::pack8; using pg8::unpack8; using pg8::bf_lo; using pg8::bf_hi;

__device__ __forceinline__ float sigm(float x) { return __builtin_amdgcn_rcpf(1.0f + __expf(-x)); }
__device__ __forceinline__ float gelu_tanh(float y) { const float u = 0.7978845608028654f * (y + 0.044715f * y * y * y); const float t = 1.0f - 2.0f * __builtin_amdgcn_rcpf(__expf(2.0f * u) + 1.0f); return 0.5f * y * (1.0f + t); }
__device__ __forceinline__ float wave_sum(float v) {
#pragma unroll
    for (int o = 1; o < 64; o <<= 1) v += __shfl_xor(v, o);
    return v;
}
__device__ __forceinline__ v4u ld_nt16(const void* p) { return __builtin_nontemporal_load((const v4u*)p); }
__device__ __forceinline__ void f16x8_to_f32(const f16x8 h, float (&o)[8]) {
#pragma unroll
    for (int j = 0; j < 8; ++j) o[j] = (float)h[j];
}
__device__ __forceinline__ f16x8 f32_to_f16x8(const float (&v)[8]) { f16x8 h;
#pragma unroll
    for (int j = 0; j < 8; ++j) h[j] = (f16)v[j];
    return h; }
__device__ __forceinline__ void bf16x8_to_f32(const v4u w, float (&o)[8]) { o[0] = bf_lo(w.x); o[1] = bf_hi(w.x); o[2] = bf_lo(w.y); o[3] = bf_hi(w.y); o[4] = bf_lo(w.z); o[5] = bf_hi(w.z); o[6] = bf_lo(w.w); o[7] = bf_hi(w.w); }
__device__ __forceinline__ v4u f32_to_bf16x8(const float (&v)[8]) { v4u w; w.x = cvt_pk_bf16(v[0], v[1]); w.y = cvt_pk_bf16(v[2], v[3]); w.z = cvt_pk_bf16(v[4], v[5]); w.w = cvt_pk_bf16(v[6], v[7]); return w; }
__device__ __forceinline__ void ld8f(const float* p, float (&o)[8]) { const f32x4 a = *(const f32x4*)p, b = *(const f32x4*)(p + 4); o[0] = a[0]; o[1] = a[1]; o[2] = a[2]; o[3] = a[3]; o[4] = b[0]; o[5] = b[1]; o[6] = b[2]; o[7] = b[3]; }

#define XB_TMO      128
#define XB_XCNT(j)  (256  + 64 * (j))
#define XB_XSUB(j)  (1280 + 64 * (j))
#define XB_XGEN(j)  (2304 + 64 * (j))
#define XB_TOP      3328
#define XB_TOPGEN   3392
#define XCD_BAR_WORDS 3456
#define XB_SPIN_CAP (1u << 20)

__device__ __forceinline__ unsigned xb_ld(unsigned* p)              { return __hip_atomic_load(p, __ATOMIC_RELAXED, __HIP_MEMORY_SCOPE_AGENT); }
__device__ __forceinline__ unsigned xb_add(unsigned* p, unsigned v) { return __hip_atomic_fetch_add(p, v, __ATOMIC_RELAXED, __HIP_MEMORY_SCOPE_AGENT); }
__device__ __forceinline__ unsigned xb_xcc_id() { return (unsigned)__builtin_amdgcn_s_getreg((3 << 11) | 20) & 0xFu; }
#define XB_SPIN(cond, bar) do { unsigned _sp = 0; while (cond) { __builtin_amdgcn_s_sleep(1); \
    if ((++_sp & 255u) == 0u) { if (xb_ld(&(bar)[XB_TMO])) break; if (_sp > XB_SPIN_CAP) { atomicAdd(&(bar)[XB_TMO], 1u); break; } } } } while (0)

struct XcdBarrier { unsigned* bar; unsigned x; volatile LAS unsigned* st; };

__device__ __forceinline__ XcdBarrier xcd_barrier_post(unsigned* bar, volatile LAS unsigned* st) {
    XcdBarrier b; b.bar = bar; b.x = xb_xcc_id(); b.st = st;
    if (threadIdx.x == 0) (void)xb_add(&bar[XB_XCNT(b.x)], 1u);
    return b;
}
__device__ __forceinline__ void xcd_barrier_complete(unsigned* bar, unsigned x, unsigned& nloc, unsigned& nx) {
    const unsigned G = gridDim.x * gridDim.y * gridDim.z;
    unsigned sum, cnt, mine, sp = 0u;
    for (;;) {
        sum = 0u; cnt = 0u; mine = 0u;
#pragma unroll
        for (unsigned j = 0; j < 16; ++j) { const unsigned c = xb_ld(&bar[XB_XCNT(j)]); sum += c; cnt += (c > 0u) ? 1u : 0u; mine = (j == x) ? c : mine; }
        if (sum == G) break;
        __builtin_amdgcn_s_sleep(1);
        if ((++sp & 255u) == 0u) { if (xb_ld(&bar[XB_TMO])) break; if (sp > XB_SPIN_CAP) { atomicAdd(&bar[XB_TMO], 1u); break; } }
    }
    nloc = mine > 0u ? mine : 1u; nx = cnt > 0u ? cnt : 1u;
}
__device__ __forceinline__ void xcd_barrier(const XcdBarrier& b) {
    asm volatile("s_waitcnt vmcnt(0)" ::: "memory");
    __syncthreads();
    if (threadIdx.x == 0) {
        unsigned* bar = b.bar;
        __builtin_amdgcn_s_waitcnt(0);
        unsigned nloc = b.st[0], nx = b.st[1];
        if (nloc == 0u) { xcd_barrier_complete(bar, b.x, nloc, nx); b.st[0] = nloc; b.st[1] = nx; }
        const unsigned old = xb_add(&bar[XB_XSUB(b.x)], 1u);
        const unsigned gen = old / nloc;
        if (old + 1u == (gen + 1u) * nloc) {
            __builtin_amdgcn_fence(__ATOMIC_RELEASE, "agent");
            asm volatile("s_waitcnt vmcnt(0)" ::: "memory");
            const unsigned og = xb_add(&bar[XB_TOP], 1u);
            const unsigned tg = og / nx;
            if (og + 1u == (tg + 1u) * nx) xb_add(&bar[XB_TOPGEN], 1u);
            else XB_SPIN(xb_ld(&bar[XB_TOPGEN]) == tg, bar);
            __builtin_amdgcn_fence(__ATOMIC_ACQUIRE, "agent");
            xb_add(&bar[XB_XGEN(b.x)], 1u);
            asm volatile("s_waitcnt vmcnt(0)" ::: "memory");
        } else {
            XB_SPIN(xb_ld(&bar[XB_XGEN(b.x)]) == gen, bar);
            __builtin_amdgcn_fence(__ATOMIC_ACQUIRE, "agent");
            asm volatile("s_waitcnt vmcnt(0)" ::: "memory");
        }
    }
    __syncthreads();
}

struct Args { const void* in[44]; float* out; unsigned char* ws; int ph_lo, ph_hi, li, pad; };
typedef const __attribute__((address_space(4))) Args* KArgs;
struct Frame {
    LAS unsigned char* lds;
    unsigned char* ws;
    gu32* ctl;
    int tid, lane, wave;
    int G, blk;
    float* out;
    KArgs ka;
};
#define MKFRAME(F) Frame F; { int t_ = threadIdx.x; asm volatile("" : "+v"(t_)); KArgs k_ = (KArgs)__builtin_amdgcn_kernarg_segment_ptr(); asm volatile("" : "+s"(k_)); \
    F.lds = (LAS unsigned char*)lds_raw; F.ka = k_; F.ws = k_->ws; F.ctl = (gu32*)(k_->ws + WS_CTL); F.out = k_->out; F.tid = t_; F.lane = t_ & 63; F.wave = __builtin_amdgcn_readfirstlane(t_ >> 6); F.G = gridDim.x; F.blk = blockIdx.x; }
#define WSP(T, off) ((T*)(F.ws + (off)))
#define INP(T, i) ((const T*)F.ka->in[i])
using pg8::Unit; using pg8::Epi8; using pg8::EpiGU;
__device__ __forceinline__ void f4x2_to8(const f32x4 v0, const f32x4 v1, float (&o)[8]) { o[0] = v0[0]; o[1] = v0[1]; o[2] = v0[2]; o[3] = v0[3]; o[4] = v1[0]; o[5] = v1[1]; o[6] = v1[2]; o[7] = v1[3]; }

struct FProj {
    static constexpr int BATCH = 8; bf16* mla; bf16* rw; bf16* s5u;
    __device__ __forceinline__ void begin_col(const Unit&, int) {}
    typedef pg8::NoPre Pre; __device__ __forceinline__ Pre pre(const Unit&, int, int) const { return Pre{}; }
    __device__ __forceinline__ void tile8(const Unit&, int row, int col, const f32x4 v0, const f32x4 v1, const Pre&) const {
        const v4u w = pack8(v0, v1);
        if (col < 768) *(v4u*)(mla + (unsigned)row * 768 + col) = w;
        else if (col < 2560) *(v4u*)(rw + (unsigned)row * 1792 + (col - 768)) = w;
        else { const int c = col - 2560, g = c >> 4, i = c & 15; *(v4u*)(s5u + (unsigned)((g * S5CH + (row >> 5)) * S5K) + (row & 31) * 16 + i) = w; }
    }
};
struct FQup {
    static constexpr int BATCH = 4; bf16* Q; const float* cs; float qs;
    struct Pre { f32x4 c, s; };
    __device__ __forceinline__ void begin_col(const Unit&, int) {}
    __device__ __forceinline__ Pre pre(const Unit&, int row, int col) const { Pre p; const int head = col / 96, w = (col - head * 96) >> 3;
        if (w >= 8) { const int i0 = (w - 8) * 4; p.c = *(const f32x4*)(cs + (unsigned)row * 32 + i0); p.s = *(const f32x4*)(cs + (unsigned)row * 32 + 16 + i0); } else { p.c = (f32x4){0.f, 0.f, 0.f, 0.f}; p.s = p.c; } return p; }
    __device__ __forceinline__ void tile8(const Unit&, int row, int col, const f32x4 v0, const f32x4 v1, const Pre& p) const {
        const int head = col / 96, w = (col - head * 96) >> 3;
        bf16* q = Q + (unsigned)row * 768 + head * 96;
        if (w < 8) { *(v4u*)(q + 8 * w) = pack8(v0 * qs, v1 * qs); }
        else { const int i0 = (w - 8) * 4; const f32x4 c = p.c, s = p.s;
            const f32x4 x1 = (f32x4){v0[0], v0[2], v1[0], v1[2]}, x2 = (f32x4){v0[1], v0[3], v1[1], v1[3]};
            const f32x4 o1 = (x1 * c - x2 * s) * qs, o2 = (x1 * s + x2 * c) * qs;
            v2u a, b; a.x = cvt_pk_bf16(o1[0], o1[1]); a.y = cvt_pk_bf16(o1[2], o1[3]); b.x = cvt_pk_bf16(o2[0], o2[1]); b.y = cvt_pk_bf16(o2[2], o2[3]);
            *(v2u*)(q + 64 + i0) = a; *(v2u*)(q + 80 + i0) = b; }
    }
};
struct FKVup {
    static constexpr int BATCH = 8; bf16* K; bf16* V;
    __device__ __forceinline__ void begin_col(const Unit&, int) {}
    typedef pg8::NoPre Pre; __device__ __forceinline__ Pre pre(const Unit&, int, int) const { return Pre{}; }
    __device__ __forceinline__ void tile8(const Unit&, int row, int col, const f32x4 v0, const f32x4 v1, const Pre&) const {
        const int head = col >> 7, d = col & 127; const v4u w = pack8(v0, v1);
        if (d < 64) *(v4u*)(K + (unsigned)row * 768 + head * 96 + d) = w; else *(v4u*)(V + (unsigned)row * 512 + head * 64 + (d - 64)) = w;
    }
};
struct FLora {
    static constexpr int BATCH = 4;
    const float* w0; const float* a0; const float* k_a; f16* dcy; f16* kh; const f16* kkn; f16* bv; bf16* gl; float p[8], ka[8];
    struct Pre { f16x8 k, kn; };
    __device__ __forceinline__ void begin_col(const Unit&, int col) { const int seg = col >> 9, c = col & 511; ld8f(((seg == 0) ? w0 : a0) + c, p); ld8f(k_a + c, ka); }
    __device__ __forceinline__ Pre pre(const Unit&, int row, int col) const { Pre r; const unsigned off = (unsigned)row * 512 + (col & 511);
        if ((col >> 9) == 1) { r.k = *(const f16x8*)(kh + off); r.kn = *(const f16x8*)(kkn + off); } else { r.k = (f16x8)(0); r.kn = (f16x8)(0); } return r; }
    __device__ __forceinline__ void tile8(const Unit&, int row, int col, const f32x4 v0, const f32x4 v1, const Pre& pr) const {
        float a[8]; f4x2_to8(v0, v1, a);
        const int seg = col >> 9, c = col & 511; const unsigned off = (unsigned)row * 512 + c;
        if (seg == 0) { float o[8];
#pragma unroll
            for (int j = 0; j < 8; ++j) { const float e = 0.6065306597126334f * sigm(p[j] + a[j]); o[j] = -expm1f(-e); }
            *(f16x8*)(dcy + off) = f32_to_f16x8(o); }
        else if (seg == 1) { float k[8], kn[8]; f16x8_to_f32(pr.k, k); f16x8_to_f32(pr.kn, kn); float o1[8], o2[8];
#pragma unroll
            for (int j = 0; j < 8; ++j) { const float ic = sigm(p[j] + a[j]); o1[j] = k[j] * (1.0f + (ic - 1.0f) * ka[j]); o2[j] = kn[j] * ic; }
            *(f16x8*)(kh + off) = f32_to_f16x8(o1); *(f16x8*)(bv + off) = f32_to_f16x8(o2); }
        else { *(v4u*)(gl + off) = pack8(v0, v1); }
    }
};
struct FVres {
    static constexpr int BATCH = 4;
    const float* vb; const bf16* vraw; const bf16* vfirst; f16* vfin; float p[8];
    struct Pre { v4u v, vf; };
    __device__ __forceinline__ void begin_col(const Unit&, int col) { ld8f(vb + col, p); }
    __device__ __forceinline__ Pre pre(const Unit&, int row, int col) const { Pre r; const unsigned off = (unsigned)row * 512 + col; r.v = *(const v4u*)(vraw + off); r.vf = *(const v4u*)(vfirst + off); return r; }
    __device__ __forceinline__ void tile8(const Unit&, int row, int col, const f32x4 v0, const f32x4 v1, const Pre& pr) const {
        float a[8], v[8], vf[8], o[8]; f4x2_to8(v0, v1, a); const unsigned off = (unsigned)row * 512 + col;
        bf16x8_to_f32(pr.v, v); bf16x8_to_f32(pr.vf, vf);
#pragma unroll
        for (int j = 0; j < 8; ++j) o[j] = v[j] + (vf[j] - v[j]) * sigm(p[j] + a[j]);
        *(f16x8*)(vfin + off) = f32_to_f16x8(o);
    }
};
struct FS5End {
    static constexpr int BATCH = 8; float* xend;
    __device__ __forceinline__ void begin_col(const Unit&, int) {}
    typedef pg8::NoPre Pre; __device__ __forceinline__ Pre pre(const Unit&, int, int) const { return Pre{}; }
    __device__ __forceinline__ void tile8(const Unit& u, int row, int col, const f32x4 v0, const f32x4 v1, const Pre&) const {
        if (col < 128) { float* p = xend + (unsigned)((u.z * S5CH + row) * 128 + col); *(f32x4*)p = v0; *(f32x4*)(p + 4) = v1; }
    }
};
struct FS5Main {
    static constexpr int BATCH = 8;
    const bf16* s5u; const float* dvec; bf16* ys5g; float d[8];
    struct Pre { v4u uu; };
    __device__ __forceinline__ void begin_col(const Unit& u, int col) { ld8f(dvec + u.z * 16 + (col & 15), d); }
    __device__ __forceinline__ Pre pre(const Unit& u, int row, int col) const { Pre r; r.uu = *(const v4u*)(s5u + (unsigned)((u.z * S5CH + row) * S5K + col)); return r; }
    __device__ __forceinline__ void tile8(const Unit& u, int row, int col, const f32x4 v0, const f32x4 v1, const Pre& pr) const {
        float a[8], uu[8], o[8]; f4x2_to8(v0, v1, a); const int g = u.z, t = col >> 4, o0 = col & 15;
        bf16x8_to_f32(pr.uu, uu);
#pragma unroll
        for (int j = 0; j < 8; ++j) o[j] = gelu_tanh(a[j] + d[j] * uu[j]);
        *(v4u*)(ys5g + ((unsigned)row * 32 + t) * 512 + g * 16 + o0) = f32_to_bf16x8(o);
    }
};
struct FGlu {
    static constexpr int BATCH = 8;
    const bf16* ys5g; const float* bglu; bf16* ys5; float b[8];
    struct Pre { v4u y; };
    __device__ __forceinline__ void begin_col(const Unit&, int col) { ld8f(bglu + col, b); }
    __device__ __forceinline__ Pre pre(const Unit&, int row, int col) const { Pre r; r.y = *(const v4u*)(ys5g + (unsigned)row * 512 + col); return r; }
    __device__ __forceinline__ void tile8(const Unit&, int row, int col, const f32x4 v0, const f32x4 v1, const Pre& pr) const {
        float a[8], y[8], o[8]; f4x2_to8(v0, v1, a); const unsigned off = (unsigned)row * 512 + col; bf16x8_to_f32(pr.y, y);
#pragma unroll
        for (int j = 0; j < 8; ++j) o[j] = y[j] * sigm(a[j] + b[j]);
        *(v4u*)(ys5 + off) = f32_to_bf16x8(o);
    }
};
struct FGate {
    static constexpr int BATCH = 8; bf16* gbuf;
    __device__ __forceinline__ void begin_col(const Unit&, int) {}
    typedef pg8::NoPre Pre; __device__ __forceinline__ Pre pre(const Unit&, int, int) const { return Pre{}; }
    __device__ __forceinline__ void tile8(const Unit&, int row, int col, const f32x4 v0, const f32x4 v1, const Pre&) const {
        float a[8], o[8]; f4x2_to8(v0, v1, a);
#pragma unroll
        for (int j = 0; j < 8; ++j) o[j] = sigm(a[j]);
        *(v4u*)(gbuf + (unsigned)row * 1024 + col) = f32_to_bf16x8(o);
    }
};
struct FGate2 {
    static constexpr int BATCH = 8; bf16* g0; bf16* g1;
    __device__ __forceinline__ void begin_col(const Unit&, int) {}
    typedef pg8::NoPre Pre; __device__ __forceinline__ Pre pre(const Unit&, int, int) const { return Pre{}; }
    __device__ __forceinline__ void tile8(const Unit&, int row, int col, const f32x4 v0, const f32x4 v1, const Pre&) const {
        float a[8], o[8]; f4x2_to8(v0, v1, a);
#pragma unroll
        for (int j = 0; j < 8; ++j) o[j] = sigm(a[j]);
        bf16* g = (col < 1024) ? g0 : g1;
        *(v4u*)(g + (unsigned)row * 1024 + (col & 1023)) = f32_to_bf16x8(o);
    }
};
struct FMerge {
    static constexpr int BATCH = 8; const bf16* gbuf; const bf16* min_; bf16* mout; int first;
    struct Pre { v4u g, m; };
    __device__ __forceinline__ void begin_col(const Unit&, int) {}
    __device__ __forceinline__ Pre pre(const Unit&, int row, int col) const { Pre r; const unsigned off = (unsigned)row * 1024 + col; r.g = *(const v4u*)(gbuf + off); if (!first) r.m = *(const v4u*)(min_ + off); else r.m = (v4u){0u, 0u, 0u, 0u}; return r; }
    __device__ __forceinline__ void tile8(const Unit&, int row, int col, const f32x4 v0, const f32x4 v1, const Pre& pr) const {
        float a[8], g[8], mprev[8], o[8]; f4x2_to8(v0, v1, a); const unsigned off = (unsigned)row * 1024 + col; bf16x8_to_f32(pr.g, g); bf16x8_to_f32(pr.m, mprev);
#pragma unroll
        for (int j = 0; j < 8; ++j) o[j] = mprev[j] + g[j] * a[j];
        *(v4u*)(mout + off) = f32_to_bf16x8(o);
    }
};
struct FResid {
    static constexpr int BATCH = 8; const bf16* xin; f16* xout;
    struct Pre { v4u x; };
    __device__ __forceinline__ void begin_col(const Unit&, int) {}
    __device__ __forceinline__ Pre pre(const Unit&, int row, int col) const { Pre r; r.x = *(const v4u*)(xin + (unsigned)row * 1024 + col); return r; }
    __device__ __forceinline__ void tile8(const Unit&, int row, int col, const f32x4 v0, const f32x4 v1, const Pre& pr) const {
        float x[8], a[8], o[8]; bf16x8_to_f32(pr.x, x); f4x2_to8(v0, v1, a);
#pragma unroll
        for (int j = 0; j < 8; ++j) o[j] = x[j] * ALPHA + a[j];
        *(f16x8*)(xout + (unsigned)row * 1024 + col) = f32_to_f16x8(o);
    }
};
struct FSwiglu {
    bf16* h; int ldh;
    __device__ __forceinline__ void pair8(const Unit&, int row, int colh, const f32x4 g0, const f32x4 g1, const f32x4 u0, const f32x4 u1) const {
        float g[8], uu[8], o[8]; f4x2_to8(g0, g1, g); f4x2_to8(u0, u1, uu);
#pragma unroll
        for (int j = 0; j < 8; ++j) o[j] = g[j] * sigm(g[j]) * uu[j];
        *(v4u*)(h + (unsigned)row * ldh + colh) = f32_to_bf16x8(o);
    }
};
struct FMoeDown {
    static constexpr int BATCH = 8; bf16* ypair; const float* slotw; const unsigned* cnt;
    struct Pre { float w; };
    __device__ __forceinline__ void begin_col(const Unit&, int) {}
    __device__ __forceinline__ Pre pre(const Unit& u, int row, int) const { Pre r; const int rk = u.aux + (row - u.pm * 256); r.w = ((unsigned)rk < cnt[u.z]) ? slotw[(unsigned)(u.z * MOE_CAP + rk)] : 0.f; return r; }
    __device__ __forceinline__ void tile8(const Unit& u, int row, int col, const f32x4 v0, const f32x4 v1, const Pre& pr) const {
        const int rk = u.aux + (row - u.pm * 256);
        if ((unsigned)rk < cnt[u.z]) *(v4u*)(ypair + (unsigned)row * 1024 + col) = pack8(v0 * pr.w, v1 * pr.w);
    }
};

struct MoeOrder {
    int nN, G, c; int pt[NEXP + 1];
    __device__ void init(const unsigned* cnt, int nN_, int G_, int c_) { nN = nN_; G = G_; c = c_; pt[0] = 0;
#pragma unroll
        for (int e = 0; e < NEXP; ++e) pt[e + 1] = pt[e] + (int)((cnt[e] + 255u) >> 8); }
    __device__ bool next(int i, Unit& u) const {
        const int nM = pt[NEXP], nwg = nM * nN; const long L = (long)i * G + c; if (L >= (long)nwg) return false;
        int wgid = (int)L; { const int q = nwg / pg8::NXCD, r = nwg % pg8::NXCD, xcd = wgid % pg8::NXCD, off = wgid / pg8::NXCD; wgid = (xcd < r ? xcd * (q + 1) : r * (q + 1) + (xcd - r) * q) + off; }
        const int nig = pg8::WGM * nN, gid = wgid / nig, fm = gid * pg8::WGM, gsz = (nM - fm) < pg8::WGM ? (nM - fm) : pg8::WGM;
        const int tile = fm + ((wgid % nig) % gsz); u.pn = (wgid % nig) / gsz; int e = 0;
#pragma unroll
        for (int k = 1; k < NEXP; ++k) e += (tile >= pt[k]) ? 1 : 0;
        int base = 0;
#pragma unroll
        for (int k = 1; k < NEXP; ++k) base = (tile >= pt[k]) ? pt[k] : base;
        u.z = e; u.pm = tile; u.aux = (tile - base) * 256; return true;
    }
};
struct LocMoe1 {
    static constexpr bool GATHER = true;
    const bf16* A; const bf16* Bt; int lda, ldb, K; const int* slot_tok; const unsigned* cnt;
    __device__ __forceinline__ const char* a_ptr(const Unit&) const { return (const char*)A; }
    __device__ __forceinline__ const char* b_ptr(const Unit& u) const { return (const char*)(Bt + (size_t)u.z * (2 * EXD) * DM + (size_t)u.pn * 256 * ldb); }
    __device__ __forceinline__ void a_tok(const Unit& u, int tid, unsigned (&v)[2][2]) const {
        const unsigned n = cnt[u.z];
#pragma unroll
        for (int i = 0; i < 2; ++i) { int R, C; pg8::stage_rc(tid * 16 + i * 8192, R, C);
#pragma unroll
            for (int h = 0; h < 2; ++h) { const int r = u.aux + h * 128 + R; v[h][i] = ((unsigned)r < n) ? (unsigned)slot_tok[(unsigned)(u.z * MOE_CAP + r)] : 0u; } }
    }
    __device__ __forceinline__ void a_fin(int tid, const unsigned (&t)[2][2], unsigned (&v)[2][2]) const {
#pragma unroll
        for (int i = 0; i < 2; ++i) { int R, C; pg8::stage_rc(tid * 16 + i * 8192, R, C);
#pragma unroll
            for (int h = 0; h < 2; ++h) v[h][i] = (t[h][i] * (unsigned)lda + (unsigned)C) * 2u; }
    }
    __device__ __forceinline__ void a_off(const Unit& u, int tid, unsigned (&v)[2][2]) const { unsigned t[2][2]; a_tok(u, tid, t); a_fin(tid, t, v); }
};
__device__ __forceinline__ int qperm_row(int n) { const int h = n / 96, d = n - h * 96; if (d < 64) return n; const int e = d - 64; return h * 96 + 64 + ((e < 16) ? 2 * e : 2 * (e - 16) + 1); }
struct TrDesc { const float* W; const float* ksc; bf16* WT; int ldw, k0, n0, ldd, kdst, drow0, qperm; };
struct TrRegs { f32x4 v[8]; };
__device__ __forceinline__ void tr_load(const TrDesc& d, TrRegs& r, int lane) {
    if (d.W) {
#pragma unroll
        for (int i = 0; i < 8; ++i) { const int kk = (lane >> 3) + 8 * i; f32x4 v = *(const f32x4*)(d.W + (size_t)(d.k0 + kk) * d.ldw + d.n0 + 4 * (lane & 7)); if (d.ksc) v = v * d.ksc[d.k0 + kk]; r.v[i] = v; }
    } else {
#pragma unroll
        for (int i = 0; i < 8; ++i) r.v[i] = (f32x4){0.f, 0.f, 0.f, 0.f};
    }
}
__device__ __forceinline__ void tr_finish(const TrDesc& d, const TrRegs& r, LAS float* scr, int lane) {
#pragma unroll
    for (int i = 0; i < 8; ++i) { const int kk = (lane >> 3) + 8 * i; LAS float* s = scr + kk * 33 + 4 * (lane & 7); s[0] = r.v[i][0]; s[1] = r.v[i][1]; s[2] = r.v[i][2]; s[3] = r.v[i][3]; }
    LDS_WAIT(); asm volatile("" ::: "memory");
    const int c = lane & 7;
#pragma unroll
    for (int j = 0; j < 4; ++j) { const int n = (lane >> 3) + 8 * j; const LAS float* s = scr + (8 * c) * 33 + n;
        v4u o; o.x = cvt_pk_bf16(s[0 * 33], s[1 * 33]); o.y = cvt_pk_bf16(s[2 * 33], s[3 * 33]); o.z = cvt_pk_bf16(s[4 * 33], s[5 * 33]); o.w = cvt_pk_bf16(s[6 * 33], s[7 * 33]);
        const int dr = d.qperm ? qperm_row(d.n0 + n) : (d.drow0 + n);
        *(v4u*)(d.WT + (size_t)dr * d.ldd + d.kdst + 8 * c) = o; }
    LDS_WAIT(); asm volatile("" ::: "memory");
}
__device__ __forceinline__ bool trjob(int& r, TrDesc& d, const float* W, int ldw, int K, int c0, int ncols, const float* ksc, bf16* WT, int ldd, int drow0) {
    const int nb = ncols / 32, ni = (K / 64) * nb; if (r < ni) { const int kb = r / nb, nbi = r % nb; d = TrDesc{W, ksc, WT, ldw, 64 * kb, c0 + 32 * nbi, ldd, 64 * kb, drow0 + 32 * nbi, 0}; return true; } r -= ni; return false; }
__device__ __forceinline__ bool trjob_gu(int& r, TrDesc& d, const float* W, int ldw, int K, int ncols, bf16* WT, int ldd, int up) {
    const int nb = ncols / 32, ni = (K / 64) * nb; if (r < ni) { const int kb = r / nb, n0 = 32 * (r % nb); d = TrDesc{W, nullptr, WT, ldw, 64 * kb, n0, ldd, 64 * kb, (n0 >> 7) * 256 + (n0 & 127) + (up ? 128 : 0), 0}; return true; } r -= ni; return false; }

constexpr int TR_PER_LAYER = 16 * 189 + 6 * 24 + 4 * 32 + 192 + 8 * 16 + 3 * 8 * 32 + 16 * 32 + 3 * 16;
constexpr int TR_PER_FFN = 3 * 16 * 88, TR_PROLOGUE = NLAYER * TR_PER_LAYER + 2 * TR_PER_FFN;
__device__ __forceinline__ void tr_decode_prologue(Frame& F, int it, TrDesc& d) {
    if (it < NLAYER * TR_PER_LAYER) {
        const int l = it / TR_PER_LAYER; int r = it % TR_PER_LAYER;
        const float* win = INP(float, 2) + (size_t)l * DM * IN_W;
        bf16* win_t = WSP(bf16, WS_WIN) + (size_t)l * 3072 * DM; bf16* wg_t = WSP(bf16, WS_WG) + (size_t)l * 3072 * DM;
        if (trjob(r, d, win, IN_W, DM, 0, 672, nullptr, win_t, DM, 0)) return;
        if (trjob(r, d, win, IN_W, DM, 672, 2304, nullptr, win_t, DM, 768)) return;
        if (trjob(r, d, win, IN_W, DM, 2976, 3072, nullptr, wg_t, DM, 0)) return;
        if (r < 48) { d = TrDesc{nullptr, nullptr, win_t, 0, 64 * (r / 3), 0, DM, 64 * (r / 3), 672 + 32 * (r % 3), 0}; return; } r -= 48;
        if (r < 144) { const int kb = r / 24, nbi = r % 24; d = TrDesc{INP(float, 4) + (size_t)l * 384 * 768, INP(float, 3) + l * 384, WSP(bf16, WS_WUQ) + (size_t)l * 768 * 384, 768, 64 * kb, 32 * nbi, 384, 64 * kb, 0, 1}; return; } r -= 144;
        if (trjob(r, d, INP(float, 6) + (size_t)l * 256 * 1024, 1024, 256, 0, 1024, INP(float, 5) + l * 256, WSP(bf16, WS_WUKV) + (size_t)l * 1024 * 256, 256, 0)) return;
        if (r < 192) { const int rb = r / 4, kb = r % 4; bf16* wl = WSP(bf16, WS_WLORA) + (size_t)l * 1536 * 256; const float* src = nullptr; int k0 = 0, n0 = 0;
            if (rb < 16) { if (kb == 0) { src = INP(float, 9) + (size_t)l * 64 * 512; n0 = 32 * rb; } }
            else if (rb < 32) { if (kb == 1) { src = INP(float, 11) + (size_t)l * 64 * 512; n0 = 32 * (rb - 16); } }
            else { if (kb >= 2) { src = INP(float, 12) + (size_t)l * 128 * 512; k0 = 64 * (kb - 2); n0 = 32 * (rb - 32); } }
            d = TrDesc{src, nullptr, wl, 512, k0, n0, 256, 64 * kb, 32 * rb, 0}; return; } r -= 192;
        if (trjob(r, d, INP(float, 29) + (size_t)l * 512 * 512, 512, 512, 0, 512, nullptr, WSP(bf16, WS_WGLU) + (size_t)l * 512 * 512, 512, 0)) return;
        if (trjob(r, d, INP(float, 31) + (size_t)(l * 3 + 0) * 512 * 1024, 1024, 512, 0, 1024, nullptr, WSP(bf16, WS_WBR) + (size_t)(l * 3 + 0) * 1024 * 512, 512, 0)) return;
        if (trjob(r, d, INP(float, 31) + (size_t)(l * 3 + 1) * 512 * 1024, 1024, 512, 0, 1024, nullptr, WSP(bf16, WS_WBR) + (size_t)(l * 3 + 1) * 1024 * 512, 512, 0)) return;
        if (trjob(r, d, INP(float, 31) + (size_t)(l * 3 + 2) * 512 * 1024, 1024, 512, 0, 1024, nullptr, WSP(bf16, WS_WBR) + (size_t)(l * 3 + 2) * 1024 * 512, 512, 0)) return;
        (void)trjob(r, d, INP(float, 32) + (size_t)l * DM * DM, DM, DM, 0, DM, nullptr, WSP(bf16, WS_WOUT) + (size_t)l * DM * DM, DM, 0);
    } else {
        const int q = it - NLAYER * TR_PER_LAYER, i = q / TR_PER_FFN; int r = q % TR_PER_FFN;
        if (trjob_gu(r, d, INP(float, 37) + (size_t)i * DM * FFN, FFN, DM, FFN, WSP(bf16, WS_WFGU) + (size_t)i * 2 * FFN * DM, DM, 0)) return;
        if (trjob_gu(r, d, INP(float, 38) + (size_t)i * DM * FFN, FFN, DM, FFN, WSP(bf16, WS_WFGU) + (size_t)i * 2 * FFN * DM, DM, 1)) return;
        (void)trjob(r, d, INP(float, 39) + (size_t)i * FFN * DM, DM, FFN, 0, DM, nullptr, WSP(bf16, WS_WFD) + (size_t)i * DM * FFN, FFN, 0);
    }
}
constexpr int TR_PER_E = 2 * 16 * 112 + 56 * 32;
__device__ __forceinline__ void tr_decode_moe(Frame& F, int li, int it, TrDesc& d) {
    const int e = it / TR_PER_E; int r = it % TR_PER_E; const size_t wi = (size_t)(li * NEXP + e);
    if (trjob_gu(r, d, INP(float, 41) + wi * DM * EXD, EXD, DM, EXD, WSP(bf16, WS_WMGU) + (size_t)e * 2 * EXD * DM, DM, 0)) return;
    if (trjob_gu(r, d, INP(float, 42) + wi * DM * EXD, EXD, DM, EXD, WSP(bf16, WS_WMGU) + (size_t)e * 2 * EXD * DM, DM, 1)) return;
    (void)trjob(r, d, INP(float, 43) + wi * EXD * DM, DM, EXD, 0, DM, nullptr, WSP(bf16, WS_WMD) + (size_t)e * DM * EXD, EXD, 0);
}

__device__ __forceinline__ void p0_prologue(Frame& F) {
    LAS float* scr = (LAS float*)(F.lds + F.wave * 16384);
    const int lane = F.lane; const int gw = F.blk * NWAVES + F.wave, NGW = F.G * NWAVES;
    { TrDesc dc, dn; TrRegs rc, rn; int it = gw;
      if (it < TR_PROLOGUE) { tr_decode_prologue(F, it, dc); tr_load(dc, rc, lane); }
      for (; it < TR_PROLOGUE; it += NGW) { const bool more = it + NGW < TR_PROLOGUE;
          if (more) { tr_decode_prologue(F, it + NGW, dn); tr_load(dn, rn, lane); }
          tr_finish(dc, rc, scr, lane);
          if (more) { dc = dn; rc = rn; } } }
    for (int it = F.blk * 512 + F.tid; it < 3 * 512 * 64; it += F.G * 512) {
        const int i = it / (512 * 64), rem = it % (512 * 64), n = rem >> 6, k0 = (rem & 63) * 8;
        const float* vd = INP(float, 18) + (size_t)i * 512 * 32; const float* vu = INP(float, 19) + (size_t)i * 32 * 512; float o[8];
#pragma unroll
        for (int j = 0; j < 8; ++j) o[j] = 0.f;
        for (int rr = 0; rr < 32; ++rr) { const float u = vu[rr * 512 + n];
#pragma unroll
            for (int j = 0; j < 8; ++j) o[j] += vd[(k0 + j) * 32 + rr] * u; }
        *(v4u*)(WSP(bf16, WS_WVRES) + (size_t)i * 512 * 512 + (size_t)n * 512 + k0) = f32_to_bf16x8(o);
    }
    for (int it = F.blk * 512 + F.tid; it < M * 16; it += F.G * 512) {
        const int m = it >> 4, i = it & 15; const float inv = powf(10000.0f, -(float)i * (1.0f / 16.0f)); const float ang = (float)INP(int, 1)[m] * inv;
        float sn, cn; sincosf(ang, &sn, &cn); float* cs = WSP(float, WS_ROPE) + (size_t)m * 32; cs[i] = cn; cs[16 + i] = sn;
    }
}
__device__ __forceinline__ void moe_convert(Frame& F, int li) {
    LAS float* scr = (LAS float*)(F.lds + F.wave * 16384);
    const int lane = F.lane; const int gw = F.blk * NWAVES + F.wave, NGW = F.G * NWAVES;
    TrDesc dc, dn; TrRegs rc, rn; int it = gw;
    if (it < NEXP * TR_PER_E) { tr_decode_moe(F, li, it, dc); tr_load(dc, rc, lane); }
    for (; it < NEXP * TR_PER_E; it += NGW) { const bool more = it + NGW < NEXP * TR_PER_E;
        if (more) { tr_decode_moe(F, li, it + NGW, dn); tr_load(dn, rn, lane); }
        tr_finish(dc, rc, scr, lane);
        if (more) { dc = dn; rc = rn; } }
}

__device__ __forceinline__ void ph2_prep(Frame& F, int l) {
    const int lane = F.lane; const int gw = F.blk * NWAVES + F.wave, NGW = F.G * NWAVES;
    const bf16* rwraw = WSP(bf16, WS_RWRAW); const bf16* mlaraw = WSP(bf16, WS_MLARAW);
    const float* mu = INP(float, 7) + l * 1792; const float* k_k = INP(float, 13) + l * 512;
    float mu_r[8], mu_k[8], mu_v[8], mu_t[8], kk8[8];
    ld8f(mu + 8 * lane, mu_r); ld8f(mu + 512 + 8 * lane, mu_k); ld8f(mu + 1024 + 8 * lane, mu_v); ld8f(mu + 1536 + 8 * (lane & 31), mu_t); ld8f(k_k + 8 * lane, kk8);
    const float* cs_all = WSP(float, WS_ROPE);
    constexpr int TPW = 16;
    const int m0 = gw * TPW;
    v4u n_r, n_k, n_v, n_t, n_a, n_b, p_r, p_k, p_v, p_t;
    { const bf16* cur = rwraw + (size_t)m0 * 1792; n_r = *(const v4u*)(cur + 8 * lane); n_k = *(const v4u*)(cur + 512 + 8 * lane); n_v = *(const v4u*)(cur + 1024 + 8 * lane); n_t = *(const v4u*)(cur + 1536 + 8 * (lane & 31));
      const bf16* mr = mlaraw + (size_t)m0 * 768; n_a = *(const v4u*)(mr + 8 * lane); n_b = *(const v4u*)(mr + 512 + 8 * (lane & 31));
      if (m0 & (SEQ - 1)) { const bf16* prv = cur - 1792; p_r = *(const v4u*)(prv + 8 * lane); p_k = *(const v4u*)(prv + 512 + 8 * lane); p_v = *(const v4u*)(prv + 1024 + 8 * lane); p_t = *(const v4u*)(prv + 1536 + 8 * (lane & 31)); }
      else { p_r = (v4u){0u, 0u, 0u, 0u}; p_k = p_r; p_v = p_r; p_t = p_r; } }
    for (int i = 0; i < TPW; ++i) {
        const int m = m0 + i;
        const v4u c_r = n_r, c_k = n_k, c_v = n_v, c_t = n_t, c_a = n_a, c_b = n_b;
        if (i + 1 < TPW) { const bf16* nx = rwraw + (size_t)(m + 1) * 1792; n_r = *(const v4u*)(nx + 8 * lane); n_k = *(const v4u*)(nx + 512 + 8 * lane); n_v = *(const v4u*)(nx + 1024 + 8 * lane); n_t = *(const v4u*)(nx + 1536 + 8 * (lane & 31));
            const bf16* mr = mlaraw + (size_t)(m + 1) * 768; n_a = *(const v4u*)(mr + 8 * lane); n_b = *(const v4u*)(mr + 512 + 8 * (lane & 31)); }
        float c[8], p[8], o[8];
        bf16x8_to_f32(c_r, c); bf16x8_to_f32(p_r, p);
#pragma unroll
        for (int j = 0; j < 8; ++j) o[j] = c[j] + (p[j] - c[j]) * mu_r[j];
        *(f16x8*)(WSP(f16, WS_R) + (size_t)m * 512 + 8 * lane) = f32_to_f16x8(o);
        bf16x8_to_f32(c_k, c); bf16x8_to_f32(p_k, p);
        float ss = 0.f;
#pragma unroll
        for (int j = 0; j < 8; ++j) { o[j] = c[j] + (p[j] - c[j]) * mu_k[j]; const float q = o[j] * kk8[j]; ss += q * q; }
        *(f16x8*)(WSP(f16, WS_KH) + (size_t)m * 512 + 8 * lane) = f32_to_f16x8(o);
        ss += __shfl_xor(ss, 1); ss += __shfl_xor(ss, 2); ss += __shfl_xor(ss, 4);
        { const float rn = 1.0f / fmaxf(sqrtf(ss), 1e-12f);
#pragma unroll
          for (int j = 0; j < 8; ++j) o[j] = o[j] * kk8[j] * rn; }
        *(f16x8*)(WSP(f16, WS_KKN) + (size_t)m * 512 + 8 * lane) = f32_to_f16x8(o);
        bf16x8_to_f32(c_v, c); bf16x8_to_f32(p_v, p);
#pragma unroll
        for (int j = 0; j < 8; ++j) o[j] = c[j] + (p[j] - c[j]) * mu_v[j];
        { const v4u vb = f32_to_bf16x8(o); *(v4u*)(WSP(bf16, WS_VRAW) + (size_t)m * 512 + 8 * lane) = vb;
          if (l == 0) { *(v4u*)(WSP(bf16, WS_VFIRST) + (size_t)m * 512 + 8 * lane) = vb; *(f16x8*)(WSP(f16, WS_VFIN) + (size_t)m * 512 + 8 * lane) = f32_to_f16x8(o); } }
        if (lane < 32) {
            bf16x8_to_f32(c_t, c); bf16x8_to_f32(p_t, p);
#pragma unroll
            for (int j = 0; j < 8; ++j) { float v = c[j] + (p[j] - c[j]) * mu_t[j]; if (lane < 8) v = 1.0f - 2.0f * __builtin_amdgcn_rcpf(__expf(2.0f * v) + 1.0f); else if (lane >= 16) v = sigm(v); o[j] = v; }
            *(v4u*)(WSP(bf16, WS_LORAIN) + (size_t)m * 256 + 8 * lane) = f32_to_bf16x8(o);
        }
        p_r = c_r; p_k = c_k; p_v = c_v; p_t = c_t;
        float a8[8], b8[8];
        bf16x8_to_f32(c_a, a8); float ssa = 0.f, ssb = 0.f;
#pragma unroll
        for (int j = 0; j < 8; ++j) ssa += a8[j] * a8[j];
        if (lane < 32) { bf16x8_to_f32(c_b, b8);
#pragma unroll
            for (int j = 0; j < 8; ++j) ssb += b8[j] * b8[j]; } else {
#pragma unroll
            for (int j = 0; j < 8; ++j) b8[j] = 0.f; }
        const float sq = wave_sum(lane < 48 ? ssa : 0.f), skv = wave_sum((lane >= 48 ? ssa : 0.f) + (lane < 16 ? ssb : 0.f));
        const float rq = 1.0f / sqrtf(sq * (1.0f / 384.0f) + 1e-6f), rkv = 1.0f / sqrtf(skv * (1.0f / 256.0f) + 1e-6f);
        if (lane < 48) {
#pragma unroll
            for (int j = 0; j < 8; ++j) o[j] = a8[j] * rq;
            *(v4u*)(WSP(bf16, WS_CQN) + (size_t)m * 384 + 8 * lane) = f32_to_bf16x8(o);
        } else {
#pragma unroll
            for (int j = 0; j < 8; ++j) o[j] = a8[j] * rkv;
            *(v4u*)(WSP(bf16, WS_CKVN) + (size_t)m * 256 + 8 * (lane - 48)) = f32_to_bf16x8(o);
        }
        if (lane < 16) {
#pragma unroll
            for (int j = 0; j < 8; ++j) o[j] = b8[j] * rkv;
            *(v4u*)(WSP(bf16, WS_CKVN) + (size_t)m * 256 + 128 + 8 * lane) = f32_to_bf16x8(o);
        }
        float pr[8];
#pragma unroll
        for (int j = 0; j < 8; ++j) pr[j] = __shfl_xor(b8[j], 2);
        if (lane >= 16 && lane < 20) { const int i0 = 8 * (lane & 1); const float* cs = cs_all + (size_t)m * 32; float cc[8], sn[8]; ld8f(cs + i0, cc); ld8f(cs + 16 + i0, sn);
            const bool lo = lane < 18;
#pragma unroll
            for (int j = 0; j < 8; ++j) o[j] = lo ? (b8[j] * cc[j] - pr[j] * sn[j]) : (pr[j] * sn[j] + b8[j] * cc[j]);
            const v4u w = f32_to_bf16x8(o); bf16* kd = WSP(bf16, WS_K) + (size_t)m * 768 + 64 + (lo ? 0 : 16) + i0;
#pragma unroll
            for (int h = 0; h < NH; ++h) *(v4u*)(kd + h * 96) = w; }
    }
}

__device__ __forceinline__ void s5_gen(Frame& F, int l, int g) {
    {
        __syncthreads();
        const int tid = F.tid;
        LAS float* pw = (LAS float*)F.lds;
        LAS float* Bb = pw + 33 * 64 * 2;
        LAS float* Cc = Bb + 64 * 16 * 2;
        LAS float* Kt = Cc + 16 * 64 * 2;
        const float dt = expf(INP(float, 23)[l * 32 + g]);
        const float* are = INP(float, 21) + (size_t)(l * 32 + g) * 64; const float* aim = INP(float, 22) + (size_t)(l * 32 + g) * 64;
        for (int e = tid; e < 33 * 64; e += 512) { const int n = e >> 6, p = e & 63; const float lr = fminf(are[p], -1e-4f), li = aim[p];
            const float mag = expf((float)n * (dt * lr)); float sn, cn; sincosf((float)n * (dt * li), &sn, &cn); pw[2 * e] = mag * cn; pw[2 * e + 1] = mag * sn; }
        for (int e = tid; e < 64 * 16; e += 512) { const int p = e >> 4; const float lr = fminf(are[p], -1e-4f), li = aim[p];
            const float mag = expf(dt * lr); float sn, cn; sincosf(dt * li, &sn, &cn); const float abr = mag * cn, abi = mag * sn, den = lr * lr + li * li;
            const float fr = ((abr - 1.0f) * lr + abi * li) / den, fi = (abi * lr - (abr - 1.0f) * li) / den;
            const float br = INP(float, 24)[(size_t)(l * 32 + g) * 1024 + e], bi = INP(float, 25)[(size_t)(l * 32 + g) * 1024 + e];
            Bb[2 * e] = fr * br - fi * bi; Bb[2 * e + 1] = fr * bi + fi * br; }
        for (int e = tid; e < 16 * 64; e += 512) { Cc[2 * e] = INP(float, 26)[(size_t)(l * 32 + g) * 1024 + e]; Cc[2 * e + 1] = INP(float, 27)[(size_t)(l * 32 + g) * 1024 + e]; }
        __syncthreads();
        { const int tau = tid >> 4, o = tid & 15; float acc[16];
#pragma unroll
          for (int i = 0; i < 16; ++i) acc[i] = 0.f;
          for (int p = 0; p < 64; ++p) { const float cr = Cc[2 * (o * 64 + p)], ci = Cc[2 * (o * 64 + p) + 1], pr_ = pw[2 * (tau * 64 + p)], pi_ = pw[2 * (tau * 64 + p) + 1];
              const float xr = cr * pr_ - ci * pi_, xi = cr * pi_ + ci * pr_;
#pragma unroll
              for (int i = 0; i < 16; ++i) acc[i] += xr * Bb[2 * (p * 16 + i)] - xi * Bb[2 * (p * 16 + i) + 1]; }
#pragma unroll
          for (int i = 0; i < 16; ++i) Kt[(tau * 16 + o) * 16 + i] = acc[i]; }
        __syncthreads();
        bf16* bm = WSP(bf16, WS_S5MAIN) + ((size_t)l * 32 + g) * 512 * S5K;
        for (int e = tid; e < 512 * 80; e += 512) { const int n = e / 80, k0 = (e % 80) * 8, t = n >> 4, o = n & 15; float v[8];
            if (k0 < 512) { const int sidx = k0 >> 4, i0 = k0 & 15;
#pragma unroll
                for (int j = 0; j < 8; ++j) v[j] = (sidx <= t) ? Kt[((t - sidx) * 16 + o) * 16 + i0 + j] : 0.f; }
            else {
#pragma unroll
                for (int j = 0; j < 8; ++j) { const int q = k0 - 512 + j, p = q & 63; const float cr = Cc[2 * (o * 64 + p)], ci = Cc[2 * (o * 64 + p) + 1], pr_ = pw[2 * ((t + 1) * 64 + p)], pi_ = pw[2 * ((t + 1) * 64 + p) + 1];
                    v[j] = (q < 64) ? (cr * pr_ - ci * pi_) : -(cr * pi_ + ci * pr_); } }
            *(v4u*)(bm + (size_t)n * S5K + k0) = f32_to_bf16x8(v); }
        bf16* be = WSP(bf16, WS_S5END) + ((size_t)l * 32 + g) * 256 * 512;
        for (int e = tid; e < 256 * 64; e += 512) { const int n = e / 64, k0 = (e % 64) * 8, sidx = k0 >> 4, i0 = k0 & 15; float v[8];
            if (n < 128) { const int p = n & 63; const float pr_ = pw[2 * ((31 - sidx) * 64 + p)], pi_ = pw[2 * ((31 - sidx) * 64 + p) + 1];
#pragma unroll
                for (int j = 0; j < 8; ++j) { const float br = Bb[2 * (p * 16 + i0 + j)], bi = Bb[2 * (p * 16 + i0 + j) + 1]; v[j] = (n < 64) ? (pr_ * br - pi_ * bi) : (pr_ * bi + pi_ * br); } }
            else {
#pragma unroll
                for (int j = 0; j < 8; ++j) v[j] = 0.f; }
            *(v4u*)(be + (size_t)n * 512 + k0) = f32_to_bf16x8(v); }
        if (tid < 64) { float* a32 = WSP(float, WS_S5A32) + (size_t)((l * 32 + g) * 64 + tid) * 2; a32[0] = pw[2 * (32 * 64 + tid)]; a32[1] = pw[2 * (32 * 64 + tid) + 1]; }
        __syncthreads();
    }
}

__device__ __forceinline__ void ln_core(f32x4 (&v)[4], const float* gam, const float* bet, int lane) {
    float s = 0.f;
#pragma unroll
    for (int j = 0; j < 4; ++j) s += (v[j][0] + v[j][1]) + (v[j][2] + v[j][3]);
    const float mean = wave_sum(s) * (1.f / DM); float s2 = 0.f;
#pragma unroll
    for (int j = 0; j < 4; ++j) { v[j] = v[j] - mean; s2 += (v[j][0] * v[j][0] + v[j][1] * v[j][1]) + (v[j][2] * v[j][2] + v[j][3] * v[j][3]); }
    const float rstd = 1.f / sqrtf(wave_sum(s2) * (1.f / DM) + LN_EPS);
#pragma unroll
    for (int j = 0; j < 4; ++j) { const f32x4 g4 = *(const f32x4*)(gam + 4 * lane + 256 * j), b4 = *(const f32x4*)(bet + 4 * lane + 256 * j); v[j] = v[j] * rstd * g4 + b4; }
}
__device__ __forceinline__ void ln_store(const f32x4 (&v)[4], float* xrow, bf16* xbrow, int lane) {
#pragma unroll
    for (int j = 0; j < 4; ++j) { if (xrow) *(f32x4*)(xrow + 4 * lane + 256 * j) = v[j]; v2u w; w.x = cvt_pk_bf16(v[j][0], v[j][1]); w.y = cvt_pk_bf16(v[j][2], v[j][3]); *(v2u*)(xbrow + 4 * lane + 256 * j) = w; }
}
__device__ __forceinline__ void ln_phase(Frame& F, const float* gam, const float* bet) {
    const int lane = F.lane; const int gw = F.blk * NWAVES + F.wave, NGW = F.G * NWAVES; const f16* X = (const f16*)F.out; bf16* Xb = WSP(bf16, WS_XB);
    for (int m = gw; m < M; m += NGW) { f32x4 v[4];
#pragma unroll
        for (int j = 0; j < 4; ++j) { typedef f16 f16x4 __attribute__((ext_vector_type(4))); const f16x4 h = *(const f16x4*)(X + (size_t)m * DM + 4 * lane + 256 * j); v[j] = (f32x4){(float)h[0], (float)h[1], (float)h[2], (float)h[3]}; }
        ln_core(v, gam, bet, lane); ln_store(v, nullptr, Xb + (size_t)m * DM, lane); }
}
__device__ __forceinline__ void ln2_moe_phase(Frame& F, const float* gam, const float* bet, int li, bool last) {
    const int lane = F.lane; const int gw = F.blk * NWAVES + F.wave, NGW = F.G * NWAVES; float* X = F.out; bf16* Xb = WSP(bf16, WS_XB);
    const unsigned* cnt = (const unsigned*)(F.ctl + CW_MOECNT + 64 * li); int pstart[NEXP]; { int acc = 0;
#pragma unroll
        for (int e = 0; e < NEXP; ++e) { pstart[e] = acc; acc += (int)(((cnt[e] + 255u) >> 8) << 8); } }
    const int* ppos = WSP(int, WS_PAIRPOS); const bf16* yp = WSP(bf16, WS_YPAIR);
    for (int m = gw; m < M; m += NGW) { f32x4 v[4];
        const int p0 = ppos[2 * m], p1 = ppos[2 * m + 1]; int r0 = 0, r1 = 0;
#pragma unroll
        for (int e = 0; e < NEXP; ++e) { if ((p0 >> 24) == e) r0 = pstart[e] + (p0 & 0xffffff); if ((p1 >> 24) == e) r1 = pstart[e] + (p1 & 0xffffff); }
#pragma unroll
        for (int j = 0; j < 4; ++j) { const v2u xw = *(const v2u*)(Xb + (size_t)m * DM + 4 * lane + 256 * j); const f32x4 x = (f32x4){bf_lo(xw.x), bf_hi(xw.x), bf_lo(xw.y), bf_hi(xw.y)};
            const v2u a = *(const v2u*)(yp + (size_t)r0 * DM + 4 * lane + 256 * j), b = *(const v2u*)(yp + (size_t)r1 * DM + 4 * lane + 256 * j);
            v[j] = x * ALPHA + (f32x4){bf_lo(a.x) + bf_lo(b.x), bf_hi(a.x) + bf_hi(b.x), bf_lo(a.y) + bf_lo(b.y), bf_hi(a.y) + bf_hi(b.y)}; }
        ln_core(v, gam, bet, lane); ln_store(v, last ? X + (size_t)m * DM : nullptr, Xb + (size_t)m * DM, lane); }
}
__device__ __forceinline__ void ln1_moe_phase(Frame& F, const float* gam, const float* bet, int li) {
    const int lane = F.lane; float* X = F.out; bf16* Xb = WSP(bf16, WS_XB);
    LAS int* pe = (LAS int*)F.lds;
    LAS float* pwt = (LAS float*)(F.lds + 1024);
    LAS int* cntl = (LAS int*)(F.lds + 2048);
    const float* router = INP(float, 40) + (size_t)li * DM * NEXP;
    for (int blk0 = F.blk; blk0 * 128 < M; blk0 += F.G) {
        __syncthreads();
        for (int i = 0; i < 16; ++i) { const int tl = F.wave * 16 + i, m = blk0 * 128 + tl; f32x4 v[4];
#pragma unroll
            for (int j = 0; j < 4; ++j) { typedef f16 f16x4 __attribute__((ext_vector_type(4))); const f16x4 h = *(const f16x4*)((const f16*)X + (size_t)m * DM + 4 * lane + 256 * j); v[j] = (f32x4){(float)h[0], (float)h[1], (float)h[2], (float)h[3]}; }
            ln_core(v, gam, bet, lane); ln_store(v, nullptr, Xb + (size_t)m * DM, lane);
            float lg[NEXP];
#pragma unroll
            for (int e = 0; e < NEXP; ++e) lg[e] = 0.f;
#pragma unroll
            for (int j = 0; j < 4; ++j)
#pragma unroll
                for (int q = 0; q < 4; ++q) { const float xv = v[j][q]; const float* rr = router + (size_t)(4 * lane + 256 * j + q) * NEXP; const f32x4 ra = *(const f32x4*)rr, rb = *(const f32x4*)(rr + 4);
                    lg[0] += xv * ra[0]; lg[1] += xv * ra[1]; lg[2] += xv * ra[2]; lg[3] += xv * ra[3]; lg[4] += xv * rb[0]; lg[5] += xv * rb[1]; lg[6] += xv * rb[2]; lg[7] += xv * rb[3]; }
#pragma unroll
            for (int e = 0; e < NEXP; ++e) lg[e] = wave_sum(lg[e]);
            int e0 = 0; float l0 = lg[0];
#pragma unroll
            for (int e = 1; e < NEXP; ++e) if (lg[e] > l0) { l0 = lg[e]; e0 = e; }
            int e1 = -1; float l1 = -INFINITY;
#pragma unroll
            for (int e = 0; e < NEXP; ++e) if (e != e0 && lg[e] > l1) { l1 = lg[e]; e1 = e; }
            const float w1 = 1.0f / (1.0f + expf(l0 - l1)), w0 = 1.0f - w1;
            if (lane == 0) { pe[2 * tl] = e0; pe[2 * tl + 1] = e1; pwt[2 * tl] = w0; pwt[2 * tl + 1] = w1; }
        }
        __syncthreads();
        int myrank = 0, mye = 0;
        if (F.tid < 256) { mye = pe[F.tid]; for (int q = 0; q < F.tid; ++q) myrank += (pe[q] == mye) ? 1 : 0; }
        if (F.tid < NEXP) { int c = 0; for (int q = 0; q < 256; ++q) c += (pe[q] == F.tid) ? 1 : 0; cntl[F.tid] = c;
            cntl[8 + F.tid] = (int)__hip_atomic_fetch_add((unsigned*)(F.ctl + CW_MOECNT + 64 * li + F.tid), (unsigned)c, RLX_AGENT); }
        __syncthreads();
        if (F.tid < 256) { const int rk = cntl[8 + mye] + myrank; const int m = blk0 * 128 + (F.tid >> 1);
            WSP(int, WS_SLOTTOK)[(size_t)mye * MOE_CAP + rk] = m; WSP(float, WS_SLOTW)[(size_t)mye * MOE_CAP + rk] = pwt[F.tid]; WSP(int, WS_PAIRPOS)[blk0 * 256 + F.tid] = (mye << 24) | rk; }
    }
    __syncthreads();
}
constexpr int AT_QR = 256;
constexpr int AK_SLOT = 12288, AV_SLOT = 8192;
constexpr int AT_K = 0, AT_V = 4 * AK_SLOT, AT_WSF = AT_V + 3 * AV_SLOT, AT_OST = AT_WSF + NWAVES * 256, AT_LDS = AT_OST + NWAVES * 4096;
typedef LAS const unsigned char* at_lptr;
__device__ __forceinline__ int crow(int r, int hi) { return (r & 3) + 8 * (r >> 2) + 4 * hi; }
__device__ __forceinline__ void at_dma(const void* sbase, unsigned voff, unsigned dst) {
    unsigned keep;
    asm volatile("s_mov_b32 %0, m0\n\ts_mov_b32 m0, %3\n\ts_nop 0\n\tglobal_load_lds_dwordx4 %1, %2\n\ts_mov_b32 m0, %0" : "=&s"(keep) : "v"(voff), "s"(sbase), "s"(dst) : "memory");
}
__device__ __forceinline__ s16x4 at_vtr(at_lptr p) { return __builtin_bit_cast(s16x4, __builtin_amdgcn_ds_read_tr16_b64_v4i16((LAS s16x4*)p)); }
__device__ __forceinline__ void at_kload2(bf16x8* kf, at_lptr kp, int j) { kf[2 * j] = *(const LAS bf16x8*)(kp + j * 2048); kf[2 * j + 1] = *(const LAS bf16x8*)(kp + j * 2048 + 512); }
#define AT_MX3(a, b, c) __builtin_fmaxf(__builtin_fmaxf((a), (b)), (c))
__device__ __forceinline__ float at_rowmax(const f32x16& p0, const f32x16& p1) {
    float a = AT_MX3(p0[0], p0[1], p1[0]), b = AT_MX3(p0[2], p0[3], p1[1]); a = AT_MX3(a, p1[2], p1[3]);
#pragma unroll
    for (int r = 4; r < 16; r += 4) { a = AT_MX3(a, p0[r], p0[r + 1]); b = AT_MX3(b, p0[r + 2], p0[r + 3]); a = AT_MX3(a, p1[r], p1[r + 1]); b = AT_MX3(b, p1[r + 2], p1[r + 3]); }
    const float m = __builtin_fmaxf(a, b); auto rr = __builtin_amdgcn_permlane32_swap(__float_as_uint(m), __float_as_uint(m), false, false);
    return __builtin_fmaxf(__uint_as_float(rr[0]), __uint_as_float(rr[1]));
}
__device__ __forceinline__ void at_cmask(f32x16& p0, f32x16& p1, int jb, int qrel, int hi) {
    const int kb = 64 * jb + 4 * hi;
#pragma unroll
    for (int r = 0; r < 16; ++r) { const int kv = kb + (r & 3) + 8 * (r >> 2); if (kv > qrel) p0[r] = -INFINITY; if (kv + 32 > qrel) p1[r] = -INFINITY; }
}
#define AT_SBAR() __builtin_amdgcn_sched_barrier(0)
#define AT_PIN(x) asm volatile("" : "+v"(x))
#define AT_MFMA(a, b, c) __builtin_amdgcn_mfma_f32_32x32x16_bf16(a, b, c, 0, 0, 0)
#define AT_WAIT_BAR(N) asm volatile("s_waitcnt vmcnt(" #N ") lgkmcnt(0)\n\ts_barrier" ::: "memory")

__device__ __forceinline__ void attn_unit(int tid, int b, int h, int qb, const bf16* Q, const bf16* K, const bf16* V, bf16* O, LAS unsigned char* lds) {
    const int lane = tid & 63, r32 = lane & 31, hi = lane >> 5; const int wid = __builtin_amdgcn_readfirstlane(tid >> 6);
    const size_t rowbase = (size_t)b * SEQ; const int q0 = qb * AT_QR; const int NT = (q0 + AT_QR) / 64;
    const unsigned lds0 = (unsigned)(uintptr_t)lds;
    LAS float* wsf = (LAS float*)(lds + AT_WSF) + wid * 64;
    const bf16* kbA = K + rowbase * 768 + h * 96 + wid * 8;
    const bf16* kbB = K + rowbase * 768 + h * 96 + (8 + (wid & 3)) * 8;
    const bf16* vbs = V + (rowbase + 16 * (wid & 3)) * 512 + h * 64 + (wid >> 2) * 32;
    const unsigned kvo = (unsigned)lane * 1536u, vvo = (unsigned)(lane >> 2) * 1024u + (unsigned)(lane & 3) * 16u;
    const unsigned kdA = lds0 + AT_K + wid * 1024, kdB = lds0 + AT_K + (8 + (wid & 3)) * 1024, vds = lds0 + AT_V + wid * 1024;
#define AT_DMA_K(t) do { const unsigned ks_ = (unsigned)((t) & 3) * AK_SLOT; at_dma(kbA + (size_t)(t) * (64 * 768), kvo, kdA + ks_); at_dma(kbB + (size_t)(t) * (64 * 768), kvo, kdB + ks_); } while (0)
#define AT_DMA_V(t, slot) at_dma(vbs + (size_t)(t) * (64 * 512), vvo, vds + (slot))
    const at_lptr kp0 = (at_lptr)lds + AT_K + hi * 1024 + r32 * 16;
    const at_lptr vp0 = (at_lptr)lds + AT_V + ((lane >> 4) & 1) * 32 + (lane & 3) * 8 + (4 * hi + ((lane & 15) >> 2)) * 64;
    AT_DMA_K(0); AT_DMA_V(0, 0); AT_DMA_K(1);
    bf16x8 qr[6];
    { const bf16* qp = Q + (rowbase + q0 + wid * 32 + r32) * 768 + h * 96 + hi * 8;
#pragma unroll
      for (int d0 = 0; d0 < 6; ++d0) qr[d0] = *(const bf16x8*)(qp + d0 * 16); }
    AT_DMA_K(2);
    float mhat = 0.f, l_reg = 0.f; f32x16 o[2];
#pragma unroll
    for (int r = 0; r < 16; ++r) { o[0][r] = 0.f; o[1][r] = 0.f; }
    const f32x16 zero16 = {0.f, 0.f, 0.f, 0.f, 0.f, 0.f, 0.f, 0.f, 0.f, 0.f, 0.f, 0.f, 0.f, 0.f, 0.f, 0.f};
    const int qrel = wid * 32 + r32; bool resc = false;
    f32x16 pA0, pA1, pB0, pB1; bf16x8 kf[8]; s16x4 vlo[8], vhi[8]; v4u pw0, pw1, pw2, pw3;
    int sl_prev = 0, sl_cur = 0, sl_next = AV_SLOT;
#define AT_ROT() do { sl_prev = sl_cur; sl_cur = sl_next; sl_next = (sl_next == 2 * AV_SLOT) ? 0 : sl_next + AV_SLOT; } while (0)
#define AT_EX(v) __builtin_amdgcn_exp2f((v) + nmh)
#define AT_RESC() do { if (resc) { _Pragma("unroll") for (int d_ = 0; d_ < 2; ++d_) _Pragma("unroll") for (int r = 0; r < 16; ++r) o[d_][r] *= wsf[crow(r, hi)]; } } while (0)
    AT_WAIT_BAR(2);
    { bf16x8 k0[12];
#pragma unroll
      for (int d0 = 0; d0 < 6; ++d0) at_kload2(k0, kp0, d0);
      pA0 = AT_MFMA(k0[0], qr[0], zero16); pA1 = AT_MFMA(k0[1], qr[0], zero16);
#pragma unroll
      for (int d0 = 1; d0 < 6; ++d0) { pA0 = AT_MFMA(k0[2 * d0], qr[d0], pA0); pA1 = AT_MFMA(k0[2 * d0 + 1], qr[d0], pA1); } }
    if (NT == 4) at_cmask(pA0, pA1, 0, qrel, hi);
    { const float rm = at_rowmax(pA0, pA1); mhat = rm; const float nmh = -mhat;
#pragma unroll
      for (int r = 0; r < 16; ++r) { pA0[r] = AT_EX(pA0[r]); pA1[r] = AT_EX(pA1[r]); } }
    AT_WAIT_BAR(0);
    AT_DMA_K(3); AT_DMA_V(1, AV_SLOT); AT_ROT();
#pragma unroll
    for (int d0 = 0; d0 < 4; ++d0) at_kload2(kf, kp0 + AK_SLOT, d0);
    AT_WAIT_BAR(3);
#define AT_PKW(P, i) cvt_pk_bf16(P[i], P[(i) + 1])
#define AT_PAF(k) __builtin_bit_cast(bf16x8, pw##k)
#define AT_VFR(i) (bf16x8){vlo[i][0], vlo[i][1], vlo[i][2], vlo[i][3], vhi[i][0], vhi[i][1], vhi[i][2], vhi[i][3]}
#define AT_VRD(i) do { vlo[i] = at_vtr(vp_ + (((i) >> 2) * 4096 + ((i) & 3) * 1024)); vhi[i] = at_vtr(vp_ + (((i) >> 2) * 4096 + ((i) & 3) * 1024 + 512)); } while (0)
#define AT_KRD(G, j) do { if (G) { at_kload2(kf, kn_, j); AT_SBAR(); } } while (0)
#define AT_GAP3(MF, a0, a1, a2, W0, W1, PW) do { MF; sacc += a0; sacc += a1; sacc += a2; AT_PIN(sacc); W0; W1; AT_PIN(PW); AT_SBAR(); } while (0)
#define AT_GAP2W(MF, a0, a1, W0, W1, PW) do { MF; sacc += a0; sacc += a1; AT_PIN(sacc); W0; W1; AT_PIN(PW); AT_SBAR(); } while (0)
#define AT_GAP2(MF, a0, a1) do { MF; sacc += a0; sacc += a1; AT_PIN(sacc); AT_SBAR(); } while (0)
#define AT_GAPB(MF, X, i) do { MF; X[i] = AT_EX(X[i]); X[(i) + 1] = AT_EX(X[(i) + 1]); X[(i) + 2] = AT_EX(X[(i) + 2]); X[(i) + 3] = AT_EX(X[(i) + 3]); AT_PIN(X); AT_SBAR(); } while (0)
#define AT_STEP(C0, C1, P0, P1, t, MASK, GK, GV, GL) do { AT_SBAR(); \
    const at_lptr vp_ = vp0 + sl_prev; const at_lptr kc_ = kp0 + ((t) & 3) * AK_SLOT; const at_lptr kn_ = kp0 + (((t) + 1) & 3) * AK_SLOT; bf16x8 kg[4]; \
    AT_VRD(0); AT_SBAR(); float sacc = P0[0] + P0[1]; \
                       AT_GAP3(C0 = AT_MFMA(kf[0], qr[0], zero16), P0[2], P0[3], P0[4],    pw0[0] = AT_PKW(P0, 0),  pw0[1] = AT_PKW(P0, 2),  pw0); \
    AT_VRD(4); AT_SBAR(); AT_GAP3(C1 = AT_MFMA(kf[1], qr[0], zero16), P0[5], P0[6], P0[7],    pw0[2] = AT_PKW(P0, 4),  pw0[3] = AT_PKW(P0, 6),  pw0); \
    AT_VRD(1); AT_SBAR(); AT_GAP3(C0 = AT_MFMA(kf[2], qr[1], C0),     P0[8], P0[9], P0[10],   pw1[0] = AT_PKW(P0, 8),  pw1[1] = AT_PKW(P0, 10), pw1); \
    AT_VRD(5); AT_SBAR(); AT_GAP3(C1 = AT_MFMA(kf[3], qr[1], C1),     P0[11], P0[12], P0[13], pw1[2] = AT_PKW(P0, 12), pw1[3] = AT_PKW(P0, 14), pw1); \
    at_kload2(kg, kc_ + 4 * 2048, 0); AT_SBAR();                                                                                \
    AT_VRD(2); AT_SBAR(); AT_GAP3(C0 = AT_MFMA(kf[4], qr[2], C0),     P0[14], P0[15], P1[0],  pw2[0] = AT_PKW(P1, 0),  pw2[1] = AT_PKW(P1, 2),  pw2); \
    at_kload2(kg, kc_ + 4 * 2048, 1); AT_SBAR();                                                                                \
    AT_VRD(6); AT_SBAR(); AT_GAP3(C1 = AT_MFMA(kf[5], qr[2], C1),     P1[1], P1[2], P1[3],    pw2[2] = AT_PKW(P1, 4),  pw2[3] = AT_PKW(P1, 6),  pw2); \
    AT_VRD(3); AT_SBAR(); AT_GAP2W(C0 = AT_MFMA(kf[6], qr[3], C0),    P1[4], P1[5],           pw3[0] = AT_PKW(P1, 8),  pw3[1] = AT_PKW(P1, 10), pw3); \
    AT_VRD(7); AT_SBAR(); AT_GAP2W(C1 = AT_MFMA(kf[7], qr[3], C1),    P1[6], P1[7],           pw3[2] = AT_PKW(P1, 12), pw3[3] = AT_PKW(P1, 14), pw3); \
    AT_GAP2(C0 = AT_MFMA(kg[0], qr[4], C0), P1[8], P1[9]); \
    AT_GAP2(C1 = AT_MFMA(kg[1], qr[4], C1), P1[10], P1[11]); \
    AT_GAP2(C0 = AT_MFMA(kg[2], qr[5], C0), P1[12], P1[13]); \
    AT_GAP2(C1 = AT_MFMA(kg[3], qr[5], C1), P1[14], P1[15]); \
    l_reg += sacc; \
    if (GK) AT_DMA_K((t) + 3); if (GV) AT_DMA_V((t) + 1, sl_next); \
    if (MASK) { const int jb_ = (t) - (NT - 4); if (jb_ >= 0) at_cmask(C0, C1, jb_, qrel, hi); } \
    { const float rm = at_rowmax(C0, C1) - mhat; resc = false;                                                                  \
      if (__builtin_expect(__any(rm > 8.0f), 0)) { const float dl = __builtin_fmaxf(rm, 0.f); mhat += dl;                       \
          const float f = __builtin_amdgcn_exp2f(-dl); l_reg *= f; if (hi == 0) wsf[r32] = f; resc = true; } } \
    const float nmh = -mhat; AT_SBAR(); \
    AT_GAPB(o[0] = AT_MFMA(AT_PAF(0), AT_VFR(0), o[0]), C0, 0);               AT_GAPB(o[1] = AT_MFMA(AT_PAF(0), AT_VFR(4), o[1]), C0, 4); \
    AT_KRD(GL, 0); AT_GAPB(o[0] = AT_MFMA(AT_PAF(1), AT_VFR(1), o[0]), C0, 8);  AT_KRD(GL, 1); AT_GAPB(o[1] = AT_MFMA(AT_PAF(1), AT_VFR(5), o[1]), C0, 12); \
    AT_KRD(GL, 2); AT_GAPB(o[0] = AT_MFMA(AT_PAF(2), AT_VFR(2), o[0]), C1, 0);  AT_KRD(GL, 3); AT_GAPB(o[1] = AT_MFMA(AT_PAF(2), AT_VFR(6), o[1]), C1, 4); \
    AT_GAPB(o[0] = AT_MFMA(AT_PAF(3), AT_VFR(3), o[0]), C1, 8);               AT_GAPB(o[1] = AT_MFMA(AT_PAF(3), AT_VFR(7), o[1]), C1, 12); \
    } while (0)
    int t = 1;
    for (; t + 5 < NT; t += 2) {
        AT_STEP(pB0, pB1, pA0, pA1, t, false, true, true, true);     AT_WAIT_BAR(3); AT_RESC(); AT_ROT();
        AT_STEP(pA0, pA1, pB0, pB1, t + 1, false, true, true, true); AT_WAIT_BAR(3); AT_RESC(); AT_ROT();
    }
#define AT_ENDW(tt) do { if ((tt) + 3 < NT) { AT_WAIT_BAR(3); } else if ((tt) + 2 < NT) { AT_WAIT_BAR(1); } else { AT_WAIT_BAR(0); } } while (0)
    for (; t + 1 < NT; t += 2) {
        AT_STEP(pB0, pB1, pA0, pA1, t, true, (t + 3 < NT), (t + 1 < NT), (t + 1 < NT));         AT_ENDW(t);     AT_RESC(); AT_ROT();
        AT_STEP(pA0, pA1, pB0, pB1, t + 1, true, (t + 4 < NT), (t + 2 < NT), (t + 2 < NT));     AT_ENDW(t + 1); AT_RESC(); AT_ROT();
    }
    AT_STEP(pB0, pB1, pA0, pA1, NT - 1, true, false, false, false); AT_RESC();
    { float sacc = pB0[0] + pB0[1];
#pragma unroll
      for (int r = 2; r < 16; ++r) sacc += pB0[r];
#pragma unroll
      for (int r = 0; r < 16; ++r) sacc += pB1[r];
      l_reg += sacc;
      pw0 = (v4u){AT_PKW(pB0, 0), AT_PKW(pB0, 2), AT_PKW(pB0, 4), AT_PKW(pB0, 6)}; pw1 = (v4u){AT_PKW(pB0, 8), AT_PKW(pB0, 10), AT_PKW(pB0, 12), AT_PKW(pB0, 14)};
      pw2 = (v4u){AT_PKW(pB1, 0), AT_PKW(pB1, 2), AT_PKW(pB1, 4), AT_PKW(pB1, 6)}; pw3 = (v4u){AT_PKW(pB1, 8), AT_PKW(pB1, 10), AT_PKW(pB1, 12), AT_PKW(pB1, 14)};
      const at_lptr vp_ = vp0 + sl_cur;
#pragma unroll
      for (int i = 0; i < 8; ++i) AT_VRD(i);
      o[0] = AT_MFMA(AT_PAF(0), AT_VFR(0), o[0]); o[1] = AT_MFMA(AT_PAF(0), AT_VFR(4), o[1]); o[0] = AT_MFMA(AT_PAF(1), AT_VFR(1), o[0]); o[1] = AT_MFMA(AT_PAF(1), AT_VFR(5), o[1]);
      o[0] = AT_MFMA(AT_PAF(2), AT_VFR(2), o[0]); o[1] = AT_MFMA(AT_PAF(2), AT_VFR(6), o[1]); o[0] = AT_MFMA(AT_PAF(3), AT_VFR(3), o[0]); o[1] = AT_MFMA(AT_PAF(3), AT_VFR(7), o[1]); }
    { auto rr = __builtin_amdgcn_permlane32_swap(__float_as_uint(l_reg), __float_as_uint(l_reg), false, false); l_reg = __uint_as_float(rr[0]) + __uint_as_float(rr[1]); }
    if (hi == 0) wsf[32 + r32] = l_reg;
    LDS_WAIT();
#pragma unroll
    for (int r = 0; r < 16; ++r) { const int orow = crow(r, hi); const float rl = __builtin_amdgcn_rcpf(wsf[32 + orow]);
#pragma unroll
        for (int d0 = 0; d0 < 2; ++d0) { const unsigned u = cvt_pk_bf16(o[d0][r] * rl, 0.f); ((LAS bf16*)(lds + AT_OST + wid * 4096))[orow * 64 + d0 * 32 + r32] = (bf16)(u & 0xffffu); } }
    LDS_WAIT();
    { bf16* Ow = O + (rowbase + q0 + wid * 32) * 512 + h * 64;
#pragma unroll
      for (int i = 0; i < 4; ++i) { const int row = i * 8 + (lane >> 3), ch = lane & 7; const v4u v = *(const LAS v4u*)(lds + AT_OST + wid * 4096 + (row * 64 + ch * 8) * 2); *(v4u*)(Ow + (size_t)row * 512 + ch * 8) = v; } }
    asm volatile("s_waitcnt lgkmcnt(0)\n\ts_barrier" ::: "memory");
#undef AT_DMA_K
#undef AT_DMA_V
#undef AT_ROT
#undef AT_EX
#undef AT_RESC
#undef AT_PKW
#undef AT_PAF
#undef AT_VFR
#undef AT_VRD
#undef AT_KRD
#undef AT_ENDW
#undef AT_GAP3
#undef AT_GAP2W
#undef AT_GAP2
#undef AT_GAPB
#undef AT_STEP
}

template <int CTRL> __device__ __forceinline__ float dpp_add(float v) { return v + __builtin_bit_cast(float, __builtin_amdgcn_update_dpp(0, __builtin_bit_cast(int, v), CTRL, 0xF, 0xF, true)); }
constexpr int RW_TC = 64, RW_STREAM = RW_TC * 64 * 2  , RW_BUF = 6 * RW_STREAM  , RW_YOFF = 2 * RW_BUF  , RW_LDS = RW_YOFF + 2 * RW_STREAM;
constexpr int RW_SPLIT = 2, RW_CW = 4  , RW_ROWS = 64 / RW_SPLIT, RW_RPW = RW_ROWS / RW_CW, RW_LPR = 64 / RW_RPW  , RW_CPL = 64 / RW_LPR  ;
typedef f16 f16xc __attribute__((ext_vector_type(RW_CPL)));
struct RwIn { f16xc r, k, a, b, d; f16 v; };
__device__ __forceinline__ void rw_lds_read(RwIn& x, const LAS unsigned char* buf, int tt, int cg, int row) {
    const LAS unsigned char* p = buf + tt * 128 + cg * (RW_CPL * 2);
    x.r = *(const LAS f16xc*)(p); x.k = *(const LAS f16xc*)(p + RW_STREAM); x.a = *(const LAS f16xc*)(p + 2 * RW_STREAM); x.b = *(const LAS f16xc*)(p + 3 * RW_STREAM); x.d = *(const LAS f16xc*)(p + 4 * RW_STREAM);
    x.v = *(const LAS f16*)(buf + 5 * RW_STREAM + tt * 128 + row * 2);
}
__device__ __forceinline__ void rwkv_scan(Frame& F, int unit) {
    const int bh = unit / RW_SPLIT, part = unit % RW_SPLIT;
    const int tid = F.tid, lane = F.lane, rl = lane / RW_LPR, cg = lane % RW_LPR, b = bh >> 3, h = bh & 7, row = part * RW_ROWS + F.wave * RW_RPW + rl;
    const f16* R = WSP(f16, WS_R); const f16* KH = WSP(f16, WS_KH); const f16* KKN = WSP(f16, WS_KKN); const f16* BV = WSP(f16, WS_BV); const f16* DCY = WSP(f16, WS_DCY); const f16* VF = WSP(f16, WS_VFIN);
    f16* Y = WSP(f16, WS_YRW);
    const size_t base = (size_t)b * SEQ * 512 + h * 64;
    LAS unsigned char* lds = F.lds;
    const int ts = tid >> 3, pc = tid & 7;
    const size_t goff = base + (size_t)ts * 512 + pc * 8;
    const int loff = ts * 128 + pc * 16;
    v4u g[6];
#define RW_GLOAD(t0) do { const size_t o = goff + (size_t)(t0) * 512; const size_t oa = ((t0) + ts + 1 < SEQ) ? o + 512 : o; \
        g[0] = *(const v4u*)(R + o); g[1] = *(const v4u*)(KH + o); g[2] = *(const v4u*)(KKN + oa); g[3] = *(const v4u*)(BV + o); g[4] = *(const v4u*)(DCY + o); g[5] = *(const v4u*)(VF + o); } while (0)
#define RW_LSTORE(bufoff) do { _Pragma("unroll") for (int s_ = 0; s_ < 6; ++s_) *(LAS v4u*)(lds + (bufoff) + s_ * RW_STREAM + loff) = g[s_]; } while (0)
    typedef f16 h2 __attribute__((ext_vector_type(2)));
    h2 S2[RW_CPL / 2];
#pragma unroll
    for (int j = 0; j < RW_CPL / 2; ++j) S2[j] = (h2){(f16)0.f, (f16)0.f};
    float sa = 0.f;
    __syncthreads();
    RW_GLOAD(0); RW_LSTORE(0);
    __syncthreads();
    for (int c = 0; c < SEQ / RW_TC; ++c) {
        const int cur = (c & 1) * RW_BUF, nxt = ((c + 1) & 1) * RW_BUF; const bool more = (c + 1 < SEQ / RW_TC);
        if (more) RW_GLOAD((c + 1) * RW_TC);
        const LAS unsigned char* buf = lds + cur;
        if (F.wave < RW_CW) {
        RwIn x0, x1, x2; rw_lds_read(x0, buf, 0, cg, row); rw_lds_read(x1, buf, 1, cg, row);
        float ykeep = 0.f;
#define RW_STEP(X, TT) do { \
            const h2 sa2 = {(f16)sa, (f16)sa}, v2 = {X.v, X.v}; float yp = 0.f, sp = 0.f; \
            _Pragma("unroll") for (int j = 0; j < RW_CPL / 2; ++j) { const h2 d2 = {X.d[2 * j], X.d[2 * j + 1]}, b2 = {X.b[2 * j], X.b[2 * j + 1]}, k2 = {X.k[2 * j], X.k[2 * j + 1]}, r2 = {X.r[2 * j], X.r[2 * j + 1]}, a2 = {X.a[2 * j], X.a[2 * j + 1]}; \
                h2 sj = S2[j]; sj = __builtin_elementwise_fma(-sj, d2, sj); sj = __builtin_elementwise_fma(sa2, b2, sj); sj = __builtin_elementwise_fma(v2, k2, sj); S2[j] = sj; \
                yp = __builtin_amdgcn_fdot2(sj, r2, yp, false); sp = __builtin_amdgcn_fdot2(sj, a2, sp, false); } \
            yp = dpp_add<0xB1>(yp); sp = dpp_add<0xB1>(sp); \
            yp = dpp_add<0x4E>(yp); sp = dpp_add<0x4E>(sp); \
            if (RW_LPR >= 8) { yp = dpp_add<0x141>(yp); sp = dpp_add<0x141>(sp); } \
            if (RW_LPR >= 16) { yp = dpp_add<0x140>(yp); sp = dpp_add<0x140>(sp); } \
            sa = -sp; ykeep = (cg == ((TT) & 3)) ? yp : ykeep; } while (0)
        for (int tt = 0; tt < RW_TC; tt += 4) {
            rw_lds_read(x2, buf, (tt + 2) & (RW_TC - 1), cg, row); RW_STEP(x0, tt);
            rw_lds_read(x0, buf, (tt + 3) & (RW_TC - 1), cg, row); RW_STEP(x1, tt + 1);
            rw_lds_read(x1, buf, (tt + 4) & (RW_TC - 1), cg, row); RW_STEP(x2, tt + 2);
            rw_lds_read(x2, buf, (tt + 5) & (RW_TC - 1), cg, row); RW_STEP(x0, tt + 3);
            if (cg < 4) *(LAS f16*)(lds + RW_YOFF + (c & 1) * RW_STREAM + (tt + cg) * 128 + row * 2) = (f16)ykeep;
            x0 = x1; x1 = x2;
        }
#undef RW_STEP
        }
        if (more) RW_LSTORE(nxt);
        __syncthreads();
        if (pc >= part * (8 / RW_SPLIT) && pc < (part + 1) * (8 / RW_SPLIT)) { const v4u yv = *(const LAS v4u*)(lds + RW_YOFF + (c & 1) * RW_STREAM + loff); *(v4u*)(Y + base + (size_t)(c * RW_TC + ts) * 512 + pc * 8) = yv; }
    }
    __syncthreads();
#undef RW_GLOAD
#undef RW_LSTORE
}
__device__ __forceinline__ void s5_carry(Frame& F, int l, int idx) {
    const int p = idx & 63, g = (idx >> 6) & 31, b = idx >> 11;
    const float* a32 = WSP(float, WS_S5A32) + (size_t)((l * 32 + g) * 64 + p) * 2; const float ar = a32[0], ai = a32[1];
    const float* xe = WSP(float, WS_XEND) + ((size_t)g * S5CH + b * S5NC) * 128; bf16* u = WSP(bf16, WS_S5U) + ((size_t)g * S5CH + b * S5NC) * S5K + 512;
    float xr = 0.f, xi = 0.f;
    for (int c0 = 0; c0 < S5NC; c0 += 8) { float er[8], ei[8];
#pragma unroll
        for (int c = 0; c < 8; ++c) { er[c] = xe[(size_t)(c0 + c) * 128 + p]; ei[c] = xe[(size_t)(c0 + c) * 128 + 64 + p]; }
#pragma unroll
        for (int c = 0; c < 8; ++c) { bf16* up = u + (size_t)(c0 + c) * S5K; up[p] = (bf16)(cvt_pk_bf16(xr, 0.f) & 0xffffu); up[64 + p] = (bf16)(cvt_pk_bf16(xi, 0.f) & 0xffffu);
            const float nr = ar * xr - ai * xi + er[c], ni = ar * xi + ai * xr + ei[c]; xr = nr; xi = ni; } }
}
__device__ __forceinline__ void rwkv_post(Frame& F, int l) {
    const int lane = F.lane; const int gw = F.blk * NWAVES + F.wave, NGW = F.G * NWAVES;
    float lg[8], lb[8], rk[8]; ld8f(INP(float, 16) + l * 512 + 8 * lane, lg); ld8f(INP(float, 17) + l * 512 + 8 * lane, lb); ld8f(INP(float, 15) + l * 512 + 8 * lane, rk);
    for (int m = gw; m < M; m += NGW) { const size_t off = (size_t)m * 512 + 8 * lane; float y[8], r[8], k[8], v[8], g[8], o[8];
        f16x8_to_f32(*(const f16x8*)(WSP(f16, WS_YRW) + off), y); f16x8_to_f32(*(const f16x8*)(WSP(f16, WS_R) + off), r); f16x8_to_f32(*(const f16x8*)(WSP(f16, WS_KH) + off), k);
        f16x8_to_f32(*(const f16x8*)(WSP(f16, WS_VFIN) + off), v); bf16x8_to_f32(*(const v4u*)(WSP(bf16, WS_GL) + off), g);
        float s = 0.f, bs = 0.f;
#pragma unroll
        for (int j = 0; j < 8; ++j) { s += y[j]; bs += r[j] * k[j] * rk[j]; }
        s += __shfl_xor(s, 1); s += __shfl_xor(s, 2); s += __shfl_xor(s, 4); bs += __shfl_xor(bs, 1); bs += __shfl_xor(bs, 2); bs += __shfl_xor(bs, 4);
        const float mean = s * (1.0f / 64.0f); float q = 0.f;
#pragma unroll
        for (int j = 0; j < 8; ++j) { y[j] -= mean; q += y[j] * y[j]; }
        q += __shfl_xor(q, 1); q += __shfl_xor(q, 2); q += __shfl_xor(q, 4);
        const float rstd = 1.0f / sqrtf(q * (1.0f / 64.0f) + 64e-5f);
#pragma unroll
        for (int j = 0; j < 8; ++j) o[j] = (y[j] * rstd * lg[j] + lb[j] + bs * v[j]) * g[j];
        *(v4u*)(WSP(bf16, WS_YRW) + off) = f32_to_bf16x8(o); }
}
constexpr int PH_PER_LAYER = 12, N_PHASES = 1 + NLAYER * PH_PER_LAYER;
#ifndef MK_PER_PHASE
#define MK_PER_PHASE 0
#endif
constexpr int NR_RWKV = 64 * RW_SPLIT;

__global__ void __launch_bounds__(NWAVES * 64, 2) mk_fwd(Args A) {
    extern __shared__ __attribute__((aligned(16))) unsigned char lds_raw[];
    volatile LAS unsigned* MISC = (volatile LAS unsigned*)((LAS unsigned char*)lds_raw + MISC_OFF);
    for (int u = threadIdx.x; u < (LDS_BYTES - LDSCTL_OFF) / 4; u += NWAVES * 64) ((LAS unsigned*)((LAS unsigned char*)lds_raw + LDSCTL_OFF))[u] = 0u;
    __syncthreads();
    XcdBarrier bar; bar.bar = (unsigned*)(A.ws + WS_CTL) + CW_BAR; bar.x = 0; bar.st = nullptr;
    if (!MK_PER_PHASE) bar = xcd_barrier_post((unsigned*)(A.ws + WS_CTL) + CW_BAR, MISC + 8);
    const int lo = A.ph_lo, hi = A.ph_hi;
#ifndef PHMASK
#define PHMASK 0xFFFF
#endif
#define PHON(k) ((PHMASK >> (k)) & 1)
#define IN(k) (lo <= (k) && (k) < hi)
#define SEAM(k) do { if (IN(k) && IN((k) + 1)) xcd_barrier(bar); } while (0)
    using pg8::gemm_phase; using pg8::StaticOrder; using pg8::LocDense;

    if (PHON(0) && IN(0)) {
        MKFRAME(F);
        p0_prologue(F);
        for (int it = F.G - 1 - F.blk; it < NLAYER * 32; it += F.G) s5_gen(F, it >> 5, it & 31);
        const int gw = F.blk * NWAVES + F.wave, NGW = F.G * NWAVES;
        for (int m = gw; m < M; m += NGW) {
#pragma unroll
            for (int j = 0; j < 4; ++j) { const f32x4 v = *(const f32x4*)(INP(float, 0) + (size_t)m * DM + 4 * F.lane + 256 * j); v2u w; w.x = cvt_pk_bf16(v[0], v[1]); w.y = cvt_pk_bf16(v[2], v[3]); *(v2u*)(WSP(bf16, WS_XB) + (size_t)m * DM + 4 * F.lane + 256 * j) = w; } }
    }
    SEAM(0);

    for (int l = 0; l < NLAYER; ++l) {
        const int pb = 1 + l * PH_PER_LAYER;
        const bool moe = (l & 1) != 0; const int li = l >> 1;
        if (PHON(1) && IN(pb + 0)) {
            asm volatile("; ==PH1");
            MKFRAME(F);
            LocDense L{WSP(bf16, WS_XB), WSP(bf16, WS_WIN) + (size_t)l * 3072 * DM, DM, DM, DM, 0, 0};
            StaticOrder S; S.init(M, 3072, 1, F.G, F.blk);
            Epi8<FProj> E{{WSP(bf16, WS_MLARAW), WSP(bf16, WS_RWRAW), WSP(bf16, WS_S5U)}};
            gemm_phase(F.lds + RING_OFF, L, S, E);
        }
        SEAM(pb + 0);
        if (PHON(2) && IN(pb + 1)) { MKFRAME(F); ph2_prep(F, l); }
        SEAM(pb + 1);
        if (PHON(3) && IN(pb + 2)) {
            asm volatile("; ==PH3");
            MKFRAME(F);
#ifndef P3SEL
#define P3SEL 31
#endif
            if (P3SEL & 1) { LocDense L{WSP(bf16, WS_CQN), WSP(bf16, WS_WUQ) + (size_t)l * 768 * 384, 384, 384, 384, 0, 0}; StaticOrder S; S.init(M, 768, 1, F.G, F.blk);
              Epi8<FQup> E{{WSP(bf16, WS_Q), WSP(float, WS_ROPE), 0.10206207261596575f * 1.4426950408889634f}}; gemm_phase(F.lds + RING_OFF, L, S, E); }
            if (P3SEL & 2) { LocDense L{WSP(bf16, WS_CKVN), WSP(bf16, WS_WUKV) + (size_t)l * 1024 * 256, 256, 256, 256, 0, 0}; StaticOrder S; S.init(M, 1024, 1, F.G, F.blk);
              Epi8<FKVup> E{{WSP(bf16, WS_K), WSP(bf16, WS_V)}}; gemm_phase(F.lds + RING_OFF, L, S, E); }
            if (P3SEL & 4) { LocDense L{WSP(bf16, WS_LORAIN), WSP(bf16, WS_WLORA) + (size_t)l * 1536 * 256, 256, 256, 256, 0, 0}; StaticOrder S; S.init(M, 1536, 1, F.G, F.blk);
              Epi8<FLora> E{{INP(float, 8) + l * 512, INP(float, 10) + l * 512, INP(float, 14) + l * 512, WSP(f16, WS_DCY), WSP(f16, WS_KH), WSP(f16, WS_KKN), WSP(f16, WS_BV), WSP(bf16, WS_GL), {}, {}}}; gemm_phase(F.lds + RING_OFF, L, S, E); }
            if ((P3SEL & 8) && l > 0) { LocDense L{WSP(bf16, WS_VRAW), WSP(bf16, WS_WVRES) + (size_t)(l - 1) * 512 * 512, 512, 512, 512, 0, 0}; StaticOrder S; S.init(M, 512, 1, F.G, F.blk);
              Epi8<FVres> E{{INP(float, 20) + (l - 1) * 512, WSP(bf16, WS_VRAW), WSP(bf16, WS_VFIRST), WSP(f16, WS_VFIN), {}}}; gemm_phase(F.lds + RING_OFF, L, S, E); }
            if (P3SEL & 16) { LocDense L{WSP(bf16, WS_S5U), WSP(bf16, WS_S5END) + (size_t)l * 32 * 256 * 512, S5K, 512, 512, (size_t)S5CH * S5K, (size_t)256 * 512}; StaticOrder S; S.init(S5CH, 256, 32, F.G, (F.blk + F.G / 2) % F.G);
              Epi8<FS5End> E{{WSP(float, WS_XEND)}}; gemm_phase(F.lds + RING_OFF, L, S, E); }
        }
        SEAM(pb + 2);
        if (PHON(4) && IN(pb + 3)) {
            asm volatile("; ==PH4");
            MKFRAME(F);
            if (F.blk < NR_RWKV && F.G > NR_RWKV) { for (int un = F.blk; un < NBATCH * NH * RW_SPLIT; un += NR_RWKV) rwkv_scan(F, un); }
            else { const int ab = F.blk - NR_RWKV, na = F.G - NR_RWKV; for (int idx = ab * 512 + F.tid; idx < NBATCH * 32 * 64; idx += na * 512) s5_carry(F, l, idx); }
            {
                LAS int* slot = (LAS int*)(F.lds + AT_LDS);
                for (;;) {
                    __syncthreads();
                    if (F.tid == 0) *slot = (int)__hip_atomic_fetch_add((unsigned*)(F.ctl + CW_ATTN + 64 * l), 1u, RLX_AGENT);
                    __syncthreads();
                    const int n = __builtin_amdgcn_readfirstlane(*slot); if (n >= NBATCH * NH * (SEQ / AT_QR)) break;
                    const int qb = (SEQ / AT_QR - 1) - (n >> 6), bh = n & 63;
                    attn_unit(F.tid, bh >> 3, bh & 7, qb, WSP(bf16, WS_Q), WSP(bf16, WS_K), WSP(bf16, WS_V), WSP(bf16, WS_YMLA), F.lds);
                }
            }
        }
        SEAM(pb + 3);
        if (PHON(5) && IN(pb + 4)) {
            asm volatile("; ==PH5");
            MKFRAME(F);
            { LocDense L{WSP(bf16, WS_S5U), WSP(bf16, WS_S5MAIN) + (size_t)l * 32 * 512 * S5K, S5K, S5K, S5K, (size_t)S5CH * S5K, (size_t)512 * S5K}; StaticOrder S; S.init(S5CH, 512, 32, F.G, F.blk);
              Epi8<FS5Main> E{{WSP(bf16, WS_S5U), INP(float, 28) + l * 512, WSP(bf16, WS_YS5G), {}}}; gemm_phase(F.lds + RING_OFF, L, S, E); }
            rwkv_post(F, l);
        }
        SEAM(pb + 4);
        if (PHON(6) && IN(pb + 5)) {
            asm volatile("; ==PH6");
            MKFRAME(F);
            { LocDense L{WSP(bf16, WS_YS5G), WSP(bf16, WS_WGLU) + (size_t)l * 512 * 512, 512, 512, 512, 0, 0}; StaticOrder S; S.init(M, 512, 1, F.G, F.blk);
              Epi8<FGlu> E{{WSP(bf16, WS_YS5G), INP(float, 30) + l * 512, WSP(bf16, WS_YS5), {}}}; gemm_phase(F.lds + RING_OFF, L, S, E); }
            { LocDense L{WSP(bf16, WS_XB), WSP(bf16, WS_WG) + ((size_t)l * 3 + 0) * 1024 * DM, DM, DM, DM, 0, 0}; StaticOrder S; S.init(M, 2048, 1, F.G, F.blk);
              Epi8<FGate2> E{{WSP(bf16, WS_GBUF), WSP(bf16, WS_GBUF2)}}; gemm_phase(F.lds + RING_OFF, L, S, E); }
            { LocDense L{WSP(bf16, WS_YMLA), WSP(bf16, WS_WBR) + ((size_t)l * 3 + 0) * 1024 * 512, 512, 512, 512, 0, 0}; StaticOrder S; S.init(M, 1024, 1, F.G, F.blk);
              Epi8<FMerge> E{{WSP(bf16, WS_GBUF), WSP(bf16, WS_MIXED2), WSP(bf16, WS_MIXED), 1}}; gemm_phase(F.lds + RING_OFF, L, S, E); }
            { LocDense L{WSP(bf16, WS_YRW), WSP(bf16, WS_WBR) + ((size_t)l * 3 + 1) * 1024 * 512, 512, 512, 512, 0, 0}; StaticOrder S; S.init(M, 1024, 1, F.G, F.blk);
              Epi8<FMerge> E{{WSP(bf16, WS_GBUF2), WSP(bf16, WS_MIXED), WSP(bf16, WS_MIXED2), 0}}; gemm_phase(F.lds + RING_OFF, L, S, E); }
        }
        SEAM(pb + 5);
        if (PHON(7) && IN(pb + 6)) {
            asm volatile("; ==PH7");
            MKFRAME(F);
            { LocDense L{WSP(bf16, WS_XB), WSP(bf16, WS_WG) + ((size_t)l * 3 + 2) * 1024 * DM, DM, DM, DM, 0, 0}; StaticOrder S; S.init(M, 1024, 1, F.G, F.blk);
              Epi8<FGate> E{{WSP(bf16, WS_GBUF)}}; gemm_phase(F.lds + RING_OFF, L, S, E); }
            { LocDense L{WSP(bf16, WS_YS5), WSP(bf16, WS_WBR) + ((size_t)l * 3 + 2) * 1024 * 512, 512, 512, 512, 0, 0}; StaticOrder S; S.init(M, 1024, 1, F.G, F.blk);
              Epi8<FMerge> E{{WSP(bf16, WS_GBUF), WSP(bf16, WS_MIXED2), WSP(bf16, WS_MIXED), 0}}; gemm_phase(F.lds + RING_OFF, L, S, E); }
        }
        SEAM(pb + 6);
        if (PHON(8) && IN(pb + 7)) {
            asm volatile("; ==PH8");
            MKFRAME(F);
            LocDense L{WSP(bf16, WS_MIXED), WSP(bf16, WS_WOUT) + (size_t)l * DM * DM, DM, DM, DM, 0, 0}; StaticOrder S; S.init(M, DM, 1, F.G, F.blk);
            Epi8<FResid> E{{WSP(bf16, WS_XB), (f16*)F.out}}; gemm_phase(F.lds + RING_OFF, L, S, E);
        }
        SEAM(pb + 7);
        if (PHON(9) && IN(pb + 8)) {
            asm volatile("; ==PH9");
            MKFRAME(F);
            if (moe) { ln1_moe_phase(F, INP(float, 33) + l * DM, INP(float, 34) + l * DM, li); moe_convert(F, li); }
            else ln_phase(F, INP(float, 33) + l * DM, INP(float, 34) + l * DM);
        }
        SEAM(pb + 8);
        if (PHON(10) && IN(pb + 9)) {
            asm volatile("; ==PH10");
            MKFRAME(F);
            if (moe) {
                const unsigned* cnt = (const unsigned*)(F.ctl + CW_MOECNT + 64 * li);
                LocMoe1 L{WSP(bf16, WS_XB), WSP(bf16, WS_WMGU), DM, DM, DM, WSP(int, WS_SLOTTOK), cnt}; MoeOrder S; S.init(cnt, 2 * EXD / 256, F.G, F.blk);
                EpiGU<FSwiglu> E{{WSP(bf16, WS_HM), EXD}}; gemm_phase(F.lds + RING_OFF, L, S, E);
            } else {
                LocDense L{WSP(bf16, WS_XB), WSP(bf16, WS_WFGU) + (size_t)li * 2 * FFN * DM, DM, DM, DM, 0, 0}; StaticOrder S; S.init(M, 2 * FFN, 1, F.G, F.blk);
                EpiGU<FSwiglu> E{{WSP(bf16, WS_HB), FFN}}; gemm_phase(F.lds + RING_OFF, L, S, E);
            }
        }
        SEAM(pb + 9);
        if (PHON(11) && IN(pb + 10)) {
            asm volatile("; ==PH11");
            MKFRAME(F);
            if (moe) {
                const unsigned* cnt = (const unsigned*)(F.ctl + CW_MOECNT + 64 * li);
                LocDense L{WSP(bf16, WS_HM), WSP(bf16, WS_WMD), EXD, EXD, EXD, 0, (size_t)DM * EXD}; MoeOrder S; S.init(cnt, DM / 256, F.G, F.blk);
                Epi8<FMoeDown> E{{WSP(bf16, WS_YPAIR), WSP(float, WS_SLOTW), cnt}}; gemm_phase(F.lds + RING_OFF, L, S, E);
            } else {
                LocDense L{WSP(bf16, WS_HB), WSP(bf16, WS_WFD) + (size_t)li * DM * FFN, FFN, FFN, FFN, 0, 0}; StaticOrder S; S.init(M, DM, 1, F.G, F.blk);
                Epi8<FResid> E{{WSP(bf16, WS_XB), (f16*)F.out}}; gemm_phase(F.lds + RING_OFF, L, S, E);
            }
        }
        SEAM(pb + 10);
        if (PHON(12) && IN(pb + 11)) {
            asm volatile("; ==PH12");
            MKFRAME(F);
            if (moe) ln2_moe_phase(F, INP(float, 35) + l * DM, INP(float, 36) + l * DM, li, l == NLAYER - 1);
            else ln_phase(F, INP(float, 35) + l * DM, INP(float, 36) + l * DM);
        }
        SEAM(pb + 11);
    }
#undef IN
#undef SEAM
}

extern "C" void kernel_launch(void* const* d_in, const int* in_sizes, int n_in, void* d_out, int out_size, void* d_ws, size_t ws_size, hipStream_t stream) {
    static int grid = 0;
    if (grid == 0) {
        if (n_in != 44 || out_size != M * DM || ws_size < WS_END) { fprintf(stderr, "kernel_launch: unexpected problem (n_in %d, out %d, ws %zu < %zu)\n", n_in, out_size, ws_size, (size_t)WS_END); grid = -1; return; }
        int dev = 0, cus = 0, per_cu = 0;
        if (hipGetDevice(&dev) != hipSuccess || hipDeviceGetAttribute(&cus, hipDeviceAttributeMultiprocessorCount, dev) != hipSuccess) { grid = -1; return; }
        if (hipFuncSetAttribute((const void*)mk_fwd, hipFuncAttributeMaxDynamicSharedMemorySize, LDS_BYTES) != hipSuccess) { fprintf(stderr, "kernel_launch: hipFuncSetAttribute failed\n"); grid = -1; return; }
        if (hipOccupancyMaxActiveBlocksPerMultiprocessor(&per_cu, (const void*)mk_fwd, NWAVES * 64, LDS_BYTES) != hipSuccess || per_cu < 1) { fprintf(stderr, "kernel_launch: occupancy query says %d blocks per CU\n", per_cu); }
        (void)hipGetLastError();
        grid = cus;
        if (grid != 256) fprintf(stderr, "kernel_launch: %d CUs (built for 256)\n", grid);
    }
    if (grid < 0) return;
    (void)in_sizes;
    if (hipMemsetAsync((char*)d_ws + WS_CTL, 0, CTL_ZERO_BYTES, stream) != hipSuccess) return;
    Args a{};
    for (int i = 0; i < 44; ++i) a.in[i] = d_in[i];
    a.out = (float*)d_out; a.ws = (unsigned char*)d_ws; a.pad = 0;
#if MK_PER_PHASE
    for (int p = 0; p < N_PHASES; ++p) { a.ph_lo = p; a.ph_hi = p + 1; a.li = p; hipLaunchKernelGGL(mk_fwd, dim3(grid), dim3(NWAVES * 64), LDS_BYTES, stream, a); }
#else
    a.ph_lo = 0; a.ph_hi = N_PHASES; a.li = 0;
    hipLaunchKernelGGL(mk_fwd, dim3(grid), dim3(NWAVES * 64), LDS_BYTES, stream, a);
#endif
}
```

```cpp
#include <hip/hip_runtime.h>
#include <cstdio>
#include <cstdint>
#include <cmath>
namespace pg8 {
#define PG8_LAS __attribute__((address_space(3)))
typedef unsigned short bf16_t;
typedef short bf16x8 __attribute__((ext_vector_type(8)));
typedef float f32x4 __attribute__((ext_vector_type(4)));
typedef float f32x2 __attribute__((ext_vector_type(2)));
typedef unsigned u32x4 __attribute__((ext_vector_type(4)));
typedef unsigned u32x2 __attribute__((ext_vector_type(2)));
constexpr int BM = 256, BK = 64, HALF = 128, HTB = HALF * BK * 2  , STAGE_BYTES = 8 * HTB, NXCD = 8, WGM = 8;

__host__ __device__ __forceinline__ int lds_byte(int r, int c) { const int st = (r >> 4) * 2 + (c >> 5), rr = r & 15, cc = c & 31, ob = rr * 64 + cc * 2; return st * 1024 + (ob ^ (((ob >> 9) & 1) << 5)); }
__host__ __device__ __forceinline__ void stage_rc(int b, int& R, int& C) { const int st = b / 1024, sb = b % 1024, swz = sb ^ (((sb >> 9) & 1) << 5); R = (st >> 1) * 16 + swz / 64; C = (st & 1) * 32 + (swz % 64) / 2; }
__host__ __device__ __forceinline__ int perm32(int rho) { const int n = rho >> 4, i = rho & 15; return 8 * (i >> 2) + 4 * n + (i & 3); }

struct Unit { int pm, pn, z, aux; };

typedef int v8i32 __attribute__((ext_vector_type(8)));
struct LocDense {
    static constexpr bool GATHER = false, FP8 = false;
    const bf16_t* A; const bf16_t* Bt; int lda, ldb, K; size_t zA, zB;
    __device__ __forceinline__ const char* a_ptr(const Unit& u) const { return (const char*)(A + (size_t)u.z * zA + (size_t)u.pm * BM * lda); }
    __device__ __forceinline__ const char* b_ptr(const Unit& u) const { return (const char*)(Bt + (size_t)u.z * zB + (size_t)u.pn * BM * ldb); }
    __device__ __forceinline__ void a_off(const Unit&, int tid, unsigned (&v)[2][2]) const {
#pragma unroll
        for (int i = 0; i < 2; ++i) { int R, C; stage_rc(tid * 16 + i * 8192, R, C); v[0][i] = (unsigned)(R * lda + C) * 2u; v[1][i] = 0u; }
    }
};

struct LocDense8 {
    static constexpr bool GATHER = false, FP8 = true;
    const bf16_t* A; const bf16_t* Bt; int lda, ldb, K; size_t zA, zB;
    __device__ __forceinline__ const char* a_ptr(const Unit& u) const { return (const char*)(A + (size_t)u.z * zA + (size_t)u.pm * BM * lda); }
    __device__ __forceinline__ const char* b_ptr(const Unit& u) const { return (const char*)(Bt + (size_t)u.z * zB + (size_t)u.pn * BM * ldb); }
    __device__ __forceinline__ void a_off(const Unit&, int tid, unsigned (&v)[2][2]) const {
#pragma unroll
        for (int i = 0; i < 2; ++i) { int R, C; stage_rc(tid * 16 + i * 8192, R, C); v[0][i] = (unsigned)(R * lda + C) * 2u; v[1][i] = 0u; }
    }
};

struct StaticOrder {
    int nM, nN, nwg, nZ, G, c;
    __device__ void init(int M, int N, int Z, int G_, int c_) { nM = M / BM; nN = N / BM; nwg = nM * nN; nZ = Z; G = G_; c = c_; }
    __device__ bool next(int i, Unit& u) const {
        const long L = (long)i * G + c; if (L >= (long)nwg * nZ) return false;
        u.z = (int)(L / nwg); u.aux = 0;
        int wgid = (int)(L % nwg); { const int q = nwg / NXCD, r = nwg % NXCD, xcd = wgid % NXCD, off = wgid / NXCD; wgid = (xcd < r ? xcd * (q + 1) : r * (q + 1) + (xcd - r) * q) + off; }
        const int nig = WGM * nN, gid = wgid / nig, fm = gid * WGM, gsz = (nM - fm) < WGM ? (nM - fm) : WGM;
        u.pm = fm + ((wgid % nig) % gsz); u.pn = (wgid % nig) / gsz; return true;
    }
};

typedef float f32x2_cv __attribute__((ext_vector_type(2))); typedef __bf16 bf16x2_cv __attribute__((ext_vector_type(2)));
__device__ __forceinline__ unsigned cvt_pk_bf16(float lo, float hi) { const f32x2_cv v = {lo, hi}; const bf16x2_cv b = __builtin_convertvector(v, bf16x2_cv); return __builtin_bit_cast(unsigned, b); }
__device__ __forceinline__ u32x4 pack8(const f32x4 v0, const f32x4 v1) { u32x4 w; w.x = cvt_pk_bf16(v0[0], v0[1]); w.y = cvt_pk_bf16(v0[2], v0[3]); w.z = cvt_pk_bf16(v1[0], v1[1]); w.w = cvt_pk_bf16(v1[2], v1[3]); return w; }
__device__ __forceinline__ float bf_lo(unsigned w) { return __uint_as_float(w << 16); }
__device__ __forceinline__ float bf_hi(unsigned w) { return __uint_as_float(w & 0xffff0000u); }
__device__ __forceinline__ void unpack8(const u32x4 w, f32x4& v0, f32x4& v1) { v0 = (f32x4){bf_lo(w.x), bf_hi(w.x), bf_lo(w.y), bf_hi(w.y)}; v1 = (f32x4){bf_lo(w.z), bf_hi(w.z), bf_lo(w.w), bf_hi(w.w)}; }

struct NoPre {};
template <class F, class = void> struct is_priv { static constexpr bool value = false; };
template <class F> struct is_priv<F, decltype((void)F::PRIV)> { static constexpr bool value = F::PRIV; };
template <class F> struct Epi8 {
    static constexpr bool PERM = true;
    F f;
    __device__ __forceinline__ void operator()(const f32x4 (&acc)[2][2][4][2], const Unit& u, int wr, int wc, int fr, int fq) const {
        const int row0 = u.pm * BM + wr * 64 + fr, col0 = u.pn * BM + wc * 32 + 8 * fq;
        F g = f;
        if constexpr (is_priv<F>::value) {
            const unsigned pbase = (unsigned)((u.pm * 4 + (u.pn & 3)) * 65536 + (wr * 4 + wc) * 8192 + (fq * 16 + fr) * 8);
#pragma unroll
            for (int bj = 0; bj < 2; ++bj) { const int col = col0 + bj * HALF;
#pragma unroll
                for (int b0 = 0; b0 < 8; b0 += F::BATCH) { typename F::Pre pr[F::BATCH];
#pragma unroll
                    for (int i = 0; i < F::BATCH; ++i) { const int q = b0 + i; pr[i] = g.pre_p(u, row0 + (q >> 2) * HALF + (q & 3) * 16, col, pbase + (unsigned)((bj * 8 + q) * 512)); }
#pragma unroll
                    for (int i = 0; i < F::BATCH; ++i) { const int q = b0 + i; g.tile8_p(u, row0 + (q >> 2) * HALF + (q & 3) * 16, col, acc[q >> 2][bj][q & 3][0], acc[q >> 2][bj][q & 3][1], pr[i], pbase + (unsigned)((bj * 8 + q) * 512)); }
                    asm volatile("" ::: "memory"); } }
        } else {
#pragma unroll
        for (int bj = 0; bj < 2; ++bj) { const int col = col0 + bj * HALF; g.begin_col(u, col);
#pragma unroll
            for (int b0 = 0; b0 < 8; b0 += F::BATCH) { typename F::Pre pr[F::BATCH];
#pragma unroll
                for (int i = 0; i < F::BATCH; ++i) { const int q = b0 + i; pr[i] = g.pre(u, row0 + (q >> 2) * HALF + (q & 3) * 16, col); }
#pragma unroll
                for (int i = 0; i < F::BATCH; ++i) { const int q = b0 + i; g.tile8(u, row0 + (q >> 2) * HALF + (q & 3) * 16, col, acc[q >> 2][bj][q & 3][0], acc[q >> 2][bj][q & 3][1], pr[i]); }
                asm volatile("" ::: "memory"); } }
        }
    }
};
template <class F> struct EpiGU {
    static constexpr bool PERM = true;
    F f;
    __device__ __forceinline__ void operator()(const f32x4 (&acc)[2][2][4][2], const Unit& u, int wr, int wc, int fr, int fq) const {
        const int row0 = u.pm * BM + wr * 64 + fr, colh = u.pn * HALF + wc * 32 + 8 * fq;
        if constexpr (F::WIDE) {
#pragma unroll
            for (int ai = 0; ai < 2; ++ai)
#pragma unroll
                for (int m = 0; m < 4; m += 2) { f.pair16(u, row0 + ai * HALF + m * 16, colh - 8 * fq, fq, acc[ai][0][m][0], acc[ai][0][m][1], acc[ai][1][m][0], acc[ai][1][m][1],
                                                          acc[ai][0][m + 1][0], acc[ai][0][m + 1][1], acc[ai][1][m + 1][0], acc[ai][1][m + 1][1]); asm volatile("" ::: "memory"); }
        } else {
#pragma unroll
            for (int ai = 0; ai < 2; ++ai)
#pragma unroll
                for (int m = 0; m < 4; ++m) { f.pair8(u, row0 + ai * HALF + m * 16, colh, acc[ai][0][m][0], acc[ai][0][m][1], acc[ai][1][m][0], acc[ai][1][m][1]); asm volatile("" ::: "memory"); }
        }
    }
};

template <bool F8> struct FragSel { typedef bf16x8 T; static constexpr int NK = 2; };
template <> struct FragSel<true> { typedef v8i32 T; static constexpr int NK = 1; };
__device__ __forceinline__ f32x4 pg8_mfma(const bf16x8 a, const bf16x8 b, const f32x4 c) { return __builtin_amdgcn_mfma_f32_16x16x32_bf16(a, b, c, 0, 0, 0); }
__device__ __forceinline__ f32x4 pg8_mfma(const v8i32 a, const v8i32 b, const f32x4 c) { return __builtin_amdgcn_mfma_scale_f32_16x16x128_f8f6f4(a, b, c, 0, 0, 0, 0x7f7f7f7f, 0, 0x7f7f7f7f); }
__device__ __forceinline__ void pg8_dma(const void* sbase, unsigned voff, unsigned ldsaddr) {
    unsigned keep; const unsigned long long b_ = (unsigned long long)sbase;
    const unsigned long long sb_ = ((unsigned long long)(unsigned)__builtin_amdgcn_readfirstlane((int)(b_ >> 32)) << 32) | (unsigned)__builtin_amdgcn_readfirstlane((int)(unsigned)b_);
    const unsigned la_ = (unsigned)__builtin_amdgcn_readfirstlane((int)ldsaddr);
    asm volatile("s_mov_b32 %0, m0\n\ts_mov_b32 m0, %3\n\ts_nop 0\n\tglobal_load_lds_dwordx4 %1, %2\n\ts_mov_b32 m0, %0" : "=&s"(keep) : "v"(voff), "s"(sb_), "s"(la_) : "memory");
}
template <class Epi, class Sched, class Loc>
__device__ __forceinline__ void gemm_phase(int tid_in, PG8_LAS unsigned char* lds, const Loc& L, const Sched& S, const Epi& E) {
    int tid_ = tid_in; asm volatile("" : "+v"(tid_));
    const int tid = tid_, wid = __builtin_amdgcn_readfirstlane(tid >> 6), lane = tid & 63, wr = wid >> 2, wc = wid & 3, fr = lane & 15, fq = lane >> 4;
    const int K = L.K, nt = K / BK;
    unsigned voffB[2];
#pragma unroll
    for (int i = 0; i < 2; ++i) { int R, C; stage_rc(tid * 16 + i * 8192, R, C); const int Rb = Epi::PERM ? ((R & ~31) + perm32(R & 31)) : R;
        voffB[i] = (unsigned)(Rb * L.ldb + C) * 2u; }
    const size_t kstep = (size_t)(BK * 2);
    const size_t hstepB = (size_t)HALF * L.ldb * 2;
    const unsigned lds0 = (unsigned)(uintptr_t)lds;
    const unsigned ldsw = (unsigned)wid * 1024u;
    const int aoff = Loc::FP8 ? lds_byte(wr * 64 + fr, (fq >> 1) * 32 + (fq & 1) * 16) : lds_byte(wr * 64 + fr, fq * 8);
    const int boff = Loc::FP8 ? lds_byte(wc * 32 + fr, (fq >> 1) * 32 + (fq & 1) * 16) : lds_byte(wc * 32 + fr, fq * 8);
#define PG8_SA(b, h) (((b) * 2 + (h)) * HTB)
#define PG8_SB(b, h) ((4 + (b) * 2 + (h)) * HTB)
#define PG8_STAGE(bufoff, gbase, voff) do { _Pragma("unroll") for (int _i = 0; _i < 2; ++_i) { \
        pg8_dma((const void*)(gbase), (voff)[_i], lds0 + (unsigned)((bufoff) + _i * 8192) + ldsw); } } while (0)
#define PG8_LDA(dst, b, h) do { if constexpr (Loc::FP8) { _Pragma("unroll") for (int m = 0; m < 4; ++m) dst[m][0] = *(const PG8_LAS FragT*)(lds + PG8_SA(b, h) + aoff + m * 2048); } \
        else { _Pragma("unroll") for (int m = 0; m < 4; ++m) _Pragma("unroll") for (int k = 0; k < 2; ++k) dst[m][k] = *(const PG8_LAS FragT*)(lds + PG8_SA(b, h) + aoff + m * 2048 + k * 1024); } } while (0)
#define PG8_LDB(dst, b, h) do { if constexpr (Loc::FP8) { _Pragma("unroll") for (int n = 0; n < 2; ++n) dst[n][0] = *(const PG8_LAS FragT*)(lds + PG8_SB(b, h) + boff + n * 2048); } \
        else { _Pragma("unroll") for (int n = 0; n < 2; ++n) _Pragma("unroll") for (int k = 0; k < 2; ++k) dst[n][k] = *(const PG8_LAS FragT*)(lds + PG8_SB(b, h) + boff + n * 2048 + k * 1024); } } while (0)
#define PG8_MMA(ai, bj, At, Bt) do { __builtin_amdgcn_s_setprio(1); _Pragma("unroll") for (int m = 0; m < 4; ++m) _Pragma("unroll") for (int n = 0; n < 2; ++n) _Pragma("unroll") for (int k = 0; k < NKF; ++k) \
            acc[ai][bj][m][n] = pg8_mfma(Bt[n][k], At[m][k], acc[ai][bj][m][n]); __builtin_amdgcn_s_setprio(0); } while (0)
#define PG8_WAIT_V(n) asm volatile("s_waitcnt vmcnt(" #n ")" ::: "memory")
#define PG8_WAIT_L(n) asm volatile("s_waitcnt lgkmcnt(" #n ")" ::: "memory")
#define PG8_BAR __builtin_amdgcn_s_barrier()
#define PG8_SCHED __builtin_amdgcn_sched_barrier(0)
    Unit cur, nxt; int ui = 0;
    if (!S.next(0, cur)) return;
    f32x4 acc[2][2][4][2];
#pragma unroll
    for (int a = 0; a < 2; ++a)
#pragma unroll
        for (int b = 0; b < 2; ++b)
#pragma unroll
            for (int m = 0; m < 4; ++m)
#pragma unroll
                for (int n = 0; n < 2; ++n) acc[a][b][m][n] = (f32x4){0.f, 0.f, 0.f, 0.f};
    typedef typename FragSel<Loc::FP8>::T FragT; constexpr int NKF = FragSel<Loc::FP8>::NK;
    FragT At[4][NKF], B0[2][NKF], B1[2][NKF];
    constexpr int NVH = Loc::GATHER ? 2 : 1;
    unsigned vc[2][2], vn[NVH][2];
    L.a_off(cur, tid, vc);
    if constexpr (Loc::GATHER) {
#pragma unroll
        for (int h = 0; h < 2; ++h)
#pragma unroll
            for (int i = 0; i < 2; ++i) vn[h][i] = vc[h][i];
    }
    const size_t hstepA = Loc::GATHER ? 0 : (size_t)HALF * L.lda * 2;
    const char* cA = L.a_ptr(cur); const char* cB = L.b_ptr(cur);
    PG8_STAGE(PG8_SB(0, 0), cB, voffB); PG8_STAGE(PG8_SB(0, 1), cB + hstepB, voffB); PG8_STAGE(PG8_SA(0, 0), cA, vc[0]); PG8_STAGE(PG8_SA(0, 1), cA + hstepA, vc[NVH - 1]);
    if (wr == 1) PG8_BAR;
    PG8_WAIT_V(2); PG8_BAR;
    PG8_STAGE(PG8_SB(1, 0), cB + kstep, voffB); PG8_STAGE(PG8_SA(1, 0), cA + kstep, vc[0]); PG8_STAGE(PG8_SB(1, 1), cB + hstepB + kstep, voffB);
    PG8_WAIT_V(6); PG8_BAR;
    for (;;) {
        const bool has_next = S.next(ui + 1, nxt);
        const char* nA = has_next ? L.a_ptr(nxt) : cA; const char* nB = has_next ? L.b_ptr(nxt) : cB;
        if constexpr (Loc::GATHER) { if (has_next) L.a_tok(nxt, tid, vn); }
        for (int t = 0; t < nt; t += 2) {
            const bool last = (t == nt - 2);
            const char* a1 = cA + (size_t)(t + 1) * kstep;
            const char* a2 = last ? nA : cA + (size_t)(t + 2) * kstep; const char* b2 = last ? nB : cB + (size_t)(t + 2) * kstep;
            const char* a3 = a2 + kstep; const char* b3 = b2 + kstep;
            PG8_LDB(B0, 0, 0); PG8_LDB(B1, 0, 1); PG8_SCHED; PG8_LDA(At, 0, 0); PG8_STAGE(PG8_SA(1, 1), a1 + hstepA, vc[NVH - 1]);
            if constexpr (Loc::GATHER) { if (last && has_next) L.a_fin(tid, vn, vc); }
            PG8_WAIT_V(8); PG8_WAIT_L(0); PG8_BAR; PG8_MMA(0, 0, At, B0); PG8_MMA(0, 1, At, B1); PG8_BAR; PG8_SCHED;
            PG8_LDA(At, 0, 1); PG8_STAGE(PG8_SB(0, 0), b2, voffB); PG8_STAGE(PG8_SB(0, 1), b2 + hstepB, voffB); PG8_STAGE(PG8_SA(0, 0), a2, vc[0]);
            PG8_WAIT_V(8); PG8_WAIT_L(0); PG8_BAR; PG8_MMA(1, 0, At, B0); PG8_MMA(1, 1, At, B1); PG8_BAR; PG8_SCHED;
            PG8_LDB(B0, 1, 0); PG8_LDB(B1, 1, 1); PG8_SCHED; PG8_LDA(At, 1, 0); PG8_STAGE(PG8_SA(0, 1), a2 + hstepA, vc[NVH - 1]);
            PG8_WAIT_V(8); PG8_WAIT_L(0); PG8_BAR; PG8_MMA(0, 0, At, B0); PG8_MMA(0, 1, At, B1); PG8_BAR; PG8_SCHED;
            PG8_LDA(At, 1, 1); PG8_STAGE(PG8_SB(1, 0), b3, voffB); PG8_STAGE(PG8_SB(1, 1), b3 + hstepB, voffB); PG8_STAGE(PG8_SA(1, 0), a3, vc[0]);
            PG8_WAIT_V(8); PG8_WAIT_L(0); PG8_BAR; PG8_MMA(1, 0, At, B0); PG8_MMA(1, 1, At, B1); PG8_BAR; PG8_SCHED;
        }
        if (wr == 0) PG8_BAR;
        { int ln_e; asm volatile("v_mbcnt_lo_u32_b32 %0, -1, 0\n\tv_mbcnt_hi_u32_b32 %0, -1, %0" : "=v"(ln_e)); const int fr_e = ln_e & 15, fq_e = ln_e >> 4; int wr_e = wr, wc_e = wc; asm volatile("" : "+s"(wr_e), "+s"(wc_e));
          E(acc, cur, wr_e, wc_e, fr_e, fq_e); }
        if (!has_next) break;
#pragma unroll
        for (int a = 0; a < 2; ++a)
#pragma unroll
            for (int b = 0; b < 2; ++b)
#pragma unroll
                for (int m = 0; m < 4; ++m)
#pragma unroll
                    for (int n = 0; n < 2; ++n) { f32x2 z0, z1; asm volatile("v_mov_b64 %0, 0" : "=v"(z0)); asm volatile("v_mov_b64 %0, 0" : "=v"(z1)); acc[a][b][m][n] = (f32x4){z0[0], z0[1], z1[0], z1[1]}; }
        cur = nxt; cA = nA; cB = nB; ++ui;
        if (wr == 1) PG8_BAR;
    }
    PG8_WAIT_V(0);
    PG8_BAR;
#undef PG8_SA
#undef PG8_SB
#undef PG8_STAGE
#undef PG8_LDA
#undef PG8_LDB
#undef PG8_MMA
#undef PG8_WAIT_V
#undef PG8_WAIT_L
#undef PG8_BAR
#undef PG8_SCHED
}
}
constexpr int NWAVES = 8;
constexpr int M = 32768, DM = 1024, SEQ = 4096, NBATCH = 8, NLAYER = 4;
constexpr int NH = 8;
constexpr int IN_W = 6048;
constexpr int FFN = 2816, EXD = 3584, NEXP = 8;
constexpr float LN_EPS = 1e-5f, ALPHA = 1.681792830507429f;
constexpr int S5T = 32, S5CH = M / S5T  , S5K = 640, S5NC = SEQ / S5T  ;
constexpr int MOE_CAP = 65536;
#ifndef FP8_DENSE
#define FP8_DENSE 0
#endif
#ifndef FP8_MOE
#define FP8_MOE 1
#define FP8_DD 1
#define FP8_MOED 1
constexpr float FP8_HSCALE = 2.0f;
#endif
constexpr int MOE_ROWS = 65536 + 8 * 256;

constexpr size_t MiB = 1u << 20;
constexpr size_t WS_CTL = 0, CTL_ZERO_BYTES = 1 * MiB;
constexpr size_t WS_WIN = 1 * MiB;
constexpr size_t WS_WG = 25 * MiB;
constexpr size_t WS_WUQ = 49 * MiB;
constexpr size_t WS_WUKV = 52 * MiB;
constexpr size_t WS_WLORA = 54 * MiB;
constexpr size_t WS_WVRES = 57 * MiB;
constexpr size_t WS_WGLU = 59 * MiB;
constexpr size_t WS_WBR = 61 * MiB;
constexpr size_t WS_WOUT = 73 * MiB;
constexpr size_t WS_WFGU = 81 * MiB;
constexpr size_t WS_WFD = 103 * MiB;
constexpr size_t WS_S5MAIN = 898 * MiB;
constexpr size_t WS_S5END = 978 * MiB;
constexpr size_t WS_S5A32 = 1010 * MiB;
constexpr size_t WS_ROPE = 143 * MiB;
constexpr size_t WS_XB = 147 * MiB;
constexpr size_t WS_VFIRST = 211 * MiB;
constexpr size_t RB = 243 * MiB;
constexpr size_t WS_S5U = RB + 0;
constexpr size_t WS_S1 = RB + 40 * MiB;
constexpr size_t WS_MLARAW = WS_S1;
constexpr size_t WS_RWRAW = WS_S1 + 48 * MiB;
constexpr size_t WS_Q = WS_S1;
constexpr size_t WS_V = WS_S1 + 48 * MiB;
constexpr size_t WS_BV = WS_S1 + 80 * MiB;
constexpr size_t WS_DCY = WS_S1 + 112 * MiB;
constexpr size_t WS_YS5G = WS_S1;
constexpr size_t WS_YS5 = WS_S1 + 32 * MiB;
constexpr size_t WS_MIXED = WS_S1 + 64 * MiB;
constexpr size_t WS_R = RB + 200 * MiB;
constexpr size_t WS_KH = RB + 232 * MiB;
constexpr size_t WS_KKN = RB + 264 * MiB;
constexpr size_t WS_GL = RB + 296 * MiB;
constexpr size_t WS_GBUF = RB + 264 * MiB;
constexpr size_t WS_VFIN = RB + 328 * MiB;
constexpr size_t WS_K = RB + 360 * MiB;
constexpr size_t WS_VRAW = RB + 408 * MiB;
constexpr size_t WS_YRW = WS_VRAW;
constexpr size_t WS_S2 = RB + 440 * MiB;
constexpr size_t WS_CQN = WS_S2;
constexpr size_t WS_CKVN = WS_S2 + 24 * MiB;
constexpr size_t WS_LORAIN = WS_S2 + 40 * MiB;
constexpr size_t WS_YMLA = WS_S2;
constexpr size_t WS_XEND = RB + 496 * MiB;
constexpr size_t WS_GBUF2 = RB + 512 * MiB;
constexpr size_t WS_MIXED2 = RB + 576 * MiB;
constexpr size_t WS_HB = RB + 0;
constexpr size_t WS_WMGU = RB + 0;
constexpr size_t WS_YPAIR = RB + 0;
constexpr size_t WS_XQM = RB + 56 * MiB;
constexpr size_t WS_HM = RB + 132 * MiB;
constexpr size_t WS_WMD = RB + 594 * MiB;
constexpr size_t WS_SLOTTOK = RB + 650 * MiB;
constexpr size_t WS_SLOTW = RB + 652 * MiB;
constexpr size_t WS_PAIRPOS = RB + 654 * MiB;
constexpr size_t WS_END = 1011 * MiB;
constexpr int CW_BAR = 4096;
constexpr int CW_ATTN = 200000;
constexpr int CW_MOECNT = 201024;
constexpr int CW_MOETAB = 210000;

constexpr int RING_OFF = 0, RING_BYTES = 131072;
constexpr int LDSCTL_OFF = RING_BYTES, MISC_OFF = LDSCTL_OFF + 320;
constexpr int LDS_BYTES = 147456;

#define GAS __attribute__((address_space(1)))
#define LAS __attribute__((address_space(3)))
typedef unsigned short bf16;
typedef _Float16 f16;
typedef f16 f16x8 __attribute__((ext_vector_type(8)));
typedef unsigned v4u __attribute__((ext_vector_type(4)));
typedef unsigned v2u __attribute__((ext_vector_type(2)));
typedef float f32x4 __attribute__((ext_vector_type(4)));
typedef float f32x16 __attribute__((ext_vector_type(16)));
typedef short bf16x8 __attribute__((ext_vector_type(8)));
typedef short s16x4 __attribute__((ext_vector_type(4)));
typedef GAS unsigned gu32;
#define RLX_AGENT __ATOMIC_RELAXED, __HIP_MEMORY_SCOPE_AGENT
#define LDS_WAIT() asm volatile("s_waitcnt lgkmcnt(0)" ::: "memory")
using pg8::cvt_pk_bf16; using pg8::pack8; using pg8::unpack8; using pg8::bf_lo; using pg8::bf_hi;

__device__ __forceinline__ float sigm(float x) { return __builtin_amdgcn_rcpf(1.0f + __expf(-x)); }
__device__ __forceinline__ float gelu_tanh(float y) { const float u = 0.7978845608028654f * (y + 0.044715f * y * y * y); const float t = 1.0f - 2.0f * __builtin_amdgcn_rcpf(__expf(2.0f * u) + 1.0f); return 0.5f * y * (1.0f + t); }
__device__ __forceinline__ int mk_lane() { int l; asm volatile("v_mbcnt_lo_u32_b32 %0, -1, 0\n\tv_mbcnt_hi_u32_b32 %0, -1, %0" : "=v"(l)); return l; }
__device__ __forceinline__ float mk_shfl_xor(float v, int m) { return __builtin_bit_cast(float, __builtin_amdgcn_ds_bpermute((mk_lane() ^ m) << 2, __builtin_bit_cast(int, v))); }
__device__ __forceinline__ int mk_shfl(int v, int src) { return __builtin_amdgcn_ds_bpermute(src << 2, v); }
__device__ __forceinline__ float wave_sum(float v) {
    const int l = mk_lane();
#pragma unroll
    for (int o = 1; o < 64; o <<= 1) v += __builtin_bit_cast(float, __builtin_amdgcn_ds_bpermute((l ^ o) << 2, __builtin_bit_cast(int, v)));
    return v;
}
__device__ __forceinline__ v4u ld_nt16(const void* p) { return __builtin_nontemporal_load((const v4u*)p); }
__device__ __forceinline__ void f16x8_to_f32(const f16x8 h, float (&o)[8]) {
#pragma unroll
    for (int j = 0; j < 8; ++j) o[j] = (float)h[j];
}
__device__ __forceinline__ f16x8 f32_to_f16x8(const float (&v)[8]) { f16x8 h;
#pragma unroll
    for (int j = 0; j < 8; ++j) h[j] = (f16)v[j];
    return h; }
__device__ __forceinline__ void bf16x8_to_f32(const v4u w, float (&o)[8]) { o[0] = bf_lo(w.x); o[1] = bf_hi(w.x); o[2] = bf_lo(w.y); o[3] = bf_hi(w.y); o[4] = bf_lo(w.z); o[5] = bf_hi(w.z); o[6] = bf_lo(w.w); o[7] = bf_hi(w.w); }
__device__ __forceinline__ v4u f32_to_bf16x8(const float (&v)[8]) { v4u w; w.x = cvt_pk_bf16(v[0], v[1]); w.y = cvt_pk_bf16(v[2], v[3]); w.z = cvt_pk_bf16(v[4], v[5]); w.w = cvt_pk_bf16(v[6], v[7]); return w; }
__device__ __forceinline__ void ld8f(const float* p, float (&o)[8]) { const f32x4 a = *(const f32x4*)p, b = *(const f32x4*)(p + 4); o[0] = a[0]; o[1] = a[1]; o[2] = a[2]; o[3] = a[3]; o[4] = b[0]; o[5] = b[1]; o[6] = b[2]; o[7] = b[3]; }

#define XB_TMO      128
#define XB_XCNT(j)  (256  + 64 * (j))
#define XB_XSUB(j)  (1280 + 64 * (j))
#define XB_XGEN(j)  (2304 + 64 * (j))
#define XB_TOP      3328
#define XB_TOPGEN   3392
#define XCD_BAR_WORDS 3456
#define XB_SPIN_CAP (1u << 20)

__device__ __forceinline__ unsigned xb_ld(unsigned* p)              { return __hip_atomic_load(p, __ATOMIC_RELAXED, __HIP_MEMORY_SCOPE_AGENT); }
__device__ __forceinline__ unsigned xb_add(unsigned* p, unsigned v) { return __hip_atomic_fetch_add(p, v, __ATOMIC_RELAXED, __HIP_MEMORY_SCOPE_AGENT); }
__device__ __forceinline__ unsigned xb_xcc_id() { return (unsigned)__builtin_amdgcn_s_getreg((3 << 11) | 20) & 0xFu; }
#define XB_SPIN(cond, bar) do { unsigned _sp = 0; while (cond) { __builtin_amdgcn_s_sleep(1); \
    if ((++_sp & 255u) == 0u) { if (xb_ld(&(bar)[XB_TMO])) break; if (_sp > XB_SPIN_CAP) { atomicAdd(&(bar)[XB_TMO], 1u); break; } } } } while (0)

struct XcdBarrier { unsigned* bar; unsigned x; volatile LAS unsigned* st; };

__device__ __forceinline__ XcdBarrier xcd_barrier_post(unsigned* bar, volatile LAS unsigned* st) {
    XcdBarrier b; b.bar = bar; b.x = xb_xcc_id(); b.st = st;
    if (threadIdx.x == 0) (void)xb_add(&bar[XB_XCNT(b.x)], 1u);
    return b;
}
__device__ __forceinline__ void xcd_barrier_complete(unsigned* bar, unsigned x, unsigned& nloc, unsigned& nx) {
    const unsigned G = gridDim.x * gridDim.y * gridDim.z;
    unsigned sum, cnt, mine, sp = 0u;
    for (;;) {
        sum = 0u; cnt = 0u; mine = 0u;
#pragma unroll
        for (unsigned j = 0; j < 16; ++j) { const unsigned c = xb_ld(&bar[XB_XCNT(j)]); sum += c; cnt += (c > 0u) ? 1u : 0u; mine = (j == x) ? c : mine; }
        if (sum == G) break;
        __builtin_amdgcn_s_sleep(1);
        if ((++sp & 255u) == 0u) { if (xb_ld(&bar[XB_TMO])) break; if (sp > XB_SPIN_CAP) { atomicAdd(&bar[XB_TMO], 1u); break; } }
    }
    nloc = mine > 0u ? mine : 1u; nx = cnt > 0u ? cnt : 1u;
}
__device__ __forceinline__ void xcd_barrier(const XcdBarrier& b, bool t0) {
    asm volatile("s_waitcnt vmcnt(0)" ::: "memory");
    __syncthreads();
    if (t0) {
        unsigned* bar = b.bar;
        __builtin_amdgcn_s_waitcnt(0);
        unsigned nloc = b.st[0], nx = b.st[1];
        if (nloc == 0u) { xcd_barrier_complete(bar, b.x, nloc, nx); b.st[0] = nloc; b.st[1] = nx; }
        const unsigned old = xb_add(&bar[XB_XSUB(b.x)], 1u);
        const unsigned gen = old / nloc;
        if (old + 1u == (gen + 1u) * nloc) {
            __builtin_amdgcn_fence(__ATOMIC_RELEASE, "agent");
            asm volatile("s_waitcnt vmcnt(0)" ::: "memory");
            const unsigned og = xb_add(&bar[XB_TOP], 1u);
            const unsigned tg = og / nx;
            if (og + 1u == (tg + 1u) * nx) xb_add(&bar[XB_TOPGEN], 1u);
            else XB_SPIN(xb_ld(&bar[XB_TOPGEN]) == tg, bar);
            __builtin_amdgcn_fence(__ATOMIC_ACQUIRE, "agent");
            xb_add(&bar[XB_XGEN(b.x)], 1u);
            asm volatile("s_waitcnt vmcnt(0)" ::: "memory");
        } else {
            XB_SPIN(xb_ld(&bar[XB_XGEN(b.x)]) == gen, bar);
            __builtin_amdgcn_fence(__ATOMIC_ACQUIRE, "agent");
            asm volatile("s_waitcnt vmcnt(0)" ::: "memory");
        }
    }
    __syncthreads();
}

struct Args { const void* in[44]; float* out; unsigned char* ws; int ph_lo, ph_hi, li, pad; };
typedef const __attribute__((address_space(4))) Args* KArgs;
struct Frame {
    LAS unsigned char* lds;
    unsigned char* ws;
    gu32* ctl;
    int tid, lane, wave;
    int G, blk;
    float* out;
    KArgs ka;
};
#define MK_TID() (mk_wave0 * 64 + mk_lane())
#define MKFRAME(F) Frame F; { int t_ = MK_TID(); asm volatile("" : "+v"(t_)); KArgs k_ = (KArgs)__builtin_amdgcn_kernarg_segment_ptr(); asm volatile("" : "+s"(k_)); \
    F.lds = (LAS unsigned char*)lds_raw; F.ka = k_; F.ws = k_->ws; F.ctl = (gu32*)(k_->ws + WS_CTL); F.out = k_->out; F.tid = t_; F.lane = t_ & 63; F.wave = __builtin_amdgcn_readfirstlane(t_ >> 6); F.G = gridDim.x; F.blk = blockIdx.x; }
#define WSP(T, off) ((T*)(F.ws + (off)))
#define INP(T, i) ((const T*)F.ka->in[i])
using pg8::Unit; using pg8::Epi8; using pg8::EpiGU;
__device__ __forceinline__ void f4x2_to8(const f32x4 v0, const f32x4 v1, float (&o)[8]) { o[0] = v0[0]; o[1] = v0[1]; o[2] = v0[2]; o[3] = v0[3]; o[4] = v1[0]; o[5] = v1[1]; o[6] = v1[2]; o[7] = v1[3]; }

struct FProj {
    static constexpr int BATCH = 8; bf16* mla; bf16* rw; bf16* s5u;
    __device__ __forceinline__ void begin_col(const Unit&, int) {}
    typedef pg8::NoPre Pre; __device__ __forceinline__ Pre pre(const Unit&, int, int) const { return Pre{}; }
    __device__ __forceinline__ void tile8(const Unit&, int row, int col, const f32x4 v0, const f32x4 v1, const Pre&) const {
        const v4u w = pack8(v0, v1);
        if (col < 768) *(v4u*)(mla + (unsigned)row * 768 + col) = w;
        else if (col < 2560) *(v4u*)(rw + (unsigned)row * 1792 + (col - 768)) = w;
        else { const int c = col - 2560, g = c >> 4, i = c & 15; *(v4u*)(s5u + (unsigned)((g * S5CH + (row >> 5)) * S5K) + (row & 31) * 16 + i) = w; }
    }
};
struct FQup {
    static constexpr int BATCH = 4; bf16* Q; const float* cs; float qs;
    struct Pre { f32x4 c, s; };
    __device__ __forceinline__ void begin_col(const Unit&, int) {}
    __device__ __forceinline__ Pre pre(const Unit&, int row, int col) const { Pre p; const int head = col / 96, w = (col - head * 96) >> 3;
        if (w >= 8) { const int i0 = (w - 8) * 4; p.c = *(const f32x4*)(cs + (unsigned)row * 32 + i0); p.s = *(const f32x4*)(cs + (unsigned)row * 32 + 16 + i0); } else { p.c = (f32x4){0.f, 0.f, 0.f, 0.f}; p.s = p.c; } return p; }
    __device__ __forceinline__ void tile8(const Unit&, int row, int col, const f32x4 v0, const f32x4 v1, const Pre& p) const {
        const int head = col / 96, w = (col - head * 96) >> 3;
        bf16* q = Q + (unsigned)row * 768 + head * 96;
        if (w < 8) { *(v4u*)(q + 8 * w) = pack8(v0 * qs, v1 * qs); }
        else { const int i0 = (w - 8) * 4; const f32x4 c = p.c, s = p.s;
            const f32x4 x1 = (f32x4){v0[0], v0[2], v1[0], v1[2]}, x2 = (f32x4){v0[1], v0[3], v1[1], v1[3]};
            const f32x4 o1 = (x1 * c - x2 * s) * qs, o2 = (x1 * s + x2 * c) * qs;
            v2u a, b; a.x = cvt_pk_bf16(o1[0], o1[1]); a.y = cvt_pk_bf16(o1[2], o1[3]); b.x = cvt_pk_bf16(o2[0], o2[1]); b.y = cvt_pk_bf16(o2[2], o2[3]);
            *(v2u*)(q + 64 + i0) = a; *(v2u*)(q + 80 + i0) = b; }
    }
};
struct FKVup {
    static constexpr int BATCH = 8; bf16* K; bf16* V;
    __device__ __forceinline__ void begin_col(const Unit&, int) {}
    typedef pg8::NoPre Pre; __device__ __forceinline__ Pre pre(const Unit&, int, int) const { return Pre{}; }
    __device__ __forceinline__ void tile8(const Unit&, int row, int col, const f32x4 v0, const f32x4 v1, const Pre&) const {
        const int head = col >> 7, d = col & 127; const v4u w = pack8(v0, v1);
        const unsigned bht = (unsigned)((((row >> 12) * NH + head) * (SEQ / 64)) + ((row & (SEQ - 1)) >> 6)), key = (unsigned)(row & 63);
        if (d < 64) *(v4u*)(K + ((bht * 12u + (unsigned)(d >> 3)) * 64u + key) * 8u) = w;
        else { const int dv = d - 64; *(v4u*)(V + ((bht * 2u + (unsigned)(dv >> 5)) * 64u + key) * 32u + (unsigned)(dv & 31)) = w; }
    }
};
struct FLora {
    static constexpr int BATCH = 4;
    const float* w0; const float* a0; const float* k_a; f16* dcy; f16* kh; const f16* kkn; f16* bv; bf16* gl; float p[8], ka[8];
    struct Pre { f16x8 k, kn; };
    __device__ __forceinline__ void begin_col(const Unit&, int col) { const int seg = col >> 9, c = col & 511; ld8f(((seg == 0) ? w0 : a0) + c, p); ld8f(k_a + c, ka); }
    __device__ __forceinline__ Pre pre(const Unit&, int row, int col) const { Pre r; const unsigned off = (unsigned)row * 512 + (col & 511);
        if ((col >> 9) == 1) { r.k = *(const f16x8*)(kh + off); r.kn = *(const f16x8*)(kkn + off); } else { r.k = (f16x8)(0); r.kn = (f16x8)(0); } return r; }
    __device__ __forceinline__ void tile8(const Unit&, int row, int col, const f32x4 v0, const f32x4 v1, const Pre& pr) const {
        float a[8]; f4x2_to8(v0, v1, a);
        const int seg = col >> 9, c = col & 511; const unsigned off = (unsigned)row * 512 + c;
        if (seg == 0) { float o[8];
#pragma unroll
            for (int j = 0; j < 8; ++j) { const float e = 0.6065306597126334f * sigm(p[j] + a[j]); o[j] = 1.0f - __expf(-e); }
            *(f16x8*)(dcy + off) = f32_to_f16x8(o); }
        else if (seg == 1) { float k[8], kn[8]; f16x8_to_f32(pr.k, k); f16x8_to_f32(pr.kn, kn); float o1[8], o2[8];
#pragma unroll
            for (int j = 0; j < 8; ++j) { const float ic = sigm(p[j] + a[j]); o1[j] = k[j] * (1.0f + (ic - 1.0f) * ka[j]); o2[j] = kn[j] * ic; }
            *(f16x8*)(kh + off) = f32_to_f16x8(o1); *(f16x8*)(bv + off) = f32_to_f16x8(o2); }
        else { *(v4u*)(gl + off) = pack8(v0, v1); }
    }
};
struct FVres {
    static constexpr int BATCH = 4;
    const float* vb; const bf16* vraw; const bf16* vfirst; f16* vfin; float p[8];
    struct Pre { v4u v, vf; };
    __device__ __forceinline__ void begin_col(const Unit&, int col) { ld8f(vb + col, p); }
    __device__ __forceinline__ Pre pre(const Unit&, int row, int col) const { Pre r; const unsigned off = (unsigned)row * 512 + col; r.v = *(const v4u*)(vraw + off); r.vf = *(const v4u*)(vfirst + off); return r; }
    __device__ __forceinline__ void tile8(const Unit&, int row, int col, const f32x4 v0, const f32x4 v1, const Pre& pr) const {
        float a[8], v[8], vf[8], o[8]; f4x2_to8(v0, v1, a); const unsigned off = (unsigned)row * 512 + col;
        bf16x8_to_f32(pr.v, v); bf16x8_to_f32(pr.vf, vf);
#pragma unroll
        for (int j = 0; j < 8; ++j) o[j] = v[j] + (vf[j] - v[j]) * sigm(p[j] + a[j]);
        *(f16x8*)(vfin + off) = f32_to_f16x8(o);
    }
};
struct FS5End {
    static constexpr int BATCH = 8; float* xend;
    __device__ __forceinline__ void begin_col(const Unit&, int) {}
    typedef pg8::NoPre Pre; __device__ __forceinline__ Pre pre(const Unit&, int, int) const { return Pre{}; }
    __device__ __forceinline__ void tile8(const Unit& u, int row, int col, const f32x4 v0, const f32x4 v1, const Pre&) const {
        if (col < 128) { float* p = xend + (unsigned)((u.z * S5CH + row) * 128 + col); *(f32x4*)p = v0; *(f32x4*)(p + 4) = v1; }
    }
};
struct FS5Main {
    static constexpr int BATCH = 8;
    const bf16* s5u; const float* dvec; bf16* ys5g; float d[8];
    struct Pre { v4u uu; };
    __device__ __forceinline__ void begin_col(const Unit& u, int col) { ld8f(dvec + u.z * 16 + (col & 15), d); }
    __device__ __forceinline__ Pre pre(const Unit& u, int row, int col) const { Pre r; r.uu = *(const v4u*)(s5u + (unsigned)((u.z * S5CH + row) * S5K + col)); return r; }
    __device__ __forceinline__ void tile8(const Unit& u, int row, int col, const f32x4 v0, const f32x4 v1, const Pre& pr) const {
        float a[8], uu[8], o[8]; f4x2_to8(v0, v1, a); const int g = u.z, t = col >> 4, o0 = col & 15;
        bf16x8_to_f32(pr.uu, uu);
#pragma unroll
        for (int j = 0; j < 8; ++j) o[j] = gelu_tanh(a[j] + d[j] * uu[j]);
        *(v4u*)(ys5g + ((unsigned)row * 32 + t) * 512 + g * 16 + o0) = f32_to_bf16x8(o);
    }
};
struct FGlu {
    static constexpr int BATCH = 8;
    const bf16* ys5g; const float* bglu; bf16* ys5; float b[8];
    struct Pre { v4u y; };
    __device__ __forceinline__ void begin_col(const Unit&, int col) { ld8f(bglu + col, b); }
    __device__ __forceinline__ Pre pre(const Unit&, int row, int col) const { Pre r; r.y = *(const v4u*)(ys5g + (unsigned)row * 512 + col); return r; }
    __device__ __forceinline__ void tile8(const Unit&, int row, int col, const f32x4 v0, const f32x4 v1, const Pre& pr) const {
        float a[8], y[8], o[8]; f4x2_to8(v0, v1, a); const unsigned off = (unsigned)row * 512 + col; bf16x8_to_f32(pr.y, y);
#pragma unroll
        for (int j = 0; j < 8; ++j) o[j] = y[j] * sigm(a[j] + b[j]);
        *(v4u*)(ys5 + off) = f32_to_bf16x8(o);
    }
};
struct FGate {
    static constexpr int BATCH = 8; bf16* gbuf;
    __device__ __forceinline__ void begin_col(const Unit&, int) {}
    typedef pg8::NoPre Pre; __device__ __forceinline__ Pre pre(const Unit&, int, int) const { return Pre{}; }
    static constexpr bool PRIV = true;
    __device__ __forceinline__ Pre pre_p(const Unit&, int, int, unsigned) const { return Pre{}; }
    __device__ __forceinline__ void tile8_p(const Unit&, int, int, const f32x4 v0, const f32x4 v1, const Pre&, unsigned poff) const {
        float a[8], o[8]; f4x2_to8(v0, v1, a);
#pragma unroll
        for (int j = 0; j < 8; ++j) o[j] = sigm(a[j]);
        *(v4u*)(gbuf + poff) = f32_to_bf16x8(o);
    }
};
struct FGate2 {
    static constexpr int BATCH = 8; bf16* g0; bf16* g1;
    __device__ __forceinline__ void begin_col(const Unit&, int) {}
    typedef pg8::NoPre Pre; __device__ __forceinline__ Pre pre(const Unit&, int, int) const { return Pre{}; }
    static constexpr bool PRIV = true;
    __device__ __forceinline__ Pre pre_p(const Unit&, int, int, unsigned) const { return Pre{}; }
    __device__ __forceinline__ void tile8_p(const Unit&, int, int col, const f32x4 v0, const f32x4 v1, const Pre&, unsigned poff) const {
        float a[8], o[8]; f4x2_to8(v0, v1, a);
#pragma unroll
        for (int j = 0; j < 8; ++j) o[j] = sigm(a[j]);
        bf16* g = (col < 1024) ? g0 : g1;
        *(v4u*)(g + poff) = f32_to_bf16x8(o);
    }
};
struct FMerge {
    static constexpr int BATCH = 8; const bf16* gbuf; const bf16* min_; bf16* mout; int first, outp;
    struct Pre { v4u g, m; };
    __device__ __forceinline__ void begin_col(const Unit&, int) {}
    static constexpr bool PRIV = true;
    __device__ __forceinline__ Pre pre_p(const Unit&, int, int, unsigned poff) const { Pre r; r.g = *(const v4u*)(gbuf + poff); if (!first) r.m = *(const v4u*)(min_ + poff); else r.m = (v4u){0u, 0u, 0u, 0u}; return r; }
    __device__ __forceinline__ void tile8_p(const Unit&, int row, int col, const f32x4 v0, const f32x4 v1, const Pre& pr, unsigned poff) const {
        float a[8], g[8], mprev[8], o[8]; f4x2_to8(v0, v1, a); bf16x8_to_f32(pr.g, g); bf16x8_to_f32(pr.m, mprev);
#pragma unroll
        for (int j = 0; j < 8; ++j) o[j] = mprev[j] + g[j] * a[j];
        *(v4u*)(mout + (outp ? poff : (unsigned)row * 1024 + col)) = f32_to_bf16x8(o);
    }
};
struct FResid {
    static constexpr int BATCH = 8; const bf16* xin; f16* xout; float sc;
    struct Pre { v4u x; };
    __device__ __forceinline__ void begin_col(const Unit&, int) {}
    __device__ __forceinline__ Pre pre(const Unit&, int row, int col) const { Pre r; r.x = *(const v4u*)(xin + (unsigned)row * 1024 + col); return r; }
    __device__ __forceinline__ void tile8(const Unit&, int row, int col, const f32x4 v0, const f32x4 v1, const Pre& pr) const {
        float x[8], a[8], o[8]; bf16x8_to_f32(pr.x, x); f4x2_to8(v0, v1, a);
#pragma unroll
        for (int j = 0; j < 8; ++j) o[j] = x[j] * ALPHA + a[j] * sc;
        *(f16x8*)(xout + (unsigned)row * 1024 + col) = f32_to_f16x8(o);
    }
};
typedef float f32x2 __attribute__((ext_vector_type(2)));
template <bool O8> struct FSwigluT {
    static constexpr bool WIDE = O8;
    bf16* h; int ldh; float sc;
    __device__ __forceinline__ void act8(const f32x4 g0, const f32x4 g1, const f32x4 u0, const f32x4 u1, float (&o)[8]) const {
        const float c1 = -1.4426950408889634f * sc, c2 = sc * sc * (O8 ? FP8_HSCALE : 1.0f);
#pragma unroll
        for (int j = 0; j < 4; ++j) {
            const f32x2 gg = (j < 2) ? (f32x2){g0[2 * j], g0[2 * j + 1]} : (f32x2){g1[2 * j - 4], g1[2 * j - 3]};
            const f32x2 uu = (j < 2) ? (f32x2){u0[2 * j], u0[2 * j + 1]} : (f32x2){u1[2 * j - 4], u1[2 * j - 3]};
            const f32x2 t = gg * c1; f32x2 d = (f32x2){__builtin_amdgcn_exp2f(t[0]), __builtin_amdgcn_exp2f(t[1])} + 1.0f;
            const f32x2 r = (f32x2){__builtin_amdgcn_rcpf(d[0]), __builtin_amdgcn_rcpf(d[1])};
            const f32x2 p = (gg * uu) * c2 * r; o[2 * j] = p[0]; o[2 * j + 1] = p[1];
        }
    }
    __device__ __forceinline__ void q8(const float (&o)[8], unsigned& q0, unsigned& q1) const { int w0 = 0, w1 = 0;
        w0 = __builtin_amdgcn_cvt_pk_fp8_f32(o[0], o[1], w0, false); w0 = __builtin_amdgcn_cvt_pk_fp8_f32(o[2], o[3], w0, true);
        w1 = __builtin_amdgcn_cvt_pk_fp8_f32(o[4], o[5], w1, false); w1 = __builtin_amdgcn_cvt_pk_fp8_f32(o[6], o[7], w1, true); q0 = (unsigned)w0; q1 = (unsigned)w1; }
    __device__ __forceinline__ void pair8(const Unit&, int row, int colh, const f32x4 g0, const f32x4 g1, const f32x4 u0, const f32x4 u1) const {
        float o[8]; act8(g0, g1, u0, u1, o);
        if constexpr (O8) { v2u q; q8(o, q.x, q.y); *(v2u*)((unsigned char*)h + (size_t)((unsigned)row * ldh + colh)) = q; }
        else *(v4u*)(h + (unsigned)row * ldh + colh) = f32_to_bf16x8(o);
    }
    __device__ __forceinline__ void pair16(const Unit&, int rowA, int colb, int fq, const f32x4 ga0, const f32x4 ga1, const f32x4 ua0, const f32x4 ua1,
                                           const f32x4 gb0, const f32x4 gb1, const f32x4 ub0, const f32x4 ub1) const {
        float o[8]; unsigned a0, a1, b0, b1; act8(ga0, ga1, ua0, ua1, o); q8(o, a0, a1); act8(gb0, gb1, ub0, ub1, o); q8(o, b0, b1);
        { const auto r = __builtin_amdgcn_permlane16_swap(a0, b0, false, false); a0 = r[0]; b0 = r[1]; }
        { const auto r = __builtin_amdgcn_permlane16_swap(a1, b1, false, false); a1 = r[0]; b1 = r[1]; }
        const int row = rowA + ((fq & 1) ? 16 : 0);
        *(v4u*)((unsigned char*)h + (size_t)((unsigned)row * ldh + colb + (fq >> 1) * 16)) = (v4u){a0, a1, b0, b1};
    }
};
typedef FSwigluT<false> FSwiglu;
struct FMoeDown {
    static constexpr int BATCH = 8; bf16* ypair; const float* slotw; const unsigned* cnt; float sc;
    struct Pre { float w; };
    __device__ __forceinline__ void begin_col(const Unit&, int) {}
    __device__ __forceinline__ Pre pre(const Unit& u, int row, int) const { Pre r; const int rk = u.aux + (row - u.pm * 256); r.w = ((unsigned)rk < cnt[u.z]) ? slotw[(unsigned)(u.z * MOE_CAP + rk)] * sc : 0.f; return r; }
    __device__ __forceinline__ void tile8(const Unit& u, int row, int col, const f32x4 v0, const f32x4 v1, const Pre& pr) const {
        const int rk = u.aux + (row - u.pm * 256);
        if ((unsigned)rk < cnt[u.z]) *(v4u*)(ypair + (unsigned)row * 1024 + col) = pack8(v0 * pr.w, v1 * pr.w);
    }
};

struct MoeOrder {
    int nN, G, c; int pt[NEXP + 1];
    __device__ void init(const unsigned* cnt, int nN_, int G_, int c_) { nN = nN_; G = G_; c = c_; pt[0] = 0;
#pragma unroll
        for (int e = 0; e < NEXP; ++e) pt[e + 1] = pt[e] + (int)((cnt[e] + 255u) >> 8); }
    __device__ bool next(int i, Unit& u) const {
        const int nM = pt[NEXP], nwg = nM * nN; const long L = (long)i * G + c; if (L >= (long)nwg) return false;
        int wgid = (int)L; { const int q = nwg / pg8::NXCD, r = nwg % pg8::NXCD, xcd = wgid % pg8::NXCD, off = wgid / pg8::NXCD; wgid = (xcd < r ? xcd * (q + 1) : r * (q + 1) + (xcd - r) * q) + off; }
        const int nig = pg8::WGM * nN, gid = wgid / nig, fm = gid * pg8::WGM, gsz = (nM - fm) < pg8::WGM ? (nM - fm) : pg8::WGM;
        const int tile = fm + ((wgid % nig) % gsz); u.pn = (wgid % nig) / gsz; int e = 0;
#pragma unroll
        for (int k = 1; k < NEXP; ++k) e += (tile >= pt[k]) ? 1 : 0;
        int base = 0;
#pragma unroll
        for (int k = 1; k < NEXP; ++k) base = (tile >= pt[k]) ? pt[k] : base;
        u.z = e; u.pm = tile; u.aux = (tile - base) * 256; return true;
    }
};
constexpr int MT_KS = 7, MT_K = EXD / MT_KS;
static_assert(MT_KS * MT_K == EXD && MT_K % 128 == 0, "tail K-slices");
struct MoeOrderFull {
    int nN, G, c; int pt[NEXP + 1], pf[NEXP + 1];
    __device__ void init(const unsigned* cnt, int nN_, int G_, int c_) { nN = nN_; G = G_; c = c_; pt[0] = 0; pf[0] = 0;
#pragma unroll
        for (int e = 0; e < NEXP; ++e) { pt[e + 1] = pt[e] + (int)((cnt[e] + 255u) >> 8); pf[e + 1] = pf[e] + (int)(cnt[e] >> 8); } }
    __device__ bool next(int i, Unit& u) const {
        const int nM = pf[NEXP], nwg = nM * nN; const long L = (long)i * G + c; if (L >= (long)nwg) return false;
        int wgid = (int)L; { const int q = nwg / pg8::NXCD, r = nwg % pg8::NXCD, xcd = wgid % pg8::NXCD, off = wgid / pg8::NXCD; wgid = (xcd < r ? xcd * (q + 1) : r * (q + 1) + (xcd - r) * q) + off; }
        const int nig = pg8::WGM * nN, gid = wgid / nig, fm = gid * pg8::WGM, gsz = (nM - fm) < pg8::WGM ? (nM - fm) : pg8::WGM;
        const int tile = fm + ((wgid % nig) % gsz); u.pn = (wgid % nig) / gsz; int e = 0;
#pragma unroll
        for (int k = 1; k < NEXP; ++k) e += (tile >= pf[k]) ? 1 : 0;
        int basef = 0, baset = 0;
#pragma unroll
        for (int k = 1; k < NEXP; ++k) { basef = (tile >= pf[k]) ? pf[k] : basef; baset = (tile >= pf[k]) ? pt[k] : baset; }
        u.z = __builtin_amdgcn_readfirstlane(e); u.pm = __builtin_amdgcn_readfirstlane(baset + (tile - basef)); u.aux = __builtin_amdgcn_readfirstlane((tile - basef) * 256); u.pn = __builtin_amdgcn_readfirstlane(u.pn); return true;
    }
};
struct MoeTailOrder {
    int G, c; const unsigned* cnt;
    __device__ void init(const unsigned* cnt_, int G_, int c_) { cnt = cnt_; G = G_; c = c_; }
    __device__ bool next(int i, Unit& u) const {
        const int L = G - 1 - c; if (i > 0 || L >= NEXP * 4 * MT_KS) return false;
        const int e = L / (4 * MT_KS), r = L % (4 * MT_KS); int base = 0;
#pragma unroll
        for (int k = 0; k < NEXP; ++k) base += (k < e) ? (int)((cnt[k] + 255u) >> 8) : 0;
        const unsigned n = cnt[e]; if ((n & 255u) == 0u) return false;
        u.z = e + 8 * (r % MT_KS); u.pn = r / MT_KS; u.pm = base + (int)(n >> 8); u.aux = (int)(n >> 8) * 256; return true;
    }
};
struct LocMoeTail {
    static constexpr bool GATHER = false, FP8 = (FP8_MOED != 0);
    const bf16* A; const bf16* Bt; int lda, ldb, K;
    __device__ __forceinline__ const char* a_ptr(const Unit& u) const { return (const char*)(A + (size_t)u.pm * 256 * lda + (size_t)(u.z >> 3) * K); }
    __device__ __forceinline__ const char* b_ptr(const Unit& u) const { return (const char*)(Bt + (size_t)(u.z & 7) * DM * ldb + (size_t)u.pn * 256 * ldb + (size_t)(u.z >> 3) * K); }
    __device__ __forceinline__ void a_off(const Unit&, int tid, unsigned (&v)[2][2]) const {
#pragma unroll
        for (int i = 0; i < 2; ++i) { int R, C; pg8::stage_rc(tid * 16 + i * 8192, R, C); v[0][i] = (unsigned)(R * lda + C) * 2u; v[1][i] = 0u; }
    }
};
struct FMoeTail {
    static constexpr int BATCH = 8; float* slab; const float* slotw; const unsigned* cnt; float sc;
    struct Pre { float w; };
    __device__ __forceinline__ void begin_col(const Unit&, int) {}
    __device__ __forceinline__ Pre pre(const Unit& u, int row, int) const { Pre r; const int e = u.z & 7; const int rk = u.aux + (row - u.pm * 256); r.w = ((unsigned)rk < cnt[e]) ? slotw[(unsigned)(e * MOE_CAP + rk)] * sc : 0.f; return r; }
    __device__ __forceinline__ void tile8(const Unit& u, int row, int col, const f32x4 v0, const f32x4 v1, const Pre& pr) const {
        const int e = u.z & 7, rl = row - u.pm * 256; const int rk = u.aux + rl;
        if ((unsigned)rk < cnt[e]) { float* p = slab + ((size_t)((u.z >> 3) * NEXP + e) * 256 + rl) * DM + col; *(f32x4*)p = v0 * pr.w; *(f32x4*)(p + 4) = v1 * pr.w; }
    }
};
struct LocMoe1 {
    static constexpr bool GATHER = true, FP8 = (FP8_MOE != 0);
    const bf16* A; const bf16* Bt; int lda, ldb, K; const int* slot_tok; const unsigned* cnt;
    __device__ __forceinline__ const char* a_ptr(const Unit&) const { return (const char*)A; }
    __device__ __forceinline__ const char* b_ptr(const Unit& u) const { return (const char*)(Bt + (size_t)u.z * (2 * EXD) * ldb + (size_t)u.pn * 256 * ldb); }
    __device__ __forceinline__ void a_tok(const Unit& u, int tid, unsigned (&v)[2][2]) const {
        const unsigned n = cnt[u.z];
#pragma unroll
        for (int i = 0; i < 2; ++i) { int R, C; pg8::stage_rc(tid * 16 + i * 8192, R, C);
#pragma unroll
            for (int h = 0; h < 2; ++h) { const int r = u.aux + h * 128 + R; v[h][i] = ((unsigned)r < n) ? (unsigned)slot_tok[(unsigned)(u.z * MOE_CAP + r)] : 0u; } }
    }
    __device__ __forceinline__ void a_fin(int tid, const unsigned (&t)[2][2], unsigned (&v)[2][2]) const {
#pragma unroll
        for (int i = 0; i < 2; ++i) { int R, C; pg8::stage_rc(tid * 16 + i * 8192, R, C);
#pragma unroll
            for (int h = 0; h < 2; ++h) v[h][i] = (t[h][i] * (unsigned)lda + (unsigned)C) * 2u; }
    }
    __device__ __forceinline__ void a_off(const Unit& u, int tid, unsigned (&v)[2][2]) const { unsigned t[2][2]; a_tok(u, tid, t); a_fin(tid, t, v); }
};
__device__ __forceinline__ int qperm_row(int n) { const int h = n / 96, d = n - h * 96; if (d < 64) return n; const int e = d - 64; return h * 96 + 64 + ((e < 16) ? 2 * e : 2 * (e - 16) + 1); }
struct TrDesc { const float* W; const float* ksc; bf16* WT; int ldw, k0, n0, ldd, kdst, drow0, qperm, fp8; };
constexpr float FP8_WSCALE = 32.0f;
struct TrRegs { f32x4 v[8]; };
__device__ __forceinline__ void tr_load(const TrDesc& d, TrRegs& r, int lane) {
    if (d.W) {
#pragma unroll
        for (int i = 0; i < 8; ++i) { const int kk = (lane >> 3) + 8 * i; f32x4 v = *(const f32x4*)(d.W + (size_t)(d.k0 + kk) * d.ldw + d.n0 + 4 * (lane & 7)); if (d.ksc) v = v * d.ksc[d.k0 + kk]; r.v[i] = v; }
    } else {
#pragma unroll
        for (int i = 0; i < 8; ++i) r.v[i] = (f32x4){0.f, 0.f, 0.f, 0.f};
    }
}
__device__ __forceinline__ void tr_finish(const TrDesc& d, const TrRegs& r, LAS float* scr, int lane) {
#pragma unroll
    for (int i = 0; i < 8; ++i) { const int kk = (lane >> 3) + 8 * i; LAS float* s = scr + kk * 33 + 4 * (lane & 7); s[0] = r.v[i][0]; s[1] = r.v[i][1]; s[2] = r.v[i][2]; s[3] = r.v[i][3]; }
    LDS_WAIT(); asm volatile("" ::: "memory");
    const int c = lane & 7;
#pragma unroll
    for (int j = 0; j < 4; ++j) { const int n = (lane >> 3) + 8 * j; const LAS float* s = scr + (8 * c) * 33 + n;
        v4u o; o.x = cvt_pk_bf16(s[0 * 33], s[1 * 33]); o.y = cvt_pk_bf16(s[2 * 33], s[3 * 33]); o.z = cvt_pk_bf16(s[4 * 33], s[5 * 33]); o.w = cvt_pk_bf16(s[6 * 33], s[7 * 33]);
        const int dr = d.qperm ? qperm_row(d.n0 + n) : (d.drow0 + n);
        if (d.fp8) { v2u q; int w0 = 0, w1 = 0;
            w0 = __builtin_amdgcn_cvt_pk_fp8_f32(s[0 * 33] * FP8_WSCALE, s[1 * 33] * FP8_WSCALE, w0, false); w0 = __builtin_amdgcn_cvt_pk_fp8_f32(s[2 * 33] * FP8_WSCALE, s[3 * 33] * FP8_WSCALE, w0, true);
            w1 = __builtin_amdgcn_cvt_pk_fp8_f32(s[4 * 33] * FP8_WSCALE, s[5 * 33] * FP8_WSCALE, w1, false); w1 = __builtin_amdgcn_cvt_pk_fp8_f32(s[6 * 33] * FP8_WSCALE, s[7 * 33] * FP8_WSCALE, w1, true);
            q.x = (unsigned)w0; q.y = (unsigned)w1; *(v2u*)((unsigned char*)d.WT + (size_t)dr * d.ldd + d.kdst + 8 * c) = q; }
        else *(v4u*)(d.WT + (size_t)dr * d.ldd + d.kdst + 8 * c) = o; }
    LDS_WAIT(); asm volatile("" ::: "memory");
}
__device__ __forceinline__ bool trjob(int& r, TrDesc& d, const float* W, int ldw, int K, int c0, int ncols, const float* ksc, bf16* WT, int ldd, int drow0, int fp8 = 0) {
    const int nb = ncols / 32, ni = (K / 64) * nb; if (r < ni) { const int kb = r / nb, nbi = r % nb; d = TrDesc{W, ksc, WT, ldw, 64 * kb, c0 + 32 * nbi, ldd, 64 * kb, drow0 + 32 * nbi, 0, fp8}; return true; } r -= ni; return false; }
__device__ __forceinline__ bool trjob_gu(int& r, TrDesc& d, const float* W, int ldw, int K, int ncols, bf16* WT, int ldd, int up, int fp8 = 0) {
    const int nb = ncols / 32, ni = (K / 64) * nb; if (r < ni) { const int kb = r / nb, n0 = 32 * (r % nb); d = TrDesc{W, nullptr, WT, ldw, 64 * kb, n0, ldd, 64 * kb, (n0 >> 7) * 256 + (n0 & 127) + (up ? 128 : 0), 0, fp8}; return true; } r -= ni; return false; }

constexpr int TR_PER_LAYER = 16 * 189 + 6 * 24 + 4 * 32 + 192 + 8 * 16 + 3 * 8 * 32 + 16 * 32 + 3 * 16;
constexpr int TR_PER_FFN = 3 * 16 * 88, TR_PROLOGUE = NLAYER * TR_PER_LAYER + 2 * TR_PER_FFN;
__device__ __forceinline__ void tr_decode_prologue(Frame& F, int it, TrDesc& d) {
    if (it < NLAYER * TR_PER_LAYER) {
        const int l = it / TR_PER_LAYER; int r = it % TR_PER_LAYER;
        const float* win = INP(float, 2) + (size_t)l * DM * IN_W;
        bf16* win_t = WSP(bf16, WS_WIN) + (size_t)l * 3072 * DM; bf16* wg_t = WSP(bf16, WS_WG) + (size_t)l * 3072 * DM;
        if (trjob(r, d, win, IN_W, DM, 0, 672, nullptr, win_t, DM, 0)) return;
        if (trjob(r, d, win, IN_W, DM, 672, 2304, nullptr, win_t, DM, 768)) return;
        if (trjob(r, d, win, IN_W, DM, 2976, 3072, nullptr, wg_t, DM, 0)) return;
        if (r < 48) { d = TrDesc{nullptr, nullptr, win_t, 0, 64 * (r / 3), 0, DM, 64 * (r / 3), 672 + 32 * (r % 3), 0}; return; } r -= 48;
        if (r < 144) { const int kb = r / 24, nbi = r % 24; d = TrDesc{INP(float, 4) + (size_t)l * 384 * 768, INP(float, 3) + l * 384, WSP(bf16, WS_WUQ) + (size_t)l * 768 * 384, 768, 64 * kb, 32 * nbi, 384, 64 * kb, 0, 1}; return; } r -= 144;
        if (trjob(r, d, INP(float, 6) + (size_t)l * 256 * 1024, 1024, 256, 0, 1024, INP(float, 5) + l * 256, WSP(bf16, WS_WUKV) + (size_t)l * 1024 * 256, 256, 0)) return;
        if (r < 192) { const int rb = r / 4, kb = r % 4; bf16* wl = WSP(bf16, WS_WLORA) + (size_t)l * 1536 * 256; const float* src = nullptr; int k0 = 0, n0 = 0;
            if (rb < 16) { if (kb == 0) { src = INP(float, 9) + (size_t)l * 64 * 512; n0 = 32 * rb; } }
            else if (rb < 32) { if (kb == 1) { src = INP(float, 11) + (size_t)l * 64 * 512; n0 = 32 * (rb - 16); } }
            else { if (kb >= 2) { src = INP(float, 12) + (size_t)l * 128 * 512; k0 = 64 * (kb - 2); n0 = 32 * (rb - 32); } }
            d = TrDesc{src, nullptr, wl, 512, k0, n0, 256, 64 * kb, 32 * rb, 0}; return; } r -= 192;
        if (trjob(r, d, INP(float, 29) + (size_t)l * 512 * 512, 512, 512, 0, 512, nullptr, WSP(bf16, WS_WGLU) + (size_t)l * 512 * 512, 512, 0)) return;
        if (trjob(r, d, INP(float, 31) + (size_t)(l * 3 + 0) * 512 * 1024, 1024, 512, 0, 1024, nullptr, WSP(bf16, WS_WBR) + (size_t)(l * 3 + 0) * 1024 * 512, 512, 0)) return;
        if (trjob(r, d, INP(float, 31) + (size_t)(l * 3 + 1) * 512 * 1024, 1024, 512, 0, 1024, nullptr, WSP(bf16, WS_WBR) + (size_t)(l * 3 + 1) * 1024 * 512, 512, 0)) return;
        if (trjob(r, d, INP(float, 31) + (size_t)(l * 3 + 2) * 512 * 1024, 1024, 512, 0, 1024, nullptr, WSP(bf16, WS_WBR) + (size_t)(l * 3 + 2) * 1024 * 512, 512, 0)) return;
        (void)trjob(r, d, INP(float, 32) + (size_t)l * DM * DM, DM, DM, 0, DM, nullptr, WSP(bf16, WS_WOUT) + (size_t)l * DM * DM, DM, 0);
    } else {
        const int q = it - NLAYER * TR_PER_LAYER, i = q / TR_PER_FFN; int r = q % TR_PER_FFN;
        if (trjob_gu(r, d, INP(float, 37) + (size_t)i * DM * FFN, FFN, DM, FFN, WSP(bf16, WS_WFGU) + (size_t)i * 2 * FFN * DM / (FP8_DENSE ? 2 : 1), DM, 0, FP8_DENSE)) return;
        if (trjob_gu(r, d, INP(float, 38) + (size_t)i * DM * FFN, FFN, DM, FFN, WSP(bf16, WS_WFGU) + (size_t)i * 2 * FFN * DM / (FP8_DENSE ? 2 : 1), DM, 1, FP8_DENSE)) return;
        (void)trjob(r, d, INP(float, 39) + (size_t)i * FFN * DM, DM, FFN, 0, DM, nullptr, WSP(bf16, WS_WFD) + (size_t)i * DM * FFN / (FP8_DD ? 2 : 1), FFN, 0, FP8_DD);
    }
}
constexpr int TR_PER_E = 2 * 16 * 112 + 56 * 32;
__device__ __forceinline__ void tr_decode_moe(Frame& F, int li, int it, TrDesc& d) {
    const int e = it / TR_PER_E; int r = it % TR_PER_E; const size_t wi = (size_t)(li * NEXP + e);
    if (trjob_gu(r, d, INP(float, 41) + wi * DM * EXD, EXD, DM, EXD, WSP(bf16, WS_WMGU) + (size_t)e * 2 * EXD * DM / (FP8_MOE ? 2 : 1), DM, 0, FP8_MOE)) return;
    if (trjob_gu(r, d, INP(float, 42) + wi * DM * EXD, EXD, DM, EXD, WSP(bf16, WS_WMGU) + (size_t)e * 2 * EXD * DM / (FP8_MOE ? 2 : 1), DM, 1, FP8_MOE)) return;
    (void)trjob(r, d, INP(float, 43) + wi * EXD * DM, DM, EXD, 0, DM, nullptr, WSP(bf16, WS_WMD) + (size_t)e * DM * EXD / (FP8_MOED ? 2 : 1), EXD, 0, FP8_MOED);
}

__device__ __forceinline__ void p0_prologue(Frame& F) {
    LAS float* scr = (LAS float*)(F.lds + F.wave * 16384);
    const int lane = F.lane; const int gw = F.blk * NWAVES + F.wave, NGW = F.G * NWAVES;
    { TrDesc dc, dn; TrRegs rc, rn; int it = gw;
      if (it < TR_PROLOGUE) { tr_decode_prologue(F, it, dc); tr_load(dc, rc, lane); }
      for (; it < TR_PROLOGUE; it += NGW) { const bool more = it + NGW < TR_PROLOGUE;
          if (more) { tr_decode_prologue(F, it + NGW, dn); tr_load(dn, rn, lane); }
          tr_finish(dc, rc, scr, lane);
          if (more) { dc = dn; rc = rn; } } }
    for (int it = F.blk * 512 + F.tid; it < 3 * 512 * 64; it += F.G * 512) {
        const int i = it / (512 * 64), rem = it % (512 * 64), n = rem >> 6, k0 = (rem & 63) * 8;
        const float* vd = INP(float, 18) + (size_t)i * 512 * 32; const float* vu = INP(float, 19) + (size_t)i * 32 * 512; float o[8];
#pragma unroll
        for (int j = 0; j < 8; ++j) o[j] = 0.f;
#pragma unroll 8
        for (int rr = 0; rr < 32; ++rr) { const float u = vu[rr * 512 + n];
#pragma unroll
            for (int j = 0; j < 8; ++j) o[j] += vd[(k0 + j) * 32 + rr] * u; }
        *(v4u*)(WSP(bf16, WS_WVRES) + (size_t)i * 512 * 512 + (size_t)n * 512 + k0) = f32_to_bf16x8(o);
    }
    for (int it = F.blk * 512 + F.tid; it < M * 16; it += F.G * 512) {
        const int m = it >> 4, i = it & 15; const float inv = powf(10000.0f, -(float)i * (1.0f / 16.0f)); const float ang = (float)INP(int, 1)[m] * inv;
        float sn, cn; sincosf(ang, &sn, &cn); float* cs = WSP(float, WS_ROPE) + (size_t)m * 32; cs[i] = cn; cs[16 + i] = sn;
    }
}
__device__ __forceinline__ void moe_convert(Frame& F, int li) {
    LAS float* scr = (LAS float*)(F.lds + F.wave * 16384);
    const int lane = F.lane; const int gw = F.blk * NWAVES + F.wave, NGW = F.G * NWAVES;
    TrDesc dc, dn; TrRegs rc, rn; int it = gw;
    if (it < NEXP * TR_PER_E) { tr_decode_moe(F, li, it, dc); tr_load(dc, rc, lane); }
    for (; it < NEXP * TR_PER_E; it += NGW) { const bool more = it + NGW < NEXP * TR_PER_E;
        if (more) { tr_decode_moe(F, li, it + NGW, dn); tr_load(dn, rn, lane); }
        tr_finish(dc, rc, scr, lane);
        if (more) { dc = dn; rc = rn; } }
}

__device__ __forceinline__ void ph2_prep(Frame& F, int l) {
    const int lane = F.lane; const int gw = F.blk * NWAVES + F.wave, NGW = F.G * NWAVES;
    const bf16* rwraw = WSP(bf16, WS_RWRAW); const bf16* mlaraw = WSP(bf16, WS_MLARAW);
    const float* mu = INP(float, 7) + l * 1792; const float* k_k = INP(float, 13) + l * 512;
    float mu_r[8], mu_k[8], mu_v[8], mu_t[8], kk8[8];
    ld8f(mu + 8 * lane, mu_r); ld8f(mu + 512 + 8 * lane, mu_k); ld8f(mu + 1024 + 8 * lane, mu_v); ld8f(mu + 1536 + 8 * (lane & 31), mu_t); ld8f(k_k + 8 * lane, kk8);
    const float* cs_all = WSP(float, WS_ROPE);
    constexpr int TPW = 16;
    const int m0 = gw * TPW;
    v4u n_r, n_k, n_v, n_t, n_a, n_b, p_r, p_k, p_v, p_t;
    { const bf16* cur = rwraw + (size_t)m0 * 1792; n_r = *(const v4u*)(cur + 8 * lane); n_k = *(const v4u*)(cur + 512 + 8 * lane); n_v = *(const v4u*)(cur + 1024 + 8 * lane); n_t = *(const v4u*)(cur + 1536 + 8 * (lane & 31));
      const bf16* mr = mlaraw + (size_t)m0 * 768; n_a = *(const v4u*)(mr + 8 * lane); n_b = *(const v4u*)(mr + 512 + 8 * (lane & 31));
      if (m0 & (SEQ - 1)) { const bf16* prv = cur - 1792; p_r = *(const v4u*)(prv + 8 * lane); p_k = *(const v4u*)(prv + 512 + 8 * lane); p_v = *(const v4u*)(prv + 1024 + 8 * lane); p_t = *(const v4u*)(prv + 1536 + 8 * (lane & 31)); }
      else { p_r = (v4u){0u, 0u, 0u, 0u}; p_k = p_r; p_v = p_r; p_t = p_r; } }
    for (int i = 0; i < TPW; ++i) {
        const int m = m0 + i;
        const v4u c_r = n_r, c_k = n_k, c_v = n_v, c_t = n_t, c_a = n_a, c_b = n_b;
        if (i + 1 < TPW) { const bf16* nx = rwraw + (size_t)(m + 1) * 1792; n_r = *(const v4u*)(nx + 8 * lane); n_k = *(const v4u*)(nx + 512 + 8 * lane); n_v = *(const v4u*)(nx + 1024 + 8 * lane); n_t = *(const v4u*)(nx + 1536 + 8 * (lane & 31));
            const bf16* mr = mlaraw + (size_t)(m + 1) * 768; n_a = *(const v4u*)(mr + 8 * lane); n_b = *(const v4u*)(mr + 512 + 8 * (lane & 31)); }
        float c[8], p[8], o[8];
        bf16x8_to_f32(c_r, c); bf16x8_to_f32(p_r, p);
#pragma unroll
        for (int j = 0; j < 8; ++j) o[j] = c[j] + (p[j] - c[j]) * mu_r[j];
        *(f16x8*)(WSP(f16, WS_R) + (size_t)m * 512 + 8 * lane) = f32_to_f16x8(o);
        bf16x8_to_f32(c_k, c); bf16x8_to_f32(p_k, p);
        float ss = 0.f;
#pragma unroll
        for (int j = 0; j < 8; ++j) { o[j] = c[j] + (p[j] - c[j]) * mu_k[j]; const float q = o[j] * kk8[j]; ss += q * q; }
        *(f16x8*)(WSP(f16, WS_KH) + (size_t)m * 512 + 8 * lane) = f32_to_f16x8(o);
        ss += mk_shfl_xor(ss, 1); ss += mk_shfl_xor(ss, 2); ss += mk_shfl_xor(ss, 4);
        { const float rn = __builtin_amdgcn_rsqf(fmaxf(ss, 1e-24f));
#pragma unroll
          for (int j = 0; j < 8; ++j) o[j] = o[j] * kk8[j] * rn; }
        *(f16x8*)(WSP(f16, WS_KKN) + (size_t)m * 512 + 8 * lane) = f32_to_f16x8(o);
        bf16x8_to_f32(c_v, c); bf16x8_to_f32(p_v, p);
#pragma unroll
        for (int j = 0; j < 8; ++j) o[j] = c[j] + (p[j] - c[j]) * mu_v[j];
        { const v4u vb = f32_to_bf16x8(o); *(v4u*)(WSP(bf16, WS_VRAW) + (size_t)m * 512 + 8 * lane) = vb;
          if (l == 0) { *(v4u*)(WSP(bf16, WS_VFIRST) + (size_t)m * 512 + 8 * lane) = vb; *(f16x8*)(WSP(f16, WS_VFIN) + (size_t)m * 512 + 8 * lane) = f32_to_f16x8(o); } }
        if (lane < 32) {
            bf16x8_to_f32(c_t, c); bf16x8_to_f32(p_t, p);
            const float sc = (lane < 8) ? 2.0f : 1.0f, om = (lane < 8) ? 2.0f : 1.0f, oa = (lane < 8) ? -1.0f : 0.0f; const bool idt = (lane >= 8 && lane < 16);
#pragma unroll
            for (int j = 0; j < 8; ++j) { const float v = c[j] + (p[j] - c[j]) * mu_t[j]; const float sg = sigm(sc * v); o[j] = idt ? v : sg * om + oa; }
            *(v4u*)(WSP(bf16, WS_LORAIN) + (size_t)m * 256 + 8 * lane) = f32_to_bf16x8(o);
        }
        p_r = c_r; p_k = c_k; p_v = c_v; p_t = c_t;
        float a8[8], b8[8];
        bf16x8_to_f32(c_a, a8); float ssa = 0.f, ssb = 0.f;
#pragma unroll
        for (int j = 0; j < 8; ++j) ssa += a8[j] * a8[j];
        if (lane < 32) { bf16x8_to_f32(c_b, b8);
#pragma unroll
            for (int j = 0; j < 8; ++j) ssb += b8[j] * b8[j]; } else {
#pragma unroll
            for (int j = 0; j < 8; ++j) b8[j] = 0.f; }
        const float sq = wave_sum(lane < 48 ? ssa : 0.f), skv = wave_sum((lane >= 48 ? ssa : 0.f) + (lane < 16 ? ssb : 0.f));
        const float rq = __builtin_amdgcn_rsqf(sq * (1.0f / 384.0f) + 1e-6f), rkv = __builtin_amdgcn_rsqf(skv * (1.0f / 256.0f) + 1e-6f);
        { const float rs = (lane < 48) ? rq : rkv;
#pragma unroll
          for (int j = 0; j < 8; ++j) o[j] = a8[j] * rs;
          bf16* dst = (lane < 48) ? WSP(bf16, WS_CQN) + (size_t)m * 384 + 8 * lane : WSP(bf16, WS_CKVN) + (size_t)m * 256 + 8 * (lane - 48);
          *(v4u*)dst = f32_to_bf16x8(o); }
        if (lane < 16) {
#pragma unroll
            for (int j = 0; j < 8; ++j) o[j] = b8[j] * rkv;
            *(v4u*)(WSP(bf16, WS_CKVN) + (size_t)m * 256 + 128 + 8 * lane) = f32_to_bf16x8(o);
        }
        float pr[8];
#pragma unroll
        for (int j = 0; j < 8; ++j) pr[j] = mk_shfl_xor(b8[j], 2);
        v4u w = (v4u){0u, 0u, 0u, 0u};
        if (lane >= 16 && lane < 20) { const int i0 = 8 * (lane & 1); const float* cs = cs_all + (size_t)m * 32; float cc[8], sn[8]; ld8f(cs + i0, cc); ld8f(cs + 16 + i0, sn);
            const bool lo = lane < 18;
#pragma unroll
            for (int j = 0; j < 8; ++j) o[j] = lo ? (b8[j] * cc[j] - pr[j] * sn[j]) : (pr[j] * sn[j] + b8[j] * cc[j]);
            w = f32_to_bf16x8(o); }
        { const int src = 16 + (lane & 3); v4u ww; ww.x = (unsigned)mk_shfl((int)w.x, src); ww.y = (unsigned)mk_shfl((int)w.y, src); ww.z = (unsigned)mk_shfl((int)w.z, src); ww.w = (unsigned)mk_shfl((int)w.w, src);
          if (lane < 4 * NH) { const unsigned bht = (unsigned)((((m >> 12) * NH + (lane >> 2)) * (SEQ / 64)) + ((m & (SEQ - 1)) >> 6));
              *(v4u*)(WSP(bf16, WS_K) + ((bht * 12u + 8u + (unsigned)(lane & 3)) * 64u + (unsigned)(m & 63)) * 8u) = ww; } }
    }
}

__device__ __forceinline__ void s5_gen(Frame& F, int l, int g) {
    {
        __syncthreads();
        const int tid = F.tid;
        LAS float* pw = (LAS float*)F.lds;
        LAS float* Bb = pw + 33 * 64 * 2;
        LAS float* Cc = Bb + 64 * 16 * 2;
        LAS float* Kt = Cc + 16 * 64 * 2;
        const float dt = expf(INP(float, 23)[l * 32 + g]);
        const float* are = INP(float, 21) + (size_t)(l * 32 + g) * 64; const float* aim = INP(float, 22) + (size_t)(l * 32 + g) * 64;
        for (int e = tid; e < 33 * 64; e += 512) { const int n = e >> 6, p = e & 63; const float lr = fminf(are[p], -1e-4f), li = aim[p];
            const float mag = expf((float)n * (dt * lr)); float sn, cn; sincosf((float)n * (dt * li), &sn, &cn); pw[2 * e] = mag * cn; pw[2 * e + 1] = mag * sn; }
        for (int e = tid; e < 64 * 16; e += 512) { const int p = e >> 4; const float lr = fminf(are[p], -1e-4f), li = aim[p];
            const float mag = expf(dt * lr); float sn, cn; sincosf(dt * li, &sn, &cn); const float abr = mag * cn, abi = mag * sn, den = lr * lr + li * li;
            const float fr = ((abr - 1.0f) * lr + abi * li) / den, fi = (abi * lr - (abr - 1.0f) * li) / den;
            const float br = INP(float, 24)[(size_t)(l * 32 + g) * 1024 + e], bi = INP(float, 25)[(size_t)(l * 32 + g) * 1024 + e];
            Bb[2 * e] = fr * br - fi * bi; Bb[2 * e + 1] = fr * bi + fi * br; }
        for (int e = tid; e < 16 * 64; e += 512) { Cc[2 * e] = INP(float, 26)[(size_t)(l * 32 + g) * 1024 + e]; Cc[2 * e + 1] = INP(float, 27)[(size_t)(l * 32 + g) * 1024 + e]; }
        __syncthreads();
        { const int tau = tid >> 4, o = tid & 15; float acc[16];
#pragma unroll
          for (int i = 0; i < 16; ++i) acc[i] = 0.f;
          for (int p = 0; p < 64; ++p) { const float cr = Cc[2 * (o * 64 + p)], ci = Cc[2 * (o * 64 + p) + 1], pr_ = pw[2 * (tau * 64 + p)], pi_ = pw[2 * (tau * 64 + p) + 1];
              const float xr = cr * pr_ - ci * pi_, xi = cr * pi_ + ci * pr_;
#pragma unroll
              for (int i = 0; i < 16; ++i) acc[i] += xr * Bb[2 * (p * 16 + i)] - xi * Bb[2 * (p * 16 + i) + 1]; }
#pragma unroll
          for (int i = 0; i < 16; ++i) Kt[(tau * 16 + o) * 16 + i] = acc[i]; }
        __syncthreads();
        bf16* bm = WSP(bf16, WS_S5MAIN) + ((size_t)l * 32 + g) * 512 * S5K;
        for (int e = tid; e < 512 * 80; e += 512) { const int n = e / 80, k0 = (e % 80) * 8, t = n >> 4, o = n & 15; float v[8];
            if (k0 < 512) { const int sidx = k0 >> 4, i0 = k0 & 15;
#pragma unroll
                for (int j = 0; j < 8; ++j) v[j] = (sidx <= t) ? Kt[((t - sidx) * 16 + o) * 16 + i0 + j] : 0.f; }
            else {
#pragma unroll
                for (int j = 0; j < 8; ++j) { const int q = k0 - 512 + j, p = q & 63; const float cr = Cc[2 * (o * 64 + p)], ci = Cc[2 * (o * 64 + p) + 1], pr_ = pw[2 * ((t + 1) * 64 + p)], pi_ = pw[2 * ((t + 1) * 64 + p) + 1];
                    v[j] = (q < 64) ? (cr * pr_ - ci * pi_) : -(cr * pi_ + ci * pr_); } }
            *(v4u*)(bm + (size_t)n * S5K + k0) = f32_to_bf16x8(v); }
        bf16* be = WSP(bf16, WS_S5END) + ((size_t)l * 32 + g) * 256 * 512;
        for (int e = tid; e < 256 * 64; e += 512) { const int n = e / 64, k0 = (e % 64) * 8, sidx = k0 >> 4, i0 = k0 & 15; float v[8];
            if (n < 128) { const int p = n & 63; const float pr_ = pw[2 * ((31 - sidx) * 64 + p)], pi_ = pw[2 * ((31 - sidx) * 64 + p) + 1];
#pragma unroll
                for (int j = 0; j < 8; ++j) { const float br = Bb[2 * (p * 16 + i0 + j)], bi = Bb[2 * (p * 16 + i0 + j) + 1]; v[j] = (n < 64) ? (pr_ * br - pi_ * bi) : (pr_ * bi + pi_ * br); } }
            else {
#pragma unroll
                for (int j = 0; j < 8; ++j) v[j] = 0.f; }
            *(v4u*)(be + (size_t)n * 512 + k0) = f32_to_bf16x8(v); }
        if (tid < 64) { float* a32 = WSP(float, WS_S5A32) + (size_t)((l * 32 + g) * 64 + tid) * 2; a32[0] = pw[2 * (32 * 64 + tid)]; a32[1] = pw[2 * (32 * 64 + tid) + 1]; }
        __syncthreads();
    }
}

struct LnGB { f32x4 g[4], b[4]; };
__device__ __forceinline__ LnGB ln_gb(const float* gam, const float* bet, int lane) { LnGB r;
#pragma unroll
    for (int j = 0; j < 4; ++j) { r.g[j] = *(const f32x4*)(gam + 4 * lane + 256 * j); r.b[j] = *(const f32x4*)(bet + 4 * lane + 256 * j); }
    return r; }
__device__ __forceinline__ void ln_core(f32x4 (&v)[4], const LnGB& gb) {
    float s = 0.f;
#pragma unroll
    for (int j = 0; j < 4; ++j) s += (v[j][0] + v[j][1]) + (v[j][2] + v[j][3]);
    const float mean = wave_sum(s) * (1.f / DM); float s2 = 0.f;
#pragma unroll
    for (int j = 0; j < 4; ++j) { v[j] = v[j] - mean; s2 += (v[j][0] * v[j][0] + v[j][1] * v[j][1]) + (v[j][2] * v[j][2] + v[j][3] * v[j][3]); }
    const float rstd = __builtin_amdgcn_rsqf(wave_sum(s2) * (1.f / DM) + LN_EPS);
#pragma unroll
    for (int j = 0; j < 4; ++j) v[j] = v[j] * rstd * gb.g[j] + gb.b[j];
}
__device__ __forceinline__ void ln_store(const f32x4 (&v)[4], float* xrow, bf16* xbrow, int lane) {
#pragma unroll
    for (int j = 0; j < 4; ++j) { if (xrow) *(f32x4*)(xrow + 4 * lane + 256 * j) = v[j]; if (xbrow) { v2u w; w.x = cvt_pk_bf16(v[j][0], v[j][1]); w.y = cvt_pk_bf16(v[j][2], v[j][3]); *(v2u*)(xbrow + 4 * lane + 256 * j) = w; } }
}
constexpr int LN_RB = 4;
typedef f16 f16x4_ln __attribute__((ext_vector_type(4)));
__device__ __forceinline__ void ln_phase(Frame& F, const float* gam, const float* bet, unsigned char* xq = nullptr) {
    const int lane = F.lane; const int gw = F.blk * NWAVES + F.wave, NGW = F.G * NWAVES; const f16* X = (const f16*)F.out; bf16* Xb = WSP(bf16, WS_XB);
    const LnGB gb = ln_gb(gam, bet, lane);
    for (int m = gw; m < M; m += LN_RB * NGW) { f16x4_ln h[LN_RB][4];
#pragma unroll
        for (int r = 0; r < LN_RB; ++r) { const int mr = (m + r * NGW < M) ? m + r * NGW : m;
#pragma unroll
            for (int j = 0; j < 4; ++j) h[r][j] = *(const f16x4_ln*)(X + (size_t)mr * DM + 4 * lane + 256 * j); }
#pragma unroll
        for (int r = 0; r < LN_RB; ++r) { const int mr = m + r * NGW; if (mr < M) { f32x4 v[4];
#pragma unroll
            for (int j = 0; j < 4; ++j) v[j] = (f32x4){(float)h[r][j][0], (float)h[r][j][1], (float)h[r][j][2], (float)h[r][j][3]};
            ln_core(v, gb); ln_store(v, nullptr, Xb + (size_t)mr * DM, lane);
            if (xq) {
#pragma unroll
                for (int j = 0; j < 4; ++j) { int w = 0; w = __builtin_amdgcn_cvt_pk_fp8_f32(v[j][0], v[j][1], w, false); w = __builtin_amdgcn_cvt_pk_fp8_f32(v[j][2], v[j][3], w, true);
                    *(int*)(xq + (size_t)mr * DM + 4 * lane + 256 * j) = w; } } } } }
}
__device__ __forceinline__ float* moe_tail_slab(Frame& F, int l) { return (l == NLAYER - 1) ? WSP(float, WS_S5MAIN) : (float*)((unsigned char*)F.out + 64 * MiB); }
__device__ __forceinline__ void ln2_moe_phase(Frame& F, const float* gam, const float* bet, int li, bool last, const float* slab) {
    const int lane = F.lane; const int gw = F.blk * NWAVES + F.wave, NGW = F.G * NWAVES; float* X = F.out; bf16* Xb = WSP(bf16, WS_XB);
    const unsigned* cnt = (const unsigned*)(F.ctl + CW_MOECNT + 64 * li); int pstart[NEXP]; { int acc = 0;
#pragma unroll
        for (int e = 0; e < NEXP; ++e) { pstart[e] = acc; acc += (int)(((cnt[e] + 255u) >> 8) << 8); } }
    const int* ppos = WSP(int, WS_PAIRPOS); const bf16* yp = WSP(bf16, WS_YPAIR);
    const LnGB gb = ln_gb(gam, bet, lane);
    int tailrk[NEXP];
#pragma unroll
    for (int e = 0; e < NEXP; ++e) tailrk[e] = (int)((cnt[e] >> 8) << 8);
    for (int m = gw; m < M; m += LN_RB * NGW) { int pp0[LN_RB], pp1[LN_RB]; bool tl0[LN_RB], tl1[LN_RB]; v2u xw[LN_RB][4], ya[LN_RB][4], yb[LN_RB][4];
#pragma unroll
        for (int r = 0; r < LN_RB; ++r) { tl0[r] = false; tl1[r] = false; }
#pragma unroll
        for (int r = 0; r < LN_RB; ++r) { const int mr = (m + r * NGW < M) ? m + r * NGW : m; pp0[r] = ppos[2 * mr]; pp1[r] = ppos[2 * mr + 1]; }
#pragma unroll
        for (int r = 0; r < LN_RB; ++r) { const int mr = (m + r * NGW < M) ? m + r * NGW : m; const int p0 = pp0[r], p1 = pp1[r]; int r0 = 0, r1 = 0;
#pragma unroll
            for (int e = 0; e < NEXP; ++e) { if ((p0 >> 24) == e) { r0 = pstart[e] + (p0 & 0xffffff); tl0[r] = (p0 & 0xffffff) >= tailrk[e]; } if ((p1 >> 24) == e) { r1 = pstart[e] + (p1 & 0xffffff); tl1[r] = (p1 & 0xffffff) >= tailrk[e]; } }
#pragma unroll
            for (int j = 0; j < 4; ++j) { xw[r][j] = *(const v2u*)(Xb + (size_t)mr * DM + 4 * lane + 256 * j);
                ya[r][j] = tl0[r] ? (v2u){0u, 0u} : *(const v2u*)(yp + (size_t)r0 * DM + 4 * lane + 256 * j); yb[r][j] = tl1[r] ? (v2u){0u, 0u} : *(const v2u*)(yp + (size_t)r1 * DM + 4 * lane + 256 * j); } }
#pragma unroll
        for (int r = 0; r < LN_RB; ++r) { const int mr = m + r * NGW; if (mr < M) { f32x4 v[4];
#pragma unroll
            for (int j = 0; j < 4; ++j) { const v2u x_ = xw[r][j], a = ya[r][j], b = yb[r][j]; const f32x4 x = (f32x4){bf_lo(x_.x), bf_hi(x_.x), bf_lo(x_.y), bf_hi(x_.y)};
                v[j] = x * ALPHA + (f32x4){bf_lo(a.x) + bf_lo(b.x), bf_hi(a.x) + bf_hi(b.x), bf_lo(a.y) + bf_lo(b.y), bf_hi(a.y) + bf_hi(b.y)}; }
            if (tl0[r] || tl1[r]) {
#pragma unroll
                for (int k2 = 0; k2 < 2; ++k2) { const int pk = k2 ? pp1[r] : pp0[r]; const bool tk = k2 ? tl1[r] : tl0[r];
                    if (tk) { const int e = pk >> 24, rl = (pk & 0xffffff) & 255;
#pragma unroll
                        for (int k0 = 0; k0 < MT_KS; k0 += 4) { f32x4 sv[4][4];
#pragma unroll
                            for (int kk = 0; kk < 4; ++kk) if (k0 + kk < MT_KS) { const float* sp = slab + ((size_t)((k0 + kk) * NEXP + e) * 256 + rl) * DM + 4 * lane;
#pragma unroll
                                for (int j = 0; j < 4; ++j) sv[kk][j] = *(const f32x4*)(sp + 256 * j); }
#pragma unroll
                            for (int kk = 0; kk < 4; ++kk) if (k0 + kk < MT_KS) {
#pragma unroll
                                for (int j = 0; j < 4; ++j) v[j] += sv[kk][j]; } } } } }
            ln_core(v, gb); ln_store(v, last ? X + (size_t)mr * DM : nullptr, last ? (bf16*)nullptr : Xb + (size_t)mr * DM, lane); } } }
}
__device__ __forceinline__ void ln1_moe_phase(Frame& F, const float* gam, const float* bet, int li) {
    const int lane = F.lane; float* X = F.out; bf16* Xb = WSP(bf16, WS_XB);
    LAS int* pe = (LAS int*)F.lds;
    LAS float* pwt = (LAS float*)(F.lds + 1024);
    LAS int* cntl = (LAS int*)(F.lds + 2048);
    const float* router = INP(float, 40) + (size_t)li * DM * NEXP;
    const LnGB gb = ln_gb(gam, bet, lane);
    LAS f32x4* rl = (LAS f32x4*)(F.lds + 4096);
    __syncthreads();
    for (int c = F.tid; c < DM; c += NWAVES * 64) { const int j = c >> 8, ln = (c & 255) >> 2, q = c & 3; const f32x4 ra = *(const f32x4*)(router + (size_t)c * NEXP), rb = *(const f32x4*)(router + (size_t)c * NEXP + 4);
        rl[((j * 4 + q) * 2 + 0) * 64 + ln] = ra; rl[((j * 4 + q) * 2 + 1) * 64 + ln] = rb; }
    for (int blk0 = F.blk; blk0 * 128 < M; blk0 += F.G) {
        __syncthreads();
        for (int i0 = 0; i0 < 16; i0 += LN_RB) { f16x4_ln hh[LN_RB][4];
#pragma unroll
          for (int r = 0; r < LN_RB; ++r)
#pragma unroll
            for (int j = 0; j < 4; ++j) hh[r][j] = *(const f16x4_ln*)((const f16*)X + (size_t)(blk0 * 128 + F.wave * 16 + i0 + r) * DM + 4 * lane + 256 * j);
#pragma unroll
          for (int r = 0; r < LN_RB; ++r) { const int i = i0 + r; const int tl = F.wave * 16 + i, m = blk0 * 128 + tl; f32x4 v[4];
#pragma unroll
            for (int j = 0; j < 4; ++j) v[j] = (f32x4){(float)hh[r][j][0], (float)hh[r][j][1], (float)hh[r][j][2], (float)hh[r][j][3]};
            ln_core(v, gb); ln_store(v, nullptr, Xb + (size_t)m * DM, lane);
            if (FP8_MOE) { unsigned char* xq = F.ws + WS_XQM;
#pragma unroll
                for (int j = 0; j < 4; ++j) { int w = 0; w = __builtin_amdgcn_cvt_pk_fp8_f32(v[j][0], v[j][1], w, false); w = __builtin_amdgcn_cvt_pk_fp8_f32(v[j][2], v[j][3], w, true);
                    *(int*)(xq + (size_t)m * DM + 4 * lane + 256 * j) = w; } }
            float lg[NEXP];
#pragma unroll
            for (int e = 0; e < NEXP; ++e) lg[e] = 0.f;
#pragma unroll
            for (int j = 0; j < 4; ++j)
#pragma unroll
                for (int q = 0; q < 4; ++q) { const float xv = v[j][q]; const f32x4 ra = rl[((j * 4 + q) * 2 + 0) * 64 + lane], rb = rl[((j * 4 + q) * 2 + 1) * 64 + lane];
                    lg[0] += xv * ra[0]; lg[1] += xv * ra[1]; lg[2] += xv * ra[2]; lg[3] += xv * ra[3]; lg[4] += xv * rb[0]; lg[5] += xv * rb[1]; lg[6] += xv * rb[2]; lg[7] += xv * rb[3]; }
#pragma unroll
            for (int e = 0; e < NEXP; ++e) lg[e] = wave_sum(lg[e]);
            int e0 = 0; float l0 = lg[0];
#pragma unroll
            for (int e = 1; e < NEXP; ++e) if (lg[e] > l0) { l0 = lg[e]; e0 = e; }
            int e1 = -1; float l1 = -INFINITY;
#pragma unroll
            for (int e = 0; e < NEXP; ++e) if (e != e0 && lg[e] > l1) { l1 = lg[e]; e1 = e; }
            const float w1 = 1.0f / (1.0f + expf(l0 - l1)), w0 = 1.0f - w1;
            if (lane == 0) { pe[2 * tl] = e0; pe[2 * tl + 1] = e1; pwt[2 * tl] = w0; pwt[2 * tl + 1] = w1; }
          } }
        __syncthreads();
        int myrank = 0, mye = 0;
        if (F.tid < 256) { mye = pe[F.tid]; for (int q = 0; q < F.tid; ++q) myrank += (pe[q] == mye) ? 1 : 0; }
        if (F.tid < NEXP) { int c = 0; for (int q = 0; q < 256; ++q) c += (pe[q] == F.tid) ? 1 : 0; cntl[F.tid] = c; cntl[8 + F.tid] = 0;
            (void)__hip_atomic_fetch_add((unsigned*)(F.ctl + CW_MOECNT + 64 * li + F.tid), (unsigned)c, RLX_AGENT);
            __hip_atomic_store((unsigned*)(F.ctl + CW_MOETAB + (li * 256 + blk0) * 8 + F.tid), (unsigned)c | 0x80000000u, RLX_AGENT); }
        __syncthreads();
        for (int t = F.tid; t < blk0 * NEXP; t += NWAVES * 64) { unsigned* w = (unsigned*)(F.ctl + CW_MOETAB + li * 256 * 8 + t); unsigned v = __hip_atomic_load(w, RLX_AGENT); unsigned sp = 0;
            while (!(v >> 31)) { __builtin_amdgcn_s_sleep(1); v = __hip_atomic_load(w, RLX_AGENT); if (++sp > (1u << 22)) break; }
            (void)__hip_atomic_fetch_add((LAS unsigned*)&cntl[8 + (t & 7)], v & 0x7fffffffu, __ATOMIC_RELAXED, __HIP_MEMORY_SCOPE_WORKGROUP); }
        __syncthreads();
        if (F.tid < 256) { const int rk = cntl[8 + mye] + myrank; const int m = blk0 * 128 + (F.tid >> 1);
            WSP(int, WS_SLOTTOK)[(size_t)mye * MOE_CAP + rk] = m; WSP(float, WS_SLOTW)[(size_t)mye * MOE_CAP + rk] = pwt[F.tid]; WSP(int, WS_PAIRPOS)[blk0 * 256 + F.tid] = (mye << 24) | rk; }
    }
    __syncthreads();
}
constexpr int AT_QR = 256;
constexpr int AK_SLOT = 12288, AV_SLOT = 8192;
constexpr int AT_K = 0, AT_V = 4 * AK_SLOT, AT_WSF = AT_V + 3 * AV_SLOT, AT_OST = AT_WSF + NWAVES * 256, AT_LDS = AT_OST + NWAVES * 4096;
typedef LAS const unsigned char* at_lptr;
__device__ __forceinline__ int crow(int r, int hi) { return (r & 3) + 8 * (r >> 2) + 4 * hi; }
__device__ __forceinline__ void at_dma(const void* sbase, unsigned voff, unsigned dst) {
    unsigned keep;
    asm volatile("s_mov_b32 %0, m0\n\ts_mov_b32 m0, %3\n\ts_nop 0\n\tglobal_load_lds_dwordx4 %1, %2\n\ts_mov_b32 m0, %0" : "=&s"(keep) : "v"(voff), "s"(sbase), "s"(dst) : "memory");
}
__device__ __forceinline__ s16x4 at_vtr(at_lptr p) { return __builtin_bit_cast(s16x4, __builtin_amdgcn_ds_read_tr16_b64_v4i16((LAS s16x4*)p)); }
__device__ __forceinline__ void at_kload2(bf16x8* kf, at_lptr kp, int j) { kf[2 * j] = *(const LAS bf16x8*)(kp + j * 2048); kf[2 * j + 1] = *(const LAS bf16x8*)(kp + j * 2048 + 512); }
#define AT_MX3(a, b, c) __builtin_fmaxf(__builtin_fmaxf((a), (b)), (c))
__device__ __forceinline__ float at_rowmax(const f32x16& p0, const f32x16& p1) {
    float a = AT_MX3(p0[0], p0[1], p1[0]), b = AT_MX3(p0[2], p0[3], p1[1]); a = AT_MX3(a, p1[2], p1[3]);
#pragma unroll
    for (int r = 4; r < 16; r += 4) { a = AT_MX3(a, p0[r], p0[r + 1]); b = AT_MX3(b, p0[r + 2], p0[r + 3]); a = AT_MX3(a, p1[r], p1[r + 1]); b = AT_MX3(b, p1[r + 2], p1[r + 3]); }
    const float m = __builtin_fmaxf(a, b); auto rr = __builtin_amdgcn_permlane32_swap(__float_as_uint(m), __float_as_uint(m), false, false);
    return __builtin_fmaxf(__uint_as_float(rr[0]), __uint_as_float(rr[1]));
}
__device__ __forceinline__ void at_cmask(f32x16& p0, f32x16& p1, int jb, int qrel, int hi) {
    const int kb = 64 * jb + 4 * hi;
#pragma unroll
    for (int r = 0; r < 16; ++r) { const int kv = kb + (r & 3) + 8 * (r >> 2); if (kv > qrel) p0[r] = -INFINITY; if (kv + 32 > qrel) p1[r] = -INFINITY; }
}
#define AT_SBAR() __builtin_amdgcn_sched_barrier(0)
#define AT_PIN(x) asm volatile("" : "+v"(x))
#define AT_MFMA(a, b, c) __builtin_amdgcn_mfma_f32_32x32x16_bf16(a, b, c, 0, 0, 0)
#define AT_WAIT_BAR(N) asm volatile("s_waitcnt vmcnt(" #N ") lgkmcnt(0)\n\ts_barrier" ::: "memory")

__device__ __forceinline__ void attn_unit(int tid, int b, int h, int qb, const bf16* Q, const bf16* K, const bf16* V, bf16* O, LAS unsigned char* lds) {
    const int lane = tid & 63, r32 = lane & 31, hi = lane >> 5; const int wid = __builtin_amdgcn_readfirstlane(tid >> 6);
    const size_t rowbase = (size_t)b * SEQ; const int q0 = qb * AT_QR; const int NT = (q0 + AT_QR) / 64;
    const unsigned lds0 = (unsigned)(uintptr_t)lds;
    LAS float* wsf = (LAS float*)(lds + AT_WSF) + wid * 64;
    const size_t bh0 = (size_t)(b * NH + h) * (SEQ / 64);
    const bf16* kbA = K + bh0 * 6144 + wid * 512;
    const bf16* kbB = K + bh0 * 6144 + (8 + (wid & 3)) * 512;
    const bf16* vbs = V + bh0 * 4096 + (wid >> 2) * 2048 + (wid & 3) * 512;
#define AT_LANE() ({ int l_; asm volatile("v_mbcnt_lo_u32_b32 %0, -1, 0\n\tv_mbcnt_hi_u32_b32 %0, -1, %0" : "=v"(l_)); l_; })
#define AT_KVO() ((unsigned)AT_LANE() * 16u)
#define AT_VVO() ((unsigned)AT_LANE() * 16u)
    const unsigned kdA = lds0 + AT_K + wid * 1024, kdB = lds0 + AT_K + (8 + (wid & 3)) * 1024, vds = lds0 + AT_V + wid * 1024;
#define AT_DMA_K(t) do { const unsigned ks_ = (unsigned)((t) & 3) * AK_SLOT; const unsigned kvo_ = AT_KVO(); at_dma(kbA + (size_t)(t) * 6144, kvo_, kdA + ks_); at_dma(kbB + (size_t)(t) * 6144, kvo_, kdB + ks_); } while (0)
#define AT_DMA_V(t, slot) at_dma(vbs + (size_t)(t) * 4096, AT_VVO(), vds + (slot))
    const at_lptr kp0 = (at_lptr)lds + AT_K + hi * 1024 + r32 * 16;
    const at_lptr vp0 = (at_lptr)lds + AT_V + ((lane >> 4) & 1) * 32 + (lane & 3) * 8 + (4 * hi + ((lane & 15) >> 2)) * 64;
    AT_DMA_K(0); AT_DMA_V(0, 0); AT_DMA_K(1);
    bf16x8 qr[6];
    { const bf16* qp = Q + (rowbase + q0 + wid * 32 + r32) * 768 + h * 96 + hi * 8;
#pragma unroll
      for (int d0 = 0; d0 < 6; ++d0) qr[d0] = *(const bf16x8*)(qp + d0 * 16); }
    AT_DMA_K(2);
    float mhat = 0.f, l_reg = 0.f; f32x16 o[2];
#pragma unroll
    for (int r = 0; r < 16; ++r) { o[0][r] = 0.f; o[1][r] = 0.f; }
    const f32x16 zero16 = {0.f, 0.f, 0.f, 0.f, 0.f, 0.f, 0.f, 0.f, 0.f, 0.f, 0.f, 0.f, 0.f, 0.f, 0.f, 0.f};
    f32x16 negm = zero16; AT_PIN(negm);
    const int qrel = wid * 32 + r32; bool resc = false;
    f32x16 pA0, pA1, pB0, pB1; bf16x8 kf[8]; s16x4 vlo[8], vhi[8]; v4u pw0, pw1, pw2, pw3;
    int sl_prev = 0, sl_cur = 0, sl_next = AV_SLOT;
#define AT_ROT() do { sl_prev = sl_cur; sl_cur = sl_next; sl_next = (sl_next == 2 * AV_SLOT) ? 0 : sl_next + AV_SLOT; } while (0)
#define AT_EX(v) __builtin_amdgcn_exp2f(v)
#define AT_RESC() do { if (resc) { const int h_ = AT_LANE() >> 5; _Pragma("unroll") for (int d_ = 0; d_ < 2; ++d_) _Pragma("unroll") for (int r = 0; r < 16; ++r) o[d_][r] *= wsf[crow(r, h_)]; } } while (0)
    AT_WAIT_BAR(2);
    { bf16x8 k0[12];
#pragma unroll
      for (int d0 = 0; d0 < 6; ++d0) at_kload2(k0, kp0, d0);
      pA0 = AT_MFMA(k0[0], qr[0], zero16); pA1 = AT_MFMA(k0[1], qr[0], zero16);
#pragma unroll
      for (int d0 = 1; d0 < 6; ++d0) { pA0 = AT_MFMA(k0[2 * d0], qr[d0], pA0); pA1 = AT_MFMA(k0[2 * d0 + 1], qr[d0], pA1); } }
    if (NT == 4) at_cmask(pA0, pA1, 0, qrel, hi);
    { const float rm = at_rowmax(pA0, pA1); mhat = rm;
#pragma unroll
      for (int r = 0; r < 16; ++r) negm[r] = -mhat;
      AT_PIN(negm);
#pragma unroll
      for (int r = 0; r < 16; ++r) { pA0[r] = AT_EX(pA0[r] - rm); pA1[r] = AT_EX(pA1[r] - rm); } }
    AT_WAIT_BAR(0);
    AT_DMA_K(3); AT_DMA_V(1, AV_SLOT); AT_ROT();
#pragma unroll
    for (int d0 = 0; d0 < 4; ++d0) at_kload2(kf, kp0 + AK_SLOT, d0);
    AT_WAIT_BAR(3);
#define AT_PKW(P, i) cvt_pk_bf16(P[i], P[(i) + 1])
#define AT_PAF(k) __builtin_bit_cast(bf16x8, pw##k)
#define AT_VFR(i) (bf16x8){vlo[i][0], vlo[i][1], vlo[i][2], vlo[i][3], vhi[i][0], vhi[i][1], vhi[i][2], vhi[i][3]}
#define AT_VRD(i) do { vlo[i] = at_vtr(vp_ + (((i) >> 2) * 4096 + ((i) & 3) * 1024)); vhi[i] = at_vtr(vp_ + (((i) >> 2) * 4096 + ((i) & 3) * 1024 + 512)); } while (0)
#define AT_KRD(G, j) do { if (G) { at_kload2(kf, kn_, j); AT_SBAR(); } } while (0)
#define AT_GAP3(MF, a0, a1, a2, W0, W1, PW) do { MF; sacc += a0; sacc += a1; sacc += a2; AT_PIN(sacc); W0; W1; AT_PIN(PW); AT_SBAR(); } while (0)
#define AT_GAP2W(MF, a0, a1, W0, W1, PW) do { MF; sacc += a0; sacc += a1; AT_PIN(sacc); W0; W1; AT_PIN(PW); AT_SBAR(); } while (0)
#define AT_GAP2(MF, a0, a1) do { MF; sacc += a0; sacc += a1; AT_PIN(sacc); AT_SBAR(); } while (0)
#define AT_GAPB(MF, X, i) do { MF; X[i] = AT_EX(X[i]); X[(i) + 1] = AT_EX(X[(i) + 1]); X[(i) + 2] = AT_EX(X[(i) + 2]); X[(i) + 3] = AT_EX(X[(i) + 3]); AT_PIN(X); AT_SBAR(); } while (0)
#define AT_STEP(C0, C1, P0, P1, t, MASK, GK, GV, GL) do { AT_SBAR(); \
    const int ln_ = AT_LANE(), hi_ = ln_ >> 5, r32_ = ln_ & 31; \
    const at_lptr kp_ = (at_lptr)lds + AT_K + hi_ * 1024 + r32_ * 16; const at_lptr vp_ = (at_lptr)lds + AT_V + ((ln_ >> 4) & 1) * 32 + (ln_ & 3) * 8 + (4 * hi_ + ((ln_ & 15) >> 2)) * 64 + sl_prev; \
    const at_lptr kc_ = kp_ + ((t) & 3) * AK_SLOT; const at_lptr kn_ = kp_ + (((t) + 1) & 3) * AK_SLOT; bf16x8 kg[4]; \
    AT_VRD(0); AT_SBAR(); float sacc = P0[0] + P0[1]; \
                       AT_GAP3(C0 = AT_MFMA(kf[0], qr[0], negm), P0[2], P0[3], P0[4],    pw0[0] = AT_PKW(P0, 0),  pw0[1] = AT_PKW(P0, 2),  pw0); \
    AT_VRD(4); AT_SBAR(); AT_GAP3(C1 = AT_MFMA(kf[1], qr[0], negm), P0[5], P0[6], P0[7],    pw0[2] = AT_PKW(P0, 4),  pw0[3] = AT_PKW(P0, 6),  pw0); \
    AT_VRD(1); AT_SBAR(); AT_GAP3(C0 = AT_MFMA(kf[2], qr[1], C0),     P0[8], P0[9], P0[10],   pw1[0] = AT_PKW(P0, 8),  pw1[1] = AT_PKW(P0, 10), pw1); \
    AT_VRD(5); AT_SBAR(); AT_GAP3(C1 = AT_MFMA(kf[3], qr[1], C1),     P0[11], P0[12], P0[13], pw1[2] = AT_PKW(P0, 12), pw1[3] = AT_PKW(P0, 14), pw1); \
    at_kload2(kg, kc_ + 4 * 2048, 0); AT_SBAR();                                                                                \
    AT_VRD(2); AT_SBAR(); AT_GAP3(C0 = AT_MFMA(kf[4], qr[2], C0),     P0[14], P0[15], P1[0],  pw2[0] = AT_PKW(P1, 0),  pw2[1] = AT_PKW(P1, 2),  pw2); \
    at_kload2(kg, kc_ + 4 * 2048, 1); AT_SBAR();                                                                                \
    AT_VRD(6); AT_SBAR(); AT_GAP3(C1 = AT_MFMA(kf[5], qr[2], C1),     P1[1], P1[2], P1[3],    pw2[2] = AT_PKW(P1, 4),  pw2[3] = AT_PKW(P1, 6),  pw2); \
    AT_VRD(3); AT_SBAR(); AT_GAP2W(C0 = AT_MFMA(kf[6], qr[3], C0),    P1[4], P1[5],           pw3[0] = AT_PKW(P1, 8),  pw3[1] = AT_PKW(P1, 10), pw3); \
    AT_VRD(7); AT_SBAR(); AT_GAP2W(C1 = AT_MFMA(kf[7], qr[3], C1),    P1[6], P1[7],           pw3[2] = AT_PKW(P1, 12), pw3[3] = AT_PKW(P1, 14), pw3); \
    AT_GAP2(C0 = AT_MFMA(kg[0], qr[4], C0), P1[8], P1[9]); \
    AT_GAP2(C1 = AT_MFMA(kg[1], qr[4], C1), P1[10], P1[11]); \
    AT_GAP2(C0 = AT_MFMA(kg[2], qr[5], C0), P1[12], P1[13]); \
    AT_GAP2(C1 = AT_MFMA(kg[3], qr[5], C1), P1[14], P1[15]); \
    l_reg += sacc; \
    if (GK) AT_DMA_K((t) + 3); if (GV) AT_DMA_V((t) + 1, sl_next); \
    if (MASK) { const int jb_ = (t) - (NT - 4); if (jb_ >= 0) at_cmask(C0, C1, jb_, wid * 32 + r32_, hi_); } \
    { const float rm = at_rowmax(C0, C1); resc = false;                                                                         \
      if (__builtin_expect(__any(rm > 8.0f), 0)) { const float dl = __builtin_fmaxf(rm, 0.f); mhat += dl;                       \
          _Pragma("unroll") for (int r = 0; r < 16; ++r) { C0[r] -= dl; C1[r] -= dl; } \
          _Pragma("unroll") for (int r = 0; r < 16; ++r) negm[r] = -mhat; \
          AT_PIN(negm); \
          const float f = __builtin_amdgcn_exp2f(-dl); l_reg *= f; if (hi_ == 0) wsf[r32_] = f; resc = true; } } \
    AT_SBAR(); \
    AT_GAPB(o[0] = AT_MFMA(AT_PAF(0), AT_VFR(0), o[0]), C0, 0);               AT_GAPB(o[1] = AT_MFMA(AT_PAF(0), AT_VFR(4), o[1]), C0, 4); \
    AT_KRD(GL, 0); AT_GAPB(o[0] = AT_MFMA(AT_PAF(1), AT_VFR(1), o[0]), C0, 8);  AT_KRD(GL, 1); AT_GAPB(o[1] = AT_MFMA(AT_PAF(1), AT_VFR(5), o[1]), C0, 12); \
    AT_KRD(GL, 2); AT_GAPB(o[0] = AT_MFMA(AT_PAF(2), AT_VFR(2), o[0]), C1, 0);  AT_KRD(GL, 3); AT_GAPB(o[1] = AT_MFMA(AT_PAF(2), AT_VFR(6), o[1]), C1, 4); \
    AT_GAPB(o[0] = AT_MFMA(AT_PAF(3), AT_VFR(3), o[0]), C1, 8);               AT_GAPB(o[1] = AT_MFMA(AT_PAF(3), AT_VFR(7), o[1]), C1, 12); \
    } while (0)
    int t = 1;
    for (; t + 5 < NT; t += 2) {
        AT_STEP(pB0, pB1, pA0, pA1, t, false, true, true, true);     AT_WAIT_BAR(3); AT_RESC(); AT_ROT();
        AT_STEP(pA0, pA1, pB0, pB1, t + 1, false, true, true, true); AT_WAIT_BAR(3); AT_RESC(); AT_ROT();
    }
#define AT_ENDW(tt) do { if ((tt) + 3 < NT) { AT_WAIT_BAR(3); } else if ((tt) + 2 < NT) { AT_WAIT_BAR(1); } else { AT_WAIT_BAR(0); } } while (0)
    for (; t + 1 < NT; t += 2) {
        AT_STEP(pB0, pB1, pA0, pA1, t, true, (t + 3 < NT), (t + 1 < NT), (t + 1 < NT));         AT_ENDW(t);     AT_RESC(); AT_ROT();
        AT_STEP(pA0, pA1, pB0, pB1, t + 1, true, (t + 4 < NT), (t + 2 < NT), (t + 2 < NT));     AT_ENDW(t + 1); AT_RESC(); AT_ROT();
    }
    AT_STEP(pB0, pB1, pA0, pA1, NT - 1, true, false, false, false); AT_RESC();
    { float sacc = pB0[0] + pB0[1];
#pragma unroll
      for (int r = 2; r < 16; ++r) sacc += pB0[r];
#pragma unroll
      for (int r = 0; r < 16; ++r) sacc += pB1[r];
      l_reg += sacc;
      pw0 = (v4u){AT_PKW(pB0, 0), AT_PKW(pB0, 2), AT_PKW(pB0, 4), AT_PKW(pB0, 6)}; pw1 = (v4u){AT_PKW(pB0, 8), AT_PKW(pB0, 10), AT_PKW(pB0, 12), AT_PKW(pB0, 14)};
      pw2 = (v4u){AT_PKW(pB1, 0), AT_PKW(pB1, 2), AT_PKW(pB1, 4), AT_PKW(pB1, 6)}; pw3 = (v4u){AT_PKW(pB1, 8), AT_PKW(pB1, 10), AT_PKW(pB1, 12), AT_PKW(pB1, 14)};
      const int ln_ = AT_LANE(); const at_lptr vp_ = (at_lptr)lds + AT_V + ((ln_ >> 4) & 1) * 32 + (ln_ & 3) * 8 + (4 * (ln_ >> 5) + ((ln_ & 15) >> 2)) * 64 + sl_cur;
#pragma unroll
      for (int i = 0; i < 8; ++i) AT_VRD(i);
      o[0] = AT_MFMA(AT_PAF(0), AT_VFR(0), o[0]); o[1] = AT_MFMA(AT_PAF(0), AT_VFR(4), o[1]); o[0] = AT_MFMA(AT_PAF(1), AT_VFR(1), o[0]); o[1] = AT_MFMA(AT_PAF(1), AT_VFR(5), o[1]);
      o[0] = AT_MFMA(AT_PAF(2), AT_VFR(2), o[0]); o[1] = AT_MFMA(AT_PAF(2), AT_VFR(6), o[1]); o[0] = AT_MFMA(AT_PAF(3), AT_VFR(3), o[0]); o[1] = AT_MFMA(AT_PAF(3), AT_VFR(7), o[1]); }
    { auto rr = __builtin_amdgcn_permlane32_swap(__float_as_uint(l_reg), __float_as_uint(l_reg), false, false); l_reg = __uint_as_float(rr[0]) + __uint_as_float(rr[1]); }
    const int lane_e = AT_LANE(), r32e = lane_e & 31, hie = lane_e >> 5;
    if (hie == 0) wsf[32 + r32e] = l_reg;
    LDS_WAIT();
#pragma unroll
    for (int r = 0; r < 16; ++r) { const int orow = crow(r, hie); const float rl = __builtin_amdgcn_rcpf(wsf[32 + orow]);
#pragma unroll
        for (int d0 = 0; d0 < 2; ++d0) { const unsigned u = cvt_pk_bf16(o[d0][r] * rl, 0.f); ((LAS bf16*)(lds + AT_OST + wid * 4096))[orow * 64 + d0 * 32 + r32e] = (bf16)(u & 0xffffu); } }
    LDS_WAIT();
    { bf16* Ow = O + (rowbase + q0 + wid * 32) * 512 + h * 64;
#pragma unroll
      for (int i = 0; i < 4; ++i) { const int row = i * 8 + (lane_e >> 3), ch = lane_e & 7; const v4u v = *(const LAS v4u*)(lds + AT_OST + wid * 4096 + (row * 64 + ch * 8) * 2); *(v4u*)(Ow + (size_t)row * 512 + ch * 8) = v; } }
    asm volatile("s_waitcnt lgkmcnt(0)\n\ts_barrier" ::: "memory");
#undef AT_DMA_K
#undef AT_KVO
#undef AT_LANE
#undef AT_VVO
#undef AT_DMA_V
#undef AT_ROT
#undef AT_EX
#undef AT_RESC
#undef AT_PKW
#undef AT_PAF
#undef AT_VFR
#undef AT_VRD
#undef AT_KRD
#undef AT_ENDW
#undef AT_GAP3
#undef AT_GAP2W
#undef AT_GAP2
#undef AT_GAPB
#undef AT_STEP
}

template <int CTRL> __device__ __forceinline__ float dpp_add(float v) { return v + __builtin_bit_cast(float, __builtin_amdgcn_update_dpp(0, __builtin_bit_cast(int, v), CTRL, 0xF, 0xF, true)); }
constexpr int RW_TC = 64, RW_STREAM = RW_TC * 64 * 2  , RW_BUF = 6 * RW_STREAM  , RW_YOFF = 2 * RW_BUF  , RW_LDS = RW_YOFF + 2 * RW_STREAM;
constexpr int RW_SPLIT = 2, RW_CW = 4  , RW_ROWS = 64 / RW_SPLIT, RW_RPW = RW_ROWS / RW_CW, RW_LPR = 64 / RW_RPW  , RW_CPL = 64 / RW_LPR  ;
typedef f16 f16xc __attribute__((ext_vector_type(RW_CPL)));
struct RwIn { f16xc r, k, a, b, d; f16 v; };
__device__ __forceinline__ void rw_lds_read(RwIn& x, const LAS unsigned char* buf, int tt, int cg, int row) {
    const LAS unsigned char* p = buf + tt * 128 + cg * (RW_CPL * 2);
    x.r = *(const LAS f16xc*)(p); x.k = *(const LAS f16xc*)(p + RW_STREAM); x.a = *(const LAS f16xc*)(p + 2 * RW_STREAM); x.b = *(const LAS f16xc*)(p + 3 * RW_STREAM); x.d = *(const LAS f16xc*)(p + 4 * RW_STREAM);
    x.v = *(const LAS f16*)(buf + 5 * RW_STREAM + tt * 128 + row * 2);
}
__device__ __forceinline__ void rwkv_scan(Frame& F, int unit) {
    const int bh = unit / RW_SPLIT, part = unit % RW_SPLIT;
    const int tid = F.tid, lane = F.lane, rl = lane / RW_LPR, cg = lane % RW_LPR, b = bh >> 3, h = bh & 7, row = part * RW_ROWS + F.wave * RW_RPW + rl;
    const f16* R = WSP(f16, WS_R); const f16* KH = WSP(f16, WS_KH); const f16* KKN = WSP(f16, WS_KKN); const f16* BV = WSP(f16, WS_BV); const f16* DCY = WSP(f16, WS_DCY); const f16* VF = WSP(f16, WS_VFIN);
    f16* Y = WSP(f16, WS_YRW);
    const size_t base = (size_t)b * SEQ * 512 + h * 64;
    LAS unsigned char* lds = F.lds;
    const int ts = tid >> 3, pc = tid & 7;
    const size_t goff = base + (size_t)ts * 512 + pc * 8;
    const int loff = ts * 128 + pc * 16;
    v4u g[6];
#define RW_GLOAD(t0) do { const size_t o = goff + (size_t)(t0) * 512; const size_t oa = ((t0) + ts + 1 < SEQ) ? o + 512 : o; \
        g[0] = *(const v4u*)(R + o); g[1] = *(const v4u*)(KH + o); g[2] = *(const v4u*)(KKN + oa); g[3] = *(const v4u*)(BV + o); g[4] = *(const v4u*)(DCY + o); g[5] = *(const v4u*)(VF + o); } while (0)
#define RW_LSTORE(bufoff) do { _Pragma("unroll") for (int s_ = 0; s_ < 6; ++s_) *(LAS v4u*)(lds + (bufoff) + s_ * RW_STREAM + loff) = g[s_]; } while (0)
    typedef f16 h2 __attribute__((ext_vector_type(2)));
    h2 S2[RW_CPL / 2];
#pragma unroll
    for (int j = 0; j < RW_CPL / 2; ++j) S2[j] = (h2){(f16)0.f, (f16)0.f};
    float sa = 0.f;
    __syncthreads();
    RW_GLOAD(0); RW_LSTORE(0);
    __syncthreads();
    for (int c = 0; c < SEQ / RW_TC; ++c) {
        const int cur = (c & 1) * RW_BUF, nxt = ((c + 1) & 1) * RW_BUF; const bool more = (c + 1 < SEQ / RW_TC);
        if (more) RW_GLOAD((c + 1) * RW_TC);
        const LAS unsigned char* buf = lds + cur;
        if (F.wave < RW_CW) {
        RwIn x0, x1, x2; rw_lds_read(x0, buf, 0, cg, row); rw_lds_read(x1, buf, 1, cg, row);
        float ykeep = 0.f;
#define RW_STEP(X, TT) do { \
            const h2 sa2 = {(f16)sa, (f16)sa}, v2 = {X.v, X.v}; float yp = 0.f, sp = 0.f; \
            _Pragma("unroll") for (int j = 0; j < RW_CPL / 2; ++j) { const h2 d2 = {X.d[2 * j], X.d[2 * j + 1]}, b2 = {X.b[2 * j], X.b[2 * j + 1]}, k2 = {X.k[2 * j], X.k[2 * j + 1]}, r2 = {X.r[2 * j], X.r[2 * j + 1]}, a2 = {X.a[2 * j], X.a[2 * j + 1]}; \
                h2 sj = S2[j]; sj = __builtin_elementwise_fma(-sj, d2, sj); sj = __builtin_elementwise_fma(sa2, b2, sj); sj = __builtin_elementwise_fma(v2, k2, sj); S2[j] = sj; \
                yp = __builtin_amdgcn_fdot2(sj, r2, yp, false); sp = __builtin_amdgcn_fdot2(sj, a2, sp, false); } \
            yp = dpp_add<0xB1>(yp); sp = dpp_add<0xB1>(sp); \
            yp = dpp_add<0x4E>(yp); sp = dpp_add<0x4E>(sp); \
            if (RW_LPR >= 8) { yp = dpp_add<0x141>(yp); sp = dpp_add<0x141>(sp); } \
            if (RW_LPR >= 16) { yp = dpp_add<0x140>(yp); sp = dpp_add<0x140>(sp); } \
            sa = -sp; ykeep = (cg == ((TT) & 3)) ? yp : ykeep; } while (0)
        for (int tt = 0; tt < RW_TC; tt += 4) {
            rw_lds_read(x2, buf, (tt + 2) & (RW_TC - 1), cg, row); RW_STEP(x0, tt);
            rw_lds_read(x0, buf, (tt + 3) & (RW_TC - 1), cg, row); RW_STEP(x1, tt + 1);
            rw_lds_read(x1, buf, (tt + 4) & (RW_TC - 1), cg, row); RW_STEP(x2, tt + 2);
            rw_lds_read(x2, buf, (tt + 5) & (RW_TC - 1), cg, row); RW_STEP(x0, tt + 3);
            if (cg < 4) *(LAS f16*)(lds + RW_YOFF + (c & 1) * RW_STREAM + (tt + cg) * 128 + row * 2) = (f16)ykeep;
            x0 = x1; x1 = x2;
        }
#undef RW_STEP
        }
        if (more) RW_LSTORE(nxt);
        __syncthreads();
        if (pc >= part * (8 / RW_SPLIT) && pc < (part + 1) * (8 / RW_SPLIT)) { const v4u yv = *(const LAS v4u*)(lds + RW_YOFF + (c & 1) * RW_STREAM + loff); *(v4u*)(Y + base + (size_t)(c * RW_TC + ts) * 512 + pc * 8) = yv; }
    }
    __syncthreads();
#undef RW_GLOAD
#undef RW_LSTORE
}
__device__ __forceinline__ void s5_carry(Frame& F, int l, int idx) {
    const int p = idx & 63, g = (idx >> 6) & 31, b = idx >> 11;
    const float* a32 = WSP(float, WS_S5A32) + (size_t)((l * 32 + g) * 64 + p) * 2; const float ar = a32[0], ai = a32[1];
    const float* xe = WSP(float, WS_XEND) + ((size_t)g * S5CH + b * S5NC) * 128; bf16* u = WSP(bf16, WS_S5U) + ((size_t)g * S5CH + b * S5NC) * S5K + 512;
    float xr = 0.f, xi = 0.f;
    for (int c0 = 0; c0 < S5NC; c0 += 8) { float er[8], ei[8];
#pragma unroll
        for (int c = 0; c < 8; ++c) { er[c] = xe[(size_t)(c0 + c) * 128 + p]; ei[c] = xe[(size_t)(c0 + c) * 128 + 64 + p]; }
#pragma unroll
        for (int c = 0; c < 8; ++c) { bf16* up = u + (size_t)(c0 + c) * S5K; up[p] = (bf16)(cvt_pk_bf16(xr, 0.f) & 0xffffu); up[64 + p] = (bf16)(cvt_pk_bf16(xi, 0.f) & 0xffffu);
            const float nr = ar * xr - ai * xi + er[c], ni = ar * xi + ai * xr + ei[c]; xr = nr; xi = ni; } }
}
__device__ __forceinline__ void rwkv_post(Frame& F, int l) {
    const int lane = F.lane; const int gw = F.blk * NWAVES + F.wave, NGW = F.G * NWAVES;
    float lg[8], lb[8], rk[8]; ld8f(INP(float, 16) + l * 512 + 8 * lane, lg); ld8f(INP(float, 17) + l * 512 + 8 * lane, lb); ld8f(INP(float, 15) + l * 512 + 8 * lane, rk);
    for (int m = gw; m < M; m += NGW) { const size_t off = (size_t)m * 512 + 8 * lane; float y[8], r[8], k[8], v[8], g[8], o[8];
        f16x8_to_f32(*(const f16x8*)(WSP(f16, WS_YRW) + off), y); f16x8_to_f32(*(const f16x8*)(WSP(f16, WS_R) + off), r); f16x8_to_f32(*(const f16x8*)(WSP(f16, WS_KH) + off), k);
        f16x8_to_f32(*(const f16x8*)(WSP(f16, WS_VFIN) + off), v); bf16x8_to_f32(*(const v4u*)(WSP(bf16, WS_GL) + off), g);
        float s = 0.f, bs = 0.f;
#pragma unroll
        for (int j = 0; j < 8; ++j) { s += y[j]; bs += r[j] * k[j] * rk[j]; }
        s += mk_shfl_xor(s, 1); s += mk_shfl_xor(s, 2); s += mk_shfl_xor(s, 4); bs += mk_shfl_xor(bs, 1); bs += mk_shfl_xor(bs, 2); bs += mk_shfl_xor(bs, 4);
        const float mean = s * (1.0f / 64.0f); float q = 0.f;
#pragma unroll
        for (int j = 0; j < 8; ++j) { y[j] -= mean; q += y[j] * y[j]; }
        q += mk_shfl_xor(q, 1); q += mk_shfl_xor(q, 2); q += mk_shfl_xor(q, 4);
        const float rstd = 1.0f / sqrtf(q * (1.0f / 64.0f) + 64e-5f);
#pragma unroll
        for (int j = 0; j < 8; ++j) o[j] = (y[j] * rstd * lg[j] + lb[j] + bs * v[j]) * g[j];
        *(v4u*)(WSP(bf16, WS_YRW) + off) = f32_to_bf16x8(o); }
}
constexpr int PH_PER_LAYER = 12, N_PHASES = 1 + NLAYER * PH_PER_LAYER;
#ifndef MK_PER_PHASE
#define MK_PER_PHASE 0
#endif
constexpr int NR_RWKV = 64 * RW_SPLIT;

__global__ void __launch_bounds__(NWAVES * 64, 2) mk_fwd(Args A) {
    extern __shared__ __attribute__((aligned(16))) unsigned char lds_raw[];
    volatile LAS unsigned* MISC = (volatile LAS unsigned*)((LAS unsigned char*)lds_raw + MISC_OFF);
    for (int u = threadIdx.x; u < (LDS_BYTES - LDSCTL_OFF) / 4; u += NWAVES * 64) ((LAS unsigned*)((LAS unsigned char*)lds_raw + LDSCTL_OFF))[u] = 0u;
    __syncthreads();
    XcdBarrier bar; bar.bar = (unsigned*)(A.ws + WS_CTL) + CW_BAR; bar.x = 0; bar.st = nullptr;
    if (!MK_PER_PHASE) bar = xcd_barrier_post((unsigned*)(A.ws + WS_CTL) + CW_BAR, MISC + 8);
    const int mk_wave0 = __builtin_amdgcn_readfirstlane((int)(threadIdx.x >> 6));
    const int lo = A.ph_lo, hi = A.ph_hi;
#ifndef PHMASK
#define PHMASK 0xFFFF
#endif
#define PHON(k) ((PHMASK >> (k)) & 1)
#define IN(k) (lo <= (k) && (k) < hi)
#define SEAM(k) do { if (IN(k) && IN((k) + 1)) xcd_barrier(bar, MK_TID() == 0); } while (0)
    using pg8::gemm_phase; using pg8::StaticOrder; using pg8::LocDense;

    if (PHON(0) && IN(0)) {
        MKFRAME(F);
        p0_prologue(F);
        for (int it = F.G - 1 - F.blk; it < NLAYER * 32; it += F.G) s5_gen(F, it >> 5, it & 31);
        { const int ns5 = NLAYER * 32; const bool split = F.G > ns5; const int nxb = split ? F.G - ns5 : F.G;
          if (!split || F.blk < nxb) { const int gw = F.blk * NWAVES + F.wave, NGW = nxb * NWAVES;
            for (int m = gw; m < M; m += 4 * NGW) { f32x4 v[4][4];
#pragma unroll
                for (int r = 0; r < 4; ++r) { const int mr = (m + r * NGW < M) ? m + r * NGW : m;
#pragma unroll
                    for (int j = 0; j < 4; ++j) v[r][j] = *(const f32x4*)(INP(float, 0) + (size_t)mr * DM + 4 * F.lane + 256 * j); }
#pragma unroll
                for (int r = 0; r < 4; ++r) { const int mr = m + r * NGW; if (mr < M) {
#pragma unroll
                    for (int j = 0; j < 4; ++j) { v2u w; w.x = cvt_pk_bf16(v[r][j][0], v[r][j][1]); w.y = cvt_pk_bf16(v[r][j][2], v[r][j][3]); *(v2u*)(WSP(bf16, WS_XB) + (size_t)mr * DM + 4 * F.lane + 256 * j) = w; } } } } } }
    }
    SEAM(0);

    for (int l = 0; l < NLAYER; ++l) {
        const int pb = 1 + l * PH_PER_LAYER;
        const bool moe = (l & 1) != 0; const int li = l >> 1;
        if (PHON(1) && IN(pb + 0)) {
            asm volatile("; ==PH1");
            MKFRAME(F);
            LocDense L{WSP(bf16, WS_XB), WSP(bf16, WS_WIN) + (size_t)l * 3072 * DM, DM, DM, DM, 0, 0};
            StaticOrder S; S.init(M, 3072, 1, F.G, F.blk);
            Epi8<FProj> E{{WSP(bf16, WS_MLARAW), WSP(bf16, WS_RWRAW), WSP(bf16, WS_S5U)}};
            gemm_phase(F.tid, F.lds + RING_OFF, L, S, E);
        }
        SEAM(pb + 0);
        if (PHON(2) && IN(pb + 1)) { MKFRAME(F); ph2_prep(F, l); }
        SEAM(pb + 1);
        if (PHON(3) && IN(pb + 2)) {
            asm volatile("; ==PH3");
            MKFRAME(F);
#ifndef P3SEL
#define P3SEL 31
#endif
            if (P3SEL & 1) { LocDense L{WSP(bf16, WS_CQN), WSP(bf16, WS_WUQ) + (size_t)l * 768 * 384, 384, 384, 384, 0, 0}; StaticOrder S; S.init(M, 768, 1, F.G, F.blk);
              Epi8<FQup> E{{WSP(bf16, WS_Q), WSP(float, WS_ROPE), 0.10206207261596575f * 1.4426950408889634f}}; gemm_phase(F.tid, F.lds + RING_OFF, L, S, E); }
            if (P3SEL & 2) { LocDense L{WSP(bf16, WS_CKVN), WSP(bf16, WS_WUKV) + (size_t)l * 1024 * 256, 256, 256, 256, 0, 0}; StaticOrder S; S.init(M, 1024, 1, F.G, F.blk);
              Epi8<FKVup> E{{WSP(bf16, WS_K), WSP(bf16, WS_V)}}; gemm_phase(F.tid, F.lds + RING_OFF, L, S, E); }
            if (P3SEL & 4) { LocDense L{WSP(bf16, WS_LORAIN), WSP(bf16, WS_WLORA) + (size_t)l * 1536 * 256, 256, 256, 256, 0, 0}; StaticOrder S; S.init(M, 1536, 1, F.G, F.blk);
              Epi8<FLora> E{{INP(float, 8) + l * 512, INP(float, 10) + l * 512, INP(float, 14) + l * 512, WSP(f16, WS_DCY), WSP(f16, WS_KH), WSP(f16, WS_KKN), WSP(f16, WS_BV), WSP(bf16, WS_GL), {}, {}}}; gemm_phase(F.tid, F.lds + RING_OFF, L, S, E); }
            if ((P3SEL & 8) && l > 0) { LocDense L{WSP(bf16, WS_VRAW), WSP(bf16, WS_WVRES) + (size_t)(l - 1) * 512 * 512, 512, 512, 512, 0, 0}; StaticOrder S; S.init(M, 512, 1, F.G, F.blk);
              Epi8<FVres> E{{INP(float, 20) + (l - 1) * 512, WSP(bf16, WS_VRAW), WSP(bf16, WS_VFIRST), WSP(f16, WS_VFIN), {}}}; gemm_phase(F.tid, F.lds + RING_OFF, L, S, E); }
            if (P3SEL & 16) { LocDense L{WSP(bf16, WS_S5U), WSP(bf16, WS_S5END) + (size_t)l * 32 * 256 * 512, S5K, 512, 512, (size_t)S5CH * S5K, (size_t)256 * 512}; StaticOrder S; S.init(S5CH, 256, 32, F.G, (F.blk + F.G / 2) % F.G);
              Epi8<FS5End> E{{WSP(float, WS_XEND)}}; gemm_phase(F.tid, F.lds + RING_OFF, L, S, E); }
        }
        SEAM(pb + 2);
        if (PHON(4) && IN(pb + 3)) {
            asm volatile("; ==PH4");
            MKFRAME(F);
#ifndef RW_REP
#define RW_REP 1
#endif
            if (F.blk < NR_RWKV && F.G > NR_RWKV) { for (int rr = 0; rr < RW_REP; ++rr) for (int un = F.blk; un < NBATCH * NH * RW_SPLIT; un += NR_RWKV) rwkv_scan(F, un); }
            else { const int ab = F.blk - NR_RWKV, na = F.G - NR_RWKV; for (int idx = ab * 512 + F.tid; idx < NBATCH * 32 * 64; idx += na * 512) s5_carry(F, l, idx); }
#ifndef ATT_REP
#define ATT_REP 1
#endif
            for (int rep = 0; rep < ATT_REP; ++rep) {
                LAS int* slot = (LAS int*)(F.lds + AT_LDS);
                for (;;) {
                    __syncthreads();
                    if (F.tid == 0) *slot = (int)__hip_atomic_fetch_add((unsigned*)(F.ctl + CW_ATTN + 64 * l + 16 * rep), 1u, RLX_AGENT);
                    __syncthreads();
                    const int n = __builtin_amdgcn_readfirstlane(*slot); if (n >= NBATCH * NH * (SEQ / AT_QR)) break;
                    const int qb = (SEQ / AT_QR - 1) - (n >> 6), bh = n & 63;
                    attn_unit(F.tid, bh >> 3, bh & 7, qb, WSP(bf16, WS_Q), WSP(bf16, WS_K), WSP(bf16, WS_V), WSP(bf16, WS_YMLA), F.lds);
                }
            }
        }
        SEAM(pb + 3);
        if (PHON(5) && IN(pb + 4)) {
            asm volatile("; ==PH5");
            MKFRAME(F);
            { LocDense L{WSP(bf16, WS_S5U), WSP(bf16, WS_S5MAIN) + (size_t)l * 32 * 512 * S5K, S5K, S5K, S5K, (size_t)S5CH * S5K, (size_t)512 * S5K}; StaticOrder S; S.init(S5CH, 512, 32, F.G, F.blk);
              Epi8<FS5Main> E{{WSP(bf16, WS_S5U), INP(float, 28) + l * 512, WSP(bf16, WS_YS5G), {}}}; gemm_phase(F.tid, F.lds + RING_OFF, L, S, E); }
            rwkv_post(F, l);
        }
        SEAM(pb + 4);
        if (PHON(6) && IN(pb + 5)) {
            asm volatile("; ==PH6");
            MKFRAME(F);
            { LocDense L{WSP(bf16, WS_YS5G), WSP(bf16, WS_WGLU) + (size_t)l * 512 * 512, 512, 512, 512, 0, 0}; StaticOrder S; S.init(M, 512, 1, F.G, F.blk);
              Epi8<FGlu> E{{WSP(bf16, WS_YS5G), INP(float, 30) + l * 512, WSP(bf16, WS_YS5), {}}}; gemm_phase(F.tid, F.lds + RING_OFF, L, S, E); }
            { LocDense L{WSP(bf16, WS_XB), WSP(bf16, WS_WG) + ((size_t)l * 3 + 0) * 1024 * DM, DM, DM, DM, 0, 0}; StaticOrder S; S.init(M, 2048, 1, F.G, F.blk);
              Epi8<FGate2> E{{WSP(bf16, WS_GBUF), WSP(bf16, WS_GBUF2)}}; gemm_phase(F.tid, F.lds + RING_OFF, L, S, E); }
            { LocDense L{WSP(bf16, WS_YMLA), WSP(bf16, WS_WBR) + ((size_t)l * 3 + 0) * 1024 * 512, 512, 512, 512, 0, 0}; StaticOrder S; S.init(M, 1024, 1, F.G, F.blk);
              Epi8<FMerge> E{{WSP(bf16, WS_GBUF), WSP(bf16, WS_MIXED2), WSP(bf16, WS_MIXED), 1, 1}}; gemm_phase(F.tid, F.lds + RING_OFF, L, S, E); }
            { LocDense L{WSP(bf16, WS_YRW), WSP(bf16, WS_WBR) + ((size_t)l * 3 + 1) * 1024 * 512, 512, 512, 512, 0, 0}; StaticOrder S; S.init(M, 1024, 1, F.G, F.blk);
              Epi8<FMerge> E{{WSP(bf16, WS_GBUF2), WSP(bf16, WS_MIXED), WSP(bf16, WS_MIXED2), 0, 1}}; gemm_phase(F.tid, F.lds + RING_OFF, L, S, E); }
        }
        SEAM(pb + 5);
        if (PHON(7) && IN(pb + 6)) {
            asm volatile("; ==PH7");
            MKFRAME(F);
            { LocDense L{WSP(bf16, WS_XB), WSP(bf16, WS_WG) + ((size_t)l * 3 + 2) * 1024 * DM, DM, DM, DM, 0, 0}; StaticOrder S; S.init(M, 1024, 1, F.G, F.blk);
              Epi8<FGate> E{{WSP(bf16, WS_GBUF)}}; gemm_phase(F.tid, F.lds + RING_OFF, L, S, E); }
            { LocDense L{WSP(bf16, WS_YS5), WSP(bf16, WS_WBR) + ((size_t)l * 3 + 2) * 1024 * 512, 512, 512, 512, 0, 0}; StaticOrder S; S.init(M, 1024, 1, F.G, F.blk);
              Epi8<FMerge> E{{WSP(bf16, WS_GBUF), WSP(bf16, WS_MIXED2), WSP(bf16, WS_MIXED), 0, 0}}; gemm_phase(F.tid, F.lds + RING_OFF, L, S, E); }
        }
        SEAM(pb + 6);
        if (PHON(8) && IN(pb + 7)) {
            asm volatile("; ==PH8");
            MKFRAME(F);
            LocDense L{WSP(bf16, WS_MIXED), WSP(bf16, WS_WOUT) + (size_t)l * DM * DM, DM, DM, DM, 0, 0}; StaticOrder S; S.init(M, DM, 1, F.G, F.blk);
            Epi8<FResid> E{{WSP(bf16, WS_XB), (f16*)F.out, 1.0f}}; gemm_phase(F.tid, F.lds + RING_OFF, L, S, E);
        }
        SEAM(pb + 7);
        if (PHON(9) && IN(pb + 8)) {
            asm volatile("; ==PH9");
            MKFRAME(F);
            if (moe) { ln1_moe_phase(F, INP(float, 33) + l * DM, INP(float, 34) + l * DM, li); moe_convert(F, li); }
            else ln_phase(F, INP(float, 33) + l * DM, INP(float, 34) + l * DM, FP8_DENSE ? WSP(unsigned char, WS_R) : (unsigned char*)nullptr);
        }
        SEAM(pb + 8);
        if (PHON(10) && IN(pb + 9)) {
            asm volatile("; ==PH10");
            MKFRAME(F);
            if (moe) {
                const unsigned* cnt = (const unsigned*)(F.ctl + CW_MOECNT + 64 * li);
                LocMoe1 L{FP8_MOE ? WSP(bf16, WS_XQM) : WSP(bf16, WS_XB), WSP(bf16, WS_WMGU), FP8_MOE ? DM / 2 : DM, FP8_MOE ? DM / 2 : DM, FP8_MOE ? DM / 2 : DM, WSP(int, WS_SLOTTOK), cnt}; MoeOrder S; S.init(cnt, 2 * EXD / 256, F.G, F.blk);
                EpiGU<FSwigluT<(FP8_MOED != 0)>> E{{WSP(bf16, WS_HM), EXD, FP8_MOE ? 1.0f / FP8_WSCALE : 1.0f}}; gemm_phase(F.tid, F.lds + RING_OFF, L, S, E);
            } else {
#if FP8_DENSE
                pg8::LocDense8 L{WSP(bf16, WS_R), WSP(bf16, WS_WFGU) + (size_t)li * FFN * DM, DM / 2, DM / 2, DM / 2, 0, 0}; StaticOrder S; S.init(M, 2 * FFN, 1, F.G, F.blk);
                EpiGU<FSwiglu> E{{WSP(bf16, WS_HB), FFN, 1.0f / FP8_WSCALE}}; gemm_phase(F.tid, F.lds + RING_OFF, L, S, E);
#else
                LocDense L{WSP(bf16, WS_XB), WSP(bf16, WS_WFGU) + (size_t)li * 2 * FFN * DM, DM, DM, DM, 0, 0}; StaticOrder S; S.init(M, 2 * FFN, 1, F.G, F.blk);
                EpiGU<FSwigluT<(FP8_DD != 0)>> E{{WSP(bf16, WS_HB), FFN, 1.0f}}; gemm_phase(F.tid, F.lds + RING_OFF, L, S, E);
#endif
            }
        }
        SEAM(pb + 9);
        if (PHON(11) && IN(pb + 10)) {
            asm volatile("; ==PH11");
            MKFRAME(F);
            if (moe) {
                const unsigned* cnt = (const unsigned*)(F.ctl + CW_MOECNT + 64 * li);
                constexpr int F8D = FP8_MOED ? 2 : 1; const float dsc = FP8_MOED ? 1.0f / (FP8_WSCALE * FP8_HSCALE) : 1.0f;
#if FP8_MOED
                { pg8::LocDense8 L{WSP(bf16, WS_HM), WSP(bf16, WS_WMD), EXD / 2, EXD / 2, EXD / 2, 0, (size_t)DM * EXD / 2}; MoeOrderFull S; S.init(cnt, DM / 256, F.G, F.blk);
#else
                { LocDense L{WSP(bf16, WS_HM), WSP(bf16, WS_WMD), EXD, EXD, EXD, 0, (size_t)DM * EXD}; MoeOrderFull S; S.init(cnt, DM / 256, F.G, F.blk);
#endif
                  Epi8<FMoeDown> E{{WSP(bf16, WS_YPAIR), WSP(float, WS_SLOTW), cnt, dsc}}; gemm_phase(MK_TID(), F.lds + RING_OFF, L, S, E); }
                { LocMoeTail L{WSP(bf16, WS_HM), WSP(bf16, WS_WMD), EXD / F8D, EXD / F8D, MT_K / F8D}; MoeTailOrder S; S.init(cnt, F.G, F.blk);
                  Epi8<FMoeTail> E{{moe_tail_slab(F, l), WSP(float, WS_SLOTW), cnt, dsc}}; gemm_phase(MK_TID(), F.lds + RING_OFF, L, S, E); }
            } else {
#if FP8_DD
                pg8::LocDense8 L{WSP(bf16, WS_HB), WSP(bf16, WS_WFD) + (size_t)li * DM * FFN / 2, FFN / 2, FFN / 2, FFN / 2, 0, 0}; StaticOrder S; S.init(M, DM, 1, F.G, F.blk);
                Epi8<FResid> E{{WSP(bf16, WS_XB), (f16*)F.out, 1.0f / (FP8_WSCALE * FP8_HSCALE)}}; gemm_phase(MK_TID(), F.lds + RING_OFF, L, S, E);
#else
                LocDense L{WSP(bf16, WS_HB), WSP(bf16, WS_WFD) + (size_t)li * DM * FFN, FFN, FFN, FFN, 0, 0}; StaticOrder S; S.init(M, DM, 1, F.G, F.blk);
                Epi8<FResid> E{{WSP(bf16, WS_XB), (f16*)F.out, 1.0f}}; gemm_phase(MK_TID(), F.lds + RING_OFF, L, S, E);
#endif
            }
        }
        SEAM(pb + 10);
        if (PHON(12) && IN(pb + 11)) {
            asm volatile("; ==PH12");
            MKFRAME(F);
            if (moe) ln2_moe_phase(F, INP(float, 35) + l * DM, INP(float, 36) + l * DM, li, l == NLAYER - 1, moe_tail_slab(F, l));
            else ln_phase(F, INP(float, 35) + l * DM, INP(float, 36) + l * DM);
        }
        SEAM(pb + 11);
    }
#undef IN
#undef SEAM
}

extern "C" void kernel_launch(void* const* d_in, const int* in_sizes, int n_in, void* d_out, int out_size, void* d_ws, size_t ws_size, hipStream_t stream) {
    static int grid = 0;
    if (grid == 0) {
        if (n_in != 44 || out_size != M * DM || ws_size < WS_END) { fprintf(stderr, "kernel_launch: unexpected problem (n_in %d, out %d, ws %zu < %zu)\n", n_in, out_size, ws_size, (size_t)WS_END); grid = -1; return; }
        int dev = 0, cus = 0, per_cu = 0;
        if (hipGetDevice(&dev) != hipSuccess || hipDeviceGetAttribute(&cus, hipDeviceAttributeMultiprocessorCount, dev) != hipSuccess) { grid = -1; return; }
        if (hipFuncSetAttribute((const void*)mk_fwd, hipFuncAttributeMaxDynamicSharedMemorySize, LDS_BYTES) != hipSuccess) { fprintf(stderr, "kernel_launch: hipFuncSetAttribute failed\n"); grid = -1; return; }
        if (hipOccupancyMaxActiveBlocksPerMultiprocessor(&per_cu, (const void*)mk_fwd, NWAVES * 64, LDS_BYTES) != hipSuccess || per_cu < 1) { fprintf(stderr, "kernel_launch: occupancy query says %d blocks per CU\n", per_cu); }
        (void)hipGetLastError();
        grid = cus;
        if (grid != 256) fprintf(stderr, "kernel_launch: %d CUs (built for 256)\n", grid);
    }
    if (grid < 0) return;
    (void)in_sizes;
    if (hipMemsetAsync((char*)d_ws + WS_CTL, 0, CTL_ZERO_BYTES, stream) != hipSuccess) return;
    Args a{};
    for (int i = 0; i < 44; ++i) a.in[i] = d_in[i];
    a.out = (float*)d_out; a.ws = (unsigned char*)d_ws; a.pad = 0;
#if MK_PER_PHASE
    for (int p = 0; p < N_PHASES; ++p) { a.ph_lo = p; a.ph_hi = p + 1; a.li = p; hipLaunchKernelGGL(mk_fwd, dim3(grid), dim3(NWAVES * 64), LDS_BYTES, stream, a); }
#else
    a.ph_lo = 0; a.ph_hi = N_PHASES; a.li = 0;
    hipLaunchKernelGGL(mk_fwd, dim3(grid), dim3(NWAVES * 64), LDS_BYTES, stream, a);
#endif
}
```

```cpp
#include <hip/hip_runtime.h>
#include <cstdio>
#include <cstdint>
#include <cmath>
namespace pg8 {
#define PG8_LAS __attribute__((address_space(3)))
typedef unsigned short bf16_t;
typedef short bf16x8 __attribute__((ext_vector_type(8)));
typedef float f32x4 __attribute__((ext_vector_type(4)));
typedef float f32x2 __attribute__((ext_vector_type(2)));
typedef unsigned u32x4 __attribute__((ext_vector_type(4)));
typedef unsigned u32x2 __attribute__((ext_vector_type(2)));
constexpr int BM = 256, BK = 64, HALF = 128, HTB = HALF * BK * 2  , STAGE_BYTES = 8 * HTB, NXCD = 8, WGM = 8;

__host__ __device__ __forceinline__ int lds_byte(int r, int c) { const int st = (r >> 4) * 2 + (c >> 5), rr = r & 15, cc = c & 31, ob = rr * 64 + cc * 2; return st * 1024 + (ob ^ (((ob >> 9) & 1) << 5)); }
__host__ __device__ __forceinline__ void stage_rc(int b, int& R, int& C) { const int st = b / 1024, sb = b % 1024, swz = sb ^ (((sb >> 9) & 1) << 5); R = (st >> 1) * 16 + swz / 64; C = (st & 1) * 32 + (swz % 64) / 2; }
__host__ __device__ __forceinline__ int perm32(int rho) { const int n = rho >> 4, i = rho & 15; return 8 * (i >> 2) + 4 * n + (i & 3); }

struct Unit { int pm, pn, z, aux; };

typedef int v8i32 __attribute__((ext_vector_type(8)));
struct LocDense {
    static constexpr bool GATHER = false, FP8 = false;
    const bf16_t* A; const bf16_t* Bt; int lda, ldb, K; size_t zA, zB;
    __device__ __forceinline__ const char* a_ptr(const Unit& u) const { return (const char*)(A + (size_t)u.z * zA + (size_t)u.pm * BM * lda); }
    __device__ __forceinline__ const char* b_ptr(const Unit& u) const { return (const char*)(Bt + (size_t)u.z * zB + (size_t)u.pn * BM * ldb); }
    __device__ __forceinline__ void a_off(const Unit&, int tid, unsigned (&v)[2][2]) const {
#pragma unroll
        for (int i = 0; i < 2; ++i) { int R, C; stage_rc(tid * 16 + i * 8192, R, C); v[0][i] = (unsigned)(R * lda + C) * 2u; v[1][i] = 0u; }
    }
};

struct LocDense8 {
    static constexpr bool GATHER = false, FP8 = true;
    const bf16_t* A; const bf16_t* Bt; int lda, ldb, K; size_t zA, zB;
    __device__ __forceinline__ const char* a_ptr(const Unit& u) const { return (const char*)(A + (size_t)u.z * zA + (size_t)u.pm * BM * lda); }
    __device__ __forceinline__ const char* b_ptr(const Unit& u) const { return (const char*)(Bt + (size_t)u.z * zB + (size_t)u.pn * BM * ldb); }
    __device__ __forceinline__ void a_off(const Unit&, int tid, unsigned (&v)[2][2]) const {
#pragma unroll
        for (int i = 0; i < 2; ++i) { int R, C; stage_rc(tid * 16 + i * 8192, R, C); v[0][i] = (unsigned)(R * lda + C) * 2u; v[1][i] = 0u; }
    }
};

struct StaticOrder {
    int nM, nN, nwg, nZ, G, c;
    __device__ void init(int M, int N, int Z, int G_, int c_) { nM = M / BM; nN = N / BM; nwg = nM * nN; nZ = Z; G = G_; c = c_; }
    __device__ bool next(int i, Unit& u) const {
        const long L = (long)i * G + c; if (L >= (long)nwg * nZ) return false;
        u.z = (int)(L / nwg); u.aux = 0;
        int wgid = (int)(L % nwg); { const int q = nwg / NXCD, r = nwg % NXCD, xcd = wgid % NXCD, off = wgid / NXCD; wgid = (xcd < r ? xcd * (q + 1) : r * (q + 1) + (xcd - r) * q) + off; }
        const int nig = WGM * nN, gid = wgid / nig, fm = gid * WGM, gsz = (nM - fm) < WGM ? (nM - fm) : WGM;
        u.pm = fm + ((wgid % nig) % gsz); u.pn = (wgid % nig) / gsz; return true;
    }
};

typedef float f32x2_cv __attribute__((ext_vector_type(2))); typedef __bf16 bf16x2_cv __attribute__((ext_vector_type(2)));
__device__ __forceinline__ unsigned cvt_pk_bf16(float lo, float hi) { const f32x2_cv v = {lo, hi}; const bf16x2_cv b = __builtin_convertvector(v, bf16x2_cv); return __builtin_bit_cast(unsigned, b); }
__device__ __forceinline__ u32x4 pack8(const f32x4 v0, const f32x4 v1) { u32x4 w; w.x = cvt_pk_bf16(v0[0], v0[1]); w.y = cvt_pk_bf16(v0[2], v0[3]); w.z = cvt_pk_bf16(v1[0], v1[1]); w.w = cvt_pk_bf16(v1[2], v1[3]); return w; }
__device__ __forceinline__ float bf_lo(unsigned w) { return __uint_as_float(w << 16); }
__device__ __forceinline__ float bf_hi(unsigned w) { return __uint_as_float(w & 0xffff0000u); }
__device__ __forceinline__ void unpack8(const u32x4 w, f32x4& v0, f32x4& v1) { v0 = (f32x4){bf_lo(w.x), bf_hi(w.x), bf_lo(w.y), bf_hi(w.y)}; v1 = (f32x4){bf_lo(w.z), bf_hi(w.z), bf_lo(w.w), bf_hi(w.w)}; }

struct NoPre {};
template <class F, class = void> struct is_priv { static constexpr bool value = false; };
template <class F> struct is_priv<F, decltype((void)F::PRIV)> { static constexpr bool value = F::PRIV; };
template <class F> struct Epi8 {
    static constexpr bool PERM = true;
    F f;
    __device__ __forceinline__ void operator()(const f32x4 (&acc)[2][2][4][2], const Unit& u, int wr, int wc, int fr, int fq) const {
        const int row0 = u.pm * BM + wr * 64 + fr, col0 = u.pn * BM + wc * 32 + 8 * fq;
        F g = f;
        if constexpr (is_priv<F>::value) {
            const unsigned pbase = (unsigned)((u.pm * 4 + (u.pn & 3)) * 65536 + (wr * 4 + wc) * 8192 + (fq * 16 + fr) * 8);
#pragma unroll
            for (int bj = 0; bj < 2; ++bj) { const int col = col0 + bj * HALF;
#pragma unroll
                for (int b0 = 0; b0 < 8; b0 += F::BATCH) { typename F::Pre pr[F::BATCH];
#pragma unroll
                    for (int i = 0; i < F::BATCH; ++i) { const int q = b0 + i; pr[i] = g.pre_p(u, row0 + (q >> 2) * HALF + (q & 3) * 16, col, pbase + (unsigned)((bj * 8 + q) * 512)); }
#pragma unroll
                    for (int i = 0; i < F::BATCH; ++i) { const int q = b0 + i; g.tile8_p(u, row0 + (q >> 2) * HALF + (q & 3) * 16, col, acc[q >> 2][bj][q & 3][0], acc[q >> 2][bj][q & 3][1], pr[i], pbase + (unsigned)((bj * 8 + q) * 512)); }
                    asm volatile("" ::: "memory"); } }
        } else {
#pragma unroll
        for (int bj = 0; bj < 2; ++bj) { const int col = col0 + bj * HALF; g.begin_col(u, col);
#pragma unroll
            for (int b0 = 0; b0 < 8; b0 += F::BATCH) { typename F::Pre pr[F::BATCH];
#pragma unroll
                for (int i = 0; i < F::BATCH; ++i) { const int q = b0 + i; pr[i] = g.pre(u, row0 + (q >> 2) * HALF + (q & 3) * 16, col); }
#pragma unroll
                for (int i = 0; i < F::BATCH; ++i) { const int q = b0 + i; g.tile8(u, row0 + (q >> 2) * HALF + (q & 3) * 16, col, acc[q >> 2][bj][q & 3][0], acc[q >> 2][bj][q & 3][1], pr[i]); }
                asm volatile("" ::: "memory"); } }
        }
    }
};
template <class F> struct EpiGU {
    static constexpr bool PERM = true;
    F f;
    __device__ __forceinline__ void operator()(const f32x4 (&acc)[2][2][4][2], const Unit& u, int wr, int wc, int fr, int fq) const {
        const int row0 = u.pm * BM + wr * 64 + fr, colh = u.pn * HALF + wc * 32 + 8 * fq;
        if constexpr (F::WIDE) {
#pragma unroll
            for (int ai = 0; ai < 2; ++ai)
#pragma unroll
                for (int m = 0; m < 4; m += 2) { f.pair16(u, row0 + ai * HALF + m * 16, colh - 8 * fq, fq, acc[ai][0][m][0], acc[ai][0][m][1], acc[ai][1][m][0], acc[ai][1][m][1],
                                                          acc[ai][0][m + 1][0], acc[ai][0][m + 1][1], acc[ai][1][m + 1][0], acc[ai][1][m + 1][1]); asm volatile("" ::: "memory"); }
        } else {
#pragma unroll
            for (int ai = 0; ai < 2; ++ai)
#pragma unroll
                for (int m = 0; m < 4; ++m) { f.pair8(u, row0 + ai * HALF + m * 16, colh, acc[ai][0][m][0], acc[ai][0][m][1], acc[ai][1][m][0], acc[ai][1][m][1]); asm volatile("" ::: "memory"); }
        }
    }
};

template <bool F8> struct FragSel { typedef bf16x8 T; static constexpr int NK = 2; };
template <> struct FragSel<true> { typedef v8i32 T; static constexpr int NK = 1; };
__device__ __forceinline__ f32x4 pg8_mfma(const bf16x8 a, const bf16x8 b, const f32x4 c) { return __builtin_amdgcn_mfma_f32_16x16x32_bf16(a, b, c, 0, 0, 0); }
__device__ __forceinline__ f32x4 pg8_mfma(const v8i32 a, const v8i32 b, const f32x4 c) { return __builtin_amdgcn_mfma_scale_f32_16x16x128_f8f6f4(a, b, c, 0, 0, 0, 0x7f7f7f7f, 0, 0x7f7f7f7f); }
__device__ __forceinline__ void pg8_dma(const void* sbase, unsigned voff, unsigned ldsaddr) {
    unsigned keep; const unsigned long long b_ = (unsigned long long)sbase;
    const unsigned long long sb_ = ((unsigned long long)(unsigned)__builtin_amdgcn_readfirstlane((int)(b_ >> 32)) << 32) | (unsigned)__builtin_amdgcn_readfirstlane((int)(unsigned)b_);
    const unsigned la_ = (unsigned)__builtin_amdgcn_readfirstlane((int)ldsaddr);
    asm volatile("s_mov_b32 %0, m0\n\ts_mov_b32 m0, %3\n\ts_nop 0\n\tglobal_load_lds_dwordx4 %1, %2\n\ts_mov_b32 m0, %0" : "=&s"(keep) : "v"(voff), "s"(sb_), "s"(la_) : "memory");
}
template <class Epi, class Sched, class Loc>
__device__ __forceinline__ void gemm_phase(int tid_in, PG8_LAS unsigned char* lds, const Loc& L, const Sched& S, const Epi& E) {
    int tid_ = tid_in; asm volatile("" : "+v"(tid_));
    const int tid = tid_, wid = __builtin_amdgcn_readfirstlane(tid >> 6), lane = tid & 63, wr = wid >> 2, wc = wid & 3, fr = lane & 15, fq = lane >> 4;
    const int K = L.K, nt = K / BK;
    unsigned voffB[2];
#pragma unroll
    for (int i = 0; i < 2; ++i) { int R, C; stage_rc(tid * 16 + i * 8192, R, C); const int Rb = Epi::PERM ? ((R & ~31) + perm32(R & 31)) : R;
        voffB[i] = (unsigned)(Rb * L.ldb + C) * 2u; }
    const size_t kstep = (size_t)(BK * 2);
    const size_t hstepB = (size_t)HALF * L.ldb * 2;
    const unsigned lds0 = (unsigned)(uintptr_t)lds;
    const unsigned ldsw = (unsigned)wid * 1024u;
    const int aoff = Loc::FP8 ? lds_byte(wr * 64 + fr, (fq >> 1) * 32 + (fq & 1) * 16) : lds_byte(wr * 64 + fr, fq * 8);
    const int boff = Loc::FP8 ? lds_byte(wc * 32 + fr, (fq >> 1) * 32 + (fq & 1) * 16) : lds_byte(wc * 32 + fr, fq * 8);
#define PG8_SA(b, h) (((b) * 2 + (h)) * HTB)
#define PG8_SB(b, h) ((4 + (b) * 2 + (h)) * HTB)
#define PG8_STAGE(bufoff, gbase, voff) do { _Pragma("unroll") for (int _i = 0; _i < 2; ++_i) { \
        pg8_dma((const void*)(gbase), (voff)[_i], lds0 + (unsigned)((bufoff) + _i * 8192) + ldsw); } } while (0)
#define PG8_LDA(dst, b, h) do { if constexpr (Loc::FP8) { _Pragma("unroll") for (int m = 0; m < 4; ++m) dst[m][0] = *(const PG8_LAS FragT*)(lds + PG8_SA(b, h) + aoff + m * 2048); } \
        else { _Pragma("unroll") for (int m = 0; m < 4; ++m) _Pragma("unroll") for (int k = 0; k < 2; ++k) dst[m][k] = *(const PG8_LAS FragT*)(lds + PG8_SA(b, h) + aoff + m * 2048 + k * 1024); } } while (0)
#define PG8_LDB(dst, b, h) do { if constexpr (Loc::FP8) { _Pragma("unroll") for (int n = 0; n < 2; ++n) dst[n][0] = *(const PG8_LAS FragT*)(lds + PG8_SB(b, h) + boff + n * 2048); } \
        else { _Pragma("unroll") for (int n = 0; n < 2; ++n) _Pragma("unroll") for (int k = 0; k < 2; ++k) dst[n][k] = *(const PG8_LAS FragT*)(lds + PG8_SB(b, h) + boff + n * 2048 + k * 1024); } } while (0)
#define PG8_MMA(ai, bj, At, Bt) do { __builtin_amdgcn_s_setprio(1); _Pragma("unroll") for (int m = 0; m < 4; ++m) _Pragma("unroll") for (int n = 0; n < 2; ++n) _Pragma("unroll") for (int k = 0; k < NKF; ++k) \
            acc[ai][bj][m][n] = pg8_mfma(Bt[n][k], At[m][k], acc[ai][bj][m][n]); __builtin_amdgcn_s_setprio(0); } while (0)
#define PG8_WAIT_V(n) asm volatile("s_waitcnt vmcnt(" #n ")" ::: "memory")
#define PG8_WAIT_L(n) asm volatile("s_waitcnt lgkmcnt(" #n ")" ::: "memory")
#define PG8_BAR __builtin_amdgcn_s_barrier()
#define PG8_SCHED __builtin_amdgcn_sched_barrier(0)
    Unit cur, nxt; int ui = 0;
    if (!S.next(0, cur)) return;
    f32x4 acc[2][2][4][2];
#pragma unroll
    for (int a = 0; a < 2; ++a)
#pragma unroll
        for (int b = 0; b < 2; ++b)
#pragma unroll
            for (int m = 0; m < 4; ++m)
#pragma unroll
                for (int n = 0; n < 2; ++n) acc[a][b][m][n] = (f32x4){0.f, 0.f, 0.f, 0.f};
    typedef typename FragSel<Loc::FP8>::T FragT; constexpr int NKF = FragSel<Loc::FP8>::NK;
    FragT At[4][NKF], B0[2][NKF], B1[2][NKF];
    constexpr int NVH = Loc::GATHER ? 2 : 1;
    unsigned vc[2][2], vn[NVH][2];
    L.a_off(cur, tid, vc);
    if constexpr (Loc::GATHER) {
#pragma unroll
        for (int h = 0; h < 2; ++h)
#pragma unroll
            for (int i = 0; i < 2; ++i) vn[h][i] = vc[h][i];
    }
    const size_t hstepA = Loc::GATHER ? 0 : (size_t)HALF * L.lda * 2;
    const char* cA = L.a_ptr(cur); const char* cB = L.b_ptr(cur);
    PG8_STAGE(PG8_SB(0, 0), cB, voffB); PG8_STAGE(PG8_SB(0, 1), cB + hstepB, voffB); PG8_STAGE(PG8_SA(0, 0), cA, vc[0]); PG8_STAGE(PG8_SA(0, 1), cA + hstepA, vc[NVH - 1]);
    if (wr == 1) PG8_BAR;
    PG8_WAIT_V(2); PG8_BAR;
    PG8_STAGE(PG8_SB(1, 0), cB + kstep, voffB); PG8_STAGE(PG8_SA(1, 0), cA + kstep, vc[0]); PG8_STAGE(PG8_SB(1, 1), cB + hstepB + kstep, voffB);
    PG8_WAIT_V(6); PG8_BAR;
    for (;;) {
        const bool has_next = S.next(ui + 1, nxt);
        const char* nA = has_next ? L.a_ptr(nxt) : cA; const char* nB = has_next ? L.b_ptr(nxt) : cB;
        if constexpr (Loc::GATHER) { if (has_next) L.a_tok(nxt, tid, vn); }
        for (int t = 0; t < nt; t += 2) {
            const bool last = (t == nt - 2);
            const char* a1 = cA + (size_t)(t + 1) * kstep;
            const char* a2 = last ? nA : cA + (size_t)(t + 2) * kstep; const char* b2 = last ? nB : cB + (size_t)(t + 2) * kstep;
            const char* a3 = a2 + kstep; const char* b3 = b2 + kstep;
            PG8_LDB(B0, 0, 0); PG8_LDB(B1, 0, 1); PG8_SCHED; PG8_LDA(At, 0, 0); PG8_STAGE(PG8_SA(1, 1), a1 + hstepA, vc[NVH - 1]);
            if constexpr (Loc::GATHER) { if (last && has_next) L.a_fin(tid, vn, vc); }
            PG8_WAIT_V(8); PG8_WAIT_L(0); PG8_BAR; PG8_MMA(0, 0, At, B0); PG8_MMA(0, 1, At, B1); PG8_BAR; PG8_SCHED;
            PG8_LDA(At, 0, 1); PG8_STAGE(PG8_SB(0, 0), b2, voffB); PG8_STAGE(PG8_SB(0, 1), b2 + hstepB, voffB); PG8_STAGE(PG8_SA(0, 0), a2, vc[0]);
            PG8_WAIT_V(8); PG8_WAIT_L(0); PG8_BAR; PG8_MMA(1, 0, At, B0); PG8_MMA(1, 1, At, B1); PG8_BAR; PG8_SCHED;
            PG8_LDB(B0, 1, 0); PG8_LDB(B1, 1, 1); PG8_SCHED; PG8_LDA(At, 1, 0); PG8_STAGE(PG8_SA(0, 1), a2 + hstepA, vc[NVH - 1]);
            PG8_WAIT_V(8); PG8_WAIT_L(0); PG8_BAR; PG8_MMA(0, 0, At, B0); PG8_MMA(0, 1, At, B1); PG8_BAR; PG8_SCHED;
            PG8_LDA(At, 1, 1); PG8_STAGE(PG8_SB(1, 0), b3, voffB); PG8_STAGE(PG8_SB(1, 1), b3 + hstepB, voffB); PG8_STAGE(PG8_SA(1, 0), a3, vc[0]);
            PG8_WAIT_V(8); PG8_WAIT_L(0); PG8_BAR; PG8_MMA(1, 0, At, B0); PG8_MMA(1, 1, At, B1); PG8_BAR; PG8_SCHED;
        }
        if (wr == 0) PG8_BAR;
        { int ln_e; asm volatile("v_mbcnt_lo_u32_b32 %0, -1, 0\n\tv_mbcnt_hi_u32_b32 %0, -1, %0" : "=v"(ln_e)); const int fr_e = ln_e & 15, fq_e = ln_e >> 4; int wr_e = wr, wc_e = wc; asm volatile("" : "+s"(wr_e), "+s"(wc_e));
          E(acc, cur, wr_e, wc_e, fr_e, fq_e); }
        if (!has_next) break;
#pragma unroll
        for (int a = 0; a < 2; ++a)
#pragma unroll
            for (int b = 0; b < 2; ++b)
#pragma unroll
                for (int m = 0; m < 4; ++m)
#pragma unroll
                    for (int n = 0; n < 2; ++n) { f32x2 z0, z1; asm volatile("v_mov_b64 %0, 0" : "=v"(z0)); asm volatile("v_mov_b64 %0, 0" : "=v"(z1)); acc[a][b][m][n] = (f32x4){z0[0], z0[1], z1[0], z1[1]}; }
        cur = nxt; cA = nA; cB = nB; ++ui;
        if (wr == 1) PG8_BAR;
    }
    PG8_WAIT_V(0);
    PG8_BAR;
#undef PG8_SA
#undef PG8_SB
#undef PG8_STAGE
#undef PG8_LDA
#undef PG8_LDB
#undef PG8_MMA
#undef PG8_WAIT_V
#undef PG8_WAIT_L
#undef PG8_BAR
#undef PG8_SCHED
}
}
constexpr int NWAVES = 8;
constexpr int M = 32768, DM = 1024, SEQ = 4096, NBATCH = 8, NLAYER = 4;
constexpr int NH = 8;
constexpr int IN_W = 6048;
constexpr int FFN = 2816, EXD = 3584, NEXP = 8;
constexpr float LN_EPS = 1e-5f, ALPHA = 1.681792830507429f;
constexpr int S5T = 32, S5CH = M / S5T  , S5K = 640, S5NC = SEQ / S5T  ;
constexpr int MOE_CAP = 65536;
#ifndef FP8_DENSE
#define FP8_DENSE 0
#endif
#ifndef FP8_MOE
#define FP8_MOE 1
#define FP8_DD 1
#define FP8_MOED 1
constexpr float FP8_HSCALE = 2.0f;
#endif
constexpr int MOE_ROWS = 65536 + 8 * 256;

constexpr size_t MiB = 1u << 20;
constexpr size_t WS_CTL = 0, CTL_ZERO_BYTES = 1 * MiB;
constexpr size_t WS_WIN = 1 * MiB;
constexpr size_t WS_WG = 25 * MiB;
constexpr size_t WS_WUQ = 49 * MiB;
constexpr size_t WS_WUKV = 52 * MiB;
constexpr size_t WS_WLORA = 54 * MiB;
constexpr size_t WS_WVRES = 57 * MiB;
constexpr size_t WS_WGLU = 59 * MiB;
constexpr size_t WS_WBR = 61 * MiB;
constexpr size_t WS_WOUT = 73 * MiB;
constexpr size_t WS_WFGU = 81 * MiB;
constexpr size_t WS_WFD = 103 * MiB;
constexpr size_t WS_S5MAIN = 898 * MiB;
constexpr size_t WS_S5END = 978 * MiB;
constexpr size_t WS_S5A32 = 1010 * MiB;
constexpr size_t WS_ROPE = 143 * MiB;
constexpr size_t WS_XB = 147 * MiB;
constexpr size_t WS_VFIRST = 211 * MiB;
constexpr size_t RB = 243 * MiB;
constexpr size_t WS_S5U = RB + 0;
constexpr size_t WS_S1 = RB + 40 * MiB;
constexpr size_t WS_MLARAW = WS_S1;
constexpr size_t WS_RWRAW = WS_S1 + 48 * MiB;
constexpr size_t WS_Q = WS_S1;
constexpr size_t WS_V = WS_S1 + 48 * MiB;
constexpr size_t WS_BV = WS_S1 + 80 * MiB;
constexpr size_t WS_DCY = WS_S1 + 112 * MiB;
constexpr size_t WS_YS5G = WS_S1;
constexpr size_t WS_YS5 = WS_S1 + 32 * MiB;
constexpr size_t WS_MIXED = WS_S1 + 64 * MiB;
constexpr size_t WS_R = RB + 200 * MiB;
constexpr size_t WS_KH = RB + 232 * MiB;
constexpr size_t WS_KKN = RB + 264 * MiB;
constexpr size_t WS_GL = RB + 296 * MiB;
constexpr size_t WS_GBUF = RB + 264 * MiB;
constexpr size_t WS_VFIN = RB + 328 * MiB;
constexpr size_t WS_K = RB + 360 * MiB;
constexpr size_t WS_VRAW = RB + 408 * MiB;
constexpr size_t WS_YRW = WS_VRAW;
constexpr size_t WS_S2 = RB + 440 * MiB;
constexpr size_t WS_CQN = WS_S2;
constexpr size_t WS_CKVN = WS_S2 + 24 * MiB;
constexpr size_t WS_LORAIN = WS_S2 + 40 * MiB;
constexpr size_t WS_YMLA = WS_S2;
constexpr size_t WS_XEND = RB + 496 * MiB;
constexpr size_t WS_GBUF2 = RB + 512 * MiB;
constexpr size_t WS_MIXED2 = RB + 576 * MiB;
constexpr size_t WS_HB = RB + 0;
constexpr size_t WS_WMGU = RB + 0;
constexpr size_t WS_YPAIR = RB + 0;
constexpr size_t WS_XQM = RB + 56 * MiB;
constexpr size_t WS_HM = RB + 132 * MiB;
constexpr size_t WS_WMD = RB + 594 * MiB;
constexpr size_t WS_SLOTTOK = RB + 650 * MiB;
constexpr size_t WS_SLOTW = RB + 652 * MiB;
constexpr size_t WS_PAIRPOS = RB + 654 * MiB;
constexpr size_t WS_END = 1011 * MiB;
constexpr int CW_BAR = 4096;
constexpr int CW_ATTN = 200000;
constexpr int CW_MOECNT = 201024;
constexpr int CW_MOETAB = 210000;

constexpr int RING_OFF = 0, RING_BYTES = 131072;
constexpr int LDSCTL_OFF = RING_BYTES, MISC_OFF = LDSCTL_OFF + 320;
constexpr int LDS_BYTES = 147456;

#define GAS __attribute__((address_space(1)))
#define LAS __attribute__((address_space(3)))
typedef unsigned short bf16;
typedef _Float16 f16;
typedef f16 f16x8 __attribute__((ext_vector_type(8)));
typedef unsigned v4u __attribute__((ext_vector_type(4)));
typedef unsigned v2u __attribute__((ext_vector_type(2)));
typedef float f32x4 __attribute__((ext_vector_type(4)));
typedef float f32x16 __attribute__((ext_vector_type(16)));
typedef short bf16x8 __attribute__((ext_vector_type(8)));
typedef short s16x4 __attribute__((ext_vector_type(4)));
typedef GAS unsigned gu32;
#define RLX_AGENT __ATOMIC_RELAXED, __HIP_MEMORY_SCOPE_AGENT
#define LDS_WAIT() asm volatile("s_waitcnt lgkmcnt(0)" ::: "memory")
using pg8::cvt_pk_bf16; using pg8::pack8; using pg8::unpack8; using pg8::bf_lo; using pg8::bf_hi;

__device__ __forceinline__ float sigm(float x) { return __builtin_amdgcn_rcpf(1.0f + __expf(-x)); }
__device__ __forceinline__ float gelu_tanh(float y) { const float u = 0.7978845608028654f * (y + 0.044715f * y * y * y); const float t = 1.0f - 2.0f * __builtin_amdgcn_rcpf(__expf(2.0f * u) + 1.0f); return 0.5f * y * (1.0f + t); }
__device__ __forceinline__ int mk_lane() { int l; asm volatile("v_mbcnt_lo_u32_b32 %0, -1, 0\n\tv_mbcnt_hi_u32_b32 %0, -1, %0" : "=v"(l)); return l; }
__device__ __forceinline__ float mk_shfl_xor(float v, int m) { return __builtin_bit_cast(float, __builtin_amdgcn_ds_bpermute((mk_lane() ^ m) << 2, __builtin_bit_cast(int, v))); }
__device__ __forceinline__ int mk_shfl(int v, int src) { return __builtin_amdgcn_ds_bpermute(src << 2, v); }
__device__ __forceinline__ float wave_sum(float v) {
    const int l = mk_lane();
#pragma unroll
    for (int o = 1; o < 64; o <<= 1) v += __builtin_bit_cast(float, __builtin_amdgcn_ds_bpermute((l ^ o) << 2, __builtin_bit_cast(int, v)));
    return v;
}
__device__ __forceinline__ v4u ld_nt16(const void* p) { return __builtin_nontemporal_load((const v4u*)p); }
__device__ __forceinline__ void f16x8_to_f32(const f16x8 h, float (&o)[8]) {
#pragma unroll
    for (int j = 0; j < 8; ++j) o[j] = (float)h[j];
}
__device__ __forceinline__ f16x8 f32_to_f16x8(const float (&v)[8]) { f16x8 h;
#pragma unroll
    for (int j = 0; j < 8; ++j) h[j] = (f16)v[j];
    return h; }
__device__ __forceinline__ void bf16x8_to_f32(const v4u w, float (&o)[8]) { o[0] = bf_lo(w.x); o[1] = bf_hi(w.x); o[2] = bf_lo(w.y); o[3] = bf_hi(w.y); o[4] = bf_lo(w.z); o[5] = bf_hi(w.z); o[6] = bf_lo(w.w); o[7] = bf_hi(w.w); }
__device__ __forceinline__ v4u f32_to_bf16x8(const float (&v)[8]) { v4u w; w.x = cvt_pk_bf16(v[0], v[1]); w.y = cvt_pk_bf16(v[2], v[3]); w.z = cvt_pk_bf16(v[4], v[5]); w.w = cvt_pk_bf16(v[6], v[7]); return w; }
__device__ __forceinline__ void ld8f(const float* p, float (&o)[8]) { const f32x4 a = *(const f32x4*)p, b = *(const f32x4*)(p + 4); o[0] = a[0]; o[1] = a[1]; o[2] = a[2]; o[3] = a[3]; o[4] = b[0]; o[5] = b[1]; o[6] = b[2]; o[7] = b[3]; }

#define XB_TMO      128
#define XB_XCNT(j)  (256  + 64 * (j))
#define XB_XSUB(j)  (1280 + 64 * (j))
#define XB_XGEN(j)  (2304 + 64 * (j))
#define XB_TOP      3328
#define XB_TOPGEN   3392
#define XCD_BAR_WORDS 3456
#define XB_SPIN_CAP (1u << 20)

__device__ __forceinline__ unsigned xb_ld(unsigned* p)              { return __hip_atomic_load(p, __ATOMIC_RELAXED, __HIP_MEMORY_SCOPE_AGENT); }
__device__ __forceinline__ unsigned xb_add(unsigned* p, unsigned v) { return __hip_atomic_fetch_add(p, v, __ATOMIC_RELAXED, __HIP_MEMORY_SCOPE_AGENT); }
__device__ __forceinline__ unsigned xb_xcc_id() { return (unsigned)__builtin_amdgcn_s_getreg((3 << 11) | 20) & 0xFu; }
#define XB_SPIN(cond, bar) do { unsigned _sp = 0; while (cond) { __builtin_amdgcn_s_sleep(1); \
    if ((++_sp & 255u) == 0u) { if (xb_ld(&(bar)[XB_TMO])) break; if (_sp > XB_SPIN_CAP) { atomicAdd(&(bar)[XB_TMO], 1u); break; } } } } while (0)

struct XcdBarrier { unsigned* bar; unsigned x; volatile LAS unsigned* st; };

__device__ __forceinline__ XcdBarrier xcd_barrier_post(unsigned* bar, volatile LAS unsigned* st) {
    XcdBarrier b; b.bar = bar; b.x = xb_xcc_id(); b.st = st;
    if (threadIdx.x == 0) (void)xb_add(&bar[XB_XCNT(b.x)], 1u);
    return b;
}
__device__ __forceinline__ void xcd_barrier_complete(unsigned* bar, unsigned x, unsigned& nloc, unsigned& nx) {
    const unsigned G = gridDim.x * gridDim.y * gridDim.z;
    unsigned sum, cnt, mine, sp = 0u;
    for (;;) {
        sum = 0u; cnt = 0u; mine = 0u;
#pragma unroll
        for (unsigned j = 0; j < 16; ++j) { const unsigned c = xb_ld(&bar[XB_XCNT(j)]); sum += c; cnt += (c > 0u) ? 1u : 0u; mine = (j == x) ? c : mine; }
        if (sum == G) break;
        __builtin_amdgcn_s_sleep(1);
        if ((++sp & 255u) == 0u) { if (xb_ld(&bar[XB_TMO])) break; if (sp > XB_SPIN_CAP) { atomicAdd(&bar[XB_TMO], 1u); break; } }
    }
    nloc = mine > 0u ? mine : 1u; nx = cnt > 0u ? cnt : 1u;
}
__device__ __forceinline__ void xcd_barrier(const XcdBarrier& b, bool t0) {
    asm volatile("s_waitcnt vmcnt(0)" ::: "memory");
    __syncthreads();
    if (t0) {
        unsigned* bar = b.bar;
        __builtin_amdgcn_s_waitcnt(0);
        unsigned nloc = b.st[0], nx = b.st[1];
        if (nloc == 0u) { xcd_barrier_complete(bar, b.x, nloc, nx); b.st[0] = nloc; b.st[1] = nx; }
        const unsigned old = xb_add(&bar[XB_XSUB(b.x)], 1u);
        const unsigned gen = old / nloc;
        if (old + 1u == (gen + 1u) * nloc) {
            __builtin_amdgcn_fence(__ATOMIC_RELEASE, "agent");
            asm volatile("s_waitcnt vmcnt(0)" ::: "memory");
            const unsigned og = xb_add(&bar[XB_TOP], 1u);
            const unsigned tg = og / nx;
            if (og + 1u == (tg + 1u) * nx) xb_add(&bar[XB_TOPGEN], 1u);
            else XB_SPIN(xb_ld(&bar[XB_TOPGEN]) == tg, bar);
            __builtin_amdgcn_fence(__ATOMIC_ACQUIRE, "agent");
            xb_add(&bar[XB_XGEN(b.x)], 1u);
            asm volatile("s_waitcnt vmcnt(0)" ::: "memory");
        } else {
            XB_SPIN(xb_ld(&bar[XB_XGEN(b.x)]) == gen, bar);
            __builtin_amdgcn_fence(__ATOMIC_ACQUIRE, "agent");
            asm volatile("s_waitcnt vmcnt(0)" ::: "memory");
        }
    }
    __syncthreads();
}

struct Args { const void* in[44]; float* out; unsigned char* ws; int ph_lo, ph_hi, li, pad; };
typedef const __attribute__((address_space(4))) Args* KArgs;
struct Frame {
    LAS unsigned char* lds;
    unsigned char* ws;
    gu32* ctl;
    int tid, lane, wave;
    int G, blk;
    float* out;
    KArgs ka;
};
#define MK_TID() (mk_wave0 * 64 + mk_lane())
#define MKFRAME(F) Frame F; { int t_ = MK_TID(); asm volatile("" : "+v"(t_)); KArgs k_ = (KArgs)__builtin_amdgcn_kernarg_segment_ptr(); asm volatile("" : "+s"(k_)); \
    F.lds = (LAS unsigned char*)lds_raw; F.ka = k_; F.ws = k_->ws; F.ctl = (gu32*)(k_->ws + WS_CTL); F.out = k_->out; F.tid = t_; F.lane = t_ & 63; F.wave = __builtin_amdgcn_readfirstlane(t_ >> 6); F.G = gridDim.x; F.blk = blockIdx.x; }
#define WSP(T, off) ((T*)(F.ws + (off)))
#define INP(T, i) ((const T*)F.ka->in[i])
__device__ __forceinline__ void sigm8(const float (&x)[8], float (&o)[8]) {
    typedef float f32x2s __attribute__((ext_vector_type(2)));
#pragma unroll
    for (int j = 0; j < 4; ++j) { const f32x2s t = (f32x2s){x[2 * j], x[2 * j + 1]} * -1.4426950408889634f;
        const f32x2s d = (f32x2s){__builtin_amdgcn_exp2f(t[0]), __builtin_amdgcn_exp2f(t[1])} + 1.0f; o[2 * j] = __builtin_amdgcn_rcpf(d[0]); o[2 * j + 1] = __builtin_amdgcn_rcpf(d[1]); }
}
using pg8::Unit; using pg8::Epi8; using pg8::EpiGU;
__device__ __forceinline__ void f4x2_to8(const f32x4 v0, const f32x4 v1, float (&o)[8]) { o[0] = v0[0]; o[1] = v0[1]; o[2] = v0[2]; o[3] = v0[3]; o[4] = v1[0]; o[5] = v1[1]; o[6] = v1[2]; o[7] = v1[3]; }

struct FProj {
    static constexpr int BATCH = 8; bf16* mla; bf16* rw; bf16* s5u;
    __device__ __forceinline__ void begin_col(const Unit&, int) {}
    typedef pg8::NoPre Pre; __device__ __forceinline__ Pre pre(const Unit&, int, int) const { return Pre{}; }
    __device__ __forceinline__ void tile8(const Unit&, int row, int col, const f32x4 v0, const f32x4 v1, const Pre&) const {
        const v4u w = pack8(v0, v1);
        if (col < 768) *(v4u*)(mla + (unsigned)row * 768 + col) = w;
        else if (col < 2560) *(v4u*)(rw + (unsigned)row * 1792 + (col - 768)) = w;
        else { const int c = col - 2560, g = c >> 4, i = c & 15; *(v4u*)(s5u + (unsigned)((g * S5CH + (row >> 5)) * S5K) + (row & 31) * 16 + i) = w; }
    }
};
struct FQup {
    static constexpr int BATCH = 4; bf16* Q; const float* cs; float qs;
    struct Pre { f32x4 c, s; };
    __device__ __forceinline__ void begin_col(const Unit&, int) {}
    __device__ __forceinline__ Pre pre(const Unit&, int row, int col) const { Pre p; const int head = col / 96, w = (col - head * 96) >> 3;
        if (w >= 8) { const int i0 = (w - 8) * 4; p.c = *(const f32x4*)(cs + (unsigned)row * 32 + i0); p.s = *(const f32x4*)(cs + (unsigned)row * 32 + 16 + i0); } else { p.c = (f32x4){0.f, 0.f, 0.f, 0.f}; p.s = p.c; } return p; }
    __device__ __forceinline__ void tile8(const Unit&, int row, int col, const f32x4 v0, const f32x4 v1, const Pre& p) const {
        const int head = col / 96, w = (col - head * 96) >> 3;
        bf16* q = Q + (unsigned)row * 768 + head * 96;
        if (w < 8) { *(v4u*)(q + 8 * w) = pack8(v0 * qs, v1 * qs); }
        else { const int i0 = (w - 8) * 4; const f32x4 c = p.c, s = p.s;
            const f32x4 x1 = (f32x4){v0[0], v0[2], v1[0], v1[2]}, x2 = (f32x4){v0[1], v0[3], v1[1], v1[3]};
            const f32x4 o1 = (x1 * c - x2 * s) * qs, o2 = (x1 * s + x2 * c) * qs;
            v2u a, b; a.x = cvt_pk_bf16(o1[0], o1[1]); a.y = cvt_pk_bf16(o1[2], o1[3]); b.x = cvt_pk_bf16(o2[0], o2[1]); b.y = cvt_pk_bf16(o2[2], o2[3]);
            *(v2u*)(q + 64 + i0) = a; *(v2u*)(q + 80 + i0) = b; }
    }
};
struct FKVup {
    static constexpr int BATCH = 8; bf16* K; bf16* V;
    __device__ __forceinline__ void begin_col(const Unit&, int) {}
    typedef pg8::NoPre Pre; __device__ __forceinline__ Pre pre(const Unit&, int, int) const { return Pre{}; }
    __device__ __forceinline__ void tile8(const Unit&, int row, int col, const f32x4 v0, const f32x4 v1, const Pre&) const {
        const int head = col >> 7, d = col & 127; const v4u w = pack8(v0, v1);
        const unsigned bht = (unsigned)((((row >> 12) * NH + head) * (SEQ / 64)) + ((row & (SEQ - 1)) >> 6)), key = (unsigned)(row & 63);
        if (d < 64) *(v4u*)(K + ((bht * 12u + (unsigned)(d >> 3)) * 64u + key) * 8u) = w;
        else { const int dv = d - 64; *(v4u*)(V + ((bht * 2u + (unsigned)(dv >> 5)) * 64u + key) * 32u + (unsigned)(dv & 31)) = w; }
    }
};
struct FLora {
    static constexpr int BATCH = 4;
    const float* w0; const float* a0; const float* k_a; f16* dcy; f16* kh; const f16* kkn; f16* bv; bf16* gl; float p[8], ka[8];
    struct Pre { f16x8 k, kn; };
    __device__ __forceinline__ void begin_col(const Unit&, int col) { const int seg = col >> 9, c = col & 511; ld8f(((seg == 0) ? w0 : a0) + c, p); ld8f(k_a + c, ka); }
    __device__ __forceinline__ Pre pre(const Unit&, int row, int col) const { Pre r; const unsigned off = (unsigned)row * 512 + (col & 511);
        if ((col >> 9) == 1) { r.k = *(const f16x8*)(kh + off); r.kn = *(const f16x8*)(kkn + off); } else { r.k = (f16x8)(0); r.kn = (f16x8)(0); } return r; }
    __device__ __forceinline__ void tile8(const Unit&, int row, int col, const f32x4 v0, const f32x4 v1, const Pre& pr) const {
        float a[8]; f4x2_to8(v0, v1, a);
        const int seg = col >> 9, c = col & 511; const unsigned off = (unsigned)row * 512 + c;
        if (seg == 0) { float o[8];
#pragma unroll
            for (int j = 0; j < 8; ++j) { const float e = 0.6065306597126334f * sigm(p[j] + a[j]); o[j] = 1.0f - __expf(-e); }
            *(f16x8*)(dcy + off) = f32_to_f16x8(o); }
        else if (seg == 1) { float k[8], kn[8]; f16x8_to_f32(pr.k, k); f16x8_to_f32(pr.kn, kn); float o1[8], o2[8];
#pragma unroll
            for (int j = 0; j < 8; ++j) { const float ic = sigm(p[j] + a[j]); o1[j] = k[j] * (1.0f + (ic - 1.0f) * ka[j]); o2[j] = kn[j] * ic; }
            *(f16x8*)(kh + off) = f32_to_f16x8(o1); *(f16x8*)(bv + off) = f32_to_f16x8(o2); }
        else { *(v4u*)(gl + off) = pack8(v0, v1); }
    }
};
struct FVres {
    static constexpr int BATCH = 4;
    const float* vb; const bf16* vraw; const bf16* vfirst; f16* vfin; float p[8];
    struct Pre { v4u v, vf; };
    __device__ __forceinline__ void begin_col(const Unit&, int col) { ld8f(vb + col, p); }
    __device__ __forceinline__ Pre pre(const Unit&, int row, int col) const { Pre r; const unsigned off = (unsigned)row * 512 + col; r.v = *(const v4u*)(vraw + off); r.vf = *(const v4u*)(vfirst + off); return r; }
    __device__ __forceinline__ void tile8(const Unit&, int row, int col, const f32x4 v0, const f32x4 v1, const Pre& pr) const {
        float a[8], v[8], vf[8], o[8]; f4x2_to8(v0, v1, a); const unsigned off = (unsigned)row * 512 + col;
        bf16x8_to_f32(pr.v, v); bf16x8_to_f32(pr.vf, vf);
#pragma unroll
        for (int j = 0; j < 8; ++j) o[j] = v[j] + (vf[j] - v[j]) * sigm(p[j] + a[j]);
        *(f16x8*)(vfin + off) = f32_to_f16x8(o);
    }
};
struct FS5End {
    static constexpr int BATCH = 8; float* xend;
    __device__ __forceinline__ void begin_col(const Unit&, int) {}
    typedef pg8::NoPre Pre; __device__ __forceinline__ Pre pre(const Unit&, int, int) const { return Pre{}; }
    __device__ __forceinline__ void tile8(const Unit& u, int row, int col, const f32x4 v0, const f32x4 v1, const Pre&) const {
        if (col < 128) { float* p = xend + (unsigned)((u.z * S5CH + row) * 128 + col); *(f32x4*)p = v0; *(f32x4*)(p + 4) = v1; }
    }
};
struct FS5Main {
    static constexpr int BATCH = 8;
    const bf16* s5u; const float* dvec; bf16* ys5g; float d[8];
    struct Pre { v4u uu; };
    __device__ __forceinline__ void begin_col(const Unit& u, int col) { ld8f(dvec + u.z * 16 + (col & 15), d); }
    __device__ __forceinline__ Pre pre(const Unit& u, int row, int col) const { Pre r; r.uu = *(const v4u*)(s5u + (unsigned)((u.z * S5CH + row) * S5K + col)); return r; }
    __device__ __forceinline__ void tile8(const Unit& u, int row, int col, const f32x4 v0, const f32x4 v1, const Pre& pr) const {
        float a[8], uu[8], o[8]; f4x2_to8(v0, v1, a); const int g = u.z, t = col >> 4, o0 = col & 15;
        bf16x8_to_f32(pr.uu, uu);
#pragma unroll
        for (int j = 0; j < 8; ++j) o[j] = gelu_tanh(a[j] + d[j] * uu[j]);
        *(v4u*)(ys5g + ((unsigned)row * 32 + t) * 512 + g * 16 + o0) = f32_to_bf16x8(o);
    }
};
struct FGlu {
    static constexpr int BATCH = 8;
    const bf16* ys5g; const float* bglu; bf16* ys5; float b[8];
    struct Pre { v4u y; };
    __device__ __forceinline__ void begin_col(const Unit&, int col) { ld8f(bglu + col, b); }
    __device__ __forceinline__ Pre pre(const Unit&, int row, int col) const { Pre r; r.y = *(const v4u*)(ys5g + (unsigned)row * 512 + col); return r; }
    __device__ __forceinline__ void tile8(const Unit&, int row, int col, const f32x4 v0, const f32x4 v1, const Pre& pr) const {
        float a[8], y[8], o[8]; f4x2_to8(v0, v1, a); const unsigned off = (unsigned)row * 512 + col; bf16x8_to_f32(pr.y, y);
#pragma unroll
        for (int j = 0; j < 8; ++j) o[j] = y[j] * sigm(a[j] + b[j]);
        *(v4u*)(ys5 + off) = f32_to_bf16x8(o);
    }
};
struct FGate {
    static constexpr int BATCH = 8; bf16* gbuf;
    __device__ __forceinline__ void begin_col(const Unit&, int) {}
    typedef pg8::NoPre Pre; __device__ __forceinline__ Pre pre(const Unit&, int, int) const { return Pre{}; }
    static constexpr bool PRIV = true;
    __device__ __forceinline__ Pre pre_p(const Unit&, int, int, unsigned) const { return Pre{}; }
    __device__ __forceinline__ void tile8_p(const Unit&, int, int, const f32x4 v0, const f32x4 v1, const Pre&, unsigned poff) const {
        float a[8], o[8]; f4x2_to8(v0, v1, a);
        sigm8(a, o);
        *(v4u*)(gbuf + poff) = f32_to_bf16x8(o);
    }
};
struct FGate2 {
    static constexpr int BATCH = 8; bf16* g0; bf16* g1;
    __device__ __forceinline__ void begin_col(const Unit&, int) {}
    typedef pg8::NoPre Pre; __device__ __forceinline__ Pre pre(const Unit&, int, int) const { return Pre{}; }
    static constexpr bool PRIV = true;
    __device__ __forceinline__ Pre pre_p(const Unit&, int, int, unsigned) const { return Pre{}; }
    __device__ __forceinline__ void tile8_p(const Unit&, int, int col, const f32x4 v0, const f32x4 v1, const Pre&, unsigned poff) const {
        float a[8], o[8]; f4x2_to8(v0, v1, a);
        sigm8(a, o);
        bf16* g = (col < 1024) ? g0 : g1;
        *(v4u*)(g + poff) = f32_to_bf16x8(o);
    }
};
struct FMerge {
    static constexpr int BATCH = 8; const bf16* gbuf; const bf16* min_; bf16* mout; int first, outp;
    struct Pre { v4u g, m; };
    __device__ __forceinline__ void begin_col(const Unit&, int) {}
    static constexpr bool PRIV = true;
    __device__ __forceinline__ Pre pre_p(const Unit&, int, int, unsigned poff) const { Pre r; r.g = *(const v4u*)(gbuf + poff); if (!first) r.m = *(const v4u*)(min_ + poff); else r.m = (v4u){0u, 0u, 0u, 0u}; return r; }
    __device__ __forceinline__ void tile8_p(const Unit&, int row, int col, const f32x4 v0, const f32x4 v1, const Pre& pr, unsigned poff) const {
        float a[8], g[8], mprev[8], o[8]; f4x2_to8(v0, v1, a); bf16x8_to_f32(pr.g, g); bf16x8_to_f32(pr.m, mprev);
#pragma unroll
        for (int j = 0; j < 8; ++j) o[j] = mprev[j] + g[j] * a[j];
        *(v4u*)(mout + (outp ? poff : (unsigned)row * 1024 + col)) = f32_to_bf16x8(o);
    }
};
struct FResid {
    static constexpr int BATCH = 8; const bf16* xin; f16* xout; float sc;
    struct Pre { v4u x; };
    __device__ __forceinline__ void begin_col(const Unit&, int) {}
    __device__ __forceinline__ Pre pre(const Unit&, int row, int col) const { Pre r; r.x = *(const v4u*)(xin + (unsigned)row * 1024 + col); return r; }
    __device__ __forceinline__ void tile8(const Unit&, int row, int col, const f32x4 v0, const f32x4 v1, const Pre& pr) const {
        float x[8], a[8], o[8]; bf16x8_to_f32(pr.x, x); f4x2_to8(v0, v1, a);
#pragma unroll
        for (int j = 0; j < 8; ++j) o[j] = x[j] * ALPHA + a[j] * sc;
        *(f16x8*)(xout + (unsigned)row * 1024 + col) = f32_to_f16x8(o);
    }
};
typedef float f32x2 __attribute__((ext_vector_type(2)));
template <bool O8> struct FSwigluT {
    static constexpr bool WIDE = O8;
    bf16* h; int ldh; float sc;
    __device__ __forceinline__ void act8(const f32x4 g0, const f32x4 g1, const f32x4 u0, const f32x4 u1, float (&o)[8]) const {
        const float c1 = -1.4426950408889634f * sc, c2 = sc * sc * (O8 ? FP8_HSCALE : 1.0f);
#pragma unroll
        for (int j = 0; j < 4; ++j) {
            const f32x2 gg = (j < 2) ? (f32x2){g0[2 * j], g0[2 * j + 1]} : (f32x2){g1[2 * j - 4], g1[2 * j - 3]};
            const f32x2 uu = (j < 2) ? (f32x2){u0[2 * j], u0[2 * j + 1]} : (f32x2){u1[2 * j - 4], u1[2 * j - 3]};
            const f32x2 t = gg * c1; f32x2 d = (f32x2){__builtin_amdgcn_exp2f(t[0]), __builtin_amdgcn_exp2f(t[1])} + 1.0f;
            const f32x2 r = (f32x2){__builtin_amdgcn_rcpf(d[0]), __builtin_amdgcn_rcpf(d[1])};
            const f32x2 p = (gg * uu) * c2 * r; o[2 * j] = p[0]; o[2 * j + 1] = p[1];
        }
    }
    __device__ __forceinline__ void q8(const float (&o)[8], unsigned& q0, unsigned& q1) const { int w0 = 0, w1 = 0;
        w0 = __builtin_amdgcn_cvt_pk_fp8_f32(o[0], o[1], w0, false); w0 = __builtin_amdgcn_cvt_pk_fp8_f32(o[2], o[3], w0, true);
        w1 = __builtin_amdgcn_cvt_pk_fp8_f32(o[4], o[5], w1, false); w1 = __builtin_amdgcn_cvt_pk_fp8_f32(o[6], o[7], w1, true); q0 = (unsigned)w0; q1 = (unsigned)w1; }
    __device__ __forceinline__ void pair8(const Unit&, int row, int colh, const f32x4 g0, const f32x4 g1, const f32x4 u0, const f32x4 u1) const {
        float o[8]; act8(g0, g1, u0, u1, o);
        if constexpr (O8) { v2u q; q8(o, q.x, q.y); *(v2u*)((unsigned char*)h + (size_t)((unsigned)row * ldh + colh)) = q; }
        else *(v4u*)(h + (unsigned)row * ldh + colh) = f32_to_bf16x8(o);
    }
    __device__ __forceinline__ void pair16(const Unit&, int rowA, int colb, int fq, const f32x4 ga0, const f32x4 ga1, const f32x4 ua0, const f32x4 ua1,
                                           const f32x4 gb0, const f32x4 gb1, const f32x4 ub0, const f32x4 ub1) const {
        float o[8]; unsigned a0, a1, b0, b1; act8(ga0, ga1, ua0, ua1, o); q8(o, a0, a1); act8(gb0, gb1, ub0, ub1, o); q8(o, b0, b1);
        { const auto r = __builtin_amdgcn_permlane16_swap(a0, b0, false, false); a0 = r[0]; b0 = r[1]; }
        { const auto r = __builtin_amdgcn_permlane16_swap(a1, b1, false, false); a1 = r[0]; b1 = r[1]; }
        const int row = rowA + ((fq & 1) ? 16 : 0);
        *(v4u*)((unsigned char*)h + (size_t)((unsigned)row * ldh + colb + (fq >> 1) * 16)) = (v4u){a0, a1, b0, b1};
    }
};
typedef FSwigluT<false> FSwiglu;
struct FMoeDown {
    static constexpr int BATCH = 8; bf16* ypair; const float* slotw; const unsigned* cnt; float sc;
    struct Pre { float w; };
    __device__ __forceinline__ void begin_col(const Unit&, int) {}
    __device__ __forceinline__ Pre pre(const Unit& u, int row, int) const { Pre r; const int rk = u.aux + (row - u.pm * 256); r.w = ((unsigned)rk < cnt[u.z]) ? slotw[(unsigned)(u.z * MOE_CAP + rk)] * sc : 0.f; return r; }
    __device__ __forceinline__ void tile8(const Unit& u, int row, int col, const f32x4 v0, const f32x4 v1, const Pre& pr) const {
        const int rk = u.aux + (row - u.pm * 256);
        if ((unsigned)rk < cnt[u.z]) *(v4u*)(ypair + (unsigned)row * 1024 + col) = pack8(v0 * pr.w, v1 * pr.w);
    }
};

struct MoeOrder {
    int nN, G, c; int pt[NEXP + 1];
    __device__ void init(const unsigned* cnt, int nN_, int G_, int c_) { nN = nN_; G = G_; c = c_; pt[0] = 0;
#pragma unroll
        for (int e = 0; e < NEXP; ++e) pt[e + 1] = pt[e] + (int)((cnt[e] + 255u) >> 8); }
    __device__ bool next(int i, Unit& u) const {
        const int nM = pt[NEXP], nwg = nM * nN; const long L = (long)i * G + c; if (L >= (long)nwg) return false;
        int wgid = (int)L; { const int q = nwg / pg8::NXCD, r = nwg % pg8::NXCD, xcd = wgid % pg8::NXCD, off = wgid / pg8::NXCD; wgid = (xcd < r ? xcd * (q + 1) : r * (q + 1) + (xcd - r) * q) + off; }
        const int nig = pg8::WGM * nN, gid = wgid / nig, fm = gid * pg8::WGM, gsz = (nM - fm) < pg8::WGM ? (nM - fm) : pg8::WGM;
        const int tile = fm + ((wgid % nig) % gsz); u.pn = (wgid % nig) / gsz; int e = 0;
#pragma unroll
        for (int k = 1; k < NEXP; ++k) e += (tile >= pt[k]) ? 1 : 0;
        int base = 0;
#pragma unroll
        for (int k = 1; k < NEXP; ++k) base = (tile >= pt[k]) ? pt[k] : base;
        u.z = e; u.pm = tile; u.aux = (tile - base) * 256; return true;
    }
};
constexpr int MT_KS = 7, MT_K = EXD / MT_KS;
static_assert(MT_KS * MT_K == EXD && MT_K % 128 == 0, "tail K-slices");
struct MoeOrderFull {
    int nN, G, c; int pt[NEXP + 1], pf[NEXP + 1];
    __device__ void init(const unsigned* cnt, int nN_, int G_, int c_) { nN = nN_; G = G_; c = c_; pt[0] = 0; pf[0] = 0;
#pragma unroll
        for (int e = 0; e < NEXP; ++e) { pt[e + 1] = pt[e] + (int)((cnt[e] + 255u) >> 8); pf[e + 1] = pf[e] + (int)(cnt[e] >> 8); } }
    __device__ bool next(int i, Unit& u) const {
        const int nM = pf[NEXP], nwg = nM * nN; const long L = (long)i * G + c; if (L >= (long)nwg) return false;
        int wgid = (int)L; { const int q = nwg / pg8::NXCD, r = nwg % pg8::NXCD, xcd = wgid % pg8::NXCD, off = wgid / pg8::NXCD; wgid = (xcd < r ? xcd * (q + 1) : r * (q + 1) + (xcd - r) * q) + off; }
        const int nig = pg8::WGM * nN, gid = wgid / nig, fm = gid * pg8::WGM, gsz = (nM - fm) < pg8::WGM ? (nM - fm) : pg8::WGM;
        const int tile = fm + ((wgid % nig) % gsz); u.pn = (wgid % nig) / gsz; int e = 0;
#pragma unroll
        for (int k = 1; k < NEXP; ++k) e += (tile >= pf[k]) ? 1 : 0;
        int basef = 0, baset = 0;
#pragma unroll
        for (int k = 1; k < NEXP; ++k) { basef = (tile >= pf[k]) ? pf[k] : basef; baset = (tile >= pf[k]) ? pt[k] : baset; }
        u.z = __builtin_amdgcn_readfirstlane(e); u.pm = __builtin_amdgcn_readfirstlane(baset + (tile - basef)); u.aux = __builtin_amdgcn_readfirstlane((tile - basef) * 256); u.pn = __builtin_amdgcn_readfirstlane(u.pn); return true;
    }
};
struct MoeTailOrder {
    int G, c; const unsigned* cnt;
    __device__ void init(const unsigned* cnt_, int G_, int c_) { cnt = cnt_; G = G_; c = c_; }
    __device__ bool next(int i, Unit& u) const {
        const int L = G - 1 - c; if (i > 0 || L >= NEXP * 4 * MT_KS) return false;
        const int e = L / (4 * MT_KS), r = L % (4 * MT_KS); int base = 0;
#pragma unroll
        for (int k = 0; k < NEXP; ++k) base += (k < e) ? (int)((cnt[k] + 255u) >> 8) : 0;
        const unsigned n = cnt[e]; if ((n & 255u) == 0u) return false;
        u.z = e + 8 * (r % MT_KS); u.pn = r / MT_KS; u.pm = base + (int)(n >> 8); u.aux = (int)(n >> 8) * 256; return true;
    }
};
struct LocMoeTail {
    static constexpr bool GATHER = false, FP8 = (FP8_MOED != 0);
    const bf16* A; const bf16* Bt; int lda, ldb, K;
    __device__ __forceinline__ const char* a_ptr(const Unit& u) const { return (const char*)(A + (size_t)u.pm * 256 * lda + (size_t)(u.z >> 3) * K); }
    __device__ __forceinline__ const char* b_ptr(const Unit& u) const { return (const char*)(Bt + (size_t)(u.z & 7) * DM * ldb + (size_t)u.pn * 256 * ldb + (size_t)(u.z >> 3) * K); }
    __device__ __forceinline__ void a_off(const Unit&, int tid, unsigned (&v)[2][2]) const {
#pragma unroll
        for (int i = 0; i < 2; ++i) { int R, C; pg8::stage_rc(tid * 16 + i * 8192, R, C); v[0][i] = (unsigned)(R * lda + C) * 2u; v[1][i] = 0u; }
    }
};
struct FMoeTail {
    static constexpr int BATCH = 8; float* slab; const float* slotw; const unsigned* cnt; float sc;
    struct Pre { float w; };
    __device__ __forceinline__ void begin_col(const Unit&, int) {}
    __device__ __forceinline__ Pre pre(const Unit& u, int row, int) const { Pre r; const int e = u.z & 7; const int rk = u.aux + (row - u.pm * 256); r.w = ((unsigned)rk < cnt[e]) ? slotw[(unsigned)(e * MOE_CAP + rk)] * sc : 0.f; return r; }
    __device__ __forceinline__ void tile8(const Unit& u, int row, int col, const f32x4 v0, const f32x4 v1, const Pre& pr) const {
        const int e = u.z & 7, rl = row - u.pm * 256; const int rk = u.aux + rl;
        if ((unsigned)rk < cnt[e]) { float* p = slab + ((size_t)((u.z >> 3) * NEXP + e) * 256 + rl) * DM + col; *(f32x4*)p = v0 * pr.w; *(f32x4*)(p + 4) = v1 * pr.w; }
    }
};
struct LocMoe1 {
    static constexpr bool GATHER = true, FP8 = (FP8_MOE != 0);
    const bf16* A; const bf16* Bt; int lda, ldb, K; const int* slot_tok; const unsigned* cnt;
    __device__ __forceinline__ const char* a_ptr(const Unit&) const { return (const char*)A; }
    __device__ __forceinline__ const char* b_ptr(const Unit& u) const { return (const char*)(Bt + (size_t)u.z * (2 * EXD) * ldb + (size_t)u.pn * 256 * ldb); }
    __device__ __forceinline__ void a_tok(const Unit& u, int tid, unsigned (&v)[2][2]) const {
        const unsigned n = cnt[u.z];
#pragma unroll
        for (int i = 0; i < 2; ++i) { int R, C; pg8::stage_rc(tid * 16 + i * 8192, R, C);
#pragma unroll
            for (int h = 0; h < 2; ++h) { const int r = u.aux + h * 128 + R; v[h][i] = ((unsigned)r < n) ? (unsigned)slot_tok[(unsigned)(u.z * MOE_CAP + r)] : 0u; } }
    }
    __device__ __forceinline__ void a_fin(int tid, const unsigned (&t)[2][2], unsigned (&v)[2][2]) const {
#pragma unroll
        for (int i = 0; i < 2; ++i) { int R, C; pg8::stage_rc(tid * 16 + i * 8192, R, C);
#pragma unroll
            for (int h = 0; h < 2; ++h) v[h][i] = (t[h][i] * (unsigned)lda + (unsigned)C) * 2u; }
    }
    __device__ __forceinline__ void a_off(const Unit& u, int tid, unsigned (&v)[2][2]) const { unsigned t[2][2]; a_tok(u, tid, t); a_fin(tid, t, v); }
};
__device__ __forceinline__ int qperm_row(int n) { const int h = n / 96, d = n - h * 96; if (d < 64) return n; const int e = d - 64; return h * 96 + 64 + ((e < 16) ? 2 * e : 2 * (e - 16) + 1); }
struct TrDesc { const float* W; const float* ksc; bf16* WT; int ldw, k0, n0, ldd, kdst, drow0, qperm, fp8; };
constexpr float FP8_WSCALE = 32.0f;
struct TrRegs { f32x4 v[8]; };
__device__ __forceinline__ void tr_load(const TrDesc& d, TrRegs& r, int lane) {
    if (d.W) {
#pragma unroll
        for (int i = 0; i < 8; ++i) { const int kk = (lane >> 3) + 8 * i; f32x4 v = *(const f32x4*)(d.W + (size_t)(d.k0 + kk) * d.ldw + d.n0 + 4 * (lane & 7)); if (d.ksc) v = v * d.ksc[d.k0 + kk]; r.v[i] = v; }
    } else {
#pragma unroll
        for (int i = 0; i < 8; ++i) r.v[i] = (f32x4){0.f, 0.f, 0.f, 0.f};
    }
}
__device__ __forceinline__ void tr_finish(const TrDesc& d, const TrRegs& r, LAS float* scr, int lane) {
#pragma unroll
    for (int i = 0; i < 8; ++i) { const int kk = (lane >> 3) + 8 * i; LAS float* s = scr + kk * 33 + 4 * (lane & 7); s[0] = r.v[i][0]; s[1] = r.v[i][1]; s[2] = r.v[i][2]; s[3] = r.v[i][3]; }
    LDS_WAIT(); asm volatile("" ::: "memory");
    const int c = lane & 7;
#pragma unroll
    for (int j = 0; j < 4; ++j) { const int n = (lane >> 3) + 8 * j; const LAS float* s = scr + (8 * c) * 33 + n;
        v4u o; o.x = cvt_pk_bf16(s[0 * 33], s[1 * 33]); o.y = cvt_pk_bf16(s[2 * 33], s[3 * 33]); o.z = cvt_pk_bf16(s[4 * 33], s[5 * 33]); o.w = cvt_pk_bf16(s[6 * 33], s[7 * 33]);
        const int dr = d.qperm ? qperm_row(d.n0 + n) : (d.drow0 + n);
        if (d.fp8) { v2u q; int w0 = 0, w1 = 0;
            w0 = __builtin_amdgcn_cvt_pk_fp8_f32(s[0 * 33] * FP8_WSCALE, s[1 * 33] * FP8_WSCALE, w0, false); w0 = __builtin_amdgcn_cvt_pk_fp8_f32(s[2 * 33] * FP8_WSCALE, s[3 * 33] * FP8_WSCALE, w0, true);
            w1 = __builtin_amdgcn_cvt_pk_fp8_f32(s[4 * 33] * FP8_WSCALE, s[5 * 33] * FP8_WSCALE, w1, false); w1 = __builtin_amdgcn_cvt_pk_fp8_f32(s[6 * 33] * FP8_WSCALE, s[7 * 33] * FP8_WSCALE, w1, true);
            q.x = (unsigned)w0; q.y = (unsigned)w1; *(v2u*)((unsigned char*)d.WT + (size_t)dr * d.ldd + d.kdst + 8 * c) = q; }
        else *(v4u*)(d.WT + (size_t)dr * d.ldd + d.kdst + 8 * c) = o; }
    LDS_WAIT(); asm volatile("" ::: "memory");
}
__device__ __forceinline__ bool trjob(int& r, TrDesc& d, const float* W, int ldw, int K, int c0, int ncols, const float* ksc, bf16* WT, int ldd, int drow0, int fp8 = 0) {
    const int nb = ncols / 32, ni = (K / 64) * nb; if (r < ni) { const int kb = r / nb, nbi = r % nb; d = TrDesc{W, ksc, WT, ldw, 64 * kb, c0 + 32 * nbi, ldd, 64 * kb, drow0 + 32 * nbi, 0, fp8}; return true; } r -= ni; return false; }
__device__ __forceinline__ bool trjob_gu(int& r, TrDesc& d, const float* W, int ldw, int K, int ncols, bf16* WT, int ldd, int up, int fp8 = 0) {
    const int nb = ncols / 32, ni = (K / 64) * nb; if (r < ni) { const int kb = r / nb, n0 = 32 * (r % nb); d = TrDesc{W, nullptr, WT, ldw, 64 * kb, n0, ldd, 64 * kb, (n0 >> 7) * 256 + (n0 & 127) + (up ? 128 : 0), 0, fp8}; return true; } r -= ni; return false; }

constexpr int TR_PER_LAYER = 16 * 189 + 6 * 24 + 4 * 32 + 192 + 8 * 16 + 3 * 8 * 32 + 16 * 32 + 3 * 16;
constexpr int TR_PER_FFN = 3 * 16 * 88, TR_PROLOGUE = NLAYER * TR_PER_LAYER + 2 * TR_PER_FFN;
__device__ __forceinline__ void tr_decode_prologue(Frame& F, int it, TrDesc& d) {
    if (it < NLAYER * TR_PER_LAYER) {
        const int l = it / TR_PER_LAYER; int r = it % TR_PER_LAYER;
        const float* win = INP(float, 2) + (size_t)l * DM * IN_W;
        bf16* win_t = WSP(bf16, WS_WIN) + (size_t)l * 3072 * DM; bf16* wg_t = WSP(bf16, WS_WG) + (size_t)l * 3072 * DM;
        if (trjob(r, d, win, IN_W, DM, 0, 672, nullptr, win_t, DM, 0)) return;
        if (trjob(r, d, win, IN_W, DM, 672, 2304, nullptr, win_t, DM, 768)) return;
        if (trjob(r, d, win, IN_W, DM, 2976, 3072, nullptr, wg_t, DM, 0)) return;
        if (r < 48) { d = TrDesc{nullptr, nullptr, win_t, 0, 64 * (r / 3), 0, DM, 64 * (r / 3), 672 + 32 * (r % 3), 0}; return; } r -= 48;
        if (r < 144) { const int kb = r / 24, nbi = r % 24; d = TrDesc{INP(float, 4) + (size_t)l * 384 * 768, INP(float, 3) + l * 384, WSP(bf16, WS_WUQ) + (size_t)l * 768 * 384, 768, 64 * kb, 32 * nbi, 384, 64 * kb, 0, 1}; return; } r -= 144;
        if (trjob(r, d, INP(float, 6) + (size_t)l * 256 * 1024, 1024, 256, 0, 1024, INP(float, 5) + l * 256, WSP(bf16, WS_WUKV) + (size_t)l * 1024 * 256, 256, 0)) return;
        if (r < 192) { const int rb = r / 4, kb = r % 4; bf16* wl = WSP(bf16, WS_WLORA) + (size_t)l * 1536 * 256; const float* src = nullptr; int k0 = 0, n0 = 0;
            if (rb < 16) { if (kb == 0) { src = INP(float, 9) + (size_t)l * 64 * 512; n0 = 32 * rb; } }
            else if (rb < 32) { if (kb == 1) { src = INP(float, 11) + (size_t)l * 64 * 512; n0 = 32 * (rb - 16); } }
            else { if (kb >= 2) { src = INP(float, 12) + (size_t)l * 128 * 512; k0 = 64 * (kb - 2); n0 = 32 * (rb - 32); } }
            d = TrDesc{src, nullptr, wl, 512, k0, n0, 256, 64 * kb, 32 * rb, 0}; return; } r -= 192;
        if (trjob(r, d, INP(float, 29) + (size_t)l * 512 * 512, 512, 512, 0, 512, nullptr, WSP(bf16, WS_WGLU) + (size_t)l * 512 * 512, 512, 0)) return;
        if (trjob(r, d, INP(float, 31) + (size_t)(l * 3 + 0) * 512 * 1024, 1024, 512, 0, 1024, nullptr, WSP(bf16, WS_WBR) + (size_t)(l * 3 + 0) * 1024 * 512, 512, 0)) return;
        if (trjob(r, d, INP(float, 31) + (size_t)(l * 3 + 1) * 512 * 1024, 1024, 512, 0, 1024, nullptr, WSP(bf16, WS_WBR) + (size_t)(l * 3 + 1) * 1024 * 512, 512, 0)) return;
        if (trjob(r, d, INP(float, 31) + (size_t)(l * 3 + 2) * 512 * 1024, 1024, 512, 0, 1024, nullptr, WSP(bf16, WS_WBR) + (size_t)(l * 3 + 2) * 1024 * 512, 512, 0)) return;
        (void)trjob(r, d, INP(float, 32) + (size_t)l * DM * DM, DM, DM, 0, DM, nullptr, WSP(bf16, WS_WOUT) + (size_t)l * DM * DM, DM, 0);
    } else {
        const int q = it - NLAYER * TR_PER_LAYER, i = q / TR_PER_FFN; int r = q % TR_PER_FFN;
        if (trjob_gu(r, d, INP(float, 37) + (size_t)i * DM * FFN, FFN, DM, FFN, WSP(bf16, WS_WFGU) + (size_t)i * 2 * FFN * DM / (FP8_DENSE ? 2 : 1), DM, 0, FP8_DENSE)) return;
        if (trjob_gu(r, d, INP(float, 38) + (size_t)i * DM * FFN, FFN, DM, FFN, WSP(bf16, WS_WFGU) + (size_t)i * 2 * FFN * DM / (FP8_DENSE ? 2 : 1), DM, 1, FP8_DENSE)) return;
        (void)trjob(r, d, INP(float, 39) + (size_t)i * FFN * DM, DM, FFN, 0, DM, nullptr, WSP(bf16, WS_WFD) + (size_t)i * DM * FFN / (FP8_DD ? 2 : 1), FFN, 0, FP8_DD);
    }
}
constexpr int TR_PER_E = 2 * 16 * 112 + 56 * 32;
__device__ __forceinline__ void tr_decode_moe(Frame& F, int li, int it, TrDesc& d) {
    const int e = it / TR_PER_E; int r = it % TR_PER_E; const size_t wi = (size_t)(li * NEXP + e);
    if (trjob_gu(r, d, INP(float, 41) + wi * DM * EXD, EXD, DM, EXD, WSP(bf16, WS_WMGU) + (size_t)e * 2 * EXD * DM / (FP8_MOE ? 2 : 1), DM, 0, FP8_MOE)) return;
    if (trjob_gu(r, d, INP(float, 42) + wi * DM * EXD, EXD, DM, EXD, WSP(bf16, WS_WMGU) + (size_t)e * 2 * EXD * DM / (FP8_MOE ? 2 : 1), DM, 1, FP8_MOE)) return;
    (void)trjob(r, d, INP(float, 43) + wi * EXD * DM, DM, EXD, 0, DM, nullptr, WSP(bf16, WS_WMD) + (size_t)e * DM * EXD / (FP8_MOED ? 2 : 1), EXD, 0, FP8_MOED);
}

__device__ __forceinline__ void p0_prologue(Frame& F) {
    LAS float* scr = (LAS float*)(F.lds + F.wave * 16384);
    const int lane = F.lane; const int gw = F.blk * NWAVES + F.wave, NGW = F.G * NWAVES;
    { TrDesc dc, dn; TrRegs rc, rn; int it = gw;
      if (it < TR_PROLOGUE) { tr_decode_prologue(F, it, dc); tr_load(dc, rc, lane); }
      for (; it < TR_PROLOGUE; it += NGW) { const bool more = it + NGW < TR_PROLOGUE;
          if (more) { tr_decode_prologue(F, it + NGW, dn); tr_load(dn, rn, lane); }
          tr_finish(dc, rc, scr, lane);
          if (more) { dc = dn; rc = rn; } } }
    for (int it = F.blk * 512 + F.tid; it < 3 * 512 * 64; it += F.G * 512) {
        const int i = it / (512 * 64), rem = it % (512 * 64), n = rem >> 6, k0 = (rem & 63) * 8;
        const float* vd = INP(float, 18) + (size_t)i * 512 * 32; const float* vu = INP(float, 19) + (size_t)i * 32 * 512; float o[8];
#pragma unroll
        for (int j = 0; j < 8; ++j) o[j] = 0.f;
#pragma unroll 8
        for (int rr = 0; rr < 32; ++rr) { const float u = vu[rr * 512 + n];
#pragma unroll
            for (int j = 0; j < 8; ++j) o[j] += vd[(k0 + j) * 32 + rr] * u; }
        *(v4u*)(WSP(bf16, WS_WVRES) + (size_t)i * 512 * 512 + (size_t)n * 512 + k0) = f32_to_bf16x8(o);
    }
    for (int it = F.blk * 512 + F.tid; it < M * 16; it += F.G * 512) {
        const int m = it >> 4, i = it & 15; const float inv = powf(10000.0f, -(float)i * (1.0f / 16.0f)); const float ang = (float)INP(int, 1)[m] * inv;
        float sn, cn; sincosf(ang, &sn, &cn); float* cs = WSP(float, WS_ROPE) + (size_t)m * 32; cs[i] = cn; cs[16 + i] = sn;
    }
}
__device__ __forceinline__ void moe_convert(Frame& F, int li) {
    LAS float* scr = (LAS float*)(F.lds + F.wave * 16384);
    const int lane = F.lane; const int gw = F.blk * NWAVES + F.wave, NGW = F.G * NWAVES;
    TrDesc dc, dn; TrRegs rc, rn; int it = gw;
    if (it < NEXP * TR_PER_E) { tr_decode_moe(F, li, it, dc); tr_load(dc, rc, lane); }
    for (; it < NEXP * TR_PER_E; it += NGW) { const bool more = it + NGW < NEXP * TR_PER_E;
        if (more) { tr_decode_moe(F, li, it + NGW, dn); tr_load(dn, rn, lane); }
        tr_finish(dc, rc, scr, lane);
        if (more) { dc = dn; rc = rn; } }
}

__device__ __forceinline__ void ph2_prep(Frame& F, int l) {
    const int lane = F.lane; const int gw = F.blk * NWAVES + F.wave, NGW = F.G * NWAVES;
    const bf16* rwraw = WSP(bf16, WS_RWRAW); const bf16* mlaraw = WSP(bf16, WS_MLARAW);
    const float* mu = INP(float, 7) + l * 1792; const float* k_k = INP(float, 13) + l * 512;
    float mu_r[8], mu_k[8], mu_v[8], mu_t[8], kk8[8];
    ld8f(mu + 8 * lane, mu_r); ld8f(mu + 512 + 8 * lane, mu_k); ld8f(mu + 1024 + 8 * lane, mu_v); ld8f(mu + 1536 + 8 * (lane & 31), mu_t); ld8f(k_k + 8 * lane, kk8);
    const float* cs_all = WSP(float, WS_ROPE);
    constexpr int TPW = 16;
    const int m0 = gw * TPW;
    v4u n_r, n_k, n_v, n_t, n_a, n_b, p_r, p_k, p_v, p_t;
    { const bf16* cur = rwraw + (size_t)m0 * 1792; n_r = *(const v4u*)(cur + 8 * lane); n_k = *(const v4u*)(cur + 512 + 8 * lane); n_v = *(const v4u*)(cur + 1024 + 8 * lane); n_t = *(const v4u*)(cur + 1536 + 8 * (lane & 31));
      const bf16* mr = mlaraw + (size_t)m0 * 768; n_a = *(const v4u*)(mr + 8 * lane); n_b = *(const v4u*)(mr + 512 + 8 * (lane & 31));
      if (m0 & (SEQ - 1)) { const bf16* prv = cur - 1792; p_r = *(const v4u*)(prv + 8 * lane); p_k = *(const v4u*)(prv + 512 + 8 * lane); p_v = *(const v4u*)(prv + 1024 + 8 * lane); p_t = *(const v4u*)(prv + 1536 + 8 * (lane & 31)); }
      else { p_r = (v4u){0u, 0u, 0u, 0u}; p_k = p_r; p_v = p_r; p_t = p_r; } }
    for (int i = 0; i < TPW; ++i) {
        const int m = m0 + i;
        const v4u c_r = n_r, c_k = n_k, c_v = n_v, c_t = n_t, c_a = n_a, c_b = n_b;
        if (i + 1 < TPW) { const bf16* nx = rwraw + (size_t)(m + 1) * 1792; n_r = *(const v4u*)(nx + 8 * lane); n_k = *(const v4u*)(nx + 512 + 8 * lane); n_v = *(const v4u*)(nx + 1024 + 8 * lane); n_t = *(const v4u*)(nx + 1536 + 8 * (lane & 31));
            const bf16* mr = mlaraw + (size_t)(m + 1) * 768; n_a = *(const v4u*)(mr + 8 * lane); n_b = *(const v4u*)(mr + 512 + 8 * (lane & 31)); }
        float c[8], p[8], o[8];
        bf16x8_to_f32(c_r, c); bf16x8_to_f32(p_r, p);
#pragma unroll
        for (int j = 0; j < 8; ++j) o[j] = c[j] + (p[j] - c[j]) * mu_r[j];
        *(f16x8*)(WSP(f16, WS_R) + (size_t)m * 512 + 8 * lane) = f32_to_f16x8(o);
        bf16x8_to_f32(c_k, c); bf16x8_to_f32(p_k, p);
        float ss = 0.f;
#pragma unroll
        for (int j = 0; j < 8; ++j) { o[j] = c[j] + (p[j] - c[j]) * mu_k[j]; const float q = o[j] * kk8[j]; ss += q * q; }
        *(f16x8*)(WSP(f16, WS_KH) + (size_t)m * 512 + 8 * lane) = f32_to_f16x8(o);
        ss += mk_shfl_xor(ss, 1); ss += mk_shfl_xor(ss, 2); ss += mk_shfl_xor(ss, 4);
        { const float rn = __builtin_amdgcn_rsqf(fmaxf(ss, 1e-24f));
#pragma unroll
          for (int j = 0; j < 8; ++j) o[j] = o[j] * kk8[j] * rn; }
        *(f16x8*)(WSP(f16, WS_KKN) + (size_t)m * 512 + 8 * lane) = f32_to_f16x8(o);
        bf16x8_to_f32(c_v, c); bf16x8_to_f32(p_v, p);
#pragma unroll
        for (int j = 0; j < 8; ++j) o[j] = c[j] + (p[j] - c[j]) * mu_v[j];
        { const v4u vb = f32_to_bf16x8(o); *(v4u*)(WSP(bf16, WS_VRAW) + (size_t)m * 512 + 8 * lane) = vb;
          if (l == 0) { *(v4u*)(WSP(bf16, WS_VFIRST) + (size_t)m * 512 + 8 * lane) = vb; *(f16x8*)(WSP(f16, WS_VFIN) + (size_t)m * 512 + 8 * lane) = f32_to_f16x8(o); } }
        if (lane < 32) {
            bf16x8_to_f32(c_t, c); bf16x8_to_f32(p_t, p);
            const float sc = (lane < 8) ? 2.0f : 1.0f, om = (lane < 8) ? 2.0f : 1.0f, oa = (lane < 8) ? -1.0f : 0.0f; const bool idt = (lane >= 8 && lane < 16);
#pragma unroll
            for (int j = 0; j < 8; ++j) { const float v = c[j] + (p[j] - c[j]) * mu_t[j]; const float sg = sigm(sc * v); o[j] = idt ? v : sg * om + oa; }
            *(v4u*)(WSP(bf16, WS_LORAIN) + (size_t)m * 256 + 8 * lane) = f32_to_bf16x8(o);
        }
        p_r = c_r; p_k = c_k; p_v = c_v; p_t = c_t;
        float a8[8], b8[8];
        bf16x8_to_f32(c_a, a8); float ssa = 0.f, ssb = 0.f;
#pragma unroll
        for (int j = 0; j < 8; ++j) ssa += a8[j] * a8[j];
        if (lane < 32) { bf16x8_to_f32(c_b, b8);
#pragma unroll
            for (int j = 0; j < 8; ++j) ssb += b8[j] * b8[j]; } else {
#pragma unroll
            for (int j = 0; j < 8; ++j) b8[j] = 0.f; }
        const float sq = wave_sum(lane < 48 ? ssa : 0.f), skv = wave_sum((lane >= 48 ? ssa : 0.f) + (lane < 16 ? ssb : 0.f));
        const float rq = __builtin_amdgcn_rsqf(sq * (1.0f / 384.0f) + 1e-6f), rkv = __builtin_amdgcn_rsqf(skv * (1.0f / 256.0f) + 1e-6f);
        { const float rs = (lane < 48) ? rq : rkv;
#pragma unroll
          for (int j = 0; j < 8; ++j) o[j] = a8[j] * rs;
          bf16* dst = (lane < 48) ? WSP(bf16, WS_CQN) + (size_t)m * 384 + 8 * lane : WSP(bf16, WS_CKVN) + (size_t)m * 256 + 8 * (lane - 48);
          *(v4u*)dst = f32_to_bf16x8(o); }
        if (lane < 16) {
#pragma unroll
            for (int j = 0; j < 8; ++j) o[j] = b8[j] * rkv;
            *(v4u*)(WSP(bf16, WS_CKVN) + (size_t)m * 256 + 128 + 8 * lane) = f32_to_bf16x8(o);
        }
        float pr[8];
#pragma unroll
        for (int j = 0; j < 8; ++j) pr[j] = mk_shfl_xor(b8[j], 2);
        v4u w = (v4u){0u, 0u, 0u, 0u};
        if (lane >= 16 && lane < 20) { const int i0 = 8 * (lane & 1); const float* cs = cs_all + (size_t)m * 32; float cc[8], sn[8]; ld8f(cs + i0, cc); ld8f(cs + 16 + i0, sn);
            const bool lo = lane < 18;
#pragma unroll
            for (int j = 0; j < 8; ++j) o[j] = lo ? (b8[j] * cc[j] - pr[j] * sn[j]) : (pr[j] * sn[j] + b8[j] * cc[j]);
            w = f32_to_bf16x8(o); }
        { const int src = 16 + (lane & 3); v4u ww; ww.x = (unsigned)mk_shfl((int)w.x, src); ww.y = (unsigned)mk_shfl((int)w.y, src); ww.z = (unsigned)mk_shfl((int)w.z, src); ww.w = (unsigned)mk_shfl((int)w.w, src);
          if (lane < 4 * NH) { const unsigned bht = (unsigned)((((m >> 12) * NH + (lane >> 2)) * (SEQ / 64)) + ((m & (SEQ - 1)) >> 6));
              *(v4u*)(WSP(bf16, WS_K) + ((bht * 12u + 8u + (unsigned)(lane & 3)) * 64u + (unsigned)(m & 63)) * 8u) = ww; } }
    }
}

__device__ __forceinline__ void s5_gen(Frame& F, int l, int g) {
    {
        __syncthreads();
        const int tid = F.tid;
        LAS float* pw = (LAS float*)F.lds;
        LAS float* Bb = pw + 33 * 64 * 2;
        LAS float* Cc = Bb + 64 * 16 * 2;
        LAS float* Kt = Cc + 16 * 64 * 2;
        const float dt = expf(INP(float, 23)[l * 32 + g]);
        const float* are = INP(float, 21) + (size_t)(l * 32 + g) * 64; const float* aim = INP(float, 22) + (size_t)(l * 32 + g) * 64;
        for (int e = tid; e < 33 * 64; e += 512) { const int n = e >> 6, p = e & 63; const float lr = fminf(are[p], -1e-4f), li = aim[p];
            const float mag = expf((float)n * (dt * lr)); float sn, cn; sincosf((float)n * (dt * li), &sn, &cn); pw[2 * e] = mag * cn; pw[2 * e + 1] = mag * sn; }
        for (int e = tid; e < 64 * 16; e += 512) { const int p = e >> 4; const float lr = fminf(are[p], -1e-4f), li = aim[p];
            const float mag = expf(dt * lr); float sn, cn; sincosf(dt * li, &sn, &cn); const float abr = mag * cn, abi = mag * sn, den = lr * lr + li * li;
            const float fr = ((abr - 1.0f) * lr + abi * li) / den, fi = (abi * lr - (abr - 1.0f) * li) / den;
            const float br = INP(float, 24)[(size_t)(l * 32 + g) * 1024 + e], bi = INP(float, 25)[(size_t)(l * 32 + g) * 1024 + e];
            Bb[2 * e] = fr * br - fi * bi; Bb[2 * e + 1] = fr * bi + fi * br; }
        for (int e = tid; e < 16 * 64; e += 512) { Cc[2 * e] = INP(float, 26)[(size_t)(l * 32 + g) * 1024 + e]; Cc[2 * e + 1] = INP(float, 27)[(size_t)(l * 32 + g) * 1024 + e]; }
        __syncthreads();
        { const int tau = tid >> 4, o = tid & 15; float acc[16];
#pragma unroll
          for (int i = 0; i < 16; ++i) acc[i] = 0.f;
          for (int p = 0; p < 64; ++p) { const float cr = Cc[2 * (o * 64 + p)], ci = Cc[2 * (o * 64 + p) + 1], pr_ = pw[2 * (tau * 64 + p)], pi_ = pw[2 * (tau * 64 + p) + 1];
              const float xr = cr * pr_ - ci * pi_, xi = cr * pi_ + ci * pr_;
#pragma unroll
              for (int i = 0; i < 16; ++i) acc[i] += xr * Bb[2 * (p * 16 + i)] - xi * Bb[2 * (p * 16 + i) + 1]; }
#pragma unroll
          for (int i = 0; i < 16; ++i) Kt[(tau * 16 + o) * 16 + i] = acc[i]; }
        __syncthreads();
        bf16* bm = WSP(bf16, WS_S5MAIN) + ((size_t)l * 32 + g) * 512 * S5K;
        for (int e = tid; e < 512 * 80; e += 512) { const int n = e / 80, k0 = (e % 80) * 8, t = n >> 4, o = n & 15; float v[8];
            if (k0 < 512) { const int sidx = k0 >> 4, i0 = k0 & 15;
#pragma unroll
                for (int j = 0; j < 8; ++j) v[j] = (sidx <= t) ? Kt[((t - sidx) * 16 + o) * 16 + i0 + j] : 0.f; }
            else {
#pragma unroll
                for (int j = 0; j < 8; ++j) { const int q = k0 - 512 + j, p = q & 63; const float cr = Cc[2 * (o * 64 + p)], ci = Cc[2 * (o * 64 + p) + 1], pr_ = pw[2 * ((t + 1) * 64 + p)], pi_ = pw[2 * ((t + 1) * 64 + p) + 1];
                    v[j] = (q < 64) ? (cr * pr_ - ci * pi_) : -(cr * pi_ + ci * pr_); } }
            *(v4u*)(bm + (size_t)n * S5K + k0) = f32_to_bf16x8(v); }
        bf16* be = WSP(bf16, WS_S5END) + ((size_t)l * 32 + g) * 256 * 512;
        for (int e = tid; e < 256 * 64; e += 512) { const int n = e / 64, k0 = (e % 64) * 8, sidx = k0 >> 4, i0 = k0 & 15; float v[8];
            if (n < 128) { const int p = n & 63; const float pr_ = pw[2 * ((31 - sidx) * 64 + p)], pi_ = pw[2 * ((31 - sidx) * 64 + p) + 1];
#pragma unroll
                for (int j = 0; j < 8; ++j) { const float br = Bb[2 * (p * 16 + i0 + j)], bi = Bb[2 * (p * 16 + i0 + j) + 1]; v[j] = (n < 64) ? (pr_ * br - pi_ * bi) : (pr_ * bi + pi_ * br); } }
            else {
#pragma unroll
                for (int j = 0; j < 8; ++j) v[j] = 0.f; }
            *(v4u*)(be + (size_t)n * 512 + k0) = f32_to_bf16x8(v); }
        if (tid < 64) { float* a32 = WSP(float, WS_S5A32) + (size_t)((l * 32 + g) * 64 + tid) * 2; a32[0] = pw[2 * (32 * 64 + tid)]; a32[1] = pw[2 * (32 * 64 + tid) + 1]; }
        __syncthreads();
    }
}

struct LnGB { f32x4 g[4], b[4]; };
__device__ __forceinline__ LnGB ln_gb(const float* gam, const float* bet, int lane) { LnGB r;
#pragma unroll
    for (int j = 0; j < 4; ++j) { r.g[j] = *(const f32x4*)(gam + 4 * lane + 256 * j); r.b[j] = *(const f32x4*)(bet + 4 * lane + 256 * j); }
    return r; }
__device__ __forceinline__ void ln_core(f32x4 (&v)[4], const LnGB& gb) {
    float s = 0.f;
#pragma unroll
    for (int j = 0; j < 4; ++j) s += (v[j][0] + v[j][1]) + (v[j][2] + v[j][3]);
    const float mean = wave_sum(s) * (1.f / DM); float s2 = 0.f;
#pragma unroll
    for (int j = 0; j < 4; ++j) { v[j] = v[j] - mean; s2 += (v[j][0] * v[j][0] + v[j][1] * v[j][1]) + (v[j][2] * v[j][2] + v[j][3] * v[j][3]); }
    const float rstd = __builtin_amdgcn_rsqf(wave_sum(s2) * (1.f / DM) + LN_EPS);
#pragma unroll
    for (int j = 0; j < 4; ++j) v[j] = v[j] * rstd * gb.g[j] + gb.b[j];
}
__device__ __forceinline__ void ln_store(const f32x4 (&v)[4], float* xrow, bf16* xbrow, int lane) {
#pragma unroll
    for (int j = 0; j < 4; ++j) { if (xrow) *(f32x4*)(xrow + 4 * lane + 256 * j) = v[j]; if (xbrow) { v2u w; w.x = cvt_pk_bf16(v[j][0], v[j][1]); w.y = cvt_pk_bf16(v[j][2], v[j][3]); *(v2u*)(xbrow + 4 * lane + 256 * j) = w; } }
}
constexpr int LN_RB = 4;
typedef f16 f16x4_ln __attribute__((ext_vector_type(4)));
__device__ __forceinline__ void ln_phase(Frame& F, const float* gam, const float* bet, unsigned char* xq = nullptr) {
    const int lane = F.lane; const int gw = F.blk * NWAVES + F.wave, NGW = F.G * NWAVES; const f16* X = (const f16*)F.out; bf16* Xb = WSP(bf16, WS_XB);
    const LnGB gb = ln_gb(gam, bet, lane);
    for (int m = gw; m < M; m += LN_RB * NGW) { f16x4_ln h[LN_RB][4];
#pragma unroll
        for (int r = 0; r < LN_RB; ++r) { const int mr = (m + r * NGW < M) ? m + r * NGW : m;
#pragma unroll
            for (int j = 0; j < 4; ++j) h[r][j] = *(const f16x4_ln*)(X + (size_t)mr * DM + 4 * lane + 256 * j); }
#pragma unroll
        for (int r = 0; r < LN_RB; ++r) { const int mr = m + r * NGW; if (mr < M) { f32x4 v[4];
#pragma unroll
            for (int j = 0; j < 4; ++j) v[j] = (f32x4){(float)h[r][j][0], (float)h[r][j][1], (float)h[r][j][2], (float)h[r][j][3]};
            ln_core(v, gb); ln_store(v, nullptr, Xb + (size_t)mr * DM, lane);
            if (xq) {
#pragma unroll
                for (int j = 0; j < 4; ++j) { int w = 0; w = __builtin_amdgcn_cvt_pk_fp8_f32(v[j][0], v[j][1], w, false); w = __builtin_amdgcn_cvt_pk_fp8_f32(v[j][2], v[j][3], w, true);
                    *(int*)(xq + (size_t)mr * DM + 4 * lane + 256 * j) = w; } } } } }
}
__device__ __forceinline__ float* moe_tail_slab(Frame& F, int l) { return (l == NLAYER - 1) ? WSP(float, WS_S5MAIN) : (float*)((unsigned char*)F.out + 64 * MiB); }
__device__ __forceinline__ void ln2_moe_phase(Frame& F, const float* gam, const float* bet, int li, bool last, const float* slab) {
    const int lane = F.lane; const int gw = F.blk * NWAVES + F.wave, NGW = F.G * NWAVES; float* X = F.out; bf16* Xb = WSP(bf16, WS_XB);
    const unsigned* cnt = (const unsigned*)(F.ctl + CW_MOECNT + 64 * li); int pstart[NEXP]; { int acc = 0;
#pragma unroll
        for (int e = 0; e < NEXP; ++e) { pstart[e] = acc; acc += (int)(((cnt[e] + 255u) >> 8) << 8); } }
    const int* ppos = WSP(int, WS_PAIRPOS); const bf16* yp = WSP(bf16, WS_YPAIR);
    const LnGB gb = ln_gb(gam, bet, lane);
    int tailrk[NEXP];
#pragma unroll
    for (int e = 0; e < NEXP; ++e) tailrk[e] = (int)((cnt[e] >> 8) << 8);
    for (int m = gw; m < M; m += LN_RB * NGW) { int pp0[LN_RB], pp1[LN_RB]; bool tl0[LN_RB], tl1[LN_RB]; v2u xw[LN_RB][4], ya[LN_RB][4], yb[LN_RB][4];
#pragma unroll
        for (int r = 0; r < LN_RB; ++r) { tl0[r] = false; tl1[r] = false; }
#pragma unroll
        for (int r = 0; r < LN_RB; ++r) { const int mr = (m + r * NGW < M) ? m + r * NGW : m; pp0[r] = ppos[2 * mr]; pp1[r] = ppos[2 * mr + 1]; }
#pragma unroll
        for (int r = 0; r < LN_RB; ++r) { const int mr = (m + r * NGW < M) ? m + r * NGW : m; const int p0 = pp0[r], p1 = pp1[r]; int r0 = 0, r1 = 0;
#pragma unroll
            for (int e = 0; e < NEXP; ++e) { if ((p0 >> 24) == e) { r0 = pstart[e] + (p0 & 0xffffff); tl0[r] = (p0 & 0xffffff) >= tailrk[e]; } if ((p1 >> 24) == e) { r1 = pstart[e] + (p1 & 0xffffff); tl1[r] = (p1 & 0xffffff) >= tailrk[e]; } }
#pragma unroll
            for (int j = 0; j < 4; ++j) { xw[r][j] = *(const v2u*)(Xb + (size_t)mr * DM + 4 * lane + 256 * j);
                ya[r][j] = tl0[r] ? (v2u){0u, 0u} : *(const v2u*)(yp + (size_t)r0 * DM + 4 * lane + 256 * j); yb[r][j] = tl1[r] ? (v2u){0u, 0u} : *(const v2u*)(yp + (size_t)r1 * DM + 4 * lane + 256 * j); } }
#pragma unroll
        for (int r = 0; r < LN_RB; ++r) { const int mr = m + r * NGW; if (mr < M) { f32x4 v[4];
#pragma unroll
            for (int j = 0; j < 4; ++j) { const v2u x_ = xw[r][j], a = ya[r][j], b = yb[r][j]; const f32x4 x = (f32x4){bf_lo(x_.x), bf_hi(x_.x), bf_lo(x_.y), bf_hi(x_.y)};
                v[j] = x * ALPHA + (f32x4){bf_lo(a.x) + bf_lo(b.x), bf_hi(a.x) + bf_hi(b.x), bf_lo(a.y) + bf_lo(b.y), bf_hi(a.y) + bf_hi(b.y)}; }
            if (tl0[r] || tl1[r]) {
#pragma unroll
                for (int k2 = 0; k2 < 2; ++k2) { const int pk = k2 ? pp1[r] : pp0[r]; const bool tk = k2 ? tl1[r] : tl0[r];
                    if (tk) { const int e = pk >> 24, rl = (pk & 0xffffff) & 255;
#pragma unroll
                        for (int k0 = 0; k0 < MT_KS; k0 += 4) { f32x4 sv[4][4];
#pragma unroll
                            for (int kk = 0; kk < 4; ++kk) if (k0 + kk < MT_KS) { const float* sp = slab + ((size_t)((k0 + kk) * NEXP + e) * 256 + rl) * DM + 4 * lane;
#pragma unroll
                                for (int j = 0; j < 4; ++j) sv[kk][j] = *(const f32x4*)(sp + 256 * j); }
#pragma unroll
                            for (int kk = 0; kk < 4; ++kk) if (k0 + kk < MT_KS) {
#pragma unroll
                                for (int j = 0; j < 4; ++j) v[j] += sv[kk][j]; } } } } }
            ln_core(v, gb); ln_store(v, last ? X + (size_t)mr * DM : nullptr, last ? (bf16*)nullptr : Xb + (size_t)mr * DM, lane); } } }
}
__device__ __forceinline__ void ln1_moe_phase(Frame& F, const float* gam, const float* bet, int li) {
    const int lane = F.lane; float* X = F.out; bf16* Xb = WSP(bf16, WS_XB);
    LAS int* pe = (LAS int*)F.lds;
    LAS float* pwt = (LAS float*)(F.lds + 1024);
    LAS int* cntl = (LAS int*)(F.lds + 2048);
    const float* router = INP(float, 40) + (size_t)li * DM * NEXP;
    const LnGB gb = ln_gb(gam, bet, lane);
    LAS f32x4* rl = (LAS f32x4*)(F.lds + 4096);
    __syncthreads();
    for (int c = F.tid; c < DM; c += NWAVES * 64) { const int j = c >> 8, ln = (c & 255) >> 2, q = c & 3; const f32x4 ra = *(const f32x4*)(router + (size_t)c * NEXP), rb = *(const f32x4*)(router + (size_t)c * NEXP + 4);
        rl[((j * 4 + q) * 2 + 0) * 64 + ln] = ra; rl[((j * 4 + q) * 2 + 1) * 64 + ln] = rb; }
    for (int blk0 = F.blk; blk0 * 128 < M; blk0 += F.G) {
        __syncthreads();
        for (int i0 = 0; i0 < 16; i0 += LN_RB) { f16x4_ln hh[LN_RB][4];
#pragma unroll
          for (int r = 0; r < LN_RB; ++r)
#pragma unroll
            for (int j = 0; j < 4; ++j) hh[r][j] = *(const f16x4_ln*)((const f16*)X + (size_t)(blk0 * 128 + F.wave * 16 + i0 + r) * DM + 4 * lane + 256 * j);
#pragma unroll
          for (int r = 0; r < LN_RB; ++r) { const int i = i0 + r; const int tl = F.wave * 16 + i, m = blk0 * 128 + tl; f32x4 v[4];
#pragma unroll
            for (int j = 0; j < 4; ++j) v[j] = (f32x4){(float)hh[r][j][0], (float)hh[r][j][1], (float)hh[r][j][2], (float)hh[r][j][3]};
            ln_core(v, gb); ln_store(v, nullptr, Xb + (size_t)m * DM, lane);
            if (FP8_MOE) { unsigned char* xq = F.ws + WS_XQM;
#pragma unroll
                for (int j = 0; j < 4; ++j) { int w = 0; w = __builtin_amdgcn_cvt_pk_fp8_f32(v[j][0], v[j][1], w, false); w = __builtin_amdgcn_cvt_pk_fp8_f32(v[j][2], v[j][3], w, true);
                    *(int*)(xq + (size_t)m * DM + 4 * lane + 256 * j) = w; } }
            float lg[NEXP];
#pragma unroll
            for (int e = 0; e < NEXP; ++e) lg[e] = 0.f;
#pragma unroll
            for (int j = 0; j < 4; ++j)
#pragma unroll
                for (int q = 0; q < 4; ++q) { const float xv = v[j][q]; const f32x4 ra = rl[((j * 4 + q) * 2 + 0) * 64 + lane], rb = rl[((j * 4 + q) * 2 + 1) * 64 + lane];
                    lg[0] += xv * ra[0]; lg[1] += xv * ra[1]; lg[2] += xv * ra[2]; lg[3] += xv * ra[3]; lg[4] += xv * rb[0]; lg[5] += xv * rb[1]; lg[6] += xv * rb[2]; lg[7] += xv * rb[3]; }
#pragma unroll
            for (int e = 0; e < NEXP; ++e) lg[e] = wave_sum(lg[e]);
            int e0 = 0; float l0 = lg[0];
#pragma unroll
            for (int e = 1; e < NEXP; ++e) if (lg[e] > l0) { l0 = lg[e]; e0 = e; }
            int e1 = -1; float l1 = -INFINITY;
#pragma unroll
            for (int e = 0; e < NEXP; ++e) if (e != e0 && lg[e] > l1) { l1 = lg[e]; e1 = e; }
            const float w1 = 1.0f / (1.0f + expf(l0 - l1)), w0 = 1.0f - w1;
            if (lane == 0) { pe[2 * tl] = e0; pe[2 * tl + 1] = e1; pwt[2 * tl] = w0; pwt[2 * tl + 1] = w1; }
          } }
        __syncthreads();
        int myrank = 0, mye = 0;
        if (F.tid < 256) { mye = pe[F.tid]; for (int q = 0; q < F.tid; ++q) myrank += (pe[q] == mye) ? 1 : 0; }
        if (F.tid < NEXP) { int c = 0; for (int q = 0; q < 256; ++q) c += (pe[q] == F.tid) ? 1 : 0; cntl[F.tid] = c; cntl[8 + F.tid] = 0;
            (void)__hip_atomic_fetch_add((unsigned*)(F.ctl + CW_MOECNT + 64 * li + F.tid), (unsigned)c, RLX_AGENT);
            __hip_atomic_store((unsigned*)(F.ctl + CW_MOETAB + (li * 256 + blk0) * 8 + F.tid), (unsigned)c | 0x80000000u, RLX_AGENT); }
        __syncthreads();
        for (int t = F.tid; t < blk0 * NEXP; t += NWAVES * 64) { unsigned* w = (unsigned*)(F.ctl + CW_MOETAB + li * 256 * 8 + t); unsigned v = __hip_atomic_load(w, RLX_AGENT); unsigned sp = 0;
            while (!(v >> 31)) { __builtin_amdgcn_s_sleep(1); v = __hip_atomic_load(w, RLX_AGENT); if (++sp > (1u << 22)) break; }
            (void)__hip_atomic_fetch_add((LAS unsigned*)&cntl[8 + (t & 7)], v & 0x7fffffffu, __ATOMIC_RELAXED, __HIP_MEMORY_SCOPE_WORKGROUP); }
        __syncthreads();
        if (F.tid < 256) { const int rk = cntl[8 + mye] + myrank; const int m = blk0 * 128 + (F.tid >> 1);
            WSP(int, WS_SLOTTOK)[(size_t)mye * MOE_CAP + rk] = m; WSP(float, WS_SLOTW)[(size_t)mye * MOE_CAP + rk] = pwt[F.tid]; WSP(int, WS_PAIRPOS)[blk0 * 256 + F.tid] = (mye << 24) | rk; }
    }
    __syncthreads();
}
constexpr int AT_QR = 256;
constexpr int AK_SLOT = 12288, AV_SLOT = 8192;
constexpr int AT_K = 0, AT_V = 4 * AK_SLOT, AT_WSF = AT_V + 3 * AV_SLOT, AT_OST = AT_WSF + NWAVES * 256, AT_LDS = AT_OST + NWAVES * 4096;
typedef LAS const unsigned char* at_lptr;
__device__ __forceinline__ int crow(int r, int hi) { return (r & 3) + 8 * (r >> 2) + 4 * hi; }
__device__ __forceinline__ void at_dma(const void* sbase, unsigned voff, unsigned dst) {
    unsigned keep;
    asm volatile("s_mov_b32 %0, m0\n\ts_mov_b32 m0, %3\n\ts_nop 0\n\tglobal_load_lds_dwordx4 %1, %2\n\ts_mov_b32 m0, %0" : "=&s"(keep) : "v"(voff), "s"(sbase), "s"(dst) : "memory");
}
__device__ __forceinline__ s16x4 at_vtr(at_lptr p) { return __builtin_bit_cast(s16x4, __builtin_amdgcn_ds_read_tr16_b64_v4i16((LAS s16x4*)p)); }
__device__ __forceinline__ void at_kload2(bf16x8* kf, at_lptr kp, int j) { kf[2 * j] = *(const LAS bf16x8*)(kp + j * 2048); kf[2 * j + 1] = *(const LAS bf16x8*)(kp + j * 2048 + 512); }
#define AT_MX3(a, b, c) __builtin_fmaxf(__builtin_fmaxf((a), (b)), (c))
__device__ __forceinline__ float at_rowmax(const f32x16& p0, const f32x16& p1) {
    float a = AT_MX3(p0[0], p0[1], p1[0]), b = AT_MX3(p0[2], p0[3], p1[1]); a = AT_MX3(a, p1[2], p1[3]);
#pragma unroll
    for (int r = 4; r < 16; r += 4) { a = AT_MX3(a, p0[r], p0[r + 1]); b = AT_MX3(b, p0[r + 2], p0[r + 3]); a = AT_MX3(a, p1[r], p1[r + 1]); b = AT_MX3(b, p1[r + 2], p1[r + 3]); }
    const float m = __builtin_fmaxf(a, b); auto rr = __builtin_amdgcn_permlane32_swap(__float_as_uint(m), __float_as_uint(m), false, false);
    return __builtin_fmaxf(__uint_as_float(rr[0]), __uint_as_float(rr[1]));
}
__device__ __forceinline__ void at_cmask(f32x16& p0, f32x16& p1, int jb, int qrel, int hi) {
    const int kb = 64 * jb + 4 * hi;
#pragma unroll
    for (int r = 0; r < 16; ++r) { const int kv = kb + (r & 3) + 8 * (r >> 2); if (kv > qrel) p0[r] = -INFINITY; if (kv + 32 > qrel) p1[r] = -INFINITY; }
}
#define AT_SBAR() __builtin_amdgcn_sched_barrier(0)
#define AT_PIN(x) asm volatile("" : "+v"(x))
#define AT_MFMA(a, b, c) __builtin_amdgcn_mfma_f32_32x32x16_bf16(a, b, c, 0, 0, 0)
#define AT_WAIT_BAR(N) asm volatile("s_waitcnt vmcnt(" #N ") lgkmcnt(0)\n\ts_barrier" ::: "memory")

__device__ __forceinline__ void attn_unit(int tid, int b, int h, int qb, const bf16* Q, const bf16* K, const bf16* V, bf16* O, LAS unsigned char* lds) {
    const int lane = tid & 63, r32 = lane & 31, hi = lane >> 5; const int wid = __builtin_amdgcn_readfirstlane(tid >> 6);
    const size_t rowbase = (size_t)b * SEQ; const int q0 = qb * AT_QR; const int NT = (q0 + AT_QR) / 64;
    const unsigned lds0 = (unsigned)(uintptr_t)lds;
    LAS float* wsf = (LAS float*)(lds + AT_WSF) + wid * 64;
    const size_t bh0 = (size_t)(b * NH + h) * (SEQ / 64);
    const bf16* kbA = K + bh0 * 6144 + wid * 512;
    const bf16* kbB = K + bh0 * 6144 + (8 + (wid & 3)) * 512;
    const bf16* vbs = V + bh0 * 4096 + (wid >> 2) * 2048 + (wid & 3) * 512;
#define AT_LANE() ({ int l_; asm volatile("v_mbcnt_lo_u32_b32 %0, -1, 0\n\tv_mbcnt_hi_u32_b32 %0, -1, %0" : "=v"(l_)); l_; })
#define AT_KVO() ((unsigned)AT_LANE() * 16u)
#define AT_VVO() ((unsigned)AT_LANE() * 16u)
    const unsigned kdA = lds0 + AT_K + wid * 1024, kdB = lds0 + AT_K + (8 + (wid & 3)) * 1024, vds = lds0 + AT_V + wid * 1024;
#define AT_DMA_K(t) do { const unsigned ks_ = (unsigned)((t) & 3) * AK_SLOT; const unsigned kvo_ = AT_KVO(); at_dma(kbA + (size_t)(t) * 6144, kvo_, kdA + ks_); at_dma(kbB + (size_t)(t) * 6144, kvo_, kdB + ks_); } while (0)
#define AT_DMA_V(t, slot) at_dma(vbs + (size_t)(t) * 4096, AT_VVO(), vds + (slot))
    const at_lptr kp0 = (at_lptr)lds + AT_K + hi * 1024 + r32 * 16;
    const at_lptr vp0 = (at_lptr)lds + AT_V + ((lane >> 4) & 1) * 32 + (lane & 3) * 8 + (4 * hi + ((lane & 15) >> 2)) * 64;
    AT_DMA_K(0); AT_DMA_V(0, 0); AT_DMA_K(1);
    bf16x8 qr[6];
    { const bf16* qp = Q + (rowbase + q0 + wid * 32 + r32) * 768 + h * 96 + hi * 8;
#pragma unroll
      for (int d0 = 0; d0 < 6; ++d0) qr[d0] = *(const bf16x8*)(qp + d0 * 16); }
    AT_DMA_K(2);
    float mhat = 0.f, l_reg = 0.f; f32x16 o[2];
#pragma unroll
    for (int r = 0; r < 16; ++r) { o[0][r] = 0.f; o[1][r] = 0.f; }
    const f32x16 zero16 = {0.f, 0.f, 0.f, 0.f, 0.f, 0.f, 0.f, 0.f, 0.f, 0.f, 0.f, 0.f, 0.f, 0.f, 0.f, 0.f};
    f32x16 negm = zero16; AT_PIN(negm);
    const int qrel = wid * 32 + r32; bool resc = false;
    f32x16 pA0, pA1, pB0, pB1; bf16x8 kf[8]; s16x4 vlo[8], vhi[8]; v4u pw0, pw1, pw2, pw3;
    int sl_prev = 0, sl_cur = 0, sl_next = AV_SLOT;
#define AT_ROT() do { sl_prev = sl_cur; sl_cur = sl_next; sl_next = (sl_next == 2 * AV_SLOT) ? 0 : sl_next + AV_SLOT; } while (0)
#define AT_EX(v) __builtin_amdgcn_exp2f(v)
#define AT_RESC() do { if (resc) { const int h_ = AT_LANE() >> 5; _Pragma("unroll") for (int d_ = 0; d_ < 2; ++d_) _Pragma("unroll") for (int r = 0; r < 16; ++r) o[d_][r] *= wsf[crow(r, h_)]; } } while (0)
    AT_WAIT_BAR(2);
    { bf16x8 k0[12];
#pragma unroll
      for (int d0 = 0; d0 < 6; ++d0) at_kload2(k0, kp0, d0);
      pA0 = AT_MFMA(k0[0], qr[0], zero16); pA1 = AT_MFMA(k0[1], qr[0], zero16);
#pragma unroll
      for (int d0 = 1; d0 < 6; ++d0) { pA0 = AT_MFMA(k0[2 * d0], qr[d0], pA0); pA1 = AT_MFMA(k0[2 * d0 + 1], qr[d0], pA1); } }
    if (NT == 4) at_cmask(pA0, pA1, 0, qrel, hi);
    { const float rm = at_rowmax(pA0, pA1); mhat = rm;
#pragma unroll
      for (int r = 0; r < 16; ++r) negm[r] = -mhat;
      AT_PIN(negm);
#pragma unroll
      for (int r = 0; r < 16; ++r) { pA0[r] = AT_EX(pA0[r] - rm); pA1[r] = AT_EX(pA1[r] - rm); } }
    AT_WAIT_BAR(0);
    AT_DMA_K(3); AT_DMA_V(1, AV_SLOT); AT_ROT();
#pragma unroll
    for (int d0 = 0; d0 < 4; ++d0) at_kload2(kf, kp0 + AK_SLOT, d0);
    AT_WAIT_BAR(3);
#define AT_PKW(P, i) cvt_pk_bf16(P[i], P[(i) + 1])
#define AT_PAF(k) __builtin_bit_cast(bf16x8, pw##k)
#define AT_VFR(i) (bf16x8){vlo[i][0], vlo[i][1], vlo[i][2], vlo[i][3], vhi[i][0], vhi[i][1], vhi[i][2], vhi[i][3]}
#define AT_VRD(i) do { vlo[i] = at_vtr(vp_ + (((i) >> 2) * 4096 + ((i) & 3) * 1024)); vhi[i] = at_vtr(vp_ + (((i) >> 2) * 4096 + ((i) & 3) * 1024 + 512)); } while (0)
#define AT_KRD(G, j) do { if (G) { at_kload2(kf, kn_, j); AT_SBAR(); } } while (0)
#define AT_GAP3(MF, a0, a1, a2, W0, W1, PW) do { MF; sacc += a0; sacc += a1; sacc += a2; AT_PIN(sacc); W0; W1; AT_PIN(PW); AT_SBAR(); } while (0)
#define AT_GAP2W(MF, a0, a1, W0, W1, PW) do { MF; sacc += a0; sacc += a1; AT_PIN(sacc); W0; W1; AT_PIN(PW); AT_SBAR(); } while (0)
#define AT_GAP2(MF, a0, a1) do { MF; sacc += a0; sacc += a1; AT_PIN(sacc); AT_SBAR(); } while (0)
#define AT_GAPB(MF, X, i) do { MF; X[i] = AT_EX(X[i]); X[(i) + 1] = AT_EX(X[(i) + 1]); X[(i) + 2] = AT_EX(X[(i) + 2]); X[(i) + 3] = AT_EX(X[(i) + 3]); AT_PIN(X); AT_SBAR(); } while (0)
#define AT_STEP(C0, C1, P0, P1, t, MASK, GK, GV, GL) do { AT_SBAR(); \
    const int ln_ = AT_LANE(), hi_ = ln_ >> 5, r32_ = ln_ & 31; \
    const at_lptr kp_ = (at_lptr)lds + AT_K + hi_ * 1024 + r32_ * 16; const at_lptr vp_ = (at_lptr)lds + AT_V + ((ln_ >> 4) & 1) * 32 + (ln_ & 3) * 8 + (4 * hi_ + ((ln_ & 15) >> 2)) * 64 + sl_prev; \
    const at_lptr kc_ = kp_ + ((t) & 3) * AK_SLOT; const at_lptr kn_ = kp_ + (((t) + 1) & 3) * AK_SLOT; bf16x8 kg[4]; \
    AT_VRD(0); AT_SBAR(); float sacc = P0[0] + P0[1]; \
                       AT_GAP3(C0 = AT_MFMA(kf[0], qr[0], negm), P0[2], P0[3], P0[4],    pw0[0] = AT_PKW(P0, 0),  pw0[1] = AT_PKW(P0, 2),  pw0); \
    AT_VRD(4); AT_SBAR(); AT_GAP3(C1 = AT_MFMA(kf[1], qr[0], negm), P0[5], P0[6], P0[7],    pw0[2] = AT_PKW(P0, 4),  pw0[3] = AT_PKW(P0, 6),  pw0); \
    AT_VRD(1); AT_SBAR(); AT_GAP3(C0 = AT_MFMA(kf[2], qr[1], C0),     P0[8], P0[9], P0[10],   pw1[0] = AT_PKW(P0, 8),  pw1[1] = AT_PKW(P0, 10), pw1); \
    AT_VRD(5); AT_SBAR(); AT_GAP3(C1 = AT_MFMA(kf[3], qr[1], C1),     P0[11], P0[12], P0[13], pw1[2] = AT_PKW(P0, 12), pw1[3] = AT_PKW(P0, 14), pw1); \
    at_kload2(kg, kc_ + 4 * 2048, 0); AT_SBAR();                                                                                \
    AT_VRD(2); AT_SBAR(); AT_GAP3(C0 = AT_MFMA(kf[4], qr[2], C0),     P0[14], P0[15], P1[0],  pw2[0] = AT_PKW(P1, 0),  pw2[1] = AT_PKW(P1, 2),  pw2); \
    at_kload2(kg, kc_ + 4 * 2048, 1); AT_SBAR();                                                                                \
    AT_VRD(6); AT_SBAR(); AT_GAP3(C1 = AT_MFMA(kf[5], qr[2], C1),     P1[1], P1[2], P1[3],    pw2[2] = AT_PKW(P1, 4),  pw2[3] = AT_PKW(P1, 6),  pw2); \
    AT_VRD(3); AT_SBAR(); AT_GAP2W(C0 = AT_MFMA(kf[6], qr[3], C0),    P1[4], P1[5],           pw3[0] = AT_PKW(P1, 8),  pw3[1] = AT_PKW(P1, 10), pw3); \
    AT_VRD(7); AT_SBAR(); AT_GAP2W(C1 = AT_MFMA(kf[7], qr[3], C1),    P1[6], P1[7],           pw3[2] = AT_PKW(P1, 12), pw3[3] = AT_PKW(P1, 14), pw3); \
    AT_GAP2(C0 = AT_MFMA(kg[0], qr[4], C0), P1[8], P1[9]); \
    AT_GAP2(C1 = AT_MFMA(kg[1], qr[4], C1), P1[10], P1[11]); \
    AT_GAP2(C0 = AT_MFMA(kg[2], qr[5], C0), P1[12], P1[13]); \
    AT_GAP2(C1 = AT_MFMA(kg[3], qr[5], C1), P1[14], P1[15]); \
    l_reg += sacc; \
    if (GK) AT_DMA_K((t) + 3); if (GV) AT_DMA_V((t) + 1, sl_next); \
    if (MASK) { const int jb_ = (t) - (NT - 4); if (jb_ >= 0) at_cmask(C0, C1, jb_, wid * 32 + r32_, hi_); } \
    { const float rm = at_rowmax(C0, C1); resc = false;                                                                         \
      if (__builtin_expect(__any(rm > 8.0f), 0)) { const float dl = __builtin_fmaxf(rm, 0.f); mhat += dl;                       \
          _Pragma("unroll") for (int r = 0; r < 16; ++r) { C0[r] -= dl; C1[r] -= dl; } \
          _Pragma("unroll") for (int r = 0; r < 16; ++r) negm[r] = -mhat; \
          AT_PIN(negm); \
          const float f = __builtin_amdgcn_exp2f(-dl); l_reg *= f; if (hi_ == 0) wsf[r32_] = f; resc = true; } } \
    AT_SBAR(); \
    AT_GAPB(o[0] = AT_MFMA(AT_PAF(0), AT_VFR(0), o[0]), C0, 0);               AT_GAPB(o[1] = AT_MFMA(AT_PAF(0), AT_VFR(4), o[1]), C0, 4); \
    AT_KRD(GL, 0); AT_GAPB(o[0] = AT_MFMA(AT_PAF(1), AT_VFR(1), o[0]), C0, 8);  AT_KRD(GL, 1); AT_GAPB(o[1] = AT_MFMA(AT_PAF(1), AT_VFR(5), o[1]), C0, 12); \
    AT_KRD(GL, 2); AT_GAPB(o[0] = AT_MFMA(AT_PAF(2), AT_VFR(2), o[0]), C1, 0);  AT_KRD(GL, 3); AT_GAPB(o[1] = AT_MFMA(AT_PAF(2), AT_VFR(6), o[1]), C1, 4); \
    AT_GAPB(o[0] = AT_MFMA(AT_PAF(3), AT_VFR(3), o[0]), C1, 8);               AT_GAPB(o[1] = AT_MFMA(AT_PAF(3), AT_VFR(7), o[1]), C1, 12); \
    } while (0)
    int t = 1;
    for (; t + 5 < NT; t += 2) {
        AT_STEP(pB0, pB1, pA0, pA1, t, false, true, true, true);     AT_WAIT_BAR(3); AT_RESC(); AT_ROT();
        AT_STEP(pA0, pA1, pB0, pB1, t + 1, false, true, true, true); AT_WAIT_BAR(3); AT_RESC(); AT_ROT();
    }
#define AT_ENDW(tt) do { if ((tt) + 3 < NT) { AT_WAIT_BAR(3); } else if ((tt) + 2 < NT) { AT_WAIT_BAR(1); } else { AT_WAIT_BAR(0); } } while (0)
    for (; t + 1 < NT; t += 2) {
        AT_STEP(pB0, pB1, pA0, pA1, t, true, (t + 3 < NT), (t + 1 < NT), (t + 1 < NT));         AT_ENDW(t);     AT_RESC(); AT_ROT();
        AT_STEP(pA0, pA1, pB0, pB1, t + 1, true, (t + 4 < NT), (t + 2 < NT), (t + 2 < NT));     AT_ENDW(t + 1); AT_RESC(); AT_ROT();
    }
    AT_STEP(pB0, pB1, pA0, pA1, NT - 1, true, false, false, false); AT_RESC();
    { float sacc = pB0[0] + pB0[1];
#pragma unroll
      for (int r = 2; r < 16; ++r) sacc += pB0[r];
#pragma unroll
      for (int r = 0; r < 16; ++r) sacc += pB1[r];
      l_reg += sacc;
      pw0 = (v4u){AT_PKW(pB0, 0), AT_PKW(pB0, 2), AT_PKW(pB0, 4), AT_PKW(pB0, 6)}; pw1 = (v4u){AT_PKW(pB0, 8), AT_PKW(pB0, 10), AT_PKW(pB0, 12), AT_PKW(pB0, 14)};
      pw2 = (v4u){AT_PKW(pB1, 0), AT_PKW(pB1, 2), AT_PKW(pB1, 4), AT_PKW(pB1, 6)}; pw3 = (v4u){AT_PKW(pB1, 8), AT_PKW(pB1, 10), AT_PKW(pB1, 12), AT_PKW(pB1, 14)};
      const int ln_ = AT_LANE(); const at_lptr vp_ = (at_lptr)lds + AT_V + ((ln_ >> 4) & 1) * 32 + (ln_ & 3) * 8 + (4 * (ln_ >> 5) + ((ln_ & 15) >> 2)) * 64 + sl_cur;
#pragma unroll
      for (int i = 0; i < 8; ++i) AT_VRD(i);
      o[0] = AT_MFMA(AT_PAF(0), AT_VFR(0), o[0]); o[1] = AT_MFMA(AT_PAF(0), AT_VFR(4), o[1]); o[0] = AT_MFMA(AT_PAF(1), AT_VFR(1), o[0]); o[1] = AT_MFMA(AT_PAF(1), AT_VFR(5), o[1]);
      o[0] = AT_MFMA(AT_PAF(2), AT_VFR(2), o[0]); o[1] = AT_MFMA(AT_PAF(2), AT_VFR(6), o[1]); o[0] = AT_MFMA(AT_PAF(3), AT_VFR(3), o[0]); o[1] = AT_MFMA(AT_PAF(3), AT_VFR(7), o[1]); }
    { auto rr = __builtin_amdgcn_permlane32_swap(__float_as_uint(l_reg), __float_as_uint(l_reg), false, false); l_reg = __uint_as_float(rr[0]) + __uint_as_float(rr[1]); }
    const int lane_e = AT_LANE(), r32e = lane_e & 31, hie = lane_e >> 5;
    if (hie == 0) wsf[32 + r32e] = l_reg;
    LDS_WAIT();
#pragma unroll
    for (int r = 0; r < 16; ++r) { const int orow = crow(r, hie); const float rl = __builtin_amdgcn_rcpf(wsf[32 + orow]);
#pragma unroll
        for (int d0 = 0; d0 < 2; ++d0) { const unsigned u = cvt_pk_bf16(o[d0][r] * rl, 0.f); ((LAS bf16*)(lds + AT_OST + wid * 4096))[orow * 64 + d0 * 32 + r32e] = (bf16)(u & 0xffffu); } }
    LDS_WAIT();
    { bf16* Ow = O + (rowbase + q0 + wid * 32) * 512 + h * 64;
#pragma unroll
      for (int i = 0; i < 4; ++i) { const int row = i * 8 + (lane_e >> 3), ch = lane_e & 7; const v4u v = *(const LAS v4u*)(lds + AT_OST + wid * 4096 + (row * 64 + ch * 8) * 2); *(v4u*)(Ow + (size_t)row * 512 + ch * 8) = v; } }
    asm volatile("s_waitcnt lgkmcnt(0)\n\ts_barrier" ::: "memory");
#undef AT_DMA_K
#undef AT_KVO
#undef AT_LANE
#undef AT_VVO
#undef AT_DMA_V
#undef AT_ROT
#undef AT_EX
#undef AT_RESC
#undef AT_PKW
#undef AT_PAF
#undef AT_VFR
#undef AT_VRD
#undef AT_KRD
#undef AT_ENDW
#undef AT_GAP3
#undef AT_GAP2W
#undef AT_GAP2
#undef AT_GAPB
#undef AT_STEP
}

template <int CTRL> __device__ __forceinline__ float dpp_add(float v) { return v + __builtin_bit_cast(float, __builtin_amdgcn_update_dpp(0, __builtin_bit_cast(int, v), CTRL, 0xF, 0xF, true)); }
constexpr int RW_TC = 64, RW_STREAM = RW_TC * 64 * 2  , RW_BUF = 6 * RW_STREAM  , RW_YOFF = 2 * RW_BUF  , RW_LDS = RW_YOFF + 2 * RW_STREAM;
constexpr int RW_SPLIT = 2, RW_CW = 4  , RW_ROWS = 64 / RW_SPLIT, RW_RPW = RW_ROWS / RW_CW, RW_LPR = 64 / RW_RPW  , RW_CPL = 64 / RW_LPR  ;
typedef f16 f16xc __attribute__((ext_vector_type(RW_CPL)));
struct RwIn { f16xc r, k, a, b, d; f16 v; };
__device__ __forceinline__ void rw_lds_read(RwIn& x, const LAS unsigned char* buf, int tt, int cg, int row) {
    const LAS unsigned char* p = buf + tt * 128 + cg * (RW_CPL * 2);
    x.r = *(const LAS f16xc*)(p); x.k = *(const LAS f16xc*)(p + RW_STREAM); x.a = *(const LAS f16xc*)(p + 2 * RW_STREAM); x.b = *(const LAS f16xc*)(p + 3 * RW_STREAM); x.d = *(const LAS f16xc*)(p + 4 * RW_STREAM);
    x.v = *(const LAS f16*)(buf + 5 * RW_STREAM + tt * 128 + row * 2);
}
__device__ __forceinline__ void rwkv_scan(Frame& F, int unit) {
    const int bh = unit / RW_SPLIT, part = unit % RW_SPLIT;
    const int tid = F.tid, lane = F.lane, rl = lane / RW_LPR, cg = lane % RW_LPR, b = bh >> 3, h = bh & 7, row = part * RW_ROWS + F.wave * RW_RPW + rl;
    const f16* R = WSP(f16, WS_R); const f16* KH = WSP(f16, WS_KH); const f16* KKN = WSP(f16, WS_KKN); const f16* BV = WSP(f16, WS_BV); const f16* DCY = WSP(f16, WS_DCY); const f16* VF = WSP(f16, WS_VFIN);
    f16* Y = WSP(f16, WS_YRW);
    const size_t base = (size_t)b * SEQ * 512 + h * 64;
    LAS unsigned char* lds = F.lds;
    const int ts = tid >> 3, pc = tid & 7;
    const size_t goff = base + (size_t)ts * 512 + pc * 8;
    const int loff = ts * 128 + pc * 16;
    v4u g[6];
#define RW_GLOAD(t0) do { const size_t o = goff + (size_t)(t0) * 512; const size_t oa = ((t0) + ts + 1 < SEQ) ? o + 512 : o; \
        g[0] = *(const v4u*)(R + o); g[1] = *(const v4u*)(KH + o); g[2] = *(const v4u*)(KKN + oa); g[3] = *(const v4u*)(BV + o); g[4] = *(const v4u*)(DCY + o); g[5] = *(const v4u*)(VF + o); } while (0)
#define RW_LSTORE(bufoff) do { _Pragma("unroll") for (int s_ = 0; s_ < 6; ++s_) *(LAS v4u*)(lds + (bufoff) + s_ * RW_STREAM + loff) = g[s_]; } while (0)
    typedef f16 h2 __attribute__((ext_vector_type(2)));
    h2 S2[RW_CPL / 2];
#pragma unroll
    for (int j = 0; j < RW_CPL / 2; ++j) S2[j] = (h2){(f16)0.f, (f16)0.f};
    float sa = 0.f;
    __syncthreads();
    RW_GLOAD(0); RW_LSTORE(0);
    __syncthreads();
    for (int c = 0; c < SEQ / RW_TC; ++c) {
        const int cur = (c & 1) * RW_BUF, nxt = ((c + 1) & 1) * RW_BUF; const bool more = (c + 1 < SEQ / RW_TC);
        if (more) RW_GLOAD((c + 1) * RW_TC);
        const LAS unsigned char* buf = lds + cur;
        if (F.wave < RW_CW) {
        RwIn x0, x1, x2; rw_lds_read(x0, buf, 0, cg, row); rw_lds_read(x1, buf, 1, cg, row);
        float ykeep = 0.f;
#define RW_STEP(X, TT) do { \
            const h2 sa2 = {(f16)sa, (f16)sa}, v2 = {X.v, X.v}; float yp = 0.f, sp = 0.f; \
            _Pragma("unroll") for (int j = 0; j < RW_CPL / 2; ++j) { const h2 d2 = {X.d[2 * j], X.d[2 * j + 1]}, b2 = {X.b[2 * j], X.b[2 * j + 1]}, k2 = {X.k[2 * j], X.k[2 * j + 1]}, r2 = {X.r[2 * j], X.r[2 * j + 1]}, a2 = {X.a[2 * j], X.a[2 * j + 1]}; \
                h2 sj = S2[j]; sj = __builtin_elementwise_fma(-sj, d2, sj); sj = __builtin_elementwise_fma(sa2, b2, sj); sj = __builtin_elementwise_fma(v2, k2, sj); S2[j] = sj; \
                yp = __builtin_amdgcn_fdot2(sj, r2, yp, false); sp = __builtin_amdgcn_fdot2(sj, a2, sp, false); } \
            yp = dpp_add<0xB1>(yp); sp = dpp_add<0xB1>(sp); \
            yp = dpp_add<0x4E>(yp); sp = dpp_add<0x4E>(sp); \
            if (RW_LPR >= 8) { yp = dpp_add<0x141>(yp); sp = dpp_add<0x141>(sp); } \
            if (RW_LPR >= 16) { yp = dpp_add<0x140>(yp); sp = dpp_add<0x140>(sp); } \
            sa = -sp; ykeep = (cg == ((TT) & 3)) ? yp : ykeep; } while (0)
        for (int tt = 0; tt < RW_TC; tt += 4) {
            rw_lds_read(x2, buf, (tt + 2) & (RW_TC - 1), cg, row); RW_STEP(x0, tt);
            rw_lds_read(x0, buf, (tt + 3) & (RW_TC - 1), cg, row); RW_STEP(x1, tt + 1);
            rw_lds_read(x1, buf, (tt + 4) & (RW_TC - 1), cg, row); RW_STEP(x2, tt + 2);
            rw_lds_read(x2, buf, (tt + 5) & (RW_TC - 1), cg, row); RW_STEP(x0, tt + 3);
            if (cg < 4) *(LAS f16*)(lds + RW_YOFF + (c & 1) * RW_STREAM + (tt + cg) * 128 + row * 2) = (f16)ykeep;
            x0 = x1; x1 = x2;
        }
#undef RW_STEP
        }
        if (more) RW_LSTORE(nxt);
        __syncthreads();
        if (pc >= part * (8 / RW_SPLIT) && pc < (part + 1) * (8 / RW_SPLIT)) { const v4u yv = *(const LAS v4u*)(lds + RW_YOFF + (c & 1) * RW_STREAM + loff); *(v4u*)(Y + base + (size_t)(c * RW_TC + ts) * 512 + pc * 8) = yv; }
    }
    __syncthreads();
#undef RW_GLOAD
#undef RW_LSTORE
}
__device__ __forceinline__ void s5_carry(Frame& F, int l, int idx) {
    const int p = idx & 63, g = (idx >> 6) & 31, b = idx >> 11;
    const float* a32 = WSP(float, WS_S5A32) + (size_t)((l * 32 + g) * 64 + p) * 2; const float ar = a32[0], ai = a32[1];
    const float* xe = WSP(float, WS_XEND) + ((size_t)g * S5CH + b * S5NC) * 128; bf16* u = WSP(bf16, WS_S5U) + ((size_t)g * S5CH + b * S5NC) * S5K + 512;
    float xr = 0.f, xi = 0.f;
    for (int c0 = 0; c0 < S5NC; c0 += 8) { float er[8], ei[8];
#pragma unroll
        for (int c = 0; c < 8; ++c) { er[c] = xe[(size_t)(c0 + c) * 128 + p]; ei[c] = xe[(size_t)(c0 + c) * 128 + 64 + p]; }
#pragma unroll
        for (int c = 0; c < 8; ++c) { bf16* up = u + (size_t)(c0 + c) * S5K; up[p] = (bf16)(cvt_pk_bf16(xr, 0.f) & 0xffffu); up[64 + p] = (bf16)(cvt_pk_bf16(xi, 0.f) & 0xffffu);
            const float nr = ar * xr - ai * xi + er[c], ni = ar * xi + ai * xr + ei[c]; xr = nr; xi = ni; } }
}
__device__ __forceinline__ void rwkv_post(Frame& F, int l) {
    const int lane = F.lane; const int gw = F.blk * NWAVES + F.wave, NGW = F.G * NWAVES;
    float lg[8], lb[8], rk[8]; ld8f(INP(float, 16) + l * 512 + 8 * lane, lg); ld8f(INP(float, 17) + l * 512 + 8 * lane, lb); ld8f(INP(float, 15) + l * 512 + 8 * lane, rk);
    for (int m = gw; m < M; m += NGW) { const size_t off = (size_t)m * 512 + 8 * lane; float y[8], r[8], k[8], v[8], g[8], o[8];
        f16x8_to_f32(*(const f16x8*)(WSP(f16, WS_YRW) + off), y); f16x8_to_f32(*(const f16x8*)(WSP(f16, WS_R) + off), r); f16x8_to_f32(*(const f16x8*)(WSP(f16, WS_KH) + off), k);
        f16x8_to_f32(*(const f16x8*)(WSP(f16, WS_VFIN) + off), v); bf16x8_to_f32(*(const v4u*)(WSP(bf16, WS_GL) + off), g);
        float s = 0.f, bs = 0.f;
#pragma unroll
        for (int j = 0; j < 8; ++j) { s += y[j]; bs += r[j] * k[j] * rk[j]; }
        s += mk_shfl_xor(s, 1); s += mk_shfl_xor(s, 2); s += mk_shfl_xor(s, 4); bs += mk_shfl_xor(bs, 1); bs += mk_shfl_xor(bs, 2); bs += mk_shfl_xor(bs, 4);
        const float mean = s * (1.0f / 64.0f); float q = 0.f;
#pragma unroll
        for (int j = 0; j < 8; ++j) { y[j] -= mean; q += y[j] * y[j]; }
        q += mk_shfl_xor(q, 1); q += mk_shfl_xor(q, 2); q += mk_shfl_xor(q, 4);
        const float rstd = 1.0f / sqrtf(q * (1.0f / 64.0f) + 64e-5f);
#pragma unroll
        for (int j = 0; j < 8; ++j) o[j] = (y[j] * rstd * lg[j] + lb[j] + bs * v[j]) * g[j];
        *(v4u*)(WSP(bf16, WS_YRW) + off) = f32_to_bf16x8(o); }
}
constexpr int PH_PER_LAYER = 12, N_PHASES = 1 + NLAYER * PH_PER_LAYER;
#ifndef MK_PER_PHASE
#define MK_PER_PHASE 0
#endif
constexpr int NR_RWKV = 64 * RW_SPLIT;

__global__ void __launch_bounds__(NWAVES * 64, 2) mk_fwd(Args A) {
    extern __shared__ __attribute__((aligned(16))) unsigned char lds_raw[];
    volatile LAS unsigned* MISC = (volatile LAS unsigned*)((LAS unsigned char*)lds_raw + MISC_OFF);
    for (int u = threadIdx.x; u < (LDS_BYTES - LDSCTL_OFF) / 4; u += NWAVES * 64) ((LAS unsigned*)((LAS unsigned char*)lds_raw + LDSCTL_OFF))[u] = 0u;
    __syncthreads();
    XcdBarrier bar; bar.bar = (unsigned*)(A.ws + WS_CTL) + CW_BAR; bar.x = 0; bar.st = nullptr;
    if (!MK_PER_PHASE) bar = xcd_barrier_post((unsigned*)(A.ws + WS_CTL) + CW_BAR, MISC + 8);
    const int mk_wave0 = __builtin_amdgcn_readfirstlane((int)(threadIdx.x >> 6));
    const int lo = A.ph_lo, hi = A.ph_hi;
#ifndef PHMASK
#define PHMASK 0xFFFF
#endif
#define PHON(k) ((PHMASK >> (k)) & 1)
#define IN(k) (lo <= (k) && (k) < hi)
#define SEAM(k) do { if (IN(k) && IN((k) + 1)) xcd_barrier(bar, MK_TID() == 0); } while (0)
    using pg8::gemm_phase; using pg8::StaticOrder; using pg8::LocDense;

    if (PHON(0) && IN(0)) {
        MKFRAME(F);
        p0_prologue(F);
        for (int it = F.G - 1 - F.blk; it < NLAYER * 32; it += F.G) s5_gen(F, it >> 5, it & 31);
        { const int ns5 = NLAYER * 32; const bool split = F.G > ns5; const int nxb = split ? F.G - ns5 : F.G;
          if (!split || F.blk < nxb) { const int gw = F.blk * NWAVES + F.wave, NGW = nxb * NWAVES;
            for (int m = gw; m < M; m += 4 * NGW) { f32x4 v[4][4];
#pragma unroll
                for (int r = 0; r < 4; ++r) { const int mr = (m + r * NGW < M) ? m + r * NGW : m;
#pragma unroll
                    for (int j = 0; j < 4; ++j) v[r][j] = *(const f32x4*)(INP(float, 0) + (size_t)mr * DM + 4 * F.lane + 256 * j); }
#pragma unroll
                for (int r = 0; r < 4; ++r) { const int mr = m + r * NGW; if (mr < M) {
#pragma unroll
                    for (int j = 0; j < 4; ++j) { v2u w; w.x = cvt_pk_bf16(v[r][j][0], v[r][j][1]); w.y = cvt_pk_bf16(v[r][j][2], v[r][j][3]); *(v2u*)(WSP(bf16, WS_XB) + (size_t)mr * DM + 4 * F.lane + 256 * j) = w; } } } } } }
    }
    SEAM(0);

    for (int l = 0; l < NLAYER; ++l) {
        const int pb = 1 + l * PH_PER_LAYER;
        const bool moe = (l & 1) != 0; const int li = l >> 1;
        if (PHON(1) && IN(pb + 0)) {
            asm volatile("; ==PH1");
            MKFRAME(F);
            LocDense L{WSP(bf16, WS_XB), WSP(bf16, WS_WIN) + (size_t)l * 3072 * DM, DM, DM, DM, 0, 0};
            StaticOrder S; S.init(M, 3072, 1, F.G, F.blk);
            Epi8<FProj> E{{WSP(bf16, WS_MLARAW), WSP(bf16, WS_RWRAW), WSP(bf16, WS_S5U)}};
            gemm_phase(F.tid, F.lds + RING_OFF, L, S, E);
        }
        SEAM(pb + 0);
        if (PHON(2) && IN(pb + 1)) { MKFRAME(F); ph2_prep(F, l); }
        SEAM(pb + 1);
        if (PHON(3) && IN(pb + 2)) {
            asm volatile("; ==PH3");
            MKFRAME(F);
#ifndef P3SEL
#define P3SEL 31
#endif
            if (P3SEL & 1) { LocDense L{WSP(bf16, WS_CQN), WSP(bf16, WS_WUQ) + (size_t)l * 768 * 384, 384, 384, 384, 0, 0}; StaticOrder S; S.init(M, 768, 1, F.G, F.blk);
              Epi8<FQup> E{{WSP(bf16, WS_Q), WSP(float, WS_ROPE), 0.10206207261596575f * 1.4426950408889634f}}; gemm_phase(F.tid, F.lds + RING_OFF, L, S, E); }
            if (P3SEL & 2) { LocDense L{WSP(bf16, WS_CKVN), WSP(bf16, WS_WUKV) + (size_t)l * 1024 * 256, 256, 256, 256, 0, 0}; StaticOrder S; S.init(M, 1024, 1, F.G, F.blk);
              Epi8<FKVup> E{{WSP(bf16, WS_K), WSP(bf16, WS_V)}}; gemm_phase(F.tid, F.lds + RING_OFF, L, S, E); }
            if (P3SEL & 4) { LocDense L{WSP(bf16, WS_LORAIN), WSP(bf16, WS_WLORA) + (size_t)l * 1536 * 256, 256, 256, 256, 0, 0}; StaticOrder S; S.init(M, 1536, 1, F.G, F.blk);
              Epi8<FLora> E{{INP(float, 8) + l * 512, INP(float, 10) + l * 512, INP(float, 14) + l * 512, WSP(f16, WS_DCY), WSP(f16, WS_KH), WSP(f16, WS_KKN), WSP(f16, WS_BV), WSP(bf16, WS_GL), {}, {}}}; gemm_phase(F.tid, F.lds + RING_OFF, L, S, E); }
            if ((P3SEL & 8) && l > 0) { LocDense L{WSP(bf16, WS_VRAW), WSP(bf16, WS_WVRES) + (size_t)(l - 1) * 512 * 512, 512, 512, 512, 0, 0}; StaticOrder S; S.init(M, 512, 1, F.G, F.blk);
              Epi8<FVres> E{{INP(float, 20) + (l - 1) * 512, WSP(bf16, WS_VRAW), WSP(bf16, WS_VFIRST), WSP(f16, WS_VFIN), {}}}; gemm_phase(F.tid, F.lds + RING_OFF, L, S, E); }
            if (P3SEL & 16) { LocDense L{WSP(bf16, WS_S5U), WSP(bf16, WS_S5END) + (size_t)l * 32 * 256 * 512, S5K, 512, 512, (size_t)S5CH * S5K, (size_t)256 * 512}; StaticOrder S; S.init(S5CH, 256, 32, F.G, (F.blk + F.G / 2) % F.G);
              Epi8<FS5End> E{{WSP(float, WS_XEND)}}; gemm_phase(F.tid, F.lds + RING_OFF, L, S, E); }
        }
        SEAM(pb + 2);
        if (PHON(4) && IN(pb + 3)) {
            asm volatile("; ==PH4");
            MKFRAME(F);
#ifndef RW_REP
#define RW_REP 1
#endif
            if (F.blk < NR_RWKV && F.G > NR_RWKV) { for (int rr = 0; rr < RW_REP; ++rr) for (int un = F.blk; un < NBATCH * NH * RW_SPLIT; un += NR_RWKV) rwkv_scan(F, un); }
            else { const int ab = F.blk - NR_RWKV, na = F.G - NR_RWKV; for (int idx = ab * 512 + F.tid; idx < NBATCH * 32 * 64; idx += na * 512) s5_carry(F, l, idx); }
#ifndef ATT_REP
#define ATT_REP 1
#endif
            for (int rep = 0; rep < ATT_REP; ++rep) {
                LAS int* slot = (LAS int*)(F.lds + AT_LDS);
                for (;;) {
                    __syncthreads();
                    if (F.tid == 0) *slot = (int)__hip_atomic_fetch_add((unsigned*)(F.ctl + CW_ATTN + 64 * l + 16 * rep), 1u, RLX_AGENT);
                    __syncthreads();
                    const int n = __builtin_amdgcn_readfirstlane(*slot); if (n >= NBATCH * NH * (SEQ / AT_QR)) break;
                    const int qb = (SEQ / AT_QR - 1) - (n >> 6), bh = n & 63;
                    attn_unit(F.tid, bh >> 3, bh & 7, qb, WSP(bf16, WS_Q), WSP(bf16, WS_K), WSP(bf16, WS_V), WSP(bf16, WS_YMLA), F.lds);
                }
            }
        }
        SEAM(pb + 3);
        if (PHON(5) && IN(pb + 4)) {
            asm volatile("; ==PH5");
            MKFRAME(F);
            { LocDense L{WSP(bf16, WS_S5U), WSP(bf16, WS_S5MAIN) + (size_t)l * 32 * 512 * S5K, S5K, S5K, S5K, (size_t)S5CH * S5K, (size_t)512 * S5K}; StaticOrder S; S.init(S5CH, 512, 32, F.G, F.blk);
              Epi8<FS5Main> E{{WSP(bf16, WS_S5U), INP(float, 28) + l * 512, WSP(bf16, WS_YS5G), {}}}; gemm_phase(F.tid, F.lds + RING_OFF, L, S, E); }
            rwkv_post(F, l);
        }
        SEAM(pb + 4);
        if (PHON(6) && IN(pb + 5)) {
            asm volatile("; ==PH6");
            MKFRAME(F);
            { LocDense L{WSP(bf16, WS_YS5G), WSP(bf16, WS_WGLU) + (size_t)l * 512 * 512, 512, 512, 512, 0, 0}; StaticOrder S; S.init(M, 512, 1, F.G, F.blk);
              Epi8<FGlu> E{{WSP(bf16, WS_YS5G), INP(float, 30) + l * 512, WSP(bf16, WS_YS5), {}}}; gemm_phase(F.tid, F.lds + RING_OFF, L, S, E); }
            { LocDense L{WSP(bf16, WS_XB), WSP(bf16, WS_WG) + ((size_t)l * 3 + 0) * 1024 * DM, DM, DM, DM, 0, 0}; StaticOrder S; S.init(M, 2048, 1, F.G, F.blk);
              Epi8<FGate2> E{{WSP(bf16, WS_GBUF), WSP(bf16, WS_GBUF2)}}; gemm_phase(F.tid, F.lds + RING_OFF, L, S, E); }
            { LocDense L{WSP(bf16, WS_YMLA), WSP(bf16, WS_WBR) + ((size_t)l * 3 + 0) * 1024 * 512, 512, 512, 512, 0, 0}; StaticOrder S; S.init(M, 1024, 1, F.G, F.blk);
              Epi8<FMerge> E{{WSP(bf16, WS_GBUF), WSP(bf16, WS_MIXED2), WSP(bf16, WS_MIXED), 1, 1}}; gemm_phase(F.tid, F.lds + RING_OFF, L, S, E); }
            { LocDense L{WSP(bf16, WS_YRW), WSP(bf16, WS_WBR) + ((size_t)l * 3 + 1) * 1024 * 512, 512, 512, 512, 0, 0}; StaticOrder S; S.init(M, 1024, 1, F.G, F.blk);
              Epi8<FMerge> E{{WSP(bf16, WS_GBUF2), WSP(bf16, WS_MIXED), WSP(bf16, WS_MIXED2), 0, 1}}; gemm_phase(F.tid, F.lds + RING_OFF, L, S, E); }
        }
        SEAM(pb + 5);
        if (PHON(7) && IN(pb + 6)) {
            asm volatile("; ==PH7");
            MKFRAME(F);
            { LocDense L{WSP(bf16, WS_XB), WSP(bf16, WS_WG) + ((size_t)l * 3 + 2) * 1024 * DM, DM, DM, DM, 0, 0}; StaticOrder S; S.init(M, 1024, 1, F.G, F.blk);
              Epi8<FGate> E{{WSP(bf16, WS_GBUF)}}; gemm_phase(F.tid, F.lds + RING_OFF, L, S, E); }
            { LocDense L{WSP(bf16, WS_YS5), WSP(bf16, WS_WBR) + ((size_t)l * 3 + 2) * 1024 * 512, 512, 512, 512, 0, 0}; StaticOrder S; S.init(M, 1024, 1, F.G, F.blk);
              Epi8<FMerge> E{{WSP(bf16, WS_GBUF), WSP(bf16, WS_MIXED2), WSP(bf16, WS_MIXED), 0, 0}}; gemm_phase(F.tid, F.lds + RING_OFF, L, S, E); }
        }
        SEAM(pb + 6);
        if (PHON(8) && IN(pb + 7)) {
            asm volatile("; ==PH8");
            MKFRAME(F);
            LocDense L{WSP(bf16, WS_MIXED), WSP(bf16, WS_WOUT) + (size_t)l * DM * DM, DM, DM, DM, 0, 0}; StaticOrder S; S.init(M, DM, 1, F.G, F.blk);
            Epi8<FResid> E{{WSP(bf16, WS_XB), (f16*)F.out, 1.0f}}; gemm_phase(F.tid, F.lds + RING_OFF, L, S, E);
        }
        SEAM(pb + 7);
        if (PHON(9) && IN(pb + 8)) {
            asm volatile("; ==PH9");
            MKFRAME(F);
            if (moe) { ln1_moe_phase(F, INP(float, 33) + l * DM, INP(float, 34) + l * DM, li); moe_convert(F, li); }
            else ln_phase(F, INP(float, 33) + l * DM, INP(float, 34) + l * DM, FP8_DENSE ? WSP(unsigned char, WS_R) : (unsigned char*)nullptr);
        }
        SEAM(pb + 8);
        if (PHON(10) && IN(pb + 9)) {
            asm volatile("; ==PH10");
            MKFRAME(F);
            if (moe) {
                const unsigned* cnt = (const unsigned*)(F.ctl + CW_MOECNT + 64 * li);
                LocMoe1 L{FP8_MOE ? WSP(bf16, WS_XQM) : WSP(bf16, WS_XB), WSP(bf16, WS_WMGU), FP8_MOE ? DM / 2 : DM, FP8_MOE ? DM / 2 : DM, FP8_MOE ? DM / 2 : DM, WSP(int, WS_SLOTTOK), cnt}; MoeOrder S; S.init(cnt, 2 * EXD / 256, F.G, F.blk);
                EpiGU<FSwigluT<(FP8_MOED != 0)>> E{{WSP(bf16, WS_HM), EXD, FP8_MOE ? 1.0f / FP8_WSCALE : 1.0f}}; gemm_phase(F.tid, F.lds + RING_OFF, L, S, E);
            } else {
#if FP8_DENSE
                pg8::LocDense8 L{WSP(bf16, WS_R), WSP(bf16, WS_WFGU) + (size_t)li * FFN * DM, DM / 2, DM / 2, DM / 2, 0, 0}; StaticOrder S; S.init(M, 2 * FFN, 1, F.G, F.blk);
                EpiGU<FSwiglu> E{{WSP(bf16, WS_HB), FFN, 1.0f / FP8_WSCALE}}; gemm_phase(F.tid, F.lds + RING_OFF, L, S, E);
#else
                LocDense L{WSP(bf16, WS_XB), WSP(bf16, WS_WFGU) + (size_t)li * 2 * FFN * DM, DM, DM, DM, 0, 0}; StaticOrder S; S.init(M, 2 * FFN, 1, F.G, F.blk);
                EpiGU<FSwigluT<(FP8_DD != 0)>> E{{WSP(bf16, WS_HB), FFN, 1.0f}}; gemm_phase(F.tid, F.lds + RING_OFF, L, S, E);
#endif
            }
        }
        SEAM(pb + 9);
        if (PHON(11) && IN(pb + 10)) {
            asm volatile("; ==PH11");
            MKFRAME(F);
            if (moe) {
                const unsigned* cnt = (const unsigned*)(F.ctl + CW_MOECNT + 64 * li);
                constexpr int F8D = FP8_MOED ? 2 : 1; const float dsc = FP8_MOED ? 1.0f / (FP8_WSCALE * FP8_HSCALE) : 1.0f;
#if FP8_MOED
                { pg8::LocDense8 L{WSP(bf16, WS_HM), WSP(bf16, WS_WMD), EXD / 2, EXD / 2, EXD / 2, 0, (size_t)DM * EXD / 2}; MoeOrderFull S; S.init(cnt, DM / 256, F.G, F.blk);
#else
                { LocDense L{WSP(bf16, WS_HM), WSP(bf16, WS_WMD), EXD, EXD, EXD, 0, (size_t)DM * EXD}; MoeOrderFull S; S.init(cnt, DM / 256, F.G, F.blk);
#endif
                  Epi8<FMoeDown> E{{WSP(bf16, WS_YPAIR), WSP(float, WS_SLOTW), cnt, dsc}}; gemm_phase(MK_TID(), F.lds + RING_OFF, L, S, E); }
                { LocMoeTail L{WSP(bf16, WS_HM), WSP(bf16, WS_WMD), EXD / F8D, EXD / F8D, MT_K / F8D}; MoeTailOrder S; S.init(cnt, F.G, F.blk);
                  Epi8<FMoeTail> E{{moe_tail_slab(F, l), WSP(float, WS_SLOTW), cnt, dsc}}; gemm_phase(MK_TID(), F.lds + RING_OFF, L, S, E); }
            } else {
#if FP8_DD
                pg8::LocDense8 L{WSP(bf16, WS_HB), WSP(bf16, WS_WFD) + (size_t)li * DM * FFN / 2, FFN / 2, FFN / 2, FFN / 2, 0, 0}; StaticOrder S; S.init(M, DM, 1, F.G, F.blk);
                Epi8<FResid> E{{WSP(bf16, WS_XB), (f16*)F.out, 1.0f / (FP8_WSCALE * FP8_HSCALE)}}; gemm_phase(MK_TID(), F.lds + RING_OFF, L, S, E);
#else
                LocDense L{WSP(bf16, WS_HB), WSP(bf16, WS_WFD) + (size_t)li * DM * FFN, FFN, FFN, FFN, 0, 0}; StaticOrder S; S.init(M, DM, 1, F.G, F.blk);
                Epi8<FResid> E{{WSP(bf16, WS_XB), (f16*)F.out, 1.0f}}; gemm_phase(MK_TID(), F.lds + RING_OFF, L, S, E);
#endif
            }
        }
        SEAM(pb + 10);
        if (PHON(12) && IN(pb + 11)) {
            asm volatile("; ==PH12");
            MKFRAME(F);
            if (moe) ln2_moe_phase(F, INP(float, 35) + l * DM, INP(float, 36) + l * DM, li, l == NLAYER - 1, moe_tail_slab(F, l));
            else ln_phase(F, INP(float, 35) + l * DM, INP(float, 36) + l * DM);
        }
        SEAM(pb + 11);
    }
#undef IN
#undef SEAM
}

extern "C" void kernel_launch(void* const* d_in, const int* in_sizes, int n_in, void* d_out, int out_size, void* d_ws, size_t ws_size, hipStream_t stream) {
    static int grid = 0;
    if (grid == 0) {
        if (n_in != 44 || out_size != M * DM || ws_size < WS_END) { fprintf(stderr, "kernel_launch: unexpected problem (n_in %d, out %d, ws %zu < %zu)\n", n_in, out_size, ws_size, (size_t)WS_END); grid = -1; return; }
        int dev = 0, cus = 0, per_cu = 0;
        if (hipGetDevice(&dev) != hipSuccess || hipDeviceGetAttribute(&cus, hipDeviceAttributeMultiprocessorCount, dev) != hipSuccess) { grid = -1; return; }
        if (hipFuncSetAttribute((const void*)mk_fwd, hipFuncAttributeMaxDynamicSharedMemorySize, LDS_BYTES) != hipSuccess) { fprintf(stderr, "kernel_launch: hipFuncSetAttribute failed\n"); grid = -1; return; }
        if (hipOccupancyMaxActiveBlocksPerMultiprocessor(&per_cu, (const void*)mk_fwd, NWAVES * 64, LDS_BYTES) != hipSuccess || per_cu < 1) { fprintf(stderr, "kernel_launch: occupancy query says %d blocks per CU\n", per_cu); }
        (void)hipGetLastError();
        grid = cus;
        if (grid != 256) fprintf(stderr, "kernel_launch: %d CUs (built for 256)\n", grid);
    }
    if (grid < 0) return;
    (void)in_sizes;
    if (hipMemsetAsync((char*)d_ws + WS_CTL, 0, CTL_ZERO_BYTES, stream) != hipSuccess) return;
    Args a{};
    for (int i = 0; i < 44; ++i) a.in[i] = d_in[i];
    a.out = (float*)d_out; a.ws = (unsigned char*)d_ws; a.pad = 0;
#if MK_PER_PHASE
    for (int p = 0; p < N_PHASES; ++p) { a.ph_lo = p; a.ph_hi = p + 1; a.li = p; hipLaunchKernelGGL(mk_fwd, dim3(grid), dim3(NWAVES * 64), LDS_BYTES, stream, a); }
#else
    a.ph_lo = 0; a.ph_hi = N_PHASES; a.li = 0;
    hipLaunchKernelGGL(mk_fwd, dim3(grid), dim3(NWAVES * 64), LDS_BYTES, stream, a);
#endif
}
```
